# Optimizing an MI355X kernel written in HIP

```python
import jax, jax.numpy as jnp
from jax import lax
import numpy as np

D_MODEL = 1024
BATCH = 16
SEQ = 256
DEPTH = 4
DEC_BATCH = 8
DEC_SEQ = 1024
PAST_LEN = 512

GRID_W = 64
N_MIXERS = 2
N_RWKV_LAYERS = (DEPTH + 1) // 2
N_ATTN_LAYERS = DEPTH // 2
ALPHA = (2 * DEPTH) ** 0.25
BETA = (8 * DEPTH) ** -0.25
LN_EPS = 1e-5
RWKV_HEAD = 64
RWKV_HEADS = D_MODEL // RWKV_HEAD
DECAY_LORA = 64
ICLR_LORA = 64
GATE_LORA = 128
GN_EPS = RWKV_HEAD * 1e-5
HEAD_DIM = 64
N_HEADS = D_MODEL // HEAD_DIM
KV_HEADS = 4
GROUP = N_HEADS // KV_HEADS
Q_WIDTH = N_HEADS * HEAD_DIM
KV_WIDTH = KV_HEADS * HEAD_DIM
Q_BLOCK = 128
ROPE_THETA = 10000.0
ROPE_FREQS = HEAD_DIM // 4
ATTN_SCALE = HEAD_DIM ** -0.5
RMS_EPS = 1e-6
PEER_HEADS = 8
N_KEYS = 128
N_EXPERTS = N_KEYS * N_KEYS
PEER_QUERY = 256
PEER_HALF = PEER_QUERY // 2
PEER_TOPK = 16
PEER_BLOCK = 128

kernel_name = 'hybrid_rwkv7_gqa_peer_diffusion_step'


def residual_post_norm(x, branch, g, b):
    z = ALPHA * x.astype(jnp.float32) + branch.astype(jnp.float32)
    mu = jnp.mean(z, -1, keepdims=True)
    var = jnp.mean(jnp.square(z - mu), -1, keepdims=True)
    return ((z - mu) * lax.rsqrt(var + LN_EPS) * g + b).astype(x.dtype)


def rms_norm(x, g):
    xf = x.astype(jnp.float32)
    return (xf * lax.rsqrt(jnp.mean(xf * xf, -1, keepdims=True) + RMS_EPS) * g).astype(x.dtype)


def adaln_params(cond, w, b):
    return (jax.nn.silu(cond) @ w + b).reshape(cond.shape[0], 6, D_MODEL)


def modulate(x, shift, scale):
    return x * (1 + scale[:, None]) + shift[:, None]


def centred_shift(x):
    prev = jnp.pad(x[:, :-1], ((0, 0), (1, 0), (0, 0)))
    nxt = jnp.pad(x[:, 1:], ((0, 0), (0, 1), (0, 0)))
    return 0.5 * (prev + nxt)


def wkv_scan(r, w, k, v, kk, a, s0, reverse):
    def step(S, inp):
        r_t, w_t, k_t, v_t, kk_t, a_t = inp
        s_kk = jnp.einsum('bhij,bhj->bhi', S, kk_t)
        S = (S * w_t[:, :, None, :] - s_kk[..., None] * (kk_t * a_t)[:, :, None, :]
             + v_t[..., None] * k_t[:, :, None, :])
        return S, jnp.einsum('bhij,bhj->bhi', S, r_t)
    seq = tuple(jnp.swapaxes(t, 0, 1) for t in (r, w, k, v, kk, a))
    s_fin, y = lax.scan(step, s0, seq, reverse=reverse)
    return jnp.swapaxes(y, 0, 1), s_fin


def rwkv_time_mix(h, s0, mu, wrkv, wo, w0, w1, w2, a0, a1, a2, g1, g2, k_k, k_a, r_k, lnx_g, lnx_b):
    B, T, D = h.shape
    f32 = jnp.float32
    heads = lambda t: t.reshape(t.shape[:-1] + (RWKV_HEADS, RWKV_HEAD))
    xx = centred_shift(h) - h
    xr, xw, xk, xv, xa, xg = (h + xx * mu[m] for m in range(6))
    r = xr @ wrkv[0]
    k = xk @ wrkv[1]
    v = xv @ wrkv[2]
    wl = w0[:, None, None, :] + jnp.einsum('zbtl,zld->zbtd', jnp.tanh(jnp.einsum('btd,zdl->zbtl', xw, w1)), w2)
    decay = jnp.exp(-jnp.exp(-jax.nn.softplus(-wl.astype(f32)) - 0.5))
    a = jax.nn.sigmoid((a0[:, None, None, :] + jnp.einsum('zbtl,zld->zbtd', jnp.einsum('btd,zdl->zbtl', xa, a1), a2)).astype(f32))
    g = jax.nn.sigmoid(xg @ g1) @ g2
    kk = heads((k * k_k).astype(f32))
    kk = kk / jnp.maximum(jnp.sqrt(jnp.sum(kk * kk, -1, keepdims=True)), 1e-12)
    kd = k.astype(f32)[None] * (1 + (a - 1) * k_a.astype(f32))
    rf, vf = heads(r.astype(f32)), heads(v.astype(f32))
    s0 = s0.astype(f32)
    y_f, s_f = wkv_scan(rf, heads(decay[0]), heads(kd[0]), vf, kk, heads(a[0]), s0[:, 0], False)
    y_b, s_b = wkv_scan(rf, heads(decay[1]), heads(kd[1]), vf, kk, heads(a[1]), s0[:, 1], True)
    y = y_f + y_b
    ym = jnp.mean(y, -1, keepdims=True)
    yv = jnp.mean(jnp.square(y - ym), -1, keepdims=True)
    yn = ((y - ym) * lax.rsqrt(yv + GN_EPS)).reshape(B, T, D) * lnx_g + lnx_b
    bonus = jnp.sum(rf[None] * heads(kd) * r_k, axis=(0, -1))[..., None] * vf
    out = ((yn + bonus.reshape(B, T, D)).astype(h.dtype) * g) @ wo
    return out, jnp.stack([s_f, s_b], axis=1)


def axial_rope_angles(n):
    rows = n // GRID_W
    row = jnp.repeat(jnp.arange(rows), GRID_W).astype(jnp.float32)
    col = (jnp.arange(rows * GRID_W) % GRID_W).astype(jnp.float32)
    freqs = ROPE_THETA ** (-jnp.arange(ROPE_FREQS, dtype=jnp.float32) / ROPE_FREQS)
    ang = jnp.stack([row[:, None] * freqs, col[:, None] * freqs], axis=1)
    return jnp.cos(ang), jnp.sin(ang)


def apply_axial_rope(x, cos, sin):
    xs = x.astype(jnp.float32).reshape(x.shape[:-1] + (2, 2, ROPE_FREQS))
    bshape = (x.shape[1],) + (1,) * (x.ndim - 3) + (2, ROPE_FREQS)
    cos, sin = cos.reshape(bshape), sin.reshape(bshape)
    x1, x2 = xs[..., 0, :], xs[..., 1, :]
    out = jnp.stack([x1 * cos - x2 * sin, x2 * cos + x1 * sin], axis=-2)
    return out.reshape(x.shape).astype(x.dtype)


def attn_project(h, wqkv, qn, kn):
    B, n, _ = h.shape
    qkv = h @ wqkv
    q = rms_norm(qkv[..., :Q_WIDTH].reshape(B, n, KV_HEADS, GROUP, HEAD_DIM), qn)
    k = rms_norm(qkv[..., Q_WIDTH:Q_WIDTH + KV_WIDTH].reshape(B, n, KV_HEADS, HEAD_DIM), kn)
    v = qkv[..., Q_WIDTH + KV_WIDTH:].reshape(B, n, KV_HEADS, HEAD_DIM)
    return q, k, v


def block_attention(q, k, v):
    B, T = q.shape[:2]
    qb = jnp.moveaxis(q.reshape((B, T // Q_BLOCK, Q_BLOCK) + q.shape[2:]), 1, 0)
    def one_block(qi):
        s = jnp.einsum('bqkgd,bskd->bkgqs', qi, k).astype(jnp.float32) * ATTN_SCALE
        p = jax.nn.softmax(s, axis=-1).astype(v.dtype)
        return jnp.einsum('bkgqs,bskd->bqkgd', p, v)
    o = lax.map(one_block, qb)
    return jnp.moveaxis(o, 0, 1).reshape(q.shape)


def attention_context(h, wqkv, wo, qn, kn):
    q, k, v = attn_project(h, wqkv, qn, kn)
    o = block_attention(q, k, v)
    return o.reshape(h.shape[0], h.shape[1], Q_WIDTH) @ wo, k, v


def attention_latent(h, ctx_k, ctx_v, wqkv, wo, qn, kn):
    q, k, v = attn_project(h, wqkv, qn, kn)
    cos, sin = axial_rope_angles(h.shape[1])
    q = apply_axial_rope(q, cos, sin)
    k = apply_axial_rope(k, cos, sin)
    keys = jnp.concatenate([ctx_k.astype(k.dtype), k], axis=1)
    vals = jnp.concatenate([ctx_v.astype(v.dtype), v], axis=1)
    o = block_attention(q, keys, vals)
    return o.reshape(h.shape[0], h.shape[1], Q_WIDTH) @ wo


def peer_ffn(h, wq, sub_keys, u, v):
    B, n, D = h.shape
    x = h.reshape(B * n, D)
    q = (x @ wq).reshape(B * n, PEER_HEADS, 2, PEER_HALF)
    s = jnp.einsum('thzd,zkd->thzk', q, sub_keys).astype(jnp.float32)
    sv, si = lax.top_k(s, PEER_TOPK)
    cand = (sv[:, :, 0, :, None] + sv[:, :, 1, None, :]).reshape(B * n, PEER_HEADS, PEER_TOPK * PEER_TOPK)
    cv, ci = lax.top_k(cand, PEER_TOPK)
    i1 = jnp.take_along_axis(si[:, :, 0], ci // PEER_TOPK, axis=-1)
    i2 = jnp.take_along_axis(si[:, :, 1], ci % PEER_TOPK, axis=-1)
    idx = (i1 * N_KEYS + i2).reshape(-1, PEER_BLOCK, PEER_HEADS * PEER_TOPK)
    gate = jax.nn.softmax(cv, axis=-1).astype(x.dtype).reshape(-1, PEER_BLOCK, PEER_HEADS * PEER_TOPK)
    xb = x.reshape(-1, PEER_BLOCK, D)
    def experts(args):
        xt, it, gt = args
        act = jax.nn.gelu(jnp.einsum('tkd,td->tk', u[it], xt), approximate=False)
        return jnp.einsum('tk,tkd->td', gt * act, v[it])
    out = lax.map(experts, (xb, idx, gate))
    return out.reshape(B, n, D)


def setup_inputs(seed: int = 0) -> dict:
    key = jax.random.key(seed)
    ks = iter(jax.random.split(key, 40))
    nrm = lambda shape, scale: jax.random.normal(next(ks), shape, jnp.float32) * scale
    D = D_MODEL
    NR, NA = N_RWKV_LAYERS, N_ATTN_LAYERS
    return {
        'x_prompt': nrm((BATCH, SEQ, D), 1.0),
        'x_sample': nrm((DEC_BATCH, DEC_SEQ, D), 1.0),
        'c': nrm((DEC_BATCH, D), 1.0),
        'state_rwkv': nrm((DEC_BATCH, NR, 2, RWKV_HEADS, RWKV_HEAD, RWKV_HEAD), 1.0),
        'cache_k': nrm((DEC_BATCH, NA, PAST_LEN, KV_HEADS, HEAD_DIM), 1.0),
        'cache_v': nrm((DEC_BATCH, NA, PAST_LEN, KV_HEADS, HEAD_DIM), 1.0),
        'c_ctx': nrm((D,), 1.0),
        'ada_w': nrm((DEPTH, D, 6 * D), 0.5 * D ** -0.5),
        'ada_b': nrm((DEPTH, 6 * D), 0.02),
        'ln_g': 1.0 + nrm((DEPTH, 2, D), 0.02),
        'ln_b': nrm((DEPTH, 2, D), 0.02),
        'rwkv_mu': jax.random.uniform(next(ks), (NR, 6, D), jnp.float32),
        'rwkv_wrkv': nrm((NR, 3, D, D), D ** -0.5),
        'rwkv_wo': nrm((NR, D, D), BETA * D ** -0.5),
        'rwkv_w0': jax.random.uniform(next(ks), (NR, 2, D), jnp.float32, -6.0, -1.0),
        'rwkv_w1': nrm((NR, 2, D, DECAY_LORA), 0.1 * D ** -0.5),
        'rwkv_w2': nrm((NR, 2, DECAY_LORA, D), 0.1 * DECAY_LORA ** -0.5),
        'rwkv_a0': nrm((NR, 2, D), 0.1),
        'rwkv_a1': nrm((NR, 2, D, ICLR_LORA), 0.1 * D ** -0.5),
        'rwkv_a2': nrm((NR, 2, ICLR_LORA, D), 0.1 * ICLR_LORA ** -0.5),
        'rwkv_g1': nrm((NR, D, GATE_LORA), D ** -0.5),
        'rwkv_g2': nrm((NR, GATE_LORA, D), GATE_LORA ** -0.5),
        'rwkv_kk': 0.85 + nrm((NR, D), 0.05),
        'rwkv_ka': 1.0 + nrm((NR, D), 0.05),
        'rwkv_rk': nrm((NR, RWKV_HEADS, RWKV_HEAD), 0.1),
        'rwkv_lnx_g': 1.0 + nrm((NR, D), 0.02),
        'rwkv_lnx_b': nrm((NR, D), 0.02),
        'attn_wqkv': nrm((NA, D, Q_WIDTH + 2 * KV_WIDTH), D ** -0.5),
        'attn_wo': nrm((NA, Q_WIDTH, D), BETA * Q_WIDTH ** -0.5),
        'attn_qn': 1.0 + nrm((NA, HEAD_DIM), 0.02),
        'attn_kn': 1.0 + nrm((NA, HEAD_DIM), 0.02),
        'peer_wq': nrm((DEPTH, D, PEER_HEADS * PEER_QUERY), D ** -0.5),
        'peer_keys': nrm((DEPTH, 2, N_KEYS, PEER_HALF), PEER_HALF ** -0.5),
        'peer_u': nrm((DEPTH, N_EXPERTS, D), D ** -0.5),
        'peer_v': nrm((DEPTH, N_EXPERTS, D), BETA),
    }


def reference(x_prompt, x_sample, c, state_rwkv, cache_k, cache_v, c_ctx, ada_w, ada_b, ln_g, ln_b,
              rwkv_mu, rwkv_wrkv, rwkv_wo, rwkv_w0, rwkv_w1, rwkv_w2, rwkv_a0, rwkv_a1, rwkv_a2,
              rwkv_g1, rwkv_g2, rwkv_kk, rwkv_ka, rwkv_rk, rwkv_lnx_g, rwkv_lnx_b,
              attn_wqkv, attn_wo, attn_qn, attn_kn, peer_wq, peer_keys, peer_u, peer_v):
    xp, xs = x_prompt, x_sample
    states, keys_out, vals_out = [], [], []
    for i in range(DEPTH):
        j = i // N_MIXERS
        mod_p = adaln_params(c_ctx[None], ada_w[i], ada_b[i])
        mod_s = adaln_params(c, ada_w[i], ada_b[i])
        hp = modulate(xp, mod_p[:, 0], mod_p[:, 1])
        hs = modulate(xs, mod_s[:, 0], mod_s[:, 1])
        if i % N_MIXERS == 0:
            rw = (rwkv_mu[j], rwkv_wrkv[j], rwkv_wo[j], rwkv_w0[j], rwkv_w1[j], rwkv_w2[j],
                  rwkv_a0[j], rwkv_a1[j], rwkv_a2[j], rwkv_g1[j], rwkv_g2[j], rwkv_kk[j], rwkv_ka[j],
                  rwkv_rk[j], rwkv_lnx_g[j], rwkv_lnx_b[j])
            s_zero = jnp.zeros((xp.shape[0], 2, RWKV_HEADS, RWKV_HEAD, RWKV_HEAD), jnp.float32)
            op, s_ctx = rwkv_time_mix(hp, s_zero, *rw)
            os_, _ = rwkv_time_mix(hs, state_rwkv[:, j], *rw)
            states.append(s_ctx)
        else:
            op, kp, vp = attention_context(hp, attn_wqkv[j], attn_wo[j], attn_qn[j], attn_kn[j])
            os_ = attention_latent(hs, cache_k[:, j], cache_v[:, j], attn_wqkv[j], attn_wo[j], attn_qn[j], attn_kn[j])
            keys_out.append(kp)
            vals_out.append(vp)
        xp = residual_post_norm(xp, mod_p[:, 2][:, None] * op, ln_g[i, 0], ln_b[i, 0])
        xs = residual_post_norm(xs, mod_s[:, 2][:, None] * os_, ln_g[i, 0], ln_b[i, 0])
        hp = modulate(xp, mod_p[:, 3], mod_p[:, 4])
        hs = modulate(xs, mod_s[:, 3], mod_s[:, 4])
        fp = peer_ffn(hp, peer_wq[i], peer_keys[i], peer_u[i], peer_v[i])
        fs = peer_ffn(hs, peer_wq[i], peer_keys[i], peer_u[i], peer_v[i])
        xp = residual_post_norm(xp, mod_p[:, 5][:, None] * fp, ln_g[i, 1], ln_b[i, 1])
        xs = residual_post_norm(xs, mod_s[:, 5][:, None] * fs, ln_g[i, 1], ln_b[i, 1])
    new_state_rwkv = jnp.stack(states, axis=1)
    new_cache_k = jnp.stack(keys_out, axis=1)
    new_cache_v = jnp.stack(vals_out, axis=1)
    return (xp, xs, new_state_rwkv, new_cache_k, new_cache_v)
```

```cpp
#include <hip/hip_runtime.h>
#include <hip/hip_cooperative_groups.h>
#include <stdint.h>
#include <string.h>
#include <math.h>
#include <stdio.h>

namespace cg = cooperative_groups;

typedef unsigned short bf16_t;
typedef __attribute__((ext_vector_type(8))) short bf16x8;
typedef __attribute__((ext_vector_type(4))) float f32x4;
typedef __attribute__((ext_vector_type(16))) float f32x16;

#define DEVINL __device__ __forceinline__
#define NTHREADS 256
#define SMEM_BYTES 49152

#define DM 1024
#define TCTX 4096
#define TLAT 8192
#define TT 12288
#define ALPHA_F 1.681792830507429f
#define LN_EPS_F 1e-5f
#define GN_EPS_F 6.4e-4f
#define RMS_EPS_F 1e-6f
#define QSCALE_F (0.125f * 1.4426950408889634f)

#define OUT_Y 0
#define OUT_STATE 12582912
#define OUT_CK 16777216
#define OUT_CV 18874368

struct Params {
  const float* in[35];
  float* out;
  float* mod;
  float* rope;
  bf16_t* rwkv_in_t;
  bf16_t* w2t;
  bf16_t* a2t;
  bf16_t* g2t;
  bf16_t* rwkv_wo_t;
  bf16_t* attn_wqkv_t;
  bf16_t* attn_wo_t;
  bf16_t* wq_t;
  bf16_t* keysb;
  bf16_t* ub;
  bf16_t* vb;
  bf16_t* Klat;
  bf16_t* VlatT;
  bf16_t* Kctx;
  bf16_t* VctxT;
  float* xbuf;
  float* zbuf;
  bf16_t* hbuf;
  bf16_t* abuf;
  char* U1;
  char* U2;
  char* U3;
  int* pidx;
  float* pgate;
  double freqs[16];
};

DEVINL bf16_t f2bf(float f) {
  unsigned u = __float_as_uint(f);
  u += 0x7FFFu + ((u >> 16) & 1u);
  return (bf16_t)(u >> 16);
}
DEVINL float bf2f(bf16_t h) { return __uint_as_float(((unsigned)h) << 16); }
DEVINL unsigned pack2(float a, float b) { return (unsigned)f2bf(a) | ((unsigned)f2bf(b) << 16); }
DEVINL float bflo(unsigned u) { return __uint_as_float(u << 16); }
DEVINL float bfhi(unsigned u) { return __uint_as_float(u & 0xFFFF0000u); }

DEVINL float wave_sum(float v) {
#pragma unroll
  for (int o = 32; o > 0; o >>= 1) v += __shfl_xor(v, o);
  return v;
}
DEVINL float grp16_sum(float v) {
#pragma unroll
  for (int o = 8; o > 0; o >>= 1) v += __shfl_xor(v, o);
  return v;
}
DEVINL unsigned wave_max_u(unsigned v) {
#pragma unroll
  for (int o = 32; o > 0; o >>= 1) { unsigned t = (unsigned)__shfl_xor((int)v, o); v = v > t ? v : t; }
  return v;
}
DEVINL float sigmoidf_(float x) { return 1.0f / (1.0f + __expf(-x)); }
DEVINL float tanhf_(float x) { float e = __expf(-2.0f * fabsf(x)); float t = (1.0f - e) / (1.0f + e); return x < 0 ? -t : t; }
DEVINL unsigned ordf(float f) { unsigned u = __float_as_uint(f); return (u & 0x80000000u) ? ~u : (u | 0x80000000u); }

DEVINL int cond_of_row(int row) { return row < TCTX ? 8 : ((row - TCTX) >> 10); }

DEVINL void gemm_tile_128(const bf16_t* __restrict__ A, int lda, const bf16_t* __restrict__ Bt, int ldb, int K,
                          char* smem, f32x4 (&acc)[4][4]) {
  const int tid = threadIdx.x, wid = tid >> 6, lane = tid & 63;
  const int wr = wid >> 1, wc = wid & 1, fr = lane & 15, fq = lane >> 4;
  char* SA = smem;
  char* SB = smem + 8192;
#pragma unroll
  for (int m = 0; m < 4; ++m)
#pragma unroll
    for (int n = 0; n < 4; ++n) acc[m][n] = (f32x4){0.f, 0.f, 0.f, 0.f};
  for (int k0 = 0; k0 < K; k0 += 32) {
#pragma unroll
    for (int i = 0; i < 2; ++i) {
      int b = tid * 16 + i * 4096;
      int r = b >> 6, c = (b & 63) >> 1;
      __builtin_amdgcn_global_load_lds((const unsigned*)(A + (size_t)r * lda + k0 + c), (unsigned*)(SA + b), 16, 0, 0);
      __builtin_amdgcn_global_load_lds((const unsigned*)(Bt + (size_t)r * ldb + k0 + c), (unsigned*)(SB + b), 16, 0, 0);
    }
    asm volatile("s_waitcnt vmcnt(0)" ::: "memory");
    __syncthreads();
    bf16x8 a[4], b[4];
#pragma unroll
    for (int m = 0; m < 4; ++m) a[m] = *reinterpret_cast<const bf16x8*>(SA + (wr * 64 + m * 16 + fr) * 64 + fq * 16);
#pragma unroll
    for (int n = 0; n < 4; ++n) b[n] = *reinterpret_cast<const bf16x8*>(SB + (wc * 64 + n * 16 + fr) * 64 + fq * 16);
#pragma unroll
    for (int m = 0; m < 4; ++m)
#pragma unroll
      for (int n = 0; n < 4; ++n) acc[m][n] = __builtin_amdgcn_mfma_f32_16x16x32_bf16(a[m], b[n], acc[m][n], 0, 0, 0);
    __syncthreads();
  }
}

#define GEMM_LANE_VARS \
  const int tid = threadIdx.x, wid = tid >> 6, lane = tid & 63; \
  const int wr = wid >> 1, wc = wid & 1, fr = lane & 15, fq = lane >> 4; \
  (void)tid; (void)wid; (void)lane; (void)wr; (void)wc; (void)fr; (void)fq;

DEVINL void get_tjob(const Params& p, int ji, const float*& src, bf16_t*& dst, int& K, int& N) {
  if (ji < 28) {
    int j = ji / 14, s = ji % 14;
    if (s < 3) { src = p.in[12] + ((size_t)(j * 3 + s) << 20); dst = p.rwkv_in_t + (size_t)j * 3456 * 1024 + ((size_t)s << 20); K = 1024; N = 1024; }
    else if (s < 5) { int z = s - 3; src = p.in[15] + (size_t)(j * 2 + z) * 65536; dst = p.rwkv_in_t + (size_t)j * 3456 * 1024 + (size_t)(3072 + z * 64) * 1024; K = 1024; N = 64; }
    else if (s < 7) { int z = s - 5; src = p.in[18] + (size_t)(j * 2 + z) * 65536; dst = p.rwkv_in_t + (size_t)j * 3456 * 1024 + (size_t)(3200 + z * 64) * 1024; K = 1024; N = 64; }
    else if (s == 7) { src = p.in[20] + (size_t)j * 131072; dst = p.rwkv_in_t + (size_t)j * 3456 * 1024 + (size_t)3328 * 1024; K = 1024; N = 128; }
    else if (s < 10) { int z = s - 8; src = p.in[16] + (size_t)(j * 2 + z) * 65536; dst = p.w2t + (size_t)(j * 2 + z) * 65536; K = 64; N = 1024; }
    else if (s < 12) { int z = s - 10; src = p.in[19] + (size_t)(j * 2 + z) * 65536; dst = p.a2t + (size_t)(j * 2 + z) * 65536; K = 64; N = 1024; }
    else if (s == 12) { src = p.in[21] + (size_t)j * 131072; dst = p.g2t + (size_t)j * 131072; K = 128; N = 1024; }
    else { src = p.in[13] + ((size_t)j << 20); dst = p.rwkv_wo_t + ((size_t)j << 20); K = 1024; N = 1024; }
  } else if (ji < 32) {
    int j = (ji - 28) >> 1, s = (ji - 28) & 1;
    if (s == 0) { src = p.in[27] + (size_t)j * 1024 * 1536; dst = p.attn_wqkv_t + (size_t)j * 1536 * 1024; K = 1024; N = 1536; }
    else { src = p.in[28] + ((size_t)j << 20); dst = p.attn_wo_t + ((size_t)j << 20); K = 1024; N = 1024; }
  } else {
    int i = ji - 32;
    src = p.in[31] + (size_t)i * 1024 * 2048; dst = p.wq_t + (size_t)i * 2048 * 1024; K = 1024; N = 2048;
  }
}

DEVINL void sincos_d(double x, float& c, float& s) {
  const double TWO_PI = 6.283185307179586476925;
  double r = x - TWO_PI * rint(x / TWO_PI);
  double r2 = r * r;
  double ts = r, tc = 1.0, ss = r, cs = 1.0;
#pragma unroll 1
  for (int n = 1; n <= 14; ++n) {
    tc = -tc * r2 / (double)((2 * n - 1) * (2 * n));
    ts = -ts * r2 / (double)((2 * n) * (2 * n + 1));
    cs += tc; ss += ts;
  }
  c = (float)cs; s = (float)ss;
}

DEVINL void phase_prep(const Params& p, int w, int nw, char* smem) {
  const int tid = threadIdx.x;
  {
    float (*tile)[65] = reinterpret_cast<float (*)[65]>(smem);
    int toff = 0;
    for (int ji = 0; ji < 36; ++ji) {
      const float* src; bf16_t* dst; int K, N;
      get_tjob(p, ji, src, dst, K, N);
      const int tn = N >> 6, nt = (K >> 6) * tn;
      int t0 = (w - (toff % nw) + nw) % nw;
      for (int t = t0; t < nt; t += nw) {
        const int k0 = (t / tn) << 6, n0 = (t % tn) << 6;
#pragma unroll
        for (int i = 0; i < 4; ++i) {
          int r = (tid >> 4) + 16 * i, c = (tid & 15) * 4;
          float4 v = *reinterpret_cast<const float4*>(src + (size_t)(k0 + r) * N + n0 + c);
          tile[r][c] = v.x; tile[r][c + 1] = v.y; tile[r][c + 2] = v.z; tile[r][c + 3] = v.w;
        }
        __syncthreads();
#pragma unroll
        for (int i = 0; i < 2; ++i) {
          int q = tid + 256 * i;
          int n = q >> 3, kc = (q & 7) * 8;
          uint4 o;
          o.x = pack2(tile[kc + 0][n], tile[kc + 1][n]);
          o.y = pack2(tile[kc + 2][n], tile[kc + 3][n]);
          o.z = pack2(tile[kc + 4][n], tile[kc + 5][n]);
          o.w = pack2(tile[kc + 6][n], tile[kc + 7][n]);
          *reinterpret_cast<uint4*>(dst + (size_t)(n0 + n) * K + k0 + kc) = o;
        }
        __syncthreads();
      }
      toff += nt;
    }
  }
  const size_t gtid = (size_t)w * NTHREADS + tid, gn = (size_t)nw * NTHREADS;
  {
    const size_t n8 = (size_t)4 * 16384 * 1024 / 8;
    for (size_t i = gtid; i < n8; i += gn) {
      const float4* su = reinterpret_cast<const float4*>(p.in[33]) + i * 2;
      float4 a = su[0], b = su[1];
      uint4 o; o.x = pack2(a.x, a.y); o.y = pack2(a.z, a.w); o.z = pack2(b.x, b.y); o.w = pack2(b.z, b.w);
      reinterpret_cast<uint4*>(p.ub)[i] = o;
      const float4* sv = reinterpret_cast<const float4*>(p.in[34]) + i * 2;
      a = sv[0]; b = sv[1];
      o.x = pack2(a.x, a.y); o.y = pack2(a.z, a.w); o.z = pack2(b.x, b.y); o.w = pack2(b.z, b.w);
      reinterpret_cast<uint4*>(p.vb)[i] = o;
    }
    const size_t nk8 = (size_t)4 * 2 * 128 * 128 / 8;
    for (size_t i = gtid; i < nk8; i += gn) {
      const float4* su = reinterpret_cast<const float4*>(p.in[32]) + i * 2;
      float4 a = su[0], b = su[1];
      uint4 o; o.x = pack2(a.x, a.y); o.y = pack2(a.z, a.w); o.z = pack2(b.x, b.y); o.w = pack2(b.z, b.w);
      reinterpret_cast<uint4*>(p.keysb)[i] = o;
    }
  }
  {
    const size_t nk = (size_t)8 * 2 * 512 * 4 * 64;
    for (size_t i = gtid; i < nk; i += gn) {
      int d = i & 63, kvh = (i >> 6) & 3, s = (i >> 8) & 511, j = (i >> 17) & 1, b = (int)(i >> 18);
      p.Klat[((size_t)((j * 8 + b) * 4 + kvh) * 1536 + s) * 64 + d] = f2bf(p.in[4][i]);
      p.VlatT[((size_t)((j * 8 + b) * 4 + kvh) * 64 + d) * 1536 + s] = f2bf(p.in[5][i]);
    }
  }
  for (size_t i = gtid; i < 1024; i += gn) {
    int pos = (int)(i >> 4), f = (int)(i & 15);
    float c, s; sincos_d((double)pos * p.freqs[f], c, s);
    p.rope[i * 2] = c; p.rope[i * 2 + 1] = s;
  }
  {
    const size_t n4 = (size_t)TT * DM / 4, nc4 = (size_t)TCTX * DM / 4;
    for (size_t i = gtid; i < n4; i += gn) {
      float4 v = (i < nc4) ? reinterpret_cast<const float4*>(p.in[0])[i] : reinterpret_cast<const float4*>(p.in[1])[i - nc4];
      reinterpret_cast<float4*>(p.xbuf)[i] = v;
    }
  }
  {
    float* sc = reinterpret_cast<float*>(smem);
    float* red = sc + 9 * 1024;
    bool loaded = false;
    for (int item = w; item < 384; item += nw) {
      if (!loaded) {
        __syncthreads();
        for (int e = tid; e < 9 * 1024; e += NTHREADS) {
          int c = e >> 10, d = e & 1023;
          float v = (c < 8) ? p.in[2][c * 1024 + d] : p.in[6][d];
          sc[e] = v / (1.0f + __expf(-v));
        }
        __syncthreads();
        loaded = true;
      }
      const int i = item / 96, cc = item % 96;
      const int col = cc * 64 + (tid & 63), ks = tid >> 6;
      float acc[9];
#pragma unroll
      for (int c = 0; c < 9; ++c) acc[c] = 0.f;
      const float* wp = p.in[7] + (size_t)i * 1024 * 6144 + col;
      for (int d = ks * 256; d < ks * 256 + 256; ++d) {
        float wv = wp[(size_t)d * 6144];
#pragma unroll
        for (int c = 0; c < 9; ++c) acc[c] += sc[c * 1024 + d] * wv;
      }
#pragma unroll
      for (int c = 0; c < 9; ++c) red[(ks * 9 + c) * 64 + (tid & 63)] = acc[c];
      __syncthreads();
      for (int o = tid; o < 576; o += NTHREADS) {
        int c = o >> 6, cl = o & 63;
        float s = red[(0 * 9 + c) * 64 + cl] + red[(1 * 9 + c) * 64 + cl] + red[(2 * 9 + c) * 64 + cl] + red[(3 * 9 + c) * 64 + cl];
        int n = cc * 64 + cl;
        p.mod[((size_t)i * 9 + c) * 6144 + n] = s + p.in[8][i * 6144 + n];
      }
      __syncthreads();
    }
  }
}

DEVINL void phase_r1(const Params& p, int layer, int w, int nw) {
  const int j = layer >> 1;
  const int lane = threadIdx.x & 63;
  const int gw = w * 4 + (threadIdx.x >> 6), ngw = nw * 4;
  bf16_t* A6 = reinterpret_cast<bf16_t*>(p.U1);
  const float* mu = p.in[11] + (size_t)j * 6 * 1024;
  for (int row = gw; row < TT; row += ngw) {
    int t, Tlen;
    if (row < TCTX) { t = row & 255; Tlen = 256; } else { t = (row - TCTX) & 1023; Tlen = 1024; }
    const int cond = cond_of_row(row);
    const float* sh = p.mod + ((size_t)layer * 9 + cond) * 6144;
    const float* sc = sh + 1024;
    const bool hasp = t > 0, hasn = t < Tlen - 1;
#pragma unroll
    for (int k = 0; k < 4; ++k) {
      const int col = k * 256 + lane * 4;
      const float4 xc = *reinterpret_cast<const float4*>(p.xbuf + (size_t)row * DM + col);
      float4 xp = make_float4(0, 0, 0, 0), xn = make_float4(0, 0, 0, 0);
      if (hasp) xp = *reinterpret_cast<const float4*>(p.xbuf + (size_t)(row - 1) * DM + col);
      if (hasn) xn = *reinterpret_cast<const float4*>(p.xbuf + (size_t)(row + 1) * DM + col);
      const float4 s4 = *reinterpret_cast<const float4*>(sh + col);
      const float4 c4 = *reinterpret_cast<const float4*>(sc + col);
      float h[4], xx[4];
      const float xcv[4] = {xc.x, xc.y, xc.z, xc.w}, xpv[4] = {xp.x, xp.y, xp.z, xp.w}, xnv[4] = {xn.x, xn.y, xn.z, xn.w};
      const float shv[4] = {s4.x, s4.y, s4.z, s4.w}, scv[4] = {c4.x, c4.y, c4.z, c4.w};
#pragma unroll
      for (int e = 0; e < 4; ++e) {
        float g = 1.0f + scv[e];
        h[e] = xcv[e] * g + shv[e];
        float hp = hasp ? (xpv[e] * g + shv[e]) : 0.f;
        float hn = hasn ? (xnv[e] * g + shv[e]) : 0.f;
        xx[e] = 0.5f * (hp + hn) - h[e];
      }
#pragma unroll
      for (int m = 0; m < 6; ++m) {
        const float4 m4 = *reinterpret_cast<const float4*>(mu + m * 1024 + col);
        uint2 o;
        o.x = pack2(h[0] + xx[0] * m4.x, h[1] + xx[1] * m4.y);
        o.y = pack2(h[2] + xx[2] * m4.z, h[3] + xx[3] * m4.w);
        *reinterpret_cast<uint2*>(A6 + ((size_t)m * TT + row) * DM + col) = o;
      }
    }
  }
}

#define U1_AA_OFF ((size_t)2 * TT * DM * 4)
#define U1_GG_OFF (U1_AA_OFF + (size_t)2 * TT * DM * 2)

DEVINL void phase_r2(const Params& p, int layer, int w, int nw, char* smem) {
  const int j = layer >> 1;
  GEMM_LANE_VARS
  const bf16_t* A6 = reinterpret_cast<const bf16_t*>(p.U1);
  bf16_t* rb = reinterpret_cast<bf16_t*>(p.U2);
  bf16_t* kb = rb + (size_t)TT * DM;
  bf16_t* vb = kb + (size_t)TT * DM;
  bf16_t* kkb = vb + (size_t)TT * DM;
  bf16_t* lw = p.abuf;
  bf16_t* la = lw + (size_t)TT * 128;
  bf16_t* lg = la + (size_t)TT * 128;
  const bf16_t* Wt = p.rwkv_in_t + (size_t)j * 3456 * 1024;
  const float* k_k = p.in[22] + j * 1024;
  for (int tile = w; tile < 96 * 27; tile += nw) {
    const int ct = tile / 96, rt = tile % 96;
    const int mA = ct < 8 ? 0 : ct < 16 ? 2 : ct < 24 ? 3 : ct == 24 ? 1 : ct == 25 ? 4 : 5;
    const int row0 = rt * 128;
    f32x4 acc[4][4];
    gemm_tile_128(A6 + ((size_t)mA * TT + row0) * DM, DM, Wt + (size_t)ct * 128 * 1024, DM, 1024, smem, acc);
    if (ct < 8 || (ct >= 16 && ct < 24)) {
      bf16_t* dst = ct < 8 ? rb : vb;
      const int cbase = (ct & 7) * 128 + wc * 64;
#pragma unroll
      for (int m = 0; m < 4; ++m)
#pragma unroll
        for (int n = 0; n < 4; ++n)
#pragma unroll
          for (int jj = 0; jj < 4; ++jj) {
            int row = row0 + wr * 64 + m * 16 + fq * 4 + jj;
            dst[(size_t)row * DM + cbase + n * 16 + fr] = f2bf(acc[m][n][jj]);
          }
    } else if (ct < 16) {
      const int cbase = (ct - 8) * 128 + wc * 64;
      float kkw[4];
#pragma unroll
      for (int n = 0; n < 4; ++n) kkw[n] = k_k[cbase + n * 16 + fr];
#pragma unroll
      for (int m = 0; m < 4; ++m)
#pragma unroll
        for (int jj = 0; jj < 4; ++jj) {
          int row = row0 + wr * 64 + m * 16 + fq * 4 + jj;
          float kv[4], ss = 0.f;
#pragma unroll
          for (int n = 0; n < 4; ++n) { kv[n] = acc[m][n][jj] * kkw[n]; ss += kv[n] * kv[n]; }
          ss = grp16_sum(ss);
          float inv = 1.0f / fmaxf(sqrtf(ss), 1e-12f);
#pragma unroll
          for (int n = 0; n < 4; ++n) {
            kb[(size_t)row * DM + cbase + n * 16 + fr] = f2bf(acc[m][n][jj]);
            kkb[(size_t)row * DM + cbase + n * 16 + fr] = f2bf(kv[n] * inv);
          }
        }
    } else {
      bf16_t* dst = ct == 24 ? lw : ct == 25 ? la : lg;
#pragma unroll
      for (int m = 0; m < 4; ++m)
#pragma unroll
        for (int n = 0; n < 4; ++n)
#pragma unroll
          for (int jj = 0; jj < 4; ++jj) {
            int row = row0 + wr * 64 + m * 16 + fq * 4 + jj;
            float v = acc[m][n][jj];
            if (ct == 24) v = tanhf_(v); else if (ct == 26) v = sigmoidf_(v);
            dst[(size_t)row * 128 + wc * 64 + n * 16 + fr] = f2bf(v);
          }
    }
  }
}

DEVINL void phase_r3(const Params& p, int layer, int w, int nw, char* smem) {
  const int j = layer >> 1;
  GEMM_LANE_VARS
  const bf16_t* lw = p.abuf;
  const bf16_t* la = lw + (size_t)TT * 128;
  const bf16_t* lg = la + (size_t)TT * 128;
  float* wdec = reinterpret_cast<float*>(p.U1);
  bf16_t* aa = reinterpret_cast<bf16_t*>(p.U1 + U1_AA_OFF);
  bf16_t* gg = reinterpret_cast<bf16_t*>(p.U1 + U1_GG_OFF);
  for (int tile = w; tile < 96 * 40; tile += nw) {
    const int ct = tile / 96, rt = tile % 96;
    const int job = ct >> 3, nt = ct & 7;
    const int row0 = rt * 128, col0 = nt * 128;
    f32x4 acc[4][4];
    if (job < 2) {
      const int z = job;
      gemm_tile_128(lw + (size_t)row0 * 128 + z * 64, 128, p.w2t + (size_t)(j * 2 + z) * 65536 + (size_t)col0 * 64, 64, 64, smem, acc);
      const float* w0 = p.in[14] + (size_t)(j * 2 + z) * 1024;
#pragma unroll
      for (int m = 0; m < 4; ++m)
#pragma unroll
        for (int n = 0; n < 4; ++n)
#pragma unroll
          for (int jj = 0; jj < 4; ++jj) {
            int row = row0 + wr * 64 + m * 16 + fq * 4 + jj, col = col0 + wc * 64 + n * 16 + fr;
            float wl = acc[m][n][jj] + w0[col];
            wdec[((size_t)z * TT + row) * DM + col] = __expf(-0.6065306597126334f * sigmoidf_(wl));
          }
    } else if (job < 4) {
      const int z = job - 2;
      gemm_tile_128(la + (size_t)row0 * 128 + z * 64, 128, p.a2t + (size_t)(j * 2 + z) * 65536 + (size_t)col0 * 64, 64, 64, smem, acc);
      const float* a0 = p.in[17] + (size_t)(j * 2 + z) * 1024;
#pragma unroll
      for (int m = 0; m < 4; ++m)
#pragma unroll
        for (int n = 0; n < 4; ++n)
#pragma unroll
          for (int jj = 0; jj < 4; ++jj) {
            int row = row0 + wr * 64 + m * 16 + fq * 4 + jj, col = col0 + wc * 64 + n * 16 + fr;
            aa[((size_t)z * TT + row) * DM + col] = f2bf(sigmoidf_(acc[m][n][jj] + a0[col]));
          }
    } else {
      gemm_tile_128(lg + (size_t)row0 * 128, 128, p.g2t + (size_t)j * 131072 + (size_t)col0 * 128, 128, 128, smem, acc);
#pragma unroll
      for (int m = 0; m < 4; ++m)
#pragma unroll
        for (int n = 0; n < 4; ++n)
#pragma unroll
          for (int jj = 0; jj < 4; ++jj) {
            int row = row0 + wr * 64 + m * 16 + fq * 4 + jj, col = col0 + wc * 64 + n * 16 + fr;
            gg[(size_t)row * DM + col] = f2bf(acc[m][n][jj]);
          }
    }
  }
}

DEVINL void phase_r4(const Params& p, int layer, int w, int nw, char* smem) {
  const int j = layer >> 1;
  const int lane = threadIdx.x & 63, wid = threadIdx.x >> 6;
  const bf16_t* rb = reinterpret_cast<const bf16_t*>(p.U2);
  const bf16_t* kb = rb + (size_t)TT * DM;
  const bf16_t* vb = kb + (size_t)TT * DM;
  const bf16_t* kkb = vb + (size_t)TT * DM;
  const float* wdec = reinterpret_cast<const float*>(p.U1);
  const bf16_t* aa = reinterpret_cast<const bf16_t*>(p.U1 + U1_AA_OFF);
  float* yout = reinterpret_cast<float*>(p.U3);
  float* lds = reinterpret_cast<float*>(smem) + wid * (8 * 5 * 64);
  for (int c = w + nw * wid; c < 768; c += nw * 4) {
    int seq, h, z;
    if (c < 256) { seq = 16 + (c >> 5); h = (c >> 1) & 15; z = c & 1; }
    else { int cc = c - 256; seq = cc >> 5; h = (cc >> 1) & 15; z = cc & 1; }
    const int Tlen = seq < 16 ? 256 : 1024;
    const int base = seq < 16 ? seq * 256 : TCTX + (seq - 16) * 1024;
    const int colb = h * 64;
    const float kal = p.in[23][j * 1024 + colb + lane];
    float S[64];
    if (seq >= 16) {
      const float* s0 = p.in[3] + ((((size_t)(seq - 16) * 2 + j) * 2 + z) * 16 + h) * 4096 + (size_t)lane * 64;
#pragma unroll
      for (int q = 0; q < 16; ++q) {
        float4 v = reinterpret_cast<const float4*>(s0)[q];
        S[q * 4] = v.x; S[q * 4 + 1] = v.y; S[q * 4 + 2] = v.z; S[q * 4 + 3] = v.w;
      }
    } else {
#pragma unroll
      for (int q = 0; q < 64; ++q) S[q] = 0.f;
    }
    for (int t0 = 0; t0 < Tlen; t0 += 8) {
      float vreg[8];
      __builtin_amdgcn_wave_barrier();
#pragma unroll
      for (int tt = 0; tt < 8; ++tt) {
        const int t = t0 + tt;
        const int row = base + (z == 0 ? t : (Tlen - 1 - t));
        const size_t o = (size_t)row * DM + colb + lane;
        float r = bf2f(rb[o]), k = bf2f(kb[o]), kk = bf2f(kkb[o]);
        vreg[tt] = bf2f(vb[o]);
        float a = bf2f(aa[(size_t)z * TT * DM + o]);
        float wd = wdec[(size_t)z * TT * DM + o];
        float* l = lds + tt * 320;
        l[lane] = r; l[64 + lane] = wd; l[128 + lane] = k * (1.0f + (a - 1.0f) * kal); l[192 + lane] = kk; l[256 + lane] = kk * a;
      }
      __builtin_amdgcn_wave_barrier();
#pragma unroll 1
      for (int tt = 0; tt < 8; ++tt) {
        const float* l = lds + tt * 320;
        const float vi = vreg[0];
        float skk = 0.f;
#pragma unroll
        for (int q = 0; q < 16; ++q) {
          float4 kk4 = reinterpret_cast<const float4*>(l + 192)[q];
          skk += S[q * 4] * kk4.x + S[q * 4 + 1] * kk4.y + S[q * 4 + 2] * kk4.z + S[q * 4 + 3] * kk4.w;
        }
        float y = 0.f;
#pragma unroll
        for (int q = 0; q < 16; ++q) {
          float4 w4 = reinterpret_cast<const float4*>(l + 64)[q];
          float4 k4 = reinterpret_cast<const float4*>(l + 128)[q];
          float4 a4 = reinterpret_cast<const float4*>(l + 256)[q];
          float4 r4 = reinterpret_cast<const float4*>(l)[q];
          S[q * 4 + 0] = S[q * 4 + 0] * w4.x + (vi * k4.x - skk * a4.x);
          S[q * 4 + 1] = S[q * 4 + 1] * w4.y + (vi * k4.y - skk * a4.y);
          S[q * 4 + 2] = S[q * 4 + 2] * w4.z + (vi * k4.z - skk * a4.z);
          S[q * 4 + 3] = S[q * 4 + 3] * w4.w + (vi * k4.w - skk * a4.w);
          y += S[q * 4] * r4.x + S[q * 4 + 1] * r4.y + S[q * 4 + 2] * r4.z + S[q * 4 + 3] * r4.w;
        }
        const int t = t0 + tt;
        const int row = base + (z == 0 ? t : (Tlen - 1 - t));
        yout[((size_t)z * TT + row) * DM + colb + lane] = y;
#pragma unroll
        for (int q = 0; q < 7; ++q) vreg[q] = vreg[q + 1];
      }
    }
    if (seq < 16) {
      float* so = p.out + OUT_STATE + ((((size_t)seq * 2 + j) * 2 + z) * 16 + h) * 4096 + (size_t)lane * 64;
#pragma unroll
      for (int q = 0; q < 16; ++q) reinterpret_cast<float4*>(so)[q] = make_float4(S[q * 4], S[q * 4 + 1], S[q * 4 + 2], S[q * 4 + 3]);
    }
  }
}

DEVINL void phase_r5(const Params& p, int layer, int w, int nw) {
  const int j = layer >> 1;
  const int lane = threadIdx.x & 63;
  const int gw = w * 4 + (threadIdx.x >> 6), ngw = nw * 4;
  const bf16_t* rb = reinterpret_cast<const bf16_t*>(p.U2);
  const bf16_t* kb = rb + (size_t)TT * DM;
  const bf16_t* vb = kb + (size_t)TT * DM;
  const bf16_t* aa = reinterpret_cast<const bf16_t*>(p.U1 + U1_AA_OFF);
  const bf16_t* gg = reinterpret_cast<const bf16_t*>(p.U1 + U1_GG_OFF);
  const float* yin = reinterpret_cast<const float*>(p.U3);
  const float* ka = p.in[23] + j * 1024;
  const float* rk = p.in[24] + j * 1024;
  const float* lg = p.in[25] + j * 1024;
  const float* lb = p.in[26] + j * 1024;
  for (int row = gw; row < TT; row += ngw) {
#pragma unroll
    for (int k = 0; k < 4; ++k) {
      const int col = k * 256 + lane * 4;
      const size_t o = (size_t)row * DM + col;
      const float4 yf = *reinterpret_cast<const float4*>(yin + o);
      const float4 yb = *reinterpret_cast<const float4*>(yin + (size_t)TT * DM + o);
      const uint2 r2 = *reinterpret_cast<const uint2*>(rb + o);
      const uint2 k2 = *reinterpret_cast<const uint2*>(kb + o);
      const uint2 v2 = *reinterpret_cast<const uint2*>(vb + o);
      const uint2 a02 = *reinterpret_cast<const uint2*>(aa + o);
      const uint2 a12 = *reinterpret_cast<const uint2*>(aa + (size_t)TT * DM + o);
      const uint2 g2 = *reinterpret_cast<const uint2*>(gg + o);
      const float4 ka4 = *reinterpret_cast<const float4*>(ka + col);
      const float4 rk4 = *reinterpret_cast<const float4*>(rk + col);
      const float4 lg4 = *reinterpret_cast<const float4*>(lg + col);
      const float4 lb4 = *reinterpret_cast<const float4*>(lb + col);
      float y[4] = {yf.x + yb.x, yf.y + yb.y, yf.z + yb.z, yf.w + yb.w};
      float r[4] = {bflo(r2.x), bfhi(r2.x), bflo(r2.y), bfhi(r2.y)};
      float kx[4] = {bflo(k2.x), bfhi(k2.x), bflo(k2.y), bfhi(k2.y)};
      float v[4] = {bflo(v2.x), bfhi(v2.x), bflo(v2.y), bfhi(v2.y)};
      float a0[4] = {bflo(a02.x), bfhi(a02.x), bflo(a02.y), bfhi(a02.y)};
      float a1[4] = {bflo(a12.x), bfhi(a12.x), bflo(a12.y), bfhi(a12.y)};
      float g[4] = {bflo(g2.x), bfhi(g2.x), bflo(g2.y), bfhi(g2.y)};
      float kav[4] = {ka4.x, ka4.y, ka4.z, ka4.w}, rkv[4] = {rk4.x, rk4.y, rk4.z, rk4.w};
      float lgv[4] = {lg4.x, lg4.y, lg4.z, lg4.w}, lbv[4] = {lb4.x, lb4.y, lb4.z, lb4.w};
      float sm = y[0] + y[1] + y[2] + y[3];
      sm = grp16_sum(sm);
      const float mean = sm * (1.0f / 64.0f);
      float sv = 0.f, sb = 0.f;
#pragma unroll
      for (int e = 0; e < 4; ++e) {
        float d = y[e] - mean; sv += d * d;
        float kd0 = kx[e] * (1.0f + (a0[e] - 1.0f) * kav[e]);
        float kd1 = kx[e] * (1.0f + (a1[e] - 1.0f) * kav[e]);
        sb += r[e] * (kd0 + kd1) * rkv[e];
      }
      sv = grp16_sum(sv); sb = grp16_sum(sb);
      const float rstd = rsqrtf(sv * (1.0f / 64.0f) + GN_EPS_F);
      float o4[4];
#pragma unroll
      for (int e = 0; e < 4; ++e) {
        float yn = (y[e] - mean) * rstd * lgv[e] + lbv[e];
        o4[e] = (yn + sb * v[e]) * g[e];
      }
      uint2 oo; oo.x = pack2(o4[0], o4[1]); oo.y = pack2(o4[2], o4[3]);
      *reinterpret_cast<uint2*>(p.abuf + o) = oo;
    }
  }
}

DEVINL void phase_wo(const Params& p, int layer, int w, int nw, char* smem) {
  const int j = layer >> 1;
  GEMM_LANE_VARS
  const bf16_t* Wt = ((layer & 1) ? p.attn_wo_t : p.rwkv_wo_t) + ((size_t)j << 20);
  for (int tile = w; tile < 96 * 8; tile += nw) {
    const int ct = tile / 96, rt = tile % 96;
    const int row0 = rt * 128, col0 = ct * 128;
    f32x4 acc[4][4];
    gemm_tile_128(p.abuf + (size_t)row0 * DM, DM, Wt + (size_t)col0 * DM, DM, 1024, smem, acc);
    const float* gate = p.mod + ((size_t)layer * 9 + cond_of_row(row0)) * 6144 + 2 * 1024;
#pragma unroll
    for (int m = 0; m < 4; ++m)
#pragma unroll
      for (int n = 0; n < 4; ++n)
#pragma unroll
        for (int jj = 0; jj < 4; ++jj) {
          int row = row0 + wr * 64 + m * 16 + fq * 4 + jj, col = col0 + wc * 64 + n * 16 + fr;
          size_t o = (size_t)row * DM + col;
          p.zbuf[o] = ALPHA_F * p.xbuf[o] + gate[col] * acc[m][n][jj];
        }
  }
}

DEVINL void phase_ln1(const Params& p, int layer, int w, int nw) {
  const int lane = threadIdx.x & 63;
  const int gw = w * 4 + (threadIdx.x >> 6), ngw = nw * 4;
  const float* lng = p.in[9] + (size_t)(layer * 2 + 0) * 1024;
  const float* lnb = p.in[10] + (size_t)(layer * 2 + 0) * 1024;
  for (int row = gw; row < TT; row += ngw) {
    const float* md = p.mod + ((size_t)layer * 9 + cond_of_row(row)) * 6144;
    float4 z[4];
    float s = 0.f;
#pragma unroll
    for (int k = 0; k < 4; ++k) {
      z[k] = *reinterpret_cast<const float4*>(p.zbuf + (size_t)row * DM + k * 256 + lane * 4);
      s += z[k].x + z[k].y + z[k].z + z[k].w;
    }
    const float mean = wave_sum(s) * (1.0f / 1024.0f);
    float sv = 0.f;
#pragma unroll
    for (int k = 0; k < 4; ++k) {
      float a = z[k].x - mean, b = z[k].y - mean, c = z[k].z - mean, d = z[k].w - mean;
      sv += a * a + b * b + c * c + d * d;
    }
    const float rstd = rsqrtf(wave_sum(sv) * (1.0f / 1024.0f) + LN_EPS_F);
#pragma unroll
    for (int k = 0; k < 4; ++k) {
      const int col = k * 256 + lane * 4;
      const float4 g4 = *reinterpret_cast<const float4*>(lng + col);
      const float4 b4 = *reinterpret_cast<const float4*>(lnb + col);
      const float4 sh = *reinterpret_cast<const float4*>(md + 3 * 1024 + col);
      const float4 sc = *reinterpret_cast<const float4*>(md + 4 * 1024 + col);
      float4 x1;
      x1.x = (z[k].x - mean) * rstd * g4.x + b4.x;
      x1.y = (z[k].y - mean) * rstd * g4.y + b4.y;
      x1.z = (z[k].z - mean) * rstd * g4.z + b4.z;
      x1.w = (z[k].w - mean) * rstd * g4.w + b4.w;
      *reinterpret_cast<float4*>(p.xbuf + (size_t)row * DM + col) = x1;
      uint2 o;
      o.x = pack2(x1.x * (1.0f + sc.x) + sh.x, x1.y * (1.0f + sc.y) + sh.y);
      o.y = pack2(x1.z * (1.0f + sc.z) + sh.z, x1.w * (1.0f + sc.w) + sh.w);
      *reinterpret_cast<uint2*>(p.hbuf + (size_t)row * DM + col) = o;
    }
  }
}

DEVINL void phase_p1(const Params& p, int layer, int w, int nw, char* smem) {
  GEMM_LANE_VARS
  bf16_t* qb = reinterpret_cast<bf16_t*>(p.U1);
  const bf16_t* Wt = p.wq_t + (size_t)layer * 2048 * 1024;
  for (int tile = w; tile < 96 * 16; tile += nw) {
    const int ct = tile / 96, rt = tile % 96;
    const int row0 = rt * 128, col0 = ct * 128;
    f32x4 acc[4][4];
    gemm_tile_128(p.hbuf + (size_t)row0 * DM, DM, Wt + (size_t)col0 * DM, DM, 1024, smem, acc);
#pragma unroll
    for (int m = 0; m < 4; ++m)
#pragma unroll
      for (int n = 0; n < 4; ++n)
#pragma unroll
        for (int jj = 0; jj < 4; ++jj) {
          int row = row0 + wr * 64 + m * 16 + fq * 4 + jj, col = col0 + wc * 64 + n * 16 + fr;
          qb[(size_t)row * 2048 + col] = f2bf(acc[m][n][jj]);
        }
  }
}

#define U1_S_OFF ((size_t)TT * 2048 * 2)
DEVINL void phase_p2(const Params& p, int layer, int w, int nw, char* smem) {
  GEMM_LANE_VARS
  const bf16_t* qb = reinterpret_cast<const bf16_t*>(p.U1);
  float* sb = reinterpret_cast<float*>(p.U1 + U1_S_OFF);
  for (int tile = w; tile < 96 * 16; tile += nw) {
    const int ct = tile / 96, rt = tile % 96;
    const int row0 = rt * 128;
    const int z = ct & 1;
    f32x4 acc[4][4];
    gemm_tile_128(qb + (size_t)row0 * 2048 + ct * 128, 2048, p.keysb + (size_t)(layer * 2 + z) * 16384, 128, 128, smem, acc);
#pragma unroll
    for (int m = 0; m < 4; ++m)
#pragma unroll
      for (int n = 0; n < 4; ++n)
#pragma unroll
        for (int jj = 0; jj < 4; ++jj) {
          int row = row0 + wr * 64 + m * 16 + fq * 4 + jj, col = wc * 64 + n * 16 + fr;
          sb[(size_t)row * 2048 + ct * 128 + col] = acc[m][n][jj];
        }
  }
}

DEVINL void phase_p3(const Params& p, int layer, int w, int nw, char* smem) {
  const int lane = threadIdx.x & 63, wid = threadIdx.x >> 6;
  const int gw = w * 4 + wid, ngw = nw * 4;
  const float* sb = reinterpret_cast<const float*>(p.U1 + U1_S_OFF);
  float* svl = reinterpret_cast<float*>(smem) + wid * 64;
  int* sil = reinterpret_cast<int*>(smem) + 256 + wid * 64;
  for (int t = gw; t < TT; t += ngw) {
    for (int h = 0; h < 8; ++h) {
      __builtin_amdgcn_wave_barrier();
#pragma unroll 1
      for (int z = 0; z < 2; ++z) {
        const float* sp = sb + (size_t)t * 2048 + (h * 2 + z) * 128;
        const float s0 = sp[lane], s1 = sp[lane + 64];
        unsigned k0 = (ordf(s0) & ~127u) | (unsigned)(127 - lane);
        unsigned k1 = (ordf(s1) & ~127u) | (unsigned)(63 - lane);
        int myidx = 0;
#pragma unroll 1
        for (int it = 0; it < 16; ++it) {
          unsigned m = wave_max_u(k0 > k1 ? k0 : k1);
          int idx = 127 - (int)(m & 127u);
          if (lane == it) myidx = idx;
          if (k0 == m) k0 = 0;
          if (k1 == m) k1 = 0;
        }
        if (lane < 16) { svl[z * 16 + lane] = sp[myidx]; sil[z * 16 + lane] = myidx; }
      }
      __builtin_amdgcn_wave_barrier();
      unsigned kc[4];
#pragma unroll
      for (int c = 0; c < 4; ++c) {
        int ci = lane * 4 + c;
        float sum = svl[ci >> 4] + svl[16 + (ci & 15)];
        kc[c] = (ordf(sum) & ~255u) | (unsigned)(255 - ci);
      }
      int myci = 0;
#pragma unroll 1
      for (int it = 0; it < 16; ++it) {
        unsigned a = kc[0] > kc[1] ? kc[0] : kc[1], b = kc[2] > kc[3] ? kc[2] : kc[3];
        unsigned m = wave_max_u(a > b ? a : b);
        int ci = 255 - (int)(m & 255u);
        if (lane == it) myci = ci;
#pragma unroll
        for (int c = 0; c < 4; ++c) if (kc[c] == m) kc[c] = 0;
      }
      const int ii = (myci >> 4) & 15, jj = myci & 15;
      float cv = svl[ii] + svl[16 + jj];
      int e = sil[ii] * 128 + sil[16 + jj];
      float mx = cv;
#pragma unroll
      for (int o = 8; o > 0; o >>= 1) mx = fmaxf(mx, __shfl_xor(mx, o));
      float ex = __expf(cv - mx);
      float sm = grp16_sum(ex);
      if (lane < 16) {
        p.pidx[(size_t)t * 128 + h * 16 + lane] = e;
        p.pgate[(size_t)t * 128 + h * 16 + lane] = ex / sm;
      }
    }
  }
}

DEVINL float gelu_exact(float x) { return 0.5f * x * (1.0f + erff(x * 0.7071067811865476f)); }

DEVINL void phase_p4(const Params& p, int layer, int w, int nw) {
  const int lane = threadIdx.x & 63;
  const int gw = w * 4 + (threadIdx.x >> 6), ngw = nw * 4;
  const bf16_t* U = p.ub + (size_t)layer * 16384 * 1024;
  const bf16_t* V = p.vb + (size_t)layer * 16384 * 1024;
  const float* lng = p.in[9] + (size_t)(layer * 2 + 1) * 1024;
  const float* lnb = p.in[10] + (size_t)(layer * 2 + 1) * 1024;
  float* xout = (layer == 3) ? p.out : p.xbuf;
  for (int t = gw; t < TT; t += ngw) {
    float x[16], f[16];
    {
      const uint4 a = *reinterpret_cast<const uint4*>(p.hbuf + (size_t)t * DM + lane * 8);
      const uint4 b = *reinterpret_cast<const uint4*>(p.hbuf + (size_t)t * DM + 512 + lane * 8);
      x[0] = bflo(a.x); x[1] = bfhi(a.x); x[2] = bflo(a.y); x[3] = bfhi(a.y); x[4] = bflo(a.z); x[5] = bfhi(a.z); x[6] = bflo(a.w); x[7] = bfhi(a.w);
      x[8] = bflo(b.x); x[9] = bfhi(b.x); x[10] = bflo(b.y); x[11] = bfhi(b.y); x[12] = bflo(b.z); x[13] = bfhi(b.z); x[14] = bflo(b.w); x[15] = bfhi(b.w);
    }
#pragma unroll
    for (int e = 0; e < 16; ++e) f[e] = 0.f;
    const int myidx0 = p.pidx[(size_t)t * 128 + lane], myidx1 = p.pidx[(size_t)t * 128 + 64 + lane];
    const float myg0 = p.pgate[(size_t)t * 128 + lane], myg1 = p.pgate[(size_t)t * 128 + 64 + lane];
#pragma unroll 4
    for (int e = 0; e < 128; ++e) {
      const int idx = __shfl(e < 64 ? myidx0 : myidx1, e & 63);
      const float gt = __shfl(e < 64 ? myg0 : myg1, e & 63);
      const bf16_t* up = U + (size_t)idx * DM;
      const uint4 a = *reinterpret_cast<const uint4*>(up + lane * 8);
      const uint4 b = *reinterpret_cast<const uint4*>(up + 512 + lane * 8);
      float d = x[0] * bflo(a.x) + x[1] * bfhi(a.x) + x[2] * bflo(a.y) + x[3] * bfhi(a.y) + x[4] * bflo(a.z) + x[5] * bfhi(a.z) + x[6] * bflo(a.w) + x[7] * bfhi(a.w)
              + x[8] * bflo(b.x) + x[9] * bfhi(b.x) + x[10] * bflo(b.y) + x[11] * bfhi(b.y) + x[12] * bflo(b.z) + x[13] * bfhi(b.z) + x[14] * bflo(b.w) + x[15] * bfhi(b.w);
      d = wave_sum(d);
      const float wgt = gt * gelu_exact(d);
      const bf16_t* vp = V + (size_t)idx * DM;
      const uint4 c = *reinterpret_cast<const uint4*>(vp + lane * 8);
      const uint4 dd = *reinterpret_cast<const uint4*>(vp + 512 + lane * 8);
      f[0] += wgt * bflo(c.x); f[1] += wgt * bfhi(c.x); f[2] += wgt * bflo(c.y); f[3] += wgt * bfhi(c.y);
      f[4] += wgt * bflo(c.z); f[5] += wgt * bfhi(c.z); f[6] += wgt * bflo(c.w); f[7] += wgt * bfhi(c.w);
      f[8] += wgt * bflo(dd.x); f[9] += wgt * bfhi(dd.x); f[10] += wgt * bflo(dd.y); f[11] += wgt * bfhi(dd.y);
      f[12] += wgt * bflo(dd.z); f[13] += wgt * bfhi(dd.z); f[14] += wgt * bflo(dd.w); f[15] += wgt * bfhi(dd.w);
    }
    const float* md = p.mod + ((size_t)layer * 9 + cond_of_row(t)) * 6144 + 5 * 1024;
    float zz[16];
    float s = 0.f;
#pragma unroll
    for (int hf = 0; hf < 2; ++hf) {
      const int col = hf * 512 + lane * 8;
      const float4 x0 = *reinterpret_cast<const float4*>(p.xbuf + (size_t)t * DM + col);
      const float4 x1 = *reinterpret_cast<const float4*>(p.xbuf + (size_t)t * DM + col + 4);
      const float4 g0 = *reinterpret_cast<const float4*>(md + col);
      const float4 g1 = *reinterpret_cast<const float4*>(md + col + 4);
      const float xv[8] = {x0.x, x0.y, x0.z, x0.w, x1.x, x1.y, x1.z, x1.w};
      const float gv[8] = {g0.x, g0.y, g0.z, g0.w, g1.x, g1.y, g1.z, g1.w};
#pragma unroll
      for (int e = 0; e < 8; ++e) { zz[hf * 8 + e] = ALPHA_F * xv[e] + gv[e] * f[hf * 8 + e]; s += zz[hf * 8 + e]; }
    }
    const float mean = wave_sum(s) * (1.0f / 1024.0f);
    float sv = 0.f;
#pragma unroll
    for (int e = 0; e < 16; ++e) { float d = zz[e] - mean; sv += d * d; }
    const float rstd = rsqrtf(wave_sum(sv) * (1.0f / 1024.0f) + LN_EPS_F);
#pragma unroll
    for (int hf = 0; hf < 2; ++hf) {
      const int col = hf * 512 + lane * 8;
      const float4 g0 = *reinterpret_cast<const float4*>(lng + col);
      const float4 g1 = *reinterpret_cast<const float4*>(lng + col + 4);
      const float4 b0 = *reinterpret_cast<const float4*>(lnb + col);
      const float4 b1 = *reinterpret_cast<const float4*>(lnb + col + 4);
      float4 o0, o1;
      o0.x = (zz[hf * 8 + 0] - mean) * rstd * g0.x + b0.x;
      o0.y = (zz[hf * 8 + 1] - mean) * rstd * g0.y + b0.y;
      o0.z = (zz[hf * 8 + 2] - mean) * rstd * g0.z + b0.z;
      o0.w = (zz[hf * 8 + 3] - mean) * rstd * g0.w + b0.w;
      o1.x = (zz[hf * 8 + 4] - mean) * rstd * g1.x + b1.x;
      o1.y = (zz[hf * 8 + 5] - mean) * rstd * g1.y + b1.y;
      o1.z = (zz[hf * 8 + 6] - mean) * rstd * g1.z + b1.z;
      o1.w = (zz[hf * 8 + 7] - mean) * rstd * g1.w + b1.w;
      *reinterpret_cast<float4*>(xout + (size_t)t * DM + col) = o0;
      *reinterpret_cast<float4*>(xout + (size_t)t * DM + col + 4) = o1;
    }
  }
}

DEVINL void phase_a1(const Params& p, int layer, int w, int nw) {
  const int lane = threadIdx.x & 63;
  const int gw = w * 4 + (threadIdx.x >> 6), ngw = nw * 4;
  for (int row = gw; row < TT; row += ngw) {
    const float* md = p.mod + ((size_t)layer * 9 + cond_of_row(row)) * 6144;
#pragma unroll
    for (int k = 0; k < 4; ++k) {
      const int col = k * 256 + lane * 4;
      const float4 x = *reinterpret_cast<const float4*>(p.xbuf + (size_t)row * DM + col);
      const float4 sh = *reinterpret_cast<const float4*>(md + col);
      const float4 sc = *reinterpret_cast<const float4*>(md + 1024 + col);
      uint2 o;
      o.x = pack2(x.x * (1.0f + sc.x) + sh.x, x.y * (1.0f + sc.y) + sh.y);
      o.y = pack2(x.z * (1.0f + sc.z) + sh.z, x.w * (1.0f + sc.w) + sh.w);
      *reinterpret_cast<uint2*>(p.hbuf + (size_t)row * DM + col) = o;
    }
  }
}

DEVINL void phase_a2(const Params& p, int layer, int w, int nw, char* smem) {
  const int j = layer >> 1;
  GEMM_LANE_VARS
  bf16_t* qb = reinterpret_cast<bf16_t*>(p.U2);
  const bf16_t* Wt = p.attn_wqkv_t + (size_t)j * 1536 * 1024;
  const float* qn = p.in[29] + j * 64;
  const float* kn = p.in[30] + j * 64;
  for (int tile = w; tile < 96 * 12; tile += nw) {
    const int ct = tile / 96, rt = tile % 96;
    const int row0 = rt * 128;
    const bool lat = row0 >= TCTX;
    f32x4 acc[4][4];
    gemm_tile_128(p.hbuf + (size_t)row0 * DM, DM, Wt + (size_t)ct * 128 * DM, DM, 1024, smem, acc);
    if (ct < 10) {
      const bool isq = ct < 8;
      const int head = isq ? (ct * 2 + wc) : ((ct - 8) * 2 + wc);
      const float* nw_ = isq ? qn : kn;
      float nv[4];
#pragma unroll
      for (int n = 0; n < 4; ++n) nv[n] = nw_[n * 16 + fr];
#pragma unroll
      for (int m = 0; m < 4; ++m)
#pragma unroll
        for (int jj = 0; jj < 4; ++jj) {
          const int row = row0 + wr * 64 + m * 16 + fq * 4 + jj;
          float v[4], ss = 0.f;
#pragma unroll
          for (int n = 0; n < 4; ++n) { v[n] = acc[m][n][jj]; ss += v[n] * v[n]; }
          ss = grp16_sum(ss);
          const float rinv = rsqrtf(ss * (1.0f / 64.0f) + RMS_EPS_F);
#pragma unroll
          for (int n = 0; n < 4; ++n) v[n] = v[n] * rinv * nv[n];
          if (lat) {
            const int t = (row - TCTX) & 1023, b = (row - TCTX) >> 10;
            const int pr = t >> 6, pc = t & 63;
            const float c0 = p.rope[(pr * 16 + fr) * 2], s0 = p.rope[(pr * 16 + fr) * 2 + 1];
            const float c1 = p.rope[(pc * 16 + fr) * 2], s1 = p.rope[(pc * 16 + fr) * 2 + 1];
            const float o0 = v[0] * c0 - v[1] * s0, o1 = v[1] * c0 + v[0] * s0;
            const float o2 = v[2] * c1 - v[3] * s1, o3 = v[3] * c1 + v[2] * s1;
            v[0] = o0; v[1] = o1; v[2] = o2; v[3] = o3;
            if (isq) {
#pragma unroll
              for (int n = 0; n < 4; ++n) qb[(size_t)row * DM + head * 64 + n * 16 + fr] = f2bf(v[n] * QSCALE_F);
            } else {
              bf16_t* kd = p.Klat + ((size_t)((j * 8 + b) * 4 + head) * 1536 + 512 + t) * 64;
#pragma unroll
              for (int n = 0; n < 4; ++n) kd[n * 16 + fr] = f2bf(v[n]);
            }
          } else {
            const int t = row & 255, b = row >> 8;
            if (isq) {
#pragma unroll
              for (int n = 0; n < 4; ++n) qb[(size_t)row * DM + head * 64 + n * 16 + fr] = f2bf(v[n] * QSCALE_F);
            } else {
              bf16_t* kd = p.Kctx + ((size_t)((j * 16 + b) * 4 + head) * 256 + t) * 64;
              float* ko = p.out + OUT_CK + ((size_t)(b * 2 + j) * 256 + t) * 256 + head * 64;
#pragma unroll
              for (int n = 0; n < 4; ++n) { kd[n * 16 + fr] = f2bf(v[n]); ko[n * 16 + fr] = v[n]; }
            }
          }
        }
    } else {
      const int head = (ct - 10) * 2 + wc;
#pragma unroll
      for (int m = 0; m < 4; ++m)
#pragma unroll
        for (int jj = 0; jj < 4; ++jj) {
          const int row = row0 + wr * 64 + m * 16 + fq * 4 + jj;
          if (lat) {
            const int t = (row - TCTX) & 1023, b = (row - TCTX) >> 10;
            bf16_t* vd = p.VlatT + (size_t)((j * 8 + b) * 4 + head) * 64 * 1536 + 512 + t;
#pragma unroll
            for (int n = 0; n < 4; ++n) vd[(size_t)(n * 16 + fr) * 1536] = f2bf(acc[m][n][jj]);
          } else {
            const int t = row & 255, b = row >> 8;
            bf16_t* vd = p.VctxT + (size_t)((j * 16 + b) * 4 + head) * 64 * 256 + t;
            float* vo = p.out + OUT_CV + ((size_t)(b * 2 + j) * 256 + t) * 256 + head * 64;
#pragma unroll
            for (int n = 0; n < 4; ++n) { vd[(size_t)(n * 16 + fr) * 256] = f2bf(acc[m][n][jj]); vo[n * 16 + fr] = acc[m][n][jj]; }
          }
        }
    }
  }
}

DEVINL void phase_a3(const Params& p, int layer, int w, int nw) {
  const int j = layer >> 1;
  const int lane = threadIdx.x & 63, wid = threadIdx.x >> 6;
  const int ql = lane & 31, hh = lane >> 5;
  const bf16_t* qb = reinterpret_cast<const bf16_t*>(p.U2);
  for (int item = w; item < 1536; item += nw) {
    int hq, Tk, row0;
    const bf16_t *Kb, *Vt;
    if (item < 1024) {
      const int b = item >> 7, qblk = item & 7;
      hq = (item >> 3) & 15;
      const int kvh = hq >> 2;
      Kb = p.Klat + (size_t)((j * 8 + b) * 4 + kvh) * 1536 * 64;
      Vt = p.VlatT + (size_t)((j * 8 + b) * 4 + kvh) * 64 * 1536;
      Tk = 1536; row0 = TCTX + b * 1024 + qblk * 128;
    } else {
      const int it = item - 1024;
      const int b = it >> 5, qblk = it & 1;
      hq = (it >> 1) & 15;
      const int kvh = hq >> 2;
      Kb = p.Kctx + (size_t)((j * 16 + b) * 4 + kvh) * 256 * 64;
      Vt = p.VctxT + (size_t)((j * 16 + b) * 4 + kvh) * 64 * 256;
      Tk = 256; row0 = b * 256 + qblk * 128;
    }
    const int qrow = row0 + wid * 32 + ql;
    bf16x8 bq[4];
#pragma unroll
    for (int ks = 0; ks < 4; ++ks) bq[ks] = *reinterpret_cast<const bf16x8*>(qb + (size_t)qrow * DM + hq * 64 + ks * 16 + hh * 8);
    f32x16 o0, o1;
#pragma unroll
    for (int r = 0; r < 16; ++r) { o0[r] = 0.f; o1[r] = 0.f; }
    float mrun = -1e30f, lrun = 0.f;
    for (int kt = 0; kt < Tk; kt += 32) {
      f32x16 sacc;
#pragma unroll
      for (int r = 0; r < 16; ++r) sacc[r] = 0.f;
#pragma unroll
      for (int ks = 0; ks < 4; ++ks) {
        bf16x8 ka = *reinterpret_cast<const bf16x8*>(Kb + (size_t)(kt + ql) * 64 + ks * 16 + hh * 8);
        sacc = __builtin_amdgcn_mfma_f32_32x32x16_bf16(ka, bq[ks], sacc, 0, 0, 0);
      }
      float tmax = sacc[0];
#pragma unroll
      for (int r = 1; r < 16; ++r) tmax = fmaxf(tmax, sacc[r]);
      tmax = fmaxf(tmax, __shfl_xor(tmax, 32));
      const float mnew = fmaxf(mrun, tmax);
      const float corr = exp2f(mrun - mnew);
      mrun = mnew;
      lrun *= corr;
#pragma unroll
      for (int r = 0; r < 16; ++r) { o0[r] *= corr; o1[r] *= corr; }
      float pv[16];
#pragma unroll
      for (int r = 0; r < 16; ++r) { pv[r] = exp2f(sacc[r] - mnew); lrun += pv[r]; }
#pragma unroll
      for (int s2 = 0; s2 < 2; ++s2) {
        union { bf16x8 v; unsigned u[4]; } pb;
#pragma unroll
        for (int q = 0; q < 4; ++q) pb.u[q] = pack2(pv[s2 * 8 + q * 2], pv[s2 * 8 + q * 2 + 1]);
#pragma unroll
        for (int dblk = 0; dblk < 2; ++dblk) {
          const bf16_t* vp = Vt + (size_t)(dblk * 32 + ql) * Tk + kt + 16 * s2 + 4 * hh;
          const uint2 lo = *reinterpret_cast<const uint2*>(vp);
          const uint2 hi = *reinterpret_cast<const uint2*>(vp + 8);
          union { bf16x8 v; unsigned u[4]; } va;
          va.u[0] = lo.x; va.u[1] = lo.y; va.u[2] = hi.x; va.u[3] = hi.y;
          if (dblk == 0) o0 = __builtin_amdgcn_mfma_f32_32x32x16_bf16(va.v, pb.v, o0, 0, 0, 0);
          else o1 = __builtin_amdgcn_mfma_f32_32x32x16_bf16(va.v, pb.v, o1, 0, 0, 0);
        }
      }
    }
    const float ltot = lrun + __shfl_xor(lrun, 32);
    const float inv = 1.0f / ltot;
#pragma unroll
    for (int g = 0; g < 4; ++g) {
      uint2 oa, ob;
      oa.x = pack2(o0[4 * g] * inv, o0[4 * g + 1] * inv); oa.y = pack2(o0[4 * g + 2] * inv, o0[4 * g + 3] * inv);
      ob.x = pack2(o1[4 * g] * inv, o1[4 * g + 1] * inv); ob.y = pack2(o1[4 * g + 2] * inv, o1[4 * g + 3] * inv);
      *reinterpret_cast<uint2*>(p.abuf + (size_t)qrow * DM + hq * 64 + 8 * g + 4 * hh) = oa;
      *reinterpret_cast<uint2*>(p.abuf + (size_t)qrow * DM + hq * 64 + 32 + 8 * g + 4 * hh) = ob;
    }
  }
}

enum { PH_PREP = 0, PH_R1, PH_R2, PH_R3, PH_R4, PH_R5, PH_WO, PH_LN1, PH_P1, PH_P2, PH_P3, PH_P4, PH_A1, PH_A2, PH_A3 };

template <int PH>
__global__ void __launch_bounds__(NTHREADS) phase_kernel(Params p, int layer) {
  __shared__ __attribute__((aligned(16))) char smem[SMEM_BYTES];
  const int w = blockIdx.x, nw = gridDim.x;
  if constexpr (PH == PH_PREP) phase_prep(p, w, nw, smem);
  else if constexpr (PH == PH_R1) phase_r1(p, layer, w, nw);
  else if constexpr (PH == PH_R2) phase_r2(p, layer, w, nw, smem);
  else if constexpr (PH == PH_R3) phase_r3(p, layer, w, nw, smem);
  else if constexpr (PH == PH_R4) phase_r4(p, layer, w, nw, smem);
  else if constexpr (PH == PH_R5) phase_r5(p, layer, w, nw);
  else if constexpr (PH == PH_WO) phase_wo(p, layer, w, nw, smem);
  else if constexpr (PH == PH_LN1) phase_ln1(p, layer, w, nw);
  else if constexpr (PH == PH_P1) phase_p1(p, layer, w, nw, smem);
  else if constexpr (PH == PH_P2) phase_p2(p, layer, w, nw, smem);
  else if constexpr (PH == PH_P3) phase_p3(p, layer, w, nw, smem);
  else if constexpr (PH == PH_P4) phase_p4(p, layer, w, nw);
  else if constexpr (PH == PH_A1) phase_a1(p, layer, w, nw);
  else if constexpr (PH == PH_A2) phase_a2(p, layer, w, nw, smem);
  else if constexpr (PH == PH_A3) phase_a3(p, layer, w, nw);
}

static inline char* carve(char*& cur, size_t bytes) {
  char* r = cur;
  cur += (bytes + 255) & ~(size_t)255;
  return r;
}

extern "C" void kernel_launch(void* const* d_in, const int* in_sizes, int n_in, void* d_out, int out_size, void* d_ws,
                              size_t ws_size, hipStream_t stream) {
  Params p;
  memset(&p, 0, sizeof(p));
  for (int i = 0; i < 35; ++i) p.in[i] = (const float*)d_in[i];
  p.out = (float*)d_out;
  char* cur = (char*)d_ws;
  carve(cur, 16384);
  p.mod = (float*)carve(cur, (size_t)4 * 9 * 6144 * 4);
  p.rope = (float*)carve(cur, 64 * 16 * 2 * 4);
  p.rwkv_in_t = (bf16_t*)carve(cur, (size_t)2 * 3456 * 1024 * 2);
  p.w2t = (bf16_t*)carve(cur, (size_t)4 * 65536 * 2);
  p.a2t = (bf16_t*)carve(cur, (size_t)4 * 65536 * 2);
  p.g2t = (bf16_t*)carve(cur, (size_t)2 * 131072 * 2);
  p.rwkv_wo_t = (bf16_t*)carve(cur, (size_t)2 * 1048576 * 2);
  p.attn_wqkv_t = (bf16_t*)carve(cur, (size_t)2 * 1536 * 1024 * 2);
  p.attn_wo_t = (bf16_t*)carve(cur, (size_t)2 * 1048576 * 2);
  p.wq_t = (bf16_t*)carve(cur, (size_t)4 * 2048 * 1024 * 2);
  p.keysb = (bf16_t*)carve(cur, (size_t)4 * 2 * 128 * 128 * 2);
  p.ub = (bf16_t*)carve(cur, (size_t)4 * 16384 * 1024 * 2);
  p.vb = (bf16_t*)carve(cur, (size_t)4 * 16384 * 1024 * 2);
  p.Klat = (bf16_t*)carve(cur, (size_t)2 * 8 * 4 * 1536 * 64 * 2);
  p.VlatT = (bf16_t*)carve(cur, (size_t)2 * 8 * 4 * 1536 * 64 * 2);
  p.Kctx = (bf16_t*)carve(cur, (size_t)2 * 16 * 4 * 256 * 64 * 2);
  p.VctxT = (bf16_t*)carve(cur, (size_t)2 * 16 * 4 * 256 * 64 * 2);
  p.xbuf = (float*)carve(cur, (size_t)TT * DM * 4);
  p.zbuf = (float*)carve(cur, (size_t)TT * DM * 4);
  p.hbuf = (bf16_t*)carve(cur, (size_t)TT * DM * 2);
  p.abuf = (bf16_t*)carve(cur, (size_t)TT * DM * 2);
  p.U1 = carve(cur, (size_t)TT * DM * 14);
  p.U2 = carve(cur, (size_t)TT * DM * 8);
  p.U3 = carve(cur, (size_t)TT * DM * 8);
  p.pidx = (int*)carve(cur, (size_t)TT * 128 * 4);
  p.pgate = (float*)carve(cur, (size_t)TT * 128 * 4);
  for (int f = 0; f < 16; ++f) p.freqs[f] = pow(10000.0, -(double)f / 16.0);
  if ((size_t)(cur - (char*)d_ws) > ws_size) {
    fprintf(stderr, "workspace too small: need %zu have %zu\n", (size_t)(cur - (char*)d_ws), ws_size);
    return;
  }
  const int G = 2048;
#define LAUNCH(PH, L) hipLaunchKernelGGL(phase_kernel<PH>, dim3(G), dim3(NTHREADS), 0, stream, p, L)
  LAUNCH(PH_PREP, 0);
  for (int layer = 0; layer < 4; ++layer) {
    if ((layer & 1) == 0) {
      LAUNCH(PH_R1, layer);
      LAUNCH(PH_R2, layer);
      LAUNCH(PH_R3, layer);
      LAUNCH(PH_R4, layer);
      LAUNCH(PH_R5, layer);
    } else {
      LAUNCH(PH_A1, layer);
      LAUNCH(PH_A2, layer);
      LAUNCH(PH_A3, layer);
    }
    LAUNCH(PH_WO, layer);
    LAUNCH(PH_LN1, layer);
    LAUNCH(PH_P1, layer);
    LAUNCH(PH_P2, layer);
    LAUNCH(PH_P3, layer);
    LAUNCH(PH_P4, layer);
  }
}
```

```cpp
#include <hip/hip_runtime.h>
#include <hip/hip_cooperative_groups.h>
#include <stdint.h>
#include <string.h>
#include <math.h>
#include <stdio.h>

namespace cg = cooperative_groups;

typedef unsigned short bf16_t;
typedef __attribute__((ext_vector_type(8))) short bf16x8;
typedef __attribute__((ext_vector_type(4))) float f32x4;
typedef __attribute__((ext_vector_type(16))) float f32x16;

#define DEVINL __device__ __forceinline__
#define NTHREADS 256
#define SMEM_BYTES 49152

#define DM 1024
#define TCTX 4096
#define TLAT 8192
#define TT 12288
#define ALPHA_F 1.681792830507429f
#define LN_EPS_F 1e-5f
#define GN_EPS_F 6.4e-4f
#define RMS_EPS_F 1e-6f
#define QSCALE_F (0.125f * 1.4426950408889634f)

#define OUT_Y 0
#define OUT_STATE 12582912
#define OUT_CK 16777216
#define OUT_CV 18874368

struct Params {
  const float* in[35];
  float* out;
  float* mod;
  float* rope;
  bf16_t* rwkv_in_t;
  bf16_t* w2t;
  bf16_t* a2t;
  bf16_t* g2t;
  bf16_t* rwkv_wo_t;
  bf16_t* attn_wqkv_t;
  bf16_t* attn_wo_t;
  bf16_t* wq_t;
  bf16_t* keysb;
  bf16_t* ub;
  bf16_t* vb;
  bf16_t* Klat;
  bf16_t* VlatT;
  bf16_t* Kctx;
  bf16_t* VctxT;
  float* xbuf;
  float* zbuf;
  bf16_t* hbuf;
  bf16_t* abuf;
  char* U1;
  char* U2;
  char* U3;
  int* pidx;
  float* pgate;
  double freqs[16];
};

DEVINL int tidx() { int t = threadIdx.x; asm volatile("" : "+v"(t)); return t; }
DEVINL bf16_t f2bf(float f) {
  unsigned u = __float_as_uint(f);
  u += 0x7FFFu + ((u >> 16) & 1u);
  return (bf16_t)(u >> 16);
}
DEVINL float bf2f(bf16_t h) { return __uint_as_float(((unsigned)h) << 16); }
DEVINL unsigned pack2(float a, float b) { return (unsigned)f2bf(a) | ((unsigned)f2bf(b) << 16); }
DEVINL float bflo(unsigned u) { return __uint_as_float(u << 16); }
DEVINL float bfhi(unsigned u) { return __uint_as_float(u & 0xFFFF0000u); }

DEVINL float wave_sum(float v) {
#pragma unroll
  for (int o = 32; o > 0; o >>= 1) v += __shfl_xor(v, o);
  return v;
}
DEVINL float grp16_sum(float v) {
#pragma unroll
  for (int o = 8; o > 0; o >>= 1) v += __shfl_xor(v, o);
  return v;
}
DEVINL unsigned wave_max_u(unsigned v) {
#pragma unroll
  for (int o = 32; o > 0; o >>= 1) { unsigned t = (unsigned)__shfl_xor((int)v, o); v = v > t ? v : t; }
  return v;
}
DEVINL float sigmoidf_(float x) { return 1.0f / (1.0f + __expf(-x)); }
DEVINL float tanhf_(float x) { float e = __expf(-2.0f * fabsf(x)); float t = (1.0f - e) / (1.0f + e); return x < 0 ? -t : t; }
DEVINL unsigned ordf(float f) { unsigned u = __float_as_uint(f); return (u & 0x80000000u) ? ~u : (u | 0x80000000u); }

DEVINL int cond_of_row(int row) { return row < TCTX ? 8 : ((row - TCTX) >> 10); }

DEVINL void gemm_tile_128(const bf16_t* __restrict__ A, int lda, const bf16_t* __restrict__ Bt, int ldb, int K,
                          char* smem, f32x4 (&acc)[4][4]) {
  const int tid = tidx(), wid = tid >> 6, lane = tid & 63;
  const int wr = wid >> 1, wc = wid & 1, fr = lane & 15, fq = lane >> 4;
  char* SA = smem;
  char* SB = smem + 8192;
#pragma unroll
  for (int m = 0; m < 4; ++m)
#pragma unroll
    for (int n = 0; n < 4; ++n) acc[m][n] = (f32x4){0.f, 0.f, 0.f, 0.f};
  for (int k0 = 0; k0 < K; k0 += 32) {
#pragma unroll
    for (int i = 0; i < 2; ++i) {
      int b = tid * 16 + i * 4096;
      int r = b >> 6, c = (b & 63) >> 1;
      __builtin_amdgcn_global_load_lds((const unsigned*)(A + (size_t)r * lda + k0 + c), (unsigned*)(SA + b), 16, 0, 0);
      __builtin_amdgcn_global_load_lds((const unsigned*)(Bt + (size_t)r * ldb + k0 + c), (unsigned*)(SB + b), 16, 0, 0);
    }
    asm volatile("s_waitcnt vmcnt(0)" ::: "memory");
    __syncthreads();
    bf16x8 a[4], b[4];
#pragma unroll
    for (int m = 0; m < 4; ++m) a[m] = *reinterpret_cast<const bf16x8*>(SA + (wr * 64 + m * 16 + fr) * 64 + fq * 16);
#pragma unroll
    for (int n = 0; n < 4; ++n) b[n] = *reinterpret_cast<const bf16x8*>(SB + (wc * 64 + n * 16 + fr) * 64 + fq * 16);
#pragma unroll
    for (int m = 0; m < 4; ++m)
#pragma unroll
      for (int n = 0; n < 4; ++n) acc[m][n] = __builtin_amdgcn_mfma_f32_16x16x32_bf16(a[m], b[n], acc[m][n], 0, 0, 0);
    __syncthreads();
  }
}

#define GEMM_LANE_VARS \
  const int tid = tidx(), wid = tid >> 6, lane = tid & 63; \
  const int wr = wid >> 1, wc = wid & 1, fr = lane & 15, fq = lane >> 4; \
  (void)tid; (void)wid; (void)lane; (void)wr; (void)wc; (void)fr; (void)fq;

DEVINL void get_tjob(const Params& p, int ji, const float*& src, bf16_t*& dst, int& K, int& N) {
  if (ji < 28) {
    int j = ji / 14, s = ji % 14;
    if (s < 3) { src = p.in[12] + ((size_t)(j * 3 + s) << 20); dst = p.rwkv_in_t + (size_t)j * 3456 * 1024 + ((size_t)s << 20); K = 1024; N = 1024; }
    else if (s < 5) { int z = s - 3; src = p.in[15] + (size_t)(j * 2 + z) * 65536; dst = p.rwkv_in_t + (size_t)j * 3456 * 1024 + (size_t)(3072 + z * 64) * 1024; K = 1024; N = 64; }
    else if (s < 7) { int z = s - 5; src = p.in[18] + (size_t)(j * 2 + z) * 65536; dst = p.rwkv_in_t + (size_t)j * 3456 * 1024 + (size_t)(3200 + z * 64) * 1024; K = 1024; N = 64; }
    else if (s == 7) { src = p.in[20] + (size_t)j * 131072; dst = p.rwkv_in_t + (size_t)j * 3456 * 1024 + (size_t)3328 * 1024; K = 1024; N = 128; }
    else if (s < 10) { int z = s - 8; src = p.in[16] + (size_t)(j * 2 + z) * 65536; dst = p.w2t + (size_t)(j * 2 + z) * 65536; K = 64; N = 1024; }
    else if (s < 12) { int z = s - 10; src = p.in[19] + (size_t)(j * 2 + z) * 65536; dst = p.a2t + (size_t)(j * 2 + z) * 65536; K = 64; N = 1024; }
    else if (s == 12) { src = p.in[21] + (size_t)j * 131072; dst = p.g2t + (size_t)j * 131072; K = 128; N = 1024; }
    else { src = p.in[13] + ((size_t)j << 20); dst = p.rwkv_wo_t + ((size_t)j << 20); K = 1024; N = 1024; }
  } else if (ji < 32) {
    int j = (ji - 28) >> 1, s = (ji - 28) & 1;
    if (s == 0) { src = p.in[27] + (size_t)j * 1024 * 1536; dst = p.attn_wqkv_t + (size_t)j * 1536 * 1024; K = 1024; N = 1536; }
    else { src = p.in[28] + ((size_t)j << 20); dst = p.attn_wo_t + ((size_t)j << 20); K = 1024; N = 1024; }
  } else {
    int i = ji - 32;
    src = p.in[31] + (size_t)i * 1024 * 2048; dst = p.wq_t + (size_t)i * 2048 * 1024; K = 1024; N = 2048;
  }
}

DEVINL void sincos_d(double x, float& c, float& s) {
  const double TWO_PI = 6.283185307179586476925;
  double r = x - TWO_PI * rint(x / TWO_PI);
  double r2 = r * r;
  double ts = r, tc = 1.0, ss = r, cs = 1.0;
#pragma unroll 1
  for (int n = 1; n <= 14; ++n) {
    tc = -tc * r2 / (double)((2 * n - 1) * (2 * n));
    ts = -ts * r2 / (double)((2 * n) * (2 * n + 1));
    cs += tc; ss += ts;
  }
  c = (float)cs; s = (float)ss;
}

DEVINL void phase_prep(const Params& p, int w, int nw, char* smem) {
  const int tid = tidx();
  {
    float (*tile)[65] = reinterpret_cast<float (*)[65]>(smem);
    int toff = 0;
    for (int ji = 0; ji < 36; ++ji) {
      const float* src; bf16_t* dst; int K, N;
      get_tjob(p, ji, src, dst, K, N);
      const int tn = N >> 6, nt = (K >> 6) * tn;
      int t0 = (w - (toff % nw) + nw) % nw;
      for (int t = t0; t < nt; t += nw) {
        const int k0 = (t / tn) << 6, n0 = (t % tn) << 6;
#pragma unroll
        for (int i = 0; i < 4; ++i) {
          int r = (tid >> 4) + 16 * i, c = (tid & 15) * 4;
          float4 v = *reinterpret_cast<const float4*>(src + (size_t)(k0 + r) * N + n0 + c);
          tile[r][c] = v.x; tile[r][c + 1] = v.y; tile[r][c + 2] = v.z; tile[r][c + 3] = v.w;
        }
        __syncthreads();
#pragma unroll
        for (int i = 0; i < 2; ++i) {
          int q = tid + 256 * i;
          int n = q >> 3, kc = (q & 7) * 8;
          uint4 o;
          o.x = pack2(tile[kc + 0][n], tile[kc + 1][n]);
          o.y = pack2(tile[kc + 2][n], tile[kc + 3][n]);
          o.z = pack2(tile[kc + 4][n], tile[kc + 5][n]);
          o.w = pack2(tile[kc + 6][n], tile[kc + 7][n]);
          *reinterpret_cast<uint4*>(dst + (size_t)(n0 + n) * K + k0 + kc) = o;
        }
        __syncthreads();
      }
      toff += nt;
    }
  }
  const size_t gtid = (size_t)w * NTHREADS + tid, gn = (size_t)nw * NTHREADS;
  {
    const size_t n8 = (size_t)4 * 16384 * 1024 / 8;
    for (size_t i = gtid; i < n8; i += gn) {
      const float4* su = reinterpret_cast<const float4*>(p.in[33]) + i * 2;
      float4 a = su[0], b = su[1];
      uint4 o; o.x = pack2(a.x, a.y); o.y = pack2(a.z, a.w); o.z = pack2(b.x, b.y); o.w = pack2(b.z, b.w);
      reinterpret_cast<uint4*>(p.ub)[i] = o;
      const float4* sv = reinterpret_cast<const float4*>(p.in[34]) + i * 2;
      a = sv[0]; b = sv[1];
      o.x = pack2(a.x, a.y); o.y = pack2(a.z, a.w); o.z = pack2(b.x, b.y); o.w = pack2(b.z, b.w);
      reinterpret_cast<uint4*>(p.vb)[i] = o;
    }
    const size_t nk8 = (size_t)4 * 2 * 128 * 128 / 8;
    for (size_t i = gtid; i < nk8; i += gn) {
      const float4* su = reinterpret_cast<const float4*>(p.in[32]) + i * 2;
      float4 a = su[0], b = su[1];
      uint4 o; o.x = pack2(a.x, a.y); o.y = pack2(a.z, a.w); o.z = pack2(b.x, b.y); o.w = pack2(b.z, b.w);
      reinterpret_cast<uint4*>(p.keysb)[i] = o;
    }
  }
  {
    const size_t nk = (size_t)8 * 2 * 512 * 4 * 64;
    for (size_t i = gtid; i < nk; i += gn) {
      int d = i & 63, kvh = (i >> 6) & 3, s = (i >> 8) & 511, j = (i >> 17) & 1, b = (int)(i >> 18);
      p.Klat[((size_t)((j * 8 + b) * 4 + kvh) * 1536 + s) * 64 + d] = f2bf(p.in[4][i]);
      p.VlatT[((size_t)((j * 8 + b) * 4 + kvh) * 64 + d) * 1536 + s] = f2bf(p.in[5][i]);
    }
  }
  for (size_t i = gtid; i < 1024; i += gn) {
    int pos = (int)(i >> 4), f = (int)(i & 15);
    float c, s; sincos_d((double)pos * p.freqs[f], c, s);
    p.rope[i * 2] = c; p.rope[i * 2 + 1] = s;
  }
  {
    const size_t n4 = (size_t)TT * DM / 4, nc4 = (size_t)TCTX * DM / 4;
    for (size_t i = gtid; i < n4; i += gn) {
      float4 v = (i < nc4) ? reinterpret_cast<const float4*>(p.in[0])[i] : reinterpret_cast<const float4*>(p.in[1])[i - nc4];
      reinterpret_cast<float4*>(p.xbuf)[i] = v;
    }
  }
  {
    float* sc = reinterpret_cast<float*>(smem);
    float* red = sc + 9 * 1024;
    bool loaded = false;
    for (int item = w; item < 384; item += nw) {
      if (!loaded) {
        __syncthreads();
        for (int e = tid; e < 9 * 1024; e += NTHREADS) {
          int c = e >> 10, d = e & 1023;
          float v = (c < 8) ? p.in[2][c * 1024 + d] : p.in[6][d];
          sc[e] = v / (1.0f + __expf(-v));
        }
        __syncthreads();
        loaded = true;
      }
      const int i = item / 96, cc = item % 96;
      const int col = cc * 64 + (tid & 63), ks = tid >> 6;
      float acc[9];
#pragma unroll
      for (int c = 0; c < 9; ++c) acc[c] = 0.f;
      const float* wp = p.in[7] + (size_t)i * 1024 * 6144 + col;
      for (int d = ks * 256; d < ks * 256 + 256; ++d) {
        float wv = wp[(size_t)d * 6144];
#pragma unroll
        for (int c = 0; c < 9; ++c) acc[c] += sc[c * 1024 + d] * wv;
      }
#pragma unroll
      for (int c = 0; c < 9; ++c) red[(ks * 9 + c) * 64 + (tid & 63)] = acc[c];
      __syncthreads();
      for (int o = tid; o < 576; o += NTHREADS) {
        int c = o >> 6, cl = o & 63;
        float s = red[(0 * 9 + c) * 64 + cl] + red[(1 * 9 + c) * 64 + cl] + red[(2 * 9 + c) * 64 + cl] + red[(3 * 9 + c) * 64 + cl];
        int n = cc * 64 + cl;
        p.mod[((size_t)i * 9 + c) * 6144 + n] = s + p.in[8][i * 6144 + n];
      }
      __syncthreads();
    }
  }
}

DEVINL void phase_r1(const Params& p, int layer, int w, int nw) {
  const int j = layer >> 1;
  const int lane = tidx() & 63;
  const int gw = w * 4 + (tidx() >> 6), ngw = nw * 4;
  bf16_t* A6 = reinterpret_cast<bf16_t*>(p.U1);
  const float* mu = p.in[11] + (size_t)j * 6 * 1024;
  for (int row = gw; row < TT; row += ngw) {
    int t, Tlen;
    if (row < TCTX) { t = row & 255; Tlen = 256; } else { t = (row - TCTX) & 1023; Tlen = 1024; }
    const int cond = cond_of_row(row);
    const float* sh = p.mod + ((size_t)layer * 9 + cond) * 6144;
    const float* sc = sh + 1024;
    const bool hasp = t > 0, hasn = t < Tlen - 1;
#pragma unroll
    for (int k = 0; k < 4; ++k) {
      const int col = k * 256 + lane * 4;
      const float4 xc = *reinterpret_cast<const float4*>(p.xbuf + (size_t)row * DM + col);
      float4 xp = make_float4(0, 0, 0, 0), xn = make_float4(0, 0, 0, 0);
      if (hasp) xp = *reinterpret_cast<const float4*>(p.xbuf + (size_t)(row - 1) * DM + col);
      if (hasn) xn = *reinterpret_cast<const float4*>(p.xbuf + (size_t)(row + 1) * DM + col);
      const float4 s4 = *reinterpret_cast<const float4*>(sh + col);
      const float4 c4 = *reinterpret_cast<const float4*>(sc + col);
      float h[4], xx[4];
      const float xcv[4] = {xc.x, xc.y, xc.z, xc.w}, xpv[4] = {xp.x, xp.y, xp.z, xp.w}, xnv[4] = {xn.x, xn.y, xn.z, xn.w};
      const float shv[4] = {s4.x, s4.y, s4.z, s4.w}, scv[4] = {c4.x, c4.y, c4.z, c4.w};
#pragma unroll
      for (int e = 0; e < 4; ++e) {
        float g = 1.0f + scv[e];
        h[e] = xcv[e] * g + shv[e];
        float hp = hasp ? (xpv[e] * g + shv[e]) : 0.f;
        float hn = hasn ? (xnv[e] * g + shv[e]) : 0.f;
        xx[e] = 0.5f * (hp + hn) - h[e];
      }
#pragma unroll
      for (int m = 0; m < 6; ++m) {
        const float4 m4 = *reinterpret_cast<const float4*>(mu + m * 1024 + col);
        uint2 o;
        o.x = pack2(h[0] + xx[0] * m4.x, h[1] + xx[1] * m4.y);
        o.y = pack2(h[2] + xx[2] * m4.z, h[3] + xx[3] * m4.w);
        *reinterpret_cast<uint2*>(A6 + ((size_t)m * TT + row) * DM + col) = o;
      }
    }
  }
}

#define U1_AA_OFF ((size_t)2 * TT * DM * 4)
#define U1_GG_OFF (U1_AA_OFF + (size_t)2 * TT * DM * 2)

DEVINL void phase_r2(const Params& p, int layer, int w, int nw, char* smem) {
  const int j = layer >> 1;
  GEMM_LANE_VARS
  const bf16_t* A6 = reinterpret_cast<const bf16_t*>(p.U1);
  bf16_t* rb = reinterpret_cast<bf16_t*>(p.U2);
  bf16_t* kb = rb + (size_t)TT * DM;
  bf16_t* vb = kb + (size_t)TT * DM;
  bf16_t* kkb = vb + (size_t)TT * DM;
  bf16_t* lw = p.abuf;
  bf16_t* la = lw + (size_t)TT * 128;
  bf16_t* lg = la + (size_t)TT * 128;
  const bf16_t* Wt = p.rwkv_in_t + (size_t)j * 3456 * 1024;
  const float* k_k = p.in[22] + j * 1024;
  for (int tile = w; tile < 96 * 27; tile += nw) {
    const int ct = tile / 96, rt = tile % 96;
    const int mA = ct < 8 ? 0 : ct < 16 ? 2 : ct < 24 ? 3 : ct == 24 ? 1 : ct == 25 ? 4 : 5;
    const int row0 = rt * 128;
    f32x4 acc[4][4];
    gemm_tile_128(A6 + ((size_t)mA * TT + row0) * DM, DM, Wt + (size_t)ct * 128 * 1024, DM, 1024, smem, acc);
    if (ct < 8 || (ct >= 16 && ct < 24)) {
      bf16_t* dst = ct < 8 ? rb : vb;
      const int cbase = (ct & 7) * 128 + wc * 64;
#pragma unroll
      for (int m = 0; m < 4; ++m)
#pragma unroll
        for (int n = 0; n < 4; ++n)
#pragma unroll
          for (int jj = 0; jj < 4; ++jj) {
            int row = row0 + wr * 64 + m * 16 + fq * 4 + jj;
            dst[(size_t)row * DM + cbase + n * 16 + fr] = f2bf(acc[m][n][jj]);
          }
    } else if (ct < 16) {
      const int cbase = (ct - 8) * 128 + wc * 64;
      float kkw[4];
#pragma unroll
      for (int n = 0; n < 4; ++n) kkw[n] = k_k[cbase + n * 16 + fr];
#pragma unroll
      for (int m = 0; m < 4; ++m)
#pragma unroll
        for (int jj = 0; jj < 4; ++jj) {
          asm volatile("" ::: "memory");
          int row = row0 + wr * 64 + m * 16 + fq * 4 + jj;
          float kv[4], ss = 0.f;
#pragma unroll
          for (int n = 0; n < 4; ++n) { kv[n] = acc[m][n][jj] * kkw[n]; ss += kv[n] * kv[n]; }
          ss = grp16_sum(ss);
          float inv = 1.0f / fmaxf(sqrtf(ss), 1e-12f);
#pragma unroll
          for (int n = 0; n < 4; ++n) {
            kb[(size_t)row * DM + cbase + n * 16 + fr] = f2bf(acc[m][n][jj]);
            kkb[(size_t)row * DM + cbase + n * 16 + fr] = f2bf(kv[n] * inv);
          }
        }
    } else {
      bf16_t* dst = ct == 24 ? lw : ct == 25 ? la : lg;
#pragma unroll
      for (int m = 0; m < 4; ++m)
#pragma unroll
        for (int n = 0; n < 4; ++n)
#pragma unroll
          for (int jj = 0; jj < 4; ++jj) {
            int row = row0 + wr * 64 + m * 16 + fq * 4 + jj;
            float v = acc[m][n][jj];
            if (ct == 24) v = tanhf_(v); else if (ct == 26) v = sigmoidf_(v);
            dst[(size_t)row * 128 + wc * 64 + n * 16 + fr] = f2bf(v);
          }
    }
  }
}

DEVINL void phase_r3(const Params& p, int layer, int w, int nw, char* smem) {
  const int j = layer >> 1;
  GEMM_LANE_VARS
  const bf16_t* lw = p.abuf;
  const bf16_t* la = lw + (size_t)TT * 128;
  const bf16_t* lg = la + (size_t)TT * 128;
  float* wdec = reinterpret_cast<float*>(p.U1);
  bf16_t* aa = reinterpret_cast<bf16_t*>(p.U1 + U1_AA_OFF);
  bf16_t* gg = reinterpret_cast<bf16_t*>(p.U1 + U1_GG_OFF);
  for (int tile = w; tile < 96 * 40; tile += nw) {
    const int ct = tile / 96, rt = tile % 96;
    const int job = ct >> 3, nt = ct & 7;
    const int row0 = rt * 128, col0 = nt * 128;
    f32x4 acc[4][4];
    if (job < 2) {
      const int z = job;
      gemm_tile_128(lw + (size_t)row0 * 128 + z * 64, 128, p.w2t + (size_t)(j * 2 + z) * 65536 + (size_t)col0 * 64, 64, 64, smem, acc);
      const float* w0 = p.in[14] + (size_t)(j * 2 + z) * 1024;
#pragma unroll
      for (int m = 0; m < 4; ++m)
#pragma unroll
        for (int n = 0; n < 4; ++n)
#pragma unroll
          for (int jj = 0; jj < 4; ++jj) {
            int row = row0 + wr * 64 + m * 16 + fq * 4 + jj, col = col0 + wc * 64 + n * 16 + fr;
            float wl = acc[m][n][jj] + w0[col];
            wdec[((size_t)z * TT + row) * DM + col] = __expf(-0.6065306597126334f * sigmoidf_(wl));
          }
    } else if (job < 4) {
      const int z = job - 2;
      gemm_tile_128(la + (size_t)row0 * 128 + z * 64, 128, p.a2t + (size_t)(j * 2 + z) * 65536 + (size_t)col0 * 64, 64, 64, smem, acc);
      const float* a0 = p.in[17] + (size_t)(j * 2 + z) * 1024;
#pragma unroll
      for (int m = 0; m < 4; ++m)
#pragma unroll
        for (int n = 0; n < 4; ++n)
#pragma unroll
          for (int jj = 0; jj < 4; ++jj) {
            int row = row0 + wr * 64 + m * 16 + fq * 4 + jj, col = col0 + wc * 64 + n * 16 + fr;
            aa[((size_t)z * TT + row) * DM + col] = f2bf(sigmoidf_(acc[m][n][jj] + a0[col]));
          }
    } else {
      gemm_tile_128(lg + (size_t)row0 * 128, 128, p.g2t + (size_t)j * 131072 + (size_t)col0 * 128, 128, 128, smem, acc);
#pragma unroll
      for (int m = 0; m < 4; ++m)
#pragma unroll
        for (int n = 0; n < 4; ++n)
#pragma unroll
          for (int jj = 0; jj < 4; ++jj) {
            int row = row0 + wr * 64 + m * 16 + fq * 4 + jj, col = col0 + wc * 64 + n * 16 + fr;
            gg[(size_t)row * DM + col] = f2bf(acc[m][n][jj]);
          }
    }
  }
}

DEVINL void phase_r4(const Params& p, int layer, int w, int nw, char* smem) {
  const int j = layer >> 1;
  const int lane = tidx() & 63, wid = tidx() >> 6;
  const bf16_t* rb = reinterpret_cast<const bf16_t*>(p.U2);
  const bf16_t* kb = rb + (size_t)TT * DM;
  const bf16_t* vb = kb + (size_t)TT * DM;
  const bf16_t* kkb = vb + (size_t)TT * DM;
  const float* wdec = reinterpret_cast<const float*>(p.U1);
  const bf16_t* aa = reinterpret_cast<const bf16_t*>(p.U1 + U1_AA_OFF);
  float* yout = reinterpret_cast<float*>(p.U3);
  float* lds = reinterpret_cast<float*>(smem) + wid * (8 * 5 * 64);
  for (int c = w + nw * wid; c < 768; c += nw * 4) {
    int seq, h, z;
    if (c < 256) { seq = 16 + (c >> 5); h = (c >> 1) & 15; z = c & 1; }
    else { int cc = c - 256; seq = cc >> 5; h = (cc >> 1) & 15; z = cc & 1; }
    const int Tlen = seq < 16 ? 256 : 1024;
    const int base = seq < 16 ? seq * 256 : TCTX + (seq - 16) * 1024;
    const int colb = h * 64;
    const float kal = p.in[23][j * 1024 + colb + lane];
    float S[64];
    if (seq >= 16) {
      const float* s0 = p.in[3] + ((((size_t)(seq - 16) * 2 + j) * 2 + z) * 16 + h) * 4096 + (size_t)lane * 64;
#pragma unroll
      for (int q = 0; q < 16; ++q) {
        float4 v = reinterpret_cast<const float4*>(s0)[q];
        S[q * 4] = v.x; S[q * 4 + 1] = v.y; S[q * 4 + 2] = v.z; S[q * 4 + 3] = v.w;
      }
    } else {
#pragma unroll
      for (int q = 0; q < 64; ++q) S[q] = 0.f;
    }
    for (int t0 = 0; t0 < Tlen; t0 += 8) {
      float vreg[8];
      __builtin_amdgcn_wave_barrier();
#pragma unroll
      for (int tt = 0; tt < 8; ++tt) {
        const int t = t0 + tt;
        const int row = base + (z == 0 ? t : (Tlen - 1 - t));
        const size_t o = (size_t)row * DM + colb + lane;
        float r = bf2f(rb[o]), k = bf2f(kb[o]), kk = bf2f(kkb[o]);
        vreg[tt] = bf2f(vb[o]);
        float a = bf2f(aa[(size_t)z * TT * DM + o]);
        float wd = wdec[(size_t)z * TT * DM + o];
        float* l = lds + tt * 320;
        l[lane] = r; l[64 + lane] = wd; l[128 + lane] = k * (1.0f + (a - 1.0f) * kal); l[192 + lane] = kk; l[256 + lane] = kk * a;
      }
      __builtin_amdgcn_wave_barrier();
#pragma unroll 1
      for (int tt = 0; tt < 8; ++tt) {
        const float* l = lds + tt * 320;
        const float vi = vreg[0];
        float skk = 0.f;
#pragma unroll
        for (int q = 0; q < 16; ++q) {
          float4 kk4 = reinterpret_cast<const float4*>(l + 192)[q];
          skk += S[q * 4] * kk4.x + S[q * 4 + 1] * kk4.y + S[q * 4 + 2] * kk4.z + S[q * 4 + 3] * kk4.w;
        }
        float y = 0.f;
#pragma unroll
        for (int q = 0; q < 16; ++q) {
          float4 w4 = reinterpret_cast<const float4*>(l + 64)[q];
          float4 k4 = reinterpret_cast<const float4*>(l + 128)[q];
          float4 a4 = reinterpret_cast<const float4*>(l + 256)[q];
          float4 r4 = reinterpret_cast<const float4*>(l)[q];
          S[q * 4 + 0] = S[q * 4 + 0] * w4.x + (vi * k4.x - skk * a4.x);
          S[q * 4 + 1] = S[q * 4 + 1] * w4.y + (vi * k4.y - skk * a4.y);
          S[q * 4 + 2] = S[q * 4 + 2] * w4.z + (vi * k4.z - skk * a4.z);
          S[q * 4 + 3] = S[q * 4 + 3] * w4.w + (vi * k4.w - skk * a4.w);
          y += S[q * 4] * r4.x + S[q * 4 + 1] * r4.y + S[q * 4 + 2] * r4.z + S[q * 4 + 3] * r4.w;
        }
        const int t = t0 + tt;
        const int row = base + (z == 0 ? t : (Tlen - 1 - t));
        yout[((size_t)z * TT + row) * DM + colb + lane] = y;
#pragma unroll
        for (int q = 0; q < 7; ++q) vreg[q] = vreg[q + 1];
      }
    }
    if (seq < 16) {
      float* so = p.out + OUT_STATE + ((((size_t)seq * 2 + j) * 2 + z) * 16 + h) * 4096 + (size_t)lane * 64;
#pragma unroll
      for (int q = 0; q < 16; ++q) reinterpret_cast<float4*>(so)[q] = make_float4(S[q * 4], S[q * 4 + 1], S[q * 4 + 2], S[q * 4 + 3]);
    }
  }
}

DEVINL void phase_r5(const Params& p, int layer, int w, int nw) {
  const int j = layer >> 1;
  const int lane = tidx() & 63;
  const int gw = w * 4 + (tidx() >> 6), ngw = nw * 4;
  const bf16_t* rb = reinterpret_cast<const bf16_t*>(p.U2);
  const bf16_t* kb = rb + (size_t)TT * DM;
  const bf16_t* vb = kb + (size_t)TT * DM;
  const bf16_t* aa = reinterpret_cast<const bf16_t*>(p.U1 + U1_AA_OFF);
  const bf16_t* gg = reinterpret_cast<const bf16_t*>(p.U1 + U1_GG_OFF);
  const float* yin = reinterpret_cast<const float*>(p.U3);
  const float* ka = p.in[23] + j * 1024;
  const float* rk = p.in[24] + j * 1024;
  const float* lg = p.in[25] + j * 1024;
  const float* lb = p.in[26] + j * 1024;
  for (int row = gw; row < TT; row += ngw) {
#pragma unroll
    for (int k = 0; k < 4; ++k) {
      const int col = k * 256 + lane * 4;
      const size_t o = (size_t)row * DM + col;
      const float4 yf = *reinterpret_cast<const float4*>(yin + o);
      const float4 yb = *reinterpret_cast<const float4*>(yin + (size_t)TT * DM + o);
      const uint2 r2 = *reinterpret_cast<const uint2*>(rb + o);
      const uint2 k2 = *reinterpret_cast<const uint2*>(kb + o);
      const uint2 v2 = *reinterpret_cast<const uint2*>(vb + o);
      const uint2 a02 = *reinterpret_cast<const uint2*>(aa + o);
      const uint2 a12 = *reinterpret_cast<const uint2*>(aa + (size_t)TT * DM + o);
      const uint2 g2 = *reinterpret_cast<const uint2*>(gg + o);
      const float4 ka4 = *reinterpret_cast<const float4*>(ka + col);
      const float4 rk4 = *reinterpret_cast<const float4*>(rk + col);
      const float4 lg4 = *reinterpret_cast<const float4*>(lg + col);
      const float4 lb4 = *reinterpret_cast<const float4*>(lb + col);
      float y[4] = {yf.x + yb.x, yf.y + yb.y, yf.z + yb.z, yf.w + yb.w};
      float r[4] = {bflo(r2.x), bfhi(r2.x), bflo(r2.y), bfhi(r2.y)};
      float kx[4] = {bflo(k2.x), bfhi(k2.x), bflo(k2.y), bfhi(k2.y)};
      float v[4] = {bflo(v2.x), bfhi(v2.x), bflo(v2.y), bfhi(v2.y)};
      float a0[4] = {bflo(a02.x), bfhi(a02.x), bflo(a02.y), bfhi(a02.y)};
      float a1[4] = {bflo(a12.x), bfhi(a12.x), bflo(a12.y), bfhi(a12.y)};
      float g[4] = {bflo(g2.x), bfhi(g2.x), bflo(g2.y), bfhi(g2.y)};
      float kav[4] = {ka4.x, ka4.y, ka4.z, ka4.w}, rkv[4] = {rk4.x, rk4.y, rk4.z, rk4.w};
      float lgv[4] = {lg4.x, lg4.y, lg4.z, lg4.w}, lbv[4] = {lb4.x, lb4.y, lb4.z, lb4.w};
      float sm = y[0] + y[1] + y[2] + y[3];
      sm = grp16_sum(sm);
      const float mean = sm * (1.0f / 64.0f);
      float sv = 0.f, sb = 0.f;
#pragma unroll
      for (int e = 0; e < 4; ++e) {
        float d = y[e] - mean; sv += d * d;
        float kd0 = kx[e] * (1.0f + (a0[e] - 1.0f) * kav[e]);
        float kd1 = kx[e] * (1.0f + (a1[e] - 1.0f) * kav[e]);
        sb += r[e] * (kd0 + kd1) * rkv[e];
      }
      sv = grp16_sum(sv); sb = grp16_sum(sb);
      const float rstd = rsqrtf(sv * (1.0f / 64.0f) + GN_EPS_F);
      float o4[4];
#pragma unroll
      for (int e = 0; e < 4; ++e) {
        float yn = (y[e] - mean) * rstd * lgv[e] + lbv[e];
        o4[e] = (yn + sb * v[e]) * g[e];
      }
      uint2 oo; oo.x = pack2(o4[0], o4[1]); oo.y = pack2(o4[2], o4[3]);
      *reinterpret_cast<uint2*>(p.abuf + o) = oo;
    }
  }
}

DEVINL void phase_wo(const Params& p, int layer, int w, int nw, char* smem) {
  const int j = layer >> 1;
  GEMM_LANE_VARS
  const bf16_t* Wt = ((layer & 1) ? p.attn_wo_t : p.rwkv_wo_t) + ((size_t)j << 20);
  for (int tile = w; tile < 96 * 8; tile += nw) {
    const int ct = tile / 96, rt = tile % 96;
    const int row0 = rt * 128, col0 = ct * 128;
    f32x4 acc[4][4];
    gemm_tile_128(p.abuf + (size_t)row0 * DM, DM, Wt + (size_t)col0 * DM, DM, 1024, smem, acc);
    const float* gate = p.mod + ((size_t)layer * 9 + cond_of_row(row0)) * 6144 + 2 * 1024;
#pragma unroll
    for (int m = 0; m < 4; ++m)
#pragma unroll
      for (int n = 0; n < 4; ++n)
#pragma unroll
        for (int jj = 0; jj < 4; ++jj) {
          int row = row0 + wr * 64 + m * 16 + fq * 4 + jj, col = col0 + wc * 64 + n * 16 + fr;
          size_t o = (size_t)row * DM + col;
          p.zbuf[o] = ALPHA_F * p.xbuf[o] + gate[col] * acc[m][n][jj];
        }
  }
}

DEVINL void phase_ln1(const Params& p, int layer, int w, int nw) {
  const int lane = tidx() & 63;
  const int gw = w * 4 + (tidx() >> 6), ngw = nw * 4;
  const float* lng = p.in[9] + (size_t)(layer * 2 + 0) * 1024;
  const float* lnb = p.in[10] + (size_t)(layer * 2 + 0) * 1024;
  for (int row = gw; row < TT; row += ngw) {
    const float* md = p.mod + ((size_t)layer * 9 + cond_of_row(row)) * 6144;
    float4 z[4];
    float s = 0.f;
#pragma unroll
    for (int k = 0; k < 4; ++k) {
      z[k] = *reinterpret_cast<const float4*>(p.zbuf + (size_t)row * DM + k * 256 + lane * 4);
      s += z[k].x + z[k].y + z[k].z + z[k].w;
    }
    const float mean = wave_sum(s) * (1.0f / 1024.0f);
    float sv = 0.f;
#pragma unroll
    for (int k = 0; k < 4; ++k) {
      float a = z[k].x - mean, b = z[k].y - mean, c = z[k].z - mean, d = z[k].w - mean;
      sv += a * a + b * b + c * c + d * d;
    }
    const float rstd = rsqrtf(wave_sum(sv) * (1.0f / 1024.0f) + LN_EPS_F);
#pragma unroll
    for (int k = 0; k < 4; ++k) {
      const int col = k * 256 + lane * 4;
      const float4 g4 = *reinterpret_cast<const float4*>(lng + col);
      const float4 b4 = *reinterpret_cast<const float4*>(lnb + col);
      const float4 sh = *reinterpret_cast<const float4*>(md + 3 * 1024 + col);
      const float4 sc = *reinterpret_cast<const float4*>(md + 4 * 1024 + col);
      float4 x1;
      x1.x = (z[k].x - mean) * rstd * g4.x + b4.x;
      x1.y = (z[k].y - mean) * rstd * g4.y + b4.y;
      x1.z = (z[k].z - mean) * rstd * g4.z + b4.z;
      x1.w = (z[k].w - mean) * rstd * g4.w + b4.w;
      *reinterpret_cast<float4*>(p.xbuf + (size_t)row * DM + col) = x1;
      uint2 o;
      o.x = pack2(x1.x * (1.0f + sc.x) + sh.x, x1.y * (1.0f + sc.y) + sh.y);
      o.y = pack2(x1.z * (1.0f + sc.z) + sh.z, x1.w * (1.0f + sc.w) + sh.w);
      *reinterpret_cast<uint2*>(p.hbuf + (size_t)row * DM + col) = o;
    }
  }
}

DEVINL void phase_p1(const Params& p, int layer, int w, int nw, char* smem) {
  GEMM_LANE_VARS
  bf16_t* qb = reinterpret_cast<bf16_t*>(p.U1);
  const bf16_t* Wt = p.wq_t + (size_t)layer * 2048 * 1024;
  for (int tile = w; tile < 96 * 16; tile += nw) {
    const int ct = tile / 96, rt = tile % 96;
    const int row0 = rt * 128, col0 = ct * 128;
    f32x4 acc[4][4];
    gemm_tile_128(p.hbuf + (size_t)row0 * DM, DM, Wt + (size_t)col0 * DM, DM, 1024, smem, acc);
#pragma unroll
    for (int m = 0; m < 4; ++m)
#pragma unroll
      for (int n = 0; n < 4; ++n)
#pragma unroll
        for (int jj = 0; jj < 4; ++jj) {
          int row = row0 + wr * 64 + m * 16 + fq * 4 + jj, col = col0 + wc * 64 + n * 16 + fr;
          qb[(size_t)row * 2048 + col] = f2bf(acc[m][n][jj]);
        }
  }
}

#define U1_S_OFF ((size_t)TT * 2048 * 2)
DEVINL void phase_p2(const Params& p, int layer, int w, int nw, char* smem) {
  GEMM_LANE_VARS
  const bf16_t* qb = reinterpret_cast<const bf16_t*>(p.U1);
  float* sb = reinterpret_cast<float*>(p.U1 + U1_S_OFF);
  for (int tile = w; tile < 96 * 16; tile += nw) {
    const int ct = tile / 96, rt = tile % 96;
    const int row0 = rt * 128;
    const int z = ct & 1;
    f32x4 acc[4][4];
    gemm_tile_128(qb + (size_t)row0 * 2048 + ct * 128, 2048, p.keysb + (size_t)(layer * 2 + z) * 16384, 128, 128, smem, acc);
#pragma unroll
    for (int m = 0; m < 4; ++m)
#pragma unroll
      for (int n = 0; n < 4; ++n)
#pragma unroll
        for (int jj = 0; jj < 4; ++jj) {
          int row = row0 + wr * 64 + m * 16 + fq * 4 + jj, col = wc * 64 + n * 16 + fr;
          sb[(size_t)row * 2048 + ct * 128 + col] = acc[m][n][jj];
        }
  }
}

DEVINL void phase_p3(const Params& p, int layer, int w, int nw, char* smem) {
  const int lane = tidx() & 63, wid = tidx() >> 6;
  const int gw = w * 4 + wid, ngw = nw * 4;
  const float* sb = reinterpret_cast<const float*>(p.U1 + U1_S_OFF);
  float* svl = reinterpret_cast<float*>(smem) + wid * 64;
  int* sil = reinterpret_cast<int*>(smem) + 256 + wid * 64;
  for (int t = gw; t < TT; t += ngw) {
    for (int h = 0; h < 8; ++h) {
      __builtin_amdgcn_wave_barrier();
#pragma unroll 1
      for (int z = 0; z < 2; ++z) {
        const float* sp = sb + (size_t)t * 2048 + (h * 2 + z) * 128;
        const float s0 = sp[lane], s1 = sp[lane + 64];
        unsigned k0 = (ordf(s0) & ~127u) | (unsigned)(127 - lane);
        unsigned k1 = (ordf(s1) & ~127u) | (unsigned)(63 - lane);
        int myidx = 0;
#pragma unroll 1
        for (int it = 0; it < 16; ++it) {
          unsigned m = wave_max_u(k0 > k1 ? k0 : k1);
          int idx = 127 - (int)(m & 127u);
          if (lane == it) myidx = idx;
          if (k0 == m) k0 = 0;
          if (k1 == m) k1 = 0;
        }
        if (lane < 16) { svl[z * 16 + lane] = sp[myidx]; sil[z * 16 + lane] = myidx; }
      }
      __builtin_amdgcn_wave_barrier();
      unsigned kc[4];
#pragma unroll
      for (int c = 0; c < 4; ++c) {
        int ci = lane * 4 + c;
        float sum = svl[ci >> 4] + svl[16 + (ci & 15)];
        kc[c] = (ordf(sum) & ~255u) | (unsigned)(255 - ci);
      }
      int myci = 0;
#pragma unroll 1
      for (int it = 0; it < 16; ++it) {
        unsigned a = kc[0] > kc[1] ? kc[0] : kc[1], b = kc[2] > kc[3] ? kc[2] : kc[3];
        unsigned m = wave_max_u(a > b ? a : b);
        int ci = 255 - (int)(m & 255u);
        if (lane == it) myci = ci;
#pragma unroll
        for (int c = 0; c < 4; ++c) if (kc[c] == m) kc[c] = 0;
      }
      const int ii = (myci >> 4) & 15, jj = myci & 15;
      float cv = svl[ii] + svl[16 + jj];
      int e = sil[ii] * 128 + sil[16 + jj];
      float mx = cv;
#pragma unroll
      for (int o = 8; o > 0; o >>= 1) mx = fmaxf(mx, __shfl_xor(mx, o));
      float ex = __expf(cv - mx);
      float sm = grp16_sum(ex);
      if (lane < 16) {
        p.pidx[(size_t)t * 128 + h * 16 + lane] = e;
        p.pgate[(size_t)t * 128 + h * 16 + lane] = ex / sm;
      }
    }
  }
}

DEVINL float gelu_exact(float x) { return 0.5f * x * (1.0f + erff(x * 0.7071067811865476f)); }

DEVINL void phase_p4(const Params& p, int layer, int w, int nw) {
  const int lane = tidx() & 63;
  const int gw = w * 4 + (tidx() >> 6), ngw = nw * 4;
  const bf16_t* U = p.ub + (size_t)layer * 16384 * 1024;
  const bf16_t* V = p.vb + (size_t)layer * 16384 * 1024;
  const float* lng = p.in[9] + (size_t)(layer * 2 + 1) * 1024;
  const float* lnb = p.in[10] + (size_t)(layer * 2 + 1) * 1024;
  float* xout = (layer == 3) ? p.out : p.xbuf;
  for (int t = gw; t < TT; t += ngw) {
    float x[16], f[16];
    {
      const uint4 a = *reinterpret_cast<const uint4*>(p.hbuf + (size_t)t * DM + lane * 8);
      const uint4 b = *reinterpret_cast<const uint4*>(p.hbuf + (size_t)t * DM + 512 + lane * 8);
      x[0] = bflo(a.x); x[1] = bfhi(a.x); x[2] = bflo(a.y); x[3] = bfhi(a.y); x[4] = bflo(a.z); x[5] = bfhi(a.z); x[6] = bflo(a.w); x[7] = bfhi(a.w);
      x[8] = bflo(b.x); x[9] = bfhi(b.x); x[10] = bflo(b.y); x[11] = bfhi(b.y); x[12] = bflo(b.z); x[13] = bfhi(b.z); x[14] = bflo(b.w); x[15] = bfhi(b.w);
    }
#pragma unroll
    for (int e = 0; e < 16; ++e) f[e] = 0.f;
    const int myidx0 = p.pidx[(size_t)t * 128 + lane], myidx1 = p.pidx[(size_t)t * 128 + 64 + lane];
    const float myg0 = p.pgate[(size_t)t * 128 + lane], myg1 = p.pgate[(size_t)t * 128 + 64 + lane];
#pragma unroll 4
    for (int e = 0; e < 128; ++e) {
      const int idx = __shfl(e < 64 ? myidx0 : myidx1, e & 63);
      const float gt = __shfl(e < 64 ? myg0 : myg1, e & 63);
      const bf16_t* up = U + (size_t)idx * DM;
      const uint4 a = *reinterpret_cast<const uint4*>(up + lane * 8);
      const uint4 b = *reinterpret_cast<const uint4*>(up + 512 + lane * 8);
      float d = x[0] * bflo(a.x) + x[1] * bfhi(a.x) + x[2] * bflo(a.y) + x[3] * bfhi(a.y) + x[4] * bflo(a.z) + x[5] * bfhi(a.z) + x[6] * bflo(a.w) + x[7] * bfhi(a.w)
              + x[8] * bflo(b.x) + x[9] * bfhi(b.x) + x[10] * bflo(b.y) + x[11] * bfhi(b.y) + x[12] * bflo(b.z) + x[13] * bfhi(b.z) + x[14] * bflo(b.w) + x[15] * bfhi(b.w);
      d = wave_sum(d);
      const float wgt = gt * gelu_exact(d);
      const bf16_t* vp = V + (size_t)idx * DM;
      const uint4 c = *reinterpret_cast<const uint4*>(vp + lane * 8);
      const uint4 dd = *reinterpret_cast<const uint4*>(vp + 512 + lane * 8);
      f[0] += wgt * bflo(c.x); f[1] += wgt * bfhi(c.x); f[2] += wgt * bflo(c.y); f[3] += wgt * bfhi(c.y);
      f[4] += wgt * bflo(c.z); f[5] += wgt * bfhi(c.z); f[6] += wgt * bflo(c.w); f[7] += wgt * bfhi(c.w);
      f[8] += wgt * bflo(dd.x); f[9] += wgt * bfhi(dd.x); f[10] += wgt * bflo(dd.y); f[11] += wgt * bfhi(dd.y);
      f[12] += wgt * bflo(dd.z); f[13] += wgt * bfhi(dd.z); f[14] += wgt * bflo(dd.w); f[15] += wgt * bfhi(dd.w);
    }
    const float* md = p.mod + ((size_t)layer * 9 + cond_of_row(t)) * 6144 + 5 * 1024;
    float zz[16];
    float s = 0.f;
#pragma unroll
    for (int hf = 0; hf < 2; ++hf) {
      const int col = hf * 512 + lane * 8;
      const float4 x0 = *reinterpret_cast<const float4*>(p.xbuf + (size_t)t * DM + col);
      const float4 x1 = *reinterpret_cast<const float4*>(p.xbuf + (size_t)t * DM + col + 4);
      const float4 g0 = *reinterpret_cast<const float4*>(md + col);
      const float4 g1 = *reinterpret_cast<const float4*>(md + col + 4);
      const float xv[8] = {x0.x, x0.y, x0.z, x0.w, x1.x, x1.y, x1.z, x1.w};
      const float gv[8] = {g0.x, g0.y, g0.z, g0.w, g1.x, g1.y, g1.z, g1.w};
#pragma unroll
      for (int e = 0; e < 8; ++e) { zz[hf * 8 + e] = ALPHA_F * xv[e] + gv[e] * f[hf * 8 + e]; s += zz[hf * 8 + e]; }
    }
    const float mean = wave_sum(s) * (1.0f / 1024.0f);
    float sv = 0.f;
#pragma unroll
    for (int e = 0; e < 16; ++e) { float d = zz[e] - mean; sv += d * d; }
    const float rstd = rsqrtf(wave_sum(sv) * (1.0f / 1024.0f) + LN_EPS_F);
#pragma unroll
    for (int hf = 0; hf < 2; ++hf) {
      const int col = hf * 512 + lane * 8;
      const float4 g0 = *reinterpret_cast<const float4*>(lng + col);
      const float4 g1 = *reinterpret_cast<const float4*>(lng + col + 4);
      const float4 b0 = *reinterpret_cast<const float4*>(lnb + col);
      const float4 b1 = *reinterpret_cast<const float4*>(lnb + col + 4);
      float4 o0, o1;
      o0.x = (zz[hf * 8 + 0] - mean) * rstd * g0.x + b0.x;
      o0.y = (zz[hf * 8 + 1] - mean) * rstd * g0.y + b0.y;
      o0.z = (zz[hf * 8 + 2] - mean) * rstd * g0.z + b0.z;
      o0.w = (zz[hf * 8 + 3] - mean) * rstd * g0.w + b0.w;
      o1.x = (zz[hf * 8 + 4] - mean) * rstd * g1.x + b1.x;
      o1.y = (zz[hf * 8 + 5] - mean) * rstd * g1.y + b1.y;
      o1.z = (zz[hf * 8 + 6] - mean) * rstd * g1.z + b1.z;
      o1.w = (zz[hf * 8 + 7] - mean) * rstd * g1.w + b1.w;
      *reinterpret_cast<float4*>(xout + (size_t)t * DM + col) = o0;
      *reinterpret_cast<float4*>(xout + (size_t)t * DM + col + 4) = o1;
    }
  }
}

DEVINL void phase_a1(const Params& p, int layer, int w, int nw) {
  const int lane = tidx() & 63;
  const int gw = w * 4 + (tidx() >> 6), ngw = nw * 4;
  for (int row = gw; row < TT; row += ngw) {
    const float* md = p.mod + ((size_t)layer * 9 + cond_of_row(row)) * 6144;
#pragma unroll
    for (int k = 0; k < 4; ++k) {
      const int col = k * 256 + lane * 4;
      const float4 x = *reinterpret_cast<const float4*>(p.xbuf + (size_t)row * DM + col);
      const float4 sh = *reinterpret_cast<const float4*>(md + col);
      const float4 sc = *reinterpret_cast<const float4*>(md + 1024 + col);
      uint2 o;
      o.x = pack2(x.x * (1.0f + sc.x) + sh.x, x.y * (1.0f + sc.y) + sh.y);
      o.y = pack2(x.z * (1.0f + sc.z) + sh.z, x.w * (1.0f + sc.w) + sh.w);
      *reinterpret_cast<uint2*>(p.hbuf + (size_t)row * DM + col) = o;
    }
  }
}

DEVINL void phase_a2(const Params& p, int layer, int w, int nw, char* smem) {
  const int j = layer >> 1;
  GEMM_LANE_VARS
  bf16_t* qb = reinterpret_cast<bf16_t*>(p.U2);
  const bf16_t* Wt = p.attn_wqkv_t + (size_t)j * 1536 * 1024;
  const float* qn = p.in[29] + j * 64;
  const float* kn = p.in[30] + j * 64;
  for (int tile = w; tile < 96 * 12; tile += nw) {
    const int ct = tile / 96, rt = tile % 96;
    const int row0 = rt * 128;
    const bool lat = row0 >= TCTX;
    f32x4 acc[4][4];
    gemm_tile_128(p.hbuf + (size_t)row0 * DM, DM, Wt + (size_t)ct * 128 * DM, DM, 1024, smem, acc);
    if (ct < 10) {
      const bool isq = ct < 8;
      const int head = isq ? (ct * 2 + wc) : ((ct - 8) * 2 + wc);
      const float* nw_ = isq ? qn : kn;
      float nv[4];
#pragma unroll
      for (int n = 0; n < 4; ++n) nv[n] = nw_[n * 16 + fr];
#pragma unroll
      for (int m = 0; m < 4; ++m)
#pragma unroll
        for (int jj = 0; jj < 4; ++jj) {
          asm volatile("" ::: "memory");
          const int row = row0 + wr * 64 + m * 16 + fq * 4 + jj;
          float v[4], ss = 0.f;
#pragma unroll
          for (int n = 0; n < 4; ++n) { v[n] = acc[m][n][jj]; ss += v[n] * v[n]; }
          ss = grp16_sum(ss);
          const float rinv = rsqrtf(ss * (1.0f / 64.0f) + RMS_EPS_F);
#pragma unroll
          for (int n = 0; n < 4; ++n) v[n] = v[n] * rinv * nv[n];
          if (lat) {
            const int t = (row - TCTX) & 1023, b = (row - TCTX) >> 10;
            const int pr = t >> 6, pc = t & 63;
            const float c0 = p.rope[(pr * 16 + fr) * 2], s0 = p.rope[(pr * 16 + fr) * 2 + 1];
            const float c1 = p.rope[(pc * 16 + fr) * 2], s1 = p.rope[(pc * 16 + fr) * 2 + 1];
            const float o0 = v[0] * c0 - v[1] * s0, o1 = v[1] * c0 + v[0] * s0;
            const float o2 = v[2] * c1 - v[3] * s1, o3 = v[3] * c1 + v[2] * s1;
            v[0] = o0; v[1] = o1; v[2] = o2; v[3] = o3;
            if (isq) {
#pragma unroll
              for (int n = 0; n < 4; ++n) qb[(size_t)row * DM + head * 64 + n * 16 + fr] = f2bf(v[n] * QSCALE_F);
            } else {
              bf16_t* kd = p.Klat + ((size_t)((j * 8 + b) * 4 + head) * 1536 + 512 + t) * 64;
#pragma unroll
              for (int n = 0; n < 4; ++n) kd[n * 16 + fr] = f2bf(v[n]);
            }
          } else {
            const int t = row & 255, b = row >> 8;
            if (isq) {
#pragma unroll
              for (int n = 0; n < 4; ++n) qb[(size_t)row * DM + head * 64 + n * 16 + fr] = f2bf(v[n] * QSCALE_F);
            } else {
              bf16_t* kd = p.Kctx + ((size_t)((j * 16 + b) * 4 + head) * 256 + t) * 64;
              float* ko = p.out + OUT_CK + ((size_t)(b * 2 + j) * 256 + t) * 256 + head * 64;
#pragma unroll
              for (int n = 0; n < 4; ++n) { kd[n * 16 + fr] = f2bf(v[n]); ko[n * 16 + fr] = v[n]; }
            }
          }
        }
    } else {
      const int head = (ct - 10) * 2 + wc;
#pragma unroll
      for (int m = 0; m < 4; ++m)
#pragma unroll
        for (int jj = 0; jj < 4; ++jj) {
          asm volatile("" ::: "memory");
          const int row = row0 + wr * 64 + m * 16 + fq * 4 + jj;
          if (lat) {
            const int t = (row - TCTX) & 1023, b = (row - TCTX) >> 10;
            bf16_t* vd = p.VlatT + (size_t)((j * 8 + b) * 4 + head) * 64 * 1536 + 512 + t;
#pragma unroll
            for (int n = 0; n < 4; ++n) vd[(size_t)(n * 16 + fr) * 1536] = f2bf(acc[m][n][jj]);
          } else {
            const int t = row & 255, b = row >> 8;
            bf16_t* vd = p.VctxT + (size_t)((j * 16 + b) * 4 + head) * 64 * 256 + t;
            float* vo = p.out + OUT_CV + ((size_t)(b * 2 + j) * 256 + t) * 256 + head * 64;
#pragma unroll
            for (int n = 0; n < 4; ++n) { vd[(size_t)(n * 16 + fr) * 256] = f2bf(acc[m][n][jj]); vo[n * 16 + fr] = acc[m][n][jj]; }
          }
        }
    }
  }
}

DEVINL void phase_a3(const Params& p, int layer, int w, int nw) {
  const int j = layer >> 1;
  const int lane = tidx() & 63, wid = tidx() >> 6;
  const int ql = lane & 31, hh = lane >> 5;
  const bf16_t* qb = reinterpret_cast<const bf16_t*>(p.U2);
  for (int item = w; item < 1536; item += nw) {
    int hq, Tk, row0;
    const bf16_t *Kb, *Vt;
    if (item < 1024) {
      const int b = item >> 7, qblk = item & 7;
      hq = (item >> 3) & 15;
      const int kvh = hq >> 2;
      Kb = p.Klat + (size_t)((j * 8 + b) * 4 + kvh) * 1536 * 64;
      Vt = p.VlatT + (size_t)((j * 8 + b) * 4 + kvh) * 64 * 1536;
      Tk = 1536; row0 = TCTX + b * 1024 + qblk * 128;
    } else {
      const int it = item - 1024;
      const int b = it >> 5, qblk = it & 1;
      hq = (it >> 1) & 15;
      const int kvh = hq >> 2;
      Kb = p.Kctx + (size_t)((j * 16 + b) * 4 + kvh) * 256 * 64;
      Vt = p.VctxT + (size_t)((j * 16 + b) * 4 + kvh) * 64 * 256;
      Tk = 256; row0 = b * 256 + qblk * 128;
    }
    const int qrow = row0 + wid * 32 + ql;
    bf16x8 bq[4];
#pragma unroll
    for (int ks = 0; ks < 4; ++ks) bq[ks] = *reinterpret_cast<const bf16x8*>(qb + (size_t)qrow * DM + hq * 64 + ks * 16 + hh * 8);
    f32x16 o0, o1;
#pragma unroll
    for (int r = 0; r < 16; ++r) { o0[r] = 0.f; o1[r] = 0.f; }
    float mrun = -1e30f, lrun = 0.f;
    for (int kt = 0; kt < Tk; kt += 32) {
      f32x16 sacc;
#pragma unroll
      for (int r = 0; r < 16; ++r) sacc[r] = 0.f;
#pragma unroll
      for (int ks = 0; ks < 4; ++ks) {
        bf16x8 ka = *reinterpret_cast<const bf16x8*>(Kb + (size_t)(kt + ql) * 64 + ks * 16 + hh * 8);
        sacc = __builtin_amdgcn_mfma_f32_32x32x16_bf16(ka, bq[ks], sacc, 0, 0, 0);
      }
      float tmax = sacc[0];
#pragma unroll
      for (int r = 1; r < 16; ++r) tmax = fmaxf(tmax, sacc[r]);
      tmax = fmaxf(tmax, __shfl_xor(tmax, 32));
      const float mnew = fmaxf(mrun, tmax);
      const float corr = exp2f(mrun - mnew);
      mrun = mnew;
      lrun *= corr;
#pragma unroll
      for (int r = 0; r < 16; ++r) { o0[r] *= corr; o1[r] *= corr; }
      float pv[16];
#pragma unroll
      for (int r = 0; r < 16; ++r) { pv[r] = exp2f(sacc[r] - mnew); lrun += pv[r]; }
#pragma unroll
      for (int s2 = 0; s2 < 2; ++s2) {
        union { bf16x8 v; unsigned u[4]; } pb;
#pragma unroll
        for (int q = 0; q < 4; ++q) pb.u[q] = pack2(pv[s2 * 8 + q * 2], pv[s2 * 8 + q * 2 + 1]);
#pragma unroll
        for (int dblk = 0; dblk < 2; ++dblk) {
          const bf16_t* vp = Vt + (size_t)(dblk * 32 + ql) * Tk + kt + 16 * s2 + 4 * hh;
          const uint2 lo = *reinterpret_cast<const uint2*>(vp);
          const uint2 hi = *reinterpret_cast<const uint2*>(vp + 8);
          union { bf16x8 v; unsigned u[4]; } va;
          va.u[0] = lo.x; va.u[1] = lo.y; va.u[2] = hi.x; va.u[3] = hi.y;
          if (dblk == 0) o0 = __builtin_amdgcn_mfma_f32_32x32x16_bf16(va.v, pb.v, o0, 0, 0, 0);
          else o1 = __builtin_amdgcn_mfma_f32_32x32x16_bf16(va.v, pb.v, o1, 0, 0, 0);
        }
      }
    }
    const float ltot = lrun + __shfl_xor(lrun, 32);
    const float inv = 1.0f / ltot;
#pragma unroll
    for (int g = 0; g < 4; ++g) {
      uint2 oa, ob;
      oa.x = pack2(o0[4 * g] * inv, o0[4 * g + 1] * inv); oa.y = pack2(o0[4 * g + 2] * inv, o0[4 * g + 3] * inv);
      ob.x = pack2(o1[4 * g] * inv, o1[4 * g + 1] * inv); ob.y = pack2(o1[4 * g + 2] * inv, o1[4 * g + 3] * inv);
      *reinterpret_cast<uint2*>(p.abuf + (size_t)qrow * DM + hq * 64 + 8 * g + 4 * hh) = oa;
      *reinterpret_cast<uint2*>(p.abuf + (size_t)qrow * DM + hq * 64 + 32 + 8 * g + 4 * hh) = ob;
    }
  }
}

__global__ void __launch_bounds__(NTHREADS, 2) mega_kernel(Params p) {
  __shared__ __attribute__((aligned(16))) char smem[SMEM_BYTES];
  cg::grid_group grid = cg::this_grid();
  const int w = blockIdx.x, nw = gridDim.x;
#define GSYNC() grid.sync()
  phase_prep(p, w, nw, smem);
  GSYNC();
  for (int layer = 0; layer < 4; ++layer) {
    if ((layer & 1) == 0) {
      phase_r1(p, layer, w, nw); GSYNC();
      phase_r2(p, layer, w, nw, smem); GSYNC();
      phase_r3(p, layer, w, nw, smem); GSYNC();
      phase_r4(p, layer, w, nw, smem); GSYNC();
      phase_r5(p, layer, w, nw); GSYNC();
    } else {
      phase_a1(p, layer, w, nw); GSYNC();
      phase_a2(p, layer, w, nw, smem); GSYNC();
      phase_a3(p, layer, w, nw); GSYNC();
    }
    phase_wo(p, layer, w, nw, smem); GSYNC();
    phase_ln1(p, layer, w, nw); GSYNC();
    phase_p1(p, layer, w, nw, smem); GSYNC();
    phase_p2(p, layer, w, nw, smem); GSYNC();
    phase_p3(p, layer, w, nw, smem); GSYNC();
    phase_p4(p, layer, w, nw);
    if (layer < 3) GSYNC();
  }
}

static inline char* carve(char*& cur, size_t bytes) {
  char* r = cur;
  cur += (bytes + 255) & ~(size_t)255;
  return r;
}

extern "C" void kernel_launch(void* const* d_in, const int* in_sizes, int n_in, void* d_out, int out_size, void* d_ws,
                              size_t ws_size, hipStream_t stream) {
  Params p;
  memset(&p, 0, sizeof(p));
  for (int i = 0; i < 35; ++i) p.in[i] = (const float*)d_in[i];
  p.out = (float*)d_out;
  char* cur = (char*)d_ws;
  carve(cur, 16384);
  p.mod = (float*)carve(cur, (size_t)4 * 9 * 6144 * 4);
  p.rope = (float*)carve(cur, 64 * 16 * 2 * 4);
  p.rwkv_in_t = (bf16_t*)carve(cur, (size_t)2 * 3456 * 1024 * 2);
  p.w2t = (bf16_t*)carve(cur, (size_t)4 * 65536 * 2);
  p.a2t = (bf16_t*)carve(cur, (size_t)4 * 65536 * 2);
  p.g2t = (bf16_t*)carve(cur, (size_t)2 * 131072 * 2);
  p.rwkv_wo_t = (bf16_t*)carve(cur, (size_t)2 * 1048576 * 2);
  p.attn_wqkv_t = (bf16_t*)carve(cur, (size_t)2 * 1536 * 1024 * 2);
  p.attn_wo_t = (bf16_t*)carve(cur, (size_t)2 * 1048576 * 2);
  p.wq_t = (bf16_t*)carve(cur, (size_t)4 * 2048 * 1024 * 2);
  p.keysb = (bf16_t*)carve(cur, (size_t)4 * 2 * 128 * 128 * 2);
  p.ub = (bf16_t*)carve(cur, (size_t)4 * 16384 * 1024 * 2);
  p.vb = (bf16_t*)carve(cur, (size_t)4 * 16384 * 1024 * 2);
  p.Klat = (bf16_t*)carve(cur, (size_t)2 * 8 * 4 * 1536 * 64 * 2);
  p.VlatT = (bf16_t*)carve(cur, (size_t)2 * 8 * 4 * 1536 * 64 * 2);
  p.Kctx = (bf16_t*)carve(cur, (size_t)2 * 16 * 4 * 256 * 64 * 2);
  p.VctxT = (bf16_t*)carve(cur, (size_t)2 * 16 * 4 * 256 * 64 * 2);
  p.xbuf = (float*)carve(cur, (size_t)TT * DM * 4);
  p.zbuf = (float*)carve(cur, (size_t)TT * DM * 4);
  p.hbuf = (bf16_t*)carve(cur, (size_t)TT * DM * 2);
  p.abuf = (bf16_t*)carve(cur, (size_t)TT * DM * 2);
  p.U1 = carve(cur, (size_t)TT * DM * 14);
  p.U2 = carve(cur, (size_t)TT * DM * 8);
  p.U3 = carve(cur, (size_t)TT * DM * 8);
  p.pidx = (int*)carve(cur, (size_t)TT * 128 * 4);
  p.pgate = (float*)carve(cur, (size_t)TT * 128 * 4);
  for (int f = 0; f < 16; ++f) p.freqs[f] = pow(10000.0, -(double)f / 16.0);
  if ((size_t)(cur - (char*)d_ws) > ws_size) {
    fprintf(stderr, "workspace too small: need %zu have %zu\n", (size_t)(cur - (char*)d_ws), ws_size);
    return;
  }
  static int grid_blocks = 0;
  if (!grid_blocks) {
    int dev = 0, cus = 0, per_cu = 0;
    hipGetDevice(&dev);
    hipDeviceGetAttribute(&cus, hipDeviceAttributeMultiprocessorCount, dev);
    hipOccupancyMaxActiveBlocksPerMultiprocessor(&per_cu, mega_kernel, NTHREADS, 0);
    if (per_cu > 2) per_cu = 2;
    if (per_cu < 1) per_cu = 1;
    grid_blocks = cus * per_cu;
  }
  void* args[] = {&p};
  hipError_t e = hipLaunchCooperativeKernel((void*)mega_kernel, dim3(grid_blocks), dim3(NTHREADS), args, 0, stream);
  if (e != hipSuccess) fprintf(stderr, "cooperative launch failed: %s (grid %d)\n", hipGetErrorString(e), grid_blocks);
}
```

```cpp
#include <hip/hip_runtime.h>
#include <hip/hip_cooperative_groups.h>
#include <stdint.h>
#include <string.h>
#include <math.h>
#include <stdio.h>

namespace cg = cooperative_groups;

typedef unsigned short bf16_t;
typedef __attribute__((ext_vector_type(8))) short bf16x8;
typedef __attribute__((ext_vector_type(4))) float f32x4;
typedef __attribute__((ext_vector_type(16))) float f32x16;

#define DEVINL __device__ __forceinline__
#define NTHREADS 256
#define SMEM_BYTES 49152

#define DM 1024
#define TCTX 4096
#define TLAT 8192
#define TT 12288
#define ALPHA_F 1.681792830507429f
#define LN_EPS_F 1e-5f
#define GN_EPS_F 6.4e-4f
#define RMS_EPS_F 1e-6f
#define QSCALE_F (0.125f * 1.4426950408889634f)

#define OUT_Y 0
#define OUT_STATE 12582912
#define OUT_CK 16777216
#define OUT_CV 18874368

struct Params {
  const float* in[35];
  float* out;
  float* mod;
  float* rope;
  bf16_t* rwkv_in_t;
  bf16_t* w2t;
  bf16_t* a2t;
  bf16_t* g2t;
  bf16_t* rwkv_wo_t;
  bf16_t* attn_wqkv_t;
  bf16_t* attn_wo_t;
  bf16_t* wq_t;
  bf16_t* keysb;
  bf16_t* ub;
  bf16_t* vb;
  bf16_t* Klat;
  bf16_t* VlatT;
  bf16_t* Kctx;
  bf16_t* VctxT;
  float* xbuf;
  float* zbuf;
  bf16_t* hbuf;
  bf16_t* abuf;
  char* U1;
  char* U2;
  char* U3;
  int* pidx;
  float* pgate;
  double freqs[16];
  unsigned* bar;
  int use_cg_sync;
  int pad0;
};

DEVINL int tidx() { int t = threadIdx.x; asm volatile("" : "+v"(t)); return t; }
DEVINL bf16_t f2bf(float f) {
  unsigned u = __float_as_uint(f);
  u += 0x7FFFu + ((u >> 16) & 1u);
  return (bf16_t)(u >> 16);
}
DEVINL float bf2f(bf16_t h) { return __uint_as_float(((unsigned)h) << 16); }
DEVINL unsigned pack2(float a, float b) { return (unsigned)f2bf(a) | ((unsigned)f2bf(b) << 16); }
DEVINL float bflo(unsigned u) { return __uint_as_float(u << 16); }
DEVINL float bfhi(unsigned u) { return __uint_as_float(u & 0xFFFF0000u); }

DEVINL float wave_sum(float v) {
#pragma unroll
  for (int o = 32; o > 0; o >>= 1) v += __shfl_xor(v, o);
  return v;
}
DEVINL float grp16_sum(float v) {
#pragma unroll
  for (int o = 8; o > 0; o >>= 1) v += __shfl_xor(v, o);
  return v;
}
DEVINL unsigned wave_max_u(unsigned v) {
#pragma unroll
  for (int o = 32; o > 0; o >>= 1) { unsigned t = (unsigned)__shfl_xor((int)v, o); v = v > t ? v : t; }
  return v;
}
DEVINL float sigmoidf_(float x) { return 1.0f / (1.0f + __expf(-x)); }
DEVINL float tanhf_(float x) { float e = __expf(-2.0f * fabsf(x)); float t = (1.0f - e) / (1.0f + e); return x < 0 ? -t : t; }
DEVINL unsigned ordf(float f) { unsigned u = __float_as_uint(f); return (u & 0x80000000u) ? ~u : (u | 0x80000000u); }

DEVINL int cond_of_row(int row) { return row < TCTX ? 8 : ((row - TCTX) >> 10); }

DEVINL void gemm_tile_128(const bf16_t* __restrict__ A, int lda, const bf16_t* __restrict__ Bt, int ldb, int K,
                          char* smem, f32x4 (&acc)[4][4]) {
  const int tid = tidx(), wid = tid >> 6, lane = tid & 63;
  const int wr = wid >> 1, wc = wid & 1, fr = lane & 15, fq = lane >> 4;
  char* SA = smem;
  char* SB = smem + 8192;
#pragma unroll
  for (int m = 0; m < 4; ++m)
#pragma unroll
    for (int n = 0; n < 4; ++n) acc[m][n] = (f32x4){0.f, 0.f, 0.f, 0.f};
  for (int k0 = 0; k0 < K; k0 += 32) {
#pragma unroll
    for (int i = 0; i < 2; ++i) {
      int b = tid * 16 + i * 4096;
      int r = b >> 6, c = (b & 63) >> 1;
      __builtin_amdgcn_global_load_lds((const unsigned*)(A + (size_t)r * lda + k0 + c), (unsigned*)(SA + b), 16, 0, 0);
      __builtin_amdgcn_global_load_lds((const unsigned*)(Bt + (size_t)r * ldb + k0 + c), (unsigned*)(SB + b), 16, 0, 0);
    }
    asm volatile("s_waitcnt vmcnt(0)" ::: "memory");
    __syncthreads();
    bf16x8 a[4], b[4];
#pragma unroll
    for (int m = 0; m < 4; ++m) a[m] = *reinterpret_cast<const bf16x8*>(SA + (wr * 64 + m * 16 + fr) * 64 + fq * 16);
#pragma unroll
    for (int n = 0; n < 4; ++n) b[n] = *reinterpret_cast<const bf16x8*>(SB + (wc * 64 + n * 16 + fr) * 64 + fq * 16);
#pragma unroll
    for (int m = 0; m < 4; ++m)
#pragma unroll
      for (int n = 0; n < 4; ++n) acc[m][n] = __builtin_amdgcn_mfma_f32_16x16x32_bf16(a[m], b[n], acc[m][n], 0, 0, 0);
    __syncthreads();
  }
}

#define GEMM_LANE_VARS \
  const int tid = tidx(), wid = tid >> 6, lane = tid & 63; \
  const int wr = wid >> 1, wc = wid & 1, fr = lane & 15, fq = lane >> 4; \
  (void)tid; (void)wid; (void)lane; (void)wr; (void)wc; (void)fr; (void)fq;

DEVINL void get_tjob(const Params& p, int ji, const float*& src, bf16_t*& dst, int& K, int& N) {
  if (ji < 28) {
    int j = ji / 14, s = ji % 14;
    if (s < 3) { src = p.in[12] + ((size_t)(j * 3 + s) << 20); dst = p.rwkv_in_t + (size_t)j * 3456 * 1024 + ((size_t)s << 20); K = 1024; N = 1024; }
    else if (s < 5) { int z = s - 3; src = p.in[15] + (size_t)(j * 2 + z) * 65536; dst = p.rwkv_in_t + (size_t)j * 3456 * 1024 + (size_t)(3072 + z * 64) * 1024; K = 1024; N = 64; }
    else if (s < 7) { int z = s - 5; src = p.in[18] + (size_t)(j * 2 + z) * 65536; dst = p.rwkv_in_t + (size_t)j * 3456 * 1024 + (size_t)(3200 + z * 64) * 1024; K = 1024; N = 64; }
    else if (s == 7) { src = p.in[20] + (size_t)j * 131072; dst = p.rwkv_in_t + (size_t)j * 3456 * 1024 + (size_t)3328 * 1024; K = 1024; N = 128; }
    else if (s < 10) { int z = s - 8; src = p.in[16] + (size_t)(j * 2 + z) * 65536; dst = p.w2t + (size_t)(j * 2 + z) * 65536; K = 64; N = 1024; }
    else if (s < 12) { int z = s - 10; src = p.in[19] + (size_t)(j * 2 + z) * 65536; dst = p.a2t + (size_t)(j * 2 + z) * 65536; K = 64; N = 1024; }
    else if (s == 12) { src = p.in[21] + (size_t)j * 131072; dst = p.g2t + (size_t)j * 131072; K = 128; N = 1024; }
    else { src = p.in[13] + ((size_t)j << 20); dst = p.rwkv_wo_t + ((size_t)j << 20); K = 1024; N = 1024; }
  } else if (ji < 32) {
    int j = (ji - 28) >> 1, s = (ji - 28) & 1;
    if (s == 0) { src = p.in[27] + (size_t)j * 1024 * 1536; dst = p.attn_wqkv_t + (size_t)j * 1536 * 1024; K = 1024; N = 1536; }
    else { src = p.in[28] + ((size_t)j << 20); dst = p.attn_wo_t + ((size_t)j << 20); K = 1024; N = 1024; }
  } else {
    int i = ji - 32;
    src = p.in[31] + (size_t)i * 1024 * 2048; dst = p.wq_t + (size_t)i * 2048 * 1024; K = 1024; N = 2048;
  }
}

DEVINL void sincos_d(double x, float& c, float& s) {
  const double TWO_PI = 6.283185307179586476925;
  double r = x - TWO_PI * rint(x / TWO_PI);
  double r2 = r * r;
  double ts = r, tc = 1.0, ss = r, cs = 1.0;
#pragma unroll 1
  for (int n = 1; n <= 14; ++n) {
    tc = -tc * r2 / (double)((2 * n - 1) * (2 * n));
    ts = -ts * r2 / (double)((2 * n) * (2 * n + 1));
    cs += tc; ss += ts;
  }
  c = (float)cs; s = (float)ss;
}

DEVINL void phase_prep(const Params& p, int w, int nw, char* smem) {
  const int tid = tidx();
  {
    float (*tile)[65] = reinterpret_cast<float (*)[65]>(smem);
    int toff = 0;
    for (int ji = 0; ji < 36; ++ji) {
      const float* src; bf16_t* dst; int K, N;
      get_tjob(p, ji, src, dst, K, N);
      const int tn = N >> 6, nt = (K >> 6) * tn;
      int t0 = (w - (toff % nw) + nw) % nw;
      for (int t = t0; t < nt; t += nw) {
        const int k0 = (t / tn) << 6, n0 = (t % tn) << 6;
#pragma unroll
        for (int i = 0; i < 4; ++i) {
          int r = (tid >> 4) + 16 * i, c = (tid & 15) * 4;
          float4 v = *reinterpret_cast<const float4*>(src + (size_t)(k0 + r) * N + n0 + c);
          tile[r][c] = v.x; tile[r][c + 1] = v.y; tile[r][c + 2] = v.z; tile[r][c + 3] = v.w;
        }
        __syncthreads();
#pragma unroll
        for (int i = 0; i < 2; ++i) {
          int q = tid + 256 * i;
          int n = q >> 3, kc = (q & 7) * 8;
          uint4 o;
          o.x = pack2(tile[kc + 0][n], tile[kc + 1][n]);
          o.y = pack2(tile[kc + 2][n], tile[kc + 3][n]);
          o.z = pack2(tile[kc + 4][n], tile[kc + 5][n]);
          o.w = pack2(tile[kc + 6][n], tile[kc + 7][n]);
          *reinterpret_cast<uint4*>(dst + (size_t)(n0 + n) * K + k0 + kc) = o;
        }
        __syncthreads();
      }
      toff += nt;
    }
  }
  const size_t gtid = (size_t)w * NTHREADS + tid, gn = (size_t)nw * NTHREADS;
  {
    const size_t n8 = (size_t)4 * 16384 * 1024 / 8;
    for (size_t i = gtid; i < n8; i += gn) {
      const float4* su = reinterpret_cast<const float4*>(p.in[33]) + i * 2;
      float4 a = su[0], b = su[1];
      uint4 o; o.x = pack2(a.x, a.y); o.y = pack2(a.z, a.w); o.z = pack2(b.x, b.y); o.w = pack2(b.z, b.w);
      reinterpret_cast<uint4*>(p.ub)[i] = o;
      const float4* sv = reinterpret_cast<const float4*>(p.in[34]) + i * 2;
      a = sv[0]; b = sv[1];
      o.x = pack2(a.x, a.y); o.y = pack2(a.z, a.w); o.z = pack2(b.x, b.y); o.w = pack2(b.z, b.w);
      reinterpret_cast<uint4*>(p.vb)[i] = o;
    }
    const size_t nk8 = (size_t)4 * 2 * 128 * 128 / 8;
    for (size_t i = gtid; i < nk8; i += gn) {
      const float4* su = reinterpret_cast<const float4*>(p.in[32]) + i * 2;
      float4 a = su[0], b = su[1];
      uint4 o; o.x = pack2(a.x, a.y); o.y = pack2(a.z, a.w); o.z = pack2(b.x, b.y); o.w = pack2(b.z, b.w);
      reinterpret_cast<uint4*>(p.keysb)[i] = o;
    }
  }
  {
    const size_t nk = (size_t)8 * 2 * 512 * 4 * 64;
    for (size_t i = gtid; i < nk; i += gn) {
      int d = i & 63, kvh = (i >> 6) & 3, s = (i >> 8) & 511, j = (i >> 17) & 1, b = (int)(i >> 18);
      p.Klat[((size_t)((j * 8 + b) * 4 + kvh) * 1536 + s) * 64 + d] = f2bf(p.in[4][i]);
      p.VlatT[((size_t)((j * 8 + b) * 4 + kvh) * 64 + d) * 1536 + s] = f2bf(p.in[5][i]);
    }
  }
  for (size_t i = gtid; i < 1024; i += gn) {
    int pos = (int)(i >> 4), f = (int)(i & 15);
    float c, s; sincos_d((double)pos * p.freqs[f], c, s);
    p.rope[i * 2] = c; p.rope[i * 2 + 1] = s;
  }
  {
    const size_t n4 = (size_t)TT * DM / 4, nc4 = (size_t)TCTX * DM / 4;
    for (size_t i = gtid; i < n4; i += gn) {
      float4 v = (i < nc4) ? reinterpret_cast<const float4*>(p.in[0])[i] : reinterpret_cast<const float4*>(p.in[1])[i - nc4];
      reinterpret_cast<float4*>(p.xbuf)[i] = v;
    }
  }
  {
    float* sc = reinterpret_cast<float*>(smem);
    float* red = sc + 9 * 1024;
    bool loaded = false;
    for (int item = w; item < 384; item += nw) {
      if (!loaded) {
        __syncthreads();
        for (int e = tid; e < 9 * 1024; e += NTHREADS) {
          int c = e >> 10, d = e & 1023;
          float v = (c < 8) ? p.in[2][c * 1024 + d] : p.in[6][d];
          sc[e] = v / (1.0f + __expf(-v));
        }
        __syncthreads();
        loaded = true;
      }
      const int i = item / 96, cc = item % 96;
      const int col = cc * 64 + (tid & 63), ks = tid >> 6;
      float acc[9];
#pragma unroll
      for (int c = 0; c < 9; ++c) acc[c] = 0.f;
      const float* wp = p.in[7] + (size_t)i * 1024 * 6144 + col;
      for (int d = ks * 256; d < ks * 256 + 256; ++d) {
        float wv = wp[(size_t)d * 6144];
#pragma unroll
        for (int c = 0; c < 9; ++c) acc[c] += sc[c * 1024 + d] * wv;
      }
#pragma unroll
      for (int c = 0; c < 9; ++c) red[(ks * 9 + c) * 64 + (tid & 63)] = acc[c];
      __syncthreads();
      for (int o = tid; o < 576; o += NTHREADS) {
        int c = o >> 6, cl = o & 63;
        float s = red[(0 * 9 + c) * 64 + cl] + red[(1 * 9 + c) * 64 + cl] + red[(2 * 9 + c) * 64 + cl] + red[(3 * 9 + c) * 64 + cl];
        int n = cc * 64 + cl;
        p.mod[((size_t)i * 9 + c) * 6144 + n] = s + p.in[8][i * 6144 + n];
      }
      __syncthreads();
    }
  }
}

DEVINL void phase_r1(const Params& p, int layer, int w, int nw) {
  const int j = layer >> 1;
  const int lane = tidx() & 63;
  const int gw = w * 4 + (tidx() >> 6), ngw = nw * 4;
  bf16_t* A6 = reinterpret_cast<bf16_t*>(p.U1);
  const float* mu = p.in[11] + (size_t)j * 6 * 1024;
  for (int row = gw; row < TT; row += ngw) {
    int t, Tlen;
    if (row < TCTX) { t = row & 255; Tlen = 256; } else { t = (row - TCTX) & 1023; Tlen = 1024; }
    const int cond = cond_of_row(row);
    const float* sh = p.mod + ((size_t)layer * 9 + cond) * 6144;
    const float* sc = sh + 1024;
    const bool hasp = t > 0, hasn = t < Tlen - 1;
#pragma unroll
    for (int k = 0; k < 4; ++k) {
      const int col = k * 256 + lane * 4;
      const float4 xc = *reinterpret_cast<const float4*>(p.xbuf + (size_t)row * DM + col);
      float4 xp = make_float4(0, 0, 0, 0), xn = make_float4(0, 0, 0, 0);
      if (hasp) xp = *reinterpret_cast<const float4*>(p.xbuf + (size_t)(row - 1) * DM + col);
      if (hasn) xn = *reinterpret_cast<const float4*>(p.xbuf + (size_t)(row + 1) * DM + col);
      const float4 s4 = *reinterpret_cast<const float4*>(sh + col);
      const float4 c4 = *reinterpret_cast<const float4*>(sc + col);
      float h[4], xx[4];
      const float xcv[4] = {xc.x, xc.y, xc.z, xc.w}, xpv[4] = {xp.x, xp.y, xp.z, xp.w}, xnv[4] = {xn.x, xn.y, xn.z, xn.w};
      const float shv[4] = {s4.x, s4.y, s4.z, s4.w}, scv[4] = {c4.x, c4.y, c4.z, c4.w};
#pragma unroll
      for (int e = 0; e < 4; ++e) {
        float g = 1.0f + scv[e];
        h[e] = xcv[e] * g + shv[e];
        float hp = hasp ? (xpv[e] * g + shv[e]) : 0.f;
        float hn = hasn ? (xnv[e] * g + shv[e]) : 0.f;
        xx[e] = 0.5f * (hp + hn) - h[e];
      }
#pragma unroll
      for (int m = 0; m < 6; ++m) {
        const float4 m4 = *reinterpret_cast<const float4*>(mu + m * 1024 + col);
        uint2 o;
        o.x = pack2(h[0] + xx[0] * m4.x, h[1] + xx[1] * m4.y);
        o.y = pack2(h[2] + xx[2] * m4.z, h[3] + xx[3] * m4.w);
        *reinterpret_cast<uint2*>(A6 + ((size_t)m * TT + row) * DM + col) = o;
      }
    }
  }
}

#define U1_AA_OFF ((size_t)2 * TT * DM * 4)
#define U1_GG_OFF (U1_AA_OFF + (size_t)2 * TT * DM * 2)

DEVINL void phase_r2(const Params& p, int layer, int w, int nw, char* smem) {
  const int j = layer >> 1;
  GEMM_LANE_VARS
  const bf16_t* A6 = reinterpret_cast<const bf16_t*>(p.U1);
  bf16_t* rb = reinterpret_cast<bf16_t*>(p.U2);
  bf16_t* kb = rb + (size_t)TT * DM;
  bf16_t* vb = kb + (size_t)TT * DM;
  bf16_t* kkb = vb + (size_t)TT * DM;
  bf16_t* lw = p.abuf;
  bf16_t* la = lw + (size_t)TT * 128;
  bf16_t* lg = la + (size_t)TT * 128;
  const bf16_t* Wt = p.rwkv_in_t + (size_t)j * 3456 * 1024;
  const float* k_k = p.in[22] + j * 1024;
  for (int tile = w; tile < 96 * 27; tile += nw) {
    const int ct = tile / 96, rt = tile % 96;
    const int mA = ct < 8 ? 0 : ct < 16 ? 2 : ct < 24 ? 3 : ct == 24 ? 1 : ct == 25 ? 4 : 5;
    const int row0 = rt * 128;
    f32x4 acc[4][4];
    gemm_tile_128(A6 + ((size_t)mA * TT + row0) * DM, DM, Wt + (size_t)ct * 128 * 1024, DM, 1024, smem, acc);
    if (ct < 8 || (ct >= 16 && ct < 24)) {
      bf16_t* dst = ct < 8 ? rb : vb;
      const int cbase = (ct & 7) * 128 + wc * 64;
#pragma unroll
      for (int m = 0; m < 4; ++m)
#pragma unroll
        for (int n = 0; n < 4; ++n)
#pragma unroll
          for (int jj = 0; jj < 4; ++jj) {
            int row = row0 + wr * 64 + m * 16 + fq * 4 + jj;
            dst[(size_t)row * DM + cbase + n * 16 + fr] = f2bf(acc[m][n][jj]);
          }
    } else if (ct < 16) {
      const int cbase = (ct - 8) * 128 + wc * 64;
      float kkw[4];
#pragma unroll
      for (int n = 0; n < 4; ++n) kkw[n] = k_k[cbase + n * 16 + fr];
#pragma unroll
      for (int m = 0; m < 4; ++m)
#pragma unroll
        for (int jj = 0; jj < 4; ++jj) {
          asm volatile("" ::: "memory");
          int row = row0 + wr * 64 + m * 16 + fq * 4 + jj;
          float kv[4], ss = 0.f;
#pragma unroll
          for (int n = 0; n < 4; ++n) { kv[n] = acc[m][n][jj] * kkw[n]; ss += kv[n] * kv[n]; }
          ss = grp16_sum(ss);
          float inv = 1.0f / fmaxf(sqrtf(ss), 1e-12f);
#pragma unroll
          for (int n = 0; n < 4; ++n) {
            kb[(size_t)row * DM + cbase + n * 16 + fr] = f2bf(acc[m][n][jj]);
            kkb[(size_t)row * DM + cbase + n * 16 + fr] = f2bf(kv[n] * inv);
          }
        }
    } else {
      bf16_t* dst = ct == 24 ? lw : ct == 25 ? la : lg;
#pragma unroll
      for (int m = 0; m < 4; ++m)
#pragma unroll
        for (int n = 0; n < 4; ++n)
#pragma unroll
          for (int jj = 0; jj < 4; ++jj) {
            int row = row0 + wr * 64 + m * 16 + fq * 4 + jj;
            float v = acc[m][n][jj];
            if (ct == 24) v = tanhf_(v); else if (ct == 26) v = sigmoidf_(v);
            dst[(size_t)row * 128 + wc * 64 + n * 16 + fr] = f2bf(v);
          }
    }
  }
}

DEVINL void phase_r3(const Params& p, int layer, int w, int nw, char* smem) {
  const int j = layer >> 1;
  GEMM_LANE_VARS
  const bf16_t* lw = p.abuf;
  const bf16_t* la = lw + (size_t)TT * 128;
  const bf16_t* lg = la + (size_t)TT * 128;
  float* wdec = reinterpret_cast<float*>(p.U1);
  bf16_t* aa = reinterpret_cast<bf16_t*>(p.U1 + U1_AA_OFF);
  bf16_t* gg = reinterpret_cast<bf16_t*>(p.U1 + U1_GG_OFF);
  for (int tile = w; tile < 96 * 40; tile += nw) {
    const int ct = tile / 96, rt = tile % 96;
    const int job = ct >> 3, nt = ct & 7;
    const int row0 = rt * 128, col0 = nt * 128;
    f32x4 acc[4][4];
    if (job < 2) {
      const int z = job;
      gemm_tile_128(lw + (size_t)row0 * 128 + z * 64, 128, p.w2t + (size_t)(j * 2 + z) * 65536 + (size_t)col0 * 64, 64, 64, smem, acc);
      const float* w0 = p.in[14] + (size_t)(j * 2 + z) * 1024;
#pragma unroll
      for (int m = 0; m < 4; ++m)
#pragma unroll
        for (int n = 0; n < 4; ++n)
#pragma unroll
          for (int jj = 0; jj < 4; ++jj) {
            int row = row0 + wr * 64 + m * 16 + fq * 4 + jj, col = col0 + wc * 64 + n * 16 + fr;
            float wl = acc[m][n][jj] + w0[col];
            wdec[((size_t)z * TT + row) * DM + col] = __expf(-0.6065306597126334f * sigmoidf_(wl));
          }
    } else if (job < 4) {
      const int z = job - 2;
      gemm_tile_128(la + (size_t)row0 * 128 + z * 64, 128, p.a2t + (size_t)(j * 2 + z) * 65536 + (size_t)col0 * 64, 64, 64, smem, acc);
      const float* a0 = p.in[17] + (size_t)(j * 2 + z) * 1024;
#pragma unroll
      for (int m = 0; m < 4; ++m)
#pragma unroll
        for (int n = 0; n < 4; ++n)
#pragma unroll
          for (int jj = 0; jj < 4; ++jj) {
            int row = row0 + wr * 64 + m * 16 + fq * 4 + jj, col = col0 + wc * 64 + n * 16 + fr;
            aa[((size_t)z * TT + row) * DM + col] = f2bf(sigmoidf_(acc[m][n][jj] + a0[col]));
          }
    } else {
      gemm_tile_128(lg + (size_t)row0 * 128, 128, p.g2t + (size_t)j * 131072 + (size_t)col0 * 128, 128, 128, smem, acc);
#pragma unroll
      for (int m = 0; m < 4; ++m)
#pragma unroll
        for (int n = 0; n < 4; ++n)
#pragma unroll
          for (int jj = 0; jj < 4; ++jj) {
            int row = row0 + wr * 64 + m * 16 + fq * 4 + jj, col = col0 + wc * 64 + n * 16 + fr;
            gg[(size_t)row * DM + col] = f2bf(acc[m][n][jj]);
          }
    }
  }
}

DEVINL void phase_r4(const Params& p, int layer, int w, int nw, char* smem) {
  const int j = layer >> 1;
  const int lane = tidx() & 63, wid = tidx() >> 6;
  const bf16_t* rb = reinterpret_cast<const bf16_t*>(p.U2);
  const bf16_t* kb = rb + (size_t)TT * DM;
  const bf16_t* vb = kb + (size_t)TT * DM;
  const bf16_t* kkb = vb + (size_t)TT * DM;
  const float* wdec = reinterpret_cast<const float*>(p.U1);
  const bf16_t* aa = reinterpret_cast<const bf16_t*>(p.U1 + U1_AA_OFF);
  float* yout = reinterpret_cast<float*>(p.U3);
  float* lds = reinterpret_cast<float*>(smem) + wid * (8 * 5 * 64);
  for (int c = w + nw * wid; c < 768; c += nw * 4) {
    int seq, h, z;
    if (c < 256) { seq = 16 + (c >> 5); h = (c >> 1) & 15; z = c & 1; }
    else { int cc = c - 256; seq = cc >> 5; h = (cc >> 1) & 15; z = cc & 1; }
    const int Tlen = seq < 16 ? 256 : 1024;
    const int base = seq < 16 ? seq * 256 : TCTX + (seq - 16) * 1024;
    const int colb = h * 64;
    const float kal = p.in[23][j * 1024 + colb + lane];
    float S[64];
    if (seq >= 16) {
      const float* s0 = p.in[3] + ((((size_t)(seq - 16) * 2 + j) * 2 + z) * 16 + h) * 4096 + (size_t)lane * 64;
#pragma unroll
      for (int q = 0; q < 16; ++q) {
        float4 v = reinterpret_cast<const float4*>(s0)[q];
        S[q * 4] = v.x; S[q * 4 + 1] = v.y; S[q * 4 + 2] = v.z; S[q * 4 + 3] = v.w;
      }
    } else {
#pragma unroll
      for (int q = 0; q < 64; ++q) S[q] = 0.f;
    }
    for (int t0 = 0; t0 < Tlen; t0 += 8) {
      float vreg[8];
      __builtin_amdgcn_wave_barrier();
#pragma unroll
      for (int tt = 0; tt < 8; ++tt) {
        const int t = t0 + tt;
        const int row = base + (z == 0 ? t : (Tlen - 1 - t));
        const size_t o = (size_t)row * DM + colb + lane;
        float r = bf2f(rb[o]), k = bf2f(kb[o]), kk = bf2f(kkb[o]);
        vreg[tt] = bf2f(vb[o]);
        float a = bf2f(aa[(size_t)z * TT * DM + o]);
        float wd = wdec[(size_t)z * TT * DM + o];
        float* l = lds + tt * 320;
        l[lane] = r; l[64 + lane] = wd; l[128 + lane] = k * (1.0f + (a - 1.0f) * kal); l[192 + lane] = kk; l[256 + lane] = kk * a;
      }
      __builtin_amdgcn_wave_barrier();
#pragma unroll 1
      for (int tt = 0; tt < 8; ++tt) {
        const float* l = lds + tt * 320;
        const float vi = vreg[0];
        float skk = 0.f;
#pragma unroll
        for (int q = 0; q < 16; ++q) {
          float4 kk4 = reinterpret_cast<const float4*>(l + 192)[q];
          skk += S[q * 4] * kk4.x + S[q * 4 + 1] * kk4.y + S[q * 4 + 2] * kk4.z + S[q * 4 + 3] * kk4.w;
        }
        float y = 0.f;
#pragma unroll
        for (int q = 0; q < 16; ++q) {
          float4 w4 = reinterpret_cast<const float4*>(l + 64)[q];
          float4 k4 = reinterpret_cast<const float4*>(l + 128)[q];
          float4 a4 = reinterpret_cast<const float4*>(l + 256)[q];
          float4 r4 = reinterpret_cast<const float4*>(l)[q];
          S[q * 4 + 0] = S[q * 4 + 0] * w4.x + (vi * k4.x - skk * a4.x);
          S[q * 4 + 1] = S[q * 4 + 1] * w4.y + (vi * k4.y - skk * a4.y);
          S[q * 4 + 2] = S[q * 4 + 2] * w4.z + (vi * k4.z - skk * a4.z);
          S[q * 4 + 3] = S[q * 4 + 3] * w4.w + (vi * k4.w - skk * a4.w);
          y += S[q * 4] * r4.x + S[q * 4 + 1] * r4.y + S[q * 4 + 2] * r4.z + S[q * 4 + 3] * r4.w;
        }
        const int t = t0 + tt;
        const int row = base + (z == 0 ? t : (Tlen - 1 - t));
        yout[((size_t)z * TT + row) * DM + colb + lane] = y;
#pragma unroll
        for (int q = 0; q < 7; ++q) vreg[q] = vreg[q + 1];
      }
    }
    if (seq < 16) {
      float* so = p.out + OUT_STATE + ((((size_t)seq * 2 + j) * 2 + z) * 16 + h) * 4096 + (size_t)lane * 64;
#pragma unroll
      for (int q = 0; q < 16; ++q) reinterpret_cast<float4*>(so)[q] = make_float4(S[q * 4], S[q * 4 + 1], S[q * 4 + 2], S[q * 4 + 3]);
    }
  }
}

DEVINL void phase_r5(const Params& p, int layer, int w, int nw) {
  const int j = layer >> 1;
  const int lane = tidx() & 63;
  const int gw = w * 4 + (tidx() >> 6), ngw = nw * 4;
  const bf16_t* rb = reinterpret_cast<const bf16_t*>(p.U2);
  const bf16_t* kb = rb + (size_t)TT * DM;
  const bf16_t* vb = kb + (size_t)TT * DM;
  const bf16_t* aa = reinterpret_cast<const bf16_t*>(p.U1 + U1_AA_OFF);
  const bf16_t* gg = reinterpret_cast<const bf16_t*>(p.U1 + U1_GG_OFF);
  const float* yin = reinterpret_cast<const float*>(p.U3);
  const float* ka = p.in[23] + j * 1024;
  const float* rk = p.in[24] + j * 1024;
  const float* lg = p.in[25] + j * 1024;
  const float* lb = p.in[26] + j * 1024;
  for (int row = gw; row < TT; row += ngw) {
#pragma unroll
    for (int k = 0; k < 4; ++k) {
      const int col = k * 256 + lane * 4;
      const size_t o = (size_t)row * DM + col;
      const float4 yf = *reinterpret_cast<const float4*>(yin + o);
      const float4 yb = *reinterpret_cast<const float4*>(yin + (size_t)TT * DM + o);
      const uint2 r2 = *reinterpret_cast<const uint2*>(rb + o);
      const uint2 k2 = *reinterpret_cast<const uint2*>(kb + o);
      const uint2 v2 = *reinterpret_cast<const uint2*>(vb + o);
      const uint2 a02 = *reinterpret_cast<const uint2*>(aa + o);
      const uint2 a12 = *reinterpret_cast<const uint2*>(aa + (size_t)TT * DM + o);
      const uint2 g2 = *reinterpret_cast<const uint2*>(gg + o);
      const float4 ka4 = *reinterpret_cast<const float4*>(ka + col);
      const float4 rk4 = *reinterpret_cast<const float4*>(rk + col);
      const float4 lg4 = *reinterpret_cast<const float4*>(lg + col);
      const float4 lb4 = *reinterpret_cast<const float4*>(lb + col);
      float y[4] = {yf.x + yb.x, yf.y + yb.y, yf.z + yb.z, yf.w + yb.w};
      float r[4] = {bflo(r2.x), bfhi(r2.x), bflo(r2.y), bfhi(r2.y)};
      float kx[4] = {bflo(k2.x), bfhi(k2.x), bflo(k2.y), bfhi(k2.y)};
      float v[4] = {bflo(v2.x), bfhi(v2.x), bflo(v2.y), bfhi(v2.y)};
      float a0[4] = {bflo(a02.x), bfhi(a02.x), bflo(a02.y), bfhi(a02.y)};
      float a1[4] = {bflo(a12.x), bfhi(a12.x), bflo(a12.y), bfhi(a12.y)};
      float g[4] = {bflo(g2.x), bfhi(g2.x), bflo(g2.y), bfhi(g2.y)};
      float kav[4] = {ka4.x, ka4.y, ka4.z, ka4.w}, rkv[4] = {rk4.x, rk4.y, rk4.z, rk4.w};
      float lgv[4] = {lg4.x, lg4.y, lg4.z, lg4.w}, lbv[4] = {lb4.x, lb4.y, lb4.z, lb4.w};
      float sm = y[0] + y[1] + y[2] + y[3];
      sm = grp16_sum(sm);
      const float mean = sm * (1.0f / 64.0f);
      float sv = 0.f, sb = 0.f;
#pragma unroll
      for (int e = 0; e < 4; ++e) {
        float d = y[e] - mean; sv += d * d;
        float kd0 = kx[e] * (1.0f + (a0[e] - 1.0f) * kav[e]);
        float kd1 = kx[e] * (1.0f + (a1[e] - 1.0f) * kav[e]);
        sb += r[e] * (kd0 + kd1) * rkv[e];
      }
      sv = grp16_sum(sv); sb = grp16_sum(sb);
      const float rstd = rsqrtf(sv * (1.0f / 64.0f) + GN_EPS_F);
      float o4[4];
#pragma unroll
      for (int e = 0; e < 4; ++e) {
        float yn = (y[e] - mean) * rstd * lgv[e] + lbv[e];
        o4[e] = (yn + sb * v[e]) * g[e];
      }
      uint2 oo; oo.x = pack2(o4[0], o4[1]); oo.y = pack2(o4[2], o4[3]);
      *reinterpret_cast<uint2*>(p.abuf + o) = oo;
    }
  }
}

DEVINL void phase_wo(const Params& p, int layer, int w, int nw, char* smem) {
  const int j = layer >> 1;
  GEMM_LANE_VARS
  const bf16_t* Wt = ((layer & 1) ? p.attn_wo_t : p.rwkv_wo_t) + ((size_t)j << 20);
  for (int tile = w; tile < 96 * 8; tile += nw) {
    const int ct = tile / 96, rt = tile % 96;
    const int row0 = rt * 128, col0 = ct * 128;
    f32x4 acc[4][4];
    gemm_tile_128(p.abuf + (size_t)row0 * DM, DM, Wt + (size_t)col0 * DM, DM, 1024, smem, acc);
    const float* gate = p.mod + ((size_t)layer * 9 + cond_of_row(row0)) * 6144 + 2 * 1024;
#pragma unroll
    for (int m = 0; m < 4; ++m)
#pragma unroll
      for (int n = 0; n < 4; ++n)
#pragma unroll
        for (int jj = 0; jj < 4; ++jj) {
          int row = row0 + wr * 64 + m * 16 + fq * 4 + jj, col = col0 + wc * 64 + n * 16 + fr;
          size_t o = (size_t)row * DM + col;
          p.zbuf[o] = ALPHA_F * p.xbuf[o] + gate[col] * acc[m][n][jj];
        }
  }
}

DEVINL void phase_ln1(const Params& p, int layer, int w, int nw) {
  const int lane = tidx() & 63;
  const int gw = w * 4 + (tidx() >> 6), ngw = nw * 4;
  const float* lng = p.in[9] + (size_t)(layer * 2 + 0) * 1024;
  const float* lnb = p.in[10] + (size_t)(layer * 2 + 0) * 1024;
  for (int row = gw; row < TT; row += ngw) {
    const float* md = p.mod + ((size_t)layer * 9 + cond_of_row(row)) * 6144;
    float4 z[4];
    float s = 0.f;
#pragma unroll
    for (int k = 0; k < 4; ++k) {
      z[k] = *reinterpret_cast<const float4*>(p.zbuf + (size_t)row * DM + k * 256 + lane * 4);
      s += z[k].x + z[k].y + z[k].z + z[k].w;
    }
    const float mean = wave_sum(s) * (1.0f / 1024.0f);
    float sv = 0.f;
#pragma unroll
    for (int k = 0; k < 4; ++k) {
      float a = z[k].x - mean, b = z[k].y - mean, c = z[k].z - mean, d = z[k].w - mean;
      sv += a * a + b * b + c * c + d * d;
    }
    const float rstd = rsqrtf(wave_sum(sv) * (1.0f / 1024.0f) + LN_EPS_F);
#pragma unroll
    for (int k = 0; k < 4; ++k) {
      const int col = k * 256 + lane * 4;
      const float4 g4 = *reinterpret_cast<const float4*>(lng + col);
      const float4 b4 = *reinterpret_cast<const float4*>(lnb + col);
      const float4 sh = *reinterpret_cast<const float4*>(md + 3 * 1024 + col);
      const float4 sc = *reinterpret_cast<const float4*>(md + 4 * 1024 + col);
      float4 x1;
      x1.x = (z[k].x - mean) * rstd * g4.x + b4.x;
      x1.y = (z[k].y - mean) * rstd * g4.y + b4.y;
      x1.z = (z[k].z - mean) * rstd * g4.z + b4.z;
      x1.w = (z[k].w - mean) * rstd * g4.w + b4.w;
      *reinterpret_cast<float4*>(p.xbuf + (size_t)row * DM + col) = x1;
      uint2 o;
      o.x = pack2(x1.x * (1.0f + sc.x) + sh.x, x1.y * (1.0f + sc.y) + sh.y);
      o.y = pack2(x1.z * (1.0f + sc.z) + sh.z, x1.w * (1.0f + sc.w) + sh.w);
      *reinterpret_cast<uint2*>(p.hbuf + (size_t)row * DM + col) = o;
    }
  }
}

DEVINL void phase_p1(const Params& p, int layer, int w, int nw, char* smem) {
  GEMM_LANE_VARS
  bf16_t* qb = reinterpret_cast<bf16_t*>(p.U1);
  const bf16_t* Wt = p.wq_t + (size_t)layer * 2048 * 1024;
  for (int tile = w; tile < 96 * 16; tile += nw) {
    const int ct = tile / 96, rt = tile % 96;
    const int row0 = rt * 128, col0 = ct * 128;
    f32x4 acc[4][4];
    gemm_tile_128(p.hbuf + (size_t)row0 * DM, DM, Wt + (size_t)col0 * DM, DM, 1024, smem, acc);
#pragma unroll
    for (int m = 0; m < 4; ++m)
#pragma unroll
      for (int n = 0; n < 4; ++n)
#pragma unroll
        for (int jj = 0; jj < 4; ++jj) {
          int row = row0 + wr * 64 + m * 16 + fq * 4 + jj, col = col0 + wc * 64 + n * 16 + fr;
          qb[(size_t)row * 2048 + col] = f2bf(acc[m][n][jj]);
        }
  }
}

#define U1_S_OFF ((size_t)TT * 2048 * 2)
DEVINL void phase_p2(const Params& p, int layer, int w, int nw, char* smem) {
  GEMM_LANE_VARS
  const bf16_t* qb = reinterpret_cast<const bf16_t*>(p.U1);
  float* sb = reinterpret_cast<float*>(p.U1 + U1_S_OFF);
  for (int tile = w; tile < 96 * 16; tile += nw) {
    const int ct = tile / 96, rt = tile % 96;
    const int row0 = rt * 128;
    const int z = ct & 1;
    f32x4 acc[4][4];
    gemm_tile_128(qb + (size_t)row0 * 2048 + ct * 128, 2048, p.keysb + (size_t)(layer * 2 + z) * 16384, 128, 128, smem, acc);
#pragma unroll
    for (int m = 0; m < 4; ++m)
#pragma unroll
      for (int n = 0; n < 4; ++n)
#pragma unroll
        for (int jj = 0; jj < 4; ++jj) {
          int row = row0 + wr * 64 + m * 16 + fq * 4 + jj, col = wc * 64 + n * 16 + fr;
          sb[(size_t)row * 2048 + ct * 128 + col] = acc[m][n][jj];
        }
  }
}

DEVINL void phase_p3(const Params& p, int layer, int w, int nw, char* smem) {
  const int lane = tidx() & 63, wid = tidx() >> 6;
  const int gw = w * 4 + wid, ngw = nw * 4;
  const float* sb = reinterpret_cast<const float*>(p.U1 + U1_S_OFF);
  float* svl = reinterpret_cast<float*>(smem) + wid * 64;
  int* sil = reinterpret_cast<int*>(smem) + 256 + wid * 64;
  for (int t = gw; t < TT; t += ngw) {
    for (int h = 0; h < 8; ++h) {
      __builtin_amdgcn_wave_barrier();
#pragma unroll 1
      for (int z = 0; z < 2; ++z) {
        const float* sp = sb + (size_t)t * 2048 + (h * 2 + z) * 128;
        const float s0 = sp[lane], s1 = sp[lane + 64];
        unsigned k0 = (ordf(s0) & ~127u) | (unsigned)(127 - lane);
        unsigned k1 = (ordf(s1) & ~127u) | (unsigned)(63 - lane);
        int myidx = 0;
#pragma unroll 1
        for (int it = 0; it < 16; ++it) {
          unsigned m = wave_max_u(k0 > k1 ? k0 : k1);
          int idx = 127 - (int)(m & 127u);
          if (lane == it) myidx = idx;
          if (k0 == m) k0 = 0;
          if (k1 == m) k1 = 0;
        }
        if (lane < 16) { svl[z * 16 + lane] = sp[myidx]; sil[z * 16 + lane] = myidx; }
      }
      __builtin_amdgcn_wave_barrier();
      unsigned kc[4];
#pragma unroll
      for (int c = 0; c < 4; ++c) {
        int ci = lane * 4 + c;
        float sum = svl[ci >> 4] + svl[16 + (ci & 15)];
        kc[c] = (ordf(sum) & ~255u) | (unsigned)(255 - ci);
      }
      int myci = 0;
#pragma unroll 1
      for (int it = 0; it < 16; ++it) {
        unsigned a = kc[0] > kc[1] ? kc[0] : kc[1], b = kc[2] > kc[3] ? kc[2] : kc[3];
        unsigned m = wave_max_u(a > b ? a : b);
        int ci = 255 - (int)(m & 255u);
        if (lane == it) myci = ci;
#pragma unroll
        for (int c = 0; c < 4; ++c) if (kc[c] == m) kc[c] = 0;
      }
      const int ii = (myci >> 4) & 15, jj = myci & 15;
      float cv = svl[ii] + svl[16 + jj];
      int e = sil[ii] * 128 + sil[16 + jj];
      float mx = cv;
#pragma unroll
      for (int o = 8; o > 0; o >>= 1) mx = fmaxf(mx, __shfl_xor(mx, o));
      float ex = __expf(cv - mx);
      float sm = grp16_sum(ex);
      if (lane < 16) {
        p.pidx[(size_t)t * 128 + h * 16 + lane] = e;
        p.pgate[(size_t)t * 128 + h * 16 + lane] = ex / sm;
      }
    }
  }
}

DEVINL float gelu_exact(float x) { return 0.5f * x * (1.0f + erff(x * 0.7071067811865476f)); }

DEVINL void phase_p4(const Params& p, int layer, int w, int nw) {
  const int lane = tidx() & 63;
  const int gw = w * 4 + (tidx() >> 6), ngw = nw * 4;
  const bf16_t* U = p.ub + (size_t)layer * 16384 * 1024;
  const bf16_t* V = p.vb + (size_t)layer * 16384 * 1024;
  const float* lng = p.in[9] + (size_t)(layer * 2 + 1) * 1024;
  const float* lnb = p.in[10] + (size_t)(layer * 2 + 1) * 1024;
  float* xout = (layer == 3) ? p.out : p.xbuf;
  for (int t = gw; t < TT; t += ngw) {
    float x[16], f[16];
    {
      const uint4 a = *reinterpret_cast<const uint4*>(p.hbuf + (size_t)t * DM + lane * 8);
      const uint4 b = *reinterpret_cast<const uint4*>(p.hbuf + (size_t)t * DM + 512 + lane * 8);
      x[0] = bflo(a.x); x[1] = bfhi(a.x); x[2] = bflo(a.y); x[3] = bfhi(a.y); x[4] = bflo(a.z); x[5] = bfhi(a.z); x[6] = bflo(a.w); x[7] = bfhi(a.w);
      x[8] = bflo(b.x); x[9] = bfhi(b.x); x[10] = bflo(b.y); x[11] = bfhi(b.y); x[12] = bflo(b.z); x[13] = bfhi(b.z); x[14] = bflo(b.w); x[15] = bfhi(b.w);
    }
#pragma unroll
    for (int e = 0; e < 16; ++e) f[e] = 0.f;
    const int myidx0 = p.pidx[(size_t)t * 128 + lane], myidx1 = p.pidx[(size_t)t * 128 + 64 + lane];
    const float myg0 = p.pgate[(size_t)t * 128 + lane], myg1 = p.pgate[(size_t)t * 128 + 64 + lane];
#pragma unroll 4
    for (int e = 0; e < 128; ++e) {
      const int idx = __shfl(e < 64 ? myidx0 : myidx1, e & 63);
      const float gt = __shfl(e < 64 ? myg0 : myg1, e & 63);
      const bf16_t* up = U + (size_t)idx * DM;
      const uint4 a = *reinterpret_cast<const uint4*>(up + lane * 8);
      const uint4 b = *reinterpret_cast<const uint4*>(up + 512 + lane * 8);
      float d = x[0] * bflo(a.x) + x[1] * bfhi(a.x) + x[2] * bflo(a.y) + x[3] * bfhi(a.y) + x[4] * bflo(a.z) + x[5] * bfhi(a.z) + x[6] * bflo(a.w) + x[7] * bfhi(a.w)
              + x[8] * bflo(b.x) + x[9] * bfhi(b.x) + x[10] * bflo(b.y) + x[11] * bfhi(b.y) + x[12] * bflo(b.z) + x[13] * bfhi(b.z) + x[14] * bflo(b.w) + x[15] * bfhi(b.w);
      d = wave_sum(d);
      const float wgt = gt * gelu_exact(d);
      const bf16_t* vp = V + (size_t)idx * DM;
      const uint4 c = *reinterpret_cast<const uint4*>(vp + lane * 8);
      const uint4 dd = *reinterpret_cast<const uint4*>(vp + 512 + lane * 8);
      f[0] += wgt * bflo(c.x); f[1] += wgt * bfhi(c.x); f[2] += wgt * bflo(c.y); f[3] += wgt * bfhi(c.y);
      f[4] += wgt * bflo(c.z); f[5] += wgt * bfhi(c.z); f[6] += wgt * bflo(c.w); f[7] += wgt * bfhi(c.w);
      f[8] += wgt * bflo(dd.x); f[9] += wgt * bfhi(dd.x); f[10] += wgt * bflo(dd.y); f[11] += wgt * bfhi(dd.y);
      f[12] += wgt * bflo(dd.z); f[13] += wgt * bfhi(dd.z); f[14] += wgt * bflo(dd.w); f[15] += wgt * bfhi(dd.w);
    }
    const float* md = p.mod + ((size_t)layer * 9 + cond_of_row(t)) * 6144 + 5 * 1024;
    float zz[16];
    float s = 0.f;
#pragma unroll
    for (int hf = 0; hf < 2; ++hf) {
      const int col = hf * 512 + lane * 8;
      const float4 x0 = *reinterpret_cast<const float4*>(p.xbuf + (size_t)t * DM + col);
      const float4 x1 = *reinterpret_cast<const float4*>(p.xbuf + (size_t)t * DM + col + 4);
      const float4 g0 = *reinterpret_cast<const float4*>(md + col);
      const float4 g1 = *reinterpret_cast<const float4*>(md + col + 4);
      const float xv[8] = {x0.x, x0.y, x0.z, x0.w, x1.x, x1.y, x1.z, x1.w};
      const float gv[8] = {g0.x, g0.y, g0.z, g0.w, g1.x, g1.y, g1.z, g1.w};
#pragma unroll
      for (int e = 0; e < 8; ++e) { zz[hf * 8 + e] = ALPHA_F * xv[e] + gv[e] * f[hf * 8 + e]; s += zz[hf * 8 + e]; }
    }
    const float mean = wave_sum(s) * (1.0f / 1024.0f);
    float sv = 0.f;
#pragma unroll
    for (int e = 0; e < 16; ++e) { float d = zz[e] - mean; sv += d * d; }
    const float rstd = rsqrtf(wave_sum(sv) * (1.0f / 1024.0f) + LN_EPS_F);
#pragma unroll
    for (int hf = 0; hf < 2; ++hf) {
      const int col = hf * 512 + lane * 8;
      const float4 g0 = *reinterpret_cast<const float4*>(lng + col);
      const float4 g1 = *reinterpret_cast<const float4*>(lng + col + 4);
      const float4 b0 = *reinterpret_cast<const float4*>(lnb + col);
      const float4 b1 = *reinterpret_cast<const float4*>(lnb + col + 4);
      float4 o0, o1;
      o0.x = (zz[hf * 8 + 0] - mean) * rstd * g0.x + b0.x;
      o0.y = (zz[hf * 8 + 1] - mean) * rstd * g0.y + b0.y;
      o0.z = (zz[hf * 8 + 2] - mean) * rstd * g0.z + b0.z;
      o0.w = (zz[hf * 8 + 3] - mean) * rstd * g0.w + b0.w;
      o1.x = (zz[hf * 8 + 4] - mean) * rstd * g1.x + b1.x;
      o1.y = (zz[hf * 8 + 5] - mean) * rstd * g1.y + b1.y;
      o1.z = (zz[hf * 8 + 6] - mean) * rstd * g1.z + b1.z;
      o1.w = (zz[hf * 8 + 7] - mean) * rstd * g1.w + b1.w;
      *reinterpret_cast<float4*>(xout + (size_t)t * DM + col) = o0;
      *reinterpret_cast<float4*>(xout + (size_t)t * DM + col + 4) = o1;
    }
  }
}

DEVINL void phase_a1(const Params& p, int layer, int w, int nw) {
  const int lane = tidx() & 63;
  const int gw = w * 4 + (tidx() >> 6), ngw = nw * 4;
  for (int row = gw; row < TT; row += ngw) {
    const float* md = p.mod + ((size_t)layer * 9 + cond_of_row(row)) * 6144;
#pragma unroll
    for (int k = 0; k < 4; ++k) {
      const int col = k * 256 + lane * 4;
      const float4 x = *reinterpret_cast<const float4*>(p.xbuf + (size_t)row * DM + col);
      const float4 sh = *reinterpret_cast<const float4*>(md + col);
      const float4 sc = *reinterpret_cast<const float4*>(md + 1024 + col);
      uint2 o;
      o.x = pack2(x.x * (1.0f + sc.x) + sh.x, x.y * (1.0f + sc.y) + sh.y);
      o.y = pack2(x.z * (1.0f + sc.z) + sh.z, x.w * (1.0f + sc.w) + sh.w);
      *reinterpret_cast<uint2*>(p.hbuf + (size_t)row * DM + col) = o;
    }
  }
}

DEVINL void phase_a2(const Params& p, int layer, int w, int nw, char* smem) {
  const int j = layer >> 1;
  GEMM_LANE_VARS
  bf16_t* qb = reinterpret_cast<bf16_t*>(p.U2);
  const bf16_t* Wt = p.attn_wqkv_t + (size_t)j * 1536 * 1024;
  const float* qn = p.in[29] + j * 64;
  const float* kn = p.in[30] + j * 64;
  for (int tile = w; tile < 96 * 12; tile += nw) {
    const int ct = tile / 96, rt = tile % 96;
    const int row0 = rt * 128;
    const bool lat = row0 >= TCTX;
    f32x4 acc[4][4];
    gemm_tile_128(p.hbuf + (size_t)row0 * DM, DM, Wt + (size_t)ct * 128 * DM, DM, 1024, smem, acc);
    if (ct < 10) {
      const bool isq = ct < 8;
      const int head = isq ? (ct * 2 + wc) : ((ct - 8) * 2 + wc);
      const float* nw_ = isq ? qn : kn;
      float nv[4];
#pragma unroll
      for (int n = 0; n < 4; ++n) nv[n] = nw_[n * 16 + fr];
#pragma unroll
      for (int m = 0; m < 4; ++m)
#pragma unroll
        for (int jj = 0; jj < 4; ++jj) {
          asm volatile("" ::: "memory");
          const int row = row0 + wr * 64 + m * 16 + fq * 4 + jj;
          float v[4], ss = 0.f;
#pragma unroll
          for (int n = 0; n < 4; ++n) { v[n] = acc[m][n][jj]; ss += v[n] * v[n]; }
          ss = grp16_sum(ss);
          const float rinv = rsqrtf(ss * (1.0f / 64.0f) + RMS_EPS_F);
#pragma unroll
          for (int n = 0; n < 4; ++n) v[n] = v[n] * rinv * nv[n];
          if (lat) {
            const int t = (row - TCTX) & 1023, b = (row - TCTX) >> 10;
            const int pr = t >> 6, pc = t & 63;
            const float c0 = p.rope[(pr * 16 + fr) * 2], s0 = p.rope[(pr * 16 + fr) * 2 + 1];
            const float c1 = p.rope[(pc * 16 + fr) * 2], s1 = p.rope[(pc * 16 + fr) * 2 + 1];
            const float o0 = v[0] * c0 - v[1] * s0, o1 = v[1] * c0 + v[0] * s0;
            const float o2 = v[2] * c1 - v[3] * s1, o3 = v[3] * c1 + v[2] * s1;
            v[0] = o0; v[1] = o1; v[2] = o2; v[3] = o3;
            if (isq) {
#pragma unroll
              for (int n = 0; n < 4; ++n) qb[(size_t)row * DM + head * 64 + n * 16 + fr] = f2bf(v[n] * QSCALE_F);
            } else {
              bf16_t* kd = p.Klat + ((size_t)((j * 8 + b) * 4 + head) * 1536 + 512 + t) * 64;
#pragma unroll
              for (int n = 0; n < 4; ++n) kd[n * 16 + fr] = f2bf(v[n]);
            }
          } else {
            const int t = row & 255, b = row >> 8;
            if (isq) {
#pragma unroll
              for (int n = 0; n < 4; ++n) qb[(size_t)row * DM + head * 64 + n * 16 + fr] = f2bf(v[n] * QSCALE_F);
            } else {
              bf16_t* kd = p.Kctx + ((size_t)((j * 16 + b) * 4 + head) * 256 + t) * 64;
              float* ko = p.out + OUT_CK + ((size_t)(b * 2 + j) * 256 + t) * 256 + head * 64;
#pragma unroll
              for (int n = 0; n < 4; ++n) { kd[n * 16 + fr] = f2bf(v[n]); ko[n * 16 + fr] = v[n]; }
            }
          }
        }
    } else {
      const int head = (ct - 10) * 2 + wc;
#pragma unroll
      for (int m = 0; m < 4; ++m)
#pragma unroll
        for (int jj = 0; jj < 4; ++jj) {
          asm volatile("" ::: "memory");
          const int row = row0 + wr * 64 + m * 16 + fq * 4 + jj;
          if (lat) {
            const int t = (row - TCTX) & 1023, b = (row - TCTX) >> 10;
            bf16_t* vd = p.VlatT + (size_t)((j * 8 + b) * 4 + head) * 64 * 1536 + 512 + t;
#pragma unroll
            for (int n = 0; n < 4; ++n) vd[(size_t)(n * 16 + fr) * 1536] = f2bf(acc[m][n][jj]);
          } else {
            const int t = row & 255, b = row >> 8;
            bf16_t* vd = p.VctxT + (size_t)((j * 16 + b) * 4 + head) * 64 * 256 + t;
            float* vo = p.out + OUT_CV + ((size_t)(b * 2 + j) * 256 + t) * 256 + head * 64;
#pragma unroll
            for (int n = 0; n < 4; ++n) { vd[(size_t)(n * 16 + fr) * 256] = f2bf(acc[m][n][jj]); vo[n * 16 + fr] = acc[m][n][jj]; }
          }
        }
    }
  }
}

DEVINL void phase_a3(const Params& p, int layer, int w, int nw) {
  const int j = layer >> 1;
  const int lane = tidx() & 63, wid = tidx() >> 6;
  const int ql = lane & 31, hh = lane >> 5;
  const bf16_t* qb = reinterpret_cast<const bf16_t*>(p.U2);
  for (int item = w; item < 1536; item += nw) {
    int hq, Tk, row0;
    const bf16_t *Kb, *Vt;
    if (item < 1024) {
      const int b = item >> 7, qblk = item & 7;
      hq = (item >> 3) & 15;
      const int kvh = hq >> 2;
      Kb = p.Klat + (size_t)((j * 8 + b) * 4 + kvh) * 1536 * 64;
      Vt = p.VlatT + (size_t)((j * 8 + b) * 4 + kvh) * 64 * 1536;
      Tk = 1536; row0 = TCTX + b * 1024 + qblk * 128;
    } else {
      const int it = item - 1024;
      const int b = it >> 5, qblk = it & 1;
      hq = (it >> 1) & 15;
      const int kvh = hq >> 2;
      Kb = p.Kctx + (size_t)((j * 16 + b) * 4 + kvh) * 256 * 64;
      Vt = p.VctxT + (size_t)((j * 16 + b) * 4 + kvh) * 64 * 256;
      Tk = 256; row0 = b * 256 + qblk * 128;
    }
    const int qrow = row0 + wid * 32 + ql;
    bf16x8 bq[4];
#pragma unroll
    for (int ks = 0; ks < 4; ++ks) bq[ks] = *reinterpret_cast<const bf16x8*>(qb + (size_t)qrow * DM + hq * 64 + ks * 16 + hh * 8);
    f32x16 o0, o1;
#pragma unroll
    for (int r = 0; r < 16; ++r) { o0[r] = 0.f; o1[r] = 0.f; }
    float mrun = -1e30f, lrun = 0.f;
    for (int kt = 0; kt < Tk; kt += 32) {
      f32x16 sacc;
#pragma unroll
      for (int r = 0; r < 16; ++r) sacc[r] = 0.f;
#pragma unroll
      for (int ks = 0; ks < 4; ++ks) {
        bf16x8 ka = *reinterpret_cast<const bf16x8*>(Kb + (size_t)(kt + ql) * 64 + ks * 16 + hh * 8);
        sacc = __builtin_amdgcn_mfma_f32_32x32x16_bf16(ka, bq[ks], sacc, 0, 0, 0);
      }
      float tmax = sacc[0];
#pragma unroll
      for (int r = 1; r < 16; ++r) tmax = fmaxf(tmax, sacc[r]);
      tmax = fmaxf(tmax, __shfl_xor(tmax, 32));
      const float mnew = fmaxf(mrun, tmax);
      const float corr = exp2f(mrun - mnew);
      mrun = mnew;
      lrun *= corr;
#pragma unroll
      for (int r = 0; r < 16; ++r) { o0[r] *= corr; o1[r] *= corr; }
      float pv[16];
#pragma unroll
      for (int r = 0; r < 16; ++r) { pv[r] = exp2f(sacc[r] - mnew); lrun += pv[r]; }
#pragma unroll
      for (int s2 = 0; s2 < 2; ++s2) {
        union { bf16x8 v; unsigned u[4]; } pb;
#pragma unroll
        for (int q = 0; q < 4; ++q) pb.u[q] = pack2(pv[s2 * 8 + q * 2], pv[s2 * 8 + q * 2 + 1]);
#pragma unroll
        for (int dblk = 0; dblk < 2; ++dblk) {
          const bf16_t* vp = Vt + (size_t)(dblk * 32 + ql) * Tk + kt + 16 * s2 + 4 * hh;
          const uint2 lo = *reinterpret_cast<const uint2*>(vp);
          const uint2 hi = *reinterpret_cast<const uint2*>(vp + 8);
          union { bf16x8 v; unsigned u[4]; } va;
          va.u[0] = lo.x; va.u[1] = lo.y; va.u[2] = hi.x; va.u[3] = hi.y;
          if (dblk == 0) o0 = __builtin_amdgcn_mfma_f32_32x32x16_bf16(va.v, pb.v, o0, 0, 0, 0);
          else o1 = __builtin_amdgcn_mfma_f32_32x32x16_bf16(va.v, pb.v, o1, 0, 0, 0);
        }
      }
    }
    const float ltot = lrun + __shfl_xor(lrun, 32);
    const float inv = 1.0f / ltot;
#pragma unroll
    for (int g = 0; g < 4; ++g) {
      uint2 oa, ob;
      oa.x = pack2(o0[4 * g] * inv, o0[4 * g + 1] * inv); oa.y = pack2(o0[4 * g + 2] * inv, o0[4 * g + 3] * inv);
      ob.x = pack2(o1[4 * g] * inv, o1[4 * g + 1] * inv); ob.y = pack2(o1[4 * g + 2] * inv, o1[4 * g + 3] * inv);
      *reinterpret_cast<uint2*>(p.abuf + (size_t)qrow * DM + hq * 64 + 8 * g + 4 * hh) = oa;
      *reinterpret_cast<uint2*>(p.abuf + (size_t)qrow * DM + hq * 64 + 32 + 8 * g + 4 * hh) = ob;
    }
  }
}

#define XB_TMO      128
#define XB_XCNT(j)  (256  + 64 * (j))
#define XB_XSUB(j)  (1280 + 64 * (j))
#define XB_XGEN(j)  (2304 + 64 * (j))
#define XB_TOP      3328
#define XB_TOPGEN   3392
#define XCD_BAR_WORDS 3456
#define XB_SPIN_CAP (1u << 22)
#define LAS __attribute__((address_space(3)))

DEVINL unsigned xb_ld(unsigned* p) { return __hip_atomic_load(p, __ATOMIC_RELAXED, __HIP_MEMORY_SCOPE_AGENT); }
DEVINL unsigned xb_add(unsigned* p, unsigned v) { return __hip_atomic_fetch_add(p, v, __ATOMIC_RELAXED, __HIP_MEMORY_SCOPE_AGENT); }
DEVINL unsigned xb_xcc_id() { return (unsigned)__builtin_amdgcn_s_getreg((3 << 11) | 20) & 0xFu; }
#define XB_SPIN(cond, bar) do { unsigned _sp = 0; while (cond) { __builtin_amdgcn_s_sleep(1); \
    if ((++_sp & 255u) == 0u) { if (xb_ld(&(bar)[XB_TMO])) break; if (_sp > XB_SPIN_CAP) { atomicAdd(&(bar)[XB_TMO], 1u); break; } } } } while (0)

struct XcdBarrier { unsigned* bar; unsigned x; volatile LAS unsigned* st; };

DEVINL XcdBarrier xcd_barrier_post(unsigned* bar, volatile LAS unsigned* st) {
  XcdBarrier b; b.bar = bar; b.x = xb_xcc_id(); b.st = st;
  if (threadIdx.x == 0) (void)xb_add(&bar[XB_XCNT(b.x)], 1u);
  return b;
}
DEVINL void xcd_barrier_complete(unsigned* bar, unsigned x, unsigned& nloc, unsigned& nx) {
  const unsigned G = gridDim.x * gridDim.y * gridDim.z;
  unsigned sum, cnt, mine, sp = 0u;
  for (;;) {
    sum = 0u; cnt = 0u; mine = 0u;
#pragma unroll
    for (unsigned j = 0; j < 16; ++j) { const unsigned c = xb_ld(&bar[XB_XCNT(j)]); sum += c; cnt += (c > 0u) ? 1u : 0u; mine = (j == x) ? c : mine; }
    if (sum == G) break;
    __builtin_amdgcn_s_sleep(1);
    if ((++sp & 255u) == 0u) { if (xb_ld(&bar[XB_TMO])) break; if (sp > XB_SPIN_CAP) { atomicAdd(&bar[XB_TMO], 1u); break; } }
  }
  nloc = mine > 0u ? mine : 1u; nx = cnt > 0u ? cnt : 1u;
}
DEVINL void xcd_barrier(const XcdBarrier& b) {
  asm volatile("s_waitcnt vmcnt(0)" ::: "memory");
  __syncthreads();
  if (threadIdx.x == 0) {
    unsigned* bar = b.bar;
    __builtin_amdgcn_s_waitcnt(0);
    unsigned nloc = b.st[0], nx = b.st[1];
    if (nloc == 0u) { xcd_barrier_complete(bar, b.x, nloc, nx); b.st[0] = nloc; b.st[1] = nx; }
    const unsigned old = xb_add(&bar[XB_XSUB(b.x)], 1u);
    const unsigned gen = old / nloc;
    if (old + 1u == (gen + 1u) * nloc) {
      __builtin_amdgcn_fence(__ATOMIC_RELEASE, "agent");
      asm volatile("s_waitcnt vmcnt(0)" ::: "memory");
      const unsigned og = xb_add(&bar[XB_TOP], 1u);
      const unsigned tg = og / nx;
      if (og + 1u == (tg + 1u) * nx) xb_add(&bar[XB_TOPGEN], 1u);
      else XB_SPIN(xb_ld(&bar[XB_TOPGEN]) == tg, bar);
      __builtin_amdgcn_fence(__ATOMIC_ACQUIRE, "agent");
      xb_add(&bar[XB_XGEN(b.x)], 1u);
      asm volatile("s_waitcnt vmcnt(0)" ::: "memory");
    } else {
      XB_SPIN(xb_ld(&bar[XB_XGEN(b.x)]) == gen, bar);
      __builtin_amdgcn_fence(__ATOMIC_ACQUIRE, "agent");
      asm volatile("s_waitcnt vmcnt(0)" ::: "memory");
    }
  }
  __syncthreads();
}

__global__ void __launch_bounds__(NTHREADS, 2) mega_kernel(Params p) {
  __shared__ __attribute__((aligned(16))) char smem[SMEM_BYTES];
  cg::grid_group grid = cg::this_grid();
  const int w = blockIdx.x, nw = gridDim.x;
  if (p.use_cg_sync) grid.sync();
  volatile LAS unsigned* xst = (volatile LAS unsigned*)(smem + SMEM_BYTES - 16);
  if (threadIdx.x == 0) { xst[0] = 0u; xst[1] = 0u; }
  __syncthreads();
  XcdBarrier xb = xcd_barrier_post(p.bar, xst);
#define GSYNC() xcd_barrier(xb)
  phase_prep(p, w, nw, smem);
  GSYNC();
  for (int layer = 0; layer < 4; ++layer) {
    if ((layer & 1) == 0) {
      phase_r1(p, layer, w, nw); GSYNC();
      phase_r2(p, layer, w, nw, smem); GSYNC();
      phase_r3(p, layer, w, nw, smem); GSYNC();
      phase_r4(p, layer, w, nw, smem); GSYNC();
      phase_r5(p, layer, w, nw); GSYNC();
    } else {
      phase_a1(p, layer, w, nw); GSYNC();
      phase_a2(p, layer, w, nw, smem); GSYNC();
      phase_a3(p, layer, w, nw); GSYNC();
    }
    phase_wo(p, layer, w, nw, smem); GSYNC();
    phase_ln1(p, layer, w, nw); GSYNC();
    phase_p1(p, layer, w, nw, smem); GSYNC();
    phase_p2(p, layer, w, nw, smem); GSYNC();
    phase_p3(p, layer, w, nw, smem); GSYNC();
    phase_p4(p, layer, w, nw);
    if (layer < 3) GSYNC();
  }
}

static inline char* carve(char*& cur, size_t bytes) {
  char* r = cur;
  cur += (bytes + 255) & ~(size_t)255;
  return r;
}

extern "C" void kernel_launch(void* const* d_in, const int* in_sizes, int n_in, void* d_out, int out_size, void* d_ws,
                              size_t ws_size, hipStream_t stream) {
  Params p;
  memset(&p, 0, sizeof(p));
  for (int i = 0; i < 35; ++i) p.in[i] = (const float*)d_in[i];
  p.out = (float*)d_out;
  char* cur = (char*)d_ws;
  p.bar = (unsigned*)carve(cur, 16384);
  p.mod = (float*)carve(cur, (size_t)4 * 9 * 6144 * 4);
  p.rope = (float*)carve(cur, 64 * 16 * 2 * 4);
  p.rwkv_in_t = (bf16_t*)carve(cur, (size_t)2 * 3456 * 1024 * 2);
  p.w2t = (bf16_t*)carve(cur, (size_t)4 * 65536 * 2);
  p.a2t = (bf16_t*)carve(cur, (size_t)4 * 65536 * 2);
  p.g2t = (bf16_t*)carve(cur, (size_t)2 * 131072 * 2);
  p.rwkv_wo_t = (bf16_t*)carve(cur, (size_t)2 * 1048576 * 2);
  p.attn_wqkv_t = (bf16_t*)carve(cur, (size_t)2 * 1536 * 1024 * 2);
  p.attn_wo_t = (bf16_t*)carve(cur, (size_t)2 * 1048576 * 2);
  p.wq_t = (bf16_t*)carve(cur, (size_t)4 * 2048 * 1024 * 2);
  p.keysb = (bf16_t*)carve(cur, (size_t)4 * 2 * 128 * 128 * 2);
  p.ub = (bf16_t*)carve(cur, (size_t)4 * 16384 * 1024 * 2);
  p.vb = (bf16_t*)carve(cur, (size_t)4 * 16384 * 1024 * 2);
  p.Klat = (bf16_t*)carve(cur, (size_t)2 * 8 * 4 * 1536 * 64 * 2);
  p.VlatT = (bf16_t*)carve(cur, (size_t)2 * 8 * 4 * 1536 * 64 * 2);
  p.Kctx = (bf16_t*)carve(cur, (size_t)2 * 16 * 4 * 256 * 64 * 2);
  p.VctxT = (bf16_t*)carve(cur, (size_t)2 * 16 * 4 * 256 * 64 * 2);
  p.xbuf = (float*)carve(cur, (size_t)TT * DM * 4);
  p.zbuf = (float*)carve(cur, (size_t)TT * DM * 4);
  p.hbuf = (bf16_t*)carve(cur, (size_t)TT * DM * 2);
  p.abuf = (bf16_t*)carve(cur, (size_t)TT * DM * 2);
  p.U1 = carve(cur, (size_t)TT * DM * 14);
  p.U2 = carve(cur, (size_t)TT * DM * 8);
  p.U3 = carve(cur, (size_t)TT * DM * 8);
  p.pidx = (int*)carve(cur, (size_t)TT * 128 * 4);
  p.pgate = (float*)carve(cur, (size_t)TT * 128 * 4);
  for (int f = 0; f < 16; ++f) p.freqs[f] = pow(10000.0, -(double)f / 16.0);
  if ((size_t)(cur - (char*)d_ws) > ws_size) {
    fprintf(stderr, "workspace too small: need %zu have %zu\n", (size_t)(cur - (char*)d_ws), ws_size);
    return;
  }
  static int grid_blocks = 0;
  if (!grid_blocks) {
    int dev = 0, cus = 0, per_cu = 0;
    hipGetDevice(&dev);
    hipDeviceGetAttribute(&cus, hipDeviceAttributeMultiprocessorCount, dev);
    hipOccupancyMaxActiveBlocksPerMultiprocessor(&per_cu, mega_kernel, NTHREADS, 0);
    if (per_cu > 2) per_cu = 2;
    if (per_cu < 1) per_cu = 1;
    grid_blocks = cus * per_cu;
  }
  hipMemsetAsync(p.bar, 0, 16384, stream);
  void* args[] = {&p};
  hipError_t e = hipLaunchCooperativeKernel((void*)mega_kernel, dim3(grid_blocks), dim3(NTHREADS), args, 0, stream);
  if (e != hipSuccess) fprintf(stderr, "cooperative launch failed: %s (grid %d)\n", hipGetErrorString(e), grid_blocks);
}
```

```cpp
#include <hip/hip_runtime.h>
#include <hip/hip_cooperative_groups.h>
#include <stdint.h>
#include <string.h>
#include <math.h>
#include <stdio.h>

namespace cg = cooperative_groups;

typedef unsigned short bf16_t;
typedef __attribute__((ext_vector_type(8))) short bf16x8;
typedef __attribute__((ext_vector_type(4))) float f32x4;
typedef __attribute__((ext_vector_type(16))) float f32x16;

#define DEVINL __device__ __forceinline__
#define NTHREADS 512
#define NWAVES 8
#define GEMM_LDS 131072
#define SMEM_BYTES (131072 + 16384)
#define RW_N 3840

#define DM 1024
#define TCTX 4096
#define TLAT 8192
#define TT 12288
#define ALPHA_F 1.681792830507429f
#define LN_EPS_F 1e-5f
#define GN_EPS_F 6.4e-4f
#define RMS_EPS_F 1e-6f
#define QSCALE_F (0.125f * 1.4426950408889634f)

#define OUT_Y 0
#define OUT_STATE 12582912
#define OUT_CK 16777216
#define OUT_CV 18874368

struct Params {
  const float* in[35];
  float* out;
  float* mod;
  float* rope;
  bf16_t* rwkv_in_t;
  bf16_t* w2t;
  bf16_t* a2t;
  bf16_t* g2t;
  bf16_t* rwkv_wo_t;
  bf16_t* attn_wqkv_t;
  bf16_t* attn_wo_t;
  bf16_t* wq_t;
  bf16_t* keysb;
  bf16_t* ub;
  bf16_t* vb;
  bf16_t* Klat;
  bf16_t* VlatT;
  bf16_t* Kctx;
  bf16_t* VctxT;
  float* xbuf;
  float* zbuf;
  bf16_t* hbuf;
  bf16_t* abuf;
  char* U1;
  char* U2;
  char* U3;
  int* pidx;
  float* pgate;
  double freqs[16];
  unsigned* bar;
  int use_cg_sync;
  int pad0;
};

DEVINL int tidx() { int t = threadIdx.x; asm volatile("" : "+v"(t)); return t; }
DEVINL bf16_t f2bf(float f) {
  unsigned u = __float_as_uint(f);
  u += 0x7FFFu + ((u >> 16) & 1u);
  return (bf16_t)(u >> 16);
}
DEVINL float bf2f(bf16_t h) { return __uint_as_float(((unsigned)h) << 16); }
DEVINL unsigned pack2(float a, float b) { return (unsigned)f2bf(a) | ((unsigned)f2bf(b) << 16); }
DEVINL float bflo(unsigned u) { return __uint_as_float(u << 16); }
DEVINL float bfhi(unsigned u) { return __uint_as_float(u & 0xFFFF0000u); }

DEVINL float wave_sum(float v) {
#pragma unroll
  for (int o = 32; o > 0; o >>= 1) v += __shfl_xor(v, o);
  return v;
}
DEVINL float grp16_sum(float v) {
#pragma unroll
  for (int o = 8; o > 0; o >>= 1) v += __shfl_xor(v, o);
  return v;
}
DEVINL unsigned wave_max_u(unsigned v) {
#pragma unroll
  for (int o = 32; o > 0; o >>= 1) { unsigned t = (unsigned)__shfl_xor((int)v, o); v = v > t ? v : t; }
  return v;
}
DEVINL float sigmoidf_(float x) { return 1.0f / (1.0f + __expf(-x)); }
DEVINL float tanhf_(float x) { float e = __expf(-2.0f * fabsf(x)); float t = (1.0f - e) / (1.0f + e); return x < 0 ? -t : t; }
DEVINL unsigned ordf(float f) { unsigned u = __float_as_uint(f); return (u & 0x80000000u) ? ~u : (u | 0x80000000u); }

DEVINL int cond_of_row(int row) { return row < TCTX ? 8 : ((row - TCTX) >> 10); }


namespace pg8 {
#define PG8_LAS __attribute__((address_space(3)))
typedef unsigned u32x4 __attribute__((ext_vector_type(4)));
constexpr int BM = 256, BK = 64, HALF = 128, HTB = HALF * BK * 2, STAGE_BYTES = 8 * HTB, NXCD = 8, WGM = 8;
DEVINL int lds_byte(int r, int c) { const int st = (r >> 4) * 2 + (c >> 5), rr = r & 15, cc = c & 31, ob = rr * 64 + cc * 2; return st * 1024 + (ob ^ (((ob >> 9) & 1) << 5)); }
DEVINL void stage_rc(int b, int& R, int& C) { const int st = b / 1024, sb = b % 1024, swz = sb ^ (((sb >> 9) & 1) << 5); R = (st >> 1) * 16 + swz / 64; C = (st & 1) * 32 + (swz % 64) / 2; }
DEVINL int perm32(int rho) { const int n = rho >> 4, i = rho & 15; return 8 * (i >> 2) + 4 * n + (i & 3); }
struct Unit { int pm, pn; };
struct StaticOrder {
  int nM, nN, nwg, G, c;
  DEVINL void init(int M, int N, int G_, int c_) { nM = M / BM; nN = N / BM; nwg = nM * nN; G = G_; c = c_; }
  DEVINL bool next(int i, Unit& u) const {
    const long L = (long)i * G + c; if (L >= nwg) return false;
    int wgid = (int)L; { const int q = nwg / NXCD, r = nwg % NXCD, xcd = wgid % NXCD, off = wgid / NXCD; wgid = (xcd < r ? xcd * (q + 1) : r * (q + 1) + (xcd - r) * q) + off; }
    const int nig = WGM * nN, gid = wgid / nig, fm = gid * WGM, gsz = (nM - fm) < WGM ? (nM - fm) : WGM;
    u.pm = fm + ((wgid % nig) % gsz); u.pn = (wgid % nig) / gsz; return true;
  }
};
DEVINL unsigned cvt_pk_bf16(float lo, float hi) { unsigned r; asm volatile("v_cvt_pk_bf16_f32 %0, %1, %2" : "=v"(r) : "v"(lo), "v"(hi)); return r; }

template <class Epi, class ASel>
DEVINL void gemm_phase(PG8_LAS unsigned char* lds, const ASel& asel, const bf16_t* Bt, const int K, const StaticOrder& S, const Epi& E) {
  const int tid = tidx(), wid = __builtin_amdgcn_readfirstlane(tid >> 6), lane = tid & 63, wr = wid >> 2, wc = wid & 3, fr = lane & 15, fq = lane >> 4;
  const int nt = K / BK;
  unsigned voffA[2], voffB[2];
#pragma unroll
  for (int i = 0; i < 2; ++i) { int R, C; stage_rc(tid * 16 + i * 8192, R, C); const int Rb = Epi::PERM ? ((R & ~31) + perm32(R & 31)) : R;
    voffA[i] = (unsigned)(R * K + C) * 2u; voffB[i] = (unsigned)(Rb * K + C) * 2u; }
  const size_t kstep = (size_t)(BK * 2);
  const size_t hstep = (size_t)HALF * K * 2;
  const size_t tstep = 2 * hstep;
  const unsigned ldsw = (unsigned)wid * 1024u;
  const int aoff = lds_byte(wr * 64 + fr, fq * 8), boff = lds_byte(wc * 32 + fr, fq * 8);
#define PG8_SA(b, h) (((b) * 2 + (h)) * HTB)
#define PG8_SB(b, h) ((4 + (b) * 2 + (h)) * HTB)
#define PG8_STAGE(bufoff, gbase, voff) do { _Pragma("unroll") for (int _i = 0; _i < 2; ++_i) \
    __builtin_amdgcn_global_load_lds((const unsigned*)((const char*)(gbase) + (voff)[_i]), (PG8_LAS unsigned*)(lds + (bufoff) + ldsw + _i * 8192), 16, 0, 0); } while (0)
#define PG8_LDA(dst, b, h) do { _Pragma("unroll") for (int m = 0; m < 4; ++m) _Pragma("unroll") for (int k = 0; k < 2; ++k) dst[m][k] = *(const PG8_LAS bf16x8*)(lds + PG8_SA(b, h) + aoff + m * 2048 + k * 1024); } while (0)
#define PG8_LDB(dst, b, h) do { _Pragma("unroll") for (int n = 0; n < 2; ++n) _Pragma("unroll") for (int k = 0; k < 2; ++k) dst[n][k] = *(const PG8_LAS bf16x8*)(lds + PG8_SB(b, h) + boff + n * 2048 + k * 1024); } while (0)
#define PG8_MMA(ai, bj, At, Bt_) do { __builtin_amdgcn_s_setprio(1); _Pragma("unroll") for (int m = 0; m < 4; ++m) _Pragma("unroll") for (int n = 0; n < 2; ++n) _Pragma("unroll") for (int k = 0; k < 2; ++k) \
    acc[ai][bj][m][n] = __builtin_amdgcn_mfma_f32_16x16x32_bf16(Bt_[n][k], At[m][k], acc[ai][bj][m][n], 0, 0, 0); __builtin_amdgcn_s_setprio(0); } while (0)
#define PG8_WAIT_V(n) asm volatile("s_waitcnt vmcnt(" #n ")" ::: "memory")
#define PG8_WAIT_L(n) asm volatile("s_waitcnt lgkmcnt(" #n ")" ::: "memory")
#define PG8_BAR __builtin_amdgcn_s_barrier()
#define PG8_SCHED __builtin_amdgcn_sched_barrier(0)
  Unit cur, nxt; int ui = 0;
  if (!S.next(0, cur)) return;
  f32x4 acc[2][2][4][2];
#pragma unroll
  for (int a = 0; a < 2; ++a)
#pragma unroll
    for (int b = 0; b < 2; ++b)
#pragma unroll
      for (int m = 0; m < 4; ++m)
#pragma unroll
        for (int n = 0; n < 2; ++n) acc[a][b][m][n] = (f32x4){0.f, 0.f, 0.f, 0.f};
  bf16x8 At[4][2], B0[2][2], B1[2][2];
  const char* cA = asel(cur.pn) + (size_t)cur.pm * tstep; const char* cB = (const char*)Bt + (size_t)cur.pn * tstep;
  PG8_STAGE(PG8_SB(0, 0), cB, voffB); PG8_STAGE(PG8_SA(0, 0), cA, voffA); PG8_STAGE(PG8_SB(0, 1), cB + hstep, voffB); PG8_STAGE(PG8_SA(0, 1), cA + hstep, voffA);
  if (wr == 1) PG8_BAR;
  PG8_WAIT_V(4); PG8_BAR;
  PG8_STAGE(PG8_SB(1, 0), cB + kstep, voffB); PG8_STAGE(PG8_SA(1, 0), cA + kstep, voffA); PG8_STAGE(PG8_SB(1, 1), cB + hstep + kstep, voffB);
  PG8_WAIT_V(6); PG8_BAR;
  for (;;) {
    const bool has_next = S.next(ui + 1, nxt);
    const char* nA = has_next ? asel(nxt.pn) + (size_t)nxt.pm * tstep : cA; const char* nB = has_next ? (const char*)Bt + (size_t)nxt.pn * tstep : cB;
    for (int t = 0; t < nt; t += 2) {
      const bool last = (t == nt - 2);
      const char* a1 = cA + (size_t)(t + 1) * kstep;
      const char* a2 = last ? nA : cA + (size_t)(t + 2) * kstep; const char* b2 = last ? nB : cB + (size_t)(t + 2) * kstep;
      const char* a3 = a2 + kstep; const char* b3 = b2 + kstep;
      PG8_LDB(B0, 0, 0); PG8_SCHED; PG8_LDA(At, 0, 0); PG8_STAGE(PG8_SA(1, 1), a1 + hstep, voffA);
      PG8_WAIT_L(8); PG8_BAR; PG8_WAIT_L(0); PG8_MMA(0, 0, At, B0); PG8_BAR; PG8_SCHED;
      PG8_LDB(B1, 0, 1); PG8_STAGE(PG8_SB(0, 0), b2, voffB);
      PG8_BAR; PG8_WAIT_L(0); PG8_MMA(0, 1, At, B1); PG8_BAR;
      PG8_LDA(At, 0, 1); PG8_STAGE(PG8_SA(0, 0), a2, voffA);
      PG8_BAR; PG8_WAIT_L(0); PG8_MMA(1, 0, At, B0); PG8_BAR; PG8_SCHED;
      PG8_STAGE(PG8_SB(0, 1), b2 + hstep, voffB);
      PG8_WAIT_V(6); PG8_BAR; PG8_MMA(1, 1, At, B1); PG8_BAR;
      PG8_LDB(B0, 1, 0); PG8_SCHED; PG8_LDA(At, 1, 0); PG8_STAGE(PG8_SA(0, 1), a2 + hstep, voffA);
      PG8_WAIT_L(8); PG8_BAR; PG8_WAIT_L(0); PG8_MMA(0, 0, At, B0); PG8_BAR; PG8_SCHED;
      PG8_LDB(B1, 1, 1); PG8_STAGE(PG8_SB(1, 0), b3, voffB);
      PG8_BAR; PG8_WAIT_L(0); PG8_MMA(0, 1, At, B1); PG8_BAR;
      PG8_LDA(At, 1, 1); PG8_STAGE(PG8_SA(1, 0), a3, voffA);
      PG8_BAR; PG8_WAIT_L(0); PG8_MMA(1, 0, At, B0); PG8_BAR; PG8_SCHED;
      PG8_STAGE(PG8_SB(1, 1), b3 + hstep, voffB);
      PG8_WAIT_V(6); PG8_BAR; PG8_MMA(1, 1, At, B1); PG8_BAR;
    }
    E(acc, cur, wr, wc, fr, fq);
    if (!has_next) break;
#pragma unroll
    for (int a = 0; a < 2; ++a)
#pragma unroll
      for (int b = 0; b < 2; ++b)
#pragma unroll
        for (int m = 0; m < 4; ++m)
#pragma unroll
          for (int n = 0; n < 2; ++n) acc[a][b][m][n] = (f32x4){0.f, 0.f, 0.f, 0.f};
    cur = nxt; cA = nA; cB = nB; ++ui;
  }
  PG8_WAIT_V(0);
  if (wr == 0) PG8_BAR;
  PG8_BAR;
#undef PG8_SA
#undef PG8_SB
#undef PG8_STAGE
#undef PG8_LDA
#undef PG8_LDB
#undef PG8_MMA
#undef PG8_WAIT_V
#undef PG8_WAIT_L
#undef PG8_BAR
#undef PG8_SCHED
}
struct ASelOne { const char* A; DEVINL const char* operator()(int) const { return A; } };
}

DEVINL void gemm_tile_128(const bf16_t* __restrict__ A, int lda, const bf16_t* __restrict__ Bt, int ldb, int K,
                          char* smem_half, f32x4 (&acc)[4][4]) {
  const int tid = tidx() & 255, wid = tid >> 6, lane = tid & 63;
  const int wr = wid >> 1, wc = wid & 1, fr = lane & 15, fq = lane >> 4;
  char* SA = smem_half;
  char* SB = smem_half + 8192;
#pragma unroll
  for (int m = 0; m < 4; ++m)
#pragma unroll
    for (int n = 0; n < 4; ++n) acc[m][n] = (f32x4){0.f, 0.f, 0.f, 0.f};
  for (int k0 = 0; k0 < K; k0 += 32) {
#pragma unroll
    for (int i = 0; i < 2; ++i) {
      int b = tid * 16 + i * 4096;
      int r = b >> 6, c = (b & 63) >> 1;
      __builtin_amdgcn_global_load_lds((const unsigned*)(A + (size_t)r * lda + k0 + c), (unsigned*)(SA + b), 16, 0, 0);
      __builtin_amdgcn_global_load_lds((const unsigned*)(Bt + (size_t)r * ldb + k0 + c), (unsigned*)(SB + b), 16, 0, 0);
    }
    asm volatile("s_waitcnt vmcnt(0)" ::: "memory");
    __syncthreads();
    bf16x8 a[4], b[4];
#pragma unroll
    for (int m = 0; m < 4; ++m) a[m] = *reinterpret_cast<const bf16x8*>(SA + (wr * 64 + m * 16 + fr) * 64 + fq * 16);
#pragma unroll
    for (int n = 0; n < 4; ++n) b[n] = *reinterpret_cast<const bf16x8*>(SB + (wc * 64 + n * 16 + fr) * 64 + fq * 16);
#pragma unroll
    for (int m = 0; m < 4; ++m)
#pragma unroll
      for (int n = 0; n < 4; ++n) acc[m][n] = __builtin_amdgcn_mfma_f32_16x16x32_bf16(a[m], b[n], acc[m][n], 0, 0, 0);
    __syncthreads();
  }
}

#define GEMM_LANE_VARS \
  const int tid = tidx() & 255, wid = tid >> 6, lane = tid & 63; \
  const int wr = wid >> 1, wc = wid & 1, fr = lane & 15, fq = lane >> 4; \
  (void)tid; (void)wid; (void)lane; (void)wr; (void)wc; (void)fr; (void)fq;

DEVINL void get_tjob(const Params& p, int ji, const float*& src, bf16_t*& dst, int& K, int& N) {
  if (ji < 28) {
    int j = ji / 14, s = ji % 14;
    bf16_t* rw = p.rwkv_in_t + (size_t)j * RW_N * 1024;
    if (s < 3) { src = p.in[12] + ((size_t)(j * 3 + s) << 20); dst = rw + ((size_t)s << 20); K = 1024; N = 1024; }
    else if (s < 5) { int z = s - 3; src = p.in[15] + (size_t)(j * 2 + z) * 65536; dst = rw + (size_t)(3072 + z * 64) * 1024; K = 1024; N = 64; }
    else if (s < 7) { int z = s - 5; src = p.in[18] + (size_t)(j * 2 + z) * 65536; dst = rw + (size_t)(3328 + z * 64) * 1024; K = 1024; N = 64; }
    else if (s == 7) { src = p.in[20] + (size_t)j * 131072; dst = rw + (size_t)3584 * 1024; K = 1024; N = 128; }
    else if (s < 10) { int z = s - 8; src = p.in[16] + (size_t)(j * 2 + z) * 65536; dst = p.w2t + (size_t)(j * 2 + z) * 65536; K = 64; N = 1024; }
    else if (s < 12) { int z = s - 10; src = p.in[19] + (size_t)(j * 2 + z) * 65536; dst = p.a2t + (size_t)(j * 2 + z) * 65536; K = 64; N = 1024; }
    else if (s == 12) { src = p.in[21] + (size_t)j * 131072; dst = p.g2t + (size_t)j * 131072; K = 128; N = 1024; }
    else { src = p.in[13] + ((size_t)j << 20); dst = p.rwkv_wo_t + ((size_t)j << 20); K = 1024; N = 1024; }
  } else if (ji < 32) {
    int j = (ji - 28) >> 1, s = (ji - 28) & 1;
    if (s == 0) { src = p.in[27] + (size_t)j * 1024 * 1536; dst = p.attn_wqkv_t + (size_t)j * 1536 * 1024; K = 1024; N = 1536; }
    else { src = p.in[28] + ((size_t)j << 20); dst = p.attn_wo_t + ((size_t)j << 20); K = 1024; N = 1024; }
  } else {
    int i = ji - 32;
    src = p.in[31] + (size_t)i * 1024 * 2048; dst = p.wq_t + (size_t)i * 2048 * 1024; K = 1024; N = 2048;
  }
}

DEVINL void sincos_d(double x, float& c, float& s) {
  const double TWO_PI = 6.283185307179586476925;
  double r = x - TWO_PI * rint(x / TWO_PI);
  double r2 = r * r;
  double ts = r, tc = 1.0, ss = r, cs = 1.0;
#pragma unroll 1
  for (int n = 1; n <= 14; ++n) {
    tc = -tc * r2 / (double)((2 * n - 1) * (2 * n));
    ts = -ts * r2 / (double)((2 * n) * (2 * n + 1));
    cs += tc; ss += ts;
  }
  c = (float)cs; s = (float)ss;
}

DEVINL void phase_prep(const Params& p, int w, int nw, char* smem) {
  const int tid = tidx();
  {
    float (*tile)[65] = reinterpret_cast<float (*)[65]>(smem);
    int toff = 0;
    for (int ji = 0; ji < 36; ++ji) {
      const float* src; bf16_t* dst; int K, N;
      get_tjob(p, ji, src, dst, K, N);
      const int tn = N >> 6, nt = (K >> 6) * tn;
      int t0 = (w - (toff % nw) + nw) % nw;
      for (int t = t0; t < nt; t += nw) {
        const int k0 = (t / tn) << 6, n0 = (t % tn) << 6;
#pragma unroll
        for (int i = 0; i < 2; ++i) {
          int r = (tid >> 4) + 32 * i, c = (tid & 15) * 4;
          float4 v = *reinterpret_cast<const float4*>(src + (size_t)(k0 + r) * N + n0 + c);
          tile[r][c] = v.x; tile[r][c + 1] = v.y; tile[r][c + 2] = v.z; tile[r][c + 3] = v.w;
        }
        __syncthreads();
        {
          int q = tid;
          int n = q >> 3, kc = (q & 7) * 8;
          uint4 o;
          o.x = pack2(tile[kc + 0][n], tile[kc + 1][n]);
          o.y = pack2(tile[kc + 2][n], tile[kc + 3][n]);
          o.z = pack2(tile[kc + 4][n], tile[kc + 5][n]);
          o.w = pack2(tile[kc + 6][n], tile[kc + 7][n]);
          *reinterpret_cast<uint4*>(dst + (size_t)(n0 + n) * K + k0 + kc) = o;
        }
        __syncthreads();
      }
      toff += nt;
    }
  }
  const size_t gtid = (size_t)w * NTHREADS + tid, gn = (size_t)nw * NTHREADS;
  {
    const size_t n8 = (size_t)4 * 16384 * 1024 / 8;
    for (size_t i = gtid; i < n8; i += gn) {
      const float4* su = reinterpret_cast<const float4*>(p.in[33]) + i * 2;
      float4 a = su[0], b = su[1];
      uint4 o; o.x = pack2(a.x, a.y); o.y = pack2(a.z, a.w); o.z = pack2(b.x, b.y); o.w = pack2(b.z, b.w);
      reinterpret_cast<uint4*>(p.ub)[i] = o;
      const float4* sv = reinterpret_cast<const float4*>(p.in[34]) + i * 2;
      a = sv[0]; b = sv[1];
      o.x = pack2(a.x, a.y); o.y = pack2(a.z, a.w); o.z = pack2(b.x, b.y); o.w = pack2(b.z, b.w);
      reinterpret_cast<uint4*>(p.vb)[i] = o;
    }
    const size_t nk8 = (size_t)4 * 2 * 128 * 128 / 8;
    for (size_t i = gtid; i < nk8; i += gn) {
      const float4* su = reinterpret_cast<const float4*>(p.in[32]) + i * 2;
      float4 a = su[0], b = su[1];
      uint4 o; o.x = pack2(a.x, a.y); o.y = pack2(a.z, a.w); o.z = pack2(b.x, b.y); o.w = pack2(b.z, b.w);
      reinterpret_cast<uint4*>(p.keysb)[i] = o;
    }
  }
  {
    const size_t nk = (size_t)8 * 2 * 512 * 4 * 64;
    for (size_t i = gtid; i < nk; i += gn) {
      int d = i & 63, kvh = (i >> 6) & 3, s = (i >> 8) & 511, j = (i >> 17) & 1, b = (int)(i >> 18);
      p.Klat[((size_t)((j * 8 + b) * 4 + kvh) * 1536 + s) * 64 + d] = f2bf(p.in[4][i]);
      p.VlatT[((size_t)((j * 8 + b) * 4 + kvh) * 64 + d) * 1536 + s] = f2bf(p.in[5][i]);
    }
  }
  for (size_t i = gtid; i < 1024; i += gn) {
    int pos = (int)(i >> 4), f = (int)(i & 15);
    float c, s; sincos_d((double)pos * p.freqs[f], c, s);
    p.rope[i * 2] = c; p.rope[i * 2 + 1] = s;
  }
  {
    const size_t n4 = (size_t)TT * DM / 4, nc4 = (size_t)TCTX * DM / 4;
    for (size_t i = gtid; i < n4; i += gn) {
      float4 v = (i < nc4) ? reinterpret_cast<const float4*>(p.in[0])[i] : reinterpret_cast<const float4*>(p.in[1])[i - nc4];
      reinterpret_cast<float4*>(p.xbuf)[i] = v;
    }
  }
  {
    float* sc = reinterpret_cast<float*>(smem);
    float* red = sc + 9 * 1024;
    bool loaded = false;
    for (int item = w; item < 384; item += nw) {
      if (!loaded) {
        __syncthreads();
        for (int e = tid; e < 9 * 1024; e += NTHREADS) {
          int c = e >> 10, d = e & 1023;
          float v = (c < 8) ? p.in[2][c * 1024 + d] : p.in[6][d];
          sc[e] = v / (1.0f + __expf(-v));
        }
        __syncthreads();
        loaded = true;
      }
      const int i = item / 96, cc = item % 96;
      const int col = cc * 64 + (tid & 63), ks = tid >> 6;
      float acc[9];
#pragma unroll
      for (int c = 0; c < 9; ++c) acc[c] = 0.f;
      const float* wp = p.in[7] + (size_t)i * 1024 * 6144 + col;
      for (int d0 = ks * 128; d0 < ks * 128 + 128; d0 += 16) {
        float wv[16];
#pragma unroll
        for (int u = 0; u < 16; ++u) wv[u] = wp[(size_t)(d0 + u) * 6144];
#pragma unroll
        for (int u = 0; u < 16; ++u)
#pragma unroll
          for (int c = 0; c < 9; ++c) acc[c] += sc[c * 1024 + d0 + u] * wv[u];
      }
#pragma unroll
      for (int c = 0; c < 9; ++c) red[(ks * 9 + c) * 64 + (tid & 63)] = acc[c];
      __syncthreads();
      for (int o = tid; o < 576; o += NTHREADS) {
        int c = o >> 6, cl = o & 63;
        float s = 0.f;
#pragma unroll
        for (int k2 = 0; k2 < 8; ++k2) s += red[(k2 * 9 + c) * 64 + cl];
        int n = cc * 64 + cl;
        p.mod[((size_t)i * 9 + c) * 6144 + n] = s + p.in[8][i * 6144 + n];
      }
      __syncthreads();
    }
  }
}

DEVINL void phase_r1(const Params& p, int layer, int w, int nw) {
  const int j = layer >> 1;
  const int lane = tidx() & 63;
  const int gw = w * NWAVES + (tidx() >> 6), ngw = nw * NWAVES;
  bf16_t* A6 = reinterpret_cast<bf16_t*>(p.U1);
  const float* mu = p.in[11] + (size_t)j * 6 * 1024;
  for (int row = gw; row < TT; row += ngw) {
    int t, Tlen;
    if (row < TCTX) { t = row & 255; Tlen = 256; } else { t = (row - TCTX) & 1023; Tlen = 1024; }
    const int cond = cond_of_row(row);
    const float* sh = p.mod + ((size_t)layer * 9 + cond) * 6144;
    const float* sc = sh + 1024;
    const bool hasp = t > 0, hasn = t < Tlen - 1;
#pragma unroll
    for (int k = 0; k < 4; ++k) {
      const int col = k * 256 + lane * 4;
      const float4 xc = *reinterpret_cast<const float4*>(p.xbuf + (size_t)row * DM + col);
      float4 xp = make_float4(0, 0, 0, 0), xn = make_float4(0, 0, 0, 0);
      if (hasp) xp = *reinterpret_cast<const float4*>(p.xbuf + (size_t)(row - 1) * DM + col);
      if (hasn) xn = *reinterpret_cast<const float4*>(p.xbuf + (size_t)(row + 1) * DM + col);
      const float4 s4 = *reinterpret_cast<const float4*>(sh + col);
      const float4 c4 = *reinterpret_cast<const float4*>(sc + col);
      float h[4], xx[4];
      const float xcv[4] = {xc.x, xc.y, xc.z, xc.w}, xpv[4] = {xp.x, xp.y, xp.z, xp.w}, xnv[4] = {xn.x, xn.y, xn.z, xn.w};
      const float shv[4] = {s4.x, s4.y, s4.z, s4.w}, scv[4] = {c4.x, c4.y, c4.z, c4.w};
#pragma unroll
      for (int e = 0; e < 4; ++e) {
        float g = 1.0f + scv[e];
        h[e] = xcv[e] * g + shv[e];
        float hp = hasp ? (xpv[e] * g + shv[e]) : 0.f;
        float hn = hasn ? (xnv[e] * g + shv[e]) : 0.f;
        xx[e] = 0.5f * (hp + hn) - h[e];
      }
#pragma unroll
      for (int m = 0; m < 6; ++m) {
        const float4 m4 = *reinterpret_cast<const float4*>(mu + m * 1024 + col);
        uint2 o;
        o.x = pack2(h[0] + xx[0] * m4.x, h[1] + xx[1] * m4.y);
        o.y = pack2(h[2] + xx[2] * m4.z, h[3] + xx[3] * m4.w);
        *reinterpret_cast<uint2*>(A6 + ((size_t)m * TT + row) * DM + col) = o;
      }
    }
  }
}

#define U1_AA_OFF ((size_t)2 * TT * DM * 4)
#define U1_GG_OFF (U1_AA_OFF + (size_t)2 * TT * DM * 2)

struct ASelR2 {
  const char* A6;
  DEVINL const char* operator()(int pn) const {
    const int idx = pn < 12 ? (pn >> 2) : (pn - 9);
    const int m = (0x541320 >> (4 * idx)) & 7;
    return A6 + (size_t)m * TT * DM * 2;
  }
};
struct EpiR2 {
  static constexpr bool PERM = true;
  bf16_t *rb, *lw;
  DEVINL void operator()(const f32x4 (&acc)[2][2][4][2], const pg8::Unit& u, int wr, int wc, int fr, int fq) const {
    const int row0 = u.pm * 256 + wr * 64 + fr;
    const int pn = u.pn;
    if (pn < 12) {
      bf16_t* dst = rb + (size_t)(pn >> 2) * TT * DM;
      const int col0 = (pn & 3) * 256 + wc * 32 + 8 * fq;
#pragma unroll
      for (int ai = 0; ai < 2; ++ai)
#pragma unroll
        for (int m = 0; m < 4; ++m) {
          bf16_t* rowp = dst + (size_t)(row0 + ai * 128 + m * 16) * DM + col0;
#pragma unroll
          for (int bj = 0; bj < 2; ++bj) {
            const f32x4 v0 = acc[ai][bj][m][0], v1 = acc[ai][bj][m][1];
            pg8::u32x4 o; o.x = pg8::cvt_pk_bf16(v0[0], v0[1]); o.y = pg8::cvt_pk_bf16(v0[2], v0[3]); o.z = pg8::cvt_pk_bf16(v1[0], v1[1]); o.w = pg8::cvt_pk_bf16(v1[2], v1[3]);
            *reinterpret_cast<pg8::u32x4*>(rowp + bj * 128) = o;
          }
        }
    } else {
      bf16_t* dst = lw + (size_t)(pn - 12) * TT * 128;
      const int col0 = wc * 32 + 8 * fq;
      const float kx = (pn == 12 ? 2.0f : 1.0f) * 1.4426950408889634f, ka = pn == 12 ? 2.0f : 1.0f, kb = pn == 12 ? -1.0f : 0.0f;
#pragma unroll
      for (int ai = 0; ai < 2; ++ai)
#pragma unroll
        for (int m = 0; m < 4; ++m) {
          f32x4 v0 = acc[ai][0][m][0], v1 = acc[ai][0][m][1];
          if (pn != 13) {
#pragma unroll
            for (int e = 0; e < 4; ++e) {
              const float s0 = __builtin_amdgcn_rcpf(1.0f + __builtin_amdgcn_exp2f(-kx * v0[e]));
              const float s1 = __builtin_amdgcn_rcpf(1.0f + __builtin_amdgcn_exp2f(-kx * v1[e]));
              v0[e] = ka * s0 + kb; v1[e] = ka * s1 + kb;
            }
          }
          asm volatile("" ::: "memory");
          pg8::u32x4 o; o.x = pg8::cvt_pk_bf16(v0[0], v0[1]); o.y = pg8::cvt_pk_bf16(v0[2], v0[3]); o.z = pg8::cvt_pk_bf16(v1[0], v1[1]); o.w = pg8::cvt_pk_bf16(v1[2], v1[3]);
          *reinterpret_cast<pg8::u32x4*>(dst + (size_t)(row0 + ai * 128 + m * 16) * 128 + col0) = o;
        }
    }
  }
};
DEVINL void phase_r2(const Params& p, int layer, int w, int nw, char* smem) {
  const int j = layer >> 1;
  bf16_t* rb = reinterpret_cast<bf16_t*>(p.U2);
  EpiR2 E;
  E.rb = rb; E.lw = p.abuf;
  ASelR2 as; as.A6 = p.U1;
  pg8::StaticOrder S; S.init(TT, RW_N, nw, w);
  pg8::gemm_phase<EpiR2, ASelR2>((PG8_LAS unsigned char*)smem, as, p.rwkv_in_t + (size_t)j * RW_N * 1024, 1024, S, E);
}

DEVINL void phase_r3(const Params& p, int layer, int w, int nw, char* smem) {
  const int j = layer >> 1;
  GEMM_LANE_VARS
  const int half = tidx() >> 8;
  char* sh = smem + half * 16384;
  const bf16_t* lw = p.abuf;
  const bf16_t* la = lw + (size_t)TT * 128;
  const bf16_t* lg = la + (size_t)TT * 128;
  float* wdec = reinterpret_cast<float*>(p.U1);
  bf16_t* aa = reinterpret_cast<bf16_t*>(p.U1 + U1_AA_OFF);
  bf16_t* gg = reinterpret_cast<bf16_t*>(p.U1 + U1_GG_OFF);
  const int NTILES = 96 * 40;
  for (int it = 0; it * nw * 2 < NTILES; ++it) {
    int tile = (it * nw + w) * 2 + half;
    const bool valid = tile < NTILES;
    if (!valid) tile = 0;
    const int ct = tile / 96, rt = tile % 96;
    const int job = ct >> 3, nt = ct & 7;
    const int row0 = rt * 128, col0 = nt * 128;
    f32x4 acc[4][4];
    if (job < 2) {
      const int z = job;
      gemm_tile_128(lw + (size_t)row0 * 128 + z * 64, 128, p.w2t + (size_t)(j * 2 + z) * 65536 + (size_t)col0 * 64, 64, 64, sh, acc);
      if (valid) {
        const float* w0 = p.in[14] + (size_t)(j * 2 + z) * 1024;
#pragma unroll
        for (int m = 0; m < 4; ++m)
#pragma unroll
          for (int n = 0; n < 4; ++n)
#pragma unroll
            for (int jj = 0; jj < 4; ++jj) {
              int row = row0 + wr * 64 + m * 16 + fq * 4 + jj, col = col0 + wc * 64 + n * 16 + fr;
              float wl = acc[m][n][jj] + w0[col];
              wdec[((size_t)z * TT + row) * DM + col] = __expf(-0.6065306597126334f * sigmoidf_(wl));
            }
      }
    } else if (job < 4) {
      const int z = job - 2;
      gemm_tile_128(la + (size_t)row0 * 128 + z * 64, 128, p.a2t + (size_t)(j * 2 + z) * 65536 + (size_t)col0 * 64, 64, 64, sh, acc);
      if (valid) {
        const float* a0 = p.in[17] + (size_t)(j * 2 + z) * 1024;
#pragma unroll
        for (int m = 0; m < 4; ++m)
#pragma unroll
          for (int n = 0; n < 4; ++n)
#pragma unroll
            for (int jj = 0; jj < 4; ++jj) {
              int row = row0 + wr * 64 + m * 16 + fq * 4 + jj, col = col0 + wc * 64 + n * 16 + fr;
              aa[((size_t)z * TT + row) * DM + col] = f2bf(sigmoidf_(acc[m][n][jj] + a0[col]));
            }
      }
    } else {
      gemm_tile_128(lg + (size_t)row0 * 128, 128, p.g2t + (size_t)j * 131072 + (size_t)col0 * 128, 128, 128, sh, acc);
      if (valid) {
#pragma unroll
        for (int m = 0; m < 4; ++m)
#pragma unroll
          for (int n = 0; n < 4; ++n)
#pragma unroll
            for (int jj = 0; jj < 4; ++jj) {
              int row = row0 + wr * 64 + m * 16 + fq * 4 + jj, col = col0 + wc * 64 + n * 16 + fr;
              gg[(size_t)row * DM + col] = f2bf(acc[m][n][jj]);
            }
      }
    }
  }
  {
    const int l64 = tidx() & 63;
    const int gw = w * NWAVES + (tidx() >> 6), ngw = nw * NWAVES;
    const bf16_t* kb = reinterpret_cast<const bf16_t*>(p.U2) + (size_t)TT * DM;
    bf16_t* kkb = reinterpret_cast<bf16_t*>(p.U2) + (size_t)3 * TT * DM;
    const float* k_k = p.in[22] + j * 1024;
    for (int row = gw; row < TT; row += ngw) {
#pragma unroll
      for (int k = 0; k < 4; ++k) {
        const int col = k * 256 + l64 * 4;
        const uint2 k2 = *reinterpret_cast<const uint2*>(kb + (size_t)row * DM + col);
        const float4 kk4 = *reinterpret_cast<const float4*>(k_k + col);
        float v0 = bflo(k2.x) * kk4.x, v1 = bfhi(k2.x) * kk4.y, v2 = bflo(k2.y) * kk4.z, v3 = bfhi(k2.y) * kk4.w;
        float ss = grp16_sum(v0 * v0 + v1 * v1 + v2 * v2 + v3 * v3);
        float inv = 1.0f / fmaxf(sqrtf(ss), 1e-12f);
        uint2 o; o.x = pack2(v0 * inv, v1 * inv); o.y = pack2(v2 * inv, v3 * inv);
        *reinterpret_cast<uint2*>(kkb + (size_t)row * DM + col) = o;
      }
    }
  }
}

DEVINL void phase_r4(const Params& p, int layer, int w, int nw, char* smem) {
  const int j = layer >> 1;
  const int lane = tidx() & 63, wid = tidx() >> 6;
  const bf16_t* rb = reinterpret_cast<const bf16_t*>(p.U2);
  const bf16_t* kb = rb + (size_t)TT * DM;
  const bf16_t* vb = kb + (size_t)TT * DM;
  const bf16_t* kkb = vb + (size_t)TT * DM;
  const float* wdec = reinterpret_cast<const float*>(p.U1);
  const bf16_t* aa = reinterpret_cast<const bf16_t*>(p.U1 + U1_AA_OFF);
  float* yout = reinterpret_cast<float*>(p.U3);
  float* lds = reinterpret_cast<float*>(smem) + wid * (8 * 5 * 64);
  for (int c = w + nw * wid; c < 768; c += nw * NWAVES) {
    int seq, h, z;
    if (c < 256) { seq = 16 + (c >> 5); h = (c >> 1) & 15; z = c & 1; }
    else { int cc = c - 256; seq = cc >> 5; h = (cc >> 1) & 15; z = cc & 1; }
    const int Tlen = seq < 16 ? 256 : 1024;
    const int base = seq < 16 ? seq * 256 : TCTX + (seq - 16) * 1024;
    const int colb = h * 64;
    const float kal = p.in[23][j * 1024 + colb + lane];
    float S[64];
    if (seq >= 16) {
      const float* s0 = p.in[3] + ((((size_t)(seq - 16) * 2 + j) * 2 + z) * 16 + h) * 4096 + (size_t)lane * 64;
#pragma unroll
      for (int q = 0; q < 16; ++q) {
        float4 v = reinterpret_cast<const float4*>(s0)[q];
        S[q * 4] = v.x; S[q * 4 + 1] = v.y; S[q * 4 + 2] = v.z; S[q * 4 + 3] = v.w;
      }
    } else {
#pragma unroll
      for (int q = 0; q < 64; ++q) S[q] = 0.f;
    }
    for (int t0 = 0; t0 < Tlen; t0 += 8) {
      float vreg[8];
      __builtin_amdgcn_wave_barrier();
#pragma unroll
      for (int tt = 0; tt < 8; ++tt) {
        const int t = t0 + tt;
        const int row = base + (z == 0 ? t : (Tlen - 1 - t));
        const size_t o = (size_t)row * DM + colb + lane;
        float r = bf2f(rb[o]), k = bf2f(kb[o]), kk = bf2f(kkb[o]);
        vreg[tt] = bf2f(vb[o]);
        float a = bf2f(aa[(size_t)z * TT * DM + o]);
        float wd = wdec[(size_t)z * TT * DM + o];
        float* l = lds + tt * 320;
        l[lane] = r; l[64 + lane] = wd; l[128 + lane] = k * (1.0f + (a - 1.0f) * kal); l[192 + lane] = kk; l[256 + lane] = kk * a;
      }
      __builtin_amdgcn_wave_barrier();
#pragma unroll 1
      for (int tt = 0; tt < 8; ++tt) {
        const float* l = lds + tt * 320;
        const float vi = vreg[0];
        float skk = 0.f;
#pragma unroll
        for (int q = 0; q < 16; ++q) {
          float4 kk4 = reinterpret_cast<const float4*>(l + 192)[q];
          skk += S[q * 4] * kk4.x + S[q * 4 + 1] * kk4.y + S[q * 4 + 2] * kk4.z + S[q * 4 + 3] * kk4.w;
        }
        float y = 0.f;
#pragma unroll
        for (int q = 0; q < 16; ++q) {
          float4 w4 = reinterpret_cast<const float4*>(l + 64)[q];
          float4 k4 = reinterpret_cast<const float4*>(l + 128)[q];
          float4 a4 = reinterpret_cast<const float4*>(l + 256)[q];
          float4 r4 = reinterpret_cast<const float4*>(l)[q];
          S[q * 4 + 0] = S[q * 4 + 0] * w4.x + (vi * k4.x - skk * a4.x);
          S[q * 4 + 1] = S[q * 4 + 1] * w4.y + (vi * k4.y - skk * a4.y);
          S[q * 4 + 2] = S[q * 4 + 2] * w4.z + (vi * k4.z - skk * a4.z);
          S[q * 4 + 3] = S[q * 4 + 3] * w4.w + (vi * k4.w - skk * a4.w);
          y += S[q * 4] * r4.x + S[q * 4 + 1] * r4.y + S[q * 4 + 2] * r4.z + S[q * 4 + 3] * r4.w;
        }
        const int t = t0 + tt;
        const int row = base + (z == 0 ? t : (Tlen - 1 - t));
        yout[((size_t)z * TT + row) * DM + colb + lane] = y;
#pragma unroll
        for (int q = 0; q < 7; ++q) vreg[q] = vreg[q + 1];
      }
    }
    if (seq < 16) {
      float* so = p.out + OUT_STATE + ((((size_t)seq * 2 + j) * 2 + z) * 16 + h) * 4096 + (size_t)lane * 64;
#pragma unroll
      for (int q = 0; q < 16; ++q) reinterpret_cast<float4*>(so)[q] = make_float4(S[q * 4], S[q * 4 + 1], S[q * 4 + 2], S[q * 4 + 3]);
    }
  }
}

DEVINL void phase_r5(const Params& p, int layer, int w, int nw) {
  const int j = layer >> 1;
  const int lane = tidx() & 63;
  const int gw = w * NWAVES + (tidx() >> 6), ngw = nw * NWAVES;
  const bf16_t* rb = reinterpret_cast<const bf16_t*>(p.U2);
  const bf16_t* kb = rb + (size_t)TT * DM;
  const bf16_t* vb = kb + (size_t)TT * DM;
  const bf16_t* aa = reinterpret_cast<const bf16_t*>(p.U1 + U1_AA_OFF);
  const bf16_t* gg = reinterpret_cast<const bf16_t*>(p.U1 + U1_GG_OFF);
  const float* yin = reinterpret_cast<const float*>(p.U3);
  const float* ka = p.in[23] + j * 1024;
  const float* rk = p.in[24] + j * 1024;
  const float* lg = p.in[25] + j * 1024;
  const float* lb = p.in[26] + j * 1024;
  for (int row = gw; row < TT; row += ngw) {
#pragma unroll
    for (int k = 0; k < 4; ++k) {
      const int col = k * 256 + lane * 4;
      const size_t o = (size_t)row * DM + col;
      const float4 yf = *reinterpret_cast<const float4*>(yin + o);
      const float4 yb = *reinterpret_cast<const float4*>(yin + (size_t)TT * DM + o);
      const uint2 r2 = *reinterpret_cast<const uint2*>(rb + o);
      const uint2 k2 = *reinterpret_cast<const uint2*>(kb + o);
      const uint2 v2 = *reinterpret_cast<const uint2*>(vb + o);
      const uint2 a02 = *reinterpret_cast<const uint2*>(aa + o);
      const uint2 a12 = *reinterpret_cast<const uint2*>(aa + (size_t)TT * DM + o);
      const uint2 g2 = *reinterpret_cast<const uint2*>(gg + o);
      const float4 ka4 = *reinterpret_cast<const float4*>(ka + col);
      const float4 rk4 = *reinterpret_cast<const float4*>(rk + col);
      const float4 lg4 = *reinterpret_cast<const float4*>(lg + col);
      const float4 lb4 = *reinterpret_cast<const float4*>(lb + col);
      float y[4] = {yf.x + yb.x, yf.y + yb.y, yf.z + yb.z, yf.w + yb.w};
      float r[4] = {bflo(r2.x), bfhi(r2.x), bflo(r2.y), bfhi(r2.y)};
      float kx[4] = {bflo(k2.x), bfhi(k2.x), bflo(k2.y), bfhi(k2.y)};
      float v[4] = {bflo(v2.x), bfhi(v2.x), bflo(v2.y), bfhi(v2.y)};
      float a0[4] = {bflo(a02.x), bfhi(a02.x), bflo(a02.y), bfhi(a02.y)};
      float a1[4] = {bflo(a12.x), bfhi(a12.x), bflo(a12.y), bfhi(a12.y)};
      float g[4] = {bflo(g2.x), bfhi(g2.x), bflo(g2.y), bfhi(g2.y)};
      float kav[4] = {ka4.x, ka4.y, ka4.z, ka4.w}, rkv[4] = {rk4.x, rk4.y, rk4.z, rk4.w};
      float lgv[4] = {lg4.x, lg4.y, lg4.z, lg4.w}, lbv[4] = {lb4.x, lb4.y, lb4.z, lb4.w};
      float sm = y[0] + y[1] + y[2] + y[3];
      sm = grp16_sum(sm);
      const float mean = sm * (1.0f / 64.0f);
      float sv = 0.f, sb = 0.f;
#pragma unroll
      for (int e = 0; e < 4; ++e) {
        float d = y[e] - mean; sv += d * d;
        float kd0 = kx[e] * (1.0f + (a0[e] - 1.0f) * kav[e]);
        float kd1 = kx[e] * (1.0f + (a1[e] - 1.0f) * kav[e]);
        sb += r[e] * (kd0 + kd1) * rkv[e];
      }
      sv = grp16_sum(sv); sb = grp16_sum(sb);
      const float rstd = rsqrtf(sv * (1.0f / 64.0f) + GN_EPS_F);
      float o4[4];
#pragma unroll
      for (int e = 0; e < 4; ++e) {
        float yn = (y[e] - mean) * rstd * lgv[e] + lbv[e];
        o4[e] = (yn + sb * v[e]) * g[e];
      }
      uint2 oo; oo.x = pack2(o4[0], o4[1]); oo.y = pack2(o4[2], o4[3]);
      *reinterpret_cast<uint2*>(p.abuf + o) = oo;
    }
  }
}

struct EpiWO {
  static constexpr bool PERM = false;
  const float* x; const float* mod; float* z; int layer;
  DEVINL void operator()(const f32x4 (&acc)[2][2][4][2], const pg8::Unit& u, int wr, int wc, int fr, int fq) const {
    const int row0 = u.pm * 256 + wr * 64 + fr, col0 = u.pn * 256 + wc * 32 + 4 * fq;
    const float* gate = mod + ((size_t)layer * 9 + cond_of_row(u.pm * 256)) * 6144 + 2 * 1024;
    f32x4 gv[2][2];
#pragma unroll
    for (int bj = 0; bj < 2; ++bj)
#pragma unroll
      for (int n = 0; n < 2; ++n) gv[bj][n] = *reinterpret_cast<const f32x4*>(gate + col0 + bj * 128 + n * 16);
#pragma unroll
    for (int ai = 0; ai < 2; ++ai)
#pragma unroll
      for (int m = 0; m < 4; ++m) {
        const size_t off = (size_t)(row0 + ai * 128 + m * 16) * DM + col0;
#pragma unroll
        for (int bj = 0; bj < 2; ++bj)
#pragma unroll
          for (int n = 0; n < 2; ++n) {
            const f32x4 xv = *reinterpret_cast<const f32x4*>(x + off + bj * 128 + n * 16);
            *reinterpret_cast<f32x4*>(z + off + bj * 128 + n * 16) = ALPHA_F * xv + gv[bj][n] * acc[ai][bj][m][n];
          }
        asm volatile("" ::: "memory");
      }
  }
};
DEVINL void phase_wo(const Params& p, int layer, int w, int nw, char* smem) {
  const int j = layer >> 1;
  const bf16_t* Wt = ((layer & 1) ? p.attn_wo_t : p.rwkv_wo_t) + ((size_t)j << 20);
  EpiWO E; E.x = p.xbuf; E.mod = p.mod; E.z = p.zbuf; E.layer = layer;
  pg8::ASelOne as; as.A = (const char*)p.abuf;
  pg8::StaticOrder S; S.init(TT, 1024, nw, w);
  pg8::gemm_phase<EpiWO, pg8::ASelOne>((PG8_LAS unsigned char*)smem, as, Wt, 1024, S, E);
}

DEVINL void phase_ln1(const Params& p, int layer, int w, int nw) {
  const int lane = tidx() & 63;
  const int gw = w * NWAVES + (tidx() >> 6), ngw = nw * NWAVES;
  const float* lng = p.in[9] + (size_t)(layer * 2 + 0) * 1024;
  const float* lnb = p.in[10] + (size_t)(layer * 2 + 0) * 1024;
  for (int row = gw; row < TT; row += ngw) {
    const float* md = p.mod + ((size_t)layer * 9 + cond_of_row(row)) * 6144;
    float4 z[4];
    float s = 0.f;
#pragma unroll
    for (int k = 0; k < 4; ++k) {
      z[k] = *reinterpret_cast<const float4*>(p.zbuf + (size_t)row * DM + k * 256 + lane * 4);
      s += z[k].x + z[k].y + z[k].z + z[k].w;
    }
    const float mean = wave_sum(s) * (1.0f / 1024.0f);
    float sv = 0.f;
#pragma unroll
    for (int k = 0; k < 4; ++k) {
      float a = z[k].x - mean, b = z[k].y - mean, c = z[k].z - mean, d = z[k].w - mean;
      sv += a * a + b * b + c * c + d * d;
    }
    const float rstd = rsqrtf(wave_sum(sv) * (1.0f / 1024.0f) + LN_EPS_F);
#pragma unroll
    for (int k = 0; k < 4; ++k) {
      const int col = k * 256 + lane * 4;
      const float4 g4 = *reinterpret_cast<const float4*>(lng + col);
      const float4 b4 = *reinterpret_cast<const float4*>(lnb + col);
      const float4 sh = *reinterpret_cast<const float4*>(md + 3 * 1024 + col);
      const float4 sc = *reinterpret_cast<const float4*>(md + 4 * 1024 + col);
      float4 x1;
      x1.x = (z[k].x - mean) * rstd * g4.x + b4.x;
      x1.y = (z[k].y - mean) * rstd * g4.y + b4.y;
      x1.z = (z[k].z - mean) * rstd * g4.z + b4.z;
      x1.w = (z[k].w - mean) * rstd * g4.w + b4.w;
      *reinterpret_cast<float4*>(p.xbuf + (size_t)row * DM + col) = x1;
      uint2 o;
      o.x = pack2(x1.x * (1.0f + sc.x) + sh.x, x1.y * (1.0f + sc.y) + sh.y);
      o.y = pack2(x1.z * (1.0f + sc.z) + sh.z, x1.w * (1.0f + sc.w) + sh.w);
      *reinterpret_cast<uint2*>(p.hbuf + (size_t)row * DM + col) = o;
    }
  }
}

struct EpiBf16 {
  static constexpr bool PERM = true;
  bf16_t* O; int ldc;
  DEVINL void operator()(const f32x4 (&acc)[2][2][4][2], const pg8::Unit& u, int wr, int wc, int fr, int fq) const {
    const int row0 = u.pm * 256 + wr * 64 + fr, col0 = u.pn * 256 + wc * 32 + 8 * fq;
#pragma unroll
    for (int ai = 0; ai < 2; ++ai)
#pragma unroll
      for (int m = 0; m < 4; ++m) {
        bf16_t* rowp = O + (size_t)(row0 + ai * 128 + m * 16) * ldc + col0;
#pragma unroll
        for (int bj = 0; bj < 2; ++bj) {
          const f32x4 v0 = acc[ai][bj][m][0], v1 = acc[ai][bj][m][1];
          pg8::u32x4 o; o.x = pg8::cvt_pk_bf16(v0[0], v0[1]); o.y = pg8::cvt_pk_bf16(v0[2], v0[3]); o.z = pg8::cvt_pk_bf16(v1[0], v1[1]); o.w = pg8::cvt_pk_bf16(v1[2], v1[3]);
          *reinterpret_cast<pg8::u32x4*>(rowp + bj * 128) = o;
        }
      }
  }
};

DEVINL void phase_p1(const Params& p, int layer, int w, int nw, char* smem) {
  EpiBf16 E; E.O = reinterpret_cast<bf16_t*>(p.U1); E.ldc = 2048;
  pg8::ASelOne as; as.A = (const char*)p.hbuf;
  pg8::StaticOrder S; S.init(TT, 2048, nw, w);
  pg8::gemm_phase<EpiBf16, pg8::ASelOne>((PG8_LAS unsigned char*)smem, as, p.wq_t + (size_t)layer * 2048 * 1024, 1024, S, E);
}

#define U1_S_OFF ((size_t)TT * 2048 * 2)
DEVINL void phase_p2(const Params& p, int layer, int w, int nw, char* smem) {
  GEMM_LANE_VARS
  const int half = tidx() >> 8;
  char* sh = smem + half * 16384;
  const bf16_t* qb = reinterpret_cast<const bf16_t*>(p.U1);
  float* sb = reinterpret_cast<float*>(p.U1 + U1_S_OFF);
  const int NTILES = 96 * 16;
  for (int it = 0; it * nw * 2 < NTILES; ++it) {
    int tile = (it * nw + w) * 2 + half;
    const bool valid = tile < NTILES;
    if (!valid) tile = 0;
    const int ct = tile / 96, rt = tile % 96;
    const int row0 = rt * 128;
    const int z = ct & 1;
    f32x4 acc[4][4];
    gemm_tile_128(qb + (size_t)row0 * 2048 + ct * 128, 2048, p.keysb + (size_t)(layer * 2 + z) * 16384, 128, 128, sh, acc);
    if (valid) {
#pragma unroll
      for (int m = 0; m < 4; ++m)
#pragma unroll
        for (int n = 0; n < 4; ++n)
#pragma unroll
          for (int jj = 0; jj < 4; ++jj) {
            int row = row0 + wr * 64 + m * 16 + fq * 4 + jj, col = wc * 64 + n * 16 + fr;
            sb[(size_t)row * 2048 + ct * 128 + col] = acc[m][n][jj];
          }
    }
  }
}

DEVINL void phase_p3(const Params& p, int layer, int w, int nw, char* smem) {
  const int lane = tidx() & 63, wid = tidx() >> 6;
  const int gw = w * NWAVES + wid, ngw = nw * NWAVES;
  const float* sb = reinterpret_cast<const float*>(p.U1 + U1_S_OFF);
  float* svl = reinterpret_cast<float*>(smem) + wid * 64;
  int* sil = reinterpret_cast<int*>(smem) + 512 + wid * 64;
  for (int t = gw; t < TT; t += ngw) {
    for (int h = 0; h < 8; ++h) {
      __builtin_amdgcn_wave_barrier();
#pragma unroll 1
      for (int z = 0; z < 2; ++z) {
        const float* sp = sb + (size_t)t * 2048 + (h * 2 + z) * 128;
        const float s0 = sp[lane], s1 = sp[lane + 64];
        unsigned k0 = (ordf(s0) & ~127u) | (unsigned)(127 - lane);
        unsigned k1 = (ordf(s1) & ~127u) | (unsigned)(63 - lane);
        int myidx = 0;
#pragma unroll 1
        for (int it = 0; it < 16; ++it) {
          unsigned m = wave_max_u(k0 > k1 ? k0 : k1);
          int idx = 127 - (int)(m & 127u);
          if (lane == it) myidx = idx;
          if (k0 == m) k0 = 0;
          if (k1 == m) k1 = 0;
        }
        if (lane < 16) { svl[z * 16 + lane] = sp[myidx]; sil[z * 16 + lane] = myidx; }
      }
      __builtin_amdgcn_wave_barrier();
      unsigned kc[4];
#pragma unroll
      for (int c = 0; c < 4; ++c) {
        int ci = lane * 4 + c;
        float sum = svl[ci >> 4] + svl[16 + (ci & 15)];
        kc[c] = (ordf(sum) & ~255u) | (unsigned)(255 - ci);
      }
      int myci = 0;
#pragma unroll 1
      for (int it = 0; it < 16; ++it) {
        unsigned a = kc[0] > kc[1] ? kc[0] : kc[1], b = kc[2] > kc[3] ? kc[2] : kc[3];
        unsigned m = wave_max_u(a > b ? a : b);
        int ci = 255 - (int)(m & 255u);
        if (lane == it) myci = ci;
#pragma unroll
        for (int c = 0; c < 4; ++c) if (kc[c] == m) kc[c] = 0;
      }
      const int ii = (myci >> 4) & 15, jj = myci & 15;
      float cv = svl[ii] + svl[16 + jj];
      int e = sil[ii] * 128 + sil[16 + jj];
      float mx = cv;
#pragma unroll
      for (int o = 8; o > 0; o >>= 1) mx = fmaxf(mx, __shfl_xor(mx, o));
      float ex = __expf(cv - mx);
      float sm = grp16_sum(ex);
      if (lane < 16) {
        p.pidx[(size_t)t * 128 + h * 16 + lane] = e;
        p.pgate[(size_t)t * 128 + h * 16 + lane] = ex / sm;
      }
    }
  }
}

DEVINL float gelu_exact(float x) { return 0.5f * x * (1.0f + erff(x * 0.7071067811865476f)); }

DEVINL void phase_p4(const Params& p, int layer, int w, int nw, char* smem) {
  const int tid = tidx(), lane = tid & 63, wid = tid >> 6;
  const int fr = lane & 15, fq = lane >> 4;
  const int gw = w * NWAVES + wid, ngw = nw * NWAVES;
  const bf16_t* U = p.ub + (size_t)layer * 16384 * 1024;
  const bf16_t* V = p.vb + (size_t)layer * 16384 * 1024;
  const float* lng = p.in[9] + (size_t)(layer * 2 + 1) * 1024;
  const float* lnb = p.in[10] + (size_t)(layer * 2 + 1) * 1024;
  float* xout = (layer == 3) ? p.out : p.xbuf;
  char* wl = smem + wid * 3072;
  bf16_t* xl = reinterpret_cast<bf16_t*>(wl);
  float* wgt = reinterpret_cast<float*>(wl + 2048);
  int* il = reinterpret_cast<int*>(wl + 2560);
  for (int t = gw; t < TT; t += ngw) {
    __builtin_amdgcn_wave_barrier();
    {
      const uint4 a = *reinterpret_cast<const uint4*>(p.hbuf + (size_t)t * DM + lane * 8);
      const uint4 b = *reinterpret_cast<const uint4*>(p.hbuf + (size_t)t * DM + 512 + lane * 8);
      *reinterpret_cast<uint4*>(xl + lane * 8) = a;
      *reinterpret_cast<uint4*>(xl + 512 + lane * 8) = b;
      il[lane] = p.pidx[(size_t)t * 128 + lane];
      il[64 + lane] = p.pidx[(size_t)t * 128 + 64 + lane];
    }
    __builtin_amdgcn_wave_barrier();
    const bf16_t* up[8];
#pragma unroll
    for (int g = 0; g < 8; ++g) up[g] = U + (size_t)il[g * 16 + fr] * DM + fq * 8;
    f32x4 acc[8];
#pragma unroll
    for (int g = 0; g < 8; ++g) acc[g] = (f32x4){0.f, 0.f, 0.f, 0.f};
#pragma unroll 2
    for (int s = 0; s < 32; ++s) {
      const bf16x8 xf = *reinterpret_cast<const bf16x8*>(xl + s * 32 + fq * 8);
      bf16x8 a[8];
#pragma unroll
      for (int g = 0; g < 8; ++g) a[g] = *reinterpret_cast<const bf16x8*>(up[g] + s * 32);
#pragma unroll
      for (int g = 0; g < 8; ++g) acc[g] = __builtin_amdgcn_mfma_f32_16x16x32_bf16(a[g], xf, acc[g], 0, 0, 0);
    }
#pragma unroll
    for (int g = 0; g < 8; ++g) {
      const float4 gt = *reinterpret_cast<const float4*>(p.pgate + (size_t)t * 128 + g * 16 + fq * 4);
      float4 wv;
      wv.x = gt.x * gelu_exact(acc[g][0]);
      wv.y = gt.y * gelu_exact(acc[g][1]);
      wv.z = gt.z * gelu_exact(acc[g][2]);
      wv.w = gt.w * gelu_exact(acc[g][3]);
      if (fr == 0) *reinterpret_cast<float4*>(wgt + g * 16 + fq * 4) = wv;
    }
    __builtin_amdgcn_wave_barrier();
    float f[16];
#pragma unroll
    for (int e = 0; e < 16; ++e) f[e] = 0.f;
#pragma unroll 8
    for (int e = 0; e < 128; ++e) {
      const int idx = __builtin_amdgcn_readfirstlane(il[e]);
      const float we = wgt[e];
      const bf16_t* vp = V + (size_t)idx * DM;
      const uint4 c = *reinterpret_cast<const uint4*>(vp + lane * 8);
      const uint4 dd = *reinterpret_cast<const uint4*>(vp + 512 + lane * 8);
      f[0] += we * bflo(c.x); f[1] += we * bfhi(c.x); f[2] += we * bflo(c.y); f[3] += we * bfhi(c.y);
      f[4] += we * bflo(c.z); f[5] += we * bfhi(c.z); f[6] += we * bflo(c.w); f[7] += we * bfhi(c.w);
      f[8] += we * bflo(dd.x); f[9] += we * bfhi(dd.x); f[10] += we * bflo(dd.y); f[11] += we * bfhi(dd.y);
      f[12] += we * bflo(dd.z); f[13] += we * bfhi(dd.z); f[14] += we * bflo(dd.w); f[15] += we * bfhi(dd.w);
    }
    const float* md = p.mod + ((size_t)layer * 9 + cond_of_row(t)) * 6144 + 5 * 1024;
    float zz[16];
    float s = 0.f;
#pragma unroll
    for (int hf = 0; hf < 2; ++hf) {
      const int col = hf * 512 + lane * 8;
      const float4 x0 = *reinterpret_cast<const float4*>(p.xbuf + (size_t)t * DM + col);
      const float4 x1 = *reinterpret_cast<const float4*>(p.xbuf + (size_t)t * DM + col + 4);
      const float4 g0 = *reinterpret_cast<const float4*>(md + col);
      const float4 g1 = *reinterpret_cast<const float4*>(md + col + 4);
      const float xv[8] = {x0.x, x0.y, x0.z, x0.w, x1.x, x1.y, x1.z, x1.w};
      const float gv[8] = {g0.x, g0.y, g0.z, g0.w, g1.x, g1.y, g1.z, g1.w};
#pragma unroll
      for (int e = 0; e < 8; ++e) { zz[hf * 8 + e] = ALPHA_F * xv[e] + gv[e] * f[hf * 8 + e]; s += zz[hf * 8 + e]; }
    }
    const float mean = wave_sum(s) * (1.0f / 1024.0f);
    float sv = 0.f;
#pragma unroll
    for (int e = 0; e < 16; ++e) { float d = zz[e] - mean; sv += d * d; }
    const float rstd = rsqrtf(wave_sum(sv) * (1.0f / 1024.0f) + LN_EPS_F);
#pragma unroll
    for (int hf = 0; hf < 2; ++hf) {
      const int col = hf * 512 + lane * 8;
      const float4 g0 = *reinterpret_cast<const float4*>(lng + col);
      const float4 g1 = *reinterpret_cast<const float4*>(lng + col + 4);
      const float4 b0 = *reinterpret_cast<const float4*>(lnb + col);
      const float4 b1 = *reinterpret_cast<const float4*>(lnb + col + 4);
      float4 o0, o1;
      o0.x = (zz[hf * 8 + 0] - mean) * rstd * g0.x + b0.x;
      o0.y = (zz[hf * 8 + 1] - mean) * rstd * g0.y + b0.y;
      o0.z = (zz[hf * 8 + 2] - mean) * rstd * g0.z + b0.z;
      o0.w = (zz[hf * 8 + 3] - mean) * rstd * g0.w + b0.w;
      o1.x = (zz[hf * 8 + 4] - mean) * rstd * g1.x + b1.x;
      o1.y = (zz[hf * 8 + 5] - mean) * rstd * g1.y + b1.y;
      o1.z = (zz[hf * 8 + 6] - mean) * rstd * g1.z + b1.z;
      o1.w = (zz[hf * 8 + 7] - mean) * rstd * g1.w + b1.w;
      *reinterpret_cast<float4*>(xout + (size_t)t * DM + col) = o0;
      *reinterpret_cast<float4*>(xout + (size_t)t * DM + col + 4) = o1;
    }
  }
}

DEVINL void phase_a1(const Params& p, int layer, int w, int nw) {
  const int lane = tidx() & 63;
  const int gw = w * NWAVES + (tidx() >> 6), ngw = nw * NWAVES;
  for (int row = gw; row < TT; row += ngw) {
    const float* md = p.mod + ((size_t)layer * 9 + cond_of_row(row)) * 6144;
#pragma unroll
    for (int k = 0; k < 4; ++k) {
      const int col = k * 256 + lane * 4;
      const float4 x = *reinterpret_cast<const float4*>(p.xbuf + (size_t)row * DM + col);
      const float4 sh = *reinterpret_cast<const float4*>(md + col);
      const float4 sc = *reinterpret_cast<const float4*>(md + 1024 + col);
      uint2 o;
      o.x = pack2(x.x * (1.0f + sc.x) + sh.x, x.y * (1.0f + sc.y) + sh.y);
      o.y = pack2(x.z * (1.0f + sc.z) + sh.z, x.w * (1.0f + sc.w) + sh.w);
      *reinterpret_cast<uint2*>(p.hbuf + (size_t)row * DM + col) = o;
    }
  }
}

DEVINL void phase_a2(const Params& p, int layer, int w, int nw, char* smem) {
  const int j = layer >> 1;
  EpiBf16 E; E.O = reinterpret_cast<bf16_t*>(p.U1); E.ldc = 1536;
  pg8::ASelOne as; as.A = (const char*)p.hbuf;
  pg8::StaticOrder S; S.init(TT, 1536, nw, w);
  pg8::gemm_phase<EpiBf16, pg8::ASelOne>((PG8_LAS unsigned char*)smem, as, p.attn_wqkv_t + (size_t)j * 1536 * 1024, 1024, S, E);
}

DEVINL void load16(const bf16_t* src, float (&x)[16]) {
  const uint4 a = *reinterpret_cast<const uint4*>(src);
  const uint4 b = *reinterpret_cast<const uint4*>(src + 8);
  x[0] = bflo(a.x); x[1] = bfhi(a.x); x[2] = bflo(a.y); x[3] = bfhi(a.y); x[4] = bflo(a.z); x[5] = bfhi(a.z); x[6] = bflo(a.w); x[7] = bfhi(a.w);
  x[8] = bflo(b.x); x[9] = bfhi(b.x); x[10] = bflo(b.y); x[11] = bfhi(b.y); x[12] = bflo(b.z); x[13] = bfhi(b.z); x[14] = bflo(b.w); x[15] = bfhi(b.w);
}
DEVINL void store16bf(bf16_t* dst, const float (&x)[16]) {
  uint4 a, b;
  a.x = pack2(x[0], x[1]); a.y = pack2(x[2], x[3]); a.z = pack2(x[4], x[5]); a.w = pack2(x[6], x[7]);
  b.x = pack2(x[8], x[9]); b.y = pack2(x[10], x[11]); b.z = pack2(x[12], x[13]); b.w = pack2(x[14], x[15]);
  *reinterpret_cast<uint4*>(dst) = a; *reinterpret_cast<uint4*>(dst + 8) = b;
}
DEVINL void headnorm_rope(float (&x)[16], const float* nwgt, int quarter, bool lat, int t, const float* rope) {
  float ss = 0.f;
#pragma unroll
  for (int e = 0; e < 16; ++e) ss += x[e] * x[e];
  ss += __shfl_xor(ss, 1); ss += __shfl_xor(ss, 2);
  const float rinv = rsqrtf(ss * (1.0f / 64.0f) + RMS_EPS_F);
#pragma unroll
  for (int e = 0; e < 16; ++e) x[e] = x[e] * rinv * nwgt[quarter * 16 + e];
  if (lat) {
    const int pos = (quarter < 2) ? (t >> 6) : (t & 63);
    const bool hi = quarter & 1;
#pragma unroll
    for (int e = 0; e < 16; ++e) {
      const float other = __shfl_xor(x[e], 1);
      const float c = rope[(pos * 16 + e) * 2], s = rope[(pos * 16 + e) * 2 + 1];
      x[e] = hi ? (x[e] * c + other * s) : (x[e] * c - other * s);
    }
  }
}

DEVINL void phase_a2b(const Params& p, int layer, int w, int nw) {
  const int j = layer >> 1;
  const int lane = tidx() & 63;
  const int gw = w * NWAVES + (tidx() >> 6), ngw = nw * NWAVES;
  const bf16_t* qkv = reinterpret_cast<const bf16_t*>(p.U1);
  bf16_t* qb = reinterpret_cast<bf16_t*>(p.U2);
  const float* qn = p.in[29] + j * 64;
  const float* kn = p.in[30] + j * 64;
  for (int row = gw; row < TT; row += ngw) {
    const bool lat = row >= TCTX;
    const int t = lat ? ((row - TCTX) & 1023) : (row & 255);
    const int b = lat ? ((row - TCTX) >> 10) : (row >> 8);
    const bf16_t* src = qkv + (size_t)row * 1536;
    {
      float x[16];
      load16(src + lane * 16, x);
      headnorm_rope(x, qn, lane & 3, lat, t, p.rope);
#pragma unroll
      for (int e = 0; e < 16; ++e) x[e] *= QSCALE_F;
      store16bf(qb + (size_t)row * DM + lane * 16, x);
    }
    if (lane < 16) {
      const int kvh = lane >> 2, quarter = lane & 3;
      float x[16];
      load16(src + 1024 + lane * 16, x);
      headnorm_rope(x, kn, quarter, false, t, p.rope);
      if (lat) {
        const int pos = (quarter < 2) ? (t >> 6) : (t & 63);
        const bool hi = quarter & 1;
#pragma unroll
        for (int e = 0; e < 16; ++e) {
          const float other = __shfl_xor(x[e], 1);
          const float c = p.rope[(pos * 16 + e) * 2], s = p.rope[(pos * 16 + e) * 2 + 1];
          x[e] = hi ? (x[e] * c + other * s) : (x[e] * c - other * s);
        }
        store16bf(p.Klat + ((size_t)((j * 8 + b) * 4 + kvh) * 1536 + 512 + t) * 64 + quarter * 16, x);
      } else {
        store16bf(p.Kctx + ((size_t)((j * 16 + b) * 4 + kvh) * 256 + t) * 64 + quarter * 16, x);
        float* ko = p.out + OUT_CK + ((size_t)(b * 2 + j) * 256 + t) * 256 + kvh * 64 + quarter * 16;
#pragma unroll
        for (int q4 = 0; q4 < 4; ++q4) reinterpret_cast<float4*>(ko)[q4] = make_float4(x[q4 * 4], x[q4 * 4 + 1], x[q4 * 4 + 2], x[q4 * 4 + 3]);
      }
    } else if (lane < 32) {
      const int l2 = lane - 16;
      const int kvh = l2 >> 2, quarter = l2 & 3;
      float x[16];
      load16(src + 1280 + l2 * 16, x);
      if (lat) {
        bf16_t* vd = p.VlatT + (size_t)((j * 8 + b) * 4 + kvh) * 64 * 1536 + 512 + t;
#pragma unroll
        for (int e = 0; e < 16; ++e) vd[(size_t)(quarter * 16 + e) * 1536] = f2bf(x[e]);
      } else {
        bf16_t* vd = p.VctxT + (size_t)((j * 16 + b) * 4 + kvh) * 64 * 256 + t;
#pragma unroll
        for (int e = 0; e < 16; ++e) vd[(size_t)(quarter * 16 + e) * 256] = f2bf(x[e]);
        float* vo = p.out + OUT_CV + ((size_t)(b * 2 + j) * 256 + t) * 256 + kvh * 64 + quarter * 16;
#pragma unroll
        for (int q4 = 0; q4 < 4; ++q4) reinterpret_cast<float4*>(vo)[q4] = make_float4(x[q4 * 4], x[q4 * 4 + 1], x[q4 * 4 + 2], x[q4 * 4 + 3]);
      }
    }
  }
}

DEVINL void phase_a3(const Params& p, int layer, int w, int nw) {
  const int j = layer >> 1;
  const int lane = tidx() & 63, wid = tidx() >> 6;
  const int ql = lane & 31, hh = lane >> 5;
  const bf16_t* qb = reinterpret_cast<const bf16_t*>(p.U2);
  for (int item = w; item < 768; item += nw) {
    int hq, Tk, row0;
    const bf16_t *Kb, *Vt;
    if (item < 512) {
      const int b = item >> 6, qblk = item & 3;
      hq = (item >> 2) & 15;
      const int kvh = hq >> 2;
      Kb = p.Klat + (size_t)((j * 8 + b) * 4 + kvh) * 1536 * 64;
      Vt = p.VlatT + (size_t)((j * 8 + b) * 4 + kvh) * 64 * 1536;
      Tk = 1536; row0 = TCTX + b * 1024 + qblk * 256;
    } else {
      const int it = item - 512;
      const int b = it >> 4;
      hq = it & 15;
      const int kvh = hq >> 2;
      Kb = p.Kctx + (size_t)((j * 16 + b) * 4 + kvh) * 256 * 64;
      Vt = p.VctxT + (size_t)((j * 16 + b) * 4 + kvh) * 64 * 256;
      Tk = 256; row0 = b * 256;
    }
    const int qrow = row0 + wid * 32 + ql;
    bf16x8 bq[4];
#pragma unroll
    for (int ks = 0; ks < 4; ++ks) bq[ks] = *reinterpret_cast<const bf16x8*>(qb + (size_t)qrow * DM + hq * 64 + ks * 16 + hh * 8);
    f32x16 o0, o1;
#pragma unroll
    for (int r = 0; r < 16; ++r) { o0[r] = 0.f; o1[r] = 0.f; }
    float mrun = -1e30f, lrun = 0.f;
    for (int kt = 0; kt < Tk; kt += 32) {
      f32x16 sacc;
#pragma unroll
      for (int r = 0; r < 16; ++r) sacc[r] = 0.f;
#pragma unroll
      for (int ks = 0; ks < 4; ++ks) {
        bf16x8 ka = *reinterpret_cast<const bf16x8*>(Kb + (size_t)(kt + ql) * 64 + ks * 16 + hh * 8);
        sacc = __builtin_amdgcn_mfma_f32_32x32x16_bf16(ka, bq[ks], sacc, 0, 0, 0);
      }
      float tmax = sacc[0];
#pragma unroll
      for (int r = 1; r < 16; ++r) tmax = fmaxf(tmax, sacc[r]);
      tmax = fmaxf(tmax, __shfl_xor(tmax, 32));
      const float mnew = fmaxf(mrun, tmax);
      const float corr = exp2f(mrun - mnew);
      mrun = mnew;
      lrun *= corr;
#pragma unroll
      for (int r = 0; r < 16; ++r) { o0[r] *= corr; o1[r] *= corr; }
      float pv[16];
#pragma unroll
      for (int r = 0; r < 16; ++r) { pv[r] = exp2f(sacc[r] - mnew); lrun += pv[r]; }
#pragma unroll
      for (int s2 = 0; s2 < 2; ++s2) {
        union { bf16x8 v; unsigned u[4]; } pb;
#pragma unroll
        for (int q = 0; q < 4; ++q) pb.u[q] = pack2(pv[s2 * 8 + q * 2], pv[s2 * 8 + q * 2 + 1]);
#pragma unroll
        for (int dblk = 0; dblk < 2; ++dblk) {
          const bf16_t* vp = Vt + (size_t)(dblk * 32 + ql) * Tk + kt + 16 * s2 + 4 * hh;
          const uint2 lo = *reinterpret_cast<const uint2*>(vp);
          const uint2 hi = *reinterpret_cast<const uint2*>(vp + 8);
          union { bf16x8 v; unsigned u[4]; } va;
          va.u[0] = lo.x; va.u[1] = lo.y; va.u[2] = hi.x; va.u[3] = hi.y;
          if (dblk == 0) o0 = __builtin_amdgcn_mfma_f32_32x32x16_bf16(va.v, pb.v, o0, 0, 0, 0);
          else o1 = __builtin_amdgcn_mfma_f32_32x32x16_bf16(va.v, pb.v, o1, 0, 0, 0);
        }
      }
    }
    const float ltot = lrun + __shfl_xor(lrun, 32);
    const float inv = 1.0f / ltot;
#pragma unroll
    for (int g = 0; g < 4; ++g) {
      uint2 oa, ob;
      oa.x = pack2(o0[4 * g] * inv, o0[4 * g + 1] * inv); oa.y = pack2(o0[4 * g + 2] * inv, o0[4 * g + 3] * inv);
      ob.x = pack2(o1[4 * g] * inv, o1[4 * g + 1] * inv); ob.y = pack2(o1[4 * g + 2] * inv, o1[4 * g + 3] * inv);
      *reinterpret_cast<uint2*>(p.abuf + (size_t)qrow * DM + hq * 64 + 8 * g + 4 * hh) = oa;
      *reinterpret_cast<uint2*>(p.abuf + (size_t)qrow * DM + hq * 64 + 32 + 8 * g + 4 * hh) = ob;
    }
  }
}

#define XB_TMO      128
#define XB_XCNT(j)  (256  + 64 * (j))
#define XB_XSUB(j)  (1280 + 64 * (j))
#define XB_XGEN(j)  (2304 + 64 * (j))
#define XB_TOP      3328
#define XB_TOPGEN   3392
#define XCD_BAR_WORDS 3456
#define XB_SPIN_CAP (1u << 22)
#define LAS __attribute__((address_space(3)))

DEVINL unsigned xb_ld(unsigned* p) { return __hip_atomic_load(p, __ATOMIC_RELAXED, __HIP_MEMORY_SCOPE_AGENT); }
DEVINL unsigned xb_add(unsigned* p, unsigned v) { return __hip_atomic_fetch_add(p, v, __ATOMIC_RELAXED, __HIP_MEMORY_SCOPE_AGENT); }
DEVINL unsigned xb_xcc_id() { return (unsigned)__builtin_amdgcn_s_getreg((3 << 11) | 20) & 0xFu; }
#define XB_SPIN(cond, bar) do { unsigned _sp = 0; while (cond) { __builtin_amdgcn_s_sleep(1); \
    if ((++_sp & 255u) == 0u) { if (xb_ld(&(bar)[XB_TMO])) break; if (_sp > XB_SPIN_CAP) { atomicAdd(&(bar)[XB_TMO], 1u); break; } } } } while (0)

struct XcdBarrier { unsigned* bar; unsigned x; volatile LAS unsigned* st; };

DEVINL XcdBarrier xcd_barrier_post(unsigned* bar, volatile LAS unsigned* st) {
  XcdBarrier b; b.bar = bar; b.x = xb_xcc_id(); b.st = st;
  if (threadIdx.x == 0) (void)xb_add(&bar[XB_XCNT(b.x)], 1u);
  return b;
}
DEVINL void xcd_barrier_complete(unsigned* bar, unsigned x, unsigned& nloc, unsigned& nx) {
  const unsigned G = gridDim.x * gridDim.y * gridDim.z;
  unsigned sum, cnt, mine, sp = 0u;
  for (;;) {
    sum = 0u; cnt = 0u; mine = 0u;
#pragma unroll
    for (unsigned j = 0; j < 16; ++j) { const unsigned c = xb_ld(&bar[XB_XCNT(j)]); sum += c; cnt += (c > 0u) ? 1u : 0u; mine = (j == x) ? c : mine; }
    if (sum == G) break;
    __builtin_amdgcn_s_sleep(1);
    if ((++sp & 255u) == 0u) { if (xb_ld(&bar[XB_TMO])) break; if (sp > XB_SPIN_CAP) { atomicAdd(&bar[XB_TMO], 1u); break; } }
  }
  nloc = mine > 0u ? mine : 1u; nx = cnt > 0u ? cnt : 1u;
}
DEVINL void xcd_barrier(const XcdBarrier& b) {
  asm volatile("s_waitcnt vmcnt(0)" ::: "memory");
  __syncthreads();
  if (threadIdx.x == 0) {
    unsigned* bar = b.bar;
    __builtin_amdgcn_s_waitcnt(0);
    unsigned nloc = b.st[0], nx = b.st[1];
    if (nloc == 0u) { xcd_barrier_complete(bar, b.x, nloc, nx); b.st[0] = nloc; b.st[1] = nx; }
    const unsigned old = xb_add(&bar[XB_XSUB(b.x)], 1u);
    const unsigned gen = old / nloc;
    if (old + 1u == (gen + 1u) * nloc) {
      __builtin_amdgcn_fence(__ATOMIC_RELEASE, "agent");
      asm volatile("s_waitcnt vmcnt(0)" ::: "memory");
      const unsigned og = xb_add(&bar[XB_TOP], 1u);
      const unsigned tg = og / nx;
      if (og + 1u == (tg + 1u) * nx) xb_add(&bar[XB_TOPGEN], 1u);
      else XB_SPIN(xb_ld(&bar[XB_TOPGEN]) == tg, bar);
      __builtin_amdgcn_fence(__ATOMIC_ACQUIRE, "agent");
      xb_add(&bar[XB_XGEN(b.x)], 1u);
      asm volatile("s_waitcnt vmcnt(0)" ::: "memory");
    } else {
      XB_SPIN(xb_ld(&bar[XB_XGEN(b.x)]) == gen, bar);
      __builtin_amdgcn_fence(__ATOMIC_ACQUIRE, "agent");
      asm volatile("s_waitcnt vmcnt(0)" ::: "memory");
    }
  }
  __syncthreads();
}

extern __shared__ __attribute__((aligned(16))) char dyn_smem[];
__global__ void __launch_bounds__(NTHREADS, 2) mega_kernel(Params p) {
  char* smem = dyn_smem;
  cg::grid_group grid = cg::this_grid();
  const int w = blockIdx.x, nw = gridDim.x;
  if (p.use_cg_sync) grid.sync();
  volatile LAS unsigned* xst = (volatile LAS unsigned*)(smem + SMEM_BYTES - 16);
  if (threadIdx.x == 0) { xst[0] = 0u; xst[1] = 0u; }
  __syncthreads();
  XcdBarrier xb = xcd_barrier_post(p.bar, xst);
#define GSYNC() xcd_barrier(xb)
  phase_prep(p, w, nw, smem);
  GSYNC();
  for (int layer = 0; layer < 4; ++layer) {
    if ((layer & 1) == 0) {
      phase_r1(p, layer, w, nw); GSYNC();
      phase_r2(p, layer, w, nw, smem); GSYNC();
      phase_r3(p, layer, w, nw, smem); GSYNC();
      phase_r4(p, layer, w, nw, smem); GSYNC();
      phase_r5(p, layer, w, nw); GSYNC();
    } else {
      phase_a1(p, layer, w, nw); GSYNC();
      phase_a2(p, layer, w, nw, smem); GSYNC();
      phase_a2b(p, layer, w, nw); GSYNC();
      phase_a3(p, layer, w, nw); GSYNC();
    }
    phase_wo(p, layer, w, nw, smem); GSYNC();
    phase_ln1(p, layer, w, nw); GSYNC();
    phase_p1(p, layer, w, nw, smem); GSYNC();
    phase_p2(p, layer, w, nw, smem); GSYNC();
    phase_p3(p, layer, w, nw, smem); GSYNC();
    phase_p4(p, layer, w, nw, smem);
    if (layer < 3) GSYNC();
  }
}

static inline char* carve(char*& cur, size_t bytes) {
  char* r = cur;
  cur += (bytes + 255) & ~(size_t)255;
  return r;
}

extern "C" void kernel_launch(void* const* d_in, const int* in_sizes, int n_in, void* d_out, int out_size, void* d_ws,
                              size_t ws_size, hipStream_t stream) {
  Params p;
  memset(&p, 0, sizeof(p));
  for (int i = 0; i < 35; ++i) p.in[i] = (const float*)d_in[i];
  p.out = (float*)d_out;
  char* cur = (char*)d_ws;
  p.bar = (unsigned*)carve(cur, 16384);
  p.mod = (float*)carve(cur, (size_t)4 * 9 * 6144 * 4);
  p.rope = (float*)carve(cur, 64 * 16 * 2 * 4);
  p.rwkv_in_t = (bf16_t*)carve(cur, (size_t)2 * RW_N * 1024 * 2);
  p.w2t = (bf16_t*)carve(cur, (size_t)4 * 65536 * 2);
  p.a2t = (bf16_t*)carve(cur, (size_t)4 * 65536 * 2);
  p.g2t = (bf16_t*)carve(cur, (size_t)2 * 131072 * 2);
  p.rwkv_wo_t = (bf16_t*)carve(cur, (size_t)2 * 1048576 * 2);
  p.attn_wqkv_t = (bf16_t*)carve(cur, (size_t)2 * 1536 * 1024 * 2);
  p.attn_wo_t = (bf16_t*)carve(cur, (size_t)2 * 1048576 * 2);
  p.wq_t = (bf16_t*)carve(cur, (size_t)4 * 2048 * 1024 * 2);
  p.keysb = (bf16_t*)carve(cur, (size_t)4 * 2 * 128 * 128 * 2);
  p.ub = (bf16_t*)carve(cur, (size_t)4 * 16384 * 1024 * 2);
  p.vb = (bf16_t*)carve(cur, (size_t)4 * 16384 * 1024 * 2);
  p.Klat = (bf16_t*)carve(cur, (size_t)2 * 8 * 4 * 1536 * 64 * 2);
  p.VlatT = (bf16_t*)carve(cur, (size_t)2 * 8 * 4 * 1536 * 64 * 2);
  p.Kctx = (bf16_t*)carve(cur, (size_t)2 * 16 * 4 * 256 * 64 * 2);
  p.VctxT = (bf16_t*)carve(cur, (size_t)2 * 16 * 4 * 256 * 64 * 2);
  p.xbuf = (float*)carve(cur, (size_t)TT * DM * 4);
  p.zbuf = (float*)carve(cur, (size_t)TT * DM * 4);
  p.hbuf = (bf16_t*)carve(cur, (size_t)TT * DM * 2);
  p.abuf = (bf16_t*)carve(cur, (size_t)TT * DM * 2);
  p.U1 = carve(cur, (size_t)TT * DM * 14);
  p.U2 = carve(cur, (size_t)TT * DM * 8);
  p.U3 = carve(cur, (size_t)TT * DM * 8);
  p.pidx = (int*)carve(cur, (size_t)TT * 128 * 4);
  p.pgate = (float*)carve(cur, (size_t)TT * 128 * 4);
  for (int f = 0; f < 16; ++f) p.freqs[f] = pow(10000.0, -(double)f / 16.0);
  if ((size_t)(cur - (char*)d_ws) > ws_size) {
    fprintf(stderr, "workspace too small: need %zu have %zu\n", (size_t)(cur - (char*)d_ws), ws_size);
    return;
  }
  static int grid_blocks = 0;
  if (!grid_blocks) {
    int dev = 0, cus = 0, per_cu = 0;
    (void)hipGetDevice(&dev);
    (void)hipDeviceGetAttribute(&cus, hipDeviceAttributeMultiprocessorCount, dev);
    (void)hipFuncSetAttribute((const void*)mega_kernel, hipFuncAttributeMaxDynamicSharedMemorySize, SMEM_BYTES);
    (void)hipOccupancyMaxActiveBlocksPerMultiprocessor(&per_cu, mega_kernel, NTHREADS, SMEM_BYTES);
    if (per_cu > 1) per_cu = 1;
    if (per_cu < 1) per_cu = 1;
    grid_blocks = cus * per_cu;
  }
  (void)hipMemsetAsync(p.bar, 0, 16384, stream);
  void* args[] = {&p};
  hipError_t e = hipLaunchCooperativeKernel((void*)mega_kernel, dim3(grid_blocks), dim3(NTHREADS), args, SMEM_BYTES, stream);
  if (e != hipSuccess) fprintf(stderr, "cooperative launch failed: %s (grid %d)\n", hipGetErrorString(e), grid_blocks);
}
```

```cpp
#include <hip/hip_runtime.h>
#include <hip/hip_cooperative_groups.h>
#include <stdint.h>
#include <string.h>
#include <math.h>
#include <stdio.h>

namespace cg = cooperative_groups;

typedef unsigned short bf16_t;
typedef __attribute__((ext_vector_type(8))) short bf16x8;
typedef __attribute__((ext_vector_type(4))) float f32x4;
typedef __attribute__((ext_vector_type(16))) float f32x16;

#define DEVINL __device__ __forceinline__
#define NTHREADS 512
#define NWAVES 8
#define GEMM_LDS 131072
#define SMEM_BYTES (131072 + 16384)
#define RW_N 3840

#define DM 1024
#define TCTX 4096
#define TLAT 8192
#define TT 12288
#define ALPHA_F 1.681792830507429f
#define LN_EPS_F 1e-5f
#define GN_EPS_F 6.4e-4f
#define RMS_EPS_F 1e-6f
#define QSCALE_F (0.125f * 1.4426950408889634f)

#define OUT_Y 0
#define OUT_STATE 12582912
#define OUT_CK 16777216
#define OUT_CV 18874368

struct Params {
  const float* in[35];
  float* out;
  float* mod;
  float* rope;
  bf16_t* rwkv_in_t;
  bf16_t* w2t;
  bf16_t* a2t;
  bf16_t* g2t;
  bf16_t* rwkv_wo_t;
  bf16_t* attn_wqkv_t;
  bf16_t* attn_wo_t;
  bf16_t* wq_t;
  bf16_t* keysb;
  bf16_t* ub;
  bf16_t* vb;
  bf16_t* Klat;
  bf16_t* VlatT;
  bf16_t* Kctx;
  bf16_t* VctxT;
  float* xbuf;
  float* zbuf;
  bf16_t* hbuf;
  bf16_t* abuf;
  char* U1;
  char* U2;
  char* U3;
  int* pidx;
  float* pgate;
  double freqs[16];
  unsigned* bar;
  int use_cg_sync;
  int pad0;
};

DEVINL int tidx() { int t = threadIdx.x; asm volatile("" : "+v"(t)); return t; }
DEVINL bf16_t f2bf(float f) {
  unsigned u = __float_as_uint(f);
  u += 0x7FFFu + ((u >> 16) & 1u);
  return (bf16_t)(u >> 16);
}
DEVINL float bf2f(bf16_t h) { return __uint_as_float(((unsigned)h) << 16); }
DEVINL unsigned pack2(float a, float b) { return (unsigned)f2bf(a) | ((unsigned)f2bf(b) << 16); }
DEVINL float bflo(unsigned u) { return __uint_as_float(u << 16); }
DEVINL float bfhi(unsigned u) { return __uint_as_float(u & 0xFFFF0000u); }

DEVINL float wave_sum(float v) {
#pragma unroll
  for (int o = 32; o > 0; o >>= 1) v += __shfl_xor(v, o);
  return v;
}
DEVINL float grp16_sum(float v) {
#pragma unroll
  for (int o = 8; o > 0; o >>= 1) v += __shfl_xor(v, o);
  return v;
}
DEVINL unsigned wave_max_u(unsigned v) {
#pragma unroll
  for (int o = 32; o > 0; o >>= 1) { unsigned t = (unsigned)__shfl_xor((int)v, o); v = v > t ? v : t; }
  return v;
}
DEVINL float sigmoidf_(float x) { return 1.0f / (1.0f + __expf(-x)); }
DEVINL float tanhf_(float x) { float e = __expf(-2.0f * fabsf(x)); float t = (1.0f - e) / (1.0f + e); return x < 0 ? -t : t; }
DEVINL unsigned ordf(float f) { unsigned u = __float_as_uint(f); return (u & 0x80000000u) ? ~u : (u | 0x80000000u); }

DEVINL int cond_of_row(int row) { return row < TCTX ? 8 : ((row - TCTX) >> 10); }


namespace pg8 {
#define PG8_LAS __attribute__((address_space(3)))
typedef unsigned u32x4 __attribute__((ext_vector_type(4)));
constexpr int BM = 256, BK = 64, HALF = 128, HTB = HALF * BK * 2, STAGE_BYTES = 8 * HTB, NXCD = 8, WGM = 8;
DEVINL int lds_byte(int r, int c) { const int st = (r >> 4) * 2 + (c >> 5), rr = r & 15, cc = c & 31, ob = rr * 64 + cc * 2; return st * 1024 + (ob ^ (((ob >> 9) & 1) << 5)); }
DEVINL void stage_rc(int b, int& R, int& C) { const int st = b / 1024, sb = b % 1024, swz = sb ^ (((sb >> 9) & 1) << 5); R = (st >> 1) * 16 + swz / 64; C = (st & 1) * 32 + (swz % 64) / 2; }
DEVINL int perm32(int rho) { const int n = rho >> 4, i = rho & 15; return 8 * (i >> 2) + 4 * n + (i & 3); }
struct Unit { int pm, pn; };
struct StaticOrder {
  int nM, nN, nwg, G, c;
  DEVINL void init(int M, int N, int G_, int c_) { nM = M / BM; nN = N / BM; nwg = nM * nN; G = G_; c = c_; }
  DEVINL bool next(int i, Unit& u) const {
    const long L = (long)i * G + c; if (L >= nwg) return false;
    int wgid = (int)L; { const int q = nwg / NXCD, r = nwg % NXCD, xcd = wgid % NXCD, off = wgid / NXCD; wgid = (xcd < r ? xcd * (q + 1) : r * (q + 1) + (xcd - r) * q) + off; }
    const int nig = WGM * nN, gid = wgid / nig, fm = gid * WGM, gsz = (nM - fm) < WGM ? (nM - fm) : WGM;
    u.pm = fm + ((wgid % nig) % gsz); u.pn = (wgid % nig) / gsz; return true;
  }
};
DEVINL unsigned cvt_pk_bf16(float lo, float hi) { unsigned r; asm volatile("v_cvt_pk_bf16_f32 %0, %1, %2" : "=v"(r) : "v"(lo), "v"(hi)); return r; }

template <class Epi, class ASel>
DEVINL void gemm_phase(PG8_LAS unsigned char* lds, const ASel& asel, const bf16_t* Bt, const int K, const StaticOrder& S, const Epi& E) {
  const int tid = tidx(), wid = __builtin_amdgcn_readfirstlane(tid >> 6), lane = tid & 63, wr = wid >> 2, wc = wid & 3, fr = lane & 15, fq = lane >> 4;
  const int nt = K / BK;
  unsigned voffA[2], voffB[2];
#pragma unroll
  for (int i = 0; i < 2; ++i) { int R, C; stage_rc(tid * 16 + i * 8192, R, C); const int Rb = Epi::PERM ? ((R & ~31) + perm32(R & 31)) : R;
    voffA[i] = (unsigned)(R * K + C) * 2u; voffB[i] = (unsigned)(Rb * K + C) * 2u; }
  const size_t kstep = (size_t)(BK * 2);
  const size_t hstep = (size_t)HALF * K * 2;
  const size_t tstep = 2 * hstep;
  const unsigned ldsw = (unsigned)wid * 1024u;
  const int aoff = lds_byte(wr * 64 + fr, fq * 8), boff = lds_byte(wc * 32 + fr, fq * 8);
#define PG8_SA(b, h) (((b) * 2 + (h)) * HTB)
#define PG8_SB(b, h) ((4 + (b) * 2 + (h)) * HTB)
#define PG8_STAGE(bufoff, gbase, voff) do { _Pragma("unroll") for (int _i = 0; _i < 2; ++_i) \
    __builtin_amdgcn_global_load_lds((const unsigned*)((const char*)(gbase) + (voff)[_i]), (PG8_LAS unsigned*)(lds + (bufoff) + ldsw + _i * 8192), 16, 0, 0); } while (0)
#define PG8_LDA(dst, b, h) do { _Pragma("unroll") for (int m = 0; m < 4; ++m) _Pragma("unroll") for (int k = 0; k < 2; ++k) dst[m][k] = *(const PG8_LAS bf16x8*)(lds + PG8_SA(b, h) + aoff + m * 2048 + k * 1024); } while (0)
#define PG8_LDB(dst, b, h) do { _Pragma("unroll") for (int n = 0; n < 2; ++n) _Pragma("unroll") for (int k = 0; k < 2; ++k) dst[n][k] = *(const PG8_LAS bf16x8*)(lds + PG8_SB(b, h) + boff + n * 2048 + k * 1024); } while (0)
#define PG8_MMA(ai, bj, At, Bt_) do { __builtin_amdgcn_s_setprio(1); _Pragma("unroll") for (int m = 0; m < 4; ++m) _Pragma("unroll") for (int n = 0; n < 2; ++n) _Pragma("unroll") for (int k = 0; k < 2; ++k) \
    acc[ai][bj][m][n] = __builtin_amdgcn_mfma_f32_16x16x32_bf16(Bt_[n][k], At[m][k], acc[ai][bj][m][n], 0, 0, 0); __builtin_amdgcn_s_setprio(0); } while (0)
#define PG8_WAIT_V(n) asm volatile("s_waitcnt vmcnt(" #n ")" ::: "memory")
#define PG8_WAIT_L(n) asm volatile("s_waitcnt lgkmcnt(" #n ")" ::: "memory")
#define PG8_BAR __builtin_amdgcn_s_barrier()
#define PG8_SCHED __builtin_amdgcn_sched_barrier(0)
  Unit cur, nxt; int ui = 0;
  if (!S.next(0, cur)) return;
  f32x4 acc[2][2][4][2];
#pragma unroll
  for (int a = 0; a < 2; ++a)
#pragma unroll
    for (int b = 0; b < 2; ++b)
#pragma unroll
      for (int m = 0; m < 4; ++m)
#pragma unroll
        for (int n = 0; n < 2; ++n) acc[a][b][m][n] = (f32x4){0.f, 0.f, 0.f, 0.f};
  bf16x8 At[4][2], B0[2][2], B1[2][2];
  const char* cA = asel(cur.pn) + (size_t)cur.pm * tstep; const char* cB = (const char*)Bt + (size_t)cur.pn * tstep;
  PG8_STAGE(PG8_SB(0, 0), cB, voffB); PG8_STAGE(PG8_SA(0, 0), cA, voffA); PG8_STAGE(PG8_SB(0, 1), cB + hstep, voffB); PG8_STAGE(PG8_SA(0, 1), cA + hstep, voffA);
  if (wr == 1) PG8_BAR;
  PG8_WAIT_V(4); PG8_BAR;
  PG8_STAGE(PG8_SB(1, 0), cB + kstep, voffB); PG8_STAGE(PG8_SA(1, 0), cA + kstep, voffA); PG8_STAGE(PG8_SB(1, 1), cB + hstep + kstep, voffB);
  PG8_WAIT_V(6); PG8_BAR;
  for (;;) {
    const bool has_next = S.next(ui + 1, nxt);
    const char* nA = has_next ? asel(nxt.pn) + (size_t)nxt.pm * tstep : cA; const char* nB = has_next ? (const char*)Bt + (size_t)nxt.pn * tstep : cB;
    for (int t = 0; t < nt; t += 2) {
      const bool last = (t == nt - 2);
      const char* a1 = cA + (size_t)(t + 1) * kstep;
      const char* a2 = last ? nA : cA + (size_t)(t + 2) * kstep; const char* b2 = last ? nB : cB + (size_t)(t + 2) * kstep;
      const char* a3 = a2 + kstep; const char* b3 = b2 + kstep;
      PG8_LDB(B0, 0, 0); PG8_SCHED; PG8_LDA(At, 0, 0); PG8_STAGE(PG8_SA(1, 1), a1 + hstep, voffA);
      PG8_WAIT_L(8); PG8_BAR; PG8_WAIT_L(0); PG8_MMA(0, 0, At, B0); PG8_BAR; PG8_SCHED;
      PG8_LDB(B1, 0, 1); PG8_STAGE(PG8_SB(0, 0), b2, voffB);
      PG8_BAR; PG8_WAIT_L(0); PG8_MMA(0, 1, At, B1); PG8_BAR;
      PG8_LDA(At, 0, 1); PG8_STAGE(PG8_SA(0, 0), a2, voffA);
      PG8_BAR; PG8_WAIT_L(0); PG8_MMA(1, 0, At, B0); PG8_BAR; PG8_SCHED;
      PG8_STAGE(PG8_SB(0, 1), b2 + hstep, voffB);
      PG8_WAIT_V(6); PG8_BAR; PG8_MMA(1, 1, At, B1); PG8_BAR;
      PG8_LDB(B0, 1, 0); PG8_SCHED; PG8_LDA(At, 1, 0); PG8_STAGE(PG8_SA(0, 1), a2 + hstep, voffA);
      PG8_WAIT_L(8); PG8_BAR; PG8_WAIT_L(0); PG8_MMA(0, 0, At, B0); PG8_BAR; PG8_SCHED;
      PG8_LDB(B1, 1, 1); PG8_STAGE(PG8_SB(1, 0), b3, voffB);
      PG8_BAR; PG8_WAIT_L(0); PG8_MMA(0, 1, At, B1); PG8_BAR;
      PG8_LDA(At, 1, 1); PG8_STAGE(PG8_SA(1, 0), a3, voffA);
      PG8_BAR; PG8_WAIT_L(0); PG8_MMA(1, 0, At, B0); PG8_BAR; PG8_SCHED;
      PG8_STAGE(PG8_SB(1, 1), b3 + hstep, voffB);
      PG8_WAIT_V(6); PG8_BAR; PG8_MMA(1, 1, At, B1); PG8_BAR;
    }
    E(acc, cur, wr, wc, fr, fq);
    if (!has_next) break;
#pragma unroll
    for (int a = 0; a < 2; ++a)
#pragma unroll
      for (int b = 0; b < 2; ++b)
#pragma unroll
        for (int m = 0; m < 4; ++m)
#pragma unroll
          for (int n = 0; n < 2; ++n) acc[a][b][m][n] = (f32x4){0.f, 0.f, 0.f, 0.f};
    cur = nxt; cA = nA; cB = nB; ++ui;
  }
  PG8_WAIT_V(0);
  if (wr == 0) PG8_BAR;
  PG8_BAR;
#undef PG8_SA
#undef PG8_SB
#undef PG8_STAGE
#undef PG8_LDA
#undef PG8_LDB
#undef PG8_MMA
#undef PG8_WAIT_V
#undef PG8_WAIT_L
#undef PG8_BAR
#undef PG8_SCHED
}
struct ASelOne { const char* A; DEVINL const char* operator()(int) const { return A; } };
}

DEVINL void gemm_tile_128(const bf16_t* __restrict__ A, int lda, const bf16_t* __restrict__ Bt, int ldb, int K,
                          char* smem_half, f32x4 (&acc)[4][4]) {
  const int tid = tidx() & 255, wid = tid >> 6, lane = tid & 63;
  const int wr = wid >> 1, wc = wid & 1, fr = lane & 15, fq = lane >> 4;
  char* SA = smem_half;
  char* SB = smem_half + 8192;
#pragma unroll
  for (int m = 0; m < 4; ++m)
#pragma unroll
    for (int n = 0; n < 4; ++n) acc[m][n] = (f32x4){0.f, 0.f, 0.f, 0.f};
  for (int k0 = 0; k0 < K; k0 += 32) {
#pragma unroll
    for (int i = 0; i < 2; ++i) {
      int b = tid * 16 + i * 4096;
      int r = b >> 6, c = (b & 63) >> 1;
      __builtin_amdgcn_global_load_lds((const unsigned*)(A + (size_t)r * lda + k0 + c), (unsigned*)(SA + b), 16, 0, 0);
      __builtin_amdgcn_global_load_lds((const unsigned*)(Bt + (size_t)r * ldb + k0 + c), (unsigned*)(SB + b), 16, 0, 0);
    }
    asm volatile("s_waitcnt vmcnt(0)" ::: "memory");
    __syncthreads();
    bf16x8 a[4], b[4];
#pragma unroll
    for (int m = 0; m < 4; ++m) a[m] = *reinterpret_cast<const bf16x8*>(SA + (wr * 64 + m * 16 + fr) * 64 + fq * 16);
#pragma unroll
    for (int n = 0; n < 4; ++n) b[n] = *reinterpret_cast<const bf16x8*>(SB + (wc * 64 + n * 16 + fr) * 64 + fq * 16);
#pragma unroll
    for (int m = 0; m < 4; ++m)
#pragma unroll
      for (int n = 0; n < 4; ++n) acc[m][n] = __builtin_amdgcn_mfma_f32_16x16x32_bf16(a[m], b[n], acc[m][n], 0, 0, 0);
    __syncthreads();
  }
}

#define GEMM_LANE_VARS \
  const int tid = tidx() & 255, wid = tid >> 6, lane = tid & 63; \
  const int wr = wid >> 1, wc = wid & 1, fr = lane & 15, fq = lane >> 4; \
  (void)tid; (void)wid; (void)lane; (void)wr; (void)wc; (void)fr; (void)fq;

DEVINL void get_tjob(const Params& p, int ji, const float*& src, bf16_t*& dst, int& K, int& N) {
  if (ji < 28) {
    int j = ji / 14, s = ji % 14;
    bf16_t* rw = p.rwkv_in_t + (size_t)j * RW_N * 1024;
    if (s < 3) { src = p.in[12] + ((size_t)(j * 3 + s) << 20); dst = rw + ((size_t)s << 20); K = 1024; N = 1024; }
    else if (s < 5) { int z = s - 3; src = p.in[15] + (size_t)(j * 2 + z) * 65536; dst = rw + (size_t)(3072 + z * 64) * 1024; K = 1024; N = 64; }
    else if (s < 7) { int z = s - 5; src = p.in[18] + (size_t)(j * 2 + z) * 65536; dst = rw + (size_t)(3328 + z * 64) * 1024; K = 1024; N = 64; }
    else if (s == 7) { src = p.in[20] + (size_t)j * 131072; dst = rw + (size_t)3584 * 1024; K = 1024; N = 128; }
    else if (s < 10) { int z = s - 8; src = p.in[16] + (size_t)(j * 2 + z) * 65536; dst = p.w2t + (size_t)(j * 2 + z) * 65536; K = 64; N = 1024; }
    else if (s < 12) { int z = s - 10; src = p.in[19] + (size_t)(j * 2 + z) * 65536; dst = p.a2t + (size_t)(j * 2 + z) * 65536; K = 64; N = 1024; }
    else if (s == 12) { src = p.in[21] + (size_t)j * 131072; dst = p.g2t + (size_t)j * 131072; K = 128; N = 1024; }
    else { src = p.in[13] + ((size_t)j << 20); dst = p.rwkv_wo_t + ((size_t)j << 20); K = 1024; N = 1024; }
  } else if (ji < 32) {
    int j = (ji - 28) >> 1, s = (ji - 28) & 1;
    if (s == 0) { src = p.in[27] + (size_t)j * 1024 * 1536; dst = p.attn_wqkv_t + (size_t)j * 1536 * 1024; K = 1024; N = 1536; }
    else { src = p.in[28] + ((size_t)j << 20); dst = p.attn_wo_t + ((size_t)j << 20); K = 1024; N = 1024; }
  } else {
    int i = ji - 32;
    src = p.in[31] + (size_t)i * 1024 * 2048; dst = p.wq_t + (size_t)i * 2048 * 1024; K = 1024; N = 2048;
  }
}

DEVINL void sincos_d(double x, float& c, float& s) {
  const double TWO_PI = 6.283185307179586476925;
  double r = x - TWO_PI * rint(x / TWO_PI);
  double r2 = r * r;
  double ts = r, tc = 1.0, ss = r, cs = 1.0;
#pragma unroll 1
  for (int n = 1; n <= 14; ++n) {
    tc = -tc * r2 / (double)((2 * n - 1) * (2 * n));
    ts = -ts * r2 / (double)((2 * n) * (2 * n + 1));
    cs += tc; ss += ts;
  }
  c = (float)cs; s = (float)ss;
}

DEVINL void phase_prep(const Params& p, int w, int nw, char* smem) {
  const int tid = tidx();
  {
    float (*tile)[65] = reinterpret_cast<float (*)[65]>(smem);
    int toff = 0;
    for (int ji = 0; ji < 36; ++ji) {
      const float* src; bf16_t* dst; int K, N;
      get_tjob(p, ji, src, dst, K, N);
      const int tn = N >> 6, nt = (K >> 6) * tn;
      int t0 = (w - (toff % nw) + nw) % nw;
      for (int t = t0; t < nt; t += nw) {
        const int k0 = (t / tn) << 6, n0 = (t % tn) << 6;
#pragma unroll
        for (int i = 0; i < 2; ++i) {
          int r = (tid >> 4) + 32 * i, c = (tid & 15) * 4;
          float4 v = *reinterpret_cast<const float4*>(src + (size_t)(k0 + r) * N + n0 + c);
          tile[r][c] = v.x; tile[r][c + 1] = v.y; tile[r][c + 2] = v.z; tile[r][c + 3] = v.w;
        }
        __syncthreads();
        {
          int q = tid;
          int n = q >> 3, kc = (q & 7) * 8;
          uint4 o;
          o.x = pack2(tile[kc + 0][n], tile[kc + 1][n]);
          o.y = pack2(tile[kc + 2][n], tile[kc + 3][n]);
          o.z = pack2(tile[kc + 4][n], tile[kc + 5][n]);
          o.w = pack2(tile[kc + 6][n], tile[kc + 7][n]);
          *reinterpret_cast<uint4*>(dst + (size_t)(n0 + n) * K + k0 + kc) = o;
        }
        __syncthreads();
      }
      toff += nt;
    }
  }
  const size_t gtid = (size_t)w * NTHREADS + tid, gn = (size_t)nw * NTHREADS;
  {
    const size_t n8 = (size_t)4 * 16384 * 1024 / 8;
    for (size_t i = gtid; i < n8; i += gn) {
      const float4* su = reinterpret_cast<const float4*>(p.in[33]) + i * 2;
      float4 a = su[0], b = su[1];
      uint4 o; o.x = pack2(a.x, a.y); o.y = pack2(a.z, a.w); o.z = pack2(b.x, b.y); o.w = pack2(b.z, b.w);
      reinterpret_cast<uint4*>(p.ub)[i] = o;
      const float4* sv = reinterpret_cast<const float4*>(p.in[34]) + i * 2;
      a = sv[0]; b = sv[1];
      o.x = pack2(a.x, a.y); o.y = pack2(a.z, a.w); o.z = pack2(b.x, b.y); o.w = pack2(b.z, b.w);
      reinterpret_cast<uint4*>(p.vb)[i] = o;
    }
    const size_t nk8 = (size_t)4 * 2 * 128 * 128 / 8;
    for (size_t i = gtid; i < nk8; i += gn) {
      const float4* su = reinterpret_cast<const float4*>(p.in[32]) + i * 2;
      float4 a = su[0], b = su[1];
      uint4 o; o.x = pack2(a.x, a.y); o.y = pack2(a.z, a.w); o.z = pack2(b.x, b.y); o.w = pack2(b.z, b.w);
      reinterpret_cast<uint4*>(p.keysb)[i] = o;
    }
  }
  {
    const size_t nk = (size_t)8 * 2 * 512 * 4 * 64;
    for (size_t i = gtid; i < nk; i += gn) {
      int d = i & 63, kvh = (i >> 6) & 3, s = (i >> 8) & 511, j = (i >> 17) & 1, b = (int)(i >> 18);
      p.Klat[((size_t)((j * 8 + b) * 4 + kvh) * 1536 + s) * 64 + d] = f2bf(p.in[4][i]);
      p.VlatT[((size_t)((j * 8 + b) * 4 + kvh) * 64 + d) * 1536 + s] = f2bf(p.in[5][i]);
    }
  }
  for (size_t i = gtid; i < 1024; i += gn) {
    int pos = (int)(i >> 4), f = (int)(i & 15);
    float c, s; sincos_d((double)pos * p.freqs[f], c, s);
    p.rope[i * 2] = c; p.rope[i * 2 + 1] = s;
  }
  {
    const size_t n4 = (size_t)TT * DM / 4, nc4 = (size_t)TCTX * DM / 4;
    for (size_t i = gtid; i < n4; i += gn) {
      float4 v = (i < nc4) ? reinterpret_cast<const float4*>(p.in[0])[i] : reinterpret_cast<const float4*>(p.in[1])[i - nc4];
      reinterpret_cast<float4*>(p.xbuf)[i] = v;
    }
  }
  {
    float* sc = reinterpret_cast<float*>(smem);
    float* red = sc + 9 * 1024;
    bool loaded = false;
    for (int item = w; item < 384; item += nw) {
      if (!loaded) {
        __syncthreads();
        for (int e = tid; e < 9 * 1024; e += NTHREADS) {
          int c = e >> 10, d = e & 1023;
          float v = (c < 8) ? p.in[2][c * 1024 + d] : p.in[6][d];
          sc[e] = v / (1.0f + __expf(-v));
        }
        __syncthreads();
        loaded = true;
      }
      const int i = item / 96, cc = item % 96;
      const int col = cc * 64 + (tid & 63), ks = tid >> 6;
      float acc[9];
#pragma unroll
      for (int c = 0; c < 9; ++c) acc[c] = 0.f;
      const float* wp = p.in[7] + (size_t)i * 1024 * 6144 + col;
      for (int d0 = ks * 128; d0 < ks * 128 + 128; d0 += 16) {
        float wv[16];
#pragma unroll
        for (int u = 0; u < 16; ++u) wv[u] = wp[(size_t)(d0 + u) * 6144];
#pragma unroll
        for (int u = 0; u < 16; ++u)
#pragma unroll
          for (int c = 0; c < 9; ++c) acc[c] += sc[c * 1024 + d0 + u] * wv[u];
      }
#pragma unroll
      for (int c = 0; c < 9; ++c) red[(ks * 9 + c) * 64 + (tid & 63)] = acc[c];
      __syncthreads();
      for (int o = tid; o < 576; o += NTHREADS) {
        int c = o >> 6, cl = o & 63;
        float s = 0.f;
#pragma unroll
        for (int k2 = 0; k2 < 8; ++k2) s += red[(k2 * 9 + c) * 64 + cl];
        int n = cc * 64 + cl;
        p.mod[((size_t)i * 9 + c) * 6144 + n] = s + p.in[8][i * 6144 + n];
      }
      __syncthreads();
    }
  }
}

DEVINL void phase_r1(const Params& p, int layer, int w, int nw) {
  const int j = layer >> 1;
  const int lane = tidx() & 63;
  const int gw = w * NWAVES + (tidx() >> 6), ngw = nw * NWAVES;
  bf16_t* A6 = reinterpret_cast<bf16_t*>(p.U1);
  const float* mu = p.in[11] + (size_t)j * 6 * 1024;
  for (int row = gw; row < TT; row += ngw) {
    int t, Tlen;
    if (row < TCTX) { t = row & 255; Tlen = 256; } else { t = (row - TCTX) & 1023; Tlen = 1024; }
    const int cond = cond_of_row(row);
    const float* sh = p.mod + ((size_t)layer * 9 + cond) * 6144;
    const float* sc = sh + 1024;
    const bool hasp = t > 0, hasn = t < Tlen - 1;
#pragma unroll
    for (int k = 0; k < 4; ++k) {
      const int col = k * 256 + lane * 4;
      const float4 xc = *reinterpret_cast<const float4*>(p.xbuf + (size_t)row * DM + col);
      float4 xp = make_float4(0, 0, 0, 0), xn = make_float4(0, 0, 0, 0);
      if (hasp) xp = *reinterpret_cast<const float4*>(p.xbuf + (size_t)(row - 1) * DM + col);
      if (hasn) xn = *reinterpret_cast<const float4*>(p.xbuf + (size_t)(row + 1) * DM + col);
      const float4 s4 = *reinterpret_cast<const float4*>(sh + col);
      const float4 c4 = *reinterpret_cast<const float4*>(sc + col);
      float h[4], xx[4];
      const float xcv[4] = {xc.x, xc.y, xc.z, xc.w}, xpv[4] = {xp.x, xp.y, xp.z, xp.w}, xnv[4] = {xn.x, xn.y, xn.z, xn.w};
      const float shv[4] = {s4.x, s4.y, s4.z, s4.w}, scv[4] = {c4.x, c4.y, c4.z, c4.w};
#pragma unroll
      for (int e = 0; e < 4; ++e) {
        float g = 1.0f + scv[e];
        h[e] = xcv[e] * g + shv[e];
        float hp = hasp ? (xpv[e] * g + shv[e]) : 0.f;
        float hn = hasn ? (xnv[e] * g + shv[e]) : 0.f;
        xx[e] = 0.5f * (hp + hn) - h[e];
      }
#pragma unroll
      for (int m = 0; m < 6; ++m) {
        const float4 m4 = *reinterpret_cast<const float4*>(mu + m * 1024 + col);
        uint2 o;
        o.x = pack2(h[0] + xx[0] * m4.x, h[1] + xx[1] * m4.y);
        o.y = pack2(h[2] + xx[2] * m4.z, h[3] + xx[3] * m4.w);
        *reinterpret_cast<uint2*>(A6 + ((size_t)m * TT + row) * DM + col) = o;
      }
    }
  }
}

#define U1_AA_OFF ((size_t)2 * TT * DM * 4)
#define U1_GG_OFF (U1_AA_OFF + (size_t)2 * TT * DM * 2)

struct ASelR2 {
  const char* A6;
  DEVINL const char* operator()(int pn) const {
    const int idx = pn < 12 ? (pn >> 2) : (pn - 9);
    const int m = (0x541320 >> (4 * idx)) & 7;
    return A6 + (size_t)m * TT * DM * 2;
  }
};
struct EpiR2 {
  static constexpr bool PERM = true;
  bf16_t *rb, *lw;
  DEVINL void operator()(const f32x4 (&acc)[2][2][4][2], const pg8::Unit& u, int wr, int wc, int fr, int fq) const {
    const int row0 = u.pm * 256 + wr * 64 + fr;
    const int pn = u.pn;
    if (pn < 12) {
      bf16_t* dst = rb + (size_t)(pn >> 2) * TT * DM;
      const int col0 = (pn & 3) * 256 + wc * 32 + 8 * fq;
#pragma unroll
      for (int ai = 0; ai < 2; ++ai)
#pragma unroll
        for (int m = 0; m < 4; ++m) {
          bf16_t* rowp = dst + (size_t)(row0 + ai * 128 + m * 16) * DM + col0;
#pragma unroll
          for (int bj = 0; bj < 2; ++bj) {
            const f32x4 v0 = acc[ai][bj][m][0], v1 = acc[ai][bj][m][1];
            pg8::u32x4 o; o.x = pg8::cvt_pk_bf16(v0[0], v0[1]); o.y = pg8::cvt_pk_bf16(v0[2], v0[3]); o.z = pg8::cvt_pk_bf16(v1[0], v1[1]); o.w = pg8::cvt_pk_bf16(v1[2], v1[3]);
            *reinterpret_cast<pg8::u32x4*>(rowp + bj * 128) = o;
          }
        }
    } else {
      bf16_t* dst = lw + (size_t)(pn - 12) * TT * 128;
      const int col0 = wc * 32 + 8 * fq;
      const float kx = (pn == 12 ? 2.0f : 1.0f) * 1.4426950408889634f, ka = pn == 12 ? 2.0f : 1.0f, kb = pn == 12 ? -1.0f : 0.0f;
#pragma unroll
      for (int ai = 0; ai < 2; ++ai)
#pragma unroll
        for (int m = 0; m < 4; ++m) {
          f32x4 v0 = acc[ai][0][m][0], v1 = acc[ai][0][m][1];
          if (pn != 13) {
#pragma unroll
            for (int e = 0; e < 4; ++e) {
              const float s0 = __builtin_amdgcn_rcpf(1.0f + __builtin_amdgcn_exp2f(-kx * v0[e]));
              const float s1 = __builtin_amdgcn_rcpf(1.0f + __builtin_amdgcn_exp2f(-kx * v1[e]));
              v0[e] = ka * s0 + kb; v1[e] = ka * s1 + kb;
            }
          }
          asm volatile("" ::: "memory");
          pg8::u32x4 o; o.x = pg8::cvt_pk_bf16(v0[0], v0[1]); o.y = pg8::cvt_pk_bf16(v0[2], v0[3]); o.z = pg8::cvt_pk_bf16(v1[0], v1[1]); o.w = pg8::cvt_pk_bf16(v1[2], v1[3]);
          *reinterpret_cast<pg8::u32x4*>(dst + (size_t)(row0 + ai * 128 + m * 16) * 128 + col0) = o;
        }
    }
  }
};
DEVINL void phase_r2(const Params& p, int layer, int w, int nw, char* smem) {
  const int j = layer >> 1;
  bf16_t* rb = reinterpret_cast<bf16_t*>(p.U2);
  EpiR2 E;
  E.rb = rb; E.lw = p.abuf;
  ASelR2 as; as.A6 = p.U1;
  pg8::StaticOrder S; S.init(TT, RW_N, nw, w);
  pg8::gemm_phase<EpiR2, ASelR2>((PG8_LAS unsigned char*)smem, as, p.rwkv_in_t + (size_t)j * RW_N * 1024, 1024, S, E);
}

DEVINL void phase_r3(const Params& p, int layer, int w, int nw, char* smem) {
  const int j = layer >> 1;
  GEMM_LANE_VARS
  const int half = tidx() >> 8;
  char* sh = smem + half * 16384;
  const bf16_t* lw = p.abuf;
  const bf16_t* la = lw + (size_t)TT * 128;
  const bf16_t* lg = la + (size_t)TT * 128;
  float* wdec = reinterpret_cast<float*>(p.U1);
  bf16_t* aa = reinterpret_cast<bf16_t*>(p.U1 + U1_AA_OFF);
  bf16_t* gg = reinterpret_cast<bf16_t*>(p.U1 + U1_GG_OFF);
  const int NTILES = 96 * 40;
  for (int it = 0; it * nw * 2 < NTILES; ++it) {
    int tile = (it * nw + w) * 2 + half;
    const bool valid = tile < NTILES;
    if (!valid) tile = 0;
    const int ct = tile / 96, rt = tile % 96;
    const int job = ct >> 3, nt = ct & 7;
    const int row0 = rt * 128, col0 = nt * 128;
    f32x4 acc[4][4];
    if (job < 2) {
      const int z = job;
      gemm_tile_128(lw + (size_t)row0 * 128 + z * 64, 128, p.w2t + (size_t)(j * 2 + z) * 65536 + (size_t)col0 * 64, 64, 64, sh, acc);
      if (valid) {
        const float* w0 = p.in[14] + (size_t)(j * 2 + z) * 1024;
#pragma unroll
        for (int m = 0; m < 4; ++m)
#pragma unroll
          for (int n = 0; n < 4; ++n)
#pragma unroll
            for (int jj = 0; jj < 4; ++jj) {
              int row = row0 + wr * 64 + m * 16 + fq * 4 + jj, col = col0 + wc * 64 + n * 16 + fr;
              float wl = acc[m][n][jj] + w0[col];
              wdec[((size_t)z * TT + row) * DM + col] = __expf(-0.6065306597126334f * sigmoidf_(wl));
            }
      }
    } else if (job < 4) {
      const int z = job - 2;
      gemm_tile_128(la + (size_t)row0 * 128 + z * 64, 128, p.a2t + (size_t)(j * 2 + z) * 65536 + (size_t)col0 * 64, 64, 64, sh, acc);
      if (valid) {
        const float* a0 = p.in[17] + (size_t)(j * 2 + z) * 1024;
#pragma unroll
        for (int m = 0; m < 4; ++m)
#pragma unroll
          for (int n = 0; n < 4; ++n)
#pragma unroll
            for (int jj = 0; jj < 4; ++jj) {
              int row = row0 + wr * 64 + m * 16 + fq * 4 + jj, col = col0 + wc * 64 + n * 16 + fr;
              aa[((size_t)z * TT + row) * DM + col] = f2bf(sigmoidf_(acc[m][n][jj] + a0[col]));
            }
      }
    } else {
      gemm_tile_128(lg + (size_t)row0 * 128, 128, p.g2t + (size_t)j * 131072 + (size_t)col0 * 128, 128, 128, sh, acc);
      if (valid) {
#pragma unroll
        for (int m = 0; m < 4; ++m)
#pragma unroll
          for (int n = 0; n < 4; ++n)
#pragma unroll
            for (int jj = 0; jj < 4; ++jj) {
              int row = row0 + wr * 64 + m * 16 + fq * 4 + jj, col = col0 + wc * 64 + n * 16 + fr;
              gg[(size_t)row * DM + col] = f2bf(acc[m][n][jj]);
            }
      }
    }
  }
  {
    const int l64 = tidx() & 63;
    const int gw = w * NWAVES + (tidx() >> 6), ngw = nw * NWAVES;
    const bf16_t* kb = reinterpret_cast<const bf16_t*>(p.U2) + (size_t)TT * DM;
    bf16_t* kkb = reinterpret_cast<bf16_t*>(p.U2) + (size_t)3 * TT * DM;
    const float* k_k = p.in[22] + j * 1024;
    for (int row = gw; row < TT; row += ngw) {
#pragma unroll
      for (int k = 0; k < 4; ++k) {
        const int col = k * 256 + l64 * 4;
        const uint2 k2 = *reinterpret_cast<const uint2*>(kb + (size_t)row * DM + col);
        const float4 kk4 = *reinterpret_cast<const float4*>(k_k + col);
        float v0 = bflo(k2.x) * kk4.x, v1 = bfhi(k2.x) * kk4.y, v2 = bflo(k2.y) * kk4.z, v3 = bfhi(k2.y) * kk4.w;
        float ss = grp16_sum(v0 * v0 + v1 * v1 + v2 * v2 + v3 * v3);
        float inv = 1.0f / fmaxf(sqrtf(ss), 1e-12f);
        uint2 o; o.x = pack2(v0 * inv, v1 * inv); o.y = pack2(v2 * inv, v3 * inv);
        *reinterpret_cast<uint2*>(kkb + (size_t)row * DM + col) = o;
      }
    }
  }
}

typedef __attribute__((ext_vector_type(4))) short bf16x4;
#define R4_WAVE_LDS 21504
DEVINL unsigned short bfbits(float f) { return f2bf(f); }
DEVINL bf16x4 pack4(float a, float b, float c, float d) {
  union { bf16x4 v; unsigned u[2]; } r; r.u[0] = pack2(a, b); r.u[1] = pack2(c, d); return r.v;
}
DEVINL void phase_r4(const Params& p, int layer, int w, int nw, char* smem) {
  const int j = layer >> 1;
  const int lane = tidx() & 63, wid = __builtin_amdgcn_readfirstlane(tidx() >> 6);
  const int fr = lane & 15, fq = lane >> 4;
  if (wid >= 3) return;
  const bf16_t* rb = reinterpret_cast<const bf16_t*>(p.U2);
  const bf16_t* kb = rb + (size_t)TT * DM;
  const bf16_t* vb = kb + (size_t)TT * DM;
  const bf16_t* kkb = vb + (size_t)TT * DM;
  const float* wdec = reinterpret_cast<const float*>(p.U1);
  const bf16_t* aa = reinterpret_cast<const bf16_t*>(p.U1 + U1_AA_OFF);
  float* yout = reinterpret_cast<float*>(p.U3);
  char* wl = smem + wid * R4_WAVE_LDS;
  bf16_t* khR = reinterpret_cast<bf16_t*>(wl);
  bf16_t* ahR = khR + 1024;
  bf16_t* qhR = ahR + 1024;
  bf16_t* rhR = qhR + 1024;
  bf16_t* qhT = rhR + 1024;
  bf16_t* AtT = qhT + 1024;
  bf16_t* KtT = AtT + 1024;
  bf16_t* vT = KtT + 1024;
  float* NfT = reinterpret_cast<float*>(vT + 1024);
  float* WCf = NfT + 256;
  bf16_t* TTl = reinterpret_cast<bf16_t*>(WCf + 64);
  bf16_t* AkqR = TTl + 256;
  bf16_t* GR = AkqR + 256;
  bf16_t* QpR = khR;
  {
    const int c = w + nw * wid;
    if (c >= 768) return;
    int seq, h, z;
    if (c < 256) { seq = 16 + (c >> 5); h = (c >> 1) & 15; z = c & 1; }
    else { int cc = c - 256; seq = cc >> 5; h = (cc >> 1) & 15; z = cc & 1; }
    const int Tlen = seq < 16 ? 256 : 1024;
    const int base = seq < 16 ? seq * 256 : TCTX + (seq - 16) * 1024;
    const int colb = h * 64;
    const float kal = p.in[23][j * 1024 + colb + lane];
    f32x4 ST[4][4];
    if (seq >= 16) {
      const float* s0 = p.in[3] + ((((size_t)(seq - 16) * 2 + j) * 2 + z) * 16 + h) * 4096;
#pragma unroll
      for (int b = 0; b < 4; ++b)
#pragma unroll
        for (int nb = 0; nb < 4; ++nb) ST[b][nb] = *reinterpret_cast<const f32x4*>(s0 + (size_t)(16 * nb + fr) * 64 + 16 * b + 4 * fq);
    } else {
#pragma unroll
      for (int b = 0; b < 4; ++b)
#pragma unroll
        for (int nb = 0; nb < 4; ++nb) ST[b][nb] = (f32x4){0.f, 0.f, 0.f, 0.f};
    }
#pragma unroll 1
    for (int t0 = 0; t0 < Tlen; t0 += 16) {
      __builtin_amdgcn_wave_barrier();
      {
        float wx[16];
#pragma unroll
        for (int t = 0; t < 16; ++t) {
          const int row = base + (z == 0 ? (t0 + t) : (Tlen - 1 - (t0 + t)));
          wx[t] = wdec[((size_t)z * TT + row) * DM + colb + lane];
        }
        float WCl = 1.0f;
#pragma unroll
        for (int t = 0; t < 16; ++t) WCl *= wx[t];
        WCf[lane] = WCl;
        float Wc = 1.0f;
#pragma unroll
        for (int tp = 0; tp < 8; ++tp) {
          float at2[2], kt2[2], qh2[2];
          unsigned vb2[2];
#pragma unroll
          for (int u = 0; u < 2; ++u) {
            const int t = tp * 2 + u;
            const int row = base + (z == 0 ? (t0 + t) : (Tlen - 1 - (t0 + t)));
            const size_t o = (size_t)row * DM + colb + lane;
            const float rr = bf2f(rb[o]), kx = bf2f(kb[o]), kkx = bf2f(kkb[o]);
            const float ax = bf2f(aa[(size_t)z * TT * DM + o]);
            vb2[u] = vb[o];
            const float kd = kx * (1.0f + (ax - 1.0f) * kal);
            const float kka = kkx * ax;
            const float qh = Wc * kkx;
            Wc *= wx[t];
            const float rh = Wc * rr;
            const float iw = 1.0f / Wc;
            const float kh = kd * iw, ah = kka * iw;
            khR[t * 64 + lane] = f2bf(kh); ahR[t * 64 + lane] = f2bf(ah);
            qhR[t * 64 + lane] = f2bf(qh); rhR[t * 64 + lane] = f2bf(rh);
            at2[u] = ah * WCl; kt2[u] = kh * WCl; qh2[u] = qh;
          }
          *reinterpret_cast<unsigned*>(AtT + lane * 16 + tp * 2) = pack2(at2[0], at2[1]);
          *reinterpret_cast<unsigned*>(KtT + lane * 16 + tp * 2) = pack2(kt2[0], kt2[1]);
          *reinterpret_cast<unsigned*>(qhT + lane * 16 + tp * 2) = pack2(qh2[0], qh2[1]);
          *reinterpret_cast<unsigned*>(vT + lane * 16 + tp * 2) = vb2[0] | (vb2[1] << 16);
          if ((tp & 1) == 1) asm volatile("" ::: "memory");
        }
      }
      __builtin_amdgcn_wave_barrier();
      f32x4 Akq = {0.f, 0.f, 0.f, 0.f}, Aaq = Akq, Akr = Akq, Aar = Akq;
      {
#pragma unroll
        for (int ks = 0; ks < 2; ++ks) {
          const bf16x8 khA = *reinterpret_cast<const bf16x8*>(khR + fr * 64 + ks * 32 + fq * 8);
          const bf16x8 ahA = *reinterpret_cast<const bf16x8*>(ahR + fr * 64 + ks * 32 + fq * 8);
          const bf16x8 qhB = *reinterpret_cast<const bf16x8*>(qhR + fr * 64 + ks * 32 + fq * 8);
          const bf16x8 rhB = *reinterpret_cast<const bf16x8*>(rhR + fr * 64 + ks * 32 + fq * 8);
          Akq = __builtin_amdgcn_mfma_f32_16x16x32_bf16(khA, qhB, Akq, 0, 0, 0);
          Aaq = __builtin_amdgcn_mfma_f32_16x16x32_bf16(ahA, qhB, Aaq, 0, 0, 0);
          Akr = __builtin_amdgcn_mfma_f32_16x16x32_bf16(khA, rhB, Akr, 0, 0, 0);
          Aar = __builtin_amdgcn_mfma_f32_16x16x32_bf16(ahA, rhB, Aar, 0, 0, 0);
        }
#pragma unroll
        for (int e = 0; e < 4; ++e) {
          const int s = 4 * fq + e;
          if (!(s < fr)) { Akq[e] = 0.f; Aaq[e] = 0.f; }
          if (!(s <= fr)) { Akr[e] = 0.f; Aar[e] = 0.f; }
        }
      }
      __builtin_amdgcn_wave_barrier();
      *reinterpret_cast<f32x4*>(NfT + fr * 16 + 4 * fq) = Aaq;
#pragma unroll
      for (int e = 0; e < 4; ++e) AkqR[(4 * fq + e) * 16 + fr] = f2bf(Akq[e]);
      __builtin_amdgcn_wave_barrier();
      {
        float Tr[16];
#pragma unroll
        for (int t = 0; t < 16; ++t) {
          float acc = (fr == t) ? 1.0f : 0.0f;
#pragma unroll
          for (int x = 0; x < t; ++x) acc -= Tr[x] * NfT[t * 16 + x];
          Tr[t] = acc;
        }
        if (fq == 0) {
#pragma unroll
          for (int t = 0; t < 16; ++t) TTl[t * 16 + fr] = f2bf(Tr[t]);
        }
      }
      __builtin_amdgcn_wave_barrier();
      const bf16x4 Tb = *reinterpret_cast<const bf16x4*>(TTl + fr * 16 + fq * 4);
      f32x4 G;
      {
        const bf16x4 AkqA = *reinterpret_cast<const bf16x4*>(AkqR + fr * 16 + fq * 4);
        G = __builtin_amdgcn_mfma_f32_16x16x16bf16_1k(AkqA, Tb, (f32x4){0.f, 0.f, 0.f, 0.f}, 0, 0, 0);
#pragma unroll
        for (int b = 0; b < 4; ++b) {
          const bf16x4 qa = *reinterpret_cast<const bf16x4*>(qhT + (16 * b + fr) * 16 + fq * 4);
          const f32x4 qp = __builtin_amdgcn_mfma_f32_16x16x16bf16_1k(qa, Tb, (f32x4){0.f, 0.f, 0.f, 0.f}, 0, 0, 0);
          *reinterpret_cast<bf16x4*>(QpR + fr * 64 + 16 * b + 4 * fq) = pack4(qp[0], qp[1], qp[2], qp[3]);
        }
#pragma unroll
        for (int e = 0; e < 4; ++e) GR[(4 * fq + e) * 16 + fr] = f2bf(G[e]);
      }
      __builtin_amdgcn_wave_barrier();
      f32x4 H, Zb[4];
      {
        const bf16x4 GA = *reinterpret_cast<const bf16x4*>(GR + fr * 16 + fq * 4);
        const bf16x4 AarB = pack4(Aar[0], Aar[1], Aar[2], Aar[3]);
        const f32x4 hm = __builtin_amdgcn_mfma_f32_16x16x16bf16_1k(GA, AarB, (f32x4){0.f, 0.f, 0.f, 0.f}, 0, 0, 0);
        H = Akr - hm;
#pragma unroll
        for (int b = 0; b < 4; ++b) {
          const bf16x4 AtB = *reinterpret_cast<const bf16x4*>(AtT + (16 * b + fr) * 16 + fq * 4);
          const f32x4 zm = __builtin_amdgcn_mfma_f32_16x16x16bf16_1k(GA, AtB, (f32x4){0.f, 0.f, 0.f, 0.f}, 0, 0, 0);
          const bf16x4 ktv = *reinterpret_cast<const bf16x4*>(KtT + (16 * b + fr) * 16 + fq * 4);
          union { bf16x4 v; unsigned short s[4]; } ku; ku.v = ktv;
          Zb[b][0] = bf2f(ku.s[0]) - zm[0]; Zb[b][1] = bf2f(ku.s[1]) - zm[1]; Zb[b][2] = bf2f(ku.s[2]) - zm[2]; Zb[b][3] = bf2f(ku.s[3]) - zm[3];
        }
      }
      bf16x8 QpA[2], rhA[2], AY, AS[4];
      {
#pragma unroll
        for (int ks = 0; ks < 2; ++ks) {
          union { bf16x8 v; bf16x4 h[2]; } u1, u2;
          u1.h[0] = *reinterpret_cast<const bf16x4*>(QpR + fr * 64 + 32 * ks + 4 * fq);
          u1.h[1] = *reinterpret_cast<const bf16x4*>(QpR + fr * 64 + 32 * ks + 16 + 4 * fq);
          u2.h[0] = *reinterpret_cast<const bf16x4*>(rhR + fr * 64 + 32 * ks + 4 * fq);
          u2.h[1] = *reinterpret_cast<const bf16x4*>(rhR + fr * 64 + 32 * ks + 16 + 4 * fq);
          QpA[ks] = u1.v; rhA[ks] = u2.v;
        }
        {
          union { bf16x8 v; bf16x4 h[2]; } u;
          u.h[0] = pack4(Aar[0], Aar[1], Aar[2], Aar[3]); u.h[1] = pack4(H[0], H[1], H[2], H[3]);
          AY = u.v;
        }
#pragma unroll
        for (int b = 0; b < 4; ++b) {
          union { bf16x8 v; bf16x4 h[2]; } u;
          u.h[0] = *reinterpret_cast<const bf16x4*>(AtT + (16 * b + fr) * 16 + fq * 4);
          u.h[1] = pack4(Zb[b][0], Zb[b][1], Zb[b][2], Zb[b][3]);
          AS[b] = u.v;
        }
      }
#pragma unroll
      for (int nb = 0; nb < 4; ++nb) {
        bf16x8 Bhi[2], Blo[2];
#pragma unroll
        for (int ks = 0; ks < 2; ++ks) {
          union { bf16x8 v; unsigned u[4]; } hi, lo;
          float a[8];
#pragma unroll
          for (int e = 0; e < 4; ++e) { a[e] = ST[2 * ks][nb][e]; a[4 + e] = ST[2 * ks + 1][nb][e]; }
          float rsd[8];
#pragma unroll
          for (int e = 0; e < 8; ++e) { const float hf = bf2f(f2bf(a[e])); rsd[e] = a[e] - hf; }
#pragma unroll
          for (int e = 0; e < 4; ++e) { hi.u[e] = pack2(a[2 * e], a[2 * e + 1]); lo.u[e] = pack2(rsd[2 * e], rsd[2 * e + 1]); }
          Bhi[ks] = hi.v; Blo[ks] = lo.v;
        }
        f32x4 P = {0.f, 0.f, 0.f, 0.f}, R = {0.f, 0.f, 0.f, 0.f};
        P = __builtin_amdgcn_mfma_f32_16x16x32_bf16(QpA[0], Bhi[0], P, 0, 0, 0);
        P = __builtin_amdgcn_mfma_f32_16x16x32_bf16(QpA[1], Bhi[1], P, 0, 0, 0);
        P = __builtin_amdgcn_mfma_f32_16x16x32_bf16(QpA[0], Blo[0], P, 0, 0, 0);
        P = __builtin_amdgcn_mfma_f32_16x16x32_bf16(QpA[1], Blo[1], P, 0, 0, 0);
        R = __builtin_amdgcn_mfma_f32_16x16x32_bf16(rhA[0], Bhi[0], R, 0, 0, 0);
        R = __builtin_amdgcn_mfma_f32_16x16x32_bf16(rhA[1], Bhi[1], R, 0, 0, 0);
        bf16x8 X;
        {
          union { bf16x8 v; bf16x4 h[2]; } u;
          u.h[0] = pack4(-P[0], -P[1], -P[2], -P[3]);
          u.h[1] = *reinterpret_cast<const bf16x4*>(vT + (16 * nb + fr) * 16 + fq * 4);
          X = u.v;
        }
        const f32x4 Y = __builtin_amdgcn_mfma_f32_16x16x32_bf16(AY, X, R, 0, 0, 0);
#pragma unroll
        for (int e = 0; e < 4; ++e) {
          const int t = t0 + 4 * fq + e;
          const int row = base + (z == 0 ? t : (Tlen - 1 - t));
          yout[((size_t)z * TT + row) * DM + colb + 16 * nb + fr] = Y[e];
        }
#pragma unroll
        for (int b = 0; b < 4; ++b) {
          const f32x4 wcv = *reinterpret_cast<const f32x4*>(WCf + 16 * b + 4 * fq);
          ST[b][nb] = __builtin_amdgcn_mfma_f32_16x16x32_bf16(AS[b], X, ST[b][nb] * wcv, 0, 0, 0);
        }
        __builtin_amdgcn_sched_barrier(0);
      }
    }
    if (seq < 16) {
      const int l2 = tidx() & 63, fr2 = l2 & 15, fq2 = l2 >> 4;
      float* so = p.out + OUT_STATE + ((((size_t)seq * 2 + j) * 2 + z) * 16 + h) * 4096;
#pragma unroll
      for (int b = 0; b < 4; ++b)
#pragma unroll
        for (int nb = 0; nb < 4; ++nb) *reinterpret_cast<f32x4*>(so + (size_t)(16 * nb + fr2) * 64 + 16 * b + 4 * fq2) = ST[b][nb];
    }
  }
}

DEVINL void phase_r5(const Params& p, int layer, int w, int nw) {
  const int j = layer >> 1;
  const int lane = tidx() & 63;
  const int gw = w * NWAVES + (tidx() >> 6), ngw = nw * NWAVES;
  const bf16_t* rb = reinterpret_cast<const bf16_t*>(p.U2);
  const bf16_t* kb = rb + (size_t)TT * DM;
  const bf16_t* vb = kb + (size_t)TT * DM;
  const bf16_t* aa = reinterpret_cast<const bf16_t*>(p.U1 + U1_AA_OFF);
  const bf16_t* gg = reinterpret_cast<const bf16_t*>(p.U1 + U1_GG_OFF);
  const float* yin = reinterpret_cast<const float*>(p.U3);
  const float* ka = p.in[23] + j * 1024;
  const float* rk = p.in[24] + j * 1024;
  const float* lg = p.in[25] + j * 1024;
  const float* lb = p.in[26] + j * 1024;
  for (int row = gw; row < TT; row += ngw) {
#pragma unroll
    for (int k = 0; k < 4; ++k) {
      const int col = k * 256 + lane * 4;
      const size_t o = (size_t)row * DM + col;
      const float4 yf = *reinterpret_cast<const float4*>(yin + o);
      const float4 yb = *reinterpret_cast<const float4*>(yin + (size_t)TT * DM + o);
      const uint2 r2 = *reinterpret_cast<const uint2*>(rb + o);
      const uint2 k2 = *reinterpret_cast<const uint2*>(kb + o);
      const uint2 v2 = *reinterpret_cast<const uint2*>(vb + o);
      const uint2 a02 = *reinterpret_cast<const uint2*>(aa + o);
      const uint2 a12 = *reinterpret_cast<const uint2*>(aa + (size_t)TT * DM + o);
      const uint2 g2 = *reinterpret_cast<const uint2*>(gg + o);
      const float4 ka4 = *reinterpret_cast<const float4*>(ka + col);
      const float4 rk4 = *reinterpret_cast<const float4*>(rk + col);
      const float4 lg4 = *reinterpret_cast<const float4*>(lg + col);
      const float4 lb4 = *reinterpret_cast<const float4*>(lb + col);
      float y[4] = {yf.x + yb.x, yf.y + yb.y, yf.z + yb.z, yf.w + yb.w};
      float r[4] = {bflo(r2.x), bfhi(r2.x), bflo(r2.y), bfhi(r2.y)};
      float kx[4] = {bflo(k2.x), bfhi(k2.x), bflo(k2.y), bfhi(k2.y)};
      float v[4] = {bflo(v2.x), bfhi(v2.x), bflo(v2.y), bfhi(v2.y)};
      float a0[4] = {bflo(a02.x), bfhi(a02.x), bflo(a02.y), bfhi(a02.y)};
      float a1[4] = {bflo(a12.x), bfhi(a12.x), bflo(a12.y), bfhi(a12.y)};
      float g[4] = {bflo(g2.x), bfhi(g2.x), bflo(g2.y), bfhi(g2.y)};
      float kav[4] = {ka4.x, ka4.y, ka4.z, ka4.w}, rkv[4] = {rk4.x, rk4.y, rk4.z, rk4.w};
      float lgv[4] = {lg4.x, lg4.y, lg4.z, lg4.w}, lbv[4] = {lb4.x, lb4.y, lb4.z, lb4.w};
      float sm = y[0] + y[1] + y[2] + y[3];
      sm = grp16_sum(sm);
      const float mean = sm * (1.0f / 64.0f);
      float sv = 0.f, sb = 0.f;
#pragma unroll
      for (int e = 0; e < 4; ++e) {
        float d = y[e] - mean; sv += d * d;
        float kd0 = kx[e] * (1.0f + (a0[e] - 1.0f) * kav[e]);
        float kd1 = kx[e] * (1.0f + (a1[e] - 1.0f) * kav[e]);
        sb += r[e] * (kd0 + kd1) * rkv[e];
      }
      sv = grp16_sum(sv); sb = grp16_sum(sb);
      const float rstd = rsqrtf(sv * (1.0f / 64.0f) + GN_EPS_F);
      float o4[4];
#pragma unroll
      for (int e = 0; e < 4; ++e) {
        float yn = (y[e] - mean) * rstd * lgv[e] + lbv[e];
        o4[e] = (yn + sb * v[e]) * g[e];
      }
      uint2 oo; oo.x = pack2(o4[0], o4[1]); oo.y = pack2(o4[2], o4[3]);
      *reinterpret_cast<uint2*>(p.abuf + o) = oo;
    }
  }
}

struct EpiWO {
  static constexpr bool PERM = false;
  const float* x; const float* mod; float* z; int layer;
  DEVINL void operator()(const f32x4 (&acc)[2][2][4][2], const pg8::Unit& u, int wr, int wc, int fr, int fq) const {
    const int row0 = u.pm * 256 + wr * 64 + fr, col0 = u.pn * 256 + wc * 32 + 4 * fq;
    const float* gate = mod + ((size_t)layer * 9 + cond_of_row(u.pm * 256)) * 6144 + 2 * 1024;
    f32x4 gv[2][2];
#pragma unroll
    for (int bj = 0; bj < 2; ++bj)
#pragma unroll
      for (int n = 0; n < 2; ++n) gv[bj][n] = *reinterpret_cast<const f32x4*>(gate + col0 + bj * 128 + n * 16);
#pragma unroll
    for (int ai = 0; ai < 2; ++ai)
#pragma unroll
      for (int m = 0; m < 4; ++m) {
        const size_t off = (size_t)(row0 + ai * 128 + m * 16) * DM + col0;
#pragma unroll
        for (int bj = 0; bj < 2; ++bj)
#pragma unroll
          for (int n = 0; n < 2; ++n) {
            const f32x4 xv = *reinterpret_cast<const f32x4*>(x + off + bj * 128 + n * 16);
            *reinterpret_cast<f32x4*>(z + off + bj * 128 + n * 16) = ALPHA_F * xv + gv[bj][n] * acc[ai][bj][m][n];
          }
        asm volatile("" ::: "memory");
      }
  }
};
DEVINL void phase_wo(const Params& p, int layer, int w, int nw, char* smem) {
  const int j = layer >> 1;
  const bf16_t* Wt = ((layer & 1) ? p.attn_wo_t : p.rwkv_wo_t) + ((size_t)j << 20);
  EpiWO E; E.x = p.xbuf; E.mod = p.mod; E.z = p.zbuf; E.layer = layer;
  pg8::ASelOne as; as.A = (const char*)p.abuf;
  pg8::StaticOrder S; S.init(TT, 1024, nw, w);
  pg8::gemm_phase<EpiWO, pg8::ASelOne>((PG8_LAS unsigned char*)smem, as, Wt, 1024, S, E);
}

DEVINL void phase_ln1(const Params& p, int layer, int w, int nw) {
  const int lane = tidx() & 63;
  const int gw = w * NWAVES + (tidx() >> 6), ngw = nw * NWAVES;
  const float* lng = p.in[9] + (size_t)(layer * 2 + 0) * 1024;
  const float* lnb = p.in[10] + (size_t)(layer * 2 + 0) * 1024;
  for (int row = gw; row < TT; row += ngw) {
    const float* md = p.mod + ((size_t)layer * 9 + cond_of_row(row)) * 6144;
    float4 z[4];
    float s = 0.f;
#pragma unroll
    for (int k = 0; k < 4; ++k) {
      z[k] = *reinterpret_cast<const float4*>(p.zbuf + (size_t)row * DM + k * 256 + lane * 4);
      s += z[k].x + z[k].y + z[k].z + z[k].w;
    }
    const float mean = wave_sum(s) * (1.0f / 1024.0f);
    float sv = 0.f;
#pragma unroll
    for (int k = 0; k < 4; ++k) {
      float a = z[k].x - mean, b = z[k].y - mean, c = z[k].z - mean, d = z[k].w - mean;
      sv += a * a + b * b + c * c + d * d;
    }
    const float rstd = rsqrtf(wave_sum(sv) * (1.0f / 1024.0f) + LN_EPS_F);
#pragma unroll
    for (int k = 0; k < 4; ++k) {
      const int col = k * 256 + lane * 4;
      const float4 g4 = *reinterpret_cast<const float4*>(lng + col);
      const float4 b4 = *reinterpret_cast<const float4*>(lnb + col);
      const float4 sh = *reinterpret_cast<const float4*>(md + 3 * 1024 + col);
      const float4 sc = *reinterpret_cast<const float4*>(md + 4 * 1024 + col);
      float4 x1;
      x1.x = (z[k].x - mean) * rstd * g4.x + b4.x;
      x1.y = (z[k].y - mean) * rstd * g4.y + b4.y;
      x1.z = (z[k].z - mean) * rstd * g4.z + b4.z;
      x1.w = (z[k].w - mean) * rstd * g4.w + b4.w;
      *reinterpret_cast<float4*>(p.xbuf + (size_t)row * DM + col) = x1;
      uint2 o;
      o.x = pack2(x1.x * (1.0f + sc.x) + sh.x, x1.y * (1.0f + sc.y) + sh.y);
      o.y = pack2(x1.z * (1.0f + sc.z) + sh.z, x1.w * (1.0f + sc.w) + sh.w);
      *reinterpret_cast<uint2*>(p.hbuf + (size_t)row * DM + col) = o;
    }
  }
}

struct EpiBf16 {
  static constexpr bool PERM = true;
  bf16_t* O; int ldc;
  DEVINL void operator()(const f32x4 (&acc)[2][2][4][2], const pg8::Unit& u, int wr, int wc, int fr, int fq) const {
    const int row0 = u.pm * 256 + wr * 64 + fr, col0 = u.pn * 256 + wc * 32 + 8 * fq;
#pragma unroll
    for (int ai = 0; ai < 2; ++ai)
#pragma unroll
      for (int m = 0; m < 4; ++m) {
        bf16_t* rowp = O + (size_t)(row0 + ai * 128 + m * 16) * ldc + col0;
#pragma unroll
        for (int bj = 0; bj < 2; ++bj) {
          const f32x4 v0 = acc[ai][bj][m][0], v1 = acc[ai][bj][m][1];
          pg8::u32x4 o; o.x = pg8::cvt_pk_bf16(v0[0], v0[1]); o.y = pg8::cvt_pk_bf16(v0[2], v0[3]); o.z = pg8::cvt_pk_bf16(v1[0], v1[1]); o.w = pg8::cvt_pk_bf16(v1[2], v1[3]);
          *reinterpret_cast<pg8::u32x4*>(rowp + bj * 128) = o;
        }
      }
  }
};

DEVINL void phase_p1(const Params& p, int layer, int w, int nw, char* smem) {
  EpiBf16 E; E.O = reinterpret_cast<bf16_t*>(p.U1); E.ldc = 2048;
  pg8::ASelOne as; as.A = (const char*)p.hbuf;
  pg8::StaticOrder S; S.init(TT, 2048, nw, w);
  pg8::gemm_phase<EpiBf16, pg8::ASelOne>((PG8_LAS unsigned char*)smem, as, p.wq_t + (size_t)layer * 2048 * 1024, 1024, S, E);
}

#define U1_S_OFF ((size_t)TT * 2048 * 2)
DEVINL void phase_p2(const Params& p, int layer, int w, int nw, char* smem) {
  GEMM_LANE_VARS
  const int half = tidx() >> 8;
  char* sh = smem + half * 16384;
  const bf16_t* qb = reinterpret_cast<const bf16_t*>(p.U1);
  float* sb = reinterpret_cast<float*>(p.U1 + U1_S_OFF);
  const int NTILES = 96 * 16;
  for (int it = 0; it * nw * 2 < NTILES; ++it) {
    int tile = (it * nw + w) * 2 + half;
    const bool valid = tile < NTILES;
    if (!valid) tile = 0;
    const int ct = tile / 96, rt = tile % 96;
    const int row0 = rt * 128;
    const int z = ct & 1;
    f32x4 acc[4][4];
    gemm_tile_128(qb + (size_t)row0 * 2048 + ct * 128, 2048, p.keysb + (size_t)(layer * 2 + z) * 16384, 128, 128, sh, acc);
    if (valid) {
#pragma unroll
      for (int m = 0; m < 4; ++m)
#pragma unroll
        for (int n = 0; n < 4; ++n)
#pragma unroll
          for (int jj = 0; jj < 4; ++jj) {
            int row = row0 + wr * 64 + m * 16 + fq * 4 + jj, col = wc * 64 + n * 16 + fr;
            sb[(size_t)row * 2048 + ct * 128 + col] = acc[m][n][jj];
          }
    }
  }
}

DEVINL void phase_p3(const Params& p, int layer, int w, int nw, char* smem) {
  const int lane = tidx() & 63, wid = tidx() >> 6;
  const int gw = w * NWAVES + wid, ngw = nw * NWAVES;
  const float* sb = reinterpret_cast<const float*>(p.U1 + U1_S_OFF);
  float* svl = reinterpret_cast<float*>(smem) + wid * 64;
  int* sil = reinterpret_cast<int*>(smem) + 512 + wid * 64;
  for (int t = gw; t < TT; t += ngw) {
    for (int h = 0; h < 8; ++h) {
      __builtin_amdgcn_wave_barrier();
#pragma unroll 1
      for (int z = 0; z < 2; ++z) {
        const float* sp = sb + (size_t)t * 2048 + (h * 2 + z) * 128;
        const float s0 = sp[lane], s1 = sp[lane + 64];
        unsigned k0 = (ordf(s0) & ~127u) | (unsigned)(127 - lane);
        unsigned k1 = (ordf(s1) & ~127u) | (unsigned)(63 - lane);
        int myidx = 0;
#pragma unroll 1
        for (int it = 0; it < 16; ++it) {
          unsigned m = wave_max_u(k0 > k1 ? k0 : k1);
          int idx = 127 - (int)(m & 127u);
          if (lane == it) myidx = idx;
          if (k0 == m) k0 = 0;
          if (k1 == m) k1 = 0;
        }
        if (lane < 16) { svl[z * 16 + lane] = sp[myidx]; sil[z * 16 + lane] = myidx; }
      }
      __builtin_amdgcn_wave_barrier();
      unsigned kc[4];
#pragma unroll
      for (int c = 0; c < 4; ++c) {
        int ci = lane * 4 + c;
        float sum = svl[ci >> 4] + svl[16 + (ci & 15)];
        kc[c] = (ordf(sum) & ~255u) | (unsigned)(255 - ci);
      }
      int myci = 0;
#pragma unroll 1
      for (int it = 0; it < 16; ++it) {
        unsigned a = kc[0] > kc[1] ? kc[0] : kc[1], b = kc[2] > kc[3] ? kc[2] : kc[3];
        unsigned m = wave_max_u(a > b ? a : b);
        int ci = 255 - (int)(m & 255u);
        if (lane == it) myci = ci;
#pragma unroll
        for (int c = 0; c < 4; ++c) if (kc[c] == m) kc[c] = 0;
      }
      const int ii = (myci >> 4) & 15, jj = myci & 15;
      float cv = svl[ii] + svl[16 + jj];
      int e = sil[ii] * 128 + sil[16 + jj];
      float mx = cv;
#pragma unroll
      for (int o = 8; o > 0; o >>= 1) mx = fmaxf(mx, __shfl_xor(mx, o));
      float ex = __expf(cv - mx);
      float sm = grp16_sum(ex);
      if (lane < 16) {
        p.pidx[(size_t)t * 128 + h * 16 + lane] = e;
        p.pgate[(size_t)t * 128 + h * 16 + lane] = ex / sm;
      }
    }
  }
}

DEVINL float gelu_exact(float x) { return 0.5f * x * (1.0f + erff(x * 0.7071067811865476f)); }

DEVINL void phase_p4(const Params& p, int layer, int w, int nw, char* smem) {
  const int tid = tidx(), lane = tid & 63, wid = tid >> 6;
  const int fr = lane & 15, fq = lane >> 4;
  const int gw = w * NWAVES + wid, ngw = nw * NWAVES;
  const bf16_t* U = p.ub + (size_t)layer * 16384 * 1024;
  const bf16_t* V = p.vb + (size_t)layer * 16384 * 1024;
  const float* lng = p.in[9] + (size_t)(layer * 2 + 1) * 1024;
  const float* lnb = p.in[10] + (size_t)(layer * 2 + 1) * 1024;
  float* xout = (layer == 3) ? p.out : p.xbuf;
  char* wl = smem + wid * 3072;
  bf16_t* xl = reinterpret_cast<bf16_t*>(wl);
  float* wgt = reinterpret_cast<float*>(wl + 2048);
  int* il = reinterpret_cast<int*>(wl + 2560);
  for (int t = gw; t < TT; t += ngw) {
    __builtin_amdgcn_wave_barrier();
    {
      const uint4 a = *reinterpret_cast<const uint4*>(p.hbuf + (size_t)t * DM + lane * 8);
      const uint4 b = *reinterpret_cast<const uint4*>(p.hbuf + (size_t)t * DM + 512 + lane * 8);
      *reinterpret_cast<uint4*>(xl + lane * 8) = a;
      *reinterpret_cast<uint4*>(xl + 512 + lane * 8) = b;
      il[lane] = p.pidx[(size_t)t * 128 + lane];
      il[64 + lane] = p.pidx[(size_t)t * 128 + 64 + lane];
    }
    __builtin_amdgcn_wave_barrier();
    const bf16_t* up[8];
#pragma unroll
    for (int g = 0; g < 8; ++g) up[g] = U + (size_t)il[g * 16 + fr] * DM + fq * 8;
    f32x4 acc[8];
#pragma unroll
    for (int g = 0; g < 8; ++g) acc[g] = (f32x4){0.f, 0.f, 0.f, 0.f};
#pragma unroll 2
    for (int s = 0; s < 32; ++s) {
      const bf16x8 xf = *reinterpret_cast<const bf16x8*>(xl + s * 32 + fq * 8);
      bf16x8 a[8];
#pragma unroll
      for (int g = 0; g < 8; ++g) a[g] = *reinterpret_cast<const bf16x8*>(up[g] + s * 32);
#pragma unroll
      for (int g = 0; g < 8; ++g) acc[g] = __builtin_amdgcn_mfma_f32_16x16x32_bf16(a[g], xf, acc[g], 0, 0, 0);
    }
#pragma unroll
    for (int g = 0; g < 8; ++g) {
      const float4 gt = *reinterpret_cast<const float4*>(p.pgate + (size_t)t * 128 + g * 16 + fq * 4);
      float4 wv;
      wv.x = gt.x * gelu_exact(acc[g][0]);
      wv.y = gt.y * gelu_exact(acc[g][1]);
      wv.z = gt.z * gelu_exact(acc[g][2]);
      wv.w = gt.w * gelu_exact(acc[g][3]);
      if (fr == 0) *reinterpret_cast<float4*>(wgt + g * 16 + fq * 4) = wv;
    }
    __builtin_amdgcn_wave_barrier();
    float f[16];
#pragma unroll
    for (int e = 0; e < 16; ++e) f[e] = 0.f;
#pragma unroll 8
    for (int e = 0; e < 128; ++e) {
      const int idx = __builtin_amdgcn_readfirstlane(il[e]);
      const float we = wgt[e];
      const bf16_t* vp = V + (size_t)idx * DM;
      const uint4 c = *reinterpret_cast<const uint4*>(vp + lane * 8);
      const uint4 dd = *reinterpret_cast<const uint4*>(vp + 512 + lane * 8);
      f[0] += we * bflo(c.x); f[1] += we * bfhi(c.x); f[2] += we * bflo(c.y); f[3] += we * bfhi(c.y);
      f[4] += we * bflo(c.z); f[5] += we * bfhi(c.z); f[6] += we * bflo(c.w); f[7] += we * bfhi(c.w);
      f[8] += we * bflo(dd.x); f[9] += we * bfhi(dd.x); f[10] += we * bflo(dd.y); f[11] += we * bfhi(dd.y);
      f[12] += we * bflo(dd.z); f[13] += we * bfhi(dd.z); f[14] += we * bflo(dd.w); f[15] += we * bfhi(dd.w);
    }
    const float* md = p.mod + ((size_t)layer * 9 + cond_of_row(t)) * 6144 + 5 * 1024;
    float zz[16];
    float s = 0.f;
#pragma unroll
    for (int hf = 0; hf < 2; ++hf) {
      const int col = hf * 512 + lane * 8;
      const float4 x0 = *reinterpret_cast<const float4*>(p.xbuf + (size_t)t * DM + col);
      const float4 x1 = *reinterpret_cast<const float4*>(p.xbuf + (size_t)t * DM + col + 4);
      const float4 g0 = *reinterpret_cast<const float4*>(md + col);
      const float4 g1 = *reinterpret_cast<const float4*>(md + col + 4);
      const float xv[8] = {x0.x, x0.y, x0.z, x0.w, x1.x, x1.y, x1.z, x1.w};
      const float gv[8] = {g0.x, g0.y, g0.z, g0.w, g1.x, g1.y, g1.z, g1.w};
#pragma unroll
      for (int e = 0; e < 8; ++e) { zz[hf * 8 + e] = ALPHA_F * xv[e] + gv[e] * f[hf * 8 + e]; s += zz[hf * 8 + e]; }
    }
    const float mean = wave_sum(s) * (1.0f / 1024.0f);
    float sv = 0.f;
#pragma unroll
    for (int e = 0; e < 16; ++e) { float d = zz[e] - mean; sv += d * d; }
    const float rstd = rsqrtf(wave_sum(sv) * (1.0f / 1024.0f) + LN_EPS_F);
#pragma unroll
    for (int hf = 0; hf < 2; ++hf) {
      const int col = hf * 512 + lane * 8;
      const float4 g0 = *reinterpret_cast<const float4*>(lng + col);
      const float4 g1 = *reinterpret_cast<const float4*>(lng + col + 4);
      const float4 b0 = *reinterpret_cast<const float4*>(lnb + col);
      const float4 b1 = *reinterpret_cast<const float4*>(lnb + col + 4);
      float4 o0, o1;
      o0.x = (zz[hf * 8 + 0] - mean) * rstd * g0.x + b0.x;
      o0.y = (zz[hf * 8 + 1] - mean) * rstd * g0.y + b0.y;
      o0.z = (zz[hf * 8 + 2] - mean) * rstd * g0.z + b0.z;
      o0.w = (zz[hf * 8 + 3] - mean) * rstd * g0.w + b0.w;
      o1.x = (zz[hf * 8 + 4] - mean) * rstd * g1.x + b1.x;
      o1.y = (zz[hf * 8 + 5] - mean) * rstd * g1.y + b1.y;
      o1.z = (zz[hf * 8 + 6] - mean) * rstd * g1.z + b1.z;
      o1.w = (zz[hf * 8 + 7] - mean) * rstd * g1.w + b1.w;
      *reinterpret_cast<float4*>(xout + (size_t)t * DM + col) = o0;
      *reinterpret_cast<float4*>(xout + (size_t)t * DM + col + 4) = o1;
    }
  }
}

DEVINL void phase_a1(const Params& p, int layer, int w, int nw) {
  const int lane = tidx() & 63;
  const int gw = w * NWAVES + (tidx() >> 6), ngw = nw * NWAVES;
  for (int row = gw; row < TT; row += ngw) {
    const float* md = p.mod + ((size_t)layer * 9 + cond_of_row(row)) * 6144;
#pragma unroll
    for (int k = 0; k < 4; ++k) {
      const int col = k * 256 + lane * 4;
      const float4 x = *reinterpret_cast<const float4*>(p.xbuf + (size_t)row * DM + col);
      const float4 sh = *reinterpret_cast<const float4*>(md + col);
      const float4 sc = *reinterpret_cast<const float4*>(md + 1024 + col);
      uint2 o;
      o.x = pack2(x.x * (1.0f + sc.x) + sh.x, x.y * (1.0f + sc.y) + sh.y);
      o.y = pack2(x.z * (1.0f + sc.z) + sh.z, x.w * (1.0f + sc.w) + sh.w);
      *reinterpret_cast<uint2*>(p.hbuf + (size_t)row * DM + col) = o;
    }
  }
}

DEVINL void phase_a2(const Params& p, int layer, int w, int nw, char* smem) {
  const int j = layer >> 1;
  EpiBf16 E; E.O = reinterpret_cast<bf16_t*>(p.U1); E.ldc = 1536;
  pg8::ASelOne as; as.A = (const char*)p.hbuf;
  pg8::StaticOrder S; S.init(TT, 1536, nw, w);
  pg8::gemm_phase<EpiBf16, pg8::ASelOne>((PG8_LAS unsigned char*)smem, as, p.attn_wqkv_t + (size_t)j * 1536 * 1024, 1024, S, E);
}

DEVINL void load16(const bf16_t* src, float (&x)[16]) {
  const uint4 a = *reinterpret_cast<const uint4*>(src);
  const uint4 b = *reinterpret_cast<const uint4*>(src + 8);
  x[0] = bflo(a.x); x[1] = bfhi(a.x); x[2] = bflo(a.y); x[3] = bfhi(a.y); x[4] = bflo(a.z); x[5] = bfhi(a.z); x[6] = bflo(a.w); x[7] = bfhi(a.w);
  x[8] = bflo(b.x); x[9] = bfhi(b.x); x[10] = bflo(b.y); x[11] = bfhi(b.y); x[12] = bflo(b.z); x[13] = bfhi(b.z); x[14] = bflo(b.w); x[15] = bfhi(b.w);
}
DEVINL void store16bf(bf16_t* dst, const float (&x)[16]) {
  uint4 a, b;
  a.x = pack2(x[0], x[1]); a.y = pack2(x[2], x[3]); a.z = pack2(x[4], x[5]); a.w = pack2(x[6], x[7]);
  b.x = pack2(x[8], x[9]); b.y = pack2(x[10], x[11]); b.z = pack2(x[12], x[13]); b.w = pack2(x[14], x[15]);
  *reinterpret_cast<uint4*>(dst) = a; *reinterpret_cast<uint4*>(dst + 8) = b;
}
DEVINL void headnorm_rope(float (&x)[16], const float* nwgt, int quarter, bool lat, int t, const float* rope) {
  float ss = 0.f;
#pragma unroll
  for (int e = 0; e < 16; ++e) ss += x[e] * x[e];
  ss += __shfl_xor(ss, 1); ss += __shfl_xor(ss, 2);
  const float rinv = rsqrtf(ss * (1.0f / 64.0f) + RMS_EPS_F);
#pragma unroll
  for (int e = 0; e < 16; ++e) x[e] = x[e] * rinv * nwgt[quarter * 16 + e];
  if (lat) {
    const int pos = (quarter < 2) ? (t >> 6) : (t & 63);
    const bool hi = quarter & 1;
#pragma unroll
    for (int e = 0; e < 16; ++e) {
      const float other = __shfl_xor(x[e], 1);
      const float c = rope[(pos * 16 + e) * 2], s = rope[(pos * 16 + e) * 2 + 1];
      x[e] = hi ? (x[e] * c + other * s) : (x[e] * c - other * s);
    }
  }
}

DEVINL void phase_a2b(const Params& p, int layer, int w, int nw) {
  const int j = layer >> 1;
  const int lane = tidx() & 63;
  const int gw = w * NWAVES + (tidx() >> 6), ngw = nw * NWAVES;
  const bf16_t* qkv = reinterpret_cast<const bf16_t*>(p.U1);
  bf16_t* qb = reinterpret_cast<bf16_t*>(p.U2);
  const float* qn = p.in[29] + j * 64;
  const float* kn = p.in[30] + j * 64;
  for (int row = gw; row < TT; row += ngw) {
    const bool lat = row >= TCTX;
    const int t = lat ? ((row - TCTX) & 1023) : (row & 255);
    const int b = lat ? ((row - TCTX) >> 10) : (row >> 8);
    const bf16_t* src = qkv + (size_t)row * 1536;
    {
      float x[16];
      load16(src + lane * 16, x);
      headnorm_rope(x, qn, lane & 3, lat, t, p.rope);
#pragma unroll
      for (int e = 0; e < 16; ++e) x[e] *= QSCALE_F;
      store16bf(qb + (size_t)row * DM + lane * 16, x);
    }
    if (lane < 16) {
      const int kvh = lane >> 2, quarter = lane & 3;
      float x[16];
      load16(src + 1024 + lane * 16, x);
      headnorm_rope(x, kn, quarter, false, t, p.rope);
      if (lat) {
        const int pos = (quarter < 2) ? (t >> 6) : (t & 63);
        const bool hi = quarter & 1;
#pragma unroll
        for (int e = 0; e < 16; ++e) {
          const float other = __shfl_xor(x[e], 1);
          const float c = p.rope[(pos * 16 + e) * 2], s = p.rope[(pos * 16 + e) * 2 + 1];
          x[e] = hi ? (x[e] * c + other * s) : (x[e] * c - other * s);
        }
        store16bf(p.Klat + ((size_t)((j * 8 + b) * 4 + kvh) * 1536 + 512 + t) * 64 + quarter * 16, x);
      } else {
        store16bf(p.Kctx + ((size_t)((j * 16 + b) * 4 + kvh) * 256 + t) * 64 + quarter * 16, x);
        float* ko = p.out + OUT_CK + ((size_t)(b * 2 + j) * 256 + t) * 256 + kvh * 64 + quarter * 16;
#pragma unroll
        for (int q4 = 0; q4 < 4; ++q4) reinterpret_cast<float4*>(ko)[q4] = make_float4(x[q4 * 4], x[q4 * 4 + 1], x[q4 * 4 + 2], x[q4 * 4 + 3]);
      }
    } else if (lane < 32) {
      const int l2 = lane - 16;
      const int kvh = l2 >> 2, quarter = l2 & 3;
      float x[16];
      load16(src + 1280 + l2 * 16, x);
      if (lat) {
        bf16_t* vd = p.VlatT + (size_t)((j * 8 + b) * 4 + kvh) * 64 * 1536 + 512 + t;
#pragma unroll
        for (int e = 0; e < 16; ++e) vd[(size_t)(quarter * 16 + e) * 1536] = f2bf(x[e]);
      } else {
        bf16_t* vd = p.VctxT + (size_t)((j * 16 + b) * 4 + kvh) * 64 * 256 + t;
#pragma unroll
        for (int e = 0; e < 16; ++e) vd[(size_t)(quarter * 16 + e) * 256] = f2bf(x[e]);
        float* vo = p.out + OUT_CV + ((size_t)(b * 2 + j) * 256 + t) * 256 + kvh * 64 + quarter * 16;
#pragma unroll
        for (int q4 = 0; q4 < 4; ++q4) reinterpret_cast<float4*>(vo)[q4] = make_float4(x[q4 * 4], x[q4 * 4 + 1], x[q4 * 4 + 2], x[q4 * 4 + 3]);
      }
    }
  }
}

DEVINL void phase_a3(const Params& p, int layer, int w, int nw) {
  const int j = layer >> 1;
  const int lane = tidx() & 63, wid = tidx() >> 6;
  const int ql = lane & 31, hh = lane >> 5;
  const bf16_t* qb = reinterpret_cast<const bf16_t*>(p.U2);
  for (int item = w; item < 768; item += nw) {
    int hq, Tk, row0;
    const bf16_t *Kb, *Vt;
    if (item < 512) {
      const int b = item >> 6, qblk = item & 3;
      hq = (item >> 2) & 15;
      const int kvh = hq >> 2;
      Kb = p.Klat + (size_t)((j * 8 + b) * 4 + kvh) * 1536 * 64;
      Vt = p.VlatT + (size_t)((j * 8 + b) * 4 + kvh) * 64 * 1536;
      Tk = 1536; row0 = TCTX + b * 1024 + qblk * 256;
    } else {
      const int it = item - 512;
      const int b = it >> 4;
      hq = it & 15;
      const int kvh = hq >> 2;
      Kb = p.Kctx + (size_t)((j * 16 + b) * 4 + kvh) * 256 * 64;
      Vt = p.VctxT + (size_t)((j * 16 + b) * 4 + kvh) * 64 * 256;
      Tk = 256; row0 = b * 256;
    }
    const int qrow = row0 + wid * 32 + ql;
    bf16x8 bq[4];
#pragma unroll
    for (int ks = 0; ks < 4; ++ks) bq[ks] = *reinterpret_cast<const bf16x8*>(qb + (size_t)qrow * DM + hq * 64 + ks * 16 + hh * 8);
    f32x16 o0, o1;
#pragma unroll
    for (int r = 0; r < 16; ++r) { o0[r] = 0.f; o1[r] = 0.f; }
    float mrun = -1e30f, lrun = 0.f;
    for (int kt = 0; kt < Tk; kt += 32) {
      f32x16 sacc;
#pragma unroll
      for (int r = 0; r < 16; ++r) sacc[r] = 0.f;
#pragma unroll
      for (int ks = 0; ks < 4; ++ks) {
        bf16x8 ka = *reinterpret_cast<const bf16x8*>(Kb + (size_t)(kt + ql) * 64 + ks * 16 + hh * 8);
        sacc = __builtin_amdgcn_mfma_f32_32x32x16_bf16(ka, bq[ks], sacc, 0, 0, 0);
      }
      float tmax = sacc[0];
#pragma unroll
      for (int r = 1; r < 16; ++r) tmax = fmaxf(tmax, sacc[r]);
      tmax = fmaxf(tmax, __shfl_xor(tmax, 32));
      const float mnew = fmaxf(mrun, tmax);
      const float corr = exp2f(mrun - mnew);
      mrun = mnew;
      lrun *= corr;
#pragma unroll
      for (int r = 0; r < 16; ++r) { o0[r] *= corr; o1[r] *= corr; }
      float pv[16];
#pragma unroll
      for (int r = 0; r < 16; ++r) { pv[r] = exp2f(sacc[r] - mnew); lrun += pv[r]; }
#pragma unroll
      for (int s2 = 0; s2 < 2; ++s2) {
        union { bf16x8 v; unsigned u[4]; } pb;
#pragma unroll
        for (int q = 0; q < 4; ++q) pb.u[q] = pack2(pv[s2 * 8 + q * 2], pv[s2 * 8 + q * 2 + 1]);
#pragma unroll
        for (int dblk = 0; dblk < 2; ++dblk) {
          const bf16_t* vp = Vt + (size_t)(dblk * 32 + ql) * Tk + kt + 16 * s2 + 4 * hh;
          const uint2 lo = *reinterpret_cast<const uint2*>(vp);
          const uint2 hi = *reinterpret_cast<const uint2*>(vp + 8);
          union { bf16x8 v; unsigned u[4]; } va;
          va.u[0] = lo.x; va.u[1] = lo.y; va.u[2] = hi.x; va.u[3] = hi.y;
          if (dblk == 0) o0 = __builtin_amdgcn_mfma_f32_32x32x16_bf16(va.v, pb.v, o0, 0, 0, 0);
          else o1 = __builtin_amdgcn_mfma_f32_32x32x16_bf16(va.v, pb.v, o1, 0, 0, 0);
        }
      }
    }
    const float ltot = lrun + __shfl_xor(lrun, 32);
    const float inv = 1.0f / ltot;
#pragma unroll
    for (int g = 0; g < 4; ++g) {
      uint2 oa, ob;
      oa.x = pack2(o0[4 * g] * inv, o0[4 * g + 1] * inv); oa.y = pack2(o0[4 * g + 2] * inv, o0[4 * g + 3] * inv);
      ob.x = pack2(o1[4 * g] * inv, o1[4 * g + 1] * inv); ob.y = pack2(o1[4 * g + 2] * inv, o1[4 * g + 3] * inv);
      *reinterpret_cast<uint2*>(p.abuf + (size_t)qrow * DM + hq * 64 + 8 * g + 4 * hh) = oa;
      *reinterpret_cast<uint2*>(p.abuf + (size_t)qrow * DM + hq * 64 + 32 + 8 * g + 4 * hh) = ob;
    }
  }
}

#define XB_TMO      128
#define XB_XCNT(j)  (256  + 64 * (j))
#define XB_XSUB(j)  (1280 + 64 * (j))
#define XB_XGEN(j)  (2304 + 64 * (j))
#define XB_TOP      3328
#define XB_TOPGEN   3392
#define XCD_BAR_WORDS 3456
#define XB_SPIN_CAP (1u << 22)
#define LAS __attribute__((address_space(3)))

DEVINL unsigned xb_ld(unsigned* p) { return __hip_atomic_load(p, __ATOMIC_RELAXED, __HIP_MEMORY_SCOPE_AGENT); }
DEVINL unsigned xb_add(unsigned* p, unsigned v) { return __hip_atomic_fetch_add(p, v, __ATOMIC_RELAXED, __HIP_MEMORY_SCOPE_AGENT); }
DEVINL unsigned xb_xcc_id() { return (unsigned)__builtin_amdgcn_s_getreg((3 << 11) | 20) & 0xFu; }
#define XB_SPIN(cond, bar) do { unsigned _sp = 0; while (cond) { __builtin_amdgcn_s_sleep(1); \
    if ((++_sp & 255u) == 0u) { if (xb_ld(&(bar)[XB_TMO])) break; if (_sp > XB_SPIN_CAP) { atomicAdd(&(bar)[XB_TMO], 1u); break; } } } } while (0)

struct XcdBarrier { unsigned* bar; unsigned x; volatile LAS unsigned* st; };

DEVINL XcdBarrier xcd_barrier_post(unsigned* bar, volatile LAS unsigned* st) {
  XcdBarrier b; b.bar = bar; b.x = xb_xcc_id(); b.st = st;
  if (threadIdx.x == 0) (void)xb_add(&bar[XB_XCNT(b.x)], 1u);
  return b;
}
DEVINL void xcd_barrier_complete(unsigned* bar, unsigned x, unsigned& nloc, unsigned& nx) {
  const unsigned G = gridDim.x * gridDim.y * gridDim.z;
  unsigned sum, cnt, mine, sp = 0u;
  for (;;) {
    sum = 0u; cnt = 0u; mine = 0u;
#pragma unroll
    for (unsigned j = 0; j < 16; ++j) { const unsigned c = xb_ld(&bar[XB_XCNT(j)]); sum += c; cnt += (c > 0u) ? 1u : 0u; mine = (j == x) ? c : mine; }
    if (sum == G) break;
    __builtin_amdgcn_s_sleep(1);
    if ((++sp & 255u) == 0u) { if (xb_ld(&bar[XB_TMO])) break; if (sp > XB_SPIN_CAP) { atomicAdd(&bar[XB_TMO], 1u); break; } }
  }
  nloc = mine > 0u ? mine : 1u; nx = cnt > 0u ? cnt : 1u;
}
DEVINL void xcd_barrier(const XcdBarrier& b) {
  asm volatile("s_waitcnt vmcnt(0)" ::: "memory");
  __syncthreads();
  if (threadIdx.x == 0) {
    unsigned* bar = b.bar;
    __builtin_amdgcn_s_waitcnt(0);
    unsigned nloc = b.st[0], nx = b.st[1];
    if (nloc == 0u) { xcd_barrier_complete(bar, b.x, nloc, nx); b.st[0] = nloc; b.st[1] = nx; }
    const unsigned old = xb_add(&bar[XB_XSUB(b.x)], 1u);
    const unsigned gen = old / nloc;
    if (old + 1u == (gen + 1u) * nloc) {
      __builtin_amdgcn_fence(__ATOMIC_RELEASE, "agent");
      asm volatile("s_waitcnt vmcnt(0)" ::: "memory");
      const unsigned og = xb_add(&bar[XB_TOP], 1u);
      const unsigned tg = og / nx;
      if (og + 1u == (tg + 1u) * nx) xb_add(&bar[XB_TOPGEN], 1u);
      else XB_SPIN(xb_ld(&bar[XB_TOPGEN]) == tg, bar);
      __builtin_amdgcn_fence(__ATOMIC_ACQUIRE, "agent");
      xb_add(&bar[XB_XGEN(b.x)], 1u);
      asm volatile("s_waitcnt vmcnt(0)" ::: "memory");
    } else {
      XB_SPIN(xb_ld(&bar[XB_XGEN(b.x)]) == gen, bar);
      __builtin_amdgcn_fence(__ATOMIC_ACQUIRE, "agent");
      asm volatile("s_waitcnt vmcnt(0)" ::: "memory");
    }
  }
  __syncthreads();
}

extern __shared__ __attribute__((aligned(16))) char dyn_smem[];
__global__ void __launch_bounds__(NTHREADS, 2) mega_kernel(Params p) {
  char* smem = dyn_smem;
  cg::grid_group grid = cg::this_grid();
  const int w = blockIdx.x, nw = gridDim.x;
  if (p.use_cg_sync) grid.sync();
  volatile LAS unsigned* xst = (volatile LAS unsigned*)(smem + SMEM_BYTES - 16);
  if (threadIdx.x == 0) { xst[0] = 0u; xst[1] = 0u; }
  __syncthreads();
  XcdBarrier xb = xcd_barrier_post(p.bar, xst);
#define GSYNC() xcd_barrier(xb)
#ifndef REP_PREP
#define REP_PREP 1
#endif
#ifndef REP_R4
#define REP_R4 1
#endif
#ifndef REP_P3
#define REP_P3 1
#endif
#ifndef REP_P4L3
#define REP_P4L3 1
#endif
#ifndef REP_A3
#define REP_A3 1
#endif
#ifndef REP_GEMM
#define REP_GEMM 1
#endif
#ifndef REP_SG
#define REP_SG 1
#endif
#ifndef REP_EW
#define REP_EW 1
#endif
  for (int rep = 0; rep < REP_PREP; ++rep) { phase_prep(p, w, nw, smem); GSYNC(); }
  for (int layer = 0; layer < 4; ++layer) {
    if ((layer & 1) == 0) {
      for (int rep = 0; rep < REP_EW; ++rep) { phase_r1(p, layer, w, nw); GSYNC(); }
      for (int rep = 0; rep < REP_GEMM; ++rep) { phase_r2(p, layer, w, nw, smem); GSYNC(); }
      for (int rep = 0; rep < REP_SG; ++rep) { phase_r3(p, layer, w, nw, smem); GSYNC(); }
      for (int rep = 0; rep < REP_R4; ++rep) { phase_r4(p, layer, w, nw, smem); GSYNC(); }
      for (int rep = 0; rep < REP_EW; ++rep) { phase_r5(p, layer, w, nw); GSYNC(); }
    } else {
      for (int rep = 0; rep < REP_EW; ++rep) { phase_a1(p, layer, w, nw); GSYNC(); }
      for (int rep = 0; rep < REP_GEMM; ++rep) { phase_a2(p, layer, w, nw, smem); GSYNC(); }
      for (int rep = 0; rep < REP_EW; ++rep) { phase_a2b(p, layer, w, nw); GSYNC(); }
      for (int rep = 0; rep < REP_A3; ++rep) { phase_a3(p, layer, w, nw); GSYNC(); }
    }
    for (int rep = 0; rep < REP_GEMM; ++rep) { phase_wo(p, layer, w, nw, smem); GSYNC(); }
    for (int rep = 0; rep < REP_EW; ++rep) { phase_ln1(p, layer, w, nw); GSYNC(); }
    for (int rep = 0; rep < REP_GEMM; ++rep) { phase_p1(p, layer, w, nw, smem); GSYNC(); }
    for (int rep = 0; rep < REP_SG; ++rep) { phase_p2(p, layer, w, nw, smem); GSYNC(); }
    for (int rep = 0; rep < REP_P3; ++rep) { phase_p3(p, layer, w, nw, smem); GSYNC(); }
    for (int rep = 0; rep < (layer == 3 ? REP_P4L3 : 1); ++rep) { phase_p4(p, layer, w, nw, smem); GSYNC(); }
  }
}

static inline char* carve(char*& cur, size_t bytes) {
  char* r = cur;
  cur += (bytes + 255) & ~(size_t)255;
  return r;
}

extern "C" void kernel_launch(void* const* d_in, const int* in_sizes, int n_in, void* d_out, int out_size, void* d_ws,
                              size_t ws_size, hipStream_t stream) {
  Params p;
  memset(&p, 0, sizeof(p));
  for (int i = 0; i < 35; ++i) p.in[i] = (const float*)d_in[i];
  p.out = (float*)d_out;
  char* cur = (char*)d_ws;
  p.bar = (unsigned*)carve(cur, 16384);
  p.mod = (float*)carve(cur, (size_t)4 * 9 * 6144 * 4);
  p.rope = (float*)carve(cur, 64 * 16 * 2 * 4);
  p.rwkv_in_t = (bf16_t*)carve(cur, (size_t)2 * RW_N * 1024 * 2);
  p.w2t = (bf16_t*)carve(cur, (size_t)4 * 65536 * 2);
  p.a2t = (bf16_t*)carve(cur, (size_t)4 * 65536 * 2);
  p.g2t = (bf16_t*)carve(cur, (size_t)2 * 131072 * 2);
  p.rwkv_wo_t = (bf16_t*)carve(cur, (size_t)2 * 1048576 * 2);
  p.attn_wqkv_t = (bf16_t*)carve(cur, (size_t)2 * 1536 * 1024 * 2);
  p.attn_wo_t = (bf16_t*)carve(cur, (size_t)2 * 1048576 * 2);
  p.wq_t = (bf16_t*)carve(cur, (size_t)4 * 2048 * 1024 * 2);
  p.keysb = (bf16_t*)carve(cur, (size_t)4 * 2 * 128 * 128 * 2);
  p.ub = (bf16_t*)carve(cur, (size_t)4 * 16384 * 1024 * 2);
  p.vb = (bf16_t*)carve(cur, (size_t)4 * 16384 * 1024 * 2);
  p.Klat = (bf16_t*)carve(cur, (size_t)2 * 8 * 4 * 1536 * 64 * 2);
  p.VlatT = (bf16_t*)carve(cur, (size_t)2 * 8 * 4 * 1536 * 64 * 2);
  p.Kctx = (bf16_t*)carve(cur, (size_t)2 * 16 * 4 * 256 * 64 * 2);
  p.VctxT = (bf16_t*)carve(cur, (size_t)2 * 16 * 4 * 256 * 64 * 2);
  p.xbuf = (float*)carve(cur, (size_t)TT * DM * 4);
  p.zbuf = (float*)carve(cur, (size_t)TT * DM * 4);
  p.hbuf = (bf16_t*)carve(cur, (size_t)TT * DM * 2);
  p.abuf = (bf16_t*)carve(cur, (size_t)TT * DM * 2);
  p.U1 = carve(cur, (size_t)TT * DM * 14);
  p.U2 = carve(cur, (size_t)TT * DM * 8);
  p.U3 = carve(cur, (size_t)TT * DM * 8);
  p.pidx = (int*)carve(cur, (size_t)TT * 128 * 4);
  p.pgate = (float*)carve(cur, (size_t)TT * 128 * 4);
  for (int f = 0; f < 16; ++f) p.freqs[f] = pow(10000.0, -(double)f / 16.0);
  if ((size_t)(cur - (char*)d_ws) > ws_size) {
    fprintf(stderr, "workspace too small: need %zu have %zu\n", (size_t)(cur - (char*)d_ws), ws_size);
    return;
  }
  static int grid_blocks = 0;
  if (!grid_blocks) {
    int dev = 0, cus = 0, per_cu = 0;
    (void)hipGetDevice(&dev);
    (void)hipDeviceGetAttribute(&cus, hipDeviceAttributeMultiprocessorCount, dev);
    (void)hipFuncSetAttribute((const void*)mega_kernel, hipFuncAttributeMaxDynamicSharedMemorySize, SMEM_BYTES);
    (void)hipOccupancyMaxActiveBlocksPerMultiprocessor(&per_cu, mega_kernel, NTHREADS, SMEM_BYTES);
    if (per_cu > 1) per_cu = 1;
    if (per_cu < 1) per_cu = 1;
    grid_blocks = cus * per_cu;
  }
  (void)hipMemsetAsync(p.bar, 0, 16384, stream);
  void* args[] = {&p};
  hipError_t e = hipLaunchCooperativeKernel((void*)mega_kernel, dim3(grid_blocks), dim3(NTHREADS), args, SMEM_BYTES, stream);
  if (e != hipSuccess) fprintf(stderr, "cooperative launch failed: %s (grid %d)\n", hipGetErrorString(e), grid_blocks);
}
```

```cpp
#include <hip/hip_runtime.h>
#include <hip/hip_cooperative_groups.h>
#include <stdint.h>
#include <string.h>
#include <math.h>
#include <stdio.h>

namespace cg = cooperative_groups;

typedef unsigned short bf16_t;
typedef __attribute__((ext_vector_type(8))) short bf16x8;
typedef __attribute__((ext_vector_type(4))) float f32x4;
typedef __attribute__((ext_vector_type(16))) float f32x16;

#define DEVINL __device__ __forceinline__
#define NTHREADS 512
#define NWAVES 8
#define GEMM_LDS 131072
#define SMEM_BYTES (131072 + 16384)
#define RW_N 3840

#define DM 1024
#define TCTX 4096
#define TLAT 8192
#define TT 12288
#define ALPHA_F 1.681792830507429f
#define LN_EPS_F 1e-5f
#define GN_EPS_F 6.4e-4f
#define RMS_EPS_F 1e-6f
#define QSCALE_F (0.125f * 1.4426950408889634f)

#define OUT_Y 0
#define OUT_STATE 12582912
#define OUT_CK 16777216
#define OUT_CV 18874368

struct Params {
  const float* in[35];
  float* out;
  float* mod;
  float* rope;
  bf16_t* rwkv_in_t;
  bf16_t* w2t;
  bf16_t* a2t;
  bf16_t* g2t;
  bf16_t* rwkv_wo_t;
  bf16_t* attn_wqkv_t;
  bf16_t* attn_wo_t;
  bf16_t* wq_t;
  bf16_t* keysb;
  bf16_t* ub;
  bf16_t* vb;
  bf16_t* Klat;
  bf16_t* VlatT;
  bf16_t* Kctx;
  bf16_t* VctxT;
  float* xbuf;
  float* zbuf;
  bf16_t* hbuf;
  bf16_t* abuf;
  char* U1;
  char* U2;
  char* U3;
  int* pidx;
  float* pgate;
  double freqs[16];
  unsigned* bar;
  int use_cg_sync;
  int pad0;
};

DEVINL int tidx() { int t = threadIdx.x; asm volatile("" : "+v"(t)); return t; }
DEVINL bf16_t f2bf(float f) {
  unsigned u = __float_as_uint(f);
  u += 0x7FFFu + ((u >> 16) & 1u);
  return (bf16_t)(u >> 16);
}
DEVINL float bf2f(bf16_t h) { return __uint_as_float(((unsigned)h) << 16); }
DEVINL unsigned pack2(float a, float b) { return (unsigned)f2bf(a) | ((unsigned)f2bf(b) << 16); }
DEVINL float bflo(unsigned u) { return __uint_as_float(u << 16); }
DEVINL float bfhi(unsigned u) { return __uint_as_float(u & 0xFFFF0000u); }

DEVINL float wave_sum(float v) {
#pragma unroll
  for (int o = 32; o > 0; o >>= 1) v += __shfl_xor(v, o);
  return v;
}
DEVINL float grp16_sum(float v) {
#pragma unroll
  for (int o = 8; o > 0; o >>= 1) v += __shfl_xor(v, o);
  return v;
}
DEVINL unsigned wave_max_u(unsigned v) {
#pragma unroll
  for (int o = 32; o > 0; o >>= 1) { unsigned t = (unsigned)__shfl_xor((int)v, o); v = v > t ? v : t; }
  return v;
}
DEVINL float sigmoidf_(float x) { return 1.0f / (1.0f + __expf(-x)); }
DEVINL float tanhf_(float x) { float e = __expf(-2.0f * fabsf(x)); float t = (1.0f - e) / (1.0f + e); return x < 0 ? -t : t; }
DEVINL unsigned ordf(float f) { unsigned u = __float_as_uint(f); return (u & 0x80000000u) ? ~u : (u | 0x80000000u); }

DEVINL int cond_of_row(int row) { return row < TCTX ? 8 : ((row - TCTX) >> 10); }


namespace pg8 {
#define PG8_LAS __attribute__((address_space(3)))
typedef unsigned u32x4 __attribute__((ext_vector_type(4)));
constexpr int BM = 256, BK = 64, HALF = 128, HTB = HALF * BK * 2, STAGE_BYTES = 8 * HTB, NXCD = 8, WGM = 8;
DEVINL int lds_byte(int r, int c) { const int st = (r >> 4) * 2 + (c >> 5), rr = r & 15, cc = c & 31, ob = rr * 64 + cc * 2; return st * 1024 + (ob ^ (((ob >> 9) & 1) << 5)); }
DEVINL void stage_rc(int b, int& R, int& C) { const int st = b / 1024, sb = b % 1024, swz = sb ^ (((sb >> 9) & 1) << 5); R = (st >> 1) * 16 + swz / 64; C = (st & 1) * 32 + (swz % 64) / 2; }
DEVINL int perm32(int rho) { const int n = rho >> 4, i = rho & 15; return 8 * (i >> 2) + 4 * n + (i & 3); }
struct Unit { int pm, pn; };
struct StaticOrder {
  int nM, nN, nwg, G, c;
  DEVINL void init(int M, int N, int G_, int c_) { nM = M / BM; nN = N / BM; nwg = nM * nN; G = G_; c = c_; }
  DEVINL bool next(int i, Unit& u) const {
    const long L = (long)i * G + c; if (L >= nwg) return false;
    int wgid = (int)L; { const int q = nwg / NXCD, r = nwg % NXCD, xcd = wgid % NXCD, off = wgid / NXCD; wgid = (xcd < r ? xcd * (q + 1) : r * (q + 1) + (xcd - r) * q) + off; }
    const int nig = WGM * nN, gid = wgid / nig, fm = gid * WGM, gsz = (nM - fm) < WGM ? (nM - fm) : WGM;
    u.pm = fm + ((wgid % nig) % gsz); u.pn = (wgid % nig) / gsz; return true;
  }
};
DEVINL unsigned cvt_pk_bf16(float lo, float hi) { unsigned r; asm volatile("v_cvt_pk_bf16_f32 %0, %1, %2" : "=v"(r) : "v"(lo), "v"(hi)); return r; }

template <class Epi, class ASel>
DEVINL void gemm_phase(PG8_LAS unsigned char* lds, const ASel& asel, const bf16_t* Bt, const int K, const StaticOrder& S, const Epi& E) {
  const int tid = tidx(), wid = __builtin_amdgcn_readfirstlane(tid >> 6), lane = tid & 63, wr = wid >> 2, wc = wid & 3, fr = lane & 15, fq = lane >> 4;
  const int nt = K / BK;
  unsigned voffA[2], voffB[2];
#pragma unroll
  for (int i = 0; i < 2; ++i) { int R, C; stage_rc(tid * 16 + i * 8192, R, C); const int Rb = Epi::PERM ? ((R & ~31) + perm32(R & 31)) : R;
    voffA[i] = (unsigned)(R * K + C) * 2u; voffB[i] = (unsigned)(Rb * K + C) * 2u; }
  const size_t kstep = (size_t)(BK * 2);
  const size_t hstep = (size_t)HALF * K * 2;
  const size_t tstep = 2 * hstep;
  const unsigned ldsw = (unsigned)wid * 1024u;
  const int aoff = lds_byte(wr * 64 + fr, fq * 8), boff = lds_byte(wc * 32 + fr, fq * 8);
#define PG8_SA(b, h) (((b) * 2 + (h)) * HTB)
#define PG8_SB(b, h) ((4 + (b) * 2 + (h)) * HTB)
#define PG8_STAGE(bufoff, gbase, voff) do { _Pragma("unroll") for (int _i = 0; _i < 2; ++_i) \
    __builtin_amdgcn_global_load_lds((const unsigned*)((const char*)(gbase) + (voff)[_i]), (PG8_LAS unsigned*)(lds + (bufoff) + ldsw + _i * 8192), 16, 0, 0); } while (0)
#define PG8_LDA(dst, b, h) do { _Pragma("unroll") for (int m = 0; m < 4; ++m) _Pragma("unroll") for (int k = 0; k < 2; ++k) dst[m][k] = *(const PG8_LAS bf16x8*)(lds + PG8_SA(b, h) + aoff + m * 2048 + k * 1024); } while (0)
#define PG8_LDB(dst, b, h) do { _Pragma("unroll") for (int n = 0; n < 2; ++n) _Pragma("unroll") for (int k = 0; k < 2; ++k) dst[n][k] = *(const PG8_LAS bf16x8*)(lds + PG8_SB(b, h) + boff + n * 2048 + k * 1024); } while (0)
#define PG8_MMA(ai, bj, At, Bt_) do { __builtin_amdgcn_s_setprio(1); _Pragma("unroll") for (int m = 0; m < 4; ++m) _Pragma("unroll") for (int n = 0; n < 2; ++n) _Pragma("unroll") for (int k = 0; k < 2; ++k) \
    acc[ai][bj][m][n] = __builtin_amdgcn_mfma_f32_16x16x32_bf16(Bt_[n][k], At[m][k], acc[ai][bj][m][n], 0, 0, 0); __builtin_amdgcn_s_setprio(0); } while (0)
#define PG8_WAIT_V(n) asm volatile("s_waitcnt vmcnt(" #n ")" ::: "memory")
#define PG8_WAIT_L(n) asm volatile("s_waitcnt lgkmcnt(" #n ")" ::: "memory")
#define PG8_BAR __builtin_amdgcn_s_barrier()
#define PG8_SCHED __builtin_amdgcn_sched_barrier(0)
  Unit cur, nxt; int ui = 0;
  if (!S.next(0, cur)) return;
  f32x4 acc[2][2][4][2];
#pragma unroll
  for (int a = 0; a < 2; ++a)
#pragma unroll
    for (int b = 0; b < 2; ++b)
#pragma unroll
      for (int m = 0; m < 4; ++m)
#pragma unroll
        for (int n = 0; n < 2; ++n) acc[a][b][m][n] = (f32x4){0.f, 0.f, 0.f, 0.f};
  bf16x8 At[4][2], B0[2][2], B1[2][2];
  const char* cA = asel(cur.pn) + (size_t)cur.pm * tstep; const char* cB = (const char*)Bt + (size_t)cur.pn * tstep;
  PG8_STAGE(PG8_SB(0, 0), cB, voffB); PG8_STAGE(PG8_SA(0, 0), cA, voffA); PG8_STAGE(PG8_SB(0, 1), cB + hstep, voffB); PG8_STAGE(PG8_SA(0, 1), cA + hstep, voffA);
  if (wr == 1) PG8_BAR;
  PG8_WAIT_V(4); PG8_BAR;
  PG8_STAGE(PG8_SB(1, 0), cB + kstep, voffB); PG8_STAGE(PG8_SA(1, 0), cA + kstep, voffA); PG8_STAGE(PG8_SB(1, 1), cB + hstep + kstep, voffB);
  PG8_WAIT_V(6); PG8_BAR;
  for (;;) {
    const bool has_next = S.next(ui + 1, nxt);
    const char* nA = has_next ? asel(nxt.pn) + (size_t)nxt.pm * tstep : cA; const char* nB = has_next ? (const char*)Bt + (size_t)nxt.pn * tstep : cB;
    for (int t = 0; t < nt; t += 2) {
      const bool last = (t == nt - 2);
      const char* a1 = cA + (size_t)(t + 1) * kstep;
      const char* a2 = last ? nA : cA + (size_t)(t + 2) * kstep; const char* b2 = last ? nB : cB + (size_t)(t + 2) * kstep;
      const char* a3 = a2 + kstep; const char* b3 = b2 + kstep;
      PG8_LDB(B0, 0, 0); PG8_SCHED; PG8_LDA(At, 0, 0); PG8_STAGE(PG8_SA(1, 1), a1 + hstep, voffA);
      PG8_WAIT_L(8); PG8_BAR; PG8_WAIT_L(0); PG8_MMA(0, 0, At, B0); PG8_BAR; PG8_SCHED;
      PG8_LDB(B1, 0, 1); PG8_STAGE(PG8_SB(0, 0), b2, voffB);
      PG8_BAR; PG8_WAIT_L(0); PG8_MMA(0, 1, At, B1); PG8_BAR;
      PG8_LDA(At, 0, 1); PG8_STAGE(PG8_SA(0, 0), a2, voffA);
      PG8_BAR; PG8_WAIT_L(0); PG8_MMA(1, 0, At, B0); PG8_BAR; PG8_SCHED;
      PG8_STAGE(PG8_SB(0, 1), b2 + hstep, voffB);
      PG8_WAIT_V(6); PG8_BAR; PG8_MMA(1, 1, At, B1); PG8_BAR;
      PG8_LDB(B0, 1, 0); PG8_SCHED; PG8_LDA(At, 1, 0); PG8_STAGE(PG8_SA(0, 1), a2 + hstep, voffA);
      PG8_WAIT_L(8); PG8_BAR; PG8_WAIT_L(0); PG8_MMA(0, 0, At, B0); PG8_BAR; PG8_SCHED;
      PG8_LDB(B1, 1, 1); PG8_STAGE(PG8_SB(1, 0), b3, voffB);
      PG8_BAR; PG8_WAIT_L(0); PG8_MMA(0, 1, At, B1); PG8_BAR;
      PG8_LDA(At, 1, 1); PG8_STAGE(PG8_SA(1, 0), a3, voffA);
      PG8_BAR; PG8_WAIT_L(0); PG8_MMA(1, 0, At, B0); PG8_BAR; PG8_SCHED;
      PG8_STAGE(PG8_SB(1, 1), b3 + hstep, voffB);
      PG8_WAIT_V(6); PG8_BAR; PG8_MMA(1, 1, At, B1); PG8_BAR;
    }
    E(acc, cur, wr, wc, fr, fq);
    if (!has_next) break;
#pragma unroll
    for (int a = 0; a < 2; ++a)
#pragma unroll
      for (int b = 0; b < 2; ++b)
#pragma unroll
        for (int m = 0; m < 4; ++m)
#pragma unroll
          for (int n = 0; n < 2; ++n) acc[a][b][m][n] = (f32x4){0.f, 0.f, 0.f, 0.f};
    cur = nxt; cA = nA; cB = nB; ++ui;
  }
  PG8_WAIT_V(0);
  if (wr == 0) PG8_BAR;
  PG8_BAR;
#undef PG8_SA
#undef PG8_SB
#undef PG8_STAGE
#undef PG8_LDA
#undef PG8_LDB
#undef PG8_MMA
#undef PG8_WAIT_V
#undef PG8_WAIT_L
#undef PG8_BAR
#undef PG8_SCHED
}
struct ASelOne { const char* A; DEVINL const char* operator()(int) const { return A; } };
}

DEVINL void gemm_tile_128(const bf16_t* __restrict__ A, int lda, const bf16_t* __restrict__ Bt, int ldb, int K,
                          char* smem_half, f32x4 (&acc)[4][4]) {
  const int tid = tidx() & 255, wid = tid >> 6, lane = tid & 63;
  const int wr = wid >> 1, wc = wid & 1, fr = lane & 15, fq = lane >> 4;
  char* SA = smem_half;
  char* SB = smem_half + 8192;
#pragma unroll
  for (int m = 0; m < 4; ++m)
#pragma unroll
    for (int n = 0; n < 4; ++n) acc[m][n] = (f32x4){0.f, 0.f, 0.f, 0.f};
  for (int k0 = 0; k0 < K; k0 += 32) {
#pragma unroll
    for (int i = 0; i < 2; ++i) {
      int b = tid * 16 + i * 4096;
      int r = b >> 6, c = (b & 63) >> 1;
      __builtin_amdgcn_global_load_lds((const unsigned*)(A + (size_t)r * lda + k0 + c), (unsigned*)(SA + b), 16, 0, 0);
      __builtin_amdgcn_global_load_lds((const unsigned*)(Bt + (size_t)r * ldb + k0 + c), (unsigned*)(SB + b), 16, 0, 0);
    }
    asm volatile("s_waitcnt vmcnt(0)" ::: "memory");
    __syncthreads();
    bf16x8 a[4], b[4];
#pragma unroll
    for (int m = 0; m < 4; ++m) a[m] = *reinterpret_cast<const bf16x8*>(SA + (wr * 64 + m * 16 + fr) * 64 + fq * 16);
#pragma unroll
    for (int n = 0; n < 4; ++n) b[n] = *reinterpret_cast<const bf16x8*>(SB + (wc * 64 + n * 16 + fr) * 64 + fq * 16);
#pragma unroll
    for (int m = 0; m < 4; ++m)
#pragma unroll
      for (int n = 0; n < 4; ++n) acc[m][n] = __builtin_amdgcn_mfma_f32_16x16x32_bf16(a[m], b[n], acc[m][n], 0, 0, 0);
    __syncthreads();
  }
}

#define GEMM_LANE_VARS \
  const int tid = tidx() & 255, wid = tid >> 6, lane = tid & 63; \
  const int wr = wid >> 1, wc = wid & 1, fr = lane & 15, fq = lane >> 4; \
  (void)tid; (void)wid; (void)lane; (void)wr; (void)wc; (void)fr; (void)fq;

DEVINL void get_tjob(const Params& p, int ji, const float*& src, bf16_t*& dst, int& K, int& N) {
  if (ji < 28) {
    int j = ji / 14, s = ji % 14;
    bf16_t* rw = p.rwkv_in_t + (size_t)j * RW_N * 1024;
    if (s < 3) { src = p.in[12] + ((size_t)(j * 3 + s) << 20); dst = rw + ((size_t)s << 20); K = 1024; N = 1024; }
    else if (s < 5) { int z = s - 3; src = p.in[15] + (size_t)(j * 2 + z) * 65536; dst = rw + (size_t)(3072 + z * 64) * 1024; K = 1024; N = 64; }
    else if (s < 7) { int z = s - 5; src = p.in[18] + (size_t)(j * 2 + z) * 65536; dst = rw + (size_t)(3328 + z * 64) * 1024; K = 1024; N = 64; }
    else if (s == 7) { src = p.in[20] + (size_t)j * 131072; dst = rw + (size_t)3584 * 1024; K = 1024; N = 128; }
    else if (s < 10) { int z = s - 8; src = p.in[16] + (size_t)(j * 2 + z) * 65536; dst = p.w2t + (size_t)(j * 2 + z) * 65536; K = 64; N = 1024; }
    else if (s < 12) { int z = s - 10; src = p.in[19] + (size_t)(j * 2 + z) * 65536; dst = p.a2t + (size_t)(j * 2 + z) * 65536; K = 64; N = 1024; }
    else if (s == 12) { src = p.in[21] + (size_t)j * 131072; dst = p.g2t + (size_t)j * 131072; K = 128; N = 1024; }
    else { src = p.in[13] + ((size_t)j << 20); dst = p.rwkv_wo_t + ((size_t)j << 20); K = 1024; N = 1024; }
  } else if (ji < 32) {
    int j = (ji - 28) >> 1, s = (ji - 28) & 1;
    if (s == 0) { src = p.in[27] + (size_t)j * 1024 * 1536; dst = p.attn_wqkv_t + (size_t)j * 1536 * 1024; K = 1024; N = 1536; }
    else { src = p.in[28] + ((size_t)j << 20); dst = p.attn_wo_t + ((size_t)j << 20); K = 1024; N = 1024; }
  } else {
    int i = ji - 32;
    src = p.in[31] + (size_t)i * 1024 * 2048; dst = p.wq_t + (size_t)i * 2048 * 1024; K = 1024; N = 2048;
  }
}

DEVINL void sincos_d(double x, float& c, float& s) {
  const double TWO_PI = 6.283185307179586476925;
  double r = x - TWO_PI * rint(x / TWO_PI);
  double r2 = r * r;
  double ts = r, tc = 1.0, ss = r, cs = 1.0;
#pragma unroll 1
  for (int n = 1; n <= 14; ++n) {
    tc = -tc * r2 / (double)((2 * n - 1) * (2 * n));
    ts = -ts * r2 / (double)((2 * n) * (2 * n + 1));
    cs += tc; ss += ts;
  }
  c = (float)cs; s = (float)ss;
}

DEVINL void phase_prep(const Params& p, int w, int nw, char* smem) {
  const int tid = tidx();
  {
    float (*tile)[65] = reinterpret_cast<float (*)[65]>(smem);
    int toff = 0;
    for (int ji = 0; ji < 36; ++ji) {
      const float* src; bf16_t* dst; int K, N;
      get_tjob(p, ji, src, dst, K, N);
      const int tn = N >> 6, nt = (K >> 6) * tn;
      int t0 = (w - (toff % nw) + nw) % nw;
      for (int t = t0; t < nt; t += nw) {
        const int k0 = (t / tn) << 6, n0 = (t % tn) << 6;
#pragma unroll
        for (int i = 0; i < 2; ++i) {
          int r = (tid >> 4) + 32 * i, c = (tid & 15) * 4;
          float4 v = *reinterpret_cast<const float4*>(src + (size_t)(k0 + r) * N + n0 + c);
          tile[r][c] = v.x; tile[r][c + 1] = v.y; tile[r][c + 2] = v.z; tile[r][c + 3] = v.w;
        }
        __syncthreads();
        {
          int q = tid;
          int n = q >> 3, kc = (q & 7) * 8;
          uint4 o;
          o.x = pack2(tile[kc + 0][n], tile[kc + 1][n]);
          o.y = pack2(tile[kc + 2][n], tile[kc + 3][n]);
          o.z = pack2(tile[kc + 4][n], tile[kc + 5][n]);
          o.w = pack2(tile[kc + 6][n], tile[kc + 7][n]);
          *reinterpret_cast<uint4*>(dst + (size_t)(n0 + n) * K + k0 + kc) = o;
        }
        __syncthreads();
      }
      toff += nt;
    }
  }
  const size_t gtid = (size_t)w * NTHREADS + tid, gn = (size_t)nw * NTHREADS;
  {
    const size_t n8 = (size_t)4 * 16384 * 1024 / 8;
    for (size_t i = gtid; i < n8; i += gn) {
      const float4* su = reinterpret_cast<const float4*>(p.in[33]) + i * 2;
      float4 a = su[0], b = su[1];
      uint4 o; o.x = pack2(a.x, a.y); o.y = pack2(a.z, a.w); o.z = pack2(b.x, b.y); o.w = pack2(b.z, b.w);
      reinterpret_cast<uint4*>(p.ub)[i] = o;
      const float4* sv = reinterpret_cast<const float4*>(p.in[34]) + i * 2;
      a = sv[0]; b = sv[1];
      o.x = pack2(a.x, a.y); o.y = pack2(a.z, a.w); o.z = pack2(b.x, b.y); o.w = pack2(b.z, b.w);
      reinterpret_cast<uint4*>(p.vb)[i] = o;
    }
    const size_t nk8 = (size_t)4 * 2 * 128 * 128 / 8;
    for (size_t i = gtid; i < nk8; i += gn) {
      const float4* su = reinterpret_cast<const float4*>(p.in[32]) + i * 2;
      float4 a = su[0], b = su[1];
      uint4 o; o.x = pack2(a.x, a.y); o.y = pack2(a.z, a.w); o.z = pack2(b.x, b.y); o.w = pack2(b.z, b.w);
      reinterpret_cast<uint4*>(p.keysb)[i] = o;
    }
  }
  {
    const size_t nk = (size_t)8 * 2 * 512 * 4 * 64;
    for (size_t i = gtid; i < nk; i += gn) {
      int d = i & 63, kvh = (i >> 6) & 3, s = (i >> 8) & 511, j = (i >> 17) & 1, b = (int)(i >> 18);
      p.Klat[((size_t)((j * 8 + b) * 4 + kvh) * 1536 + s) * 64 + d] = f2bf(p.in[4][i]);
      p.VlatT[((size_t)((j * 8 + b) * 4 + kvh) * 64 + d) * 1536 + s] = f2bf(p.in[5][i]);
    }
  }
  for (size_t i = gtid; i < 1024; i += gn) {
    int pos = (int)(i >> 4), f = (int)(i & 15);
    float c, s; sincos_d((double)pos * p.freqs[f], c, s);
    p.rope[i * 2] = c; p.rope[i * 2 + 1] = s;
  }
  {
    const size_t n4 = (size_t)TT * DM / 4, nc4 = (size_t)TCTX * DM / 4;
    for (size_t i = gtid; i < n4; i += gn) {
      float4 v = (i < nc4) ? reinterpret_cast<const float4*>(p.in[0])[i] : reinterpret_cast<const float4*>(p.in[1])[i - nc4];
      reinterpret_cast<float4*>(p.xbuf)[i] = v;
    }
  }
  {
    float* sc = reinterpret_cast<float*>(smem);
    float* red = sc + 9 * 1024;
    bool loaded = false;
    for (int item = w; item < 384; item += nw) {
      if (!loaded) {
        __syncthreads();
        for (int e = tid; e < 9 * 1024; e += NTHREADS) {
          int c = e >> 10, d = e & 1023;
          float v = (c < 8) ? p.in[2][c * 1024 + d] : p.in[6][d];
          sc[e] = v / (1.0f + __expf(-v));
        }
        __syncthreads();
        loaded = true;
      }
      const int i = item / 96, cc = item % 96;
      const int col = cc * 64 + (tid & 63), ks = tid >> 6;
      float acc[9];
#pragma unroll
      for (int c = 0; c < 9; ++c) acc[c] = 0.f;
      const float* wp = p.in[7] + (size_t)i * 1024 * 6144 + col;
      for (int d0 = ks * 128; d0 < ks * 128 + 128; d0 += 16) {
        float wv[16];
#pragma unroll
        for (int u = 0; u < 16; ++u) wv[u] = wp[(size_t)(d0 + u) * 6144];
#pragma unroll
        for (int u = 0; u < 16; ++u)
#pragma unroll
          for (int c = 0; c < 9; ++c) acc[c] += sc[c * 1024 + d0 + u] * wv[u];
      }
#pragma unroll
      for (int c = 0; c < 9; ++c) red[(ks * 9 + c) * 64 + (tid & 63)] = acc[c];
      __syncthreads();
      for (int o = tid; o < 576; o += NTHREADS) {
        int c = o >> 6, cl = o & 63;
        float s = 0.f;
#pragma unroll
        for (int k2 = 0; k2 < 8; ++k2) s += red[(k2 * 9 + c) * 64 + cl];
        int n = cc * 64 + cl;
        p.mod[((size_t)i * 9 + c) * 6144 + n] = s + p.in[8][i * 6144 + n];
      }
      __syncthreads();
    }
  }
}

DEVINL void phase_r1(const Params& p, int layer, int w, int nw) {
  const int j = layer >> 1;
  const int lane = tidx() & 63;
  const int gw = w * NWAVES + (tidx() >> 6), ngw = nw * NWAVES;
  bf16_t* A6 = reinterpret_cast<bf16_t*>(p.U1);
  const float* mu = p.in[11] + (size_t)j * 6 * 1024;
  for (int row = gw; row < TT; row += ngw) {
    int t, Tlen;
    if (row < TCTX) { t = row & 255; Tlen = 256; } else { t = (row - TCTX) & 1023; Tlen = 1024; }
    const int cond = cond_of_row(row);
    const float* sh = p.mod + ((size_t)layer * 9 + cond) * 6144;
    const float* sc = sh + 1024;
    const bool hasp = t > 0, hasn = t < Tlen - 1;
#pragma unroll
    for (int k = 0; k < 4; ++k) {
      const int col = k * 256 + lane * 4;
      const float4 xc = *reinterpret_cast<const float4*>(p.xbuf + (size_t)row * DM + col);
      float4 xp = make_float4(0, 0, 0, 0), xn = make_float4(0, 0, 0, 0);
      if (hasp) xp = *reinterpret_cast<const float4*>(p.xbuf + (size_t)(row - 1) * DM + col);
      if (hasn) xn = *reinterpret_cast<const float4*>(p.xbuf + (size_t)(row + 1) * DM + col);
      const float4 s4 = *reinterpret_cast<const float4*>(sh + col);
      const float4 c4 = *reinterpret_cast<const float4*>(sc + col);
      float h[4], xx[4];
      const float xcv[4] = {xc.x, xc.y, xc.z, xc.w}, xpv[4] = {xp.x, xp.y, xp.z, xp.w}, xnv[4] = {xn.x, xn.y, xn.z, xn.w};
      const float shv[4] = {s4.x, s4.y, s4.z, s4.w}, scv[4] = {c4.x, c4.y, c4.z, c4.w};
#pragma unroll
      for (int e = 0; e < 4; ++e) {
        float g = 1.0f + scv[e];
        h[e] = xcv[e] * g + shv[e];
        float hp = hasp ? (xpv[e] * g + shv[e]) : 0.f;
        float hn = hasn ? (xnv[e] * g + shv[e]) : 0.f;
        xx[e] = 0.5f * (hp + hn) - h[e];
      }
#pragma unroll
      for (int m = 0; m < 6; ++m) {
        const float4 m4 = *reinterpret_cast<const float4*>(mu + m * 1024 + col);
        uint2 o;
        o.x = pack2(h[0] + xx[0] * m4.x, h[1] + xx[1] * m4.y);
        o.y = pack2(h[2] + xx[2] * m4.z, h[3] + xx[3] * m4.w);
        *reinterpret_cast<uint2*>(A6 + ((size_t)m * TT + row) * DM + col) = o;
      }
    }
  }
}

#define U1_AA_OFF ((size_t)2 * TT * DM * 4)
#define U1_GG_OFF (U1_AA_OFF + (size_t)2 * TT * DM * 2)

struct ASelR2 {
  const char* A6;
  DEVINL const char* operator()(int pn) const {
    const int idx = pn < 12 ? (pn >> 2) : (pn - 9);
    const int m = (0x541320 >> (4 * idx)) & 7;
    return A6 + (size_t)m * TT * DM * 2;
  }
};
struct EpiR2 {
  static constexpr bool PERM = true;
  bf16_t *rb, *lw;
  DEVINL void operator()(const f32x4 (&acc)[2][2][4][2], const pg8::Unit& u, int wr, int wc, int fr, int fq) const {
    const int row0 = u.pm * 256 + wr * 64 + fr;
    const int pn = u.pn;
    if (pn < 12) {
      bf16_t* dst = rb + (size_t)(pn >> 2) * TT * DM;
      const int col0 = (pn & 3) * 256 + wc * 32 + 8 * fq;
#pragma unroll
      for (int ai = 0; ai < 2; ++ai)
#pragma unroll
        for (int m = 0; m < 4; ++m) {
          bf16_t* rowp = dst + (size_t)(row0 + ai * 128 + m * 16) * DM + col0;
#pragma unroll
          for (int bj = 0; bj < 2; ++bj) {
            const f32x4 v0 = acc[ai][bj][m][0], v1 = acc[ai][bj][m][1];
            pg8::u32x4 o; o.x = pg8::cvt_pk_bf16(v0[0], v0[1]); o.y = pg8::cvt_pk_bf16(v0[2], v0[3]); o.z = pg8::cvt_pk_bf16(v1[0], v1[1]); o.w = pg8::cvt_pk_bf16(v1[2], v1[3]);
            *reinterpret_cast<pg8::u32x4*>(rowp + bj * 128) = o;
          }
        }
    } else {
      bf16_t* dst = lw + (size_t)(pn - 12) * TT * 128;
      const int col0 = wc * 32 + 8 * fq;
      const float kx = (pn == 12 ? 2.0f : 1.0f) * 1.4426950408889634f, ka = pn == 12 ? 2.0f : 1.0f, kb = pn == 12 ? -1.0f : 0.0f;
#pragma unroll
      for (int ai = 0; ai < 2; ++ai)
#pragma unroll
        for (int m = 0; m < 4; ++m) {
          f32x4 v0 = acc[ai][0][m][0], v1 = acc[ai][0][m][1];
          if (pn != 13) {
#pragma unroll
            for (int e = 0; e < 4; ++e) {
              const float s0 = __builtin_amdgcn_rcpf(1.0f + __builtin_amdgcn_exp2f(-kx * v0[e]));
              const float s1 = __builtin_amdgcn_rcpf(1.0f + __builtin_amdgcn_exp2f(-kx * v1[e]));
              v0[e] = ka * s0 + kb; v1[e] = ka * s1 + kb;
            }
          }
          asm volatile("" ::: "memory");
          pg8::u32x4 o; o.x = pg8::cvt_pk_bf16(v0[0], v0[1]); o.y = pg8::cvt_pk_bf16(v0[2], v0[3]); o.z = pg8::cvt_pk_bf16(v1[0], v1[1]); o.w = pg8::cvt_pk_bf16(v1[2], v1[3]);
          *reinterpret_cast<pg8::u32x4*>(dst + (size_t)(row0 + ai * 128 + m * 16) * 128 + col0) = o;
        }
    }
  }
};
DEVINL void phase_r2(const Params& p, int layer, int w, int nw, char* smem) {
  const int j = layer >> 1;
  bf16_t* rb = reinterpret_cast<bf16_t*>(p.U2);
  EpiR2 E;
  E.rb = rb; E.lw = p.abuf;
  ASelR2 as; as.A6 = p.U1;
  pg8::StaticOrder S; S.init(TT, RW_N, nw, w);
  pg8::gemm_phase<EpiR2, ASelR2>((PG8_LAS unsigned char*)smem, as, p.rwkv_in_t + (size_t)j * RW_N * 1024, 1024, S, E);
}

DEVINL void phase_r3(const Params& p, int layer, int w, int nw, char* smem) {
  const int j = layer >> 1;
  GEMM_LANE_VARS
  const int half = tidx() >> 8;
  char* sh = smem + half * 16384;
  const bf16_t* lw = p.abuf;
  const bf16_t* la = lw + (size_t)TT * 128;
  const bf16_t* lg = la + (size_t)TT * 128;
  float* wdec = reinterpret_cast<float*>(p.U1);
  bf16_t* aa = reinterpret_cast<bf16_t*>(p.U1 + U1_AA_OFF);
  bf16_t* gg = reinterpret_cast<bf16_t*>(p.U1 + U1_GG_OFF);
  const int NTILES = 96 * 40;
  for (int it = 0; it * nw * 2 < NTILES; ++it) {
    int tile = (it * nw + w) * 2 + half;
    const bool valid = tile < NTILES;
    if (!valid) tile = 0;
    const int ct = tile / 96, rt = tile % 96;
    const int job = ct >> 3, nt = ct & 7;
    const int row0 = rt * 128, col0 = nt * 128;
    f32x4 acc[4][4];
    if (job < 2) {
      const int z = job;
      gemm_tile_128(lw + (size_t)row0 * 128 + z * 64, 128, p.w2t + (size_t)(j * 2 + z) * 65536 + (size_t)col0 * 64, 64, 64, sh, acc);
      if (valid) {
        const float* w0 = p.in[14] + (size_t)(j * 2 + z) * 1024;
#pragma unroll
        for (int m = 0; m < 4; ++m)
#pragma unroll
          for (int n = 0; n < 4; ++n)
#pragma unroll
            for (int jj = 0; jj < 4; ++jj) {
              int row = row0 + wr * 64 + m * 16 + fq * 4 + jj, col = col0 + wc * 64 + n * 16 + fr;
              float wl = acc[m][n][jj] + w0[col];
              wdec[((size_t)z * TT + row) * DM + col] = __expf(-0.6065306597126334f * sigmoidf_(wl));
            }
      }
    } else if (job < 4) {
      const int z = job - 2;
      gemm_tile_128(la + (size_t)row0 * 128 + z * 64, 128, p.a2t + (size_t)(j * 2 + z) * 65536 + (size_t)col0 * 64, 64, 64, sh, acc);
      if (valid) {
        const float* a0 = p.in[17] + (size_t)(j * 2 + z) * 1024;
#pragma unroll
        for (int m = 0; m < 4; ++m)
#pragma unroll
          for (int n = 0; n < 4; ++n)
#pragma unroll
            for (int jj = 0; jj < 4; ++jj) {
              int row = row0 + wr * 64 + m * 16 + fq * 4 + jj, col = col0 + wc * 64 + n * 16 + fr;
              aa[((size_t)z * TT + row) * DM + col] = f2bf(sigmoidf_(acc[m][n][jj] + a0[col]));
            }
      }
    } else {
      gemm_tile_128(lg + (size_t)row0 * 128, 128, p.g2t + (size_t)j * 131072 + (size_t)col0 * 128, 128, 128, sh, acc);
      if (valid) {
#pragma unroll
        for (int m = 0; m < 4; ++m)
#pragma unroll
          for (int n = 0; n < 4; ++n)
#pragma unroll
            for (int jj = 0; jj < 4; ++jj) {
              int row = row0 + wr * 64 + m * 16 + fq * 4 + jj, col = col0 + wc * 64 + n * 16 + fr;
              gg[(size_t)row * DM + col] = f2bf(acc[m][n][jj]);
            }
      }
    }
  }
  {
    const int l64 = tidx() & 63;
    const int gw = w * NWAVES + (tidx() >> 6), ngw = nw * NWAVES;
    const bf16_t* kb = reinterpret_cast<const bf16_t*>(p.U2) + (size_t)TT * DM;
    bf16_t* kkb = reinterpret_cast<bf16_t*>(p.U2) + (size_t)3 * TT * DM;
    const float* k_k = p.in[22] + j * 1024;
    for (int row = gw; row < TT; row += ngw) {
#pragma unroll
      for (int k = 0; k < 4; ++k) {
        const int col = k * 256 + l64 * 4;
        const uint2 k2 = *reinterpret_cast<const uint2*>(kb + (size_t)row * DM + col);
        const float4 kk4 = *reinterpret_cast<const float4*>(k_k + col);
        float v0 = bflo(k2.x) * kk4.x, v1 = bfhi(k2.x) * kk4.y, v2 = bflo(k2.y) * kk4.z, v3 = bfhi(k2.y) * kk4.w;
        float ss = grp16_sum(v0 * v0 + v1 * v1 + v2 * v2 + v3 * v3);
        float inv = 1.0f / fmaxf(sqrtf(ss), 1e-12f);
        uint2 o; o.x = pack2(v0 * inv, v1 * inv); o.y = pack2(v2 * inv, v3 * inv);
        *reinterpret_cast<uint2*>(kkb + (size_t)row * DM + col) = o;
      }
    }
  }
}

typedef __attribute__((ext_vector_type(4))) short bf16x4;
#define R4_WAVE_LDS 21504
DEVINL unsigned short bfbits(float f) { return f2bf(f); }
DEVINL bf16x4 pack4(float a, float b, float c, float d) {
  union { bf16x4 v; unsigned u[2]; } r; r.u[0] = pack2(a, b); r.u[1] = pack2(c, d); return r.v;
}
DEVINL void phase_r4(const Params& p, int layer, int w, int nw, char* smem) {
  const int j = layer >> 1;
  const int lane = tidx() & 63, wid = __builtin_amdgcn_readfirstlane(tidx() >> 6);
  const int fr = lane & 15, fq = lane >> 4;
  if (wid >= 3) return;
  const bf16_t* rb = reinterpret_cast<const bf16_t*>(p.U2);
  const bf16_t* kb = rb + (size_t)TT * DM;
  const bf16_t* vb = kb + (size_t)TT * DM;
  const bf16_t* kkb = vb + (size_t)TT * DM;
  const float* wdec = reinterpret_cast<const float*>(p.U1);
  const bf16_t* aa = reinterpret_cast<const bf16_t*>(p.U1 + U1_AA_OFF);
  float* yout = reinterpret_cast<float*>(p.U3);
  char* wl = smem + wid * R4_WAVE_LDS;
  bf16_t* khR = reinterpret_cast<bf16_t*>(wl);
  bf16_t* ahR = khR + 1024;
  bf16_t* qhR = ahR + 1024;
  bf16_t* rhR = qhR + 1024;
  bf16_t* qhT = rhR + 1024;
  bf16_t* AtT = qhT + 1024;
  bf16_t* KtT = AtT + 1024;
  bf16_t* vT = KtT + 1024;
  float* NfT = reinterpret_cast<float*>(vT + 1024);
  float* WCf = NfT + 256;
  bf16_t* TTl = reinterpret_cast<bf16_t*>(WCf + 64);
  bf16_t* AkqR = TTl + 256;
  bf16_t* GR = AkqR + 256;
  bf16_t* QpR = khR;
  {
    const int c = w + nw * wid;
    if (c >= 768) return;
    int seq, h, z;
    if (c < 256) { seq = 16 + (c >> 5); h = (c >> 1) & 15; z = c & 1; }
    else { int cc = c - 256; seq = cc >> 5; h = (cc >> 1) & 15; z = cc & 1; }
    const int Tlen = seq < 16 ? 256 : 1024;
    const int base = seq < 16 ? seq * 256 : TCTX + (seq - 16) * 1024;
    const int colb = h * 64;
    const float kal = p.in[23][j * 1024 + colb + lane];
    f32x4 ST[4][4];
    if (seq >= 16) {
      const float* s0 = p.in[3] + ((((size_t)(seq - 16) * 2 + j) * 2 + z) * 16 + h) * 4096;
#pragma unroll
      for (int b = 0; b < 4; ++b)
#pragma unroll
        for (int nb = 0; nb < 4; ++nb) ST[b][nb] = *reinterpret_cast<const f32x4*>(s0 + (size_t)(16 * nb + fr) * 64 + 16 * b + 4 * fq);
    } else {
#pragma unroll
      for (int b = 0; b < 4; ++b)
#pragma unroll
        for (int nb = 0; nb < 4; ++nb) ST[b][nb] = (f32x4){0.f, 0.f, 0.f, 0.f};
    }
#pragma unroll 1
    for (int t0 = 0; t0 < Tlen; t0 += 16) {
      __builtin_amdgcn_wave_barrier();
      {
        float wx[16];
#pragma unroll
        for (int t = 0; t < 16; ++t) {
          const int row = base + (z == 0 ? (t0 + t) : (Tlen - 1 - (t0 + t)));
          wx[t] = wdec[((size_t)z * TT + row) * DM + colb + lane];
        }
        float WCl = 1.0f;
#pragma unroll
        for (int t = 0; t < 16; ++t) WCl *= wx[t];
        WCf[lane] = WCl;
        float Wc = 1.0f;
#pragma unroll
        for (int tp = 0; tp < 8; ++tp) {
          float at2[2], kt2[2], qh2[2];
          unsigned vb2[2];
#pragma unroll
          for (int u = 0; u < 2; ++u) {
            const int t = tp * 2 + u;
            const int row = base + (z == 0 ? (t0 + t) : (Tlen - 1 - (t0 + t)));
            const size_t o = (size_t)row * DM + colb + lane;
            const float rr = bf2f(rb[o]), kx = bf2f(kb[o]), kkx = bf2f(kkb[o]);
            const float ax = bf2f(aa[(size_t)z * TT * DM + o]);
            vb2[u] = vb[o];
            const float kd = kx * (1.0f + (ax - 1.0f) * kal);
            const float kka = kkx * ax;
            const float qh = Wc * kkx;
            Wc *= wx[t];
            const float rh = Wc * rr;
            const float iw = 1.0f / Wc;
            const float kh = kd * iw, ah = kka * iw;
            khR[t * 64 + lane] = f2bf(kh); ahR[t * 64 + lane] = f2bf(ah);
            qhR[t * 64 + lane] = f2bf(qh); rhR[t * 64 + lane] = f2bf(rh);
            at2[u] = ah * WCl; kt2[u] = kh * WCl; qh2[u] = qh;
          }
          *reinterpret_cast<unsigned*>(AtT + lane * 16 + tp * 2) = pack2(at2[0], at2[1]);
          *reinterpret_cast<unsigned*>(KtT + lane * 16 + tp * 2) = pack2(kt2[0], kt2[1]);
          *reinterpret_cast<unsigned*>(qhT + lane * 16 + tp * 2) = pack2(qh2[0], qh2[1]);
          *reinterpret_cast<unsigned*>(vT + lane * 16 + tp * 2) = vb2[0] | (vb2[1] << 16);
          if ((tp & 1) == 1) asm volatile("" ::: "memory");
        }
      }
      __builtin_amdgcn_wave_barrier();
      f32x4 Akq = {0.f, 0.f, 0.f, 0.f}, Aaq = Akq, Akr = Akq, Aar = Akq;
      {
#pragma unroll
        for (int ks = 0; ks < 2; ++ks) {
          const bf16x8 khA = *reinterpret_cast<const bf16x8*>(khR + fr * 64 + ks * 32 + fq * 8);
          const bf16x8 ahA = *reinterpret_cast<const bf16x8*>(ahR + fr * 64 + ks * 32 + fq * 8);
          const bf16x8 qhB = *reinterpret_cast<const bf16x8*>(qhR + fr * 64 + ks * 32 + fq * 8);
          const bf16x8 rhB = *reinterpret_cast<const bf16x8*>(rhR + fr * 64 + ks * 32 + fq * 8);
          Akq = __builtin_amdgcn_mfma_f32_16x16x32_bf16(khA, qhB, Akq, 0, 0, 0);
          Aaq = __builtin_amdgcn_mfma_f32_16x16x32_bf16(ahA, qhB, Aaq, 0, 0, 0);
          Akr = __builtin_amdgcn_mfma_f32_16x16x32_bf16(khA, rhB, Akr, 0, 0, 0);
          Aar = __builtin_amdgcn_mfma_f32_16x16x32_bf16(ahA, rhB, Aar, 0, 0, 0);
        }
#pragma unroll
        for (int e = 0; e < 4; ++e) {
          const int s = 4 * fq + e;
          if (!(s < fr)) { Akq[e] = 0.f; Aaq[e] = 0.f; }
          if (!(s <= fr)) { Akr[e] = 0.f; Aar[e] = 0.f; }
        }
      }
      __builtin_amdgcn_wave_barrier();
      *reinterpret_cast<f32x4*>(NfT + fr * 16 + 4 * fq) = Aaq;
#pragma unroll
      for (int e = 0; e < 4; ++e) AkqR[(4 * fq + e) * 16 + fr] = f2bf(Akq[e]);
      __builtin_amdgcn_wave_barrier();
      {
        float Tr[16];
#pragma unroll
        for (int t = 0; t < 16; ++t) {
          float acc = (fr == t) ? 1.0f : 0.0f;
#pragma unroll
          for (int x = 0; x < t; ++x) acc -= Tr[x] * NfT[t * 16 + x];
          Tr[t] = acc;
        }
        if (fq == 0) {
#pragma unroll
          for (int t = 0; t < 16; ++t) TTl[t * 16 + fr] = f2bf(Tr[t]);
        }
      }
      __builtin_amdgcn_wave_barrier();
      const bf16x4 Tb = *reinterpret_cast<const bf16x4*>(TTl + fr * 16 + fq * 4);
      f32x4 G;
      {
        const bf16x4 AkqA = *reinterpret_cast<const bf16x4*>(AkqR + fr * 16 + fq * 4);
        G = __builtin_amdgcn_mfma_f32_16x16x16bf16_1k(AkqA, Tb, (f32x4){0.f, 0.f, 0.f, 0.f}, 0, 0, 0);
#pragma unroll
        for (int b = 0; b < 4; ++b) {
          const bf16x4 qa = *reinterpret_cast<const bf16x4*>(qhT + (16 * b + fr) * 16 + fq * 4);
          const f32x4 qp = __builtin_amdgcn_mfma_f32_16x16x16bf16_1k(qa, Tb, (f32x4){0.f, 0.f, 0.f, 0.f}, 0, 0, 0);
          *reinterpret_cast<bf16x4*>(QpR + fr * 64 + 16 * b + 4 * fq) = pack4(qp[0], qp[1], qp[2], qp[3]);
        }
#pragma unroll
        for (int e = 0; e < 4; ++e) GR[(4 * fq + e) * 16 + fr] = f2bf(G[e]);
      }
      __builtin_amdgcn_wave_barrier();
      f32x4 H, Zb[4];
      {
        const bf16x4 GA = *reinterpret_cast<const bf16x4*>(GR + fr * 16 + fq * 4);
        const bf16x4 AarB = pack4(Aar[0], Aar[1], Aar[2], Aar[3]);
        const f32x4 hm = __builtin_amdgcn_mfma_f32_16x16x16bf16_1k(GA, AarB, (f32x4){0.f, 0.f, 0.f, 0.f}, 0, 0, 0);
        H = Akr - hm;
#pragma unroll
        for (int b = 0; b < 4; ++b) {
          const bf16x4 AtB = *reinterpret_cast<const bf16x4*>(AtT + (16 * b + fr) * 16 + fq * 4);
          const f32x4 zm = __builtin_amdgcn_mfma_f32_16x16x16bf16_1k(GA, AtB, (f32x4){0.f, 0.f, 0.f, 0.f}, 0, 0, 0);
          const bf16x4 ktv = *reinterpret_cast<const bf16x4*>(KtT + (16 * b + fr) * 16 + fq * 4);
          union { bf16x4 v; unsigned short s[4]; } ku; ku.v = ktv;
          Zb[b][0] = bf2f(ku.s[0]) - zm[0]; Zb[b][1] = bf2f(ku.s[1]) - zm[1]; Zb[b][2] = bf2f(ku.s[2]) - zm[2]; Zb[b][3] = bf2f(ku.s[3]) - zm[3];
        }
      }
      bf16x8 QpA[2], rhA[2], AY, AS[4];
      {
#pragma unroll
        for (int ks = 0; ks < 2; ++ks) {
          union { bf16x8 v; bf16x4 h[2]; } u1, u2;
          u1.h[0] = *reinterpret_cast<const bf16x4*>(QpR + fr * 64 + 32 * ks + 4 * fq);
          u1.h[1] = *reinterpret_cast<const bf16x4*>(QpR + fr * 64 + 32 * ks + 16 + 4 * fq);
          u2.h[0] = *reinterpret_cast<const bf16x4*>(rhR + fr * 64 + 32 * ks + 4 * fq);
          u2.h[1] = *reinterpret_cast<const bf16x4*>(rhR + fr * 64 + 32 * ks + 16 + 4 * fq);
          QpA[ks] = u1.v; rhA[ks] = u2.v;
        }
        {
          union { bf16x8 v; bf16x4 h[2]; } u;
          u.h[0] = pack4(Aar[0], Aar[1], Aar[2], Aar[3]); u.h[1] = pack4(H[0], H[1], H[2], H[3]);
          AY = u.v;
        }
#pragma unroll
        for (int b = 0; b < 4; ++b) {
          union { bf16x8 v; bf16x4 h[2]; } u;
          u.h[0] = *reinterpret_cast<const bf16x4*>(AtT + (16 * b + fr) * 16 + fq * 4);
          u.h[1] = pack4(Zb[b][0], Zb[b][1], Zb[b][2], Zb[b][3]);
          AS[b] = u.v;
        }
      }
#pragma unroll
      for (int nb = 0; nb < 4; ++nb) {
        bf16x8 Bhi[2], Blo[2];
#pragma unroll
        for (int ks = 0; ks < 2; ++ks) {
          union { bf16x8 v; unsigned u[4]; } hi, lo;
          float a[8];
#pragma unroll
          for (int e = 0; e < 4; ++e) { a[e] = ST[2 * ks][nb][e]; a[4 + e] = ST[2 * ks + 1][nb][e]; }
          float rsd[8];
#pragma unroll
          for (int e = 0; e < 8; ++e) { const float hf = bf2f(f2bf(a[e])); rsd[e] = a[e] - hf; }
#pragma unroll
          for (int e = 0; e < 4; ++e) { hi.u[e] = pack2(a[2 * e], a[2 * e + 1]); lo.u[e] = pack2(rsd[2 * e], rsd[2 * e + 1]); }
          Bhi[ks] = hi.v; Blo[ks] = lo.v;
        }
        f32x4 P = {0.f, 0.f, 0.f, 0.f}, R = {0.f, 0.f, 0.f, 0.f};
        P = __builtin_amdgcn_mfma_f32_16x16x32_bf16(QpA[0], Bhi[0], P, 0, 0, 0);
        P = __builtin_amdgcn_mfma_f32_16x16x32_bf16(QpA[1], Bhi[1], P, 0, 0, 0);
        P = __builtin_amdgcn_mfma_f32_16x16x32_bf16(QpA[0], Blo[0], P, 0, 0, 0);
        P = __builtin_amdgcn_mfma_f32_16x16x32_bf16(QpA[1], Blo[1], P, 0, 0, 0);
        R = __builtin_amdgcn_mfma_f32_16x16x32_bf16(rhA[0], Bhi[0], R, 0, 0, 0);
        R = __builtin_amdgcn_mfma_f32_16x16x32_bf16(rhA[1], Bhi[1], R, 0, 0, 0);
        bf16x8 X;
        {
          union { bf16x8 v; bf16x4 h[2]; } u;
          u.h[0] = pack4(-P[0], -P[1], -P[2], -P[3]);
          u.h[1] = *reinterpret_cast<const bf16x4*>(vT + (16 * nb + fr) * 16 + fq * 4);
          X = u.v;
        }
        const f32x4 Y = __builtin_amdgcn_mfma_f32_16x16x32_bf16(AY, X, R, 0, 0, 0);
#pragma unroll
        for (int e = 0; e < 4; ++e) {
          const int t = t0 + 4 * fq + e;
          const int row = base + (z == 0 ? t : (Tlen - 1 - t));
          yout[((size_t)z * TT + row) * DM + colb + 16 * nb + fr] = Y[e];
        }
#pragma unroll
        for (int b = 0; b < 4; ++b) {
          const f32x4 wcv = *reinterpret_cast<const f32x4*>(WCf + 16 * b + 4 * fq);
          ST[b][nb] = __builtin_amdgcn_mfma_f32_16x16x32_bf16(AS[b], X, ST[b][nb] * wcv, 0, 0, 0);
        }
        __builtin_amdgcn_sched_barrier(0);
      }
    }
    if (seq < 16) {
      const int l2 = tidx() & 63, fr2 = l2 & 15, fq2 = l2 >> 4;
      float* so = p.out + OUT_STATE + ((((size_t)seq * 2 + j) * 2 + z) * 16 + h) * 4096;
#pragma unroll
      for (int b = 0; b < 4; ++b)
#pragma unroll
        for (int nb = 0; nb < 4; ++nb) *reinterpret_cast<f32x4*>(so + (size_t)(16 * nb + fr2) * 64 + 16 * b + 4 * fq2) = ST[b][nb];
    }
  }
}

DEVINL void phase_r5(const Params& p, int layer, int w, int nw) {
  const int j = layer >> 1;
  const int lane = tidx() & 63;
  const int gw = w * NWAVES + (tidx() >> 6), ngw = nw * NWAVES;
  const bf16_t* rb = reinterpret_cast<const bf16_t*>(p.U2);
  const bf16_t* kb = rb + (size_t)TT * DM;
  const bf16_t* vb = kb + (size_t)TT * DM;
  const bf16_t* aa = reinterpret_cast<const bf16_t*>(p.U1 + U1_AA_OFF);
  const bf16_t* gg = reinterpret_cast<const bf16_t*>(p.U1 + U1_GG_OFF);
  const float* yin = reinterpret_cast<const float*>(p.U3);
  const float* ka = p.in[23] + j * 1024;
  const float* rk = p.in[24] + j * 1024;
  const float* lg = p.in[25] + j * 1024;
  const float* lb = p.in[26] + j * 1024;
  for (int row = gw; row < TT; row += ngw) {
#pragma unroll
    for (int k = 0; k < 4; ++k) {
      const int col = k * 256 + lane * 4;
      const size_t o = (size_t)row * DM + col;
      const float4 yf = *reinterpret_cast<const float4*>(yin + o);
      const float4 yb = *reinterpret_cast<const float4*>(yin + (size_t)TT * DM + o);
      const uint2 r2 = *reinterpret_cast<const uint2*>(rb + o);
      const uint2 k2 = *reinterpret_cast<const uint2*>(kb + o);
      const uint2 v2 = *reinterpret_cast<const uint2*>(vb + o);
      const uint2 a02 = *reinterpret_cast<const uint2*>(aa + o);
      const uint2 a12 = *reinterpret_cast<const uint2*>(aa + (size_t)TT * DM + o);
      const uint2 g2 = *reinterpret_cast<const uint2*>(gg + o);
      const float4 ka4 = *reinterpret_cast<const float4*>(ka + col);
      const float4 rk4 = *reinterpret_cast<const float4*>(rk + col);
      const float4 lg4 = *reinterpret_cast<const float4*>(lg + col);
      const float4 lb4 = *reinterpret_cast<const float4*>(lb + col);
      float y[4] = {yf.x + yb.x, yf.y + yb.y, yf.z + yb.z, yf.w + yb.w};
      float r[4] = {bflo(r2.x), bfhi(r2.x), bflo(r2.y), bfhi(r2.y)};
      float kx[4] = {bflo(k2.x), bfhi(k2.x), bflo(k2.y), bfhi(k2.y)};
      float v[4] = {bflo(v2.x), bfhi(v2.x), bflo(v2.y), bfhi(v2.y)};
      float a0[4] = {bflo(a02.x), bfhi(a02.x), bflo(a02.y), bfhi(a02.y)};
      float a1[4] = {bflo(a12.x), bfhi(a12.x), bflo(a12.y), bfhi(a12.y)};
      float g[4] = {bflo(g2.x), bfhi(g2.x), bflo(g2.y), bfhi(g2.y)};
      float kav[4] = {ka4.x, ka4.y, ka4.z, ka4.w}, rkv[4] = {rk4.x, rk4.y, rk4.z, rk4.w};
      float lgv[4] = {lg4.x, lg4.y, lg4.z, lg4.w}, lbv[4] = {lb4.x, lb4.y, lb4.z, lb4.w};
      float sm = y[0] + y[1] + y[2] + y[3];
      sm = grp16_sum(sm);
      const float mean = sm * (1.0f / 64.0f);
      float sv = 0.f, sb = 0.f;
#pragma unroll
      for (int e = 0; e < 4; ++e) {
        float d = y[e] - mean; sv += d * d;
        float kd0 = kx[e] * (1.0f + (a0[e] - 1.0f) * kav[e]);
        float kd1 = kx[e] * (1.0f + (a1[e] - 1.0f) * kav[e]);
        sb += r[e] * (kd0 + kd1) * rkv[e];
      }
      sv = grp16_sum(sv); sb = grp16_sum(sb);
      const float rstd = rsqrtf(sv * (1.0f / 64.0f) + GN_EPS_F);
      float o4[4];
#pragma unroll
      for (int e = 0; e < 4; ++e) {
        float yn = (y[e] - mean) * rstd * lgv[e] + lbv[e];
        o4[e] = (yn + sb * v[e]) * g[e];
      }
      uint2 oo; oo.x = pack2(o4[0], o4[1]); oo.y = pack2(o4[2], o4[3]);
      *reinterpret_cast<uint2*>(p.abuf + o) = oo;
    }
  }
}

struct EpiWO {
  static constexpr bool PERM = false;
  const float* x; const float* mod; float* z; int layer;
  DEVINL void operator()(const f32x4 (&acc)[2][2][4][2], const pg8::Unit& u, int wr, int wc, int fr, int fq) const {
    const int row0 = u.pm * 256 + wr * 64 + fr, col0 = u.pn * 256 + wc * 32 + 4 * fq;
    const float* gate = mod + ((size_t)layer * 9 + cond_of_row(u.pm * 256)) * 6144 + 2 * 1024;
    f32x4 gv[2][2];
#pragma unroll
    for (int bj = 0; bj < 2; ++bj)
#pragma unroll
      for (int n = 0; n < 2; ++n) gv[bj][n] = *reinterpret_cast<const f32x4*>(gate + col0 + bj * 128 + n * 16);
#pragma unroll
    for (int ai = 0; ai < 2; ++ai)
#pragma unroll
      for (int m = 0; m < 4; ++m) {
        const size_t off = (size_t)(row0 + ai * 128 + m * 16) * DM + col0;
#pragma unroll
        for (int bj = 0; bj < 2; ++bj)
#pragma unroll
          for (int n = 0; n < 2; ++n) {
            const f32x4 xv = *reinterpret_cast<const f32x4*>(x + off + bj * 128 + n * 16);
            *reinterpret_cast<f32x4*>(z + off + bj * 128 + n * 16) = ALPHA_F * xv + gv[bj][n] * acc[ai][bj][m][n];
          }
        asm volatile("" ::: "memory");
      }
  }
};
DEVINL void phase_wo(const Params& p, int layer, int w, int nw, char* smem) {
  const int j = layer >> 1;
  const bf16_t* Wt = ((layer & 1) ? p.attn_wo_t : p.rwkv_wo_t) + ((size_t)j << 20);
  EpiWO E; E.x = p.xbuf; E.mod = p.mod; E.z = p.zbuf; E.layer = layer;
  pg8::ASelOne as; as.A = (const char*)p.abuf;
  pg8::StaticOrder S; S.init(TT, 1024, nw, w);
  pg8::gemm_phase<EpiWO, pg8::ASelOne>((PG8_LAS unsigned char*)smem, as, Wt, 1024, S, E);
}

DEVINL void phase_ln1(const Params& p, int layer, int w, int nw) {
  const int lane = tidx() & 63;
  const int gw = w * NWAVES + (tidx() >> 6), ngw = nw * NWAVES;
  const float* lng = p.in[9] + (size_t)(layer * 2 + 0) * 1024;
  const float* lnb = p.in[10] + (size_t)(layer * 2 + 0) * 1024;
  for (int row = gw; row < TT; row += ngw) {
    const float* md = p.mod + ((size_t)layer * 9 + cond_of_row(row)) * 6144;
    float4 z[4];
    float s = 0.f;
#pragma unroll
    for (int k = 0; k < 4; ++k) {
      z[k] = *reinterpret_cast<const float4*>(p.zbuf + (size_t)row * DM + k * 256 + lane * 4);
      s += z[k].x + z[k].y + z[k].z + z[k].w;
    }
    const float mean = wave_sum(s) * (1.0f / 1024.0f);
    float sv = 0.f;
#pragma unroll
    for (int k = 0; k < 4; ++k) {
      float a = z[k].x - mean, b = z[k].y - mean, c = z[k].z - mean, d = z[k].w - mean;
      sv += a * a + b * b + c * c + d * d;
    }
    const float rstd = rsqrtf(wave_sum(sv) * (1.0f / 1024.0f) + LN_EPS_F);
#pragma unroll
    for (int k = 0; k < 4; ++k) {
      const int col = k * 256 + lane * 4;
      const float4 g4 = *reinterpret_cast<const float4*>(lng + col);
      const float4 b4 = *reinterpret_cast<const float4*>(lnb + col);
      const float4 sh = *reinterpret_cast<const float4*>(md + 3 * 1024 + col);
      const float4 sc = *reinterpret_cast<const float4*>(md + 4 * 1024 + col);
      float4 x1;
      x1.x = (z[k].x - mean) * rstd * g4.x + b4.x;
      x1.y = (z[k].y - mean) * rstd * g4.y + b4.y;
      x1.z = (z[k].z - mean) * rstd * g4.z + b4.z;
      x1.w = (z[k].w - mean) * rstd * g4.w + b4.w;
      *reinterpret_cast<float4*>(p.xbuf + (size_t)row * DM + col) = x1;
      uint2 o;
      o.x = pack2(x1.x * (1.0f + sc.x) + sh.x, x1.y * (1.0f + sc.y) + sh.y);
      o.y = pack2(x1.z * (1.0f + sc.z) + sh.z, x1.w * (1.0f + sc.w) + sh.w);
      *reinterpret_cast<uint2*>(p.hbuf + (size_t)row * DM + col) = o;
    }
  }
}

struct EpiBf16 {
  static constexpr bool PERM = true;
  bf16_t* O; int ldc;
  DEVINL void operator()(const f32x4 (&acc)[2][2][4][2], const pg8::Unit& u, int wr, int wc, int fr, int fq) const {
    const int row0 = u.pm * 256 + wr * 64 + fr, col0 = u.pn * 256 + wc * 32 + 8 * fq;
#pragma unroll
    for (int ai = 0; ai < 2; ++ai)
#pragma unroll
      for (int m = 0; m < 4; ++m) {
        bf16_t* rowp = O + (size_t)(row0 + ai * 128 + m * 16) * ldc + col0;
#pragma unroll
        for (int bj = 0; bj < 2; ++bj) {
          const f32x4 v0 = acc[ai][bj][m][0], v1 = acc[ai][bj][m][1];
          pg8::u32x4 o; o.x = pg8::cvt_pk_bf16(v0[0], v0[1]); o.y = pg8::cvt_pk_bf16(v0[2], v0[3]); o.z = pg8::cvt_pk_bf16(v1[0], v1[1]); o.w = pg8::cvt_pk_bf16(v1[2], v1[3]);
          *reinterpret_cast<pg8::u32x4*>(rowp + bj * 128) = o;
        }
      }
  }
};

DEVINL void phase_p1(const Params& p, int layer, int w, int nw, char* smem) {
  EpiBf16 E; E.O = reinterpret_cast<bf16_t*>(p.U1); E.ldc = 2048;
  pg8::ASelOne as; as.A = (const char*)p.hbuf;
  pg8::StaticOrder S; S.init(TT, 2048, nw, w);
  pg8::gemm_phase<EpiBf16, pg8::ASelOne>((PG8_LAS unsigned char*)smem, as, p.wq_t + (size_t)layer * 2048 * 1024, 1024, S, E);
}

#define U1_S_OFF ((size_t)TT * 2048 * 2)
DEVINL void phase_p2(const Params& p, int layer, int w, int nw, char* smem) {
  GEMM_LANE_VARS
  const int half = tidx() >> 8;
  char* sh = smem + half * 16384;
  const bf16_t* qb = reinterpret_cast<const bf16_t*>(p.U1);
  float* sb = reinterpret_cast<float*>(p.U1 + U1_S_OFF);
  const int NTILES = 96 * 16;
  for (int it = 0; it * nw * 2 < NTILES; ++it) {
    int tile = (it * nw + w) * 2 + half;
    const bool valid = tile < NTILES;
    if (!valid) tile = 0;
    const int ct = tile / 96, rt = tile % 96;
    const int row0 = rt * 128;
    const int z = ct & 1;
    f32x4 acc[4][4];
    gemm_tile_128(qb + (size_t)row0 * 2048 + ct * 128, 2048, p.keysb + (size_t)(layer * 2 + z) * 16384, 128, 128, sh, acc);
    if (valid) {
#pragma unroll
      for (int m = 0; m < 4; ++m)
#pragma unroll
        for (int n = 0; n < 4; ++n)
#pragma unroll
          for (int jj = 0; jj < 4; ++jj) {
            int row = row0 + wr * 64 + m * 16 + fq * 4 + jj, col = wc * 64 + n * 16 + fr;
            sb[(size_t)row * 2048 + ct * 128 + col] = acc[m][n][jj];
          }
    }
  }
}

#define DPP_QP_1032 0xB1
#define DPP_QP_2301 0x4E
#define DPP_ROW_HALF_MIRROR 0x141
#define DPP_ROW_MIRROR 0x140
DEVINL unsigned umax_(unsigned a, unsigned b) { return a > b ? a : b; }
DEVINL unsigned umin_(unsigned a, unsigned b) { return a < b ? a : b; }
DEVINL unsigned row_max_u(unsigned v) {
  v = umax_(v, (unsigned)__builtin_amdgcn_update_dpp(0, (int)v, DPP_QP_1032, 0xf, 0xf, true));
  v = umax_(v, (unsigned)__builtin_amdgcn_update_dpp(0, (int)v, DPP_QP_2301, 0xf, 0xf, true));
  v = umax_(v, (unsigned)__builtin_amdgcn_update_dpp(0, (int)v, DPP_ROW_HALF_MIRROR, 0xf, 0xf, true));
  v = umax_(v, (unsigned)__builtin_amdgcn_update_dpp(0, (int)v, DPP_ROW_MIRROR, 0xf, 0xf, true));
  return v;
}
DEVINL float row_max_f(float v) {
  v = fmaxf(v, __int_as_float(__builtin_amdgcn_update_dpp(0, __float_as_int(v), DPP_QP_1032, 0xf, 0xf, true)));
  v = fmaxf(v, __int_as_float(__builtin_amdgcn_update_dpp(0, __float_as_int(v), DPP_QP_2301, 0xf, 0xf, true)));
  v = fmaxf(v, __int_as_float(__builtin_amdgcn_update_dpp(0, __float_as_int(v), DPP_ROW_HALF_MIRROR, 0xf, 0xf, true)));
  v = fmaxf(v, __int_as_float(__builtin_amdgcn_update_dpp(0, __float_as_int(v), DPP_ROW_MIRROR, 0xf, 0xf, true)));
  return v;
}
DEVINL float row_sum_f(float v) {
  v += __int_as_float(__builtin_amdgcn_update_dpp(0, __float_as_int(v), DPP_QP_1032, 0xf, 0xf, true));
  v += __int_as_float(__builtin_amdgcn_update_dpp(0, __float_as_int(v), DPP_QP_2301, 0xf, 0xf, true));
  v += __int_as_float(__builtin_amdgcn_update_dpp(0, __float_as_int(v), DPP_ROW_HALF_MIRROR, 0xf, 0xf, true));
  v += __int_as_float(__builtin_amdgcn_update_dpp(0, __float_as_int(v), DPP_ROW_MIRROR, 0xf, 0xf, true));
  return v;
}
DEVINL float unordf(unsigned u) { return __uint_as_float((u & 0x80000000u) ? (u ^ 0x80000000u) : ~u); }
#define CSWAP(a, b) { const unsigned _hi = umax_(a, b), _lo = umin_(a, b); a = _hi; b = _lo; }
DEVINL void slot_ij(int s, int& i, int& j) {
  if (s < 16) { i = 0; j = s; }
  else if (s < 24) { i = 1; j = s - 16; }
  else if (s < 29) { i = 2; j = s - 24; }
  else if (s < 33) { i = 3; j = s - 29; }
  else if (s < 36) { i = 4; j = s - 33; }
  else if (s < 42) { i = 5 + ((s - 36) >> 1); j = (s - 36) & 1; }
  else { i = s - 34; j = 0; }
}
DEVINL void phase_p3(const Params& p, int layer, int w, int nw, char* smem) {
  const int lane = tidx() & 63, wid = tidx() >> 6;
  const int fr = lane & 15, row = lane >> 4, pr = lane >> 5, l32 = lane & 31;
  const int gw = w * NWAVES + wid, ngw = nw * NWAVES;
  const float* sb = reinterpret_cast<const float*>(p.U1 + U1_S_OFF);
  float* svl = reinterpret_cast<float*>(smem) + wid * 128;
  int* sil = reinterpret_cast<int*>(smem) + wid * 128 + 64;
  int iA, jA, iB, jB;
  slot_ij(l32, iA, jA);
  const bool validB = (l32 + 32) < 50;
  slot_ij(validB ? (l32 + 32) : 0, iB, jB);
  for (int bt = gw; bt < TT * 4; bt += ngw) {
    const int t = bt >> 2, hp = bt & 3;
    {
      const int h = hp * 2 + (row >> 1), z = row & 1;
      const float* sp = sb + (size_t)t * 2048 + (h * 2 + z) * 128;
      const float4 a = *reinterpret_cast<const float4*>(sp + fr * 4);
      const float4 b = *reinterpret_cast<const float4*>(sp + 64 + fr * 4);
      unsigned k0 = (ordf(a.x) & ~127u) | (unsigned)(127 - (4 * fr + 0));
      unsigned k1 = (ordf(a.y) & ~127u) | (unsigned)(127 - (4 * fr + 1));
      unsigned k2 = (ordf(a.z) & ~127u) | (unsigned)(127 - (4 * fr + 2));
      unsigned k3 = (ordf(a.w) & ~127u) | (unsigned)(127 - (4 * fr + 3));
      unsigned k4 = (ordf(b.x) & ~127u) | (unsigned)(127 - (64 + 4 * fr + 0));
      unsigned k5 = (ordf(b.y) & ~127u) | (unsigned)(127 - (64 + 4 * fr + 1));
      unsigned k6 = (ordf(b.z) & ~127u) | (unsigned)(127 - (64 + 4 * fr + 2));
      unsigned k7 = (ordf(b.w) & ~127u) | (unsigned)(127 - (64 + 4 * fr + 3));
      CSWAP(k0, k1); CSWAP(k2, k3); CSWAP(k4, k5); CSWAP(k6, k7);
      CSWAP(k0, k2); CSWAP(k1, k3); CSWAP(k4, k6); CSWAP(k5, k7);
      CSWAP(k1, k2); CSWAP(k5, k6); CSWAP(k0, k4); CSWAP(k3, k7);
      CSWAP(k1, k5); CSWAP(k2, k6);
      CSWAP(k1, k4); CSWAP(k3, k6);
      CSWAP(k2, k4); CSWAP(k3, k5);
      CSWAP(k3, k4);
      unsigned mine = 0;
#pragma unroll
      for (int it = 0; it < 16; ++it) {
        const unsigned m = row_max_u(k0);
        if (fr == it) mine = m;
        const bool c = (k0 == m);
        k0 = c ? k1 : k0; k1 = c ? k2 : k1; k2 = c ? k3 : k2; k3 = c ? k4 : k3;
        k4 = c ? k5 : k4; k5 = c ? k6 : k5; k6 = c ? k7 : k6; k7 = c ? 0u : k7;
      }
      __builtin_amdgcn_wave_barrier();
      svl[row * 16 + fr] = unordf(mine & ~127u);
      sil[row * 16 + fr] = 127 - (int)(mine & 127u);
      __builtin_amdgcn_wave_barrier();
    }
    {
      const float* v0 = svl + (2 * pr) * 16;
      const float* v1 = svl + (2 * pr + 1) * 16;
      unsigned kA = (ordf(v0[iA] + v1[jA]) & ~63u) | (unsigned)(63 - l32);
      unsigned kB = validB ? ((ordf(v0[iB] + v1[jB]) & ~63u) | (unsigned)(63 - (l32 + 32))) : 0u;
      unsigned mine = 0;
#pragma unroll
      for (int it = 0; it < 16; ++it) {
        unsigned m = row_max_u(umax_(kA, kB));
        m = umax_(m, (unsigned)__shfl_xor((int)m, 16));
        if (l32 == it) mine = m;
        kA = (kA == m) ? 0u : kA;
        kB = (kB == m) ? 0u : kB;
      }
      int ii, jj;
      slot_ij(63 - (int)(mine & 63u), ii, jj);
      ii &= 15; jj &= 15;
      const float cv = v0[ii] + v1[jj];
      const int eidx = sil[(2 * pr) * 16 + ii] * 128 + sil[(2 * pr + 1) * 16 + jj];
      const float mx = row_max_f(cv);
      const float ex = __expf(cv - mx);
      const float sm = row_sum_f(ex);
      if (l32 < 16) {
        const int h = hp * 2 + pr;
        p.pidx[(size_t)t * 128 + h * 16 + l32] = eidx;
        p.pgate[(size_t)t * 128 + h * 16 + l32] = ex / sm;
      }
    }
  }
}

DEVINL float gelu_exact(float x) { return 0.5f * x * (1.0f + erff(x * 0.7071067811865476f)); }

DEVINL void phase_p4(const Params& p, int layer, int w, int nw, char* smem) {
  const int tid = tidx(), lane = tid & 63, wid = tid >> 6;
  const int fr = lane & 15, fq = lane >> 4;
  const int gw = w * NWAVES + wid, ngw = nw * NWAVES;
  const bf16_t* U = p.ub + (size_t)layer * 16384 * 1024;
  const bf16_t* V = p.vb + (size_t)layer * 16384 * 1024;
  const float* lng = p.in[9] + (size_t)(layer * 2 + 1) * 1024;
  const float* lnb = p.in[10] + (size_t)(layer * 2 + 1) * 1024;
  float* xout = (layer == 3) ? p.out : p.xbuf;
  char* wl = smem + wid * 3072;
  bf16_t* xl = reinterpret_cast<bf16_t*>(wl);
  float* wgt = reinterpret_cast<float*>(wl + 2048);
  int* il = reinterpret_cast<int*>(wl + 2560);
  for (int t = gw; t < TT; t += ngw) {
    __builtin_amdgcn_wave_barrier();
    {
      const uint4 a = *reinterpret_cast<const uint4*>(p.hbuf + (size_t)t * DM + lane * 8);
      const uint4 b = *reinterpret_cast<const uint4*>(p.hbuf + (size_t)t * DM + 512 + lane * 8);
      *reinterpret_cast<uint4*>(xl + lane * 8) = a;
      *reinterpret_cast<uint4*>(xl + 512 + lane * 8) = b;
      il[lane] = p.pidx[(size_t)t * 128 + lane];
      il[64 + lane] = p.pidx[(size_t)t * 128 + 64 + lane];
    }
    __builtin_amdgcn_wave_barrier();
    const bf16_t* up[8];
#pragma unroll
    for (int g = 0; g < 8; ++g) up[g] = U + (size_t)il[g * 16 + fr] * DM + fq * 8;
    f32x4 acc[8];
#pragma unroll
    for (int g = 0; g < 8; ++g) acc[g] = (f32x4){0.f, 0.f, 0.f, 0.f};
#pragma unroll 2
    for (int s = 0; s < 32; ++s) {
      const bf16x8 xf = *reinterpret_cast<const bf16x8*>(xl + s * 32 + fq * 8);
      bf16x8 a[8];
#pragma unroll
      for (int g = 0; g < 8; ++g) a[g] = *reinterpret_cast<const bf16x8*>(up[g] + s * 32);
#pragma unroll
      for (int g = 0; g < 8; ++g) acc[g] = __builtin_amdgcn_mfma_f32_16x16x32_bf16(a[g], xf, acc[g], 0, 0, 0);
    }
#pragma unroll
    for (int g = 0; g < 8; ++g) {
      const float4 gt = *reinterpret_cast<const float4*>(p.pgate + (size_t)t * 128 + g * 16 + fq * 4);
      float4 wv;
      wv.x = gt.x * gelu_exact(acc[g][0]);
      wv.y = gt.y * gelu_exact(acc[g][1]);
      wv.z = gt.z * gelu_exact(acc[g][2]);
      wv.w = gt.w * gelu_exact(acc[g][3]);
      if (fr == 0) *reinterpret_cast<float4*>(wgt + g * 16 + fq * 4) = wv;
    }
    __builtin_amdgcn_wave_barrier();
    float f[16];
#pragma unroll
    for (int e = 0; e < 16; ++e) f[e] = 0.f;
#pragma unroll 8
    for (int e = 0; e < 128; ++e) {
      const int idx = __builtin_amdgcn_readfirstlane(il[e]);
      const float we = wgt[e];
      const bf16_t* vp = V + (size_t)idx * DM;
      const uint4 c = *reinterpret_cast<const uint4*>(vp + lane * 8);
      const uint4 dd = *reinterpret_cast<const uint4*>(vp + 512 + lane * 8);
      f[0] += we * bflo(c.x); f[1] += we * bfhi(c.x); f[2] += we * bflo(c.y); f[3] += we * bfhi(c.y);
      f[4] += we * bflo(c.z); f[5] += we * bfhi(c.z); f[6] += we * bflo(c.w); f[7] += we * bfhi(c.w);
      f[8] += we * bflo(dd.x); f[9] += we * bfhi(dd.x); f[10] += we * bflo(dd.y); f[11] += we * bfhi(dd.y);
      f[12] += we * bflo(dd.z); f[13] += we * bfhi(dd.z); f[14] += we * bflo(dd.w); f[15] += we * bfhi(dd.w);
    }
    const float* md = p.mod + ((size_t)layer * 9 + cond_of_row(t)) * 6144 + 5 * 1024;
    float zz[16];
    float s = 0.f;
#pragma unroll
    for (int hf = 0; hf < 2; ++hf) {
      const int col = hf * 512 + lane * 8;
      const float4 x0 = *reinterpret_cast<const float4*>(p.xbuf + (size_t)t * DM + col);
      const float4 x1 = *reinterpret_cast<const float4*>(p.xbuf + (size_t)t * DM + col + 4);
      const float4 g0 = *reinterpret_cast<const float4*>(md + col);
      const float4 g1 = *reinterpret_cast<const float4*>(md + col + 4);
      const float xv[8] = {x0.x, x0.y, x0.z, x0.w, x1.x, x1.y, x1.z, x1.w};
      const float gv[8] = {g0.x, g0.y, g0.z, g0.w, g1.x, g1.y, g1.z, g1.w};
#pragma unroll
      for (int e = 0; e < 8; ++e) { zz[hf * 8 + e] = ALPHA_F * xv[e] + gv[e] * f[hf * 8 + e]; s += zz[hf * 8 + e]; }
    }
    const float mean = wave_sum(s) * (1.0f / 1024.0f);
    float sv = 0.f;
#pragma unroll
    for (int e = 0; e < 16; ++e) { float d = zz[e] - mean; sv += d * d; }
    const float rstd = rsqrtf(wave_sum(sv) * (1.0f / 1024.0f) + LN_EPS_F);
#pragma unroll
    for (int hf = 0; hf < 2; ++hf) {
      const int col = hf * 512 + lane * 8;
      const float4 g0 = *reinterpret_cast<const float4*>(lng + col);
      const float4 g1 = *reinterpret_cast<const float4*>(lng + col + 4);
      const float4 b0 = *reinterpret_cast<const float4*>(lnb + col);
      const float4 b1 = *reinterpret_cast<const float4*>(lnb + col + 4);
      float4 o0, o1;
      o0.x = (zz[hf * 8 + 0] - mean) * rstd * g0.x + b0.x;
      o0.y = (zz[hf * 8 + 1] - mean) * rstd * g0.y + b0.y;
      o0.z = (zz[hf * 8 + 2] - mean) * rstd * g0.z + b0.z;
      o0.w = (zz[hf * 8 + 3] - mean) * rstd * g0.w + b0.w;
      o1.x = (zz[hf * 8 + 4] - mean) * rstd * g1.x + b1.x;
      o1.y = (zz[hf * 8 + 5] - mean) * rstd * g1.y + b1.y;
      o1.z = (zz[hf * 8 + 6] - mean) * rstd * g1.z + b1.z;
      o1.w = (zz[hf * 8 + 7] - mean) * rstd * g1.w + b1.w;
      *reinterpret_cast<float4*>(xout + (size_t)t * DM + col) = o0;
      *reinterpret_cast<float4*>(xout + (size_t)t * DM + col + 4) = o1;
    }
  }
}

DEVINL void phase_a1(const Params& p, int layer, int w, int nw) {
  const int lane = tidx() & 63;
  const int gw = w * NWAVES + (tidx() >> 6), ngw = nw * NWAVES;
  for (int row = gw; row < TT; row += ngw) {
    const float* md = p.mod + ((size_t)layer * 9 + cond_of_row(row)) * 6144;
#pragma unroll
    for (int k = 0; k < 4; ++k) {
      const int col = k * 256 + lane * 4;
      const float4 x = *reinterpret_cast<const float4*>(p.xbuf + (size_t)row * DM + col);
      const float4 sh = *reinterpret_cast<const float4*>(md + col);
      const float4 sc = *reinterpret_cast<const float4*>(md + 1024 + col);
      uint2 o;
      o.x = pack2(x.x * (1.0f + sc.x) + sh.x, x.y * (1.0f + sc.y) + sh.y);
      o.y = pack2(x.z * (1.0f + sc.z) + sh.z, x.w * (1.0f + sc.w) + sh.w);
      *reinterpret_cast<uint2*>(p.hbuf + (size_t)row * DM + col) = o;
    }
  }
}

DEVINL void phase_a2(const Params& p, int layer, int w, int nw, char* smem) {
  const int j = layer >> 1;
  EpiBf16 E; E.O = reinterpret_cast<bf16_t*>(p.U1); E.ldc = 1536;
  pg8::ASelOne as; as.A = (const char*)p.hbuf;
  pg8::StaticOrder S; S.init(TT, 1536, nw, w);
  pg8::gemm_phase<EpiBf16, pg8::ASelOne>((PG8_LAS unsigned char*)smem, as, p.attn_wqkv_t + (size_t)j * 1536 * 1024, 1024, S, E);
}

DEVINL void load16(const bf16_t* src, float (&x)[16]) {
  const uint4 a = *reinterpret_cast<const uint4*>(src);
  const uint4 b = *reinterpret_cast<const uint4*>(src + 8);
  x[0] = bflo(a.x); x[1] = bfhi(a.x); x[2] = bflo(a.y); x[3] = bfhi(a.y); x[4] = bflo(a.z); x[5] = bfhi(a.z); x[6] = bflo(a.w); x[7] = bfhi(a.w);
  x[8] = bflo(b.x); x[9] = bfhi(b.x); x[10] = bflo(b.y); x[11] = bfhi(b.y); x[12] = bflo(b.z); x[13] = bfhi(b.z); x[14] = bflo(b.w); x[15] = bfhi(b.w);
}
DEVINL void store16bf(bf16_t* dst, const float (&x)[16]) {
  uint4 a, b;
  a.x = pack2(x[0], x[1]); a.y = pack2(x[2], x[3]); a.z = pack2(x[4], x[5]); a.w = pack2(x[6], x[7]);
  b.x = pack2(x[8], x[9]); b.y = pack2(x[10], x[11]); b.z = pack2(x[12], x[13]); b.w = pack2(x[14], x[15]);
  *reinterpret_cast<uint4*>(dst) = a; *reinterpret_cast<uint4*>(dst + 8) = b;
}
DEVINL void headnorm_rope(float (&x)[16], const float* nwgt, int quarter, bool lat, int t, const float* rope) {
  float ss = 0.f;
#pragma unroll
  for (int e = 0; e < 16; ++e) ss += x[e] * x[e];
  ss += __shfl_xor(ss, 1); ss += __shfl_xor(ss, 2);
  const float rinv = rsqrtf(ss * (1.0f / 64.0f) + RMS_EPS_F);
#pragma unroll
  for (int e = 0; e < 16; ++e) x[e] = x[e] * rinv * nwgt[quarter * 16 + e];
  if (lat) {
    const int pos = (quarter < 2) ? (t >> 6) : (t & 63);
    const bool hi = quarter & 1;
#pragma unroll
    for (int e = 0; e < 16; ++e) {
      const float other = __shfl_xor(x[e], 1);
      const float c = rope[(pos * 16 + e) * 2], s = rope[(pos * 16 + e) * 2 + 1];
      x[e] = hi ? (x[e] * c + other * s) : (x[e] * c - other * s);
    }
  }
}

DEVINL void phase_a2b(const Params& p, int layer, int w, int nw) {
  const int j = layer >> 1;
  const int lane = tidx() & 63;
  const int gw = w * NWAVES + (tidx() >> 6), ngw = nw * NWAVES;
  const bf16_t* qkv = reinterpret_cast<const bf16_t*>(p.U1);
  bf16_t* qb = reinterpret_cast<bf16_t*>(p.U2);
  const float* qn = p.in[29] + j * 64;
  const float* kn = p.in[30] + j * 64;
  for (int row = gw; row < TT; row += ngw) {
    const bool lat = row >= TCTX;
    const int t = lat ? ((row - TCTX) & 1023) : (row & 255);
    const int b = lat ? ((row - TCTX) >> 10) : (row >> 8);
    const bf16_t* src = qkv + (size_t)row * 1536;
    {
      float x[16];
      load16(src + lane * 16, x);
      headnorm_rope(x, qn, lane & 3, lat, t, p.rope);
#pragma unroll
      for (int e = 0; e < 16; ++e) x[e] *= QSCALE_F;
      store16bf(qb + (size_t)row * DM + lane * 16, x);
    }
    if (lane < 16) {
      const int kvh = lane >> 2, quarter = lane & 3;
      float x[16];
      load16(src + 1024 + lane * 16, x);
      headnorm_rope(x, kn, quarter, false, t, p.rope);
      if (lat) {
        const int pos = (quarter < 2) ? (t >> 6) : (t & 63);
        const bool hi = quarter & 1;
#pragma unroll
        for (int e = 0; e < 16; ++e) {
          const float other = __shfl_xor(x[e], 1);
          const float c = p.rope[(pos * 16 + e) * 2], s = p.rope[(pos * 16 + e) * 2 + 1];
          x[e] = hi ? (x[e] * c + other * s) : (x[e] * c - other * s);
        }
        store16bf(p.Klat + ((size_t)((j * 8 + b) * 4 + kvh) * 1536 + 512 + t) * 64 + quarter * 16, x);
      } else {
        store16bf(p.Kctx + ((size_t)((j * 16 + b) * 4 + kvh) * 256 + t) * 64 + quarter * 16, x);
        float* ko = p.out + OUT_CK + ((size_t)(b * 2 + j) * 256 + t) * 256 + kvh * 64 + quarter * 16;
#pragma unroll
        for (int q4 = 0; q4 < 4; ++q4) reinterpret_cast<float4*>(ko)[q4] = make_float4(x[q4 * 4], x[q4 * 4 + 1], x[q4 * 4 + 2], x[q4 * 4 + 3]);
      }
    } else if (lane < 32) {
      const int l2 = lane - 16;
      const int kvh = l2 >> 2, quarter = l2 & 3;
      float x[16];
      load16(src + 1280 + l2 * 16, x);
      if (lat) {
        bf16_t* vd = p.VlatT + (size_t)((j * 8 + b) * 4 + kvh) * 64 * 1536 + 512 + t;
#pragma unroll
        for (int e = 0; e < 16; ++e) vd[(size_t)(quarter * 16 + e) * 1536] = f2bf(x[e]);
      } else {
        bf16_t* vd = p.VctxT + (size_t)((j * 16 + b) * 4 + kvh) * 64 * 256 + t;
#pragma unroll
        for (int e = 0; e < 16; ++e) vd[(size_t)(quarter * 16 + e) * 256] = f2bf(x[e]);
        float* vo = p.out + OUT_CV + ((size_t)(b * 2 + j) * 256 + t) * 256 + kvh * 64 + quarter * 16;
#pragma unroll
        for (int q4 = 0; q4 < 4; ++q4) reinterpret_cast<float4*>(vo)[q4] = make_float4(x[q4 * 4], x[q4 * 4 + 1], x[q4 * 4 + 2], x[q4 * 4 + 3]);
      }
    }
  }
}

DEVINL void phase_a3(const Params& p, int layer, int w, int nw) {
  const int j = layer >> 1;
  const int lane = tidx() & 63, wid = tidx() >> 6;
  const int ql = lane & 31, hh = lane >> 5;
  const bf16_t* qb = reinterpret_cast<const bf16_t*>(p.U2);
  for (int item = w; item < 768; item += nw) {
    int hq, Tk, row0;
    const bf16_t *Kb, *Vt;
    if (item < 512) {
      const int b = item >> 6, qblk = item & 3;
      hq = (item >> 2) & 15;
      const int kvh = hq >> 2;
      Kb = p.Klat + (size_t)((j * 8 + b) * 4 + kvh) * 1536 * 64;
      Vt = p.VlatT + (size_t)((j * 8 + b) * 4 + kvh) * 64 * 1536;
      Tk = 1536; row0 = TCTX + b * 1024 + qblk * 256;
    } else {
      const int it = item - 512;
      const int b = it >> 4;
      hq = it & 15;
      const int kvh = hq >> 2;
      Kb = p.Kctx + (size_t)((j * 16 + b) * 4 + kvh) * 256 * 64;
      Vt = p.VctxT + (size_t)((j * 16 + b) * 4 + kvh) * 64 * 256;
      Tk = 256; row0 = b * 256;
    }
    const int qrow = row0 + wid * 32 + ql;
    bf16x8 bq[4];
#pragma unroll
    for (int ks = 0; ks < 4; ++ks) bq[ks] = *reinterpret_cast<const bf16x8*>(qb + (size_t)qrow * DM + hq * 64 + ks * 16 + hh * 8);
    f32x16 o0, o1;
#pragma unroll
    for (int r = 0; r < 16; ++r) { o0[r] = 0.f; o1[r] = 0.f; }
    float mrun = -1e30f, lrun = 0.f;
    for (int kt = 0; kt < Tk; kt += 32) {
      f32x16 sacc;
#pragma unroll
      for (int r = 0; r < 16; ++r) sacc[r] = 0.f;
#pragma unroll
      for (int ks = 0; ks < 4; ++ks) {
        bf16x8 ka = *reinterpret_cast<const bf16x8*>(Kb + (size_t)(kt + ql) * 64 + ks * 16 + hh * 8);
        sacc = __builtin_amdgcn_mfma_f32_32x32x16_bf16(ka, bq[ks], sacc, 0, 0, 0);
      }
      float tmax = sacc[0];
#pragma unroll
      for (int r = 1; r < 16; ++r) tmax = fmaxf(tmax, sacc[r]);
      tmax = fmaxf(tmax, __shfl_xor(tmax, 32));
      const float mnew = fmaxf(mrun, tmax);
      const float corr = exp2f(mrun - mnew);
      mrun = mnew;
      lrun *= corr;
#pragma unroll
      for (int r = 0; r < 16; ++r) { o0[r] *= corr; o1[r] *= corr; }
      float pv[16];
#pragma unroll
      for (int r = 0; r < 16; ++r) { pv[r] = exp2f(sacc[r] - mnew); lrun += pv[r]; }
#pragma unroll
      for (int s2 = 0; s2 < 2; ++s2) {
        union { bf16x8 v; unsigned u[4]; } pb;
#pragma unroll
        for (int q = 0; q < 4; ++q) pb.u[q] = pack2(pv[s2 * 8 + q * 2], pv[s2 * 8 + q * 2 + 1]);
#pragma unroll
        for (int dblk = 0; dblk < 2; ++dblk) {
          const bf16_t* vp = Vt + (size_t)(dblk * 32 + ql) * Tk + kt + 16 * s2 + 4 * hh;
          const uint2 lo = *reinterpret_cast<const uint2*>(vp);
          const uint2 hi = *reinterpret_cast<const uint2*>(vp + 8);
          union { bf16x8 v; unsigned u[4]; } va;
          va.u[0] = lo.x; va.u[1] = lo.y; va.u[2] = hi.x; va.u[3] = hi.y;
          if (dblk == 0) o0 = __builtin_amdgcn_mfma_f32_32x32x16_bf16(va.v, pb.v, o0, 0, 0, 0);
          else o1 = __builtin_amdgcn_mfma_f32_32x32x16_bf16(va.v, pb.v, o1, 0, 0, 0);
        }
      }
    }
    const float ltot = lrun + __shfl_xor(lrun, 32);
    const float inv = 1.0f / ltot;
#pragma unroll
    for (int g = 0; g < 4; ++g) {
      uint2 oa, ob;
      oa.x = pack2(o0[4 * g] * inv, o0[4 * g + 1] * inv); oa.y = pack2(o0[4 * g + 2] * inv, o0[4 * g + 3] * inv);
      ob.x = pack2(o1[4 * g] * inv, o1[4 * g + 1] * inv); ob.y = pack2(o1[4 * g + 2] * inv, o1[4 * g + 3] * inv);
      *reinterpret_cast<uint2*>(p.abuf + (size_t)qrow * DM + hq * 64 + 8 * g + 4 * hh) = oa;
      *reinterpret_cast<uint2*>(p.abuf + (size_t)qrow * DM + hq * 64 + 32 + 8 * g + 4 * hh) = ob;
    }
  }
}

#define XB_TMO      128
#define XB_XCNT(j)  (256  + 64 * (j))
#define XB_XSUB(j)  (1280 + 64 * (j))
#define XB_XGEN(j)  (2304 + 64 * (j))
#define XB_TOP      3328
#define XB_TOPGEN   3392
#define XCD_BAR_WORDS 3456
#define XB_SPIN_CAP (1u << 22)
#define LAS __attribute__((address_space(3)))

DEVINL unsigned xb_ld(unsigned* p) { return __hip_atomic_load(p, __ATOMIC_RELAXED, __HIP_MEMORY_SCOPE_AGENT); }
DEVINL unsigned xb_add(unsigned* p, unsigned v) { return __hip_atomic_fetch_add(p, v, __ATOMIC_RELAXED, __HIP_MEMORY_SCOPE_AGENT); }
DEVINL unsigned xb_xcc_id() { return (unsigned)__builtin_amdgcn_s_getreg((3 << 11) | 20) & 0xFu; }
#define XB_SPIN(cond, bar) do { unsigned _sp = 0; while (cond) { __builtin_amdgcn_s_sleep(1); \
    if ((++_sp & 255u) == 0u) { if (xb_ld(&(bar)[XB_TMO])) break; if (_sp > XB_SPIN_CAP) { atomicAdd(&(bar)[XB_TMO], 1u); break; } } } } while (0)

struct XcdBarrier { unsigned* bar; unsigned x; volatile LAS unsigned* st; };

DEVINL XcdBarrier xcd_barrier_post(unsigned* bar, volatile LAS unsigned* st) {
  XcdBarrier b; b.bar = bar; b.x = xb_xcc_id(); b.st = st;
  if (threadIdx.x == 0) (void)xb_add(&bar[XB_XCNT(b.x)], 1u);
  return b;
}
DEVINL void xcd_barrier_complete(unsigned* bar, unsigned x, unsigned& nloc, unsigned& nx) {
  const unsigned G = gridDim.x * gridDim.y * gridDim.z;
  unsigned sum, cnt, mine, sp = 0u;
  for (;;) {
    sum = 0u; cnt = 0u; mine = 0u;
#pragma unroll
    for (unsigned j = 0; j < 16; ++j) { const unsigned c = xb_ld(&bar[XB_XCNT(j)]); sum += c; cnt += (c > 0u) ? 1u : 0u; mine = (j == x) ? c : mine; }
    if (sum == G) break;
    __builtin_amdgcn_s_sleep(1);
    if ((++sp & 255u) == 0u) { if (xb_ld(&bar[XB_TMO])) break; if (sp > XB_SPIN_CAP) { atomicAdd(&bar[XB_TMO], 1u); break; } }
  }
  nloc = mine > 0u ? mine : 1u; nx = cnt > 0u ? cnt : 1u;
}
DEVINL void xcd_barrier(const XcdBarrier& b) {
  asm volatile("s_waitcnt vmcnt(0)" ::: "memory");
  __syncthreads();
  if (threadIdx.x == 0) {
    unsigned* bar = b.bar;
    __builtin_amdgcn_s_waitcnt(0);
    unsigned nloc = b.st[0], nx = b.st[1];
    if (nloc == 0u) { xcd_barrier_complete(bar, b.x, nloc, nx); b.st[0] = nloc; b.st[1] = nx; }
    const unsigned old = xb_add(&bar[XB_XSUB(b.x)], 1u);
    const unsigned gen = old / nloc;
    if (old + 1u == (gen + 1u) * nloc) {
      __builtin_amdgcn_fence(__ATOMIC_RELEASE, "agent");
      asm volatile("s_waitcnt vmcnt(0)" ::: "memory");
      const unsigned og = xb_add(&bar[XB_TOP], 1u);
      const unsigned tg = og / nx;
      if (og + 1u == (tg + 1u) * nx) xb_add(&bar[XB_TOPGEN], 1u);
      else XB_SPIN(xb_ld(&bar[XB_TOPGEN]) == tg, bar);
      __builtin_amdgcn_fence(__ATOMIC_ACQUIRE, "agent");
      xb_add(&bar[XB_XGEN(b.x)], 1u);
      asm volatile("s_waitcnt vmcnt(0)" ::: "memory");
    } else {
      XB_SPIN(xb_ld(&bar[XB_XGEN(b.x)]) == gen, bar);
      __builtin_amdgcn_fence(__ATOMIC_ACQUIRE, "agent");
      asm volatile("s_waitcnt vmcnt(0)" ::: "memory");
    }
  }
  __syncthreads();
}

extern __shared__ __attribute__((aligned(16))) char dyn_smem[];
__global__ void __launch_bounds__(NTHREADS, 2) mega_kernel(Params p) {
  char* smem = dyn_smem;
  cg::grid_group grid = cg::this_grid();
  const int w = blockIdx.x, nw = gridDim.x;
  if (p.use_cg_sync) grid.sync();
  volatile LAS unsigned* xst = (volatile LAS unsigned*)(smem + SMEM_BYTES - 16);
  if (threadIdx.x == 0) { xst[0] = 0u; xst[1] = 0u; }
  __syncthreads();
  XcdBarrier xb = xcd_barrier_post(p.bar, xst);
#define GSYNC() xcd_barrier(xb)
#ifndef REP_PREP
#define REP_PREP 1
#endif
#ifndef REP_R4
#define REP_R4 1
#endif
#ifndef REP_P3
#define REP_P3 1
#endif
#ifndef REP_P4L3
#define REP_P4L3 1
#endif
#ifndef REP_A3
#define REP_A3 1
#endif
#ifndef REP_GEMM
#define REP_GEMM 1
#endif
#ifndef REP_SG
#define REP_SG 1
#endif
#ifndef REP_EW
#define REP_EW 1
#endif
  for (int rep = 0; rep < REP_PREP; ++rep) { phase_prep(p, w, nw, smem); GSYNC(); }
  for (int layer = 0; layer < 4; ++layer) {
    if ((layer & 1) == 0) {
      for (int rep = 0; rep < REP_EW; ++rep) { phase_r1(p, layer, w, nw); GSYNC(); }
      for (int rep = 0; rep < REP_GEMM; ++rep) { phase_r2(p, layer, w, nw, smem); GSYNC(); }
      for (int rep = 0; rep < REP_SG; ++rep) { phase_r3(p, layer, w, nw, smem); GSYNC(); }
      for (int rep = 0; rep < REP_R4; ++rep) { phase_r4(p, layer, w, nw, smem); GSYNC(); }
      for (int rep = 0; rep < REP_EW; ++rep) { phase_r5(p, layer, w, nw); GSYNC(); }
    } else {
      for (int rep = 0; rep < REP_EW; ++rep) { phase_a1(p, layer, w, nw); GSYNC(); }
      for (int rep = 0; rep < REP_GEMM; ++rep) { phase_a2(p, layer, w, nw, smem); GSYNC(); }
      for (int rep = 0; rep < REP_EW; ++rep) { phase_a2b(p, layer, w, nw); GSYNC(); }
      for (int rep = 0; rep < REP_A3; ++rep) { phase_a3(p, layer, w, nw); GSYNC(); }
    }
    for (int rep = 0; rep < REP_GEMM; ++rep) { phase_wo(p, layer, w, nw, smem); GSYNC(); }
    for (int rep = 0; rep < REP_EW; ++rep) { phase_ln1(p, layer, w, nw); GSYNC(); }
    for (int rep = 0; rep < REP_GEMM; ++rep) { phase_p1(p, layer, w, nw, smem); GSYNC(); }
    for (int rep = 0; rep < REP_SG; ++rep) { phase_p2(p, layer, w, nw, smem); GSYNC(); }
    for (int rep = 0; rep < REP_P3; ++rep) { phase_p3(p, layer, w, nw, smem); GSYNC(); }
    for (int rep = 0; rep < (layer == 3 ? REP_P4L3 : 1); ++rep) { phase_p4(p, layer, w, nw, smem); GSYNC(); }
  }
}

static inline char* carve(char*& cur, size_t bytes) {
  char* r = cur;
  cur += (bytes + 255) & ~(size_t)255;
  return r;
}

extern "C" void kernel_launch(void* const* d_in, const int* in_sizes, int n_in, void* d_out, int out_size, void* d_ws,
                              size_t ws_size, hipStream_t stream) {
  Params p;
  memset(&p, 0, sizeof(p));
  for (int i = 0; i < 35; ++i) p.in[i] = (const float*)d_in[i];
  p.out = (float*)d_out;
  char* cur = (char*)d_ws;
  p.bar = (unsigned*)carve(cur, 16384);
  p.mod = (float*)carve(cur, (size_t)4 * 9 * 6144 * 4);
  p.rope = (float*)carve(cur, 64 * 16 * 2 * 4);
  p.rwkv_in_t = (bf16_t*)carve(cur, (size_t)2 * RW_N * 1024 * 2);
  p.w2t = (bf16_t*)carve(cur, (size_t)4 * 65536 * 2);
  p.a2t = (bf16_t*)carve(cur, (size_t)4 * 65536 * 2);
  p.g2t = (bf16_t*)carve(cur, (size_t)2 * 131072 * 2);
  p.rwkv_wo_t = (bf16_t*)carve(cur, (size_t)2 * 1048576 * 2);
  p.attn_wqkv_t = (bf16_t*)carve(cur, (size_t)2 * 1536 * 1024 * 2);
  p.attn_wo_t = (bf16_t*)carve(cur, (size_t)2 * 1048576 * 2);
  p.wq_t = (bf16_t*)carve(cur, (size_t)4 * 2048 * 1024 * 2);
  p.keysb = (bf16_t*)carve(cur, (size_t)4 * 2 * 128 * 128 * 2);
  p.ub = (bf16_t*)carve(cur, (size_t)4 * 16384 * 1024 * 2);
  p.vb = (bf16_t*)carve(cur, (size_t)4 * 16384 * 1024 * 2);
  p.Klat = (bf16_t*)carve(cur, (size_t)2 * 8 * 4 * 1536 * 64 * 2);
  p.VlatT = (bf16_t*)carve(cur, (size_t)2 * 8 * 4 * 1536 * 64 * 2);
  p.Kctx = (bf16_t*)carve(cur, (size_t)2 * 16 * 4 * 256 * 64 * 2);
  p.VctxT = (bf16_t*)carve(cur, (size_t)2 * 16 * 4 * 256 * 64 * 2);
  p.xbuf = (float*)carve(cur, (size_t)TT * DM * 4);
  p.zbuf = (float*)carve(cur, (size_t)TT * DM * 4);
  p.hbuf = (bf16_t*)carve(cur, (size_t)TT * DM * 2);
  p.abuf = (bf16_t*)carve(cur, (size_t)TT * DM * 2);
  p.U1 = carve(cur, (size_t)TT * DM * 14);
  p.U2 = carve(cur, (size_t)TT * DM * 8);
  p.U3 = carve(cur, (size_t)TT * DM * 8);
  p.pidx = (int*)carve(cur, (size_t)TT * 128 * 4);
  p.pgate = (float*)carve(cur, (size_t)TT * 128 * 4);
  for (int f = 0; f < 16; ++f) p.freqs[f] = pow(10000.0, -(double)f / 16.0);
  if ((size_t)(cur - (char*)d_ws) > ws_size) {
    fprintf(stderr, "workspace too small: need %zu have %zu\n", (size_t)(cur - (char*)d_ws), ws_size);
    return;
  }
  static int grid_blocks = 0;
  if (!grid_blocks) {
    int dev = 0, cus = 0, per_cu = 0;
    (void)hipGetDevice(&dev);
    (void)hipDeviceGetAttribute(&cus, hipDeviceAttributeMultiprocessorCount, dev);
    (void)hipFuncSetAttribute((const void*)mega_kernel, hipFuncAttributeMaxDynamicSharedMemorySize, SMEM_BYTES);
    (void)hipOccupancyMaxActiveBlocksPerMultiprocessor(&per_cu, mega_kernel, NTHREADS, SMEM_BYTES);
    if (per_cu > 1) per_cu = 1;
    if (per_cu < 1) per_cu = 1;
    grid_blocks = cus * per_cu;
  }
  (void)hipMemsetAsync(p.bar, 0, 16384, stream);
  void* args[] = {&p};
  hipError_t e = hipLaunchCooperativeKernel((void*)mega_kernel, dim3(grid_blocks), dim3(NTHREADS), args, SMEM_BYTES, stream);
  if (e != hipSuccess) fprintf(stderr, "cooperative launch failed: %s (grid %d)\n", hipGetErrorString(e), grid_blocks);
}
```

```cpp
#include <hip/hip_runtime.h>
#include <hip/hip_cooperative_groups.h>
#include <stdint.h>
#include <string.h>
#include <math.h>
#include <stdio.h>

namespace cg = cooperative_groups;

typedef unsigned short bf16_t;
typedef __attribute__((ext_vector_type(8))) short bf16x8;
typedef __attribute__((ext_vector_type(4))) float f32x4;
typedef __attribute__((ext_vector_type(16))) float f32x16;

#define DEVINL __device__ __forceinline__
#define NTHREADS 512
#define NWAVES 8
#define GEMM_LDS 131072
#define SMEM_BYTES (131072 + 16384)
#define RW_N 3840

#define DM 1024
#define TCTX 4096
#define TLAT 8192
#define TT 12288
#define ALPHA_F 1.681792830507429f
#define LN_EPS_F 1e-5f
#define GN_EPS_F 6.4e-4f
#define RMS_EPS_F 1e-6f
#define QSCALE_F (0.125f * 1.4426950408889634f)

#define OUT_Y 0
#define OUT_STATE 12582912
#define OUT_CK 16777216
#define OUT_CV 18874368

struct Params {
  const float* in[35];
  float* out;
  float* mod;
  float* rope;
  bf16_t* rwkv_in_t;
  bf16_t* w2t;
  bf16_t* a2t;
  bf16_t* g2t;
  bf16_t* rwkv_wo_t;
  bf16_t* attn_wqkv_t;
  bf16_t* attn_wo_t;
  bf16_t* wq_t;
  bf16_t* keysb;
  bf16_t* ub;
  bf16_t* vb;
  float* uinv;
  float* vinv;
  bf16_t* Klat;
  bf16_t* VlatT;
  bf16_t* Kctx;
  bf16_t* VctxT;
  float* xbuf;
  float* zbuf;
  bf16_t* hbuf;
  bf16_t* abuf;
  char* U1;
  char* U2;
  char* U3;
  int* pidx;
  float* pgate;
  double freqs[16];
  unsigned* bar;
  int use_cg_sync;
  int pad0;
};

DEVINL int tidx() { int t = threadIdx.x; asm volatile("" : "+v"(t)); return t; }
DEVINL bf16_t f2bf(float f) {
  unsigned u = __float_as_uint(f);
  u += 0x7FFFu + ((u >> 16) & 1u);
  return (bf16_t)(u >> 16);
}
DEVINL float bf2f(bf16_t h) { return __uint_as_float(((unsigned)h) << 16); }
DEVINL unsigned pack2(float a, float b) { return (unsigned)f2bf(a) | ((unsigned)f2bf(b) << 16); }
DEVINL float bflo(unsigned u) { return __uint_as_float(u << 16); }
DEVINL float bfhi(unsigned u) { return __uint_as_float(u & 0xFFFF0000u); }

DEVINL float wave_sum(float v) {
#pragma unroll
  for (int o = 32; o > 0; o >>= 1) v += __shfl_xor(v, o);
  return v;
}
DEVINL float grp16_sum(float v) {
#pragma unroll
  for (int o = 8; o > 0; o >>= 1) v += __shfl_xor(v, o);
  return v;
}
DEVINL unsigned wave_max_u(unsigned v) {
#pragma unroll
  for (int o = 32; o > 0; o >>= 1) { unsigned t = (unsigned)__shfl_xor((int)v, o); v = v > t ? v : t; }
  return v;
}
DEVINL float sigmoidf_(float x) { return 1.0f / (1.0f + __expf(-x)); }
DEVINL float tanhf_(float x) { float e = __expf(-2.0f * fabsf(x)); float t = (1.0f - e) / (1.0f + e); return x < 0 ? -t : t; }
DEVINL unsigned ordf(float f) { unsigned u = __float_as_uint(f); return (u & 0x80000000u) ? ~u : (u | 0x80000000u); }

DEVINL int cond_of_row(int row) { return row < TCTX ? 8 : ((row - TCTX) >> 10); }


namespace pg8 {
#define PG8_LAS __attribute__((address_space(3)))
typedef unsigned u32x4 __attribute__((ext_vector_type(4)));
constexpr int BM = 256, BK = 64, HALF = 128, HTB = HALF * BK * 2, STAGE_BYTES = 8 * HTB, NXCD = 8, WGM = 8;
DEVINL int lds_byte(int r, int c) { const int st = (r >> 4) * 2 + (c >> 5), rr = r & 15, cc = c & 31, ob = rr * 64 + cc * 2; return st * 1024 + (ob ^ (((ob >> 9) & 1) << 5)); }
DEVINL void stage_rc(int b, int& R, int& C) { const int st = b / 1024, sb = b % 1024, swz = sb ^ (((sb >> 9) & 1) << 5); R = (st >> 1) * 16 + swz / 64; C = (st & 1) * 32 + (swz % 64) / 2; }
DEVINL int perm32(int rho) { const int n = rho >> 4, i = rho & 15; return 8 * (i >> 2) + 4 * n + (i & 3); }
struct Unit { int pm, pn; };
struct StaticOrder {
  int nM, nN, nwg, G, c;
  DEVINL void init(int M, int N, int G_, int c_) { nM = M / BM; nN = N / BM; nwg = nM * nN; G = G_; c = c_; }
  DEVINL bool next(int i, Unit& u) const {
    const long L = (long)i * G + c; if (L >= nwg) return false;
    int wgid = (int)L; { const int q = nwg / NXCD, r = nwg % NXCD, xcd = wgid % NXCD, off = wgid / NXCD; wgid = (xcd < r ? xcd * (q + 1) : r * (q + 1) + (xcd - r) * q) + off; }
    const int nig = WGM * nN, gid = wgid / nig, fm = gid * WGM, gsz = (nM - fm) < WGM ? (nM - fm) : WGM;
    u.pm = fm + ((wgid % nig) % gsz); u.pn = (wgid % nig) / gsz; return true;
  }
};
DEVINL unsigned cvt_pk_bf16(float lo, float hi) { unsigned r; asm volatile("v_cvt_pk_bf16_f32 %0, %1, %2" : "=v"(r) : "v"(lo), "v"(hi)); return r; }

template <class Epi, class ASel>
DEVINL void gemm_phase(PG8_LAS unsigned char* lds, const ASel& asel, const bf16_t* Bt, const int K, const StaticOrder& S, const Epi& E) {
  const int tid = tidx(), wid = __builtin_amdgcn_readfirstlane(tid >> 6), lane = tid & 63, wr = wid >> 2, wc = wid & 3, fr = lane & 15, fq = lane >> 4;
  const int nt = K / BK;
  unsigned voffA[2], voffB[2];
#pragma unroll
  for (int i = 0; i < 2; ++i) { int R, C; stage_rc(tid * 16 + i * 8192, R, C); const int Rb = Epi::PERM ? ((R & ~31) + perm32(R & 31)) : R;
    voffA[i] = (unsigned)(R * K + C) * 2u; voffB[i] = (unsigned)(Rb * K + C) * 2u; }
  const size_t kstep = (size_t)(BK * 2);
  const size_t hstep = (size_t)HALF * K * 2;
  const size_t tstep = 2 * hstep;
  const unsigned ldsw = (unsigned)wid * 1024u;
  const int aoff = lds_byte(wr * 64 + fr, fq * 8), boff = lds_byte(wc * 32 + fr, fq * 8);
#define PG8_SA(b, h) (((b) * 2 + (h)) * HTB)
#define PG8_SB(b, h) ((4 + (b) * 2 + (h)) * HTB)
#define PG8_STAGE(bufoff, gbase, voff) do { _Pragma("unroll") for (int _i = 0; _i < 2; ++_i) \
    __builtin_amdgcn_global_load_lds((const unsigned*)((const char*)(gbase) + (voff)[_i]), (PG8_LAS unsigned*)(lds + (bufoff) + ldsw + _i * 8192), 16, 0, 0); } while (0)
#define PG8_LDA(dst, b, h) do { _Pragma("unroll") for (int m = 0; m < 4; ++m) _Pragma("unroll") for (int k = 0; k < 2; ++k) dst[m][k] = *(const PG8_LAS bf16x8*)(lds + PG8_SA(b, h) + aoff + m * 2048 + k * 1024); } while (0)
#define PG8_LDB(dst, b, h) do { _Pragma("unroll") for (int n = 0; n < 2; ++n) _Pragma("unroll") for (int k = 0; k < 2; ++k) dst[n][k] = *(const PG8_LAS bf16x8*)(lds + PG8_SB(b, h) + boff + n * 2048 + k * 1024); } while (0)
#define PG8_MMA(ai, bj, At, Bt_) do { __builtin_amdgcn_s_setprio(1); _Pragma("unroll") for (int m = 0; m < 4; ++m) _Pragma("unroll") for (int n = 0; n < 2; ++n) _Pragma("unroll") for (int k = 0; k < 2; ++k) \
    acc[ai][bj][m][n] = __builtin_amdgcn_mfma_f32_16x16x32_bf16(Bt_[n][k], At[m][k], acc[ai][bj][m][n], 0, 0, 0); __builtin_amdgcn_s_setprio(0); } while (0)
#define PG8_WAIT_V(n) asm volatile("s_waitcnt vmcnt(" #n ")" ::: "memory")
#define PG8_WAIT_L(n) asm volatile("s_waitcnt lgkmcnt(" #n ")" ::: "memory")
#define PG8_BAR __builtin_amdgcn_s_barrier()
#define PG8_SCHED __builtin_amdgcn_sched_barrier(0)
  Unit cur, nxt; int ui = 0;
  if (!S.next(0, cur)) return;
  f32x4 acc[2][2][4][2];
#pragma unroll
  for (int a = 0; a < 2; ++a)
#pragma unroll
    for (int b = 0; b < 2; ++b)
#pragma unroll
      for (int m = 0; m < 4; ++m)
#pragma unroll
        for (int n = 0; n < 2; ++n) acc[a][b][m][n] = (f32x4){0.f, 0.f, 0.f, 0.f};
  bf16x8 At[4][2], B0[2][2], B1[2][2];
  const char* cA = asel(cur.pn) + (size_t)cur.pm * tstep; const char* cB = (const char*)Bt + (size_t)cur.pn * tstep;
  PG8_STAGE(PG8_SB(0, 0), cB, voffB); PG8_STAGE(PG8_SA(0, 0), cA, voffA); PG8_STAGE(PG8_SB(0, 1), cB + hstep, voffB); PG8_STAGE(PG8_SA(0, 1), cA + hstep, voffA);
  if (wr == 1) PG8_BAR;
  PG8_WAIT_V(4); PG8_BAR;
  PG8_STAGE(PG8_SB(1, 0), cB + kstep, voffB); PG8_STAGE(PG8_SA(1, 0), cA + kstep, voffA); PG8_STAGE(PG8_SB(1, 1), cB + hstep + kstep, voffB);
  PG8_WAIT_V(6); PG8_BAR;
  for (;;) {
    const bool has_next = S.next(ui + 1, nxt);
    const char* nA = has_next ? asel(nxt.pn) + (size_t)nxt.pm * tstep : cA; const char* nB = has_next ? (const char*)Bt + (size_t)nxt.pn * tstep : cB;
    for (int t = 0; t < nt; t += 2) {
      const bool last = (t == nt - 2);
      const char* a1 = cA + (size_t)(t + 1) * kstep;
      const char* a2 = last ? nA : cA + (size_t)(t + 2) * kstep; const char* b2 = last ? nB : cB + (size_t)(t + 2) * kstep;
      const char* a3 = a2 + kstep; const char* b3 = b2 + kstep;
      PG8_LDB(B0, 0, 0); PG8_SCHED; PG8_LDA(At, 0, 0); PG8_STAGE(PG8_SA(1, 1), a1 + hstep, voffA);
      PG8_WAIT_L(8); PG8_BAR; PG8_WAIT_L(0); PG8_MMA(0, 0, At, B0); PG8_BAR; PG8_SCHED;
      PG8_LDB(B1, 0, 1); PG8_STAGE(PG8_SB(0, 0), b2, voffB);
      PG8_BAR; PG8_WAIT_L(0); PG8_MMA(0, 1, At, B1); PG8_BAR;
      PG8_LDA(At, 0, 1); PG8_STAGE(PG8_SA(0, 0), a2, voffA);
      PG8_BAR; PG8_WAIT_L(0); PG8_MMA(1, 0, At, B0); PG8_BAR; PG8_SCHED;
      PG8_STAGE(PG8_SB(0, 1), b2 + hstep, voffB);
      PG8_WAIT_V(6); PG8_BAR; PG8_MMA(1, 1, At, B1); PG8_BAR;
      PG8_LDB(B0, 1, 0); PG8_SCHED; PG8_LDA(At, 1, 0); PG8_STAGE(PG8_SA(0, 1), a2 + hstep, voffA);
      PG8_WAIT_L(8); PG8_BAR; PG8_WAIT_L(0); PG8_MMA(0, 0, At, B0); PG8_BAR; PG8_SCHED;
      PG8_LDB(B1, 1, 1); PG8_STAGE(PG8_SB(1, 0), b3, voffB);
      PG8_BAR; PG8_WAIT_L(0); PG8_MMA(0, 1, At, B1); PG8_BAR;
      PG8_LDA(At, 1, 1); PG8_STAGE(PG8_SA(1, 0), a3, voffA);
      PG8_BAR; PG8_WAIT_L(0); PG8_MMA(1, 0, At, B0); PG8_BAR; PG8_SCHED;
      PG8_STAGE(PG8_SB(1, 1), b3 + hstep, voffB);
      PG8_WAIT_V(6); PG8_BAR; PG8_MMA(1, 1, At, B1); PG8_BAR;
    }
    E(acc, cur, wr, wc, fr, fq);
    if (!has_next) break;
#pragma unroll
    for (int a = 0; a < 2; ++a)
#pragma unroll
      for (int b = 0; b < 2; ++b)
#pragma unroll
        for (int m = 0; m < 4; ++m)
#pragma unroll
          for (int n = 0; n < 2; ++n) acc[a][b][m][n] = (f32x4){0.f, 0.f, 0.f, 0.f};
    cur = nxt; cA = nA; cB = nB; ++ui;
  }
  PG8_WAIT_V(0);
  if (wr == 0) PG8_BAR;
  PG8_BAR;
#undef PG8_SA
#undef PG8_SB
#undef PG8_STAGE
#undef PG8_LDA
#undef PG8_LDB
#undef PG8_MMA
#undef PG8_WAIT_V
#undef PG8_WAIT_L
#undef PG8_BAR
#undef PG8_SCHED
}
struct ASelOne { const char* A; DEVINL const char* operator()(int) const { return A; } };
}

DEVINL void gemm_tile_128(const bf16_t* __restrict__ A, int lda, const bf16_t* __restrict__ Bt, int ldb, int K,
                          char* smem_half, f32x4 (&acc)[4][4]) {
  const int tid = tidx() & 255, wid = tid >> 6, lane = tid & 63;
  const int wr = wid >> 1, wc = wid & 1, fr = lane & 15, fq = lane >> 4;
  char* SA = smem_half;
  char* SB = smem_half + 8192;
#pragma unroll
  for (int m = 0; m < 4; ++m)
#pragma unroll
    for (int n = 0; n < 4; ++n) acc[m][n] = (f32x4){0.f, 0.f, 0.f, 0.f};
  for (int k0 = 0; k0 < K; k0 += 32) {
#pragma unroll
    for (int i = 0; i < 2; ++i) {
      int b = tid * 16 + i * 4096;
      int r = b >> 6, c = (b & 63) >> 1;
      __builtin_amdgcn_global_load_lds((const unsigned*)(A + (size_t)r * lda + k0 + c), (unsigned*)(SA + b), 16, 0, 0);
      __builtin_amdgcn_global_load_lds((const unsigned*)(Bt + (size_t)r * ldb + k0 + c), (unsigned*)(SB + b), 16, 0, 0);
    }
    asm volatile("s_waitcnt vmcnt(0)" ::: "memory");
    __syncthreads();
    bf16x8 a[4], b[4];
#pragma unroll
    for (int m = 0; m < 4; ++m) a[m] = *reinterpret_cast<const bf16x8*>(SA + (wr * 64 + m * 16 + fr) * 64 + fq * 16);
#pragma unroll
    for (int n = 0; n < 4; ++n) b[n] = *reinterpret_cast<const bf16x8*>(SB + (wc * 64 + n * 16 + fr) * 64 + fq * 16);
#pragma unroll
    for (int m = 0; m < 4; ++m)
#pragma unroll
      for (int n = 0; n < 4; ++n) acc[m][n] = __builtin_amdgcn_mfma_f32_16x16x32_bf16(a[m], b[n], acc[m][n], 0, 0, 0);
    __syncthreads();
  }
}

#define GEMM_LANE_VARS \
  const int tid = tidx() & 255, wid = tid >> 6, lane = tid & 63; \
  const int wr = wid >> 1, wc = wid & 1, fr = lane & 15, fq = lane >> 4; \
  (void)tid; (void)wid; (void)lane; (void)wr; (void)wc; (void)fr; (void)fq;

DEVINL void get_tjob(const Params& p, int ji, const float*& src, bf16_t*& dst, int& K, int& N) {
  if (ji < 28) {
    int j = ji / 14, s = ji % 14;
    bf16_t* rw = p.rwkv_in_t + (size_t)j * RW_N * 1024;
    if (s < 3) { src = p.in[12] + ((size_t)(j * 3 + s) << 20); dst = rw + ((size_t)s << 20); K = 1024; N = 1024; }
    else if (s < 5) { int z = s - 3; src = p.in[15] + (size_t)(j * 2 + z) * 65536; dst = rw + (size_t)(3072 + z * 64) * 1024; K = 1024; N = 64; }
    else if (s < 7) { int z = s - 5; src = p.in[18] + (size_t)(j * 2 + z) * 65536; dst = rw + (size_t)(3328 + z * 64) * 1024; K = 1024; N = 64; }
    else if (s == 7) { src = p.in[20] + (size_t)j * 131072; dst = rw + (size_t)3584 * 1024; K = 1024; N = 128; }
    else if (s < 10) { int z = s - 8; src = p.in[16] + (size_t)(j * 2 + z) * 65536; dst = p.w2t + (size_t)(j * 2 + z) * 65536; K = 64; N = 1024; }
    else if (s < 12) { int z = s - 10; src = p.in[19] + (size_t)(j * 2 + z) * 65536; dst = p.a2t + (size_t)(j * 2 + z) * 65536; K = 64; N = 1024; }
    else if (s == 12) { src = p.in[21] + (size_t)j * 131072; dst = p.g2t + (size_t)j * 131072; K = 128; N = 1024; }
    else { src = p.in[13] + ((size_t)j << 20); dst = p.rwkv_wo_t + ((size_t)j << 20); K = 1024; N = 1024; }
  } else if (ji < 32) {
    int j = (ji - 28) >> 1, s = (ji - 28) & 1;
    if (s == 0) { src = p.in[27] + (size_t)j * 1024 * 1536; dst = p.attn_wqkv_t + (size_t)j * 1536 * 1024; K = 1024; N = 1536; }
    else { src = p.in[28] + ((size_t)j << 20); dst = p.attn_wo_t + ((size_t)j << 20); K = 1024; N = 1024; }
  } else {
    int i = ji - 32;
    src = p.in[31] + (size_t)i * 1024 * 2048; dst = p.wq_t + (size_t)i * 2048 * 1024; K = 1024; N = 2048;
  }
}

DEVINL void sincos_d(double x, float& c, float& s) {
  const double TWO_PI = 6.283185307179586476925;
  double r = x - TWO_PI * rint(x / TWO_PI);
  double r2 = r * r;
  double ts = r, tc = 1.0, ss = r, cs = 1.0;
#pragma unroll 1
  for (int n = 1; n <= 14; ++n) {
    tc = -tc * r2 / (double)((2 * n - 1) * (2 * n));
    ts = -ts * r2 / (double)((2 * n) * (2 * n + 1));
    cs += tc; ss += ts;
  }
  c = (float)cs; s = (float)ss;
}

DEVINL void phase_prep(const Params& p, int w, int nw, char* smem) {
  const int tid = tidx();
  {
    float (*tile)[65] = reinterpret_cast<float (*)[65]>(smem);
    int toff = 0;
    for (int ji = 0; ji < 36; ++ji) {
      const float* src; bf16_t* dst; int K, N;
      get_tjob(p, ji, src, dst, K, N);
      const int tn = N >> 6, nt = (K >> 6) * tn;
      int t0 = (w - (toff % nw) + nw) % nw;
      for (int t = t0; t < nt; t += nw) {
        const int k0 = (t / tn) << 6, n0 = (t % tn) << 6;
#pragma unroll
        for (int i = 0; i < 2; ++i) {
          int r = (tid >> 4) + 32 * i, c = (tid & 15) * 4;
          float4 v = *reinterpret_cast<const float4*>(src + (size_t)(k0 + r) * N + n0 + c);
          tile[r][c] = v.x; tile[r][c + 1] = v.y; tile[r][c + 2] = v.z; tile[r][c + 3] = v.w;
        }
        __syncthreads();
        {
          int q = tid;
          int n = q >> 3, kc = (q & 7) * 8;
          uint4 o;
          o.x = pack2(tile[kc + 0][n], tile[kc + 1][n]);
          o.y = pack2(tile[kc + 2][n], tile[kc + 3][n]);
          o.z = pack2(tile[kc + 4][n], tile[kc + 5][n]);
          o.w = pack2(tile[kc + 6][n], tile[kc + 7][n]);
          *reinterpret_cast<uint4*>(dst + (size_t)(n0 + n) * K + k0 + kc) = o;
        }
        __syncthreads();
      }
      toff += nt;
    }
  }
  const size_t gtid = (size_t)w * NTHREADS + tid, gn = (size_t)nw * NTHREADS;
  {
    const int lane = tid & 63;
    const int gw2 = w * NWAVES + (tid >> 6), ngw2 = nw * NWAVES;
    unsigned char* u8 = reinterpret_cast<unsigned char*>(p.ub);
    unsigned char* v8 = reinterpret_cast<unsigned char*>(p.vb);
    for (int r = gw2; r < 2 * 65536; r += ngw2) {
      const bool isv = r >= 65536;
      const int row = isv ? r - 65536 : r;
      const float* srow = (isv ? p.in[34] : p.in[33]) + (size_t)row * 1024 + lane * 16;
      float x[16];
#pragma unroll
      for (int q = 0; q < 4; ++q) { const float4 v = reinterpret_cast<const float4*>(srow)[q]; x[q * 4] = v.x; x[q * 4 + 1] = v.y; x[q * 4 + 2] = v.z; x[q * 4 + 3] = v.w; }
      float mx = 0.f;
#pragma unroll
      for (int q = 0; q < 16; ++q) mx = fmaxf(mx, fabsf(x[q]));
#pragma unroll
      for (int o = 32; o > 0; o >>= 1) mx = fmaxf(mx, __shfl_xor(mx, o));
      mx = fmaxf(mx, 1e-30f);
      const float sc = 440.0f / mx;
      uint4 o4;
      unsigned* ow = reinterpret_cast<unsigned*>(&o4);
#pragma unroll
      for (int q = 0; q < 4; ++q) {
        int pk = 0;
        pk = __builtin_amdgcn_cvt_pk_fp8_f32(x[q * 4] * sc, x[q * 4 + 1] * sc, pk, false);
        pk = __builtin_amdgcn_cvt_pk_fp8_f32(x[q * 4 + 2] * sc, x[q * 4 + 3] * sc, pk, true);
        ow[q] = (unsigned)pk;
      }
      *reinterpret_cast<uint4*>((isv ? v8 : u8) + (size_t)row * 1024 + lane * 16) = o4;
      if (lane == 0) (isv ? p.vinv : p.uinv)[row] = mx * (1.0f / 440.0f);
    }
    const size_t gtid0 = (size_t)w * NTHREADS + tid, gn0 = (size_t)nw * NTHREADS;
    const size_t nk8 = (size_t)4 * 2 * 128 * 128 / 8;
    for (size_t i = gtid0; i < nk8; i += gn0) {
      const float4* su = reinterpret_cast<const float4*>(p.in[32]) + i * 2;
      float4 a = su[0], b = su[1];
      uint4 o; o.x = pack2(a.x, a.y); o.y = pack2(a.z, a.w); o.z = pack2(b.x, b.y); o.w = pack2(b.z, b.w);
      reinterpret_cast<uint4*>(p.keysb)[i] = o;
    }
  }
  {
    const size_t nk = (size_t)8 * 2 * 512 * 4 * 64;
    for (size_t i = gtid; i < nk; i += gn) {
      int d = i & 63, kvh = (i >> 6) & 3, s = (i >> 8) & 511, j = (i >> 17) & 1, b = (int)(i >> 18);
      p.Klat[((size_t)((j * 8 + b) * 4 + kvh) * 1536 + s) * 64 + d] = f2bf(p.in[4][i]);
      p.VlatT[((size_t)((j * 8 + b) * 4 + kvh) * 64 + d) * 1536 + s] = f2bf(p.in[5][i]);
    }
  }
  for (size_t i = gtid; i < 1024; i += gn) {
    int pos = (int)(i >> 4), f = (int)(i & 15);
    float c, s; sincos_d((double)pos * p.freqs[f], c, s);
    p.rope[i * 2] = c; p.rope[i * 2 + 1] = s;
  }
  {
    const size_t n4 = (size_t)TT * DM / 4, nc4 = (size_t)TCTX * DM / 4;
    for (size_t i = gtid; i < n4; i += gn) {
      float4 v = (i < nc4) ? reinterpret_cast<const float4*>(p.in[0])[i] : reinterpret_cast<const float4*>(p.in[1])[i - nc4];
      reinterpret_cast<float4*>(p.xbuf)[i] = v;
    }
  }
  {
    float* sc = reinterpret_cast<float*>(smem);
    float* red = sc + 9 * 1024;
    bool loaded = false;
    for (int item = w; item < 384; item += nw) {
      if (!loaded) {
        __syncthreads();
        for (int e = tid; e < 9 * 1024; e += NTHREADS) {
          int c = e >> 10, d = e & 1023;
          float v = (c < 8) ? p.in[2][c * 1024 + d] : p.in[6][d];
          sc[e] = v / (1.0f + __expf(-v));
        }
        __syncthreads();
        loaded = true;
      }
      const int i = item / 96, cc = item % 96;
      const int col = cc * 64 + (tid & 63), ks = tid >> 6;
      float acc[9];
#pragma unroll
      for (int c = 0; c < 9; ++c) acc[c] = 0.f;
      const float* wp = p.in[7] + (size_t)i * 1024 * 6144 + col;
      for (int d0 = ks * 128; d0 < ks * 128 + 128; d0 += 16) {
        float wv[16];
#pragma unroll
        for (int u = 0; u < 16; ++u) wv[u] = wp[(size_t)(d0 + u) * 6144];
#pragma unroll
        for (int u = 0; u < 16; ++u)
#pragma unroll
          for (int c = 0; c < 9; ++c) acc[c] += sc[c * 1024 + d0 + u] * wv[u];
      }
#pragma unroll
      for (int c = 0; c < 9; ++c) red[(ks * 9 + c) * 64 + (tid & 63)] = acc[c];
      __syncthreads();
      for (int o = tid; o < 576; o += NTHREADS) {
        int c = o >> 6, cl = o & 63;
        float s = 0.f;
#pragma unroll
        for (int k2 = 0; k2 < 8; ++k2) s += red[(k2 * 9 + c) * 64 + cl];
        int n = cc * 64 + cl;
        p.mod[((size_t)i * 9 + c) * 6144 + n] = s + p.in[8][i * 6144 + n];
      }
      __syncthreads();
    }
  }
}

DEVINL void phase_r1(const Params& p, int layer, int w, int nw) {
  const int j = layer >> 1;
  const int lane = tidx() & 63;
  const int gw = w * NWAVES + (tidx() >> 6), ngw = nw * NWAVES;
  bf16_t* A6 = reinterpret_cast<bf16_t*>(p.U1);
  const float* mu = p.in[11] + (size_t)j * 6 * 1024;
  for (int row = gw; row < TT; row += ngw) {
    int t, Tlen;
    if (row < TCTX) { t = row & 255; Tlen = 256; } else { t = (row - TCTX) & 1023; Tlen = 1024; }
    const int cond = cond_of_row(row);
    const float* sh = p.mod + ((size_t)layer * 9 + cond) * 6144;
    const float* sc = sh + 1024;
    const bool hasp = t > 0, hasn = t < Tlen - 1;
#pragma unroll
    for (int k = 0; k < 4; ++k) {
      const int col = k * 256 + lane * 4;
      const float4 xc = *reinterpret_cast<const float4*>(p.xbuf + (size_t)row * DM + col);
      float4 xp = make_float4(0, 0, 0, 0), xn = make_float4(0, 0, 0, 0);
      if (hasp) xp = *reinterpret_cast<const float4*>(p.xbuf + (size_t)(row - 1) * DM + col);
      if (hasn) xn = *reinterpret_cast<const float4*>(p.xbuf + (size_t)(row + 1) * DM + col);
      const float4 s4 = *reinterpret_cast<const float4*>(sh + col);
      const float4 c4 = *reinterpret_cast<const float4*>(sc + col);
      float h[4], xx[4];
      const float xcv[4] = {xc.x, xc.y, xc.z, xc.w}, xpv[4] = {xp.x, xp.y, xp.z, xp.w}, xnv[4] = {xn.x, xn.y, xn.z, xn.w};
      const float shv[4] = {s4.x, s4.y, s4.z, s4.w}, scv[4] = {c4.x, c4.y, c4.z, c4.w};
#pragma unroll
      for (int e = 0; e < 4; ++e) {
        float g = 1.0f + scv[e];
        h[e] = xcv[e] * g + shv[e];
        float hp = hasp ? (xpv[e] * g + shv[e]) : 0.f;
        float hn = hasn ? (xnv[e] * g + shv[e]) : 0.f;
        xx[e] = 0.5f * (hp + hn) - h[e];
      }
#pragma unroll
      for (int m = 0; m < 6; ++m) {
        const float4 m4 = *reinterpret_cast<const float4*>(mu + m * 1024 + col);
        uint2 o;
        o.x = pack2(h[0] + xx[0] * m4.x, h[1] + xx[1] * m4.y);
        o.y = pack2(h[2] + xx[2] * m4.z, h[3] + xx[3] * m4.w);
        *reinterpret_cast<uint2*>(A6 + ((size_t)m * TT + row) * DM + col) = o;
      }
    }
  }
}

#define U1_AA_OFF ((size_t)2 * TT * DM * 4)
#define U1_GG_OFF (U1_AA_OFF + (size_t)2 * TT * DM * 2)

struct ASelR2 {
  const char* A6;
  DEVINL const char* operator()(int pn) const {
    const int idx = pn < 12 ? (pn >> 2) : (pn - 9);
    const int m = (0x541320 >> (4 * idx)) & 7;
    return A6 + (size_t)m * TT * DM * 2;
  }
};
struct EpiR2 {
  static constexpr bool PERM = true;
  bf16_t *rb, *lw;
  DEVINL void operator()(const f32x4 (&acc)[2][2][4][2], const pg8::Unit& u, int wr, int wc, int fr, int fq) const {
    const int row0 = u.pm * 256 + wr * 64 + fr;
    const int pn = u.pn;
    if (pn < 12) {
      bf16_t* dst = rb + (size_t)(pn >> 2) * TT * DM;
      const int col0 = (pn & 3) * 256 + wc * 32 + 8 * fq;
#pragma unroll
      for (int ai = 0; ai < 2; ++ai)
#pragma unroll
        for (int m = 0; m < 4; ++m) {
          bf16_t* rowp = dst + (size_t)(row0 + ai * 128 + m * 16) * DM + col0;
#pragma unroll
          for (int bj = 0; bj < 2; ++bj) {
            const f32x4 v0 = acc[ai][bj][m][0], v1 = acc[ai][bj][m][1];
            pg8::u32x4 o; o.x = pg8::cvt_pk_bf16(v0[0], v0[1]); o.y = pg8::cvt_pk_bf16(v0[2], v0[3]); o.z = pg8::cvt_pk_bf16(v1[0], v1[1]); o.w = pg8::cvt_pk_bf16(v1[2], v1[3]);
            *reinterpret_cast<pg8::u32x4*>(rowp + bj * 128) = o;
          }
        }
    } else {
      bf16_t* dst = lw + (size_t)(pn - 12) * TT * 128;
      const int col0 = wc * 32 + 8 * fq;
      const float kx = (pn == 12 ? 2.0f : 1.0f) * 1.4426950408889634f, ka = pn == 12 ? 2.0f : 1.0f, kb = pn == 12 ? -1.0f : 0.0f;
#pragma unroll
      for (int ai = 0; ai < 2; ++ai)
#pragma unroll
        for (int m = 0; m < 4; ++m) {
          f32x4 v0 = acc[ai][0][m][0], v1 = acc[ai][0][m][1];
          if (pn != 13) {
#pragma unroll
            for (int e = 0; e < 4; ++e) {
              const float s0 = __builtin_amdgcn_rcpf(1.0f + __builtin_amdgcn_exp2f(-kx * v0[e]));
              const float s1 = __builtin_amdgcn_rcpf(1.0f + __builtin_amdgcn_exp2f(-kx * v1[e]));
              v0[e] = ka * s0 + kb; v1[e] = ka * s1 + kb;
            }
          }
          asm volatile("" ::: "memory");
          pg8::u32x4 o; o.x = pg8::cvt_pk_bf16(v0[0], v0[1]); o.y = pg8::cvt_pk_bf16(v0[2], v0[3]); o.z = pg8::cvt_pk_bf16(v1[0], v1[1]); o.w = pg8::cvt_pk_bf16(v1[2], v1[3]);
          *reinterpret_cast<pg8::u32x4*>(dst + (size_t)(row0 + ai * 128 + m * 16) * 128 + col0) = o;
        }
    }
  }
};
DEVINL void phase_r2(const Params& p, int layer, int w, int nw, char* smem) {
  const int j = layer >> 1;
  bf16_t* rb = reinterpret_cast<bf16_t*>(p.U2);
  EpiR2 E;
  E.rb = rb; E.lw = p.abuf;
  ASelR2 as; as.A6 = p.U1;
  pg8::StaticOrder S; S.init(TT, RW_N, nw, w);
  pg8::gemm_phase<EpiR2, ASelR2>((PG8_LAS unsigned char*)smem, as, p.rwkv_in_t + (size_t)j * RW_N * 1024, 1024, S, E);
}

DEVINL void phase_r3(const Params& p, int layer, int w, int nw, char* smem) {
  const int j = layer >> 1;
  GEMM_LANE_VARS
  const int half = tidx() >> 8;
  char* sh = smem + half * 16384;
  const bf16_t* lw = p.abuf;
  const bf16_t* la = lw + (size_t)TT * 128;
  const bf16_t* lg = la + (size_t)TT * 128;
  float* wdec = reinterpret_cast<float*>(p.U1);
  bf16_t* aa = reinterpret_cast<bf16_t*>(p.U1 + U1_AA_OFF);
  bf16_t* gg = reinterpret_cast<bf16_t*>(p.U1 + U1_GG_OFF);
  const int NTILES = 96 * 40;
  for (int it = 0; it * nw * 2 < NTILES; ++it) {
    int tile = (it * nw + w) * 2 + half;
    const bool valid = tile < NTILES;
    if (!valid) tile = 0;
    const int ct = tile / 96, rt = tile % 96;
    const int job = ct >> 3, nt = ct & 7;
    const int row0 = rt * 128, col0 = nt * 128;
    f32x4 acc[4][4];
    if (job < 2) {
      const int z = job;
      gemm_tile_128(lw + (size_t)row0 * 128 + z * 64, 128, p.w2t + (size_t)(j * 2 + z) * 65536 + (size_t)col0 * 64, 64, 64, sh, acc);
      if (valid) {
        const float* w0 = p.in[14] + (size_t)(j * 2 + z) * 1024;
#pragma unroll
        for (int m = 0; m < 4; ++m)
#pragma unroll
          for (int n = 0; n < 4; ++n)
#pragma unroll
            for (int jj = 0; jj < 4; ++jj) {
              int row = row0 + wr * 64 + m * 16 + fq * 4 + jj, col = col0 + wc * 64 + n * 16 + fr;
              float wl = acc[m][n][jj] + w0[col];
              wdec[((size_t)z * TT + row) * DM + col] = __expf(-0.6065306597126334f * sigmoidf_(wl));
            }
      }
    } else if (job < 4) {
      const int z = job - 2;
      gemm_tile_128(la + (size_t)row0 * 128 + z * 64, 128, p.a2t + (size_t)(j * 2 + z) * 65536 + (size_t)col0 * 64, 64, 64, sh, acc);
      if (valid) {
        const float* a0 = p.in[17] + (size_t)(j * 2 + z) * 1024;
#pragma unroll
        for (int m = 0; m < 4; ++m)
#pragma unroll
          for (int n = 0; n < 4; ++n)
#pragma unroll
            for (int jj = 0; jj < 4; ++jj) {
              int row = row0 + wr * 64 + m * 16 + fq * 4 + jj, col = col0 + wc * 64 + n * 16 + fr;
              aa[((size_t)z * TT + row) * DM + col] = f2bf(sigmoidf_(acc[m][n][jj] + a0[col]));
            }
      }
    } else {
      gemm_tile_128(lg + (size_t)row0 * 128, 128, p.g2t + (size_t)j * 131072 + (size_t)col0 * 128, 128, 128, sh, acc);
      if (valid) {
#pragma unroll
        for (int m = 0; m < 4; ++m)
#pragma unroll
          for (int n = 0; n < 4; ++n)
#pragma unroll
            for (int jj = 0; jj < 4; ++jj) {
              int row = row0 + wr * 64 + m * 16 + fq * 4 + jj, col = col0 + wc * 64 + n * 16 + fr;
              gg[(size_t)row * DM + col] = f2bf(acc[m][n][jj]);
            }
      }
    }
  }
  {
    const int l64 = tidx() & 63;
    const int gw = w * NWAVES + (tidx() >> 6), ngw = nw * NWAVES;
    const bf16_t* kb = reinterpret_cast<const bf16_t*>(p.U2) + (size_t)TT * DM;
    bf16_t* kkb = reinterpret_cast<bf16_t*>(p.U2) + (size_t)3 * TT * DM;
    const float* k_k = p.in[22] + j * 1024;
    for (int row = gw; row < TT; row += ngw) {
#pragma unroll
      for (int k = 0; k < 4; ++k) {
        const int col = k * 256 + l64 * 4;
        const uint2 k2 = *reinterpret_cast<const uint2*>(kb + (size_t)row * DM + col);
        const float4 kk4 = *reinterpret_cast<const float4*>(k_k + col);
        float v0 = bflo(k2.x) * kk4.x, v1 = bfhi(k2.x) * kk4.y, v2 = bflo(k2.y) * kk4.z, v3 = bfhi(k2.y) * kk4.w;
        float ss = grp16_sum(v0 * v0 + v1 * v1 + v2 * v2 + v3 * v3);
        float inv = 1.0f / fmaxf(sqrtf(ss), 1e-12f);
        uint2 o; o.x = pack2(v0 * inv, v1 * inv); o.y = pack2(v2 * inv, v3 * inv);
        *reinterpret_cast<uint2*>(kkb + (size_t)row * DM + col) = o;
      }
    }
  }
}

typedef __attribute__((ext_vector_type(4))) short bf16x4;
#define R4_WAVE_LDS 21504
DEVINL unsigned short bfbits(float f) { return f2bf(f); }
DEVINL bf16x4 pack4(float a, float b, float c, float d) {
  union { bf16x4 v; unsigned u[2]; } r; r.u[0] = pack2(a, b); r.u[1] = pack2(c, d); return r.v;
}
DEVINL void phase_r4(const Params& p, int layer, int w, int nw, char* smem) {
  const int j = layer >> 1;
  const int lane = tidx() & 63, wid = __builtin_amdgcn_readfirstlane(tidx() >> 6);
  const int fr = lane & 15, fq = lane >> 4;
  if (wid >= 3) return;
  const bf16_t* rb = reinterpret_cast<const bf16_t*>(p.U2);
  const bf16_t* kb = rb + (size_t)TT * DM;
  const bf16_t* vb = kb + (size_t)TT * DM;
  const bf16_t* kkb = vb + (size_t)TT * DM;
  const float* wdec = reinterpret_cast<const float*>(p.U1);
  const bf16_t* aa = reinterpret_cast<const bf16_t*>(p.U1 + U1_AA_OFF);
  float* yout = reinterpret_cast<float*>(p.U3);
  char* wl = smem + wid * R4_WAVE_LDS;
  bf16_t* khR = reinterpret_cast<bf16_t*>(wl);
  bf16_t* ahR = khR + 1024;
  bf16_t* qhR = ahR + 1024;
  bf16_t* rhR = qhR + 1024;
  bf16_t* qhT = rhR + 1024;
  bf16_t* AtT = qhT + 1024;
  bf16_t* KtT = AtT + 1024;
  bf16_t* vT = KtT + 1024;
  float* NfT = reinterpret_cast<float*>(vT + 1024);
  float* WCf = NfT + 256;
  bf16_t* TTl = reinterpret_cast<bf16_t*>(WCf + 64);
  bf16_t* AkqR = TTl + 256;
  bf16_t* GR = AkqR + 256;
  bf16_t* QpR = khR;
  {
    const int c = w + nw * wid;
    if (c >= 768) return;
    int seq, h, z;
    if (c < 256) { seq = 16 + (c >> 5); h = (c >> 1) & 15; z = c & 1; }
    else { int cc = c - 256; seq = cc >> 5; h = (cc >> 1) & 15; z = cc & 1; }
    const int Tlen = seq < 16 ? 256 : 1024;
    const int base = seq < 16 ? seq * 256 : TCTX + (seq - 16) * 1024;
    const int colb = h * 64;
    const float kal = p.in[23][j * 1024 + colb + lane];
    f32x4 ST[4][4];
    if (seq >= 16) {
      const float* s0 = p.in[3] + ((((size_t)(seq - 16) * 2 + j) * 2 + z) * 16 + h) * 4096;
#pragma unroll
      for (int b = 0; b < 4; ++b)
#pragma unroll
        for (int nb = 0; nb < 4; ++nb) ST[b][nb] = *reinterpret_cast<const f32x4*>(s0 + (size_t)(16 * nb + fr) * 64 + 16 * b + 4 * fq);
    } else {
#pragma unroll
      for (int b = 0; b < 4; ++b)
#pragma unroll
        for (int nb = 0; nb < 4; ++nb) ST[b][nb] = (f32x4){0.f, 0.f, 0.f, 0.f};
    }
#pragma unroll 1
    for (int t0 = 0; t0 < Tlen; t0 += 16) {
      __builtin_amdgcn_wave_barrier();
      {
        float wx[16];
#pragma unroll
        for (int t = 0; t < 16; ++t) {
          const int row = base + (z == 0 ? (t0 + t) : (Tlen - 1 - (t0 + t)));
          wx[t] = wdec[((size_t)z * TT + row) * DM + colb + lane];
        }
        float WCl = 1.0f;
#pragma unroll
        for (int t = 0; t < 16; ++t) WCl *= wx[t];
        WCf[lane] = WCl;
        float Wc = 1.0f;
#pragma unroll
        for (int tp = 0; tp < 8; ++tp) {
          float at2[2], kt2[2], qh2[2];
          unsigned vb2[2];
#pragma unroll
          for (int u = 0; u < 2; ++u) {
            const int t = tp * 2 + u;
            const int row = base + (z == 0 ? (t0 + t) : (Tlen - 1 - (t0 + t)));
            const size_t o = (size_t)row * DM + colb + lane;
            const float rr = bf2f(rb[o]), kx = bf2f(kb[o]), kkx = bf2f(kkb[o]);
            const float ax = bf2f(aa[(size_t)z * TT * DM + o]);
            vb2[u] = vb[o];
            const float kd = kx * (1.0f + (ax - 1.0f) * kal);
            const float kka = kkx * ax;
            const float qh = Wc * kkx;
            Wc *= wx[t];
            const float rh = Wc * rr;
            const float iw = 1.0f / Wc;
            const float kh = kd * iw, ah = kka * iw;
            khR[t * 64 + lane] = f2bf(kh); ahR[t * 64 + lane] = f2bf(ah);
            qhR[t * 64 + lane] = f2bf(qh); rhR[t * 64 + lane] = f2bf(rh);
            at2[u] = ah * WCl; kt2[u] = kh * WCl; qh2[u] = qh;
          }
          *reinterpret_cast<unsigned*>(AtT + lane * 16 + tp * 2) = pack2(at2[0], at2[1]);
          *reinterpret_cast<unsigned*>(KtT + lane * 16 + tp * 2) = pack2(kt2[0], kt2[1]);
          *reinterpret_cast<unsigned*>(qhT + lane * 16 + tp * 2) = pack2(qh2[0], qh2[1]);
          *reinterpret_cast<unsigned*>(vT + lane * 16 + tp * 2) = vb2[0] | (vb2[1] << 16);
          if ((tp & 1) == 1) asm volatile("" ::: "memory");
        }
      }
      __builtin_amdgcn_wave_barrier();
      f32x4 Akq = {0.f, 0.f, 0.f, 0.f}, Aaq = Akq, Akr = Akq, Aar = Akq;
      {
#pragma unroll
        for (int ks = 0; ks < 2; ++ks) {
          const bf16x8 khA = *reinterpret_cast<const bf16x8*>(khR + fr * 64 + ks * 32 + fq * 8);
          const bf16x8 ahA = *reinterpret_cast<const bf16x8*>(ahR + fr * 64 + ks * 32 + fq * 8);
          const bf16x8 qhB = *reinterpret_cast<const bf16x8*>(qhR + fr * 64 + ks * 32 + fq * 8);
          const bf16x8 rhB = *reinterpret_cast<const bf16x8*>(rhR + fr * 64 + ks * 32 + fq * 8);
          Akq = __builtin_amdgcn_mfma_f32_16x16x32_bf16(khA, qhB, Akq, 0, 0, 0);
          Aaq = __builtin_amdgcn_mfma_f32_16x16x32_bf16(ahA, qhB, Aaq, 0, 0, 0);
          Akr = __builtin_amdgcn_mfma_f32_16x16x32_bf16(khA, rhB, Akr, 0, 0, 0);
          Aar = __builtin_amdgcn_mfma_f32_16x16x32_bf16(ahA, rhB, Aar, 0, 0, 0);
        }
#pragma unroll
        for (int e = 0; e < 4; ++e) {
          const int s = 4 * fq + e;
          if (!(s < fr)) { Akq[e] = 0.f; Aaq[e] = 0.f; }
          if (!(s <= fr)) { Akr[e] = 0.f; Aar[e] = 0.f; }
        }
      }
      __builtin_amdgcn_wave_barrier();
      *reinterpret_cast<f32x4*>(NfT + fr * 16 + 4 * fq) = Aaq;
#pragma unroll
      for (int e = 0; e < 4; ++e) AkqR[(4 * fq + e) * 16 + fr] = f2bf(Akq[e]);
      __builtin_amdgcn_wave_barrier();
      {
        float Tr[16];
#pragma unroll
        for (int t = 0; t < 16; ++t) {
          float acc = (fr == t) ? 1.0f : 0.0f;
#pragma unroll
          for (int x = 0; x < t; ++x) acc -= Tr[x] * NfT[t * 16 + x];
          Tr[t] = acc;
        }
        if (fq == 0) {
#pragma unroll
          for (int t = 0; t < 16; ++t) TTl[t * 16 + fr] = f2bf(Tr[t]);
        }
      }
      __builtin_amdgcn_wave_barrier();
      const bf16x4 Tb = *reinterpret_cast<const bf16x4*>(TTl + fr * 16 + fq * 4);
      f32x4 G;
      {
        const bf16x4 AkqA = *reinterpret_cast<const bf16x4*>(AkqR + fr * 16 + fq * 4);
        G = __builtin_amdgcn_mfma_f32_16x16x16bf16_1k(AkqA, Tb, (f32x4){0.f, 0.f, 0.f, 0.f}, 0, 0, 0);
#pragma unroll
        for (int b = 0; b < 4; ++b) {
          const bf16x4 qa = *reinterpret_cast<const bf16x4*>(qhT + (16 * b + fr) * 16 + fq * 4);
          const f32x4 qp = __builtin_amdgcn_mfma_f32_16x16x16bf16_1k(qa, Tb, (f32x4){0.f, 0.f, 0.f, 0.f}, 0, 0, 0);
          *reinterpret_cast<bf16x4*>(QpR + fr * 64 + 16 * b + 4 * fq) = pack4(qp[0], qp[1], qp[2], qp[3]);
        }
#pragma unroll
        for (int e = 0; e < 4; ++e) GR[(4 * fq + e) * 16 + fr] = f2bf(G[e]);
      }
      __builtin_amdgcn_wave_barrier();
      f32x4 H, Zb[4];
      {
        const bf16x4 GA = *reinterpret_cast<const bf16x4*>(GR + fr * 16 + fq * 4);
        const bf16x4 AarB = pack4(Aar[0], Aar[1], Aar[2], Aar[3]);
        const f32x4 hm = __builtin_amdgcn_mfma_f32_16x16x16bf16_1k(GA, AarB, (f32x4){0.f, 0.f, 0.f, 0.f}, 0, 0, 0);
        H = Akr - hm;
#pragma unroll
        for (int b = 0; b < 4; ++b) {
          const bf16x4 AtB = *reinterpret_cast<const bf16x4*>(AtT + (16 * b + fr) * 16 + fq * 4);
          const f32x4 zm = __builtin_amdgcn_mfma_f32_16x16x16bf16_1k(GA, AtB, (f32x4){0.f, 0.f, 0.f, 0.f}, 0, 0, 0);
          const bf16x4 ktv = *reinterpret_cast<const bf16x4*>(KtT + (16 * b + fr) * 16 + fq * 4);
          union { bf16x4 v; unsigned short s[4]; } ku; ku.v = ktv;
          Zb[b][0] = bf2f(ku.s[0]) - zm[0]; Zb[b][1] = bf2f(ku.s[1]) - zm[1]; Zb[b][2] = bf2f(ku.s[2]) - zm[2]; Zb[b][3] = bf2f(ku.s[3]) - zm[3];
        }
      }
      bf16x8 QpA[2], rhA[2], AY, AS[4];
      {
#pragma unroll
        for (int ks = 0; ks < 2; ++ks) {
          union { bf16x8 v; bf16x4 h[2]; } u1, u2;
          u1.h[0] = *reinterpret_cast<const bf16x4*>(QpR + fr * 64 + 32 * ks + 4 * fq);
          u1.h[1] = *reinterpret_cast<const bf16x4*>(QpR + fr * 64 + 32 * ks + 16 + 4 * fq);
          u2.h[0] = *reinterpret_cast<const bf16x4*>(rhR + fr * 64 + 32 * ks + 4 * fq);
          u2.h[1] = *reinterpret_cast<const bf16x4*>(rhR + fr * 64 + 32 * ks + 16 + 4 * fq);
          QpA[ks] = u1.v; rhA[ks] = u2.v;
        }
        {
          union { bf16x8 v; bf16x4 h[2]; } u;
          u.h[0] = pack4(Aar[0], Aar[1], Aar[2], Aar[3]); u.h[1] = pack4(H[0], H[1], H[2], H[3]);
          AY = u.v;
        }
#pragma unroll
        for (int b = 0; b < 4; ++b) {
          union { bf16x8 v; bf16x4 h[2]; } u;
          u.h[0] = *reinterpret_cast<const bf16x4*>(AtT + (16 * b + fr) * 16 + fq * 4);
          u.h[1] = pack4(Zb[b][0], Zb[b][1], Zb[b][2], Zb[b][3]);
          AS[b] = u.v;
        }
      }
#pragma unroll
      for (int nb = 0; nb < 4; ++nb) {
        bf16x8 Bhi[2], Blo[2];
#pragma unroll
        for (int ks = 0; ks < 2; ++ks) {
          union { bf16x8 v; unsigned u[4]; } hi, lo;
          float a[8];
#pragma unroll
          for (int e = 0; e < 4; ++e) { a[e] = ST[2 * ks][nb][e]; a[4 + e] = ST[2 * ks + 1][nb][e]; }
          float rsd[8];
#pragma unroll
          for (int e = 0; e < 8; ++e) { const float hf = bf2f(f2bf(a[e])); rsd[e] = a[e] - hf; }
#pragma unroll
          for (int e = 0; e < 4; ++e) { hi.u[e] = pack2(a[2 * e], a[2 * e + 1]); lo.u[e] = pack2(rsd[2 * e], rsd[2 * e + 1]); }
          Bhi[ks] = hi.v; Blo[ks] = lo.v;
        }
        f32x4 P = {0.f, 0.f, 0.f, 0.f}, R = {0.f, 0.f, 0.f, 0.f};
        P = __builtin_amdgcn_mfma_f32_16x16x32_bf16(QpA[0], Bhi[0], P, 0, 0, 0);
        P = __builtin_amdgcn_mfma_f32_16x16x32_bf16(QpA[1], Bhi[1], P, 0, 0, 0);
        P = __builtin_amdgcn_mfma_f32_16x16x32_bf16(QpA[0], Blo[0], P, 0, 0, 0);
        P = __builtin_amdgcn_mfma_f32_16x16x32_bf16(QpA[1], Blo[1], P, 0, 0, 0);
        R = __builtin_amdgcn_mfma_f32_16x16x32_bf16(rhA[0], Bhi[0], R, 0, 0, 0);
        R = __builtin_amdgcn_mfma_f32_16x16x32_bf16(rhA[1], Bhi[1], R, 0, 0, 0);
        bf16x8 X;
        {
          union { bf16x8 v; bf16x4 h[2]; } u;
          u.h[0] = pack4(-P[0], -P[1], -P[2], -P[3]);
          u.h[1] = *reinterpret_cast<const bf16x4*>(vT + (16 * nb + fr) * 16 + fq * 4);
          X = u.v;
        }
        const f32x4 Y = __builtin_amdgcn_mfma_f32_16x16x32_bf16(AY, X, R, 0, 0, 0);
#pragma unroll
        for (int e = 0; e < 4; ++e) {
          const int t = t0 + 4 * fq + e;
          const int row = base + (z == 0 ? t : (Tlen - 1 - t));
          yout[((size_t)z * TT + row) * DM + colb + 16 * nb + fr] = Y[e];
        }
#pragma unroll
        for (int b = 0; b < 4; ++b) {
          const f32x4 wcv = *reinterpret_cast<const f32x4*>(WCf + 16 * b + 4 * fq);
          ST[b][nb] = __builtin_amdgcn_mfma_f32_16x16x32_bf16(AS[b], X, ST[b][nb] * wcv, 0, 0, 0);
        }
        __builtin_amdgcn_sched_barrier(0);
      }
    }
    if (seq < 16) {
      const int l2 = tidx() & 63, fr2 = l2 & 15, fq2 = l2 >> 4;
      float* so = p.out + OUT_STATE + ((((size_t)seq * 2 + j) * 2 + z) * 16 + h) * 4096;
#pragma unroll
      for (int b = 0; b < 4; ++b)
#pragma unroll
        for (int nb = 0; nb < 4; ++nb) *reinterpret_cast<f32x4*>(so + (size_t)(16 * nb + fr2) * 64 + 16 * b + 4 * fq2) = ST[b][nb];
    }
  }
}

DEVINL void phase_r5(const Params& p, int layer, int w, int nw) {
  const int j = layer >> 1;
  const int lane = tidx() & 63;
  const int gw = w * NWAVES + (tidx() >> 6), ngw = nw * NWAVES;
  const bf16_t* rb = reinterpret_cast<const bf16_t*>(p.U2);
  const bf16_t* kb = rb + (size_t)TT * DM;
  const bf16_t* vb = kb + (size_t)TT * DM;
  const bf16_t* aa = reinterpret_cast<const bf16_t*>(p.U1 + U1_AA_OFF);
  const bf16_t* gg = reinterpret_cast<const bf16_t*>(p.U1 + U1_GG_OFF);
  const float* yin = reinterpret_cast<const float*>(p.U3);
  const float* ka = p.in[23] + j * 1024;
  const float* rk = p.in[24] + j * 1024;
  const float* lg = p.in[25] + j * 1024;
  const float* lb = p.in[26] + j * 1024;
  for (int row = gw; row < TT; row += ngw) {
#pragma unroll
    for (int k = 0; k < 4; ++k) {
      const int col = k * 256 + lane * 4;
      const size_t o = (size_t)row * DM + col;
      const float4 yf = *reinterpret_cast<const float4*>(yin + o);
      const float4 yb = *reinterpret_cast<const float4*>(yin + (size_t)TT * DM + o);
      const uint2 r2 = *reinterpret_cast<const uint2*>(rb + o);
      const uint2 k2 = *reinterpret_cast<const uint2*>(kb + o);
      const uint2 v2 = *reinterpret_cast<const uint2*>(vb + o);
      const uint2 a02 = *reinterpret_cast<const uint2*>(aa + o);
      const uint2 a12 = *reinterpret_cast<const uint2*>(aa + (size_t)TT * DM + o);
      const uint2 g2 = *reinterpret_cast<const uint2*>(gg + o);
      const float4 ka4 = *reinterpret_cast<const float4*>(ka + col);
      const float4 rk4 = *reinterpret_cast<const float4*>(rk + col);
      const float4 lg4 = *reinterpret_cast<const float4*>(lg + col);
      const float4 lb4 = *reinterpret_cast<const float4*>(lb + col);
      float y[4] = {yf.x + yb.x, yf.y + yb.y, yf.z + yb.z, yf.w + yb.w};
      float r[4] = {bflo(r2.x), bfhi(r2.x), bflo(r2.y), bfhi(r2.y)};
      float kx[4] = {bflo(k2.x), bfhi(k2.x), bflo(k2.y), bfhi(k2.y)};
      float v[4] = {bflo(v2.x), bfhi(v2.x), bflo(v2.y), bfhi(v2.y)};
      float a0[4] = {bflo(a02.x), bfhi(a02.x), bflo(a02.y), bfhi(a02.y)};
      float a1[4] = {bflo(a12.x), bfhi(a12.x), bflo(a12.y), bfhi(a12.y)};
      float g[4] = {bflo(g2.x), bfhi(g2.x), bflo(g2.y), bfhi(g2.y)};
      float kav[4] = {ka4.x, ka4.y, ka4.z, ka4.w}, rkv[4] = {rk4.x, rk4.y, rk4.z, rk4.w};
      float lgv[4] = {lg4.x, lg4.y, lg4.z, lg4.w}, lbv[4] = {lb4.x, lb4.y, lb4.z, lb4.w};
      float sm = y[0] + y[1] + y[2] + y[3];
      sm = grp16_sum(sm);
      const float mean = sm * (1.0f / 64.0f);
      float sv = 0.f, sb = 0.f;
#pragma unroll
      for (int e = 0; e < 4; ++e) {
        float d = y[e] - mean; sv += d * d;
        float kd0 = kx[e] * (1.0f + (a0[e] - 1.0f) * kav[e]);
        float kd1 = kx[e] * (1.0f + (a1[e] - 1.0f) * kav[e]);
        sb += r[e] * (kd0 + kd1) * rkv[e];
      }
      sv = grp16_sum(sv); sb = grp16_sum(sb);
      const float rstd = rsqrtf(sv * (1.0f / 64.0f) + GN_EPS_F);
      float o4[4];
#pragma unroll
      for (int e = 0; e < 4; ++e) {
        float yn = (y[e] - mean) * rstd * lgv[e] + lbv[e];
        o4[e] = (yn + sb * v[e]) * g[e];
      }
      uint2 oo; oo.x = pack2(o4[0], o4[1]); oo.y = pack2(o4[2], o4[3]);
      *reinterpret_cast<uint2*>(p.abuf + o) = oo;
    }
  }
}

struct EpiWO {
  static constexpr bool PERM = false;
  const float* x; const float* mod; float* z; int layer;
  DEVINL void operator()(const f32x4 (&acc)[2][2][4][2], const pg8::Unit& u, int wr, int wc, int fr, int fq) const {
    const int row0 = u.pm * 256 + wr * 64 + fr, col0 = u.pn * 256 + wc * 32 + 4 * fq;
    const float* gate = mod + ((size_t)layer * 9 + cond_of_row(u.pm * 256)) * 6144 + 2 * 1024;
    f32x4 gv[2][2];
#pragma unroll
    for (int bj = 0; bj < 2; ++bj)
#pragma unroll
      for (int n = 0; n < 2; ++n) gv[bj][n] = *reinterpret_cast<const f32x4*>(gate + col0 + bj * 128 + n * 16);
#pragma unroll
    for (int ai = 0; ai < 2; ++ai)
#pragma unroll
      for (int m = 0; m < 4; ++m) {
        const size_t off = (size_t)(row0 + ai * 128 + m * 16) * DM + col0;
#pragma unroll
        for (int bj = 0; bj < 2; ++bj)
#pragma unroll
          for (int n = 0; n < 2; ++n) {
            const f32x4 xv = *reinterpret_cast<const f32x4*>(x + off + bj * 128 + n * 16);
            *reinterpret_cast<f32x4*>(z + off + bj * 128 + n * 16) = ALPHA_F * xv + gv[bj][n] * acc[ai][bj][m][n];
          }
        asm volatile("" ::: "memory");
      }
  }
};
DEVINL void phase_wo(const Params& p, int layer, int w, int nw, char* smem) {
  const int j = layer >> 1;
  const bf16_t* Wt = ((layer & 1) ? p.attn_wo_t : p.rwkv_wo_t) + ((size_t)j << 20);
  EpiWO E; E.x = p.xbuf; E.mod = p.mod; E.z = p.zbuf; E.layer = layer;
  pg8::ASelOne as; as.A = (const char*)p.abuf;
  pg8::StaticOrder S; S.init(TT, 1024, nw, w);
  pg8::gemm_phase<EpiWO, pg8::ASelOne>((PG8_LAS unsigned char*)smem, as, Wt, 1024, S, E);
}

DEVINL void phase_ln1(const Params& p, int layer, int w, int nw) {
  const int lane = tidx() & 63;
  const int gw = w * NWAVES + (tidx() >> 6), ngw = nw * NWAVES;
  const float* lng = p.in[9] + (size_t)(layer * 2 + 0) * 1024;
  const float* lnb = p.in[10] + (size_t)(layer * 2 + 0) * 1024;
  for (int row = gw; row < TT; row += ngw) {
    const float* md = p.mod + ((size_t)layer * 9 + cond_of_row(row)) * 6144;
    float4 z[4];
    float s = 0.f;
#pragma unroll
    for (int k = 0; k < 4; ++k) {
      z[k] = *reinterpret_cast<const float4*>(p.zbuf + (size_t)row * DM + k * 256 + lane * 4);
      s += z[k].x + z[k].y + z[k].z + z[k].w;
    }
    const float mean = wave_sum(s) * (1.0f / 1024.0f);
    float sv = 0.f;
#pragma unroll
    for (int k = 0; k < 4; ++k) {
      float a = z[k].x - mean, b = z[k].y - mean, c = z[k].z - mean, d = z[k].w - mean;
      sv += a * a + b * b + c * c + d * d;
    }
    const float rstd = rsqrtf(wave_sum(sv) * (1.0f / 1024.0f) + LN_EPS_F);
#pragma unroll
    for (int k = 0; k < 4; ++k) {
      const int col = k * 256 + lane * 4;
      const float4 g4 = *reinterpret_cast<const float4*>(lng + col);
      const float4 b4 = *reinterpret_cast<const float4*>(lnb + col);
      const float4 sh = *reinterpret_cast<const float4*>(md + 3 * 1024 + col);
      const float4 sc = *reinterpret_cast<const float4*>(md + 4 * 1024 + col);
      float4 x1;
      x1.x = (z[k].x - mean) * rstd * g4.x + b4.x;
      x1.y = (z[k].y - mean) * rstd * g4.y + b4.y;
      x1.z = (z[k].z - mean) * rstd * g4.z + b4.z;
      x1.w = (z[k].w - mean) * rstd * g4.w + b4.w;
      *reinterpret_cast<float4*>(p.xbuf + (size_t)row * DM + col) = x1;
      uint2 o;
      o.x = pack2(x1.x * (1.0f + sc.x) + sh.x, x1.y * (1.0f + sc.y) + sh.y);
      o.y = pack2(x1.z * (1.0f + sc.z) + sh.z, x1.w * (1.0f + sc.w) + sh.w);
      *reinterpret_cast<uint2*>(p.hbuf + (size_t)row * DM + col) = o;
    }
  }
}

struct EpiBf16 {
  static constexpr bool PERM = true;
  bf16_t* O; int ldc;
  DEVINL void operator()(const f32x4 (&acc)[2][2][4][2], const pg8::Unit& u, int wr, int wc, int fr, int fq) const {
    const int row0 = u.pm * 256 + wr * 64 + fr, col0 = u.pn * 256 + wc * 32 + 8 * fq;
#pragma unroll
    for (int ai = 0; ai < 2; ++ai)
#pragma unroll
      for (int m = 0; m < 4; ++m) {
        bf16_t* rowp = O + (size_t)(row0 + ai * 128 + m * 16) * ldc + col0;
#pragma unroll
        for (int bj = 0; bj < 2; ++bj) {
          const f32x4 v0 = acc[ai][bj][m][0], v1 = acc[ai][bj][m][1];
          pg8::u32x4 o; o.x = pg8::cvt_pk_bf16(v0[0], v0[1]); o.y = pg8::cvt_pk_bf16(v0[2], v0[3]); o.z = pg8::cvt_pk_bf16(v1[0], v1[1]); o.w = pg8::cvt_pk_bf16(v1[2], v1[3]);
          *reinterpret_cast<pg8::u32x4*>(rowp + bj * 128) = o;
        }
      }
  }
};

DEVINL void phase_p1(const Params& p, int layer, int w, int nw, char* smem) {
  EpiBf16 E; E.O = reinterpret_cast<bf16_t*>(p.U1); E.ldc = 2048;
  pg8::ASelOne as; as.A = (const char*)p.hbuf;
  pg8::StaticOrder S; S.init(TT, 2048, nw, w);
  pg8::gemm_phase<EpiBf16, pg8::ASelOne>((PG8_LAS unsigned char*)smem, as, p.wq_t + (size_t)layer * 2048 * 1024, 1024, S, E);
}

#define U1_S_OFF ((size_t)TT * 2048 * 2)
DEVINL void phase_p2(const Params& p, int layer, int w, int nw, char* smem) {
  GEMM_LANE_VARS
  const int half = tidx() >> 8;
  char* sh = smem + half * 16384;
  const bf16_t* qb = reinterpret_cast<const bf16_t*>(p.U1);
  float* sb = reinterpret_cast<float*>(p.U1 + U1_S_OFF);
  const int NTILES = 96 * 16;
  for (int it = 0; it * nw * 2 < NTILES; ++it) {
    int tile = (it * nw + w) * 2 + half;
    const bool valid = tile < NTILES;
    if (!valid) tile = 0;
    const int ct = tile / 96, rt = tile % 96;
    const int row0 = rt * 128;
    const int z = ct & 1;
    f32x4 acc[4][4];
    gemm_tile_128(qb + (size_t)row0 * 2048 + ct * 128, 2048, p.keysb + (size_t)(layer * 2 + z) * 16384, 128, 128, sh, acc);
    if (valid) {
#pragma unroll
      for (int m = 0; m < 4; ++m)
#pragma unroll
        for (int n = 0; n < 4; ++n)
#pragma unroll
          for (int jj = 0; jj < 4; ++jj) {
            int row = row0 + wr * 64 + m * 16 + fq * 4 + jj, col = wc * 64 + n * 16 + fr;
            sb[(size_t)row * 2048 + ct * 128 + col] = acc[m][n][jj];
          }
    }
  }
}

#define DPP_QP_1032 0xB1
#define DPP_QP_2301 0x4E
#define DPP_ROW_HALF_MIRROR 0x141
#define DPP_ROW_MIRROR 0x140
DEVINL unsigned umax_(unsigned a, unsigned b) { return a > b ? a : b; }
DEVINL unsigned umin_(unsigned a, unsigned b) { return a < b ? a : b; }
DEVINL unsigned row_max_u(unsigned v) {
  v = umax_(v, (unsigned)__builtin_amdgcn_update_dpp(0, (int)v, DPP_QP_1032, 0xf, 0xf, true));
  v = umax_(v, (unsigned)__builtin_amdgcn_update_dpp(0, (int)v, DPP_QP_2301, 0xf, 0xf, true));
  v = umax_(v, (unsigned)__builtin_amdgcn_update_dpp(0, (int)v, DPP_ROW_HALF_MIRROR, 0xf, 0xf, true));
  v = umax_(v, (unsigned)__builtin_amdgcn_update_dpp(0, (int)v, DPP_ROW_MIRROR, 0xf, 0xf, true));
  return v;
}
DEVINL float row_max_f(float v) {
  v = fmaxf(v, __int_as_float(__builtin_amdgcn_update_dpp(0, __float_as_int(v), DPP_QP_1032, 0xf, 0xf, true)));
  v = fmaxf(v, __int_as_float(__builtin_amdgcn_update_dpp(0, __float_as_int(v), DPP_QP_2301, 0xf, 0xf, true)));
  v = fmaxf(v, __int_as_float(__builtin_amdgcn_update_dpp(0, __float_as_int(v), DPP_ROW_HALF_MIRROR, 0xf, 0xf, true)));
  v = fmaxf(v, __int_as_float(__builtin_amdgcn_update_dpp(0, __float_as_int(v), DPP_ROW_MIRROR, 0xf, 0xf, true)));
  return v;
}
DEVINL float row_sum_f(float v) {
  v += __int_as_float(__builtin_amdgcn_update_dpp(0, __float_as_int(v), DPP_QP_1032, 0xf, 0xf, true));
  v += __int_as_float(__builtin_amdgcn_update_dpp(0, __float_as_int(v), DPP_QP_2301, 0xf, 0xf, true));
  v += __int_as_float(__builtin_amdgcn_update_dpp(0, __float_as_int(v), DPP_ROW_HALF_MIRROR, 0xf, 0xf, true));
  v += __int_as_float(__builtin_amdgcn_update_dpp(0, __float_as_int(v), DPP_ROW_MIRROR, 0xf, 0xf, true));
  return v;
}
DEVINL float unordf(unsigned u) { return __uint_as_float((u & 0x80000000u) ? (u ^ 0x80000000u) : ~u); }
#define CSWAP(a, b) { const unsigned _hi = umax_(a, b), _lo = umin_(a, b); a = _hi; b = _lo; }
DEVINL void slot_ij(int s, int& i, int& j) {
  if (s < 16) { i = 0; j = s; }
  else if (s < 24) { i = 1; j = s - 16; }
  else if (s < 29) { i = 2; j = s - 24; }
  else if (s < 33) { i = 3; j = s - 29; }
  else if (s < 36) { i = 4; j = s - 33; }
  else if (s < 42) { i = 5 + ((s - 36) >> 1); j = (s - 36) & 1; }
  else { i = s - 34; j = 0; }
}
DEVINL void phase_p3(const Params& p, int layer, int w, int nw, char* smem) {
  const int lane = tidx() & 63, wid = tidx() >> 6;
  const int fr = lane & 15, row = lane >> 4, pr = lane >> 5, l32 = lane & 31;
  const int gw = w * NWAVES + wid, ngw = nw * NWAVES;
  const float* sb = reinterpret_cast<const float*>(p.U1 + U1_S_OFF);
  float* svl = reinterpret_cast<float*>(smem) + wid * 128;
  int* sil = reinterpret_cast<int*>(smem) + wid * 128 + 64;
  int iA, jA, iB, jB;
  slot_ij(l32, iA, jA);
  const bool validB = (l32 + 32) < 50;
  slot_ij(validB ? (l32 + 32) : 0, iB, jB);
  for (int bt = gw; bt < TT * 4; bt += ngw) {
    const int t = bt >> 2, hp = bt & 3;
    {
      const int h = hp * 2 + (row >> 1), z = row & 1;
      const float* sp = sb + (size_t)t * 2048 + (h * 2 + z) * 128;
      const float4 a = *reinterpret_cast<const float4*>(sp + fr * 4);
      const float4 b = *reinterpret_cast<const float4*>(sp + 64 + fr * 4);
      unsigned k0 = (ordf(a.x) & ~127u) | (unsigned)(127 - (4 * fr + 0));
      unsigned k1 = (ordf(a.y) & ~127u) | (unsigned)(127 - (4 * fr + 1));
      unsigned k2 = (ordf(a.z) & ~127u) | (unsigned)(127 - (4 * fr + 2));
      unsigned k3 = (ordf(a.w) & ~127u) | (unsigned)(127 - (4 * fr + 3));
      unsigned k4 = (ordf(b.x) & ~127u) | (unsigned)(127 - (64 + 4 * fr + 0));
      unsigned k5 = (ordf(b.y) & ~127u) | (unsigned)(127 - (64 + 4 * fr + 1));
      unsigned k6 = (ordf(b.z) & ~127u) | (unsigned)(127 - (64 + 4 * fr + 2));
      unsigned k7 = (ordf(b.w) & ~127u) | (unsigned)(127 - (64 + 4 * fr + 3));
      CSWAP(k0, k1); CSWAP(k2, k3); CSWAP(k4, k5); CSWAP(k6, k7);
      CSWAP(k0, k2); CSWAP(k1, k3); CSWAP(k4, k6); CSWAP(k5, k7);
      CSWAP(k1, k2); CSWAP(k5, k6); CSWAP(k0, k4); CSWAP(k3, k7);
      CSWAP(k1, k5); CSWAP(k2, k6);
      CSWAP(k1, k4); CSWAP(k3, k6);
      CSWAP(k2, k4); CSWAP(k3, k5);
      CSWAP(k3, k4);
      unsigned mine = 0;
#pragma unroll
      for (int it = 0; it < 16; ++it) {
        const unsigned m = row_max_u(k0);
        if (fr == it) mine = m;
        const bool c = (k0 == m);
        k0 = c ? k1 : k0; k1 = c ? k2 : k1; k2 = c ? k3 : k2; k3 = c ? k4 : k3;
        k4 = c ? k5 : k4; k5 = c ? k6 : k5; k6 = c ? k7 : k6; k7 = c ? 0u : k7;
      }
      __builtin_amdgcn_wave_barrier();
      svl[row * 16 + fr] = unordf(mine & ~127u);
      sil[row * 16 + fr] = 127 - (int)(mine & 127u);
      __builtin_amdgcn_wave_barrier();
    }
    {
      const float* v0 = svl + (2 * pr) * 16;
      const float* v1 = svl + (2 * pr + 1) * 16;
      unsigned kA = (ordf(v0[iA] + v1[jA]) & ~63u) | (unsigned)(63 - l32);
      unsigned kB = validB ? ((ordf(v0[iB] + v1[jB]) & ~63u) | (unsigned)(63 - (l32 + 32))) : 0u;
      unsigned mine = 0;
#pragma unroll
      for (int it = 0; it < 16; ++it) {
        unsigned m = row_max_u(umax_(kA, kB));
        m = umax_(m, (unsigned)__shfl_xor((int)m, 16));
        if (l32 == it) mine = m;
        kA = (kA == m) ? 0u : kA;
        kB = (kB == m) ? 0u : kB;
      }
      int ii, jj;
      slot_ij(63 - (int)(mine & 63u), ii, jj);
      ii &= 15; jj &= 15;
      const float cv = v0[ii] + v1[jj];
      const int eidx = sil[(2 * pr) * 16 + ii] * 128 + sil[(2 * pr + 1) * 16 + jj];
      const float mx = row_max_f(cv);
      const float ex = __expf(cv - mx);
      const float sm = row_sum_f(ex);
      if (l32 < 16) {
        const int h = hp * 2 + pr;
        p.pidx[(size_t)t * 128 + h * 16 + l32] = eidx;
        p.pgate[(size_t)t * 128 + h * 16 + l32] = ex / sm;
      }
    }
  }
}

DEVINL float gelu_exact(float x) { return 0.5f * x * (1.0f + erff(x * 0.7071067811865476f)); }

DEVINL void phase_p4(const Params& p, int layer, int w, int nw, char* smem) {
  const int tid = tidx(), lane = tid & 63, wid = tid >> 6;
  const int fr = lane & 15, fq = lane >> 4;
  const int gw = w * NWAVES + wid, ngw = nw * NWAVES;
  const unsigned char* U = reinterpret_cast<const unsigned char*>(p.ub) + (size_t)layer * 16384 * 1024;
  const unsigned char* V = reinterpret_cast<const unsigned char*>(p.vb) + (size_t)layer * 16384 * 1024;
  const float* uinv = p.uinv + layer * 16384;
  const float* vinv = p.vinv + layer * 16384;
  const float* lng = p.in[9] + (size_t)(layer * 2 + 1) * 1024;
  const float* lnb = p.in[10] + (size_t)(layer * 2 + 1) * 1024;
  float* xout = (layer == 3) ? p.out : p.xbuf;
  char* wl = smem + wid * 3072;
  unsigned char* xhi = reinterpret_cast<unsigned char*>(wl);
  unsigned char* xlo = xhi + 1024;
  float* wgt = reinterpret_cast<float*>(wl + 2048);
  int* il = reinterpret_cast<int*>(wl + 2560);
  for (int t = gw; t < TT; t += ngw) {
    __builtin_amdgcn_wave_barrier();
    float xinv;
    {
      const uint4 a = *reinterpret_cast<const uint4*>(p.hbuf + (size_t)t * DM + lane * 16);
      const uint4 b = *reinterpret_cast<const uint4*>(p.hbuf + (size_t)t * DM + lane * 16 + 8);
      float x[16];
      x[0] = bflo(a.x); x[1] = bfhi(a.x); x[2] = bflo(a.y); x[3] = bfhi(a.y); x[4] = bflo(a.z); x[5] = bfhi(a.z); x[6] = bflo(a.w); x[7] = bfhi(a.w);
      x[8] = bflo(b.x); x[9] = bfhi(b.x); x[10] = bflo(b.y); x[11] = bfhi(b.y); x[12] = bflo(b.z); x[13] = bfhi(b.z); x[14] = bflo(b.w); x[15] = bfhi(b.w);
      float mx = 0.f;
#pragma unroll
      for (int q = 0; q < 16; ++q) mx = fmaxf(mx, fabsf(x[q]));
#pragma unroll
      for (int o = 32; o > 0; o >>= 1) mx = fmaxf(mx, __shfl_xor(mx, o));
      mx = fmaxf(mx, 1e-30f);
      const float sc = 440.0f / mx;
      xinv = mx * (1.0f / 440.0f);
      uint4 h4, l4;
      unsigned* hw = reinterpret_cast<unsigned*>(&h4);
      unsigned* lw = reinterpret_cast<unsigned*>(&l4);
#pragma unroll
      for (int q = 0; q < 4; ++q) {
        const float y0 = x[q * 4] * sc, y1 = x[q * 4 + 1] * sc, y2 = x[q * 4 + 2] * sc, y3 = x[q * 4 + 3] * sc;
        int pk = 0;
        pk = __builtin_amdgcn_cvt_pk_fp8_f32(y0, y1, pk, false);
        pk = __builtin_amdgcn_cvt_pk_fp8_f32(y2, y3, pk, true);
        const float r0 = y0 - __builtin_amdgcn_cvt_f32_fp8(pk, 0), r1 = y1 - __builtin_amdgcn_cvt_f32_fp8(pk, 1);
        const float r2 = y2 - __builtin_amdgcn_cvt_f32_fp8(pk, 2), r3 = y3 - __builtin_amdgcn_cvt_f32_fp8(pk, 3);
        int pl = 0;
        pl = __builtin_amdgcn_cvt_pk_fp8_f32(r0, r1, pl, false);
        pl = __builtin_amdgcn_cvt_pk_fp8_f32(r2, r3, pl, true);
        hw[q] = (unsigned)pk; lw[q] = (unsigned)pl;
      }
      *reinterpret_cast<uint4*>(xhi + lane * 16) = h4;
      *reinterpret_cast<uint4*>(xlo + lane * 16) = l4;
      il[lane] = p.pidx[(size_t)t * 128 + lane];
      il[64 + lane] = p.pidx[(size_t)t * 128 + 64 + lane];
    }
    __builtin_amdgcn_wave_barrier();
    const unsigned char* up[8];
#pragma unroll
    for (int g = 0; g < 8; ++g) up[g] = U + (size_t)il[g * 16 + fr] * 1024 + fq * 16;
    f32x4 acc[8];
#pragma unroll
    for (int g = 0; g < 8; ++g) acc[g] = (f32x4){0.f, 0.f, 0.f, 0.f};
#pragma unroll 2
    for (int s = 0; s < 16; ++s) {
      const uint4 xh = *reinterpret_cast<const uint4*>(xhi + s * 64 + fq * 16);
      const uint4 xl = *reinterpret_cast<const uint4*>(xlo + s * 64 + fq * 16);
      const long xh0 = (long)(((unsigned long long)xh.y << 32) | xh.x), xh1 = (long)(((unsigned long long)xh.w << 32) | xh.z);
      const long xl0 = (long)(((unsigned long long)xl.y << 32) | xl.x), xl1 = (long)(((unsigned long long)xl.w << 32) | xl.z);
      uint4 a[8];
#pragma unroll
      for (int g = 0; g < 8; ++g) a[g] = *reinterpret_cast<const uint4*>(up[g] + s * 64);
#pragma unroll
      for (int g = 0; g < 8; ++g) {
        const long a0 = (long)(((unsigned long long)a[g].y << 32) | a[g].x), a1 = (long)(((unsigned long long)a[g].w << 32) | a[g].z);
        acc[g] = __builtin_amdgcn_mfma_f32_16x16x32_fp8_fp8(a0, xh0, acc[g], 0, 0, 0);
        acc[g] = __builtin_amdgcn_mfma_f32_16x16x32_fp8_fp8(a1, xh1, acc[g], 0, 0, 0);
        acc[g] = __builtin_amdgcn_mfma_f32_16x16x32_fp8_fp8(a0, xl0, acc[g], 0, 0, 0);
        acc[g] = __builtin_amdgcn_mfma_f32_16x16x32_fp8_fp8(a1, xl1, acc[g], 0, 0, 0);
      }
    }
#pragma unroll
    for (int g = 0; g < 8; ++g) {
      const float4 gt = *reinterpret_cast<const float4*>(p.pgate + (size_t)t * 128 + g * 16 + fq * 4);
      const int e0 = g * 16 + fq * 4;
      const int i0 = il[e0], i1 = il[e0 + 1], i2 = il[e0 + 2], i3 = il[e0 + 3];
      float4 wv;
      wv.x = gt.x * gelu_exact(acc[g][0] * (uinv[i0] * xinv)) * vinv[i0];
      wv.y = gt.y * gelu_exact(acc[g][1] * (uinv[i1] * xinv)) * vinv[i1];
      wv.z = gt.z * gelu_exact(acc[g][2] * (uinv[i2] * xinv)) * vinv[i2];
      wv.w = gt.w * gelu_exact(acc[g][3] * (uinv[i3] * xinv)) * vinv[i3];
      if (fr == 0) *reinterpret_cast<float4*>(wgt + e0) = wv;
    }
    __builtin_amdgcn_wave_barrier();
    float f[16];
#pragma unroll
    for (int e = 0; e < 16; ++e) f[e] = 0.f;
#pragma unroll 16
    for (int e = 0; e < 128; ++e) {
      const int idx = __builtin_amdgcn_readfirstlane(il[e]);
      const float we = wgt[e];
      const uint4 c = *reinterpret_cast<const uint4*>(V + (size_t)idx * 1024 + lane * 16);
      const unsigned cw[4] = {c.x, c.y, c.z, c.w};
#pragma unroll
      for (int q = 0; q < 4; ++q) {
        const __attribute__((ext_vector_type(2))) float lo2 = __builtin_amdgcn_cvt_pk_f32_fp8((int)cw[q], false);
        const __attribute__((ext_vector_type(2))) float hi2 = __builtin_amdgcn_cvt_pk_f32_fp8((int)cw[q], true);
        f[q * 4 + 0] += we * lo2.x; f[q * 4 + 1] += we * lo2.y; f[q * 4 + 2] += we * hi2.x; f[q * 4 + 3] += we * hi2.y;
      }
    }
    const float* md = p.mod + ((size_t)layer * 9 + cond_of_row(t)) * 6144 + 5 * 1024;
    float zz[16];
    float s = 0.f;
#pragma unroll
    for (int q = 0; q < 4; ++q) {
      const int col = lane * 16 + q * 4;
      const float4 x0 = *reinterpret_cast<const float4*>(p.xbuf + (size_t)t * DM + col);
      const float4 g0 = *reinterpret_cast<const float4*>(md + col);
      zz[q * 4 + 0] = ALPHA_F * x0.x + g0.x * f[q * 4 + 0];
      zz[q * 4 + 1] = ALPHA_F * x0.y + g0.y * f[q * 4 + 1];
      zz[q * 4 + 2] = ALPHA_F * x0.z + g0.z * f[q * 4 + 2];
      zz[q * 4 + 3] = ALPHA_F * x0.w + g0.w * f[q * 4 + 3];
      s += zz[q * 4] + zz[q * 4 + 1] + zz[q * 4 + 2] + zz[q * 4 + 3];
    }
    const float mean = wave_sum(s) * (1.0f / 1024.0f);
    float sv = 0.f;
#pragma unroll
    for (int e = 0; e < 16; ++e) { float d = zz[e] - mean; sv += d * d; }
    const float rstd = rsqrtf(wave_sum(sv) * (1.0f / 1024.0f) + LN_EPS_F);
#pragma unroll
    for (int q = 0; q < 4; ++q) {
      const int col = lane * 16 + q * 4;
      const float4 g0 = *reinterpret_cast<const float4*>(lng + col);
      const float4 b0 = *reinterpret_cast<const float4*>(lnb + col);
      float4 o0;
      o0.x = (zz[q * 4 + 0] - mean) * rstd * g0.x + b0.x;
      o0.y = (zz[q * 4 + 1] - mean) * rstd * g0.y + b0.y;
      o0.z = (zz[q * 4 + 2] - mean) * rstd * g0.z + b0.z;
      o0.w = (zz[q * 4 + 3] - mean) * rstd * g0.w + b0.w;
      *reinterpret_cast<float4*>(xout + (size_t)t * DM + col) = o0;
    }
  }
}

DEVINL void phase_a1(const Params& p, int layer, int w, int nw) {
  const int lane = tidx() & 63;
  const int gw = w * NWAVES + (tidx() >> 6), ngw = nw * NWAVES;
  for (int row = gw; row < TT; row += ngw) {
    const float* md = p.mod + ((size_t)layer * 9 + cond_of_row(row)) * 6144;
#pragma unroll
    for (int k = 0; k < 4; ++k) {
      const int col = k * 256 + lane * 4;
      const float4 x = *reinterpret_cast<const float4*>(p.xbuf + (size_t)row * DM + col);
      const float4 sh = *reinterpret_cast<const float4*>(md + col);
      const float4 sc = *reinterpret_cast<const float4*>(md + 1024 + col);
      uint2 o;
      o.x = pack2(x.x * (1.0f + sc.x) + sh.x, x.y * (1.0f + sc.y) + sh.y);
      o.y = pack2(x.z * (1.0f + sc.z) + sh.z, x.w * (1.0f + sc.w) + sh.w);
      *reinterpret_cast<uint2*>(p.hbuf + (size_t)row * DM + col) = o;
    }
  }
}

DEVINL void phase_a2(const Params& p, int layer, int w, int nw, char* smem) {
  const int j = layer >> 1;
  EpiBf16 E; E.O = reinterpret_cast<bf16_t*>(p.U1); E.ldc = 1536;
  pg8::ASelOne as; as.A = (const char*)p.hbuf;
  pg8::StaticOrder S; S.init(TT, 1536, nw, w);
  pg8::gemm_phase<EpiBf16, pg8::ASelOne>((PG8_LAS unsigned char*)smem, as, p.attn_wqkv_t + (size_t)j * 1536 * 1024, 1024, S, E);
}

DEVINL void load16(const bf16_t* src, float (&x)[16]) {
  const uint4 a = *reinterpret_cast<const uint4*>(src);
  const uint4 b = *reinterpret_cast<const uint4*>(src + 8);
  x[0] = bflo(a.x); x[1] = bfhi(a.x); x[2] = bflo(a.y); x[3] = bfhi(a.y); x[4] = bflo(a.z); x[5] = bfhi(a.z); x[6] = bflo(a.w); x[7] = bfhi(a.w);
  x[8] = bflo(b.x); x[9] = bfhi(b.x); x[10] = bflo(b.y); x[11] = bfhi(b.y); x[12] = bflo(b.z); x[13] = bfhi(b.z); x[14] = bflo(b.w); x[15] = bfhi(b.w);
}
DEVINL void store16bf(bf16_t* dst, const float (&x)[16]) {
  uint4 a, b;
  a.x = pack2(x[0], x[1]); a.y = pack2(x[2], x[3]); a.z = pack2(x[4], x[5]); a.w = pack2(x[6], x[7]);
  b.x = pack2(x[8], x[9]); b.y = pack2(x[10], x[11]); b.z = pack2(x[12], x[13]); b.w = pack2(x[14], x[15]);
  *reinterpret_cast<uint4*>(dst) = a; *reinterpret_cast<uint4*>(dst + 8) = b;
}
DEVINL void headnorm_rope(float (&x)[16], const float* nwgt, int quarter, bool lat, int t, const float* rope) {
  float ss = 0.f;
#pragma unroll
  for (int e = 0; e < 16; ++e) ss += x[e] * x[e];
  ss += __shfl_xor(ss, 1); ss += __shfl_xor(ss, 2);
  const float rinv = rsqrtf(ss * (1.0f / 64.0f) + RMS_EPS_F);
#pragma unroll
  for (int e = 0; e < 16; ++e) x[e] = x[e] * rinv * nwgt[quarter * 16 + e];
  if (lat) {
    const int pos = (quarter < 2) ? (t >> 6) : (t & 63);
    const bool hi = quarter & 1;
#pragma unroll
    for (int e = 0; e < 16; ++e) {
      const float other = __shfl_xor(x[e], 1);
      const float c = rope[(pos * 16 + e) * 2], s = rope[(pos * 16 + e) * 2 + 1];
      x[e] = hi ? (x[e] * c + other * s) : (x[e] * c - other * s);
    }
  }
}

DEVINL void phase_a2b(const Params& p, int layer, int w, int nw) {
  const int j = layer >> 1;
  const int lane = tidx() & 63;
  const int gw = w * NWAVES + (tidx() >> 6), ngw = nw * NWAVES;
  const bf16_t* qkv = reinterpret_cast<const bf16_t*>(p.U1);
  bf16_t* qb = reinterpret_cast<bf16_t*>(p.U2);
  const float* qn = p.in[29] + j * 64;
  const float* kn = p.in[30] + j * 64;
  for (int row = gw; row < TT; row += ngw) {
    const bool lat = row >= TCTX;
    const int t = lat ? ((row - TCTX) & 1023) : (row & 255);
    const int b = lat ? ((row - TCTX) >> 10) : (row >> 8);
    const bf16_t* src = qkv + (size_t)row * 1536;
    {
      float x[16];
      load16(src + lane * 16, x);
      headnorm_rope(x, qn, lane & 3, lat, t, p.rope);
#pragma unroll
      for (int e = 0; e < 16; ++e) x[e] *= QSCALE_F;
      store16bf(qb + (size_t)row * DM + lane * 16, x);
    }
    if (lane < 16) {
      const int kvh = lane >> 2, quarter = lane & 3;
      float x[16];
      load16(src + 1024 + lane * 16, x);
      headnorm_rope(x, kn, quarter, false, t, p.rope);
      if (lat) {
        const int pos = (quarter < 2) ? (t >> 6) : (t & 63);
        const bool hi = quarter & 1;
#pragma unroll
        for (int e = 0; e < 16; ++e) {
          const float other = __shfl_xor(x[e], 1);
          const float c = p.rope[(pos * 16 + e) * 2], s = p.rope[(pos * 16 + e) * 2 + 1];
          x[e] = hi ? (x[e] * c + other * s) : (x[e] * c - other * s);
        }
        store16bf(p.Klat + ((size_t)((j * 8 + b) * 4 + kvh) * 1536 + 512 + t) * 64 + quarter * 16, x);
      } else {
        store16bf(p.Kctx + ((size_t)((j * 16 + b) * 4 + kvh) * 256 + t) * 64 + quarter * 16, x);
        float* ko = p.out + OUT_CK + ((size_t)(b * 2 + j) * 256 + t) * 256 + kvh * 64 + quarter * 16;
#pragma unroll
        for (int q4 = 0; q4 < 4; ++q4) reinterpret_cast<float4*>(ko)[q4] = make_float4(x[q4 * 4], x[q4 * 4 + 1], x[q4 * 4 + 2], x[q4 * 4 + 3]);
      }
    } else if (lane < 32) {
      const int l2 = lane - 16;
      const int kvh = l2 >> 2, quarter = l2 & 3;
      float x[16];
      load16(src + 1280 + l2 * 16, x);
      if (lat) {
        bf16_t* vd = p.VlatT + (size_t)((j * 8 + b) * 4 + kvh) * 64 * 1536 + 512 + t;
#pragma unroll
        for (int e = 0; e < 16; ++e) vd[(size_t)(quarter * 16 + e) * 1536] = f2bf(x[e]);
      } else {
        bf16_t* vd = p.VctxT + (size_t)((j * 16 + b) * 4 + kvh) * 64 * 256 + t;
#pragma unroll
        for (int e = 0; e < 16; ++e) vd[(size_t)(quarter * 16 + e) * 256] = f2bf(x[e]);
        float* vo = p.out + OUT_CV + ((size_t)(b * 2 + j) * 256 + t) * 256 + kvh * 64 + quarter * 16;
#pragma unroll
        for (int q4 = 0; q4 < 4; ++q4) reinterpret_cast<float4*>(vo)[q4] = make_float4(x[q4 * 4], x[q4 * 4 + 1], x[q4 * 4 + 2], x[q4 * 4 + 3]);
      }
    }
  }
}

DEVINL void phase_a3(const Params& p, int layer, int w, int nw) {
  const int j = layer >> 1;
  const int lane = tidx() & 63, wid = tidx() >> 6;
  const int ql = lane & 31, hh = lane >> 5;
  const bf16_t* qb = reinterpret_cast<const bf16_t*>(p.U2);
  for (int item = w; item < 768; item += nw) {
    int hq, Tk, row0;
    const bf16_t *Kb, *Vt;
    if (item < 512) {
      const int b = item >> 6, qblk = item & 3;
      hq = (item >> 2) & 15;
      const int kvh = hq >> 2;
      Kb = p.Klat + (size_t)((j * 8 + b) * 4 + kvh) * 1536 * 64;
      Vt = p.VlatT + (size_t)((j * 8 + b) * 4 + kvh) * 64 * 1536;
      Tk = 1536; row0 = TCTX + b * 1024 + qblk * 256;
    } else {
      const int it = item - 512;
      const int b = it >> 4;
      hq = it & 15;
      const int kvh = hq >> 2;
      Kb = p.Kctx + (size_t)((j * 16 + b) * 4 + kvh) * 256 * 64;
      Vt = p.VctxT + (size_t)((j * 16 + b) * 4 + kvh) * 64 * 256;
      Tk = 256; row0 = b * 256;
    }
    const int qrow = row0 + wid * 32 + ql;
    bf16x8 bq[4];
#pragma unroll
    for (int ks = 0; ks < 4; ++ks) bq[ks] = *reinterpret_cast<const bf16x8*>(qb + (size_t)qrow * DM + hq * 64 + ks * 16 + hh * 8);
    f32x16 o0, o1;
#pragma unroll
    for (int r = 0; r < 16; ++r) { o0[r] = 0.f; o1[r] = 0.f; }
    float mrun = -1e30f, lrun = 0.f;
    for (int kt = 0; kt < Tk; kt += 32) {
      f32x16 sacc;
#pragma unroll
      for (int r = 0; r < 16; ++r) sacc[r] = 0.f;
#pragma unroll
      for (int ks = 0; ks < 4; ++ks) {
        bf16x8 ka = *reinterpret_cast<const bf16x8*>(Kb + (size_t)(kt + ql) * 64 + ks * 16 + hh * 8);
        sacc = __builtin_amdgcn_mfma_f32_32x32x16_bf16(ka, bq[ks], sacc, 0, 0, 0);
      }
      float tmax = sacc[0];
#pragma unroll
      for (int r = 1; r < 16; ++r) tmax = fmaxf(tmax, sacc[r]);
      tmax = fmaxf(tmax, __shfl_xor(tmax, 32));
      const float mnew = fmaxf(mrun, tmax);
      const float corr = exp2f(mrun - mnew);
      mrun = mnew;
      lrun *= corr;
#pragma unroll
      for (int r = 0; r < 16; ++r) { o0[r] *= corr; o1[r] *= corr; }
      float pv[16];
#pragma unroll
      for (int r = 0; r < 16; ++r) { pv[r] = exp2f(sacc[r] - mnew); lrun += pv[r]; }
#pragma unroll
      for (int s2 = 0; s2 < 2; ++s2) {
        union { bf16x8 v; unsigned u[4]; } pb;
#pragma unroll
        for (int q = 0; q < 4; ++q) pb.u[q] = pack2(pv[s2 * 8 + q * 2], pv[s2 * 8 + q * 2 + 1]);
#pragma unroll
        for (int dblk = 0; dblk < 2; ++dblk) {
          const bf16_t* vp = Vt + (size_t)(dblk * 32 + ql) * Tk + kt + 16 * s2 + 4 * hh;
          const uint2 lo = *reinterpret_cast<const uint2*>(vp);
          const uint2 hi = *reinterpret_cast<const uint2*>(vp + 8);
          union { bf16x8 v; unsigned u[4]; } va;
          va.u[0] = lo.x; va.u[1] = lo.y; va.u[2] = hi.x; va.u[3] = hi.y;
          if (dblk == 0) o0 = __builtin_amdgcn_mfma_f32_32x32x16_bf16(va.v, pb.v, o0, 0, 0, 0);
          else o1 = __builtin_amdgcn_mfma_f32_32x32x16_bf16(va.v, pb.v, o1, 0, 0, 0);
        }
      }
    }
    const float ltot = lrun + __shfl_xor(lrun, 32);
    const float inv = 1.0f / ltot;
#pragma unroll
    for (int g = 0; g < 4; ++g) {
      uint2 oa, ob;
      oa.x = pack2(o0[4 * g] * inv, o0[4 * g + 1] * inv); oa.y = pack2(o0[4 * g + 2] * inv, o0[4 * g + 3] * inv);
      ob.x = pack2(o1[4 * g] * inv, o1[4 * g + 1] * inv); ob.y = pack2(o1[4 * g + 2] * inv, o1[4 * g + 3] * inv);
      *reinterpret_cast<uint2*>(p.abuf + (size_t)qrow * DM + hq * 64 + 8 * g + 4 * hh) = oa;
      *reinterpret_cast<uint2*>(p.abuf + (size_t)qrow * DM + hq * 64 + 32 + 8 * g + 4 * hh) = ob;
    }
  }
}

#define XB_TMO      128
#define XB_XCNT(j)  (256  + 64 * (j))
#define XB_XSUB(j)  (1280 + 64 * (j))
#define XB_XGEN(j)  (2304 + 64 * (j))
#define XB_TOP      3328
#define XB_TOPGEN   3392
#define XCD_BAR_WORDS 3456
#define XB_SPIN_CAP (1u << 22)
#define LAS __attribute__((address_space(3)))

DEVINL unsigned xb_ld(unsigned* p) { return __hip_atomic_load(p, __ATOMIC_RELAXED, __HIP_MEMORY_SCOPE_AGENT); }
DEVINL unsigned xb_add(unsigned* p, unsigned v) { return __hip_atomic_fetch_add(p, v, __ATOMIC_RELAXED, __HIP_MEMORY_SCOPE_AGENT); }
DEVINL unsigned xb_xcc_id() { return (unsigned)__builtin_amdgcn_s_getreg((3 << 11) | 20) & 0xFu; }
#define XB_SPIN(cond, bar) do { unsigned _sp = 0; while (cond) { __builtin_amdgcn_s_sleep(1); \
    if ((++_sp & 255u) == 0u) { if (xb_ld(&(bar)[XB_TMO])) break; if (_sp > XB_SPIN_CAP) { atomicAdd(&(bar)[XB_TMO], 1u); break; } } } } while (0)

struct XcdBarrier { unsigned* bar; unsigned x; volatile LAS unsigned* st; };

DEVINL XcdBarrier xcd_barrier_post(unsigned* bar, volatile LAS unsigned* st) {
  XcdBarrier b; b.bar = bar; b.x = xb_xcc_id(); b.st = st;
  if (threadIdx.x == 0) (void)xb_add(&bar[XB_XCNT(b.x)], 1u);
  return b;
}
DEVINL void xcd_barrier_complete(unsigned* bar, unsigned x, unsigned& nloc, unsigned& nx) {
  const unsigned G = gridDim.x * gridDim.y * gridDim.z;
  unsigned sum, cnt, mine, sp = 0u;
  for (;;) {
    sum = 0u; cnt = 0u; mine = 0u;
#pragma unroll
    for (unsigned j = 0; j < 16; ++j) { const unsigned c = xb_ld(&bar[XB_XCNT(j)]); sum += c; cnt += (c > 0u) ? 1u : 0u; mine = (j == x) ? c : mine; }
    if (sum == G) break;
    __builtin_amdgcn_s_sleep(1);
    if ((++sp & 255u) == 0u) { if (xb_ld(&bar[XB_TMO])) break; if (sp > XB_SPIN_CAP) { atomicAdd(&bar[XB_TMO], 1u); break; } }
  }
  nloc = mine > 0u ? mine : 1u; nx = cnt > 0u ? cnt : 1u;
}
DEVINL void xcd_barrier(const XcdBarrier& b) {
  asm volatile("s_waitcnt vmcnt(0)" ::: "memory");
  __syncthreads();
  if (threadIdx.x == 0) {
    unsigned* bar = b.bar;
    __builtin_amdgcn_s_waitcnt(0);
    unsigned nloc = b.st[0], nx = b.st[1];
    if (nloc == 0u) { xcd_barrier_complete(bar, b.x, nloc, nx); b.st[0] = nloc; b.st[1] = nx; }
    const unsigned old = xb_add(&bar[XB_XSUB(b.x)], 1u);
    const unsigned gen = old / nloc;
    if (old + 1u == (gen + 1u) * nloc) {
      __builtin_amdgcn_fence(__ATOMIC_RELEASE, "agent");
      asm volatile("s_waitcnt vmcnt(0)" ::: "memory");
      const unsigned og = xb_add(&bar[XB_TOP], 1u);
      const unsigned tg = og / nx;
      if (og + 1u == (tg + 1u) * nx) xb_add(&bar[XB_TOPGEN], 1u);
      else XB_SPIN(xb_ld(&bar[XB_TOPGEN]) == tg, bar);
      __builtin_amdgcn_fence(__ATOMIC_ACQUIRE, "agent");
      xb_add(&bar[XB_XGEN(b.x)], 1u);
      asm volatile("s_waitcnt vmcnt(0)" ::: "memory");
    } else {
      XB_SPIN(xb_ld(&bar[XB_XGEN(b.x)]) == gen, bar);
      __builtin_amdgcn_fence(__ATOMIC_ACQUIRE, "agent");
      asm volatile("s_waitcnt vmcnt(0)" ::: "memory");
    }
  }
  __syncthreads();
}

extern __shared__ __attribute__((aligned(16))) char dyn_smem[];
__global__ void __launch_bounds__(NTHREADS, 2) mega_kernel(Params p) {
  char* smem = dyn_smem;
  cg::grid_group grid = cg::this_grid();
  const int w = blockIdx.x, nw = gridDim.x;
  if (p.use_cg_sync) grid.sync();
  volatile LAS unsigned* xst = (volatile LAS unsigned*)(smem + SMEM_BYTES - 16);
  if (threadIdx.x == 0) { xst[0] = 0u; xst[1] = 0u; }
  __syncthreads();
  XcdBarrier xb = xcd_barrier_post(p.bar, xst);
#define GSYNC() xcd_barrier(xb)
#ifndef REP_PREP
#define REP_PREP 1
#endif
#ifndef REP_R4
#define REP_R4 1
#endif
#ifndef REP_P3
#define REP_P3 1
#endif
#ifndef REP_P4L3
#define REP_P4L3 1
#endif
#ifndef REP_A3
#define REP_A3 1
#endif
#ifndef REP_GEMM
#define REP_GEMM 1
#endif
#ifndef REP_SG
#define REP_SG 1
#endif
#ifndef REP_EW
#define REP_EW 1
#endif
  for (int rep = 0; rep < REP_PREP; ++rep) { phase_prep(p, w, nw, smem); GSYNC(); }
  for (int layer = 0; layer < 4; ++layer) {
    if ((layer & 1) == 0) {
      for (int rep = 0; rep < REP_EW; ++rep) { phase_r1(p, layer, w, nw); GSYNC(); }
      for (int rep = 0; rep < REP_GEMM; ++rep) { phase_r2(p, layer, w, nw, smem); GSYNC(); }
      for (int rep = 0; rep < REP_SG; ++rep) { phase_r3(p, layer, w, nw, smem); GSYNC(); }
      for (int rep = 0; rep < REP_R4; ++rep) { phase_r4(p, layer, w, nw, smem); GSYNC(); }
      for (int rep = 0; rep < REP_EW; ++rep) { phase_r5(p, layer, w, nw); GSYNC(); }
    } else {
      for (int rep = 0; rep < REP_EW; ++rep) { phase_a1(p, layer, w, nw); GSYNC(); }
      for (int rep = 0; rep < REP_GEMM; ++rep) { phase_a2(p, layer, w, nw, smem); GSYNC(); }
      for (int rep = 0; rep < REP_EW; ++rep) { phase_a2b(p, layer, w, nw); GSYNC(); }
      for (int rep = 0; rep < REP_A3; ++rep) { phase_a3(p, layer, w, nw); GSYNC(); }
    }
    for (int rep = 0; rep < REP_GEMM; ++rep) { phase_wo(p, layer, w, nw, smem); GSYNC(); }
    for (int rep = 0; rep < REP_EW; ++rep) { phase_ln1(p, layer, w, nw); GSYNC(); }
    for (int rep = 0; rep < REP_GEMM; ++rep) { phase_p1(p, layer, w, nw, smem); GSYNC(); }
    for (int rep = 0; rep < REP_SG; ++rep) { phase_p2(p, layer, w, nw, smem); GSYNC(); }
    for (int rep = 0; rep < REP_P3; ++rep) { phase_p3(p, layer, w, nw, smem); GSYNC(); }
    for (int rep = 0; rep < (layer == 3 ? REP_P4L3 : 1); ++rep) { phase_p4(p, layer, w, nw, smem); GSYNC(); }
  }
}

static inline char* carve(char*& cur, size_t bytes) {
  char* r = cur;
  cur += (bytes + 255) & ~(size_t)255;
  return r;
}

extern "C" void kernel_launch(void* const* d_in, const int* in_sizes, int n_in, void* d_out, int out_size, void* d_ws,
                              size_t ws_size, hipStream_t stream) {
  Params p;
  memset(&p, 0, sizeof(p));
  for (int i = 0; i < 35; ++i) p.in[i] = (const float*)d_in[i];
  p.out = (float*)d_out;
  char* cur = (char*)d_ws;
  p.bar = (unsigned*)carve(cur, 16384);
  p.mod = (float*)carve(cur, (size_t)4 * 9 * 6144 * 4);
  p.rope = (float*)carve(cur, 64 * 16 * 2 * 4);
  p.rwkv_in_t = (bf16_t*)carve(cur, (size_t)2 * RW_N * 1024 * 2);
  p.w2t = (bf16_t*)carve(cur, (size_t)4 * 65536 * 2);
  p.a2t = (bf16_t*)carve(cur, (size_t)4 * 65536 * 2);
  p.g2t = (bf16_t*)carve(cur, (size_t)2 * 131072 * 2);
  p.rwkv_wo_t = (bf16_t*)carve(cur, (size_t)2 * 1048576 * 2);
  p.attn_wqkv_t = (bf16_t*)carve(cur, (size_t)2 * 1536 * 1024 * 2);
  p.attn_wo_t = (bf16_t*)carve(cur, (size_t)2 * 1048576 * 2);
  p.wq_t = (bf16_t*)carve(cur, (size_t)4 * 2048 * 1024 * 2);
  p.keysb = (bf16_t*)carve(cur, (size_t)4 * 2 * 128 * 128 * 2);
  p.ub = (bf16_t*)carve(cur, (size_t)4 * 16384 * 1024 * 2);
  p.vb = (bf16_t*)carve(cur, (size_t)4 * 16384 * 1024 * 2);
  p.uinv = (float*)carve(cur, (size_t)65536 * 4);
  p.vinv = (float*)carve(cur, (size_t)65536 * 4);
  p.Klat = (bf16_t*)carve(cur, (size_t)2 * 8 * 4 * 1536 * 64 * 2);
  p.VlatT = (bf16_t*)carve(cur, (size_t)2 * 8 * 4 * 1536 * 64 * 2);
  p.Kctx = (bf16_t*)carve(cur, (size_t)2 * 16 * 4 * 256 * 64 * 2);
  p.VctxT = (bf16_t*)carve(cur, (size_t)2 * 16 * 4 * 256 * 64 * 2);
  p.xbuf = (float*)carve(cur, (size_t)TT * DM * 4);
  p.zbuf = (float*)carve(cur, (size_t)TT * DM * 4);
  p.hbuf = (bf16_t*)carve(cur, (size_t)TT * DM * 2);
  p.abuf = (bf16_t*)carve(cur, (size_t)TT * DM * 2);
  p.U1 = carve(cur, (size_t)TT * DM * 14);
  p.U2 = carve(cur, (size_t)TT * DM * 8);
  p.U3 = carve(cur, (size_t)TT * DM * 8);
  p.pidx = (int*)carve(cur, (size_t)TT * 128 * 4);
  p.pgate = (float*)carve(cur, (size_t)TT * 128 * 4);
  for (int f = 0; f < 16; ++f) p.freqs[f] = pow(10000.0, -(double)f / 16.0);
  if ((size_t)(cur - (char*)d_ws) > ws_size) {
    fprintf(stderr, "workspace too small: need %zu have %zu\n", (size_t)(cur - (char*)d_ws), ws_size);
    return;
  }
  static int grid_blocks = 0;
  if (!grid_blocks) {
    int dev = 0, cus = 0, per_cu = 0;
    (void)hipGetDevice(&dev);
    (void)hipDeviceGetAttribute(&cus, hipDeviceAttributeMultiprocessorCount, dev);
    (void)hipFuncSetAttribute((const void*)mega_kernel, hipFuncAttributeMaxDynamicSharedMemorySize, SMEM_BYTES);
    (void)hipOccupancyMaxActiveBlocksPerMultiprocessor(&per_cu, mega_kernel, NTHREADS, SMEM_BYTES);
    if (per_cu > 1) per_cu = 1;
    if (per_cu < 1) per_cu = 1;
    grid_blocks = cus * per_cu;
  }
  (void)hipMemsetAsync(p.bar, 0, 16384, stream);
  void* args[] = {&p};
  hipError_t e = hipLaunchCooperativeKernel((void*)mega_kernel, dim3(grid_blocks), dim3(NTHREADS), args, SMEM_BYTES, stream);
  if (e != hipSuccess) fprintf(stderr, "cooperative launch failed: %s (grid %d)\n", hipGetErrorString(e), grid_blocks);
}
```

```cpp
#include <hip/hip_runtime.h>
#include <hip/hip_cooperative_groups.h>
#include <stdint.h>
#include <string.h>
#include <math.h>
#include <stdio.h>

namespace cg = cooperative_groups;

typedef unsigned short bf16_t;
typedef __attribute__((ext_vector_type(8))) short bf16x8;
typedef __attribute__((ext_vector_type(4))) float f32x4;
typedef __attribute__((ext_vector_type(16))) float f32x16;

#define DEVINL __device__ __forceinline__
#define NTHREADS 512
#define NWAVES 8
#define GEMM_LDS 131072
#define SMEM_BYTES 163840
#define RW_N 3840

#define DM 1024
#define TCTX 4096
#define TLAT 8192
#define TT 12288
#define ALPHA_F 1.681792830507429f
#define LN_EPS_F 1e-5f
#define GN_EPS_F 6.4e-4f
#define RMS_EPS_F 1e-6f
#define QSCALE_F (0.125f * 1.4426950408889634f)

#define OUT_Y 0
#define OUT_STATE 12582912
#define OUT_CK 16777216
#define OUT_CV 18874368

struct Params {
  const float* in[35];
  float* out;
  float* mod;
  float* rope;
  bf16_t* rwkv_in_t;
  bf16_t* w2t;
  bf16_t* a2t;
  bf16_t* g2t;
  bf16_t* rwkv_wo_t;
  bf16_t* attn_wqkv_t;
  bf16_t* attn_wo_t;
  bf16_t* wq_t;
  bf16_t* keysb;
  bf16_t* ub;
  bf16_t* vb;
  float* uinv;
  float* vinv;
  bf16_t* Klat;
  bf16_t* VlatT;
  bf16_t* Kctx;
  bf16_t* VctxT;
  float* xbuf;
  float* zbuf;
  bf16_t* hbuf;
  bf16_t* abuf;
  char* U1;
  char* U2;
  char* U3;
  int* pidx;
  float* pgate;
  double freqs[16];
  unsigned* bar;
  int use_cg_sync;
  int pad0;
};

DEVINL int lane_id() { return (int)__builtin_amdgcn_mbcnt_hi(~0u, __builtin_amdgcn_mbcnt_lo(~0u, 0u)); }
DEVINL int tidx(int gwid) {
  int t = gwid * 64 + lane_id(); asm volatile("" : "+v"(t)); return t;
}
typedef __bf16 bf16v2_ __attribute__((ext_vector_type(2)));
typedef float f32v2_ __attribute__((ext_vector_type(2)));
DEVINL unsigned cvt_pk_bf16_(float lo, float hi) { f32v2_ v = {lo, hi}; bf16v2_ r = __builtin_convertvector(v, bf16v2_); return __builtin_bit_cast(unsigned, r); }
DEVINL bf16_t f2bf(float f) { return (bf16_t)(cvt_pk_bf16_(f, f) & 0xFFFFu); }
DEVINL float bf2f(bf16_t h) { return __uint_as_float(((unsigned)h) << 16); }
DEVINL unsigned pack2(float a, float b) { return cvt_pk_bf16_(a, b); }
DEVINL float bflo(unsigned u) { return __uint_as_float(u << 16); }
DEVINL float bfhi(unsigned u) { return __uint_as_float(u & 0xFFFF0000u); }

DEVINL float wave_sum(float v) {
#pragma unroll
  for (int o = 32; o > 0; o >>= 1) v += __shfl_xor(v, o);
  return v;
}
DEVINL float grp16_sum(float v) {
#pragma unroll
  for (int o = 8; o > 0; o >>= 1) v += __shfl_xor(v, o);
  return v;
}
DEVINL unsigned wave_max_u(unsigned v) {
#pragma unroll
  for (int o = 32; o > 0; o >>= 1) { unsigned t = (unsigned)__shfl_xor((int)v, o); v = v > t ? v : t; }
  return v;
}
DEVINL float sigmoidf_(float x) { return 1.0f / (1.0f + __expf(-x)); }
DEVINL float tanhf_(float x) { float e = __expf(-2.0f * fabsf(x)); float t = (1.0f - e) / (1.0f + e); return x < 0 ? -t : t; }
DEVINL unsigned ordf(float f) { unsigned u = __float_as_uint(f); return (u & 0x80000000u) ? ~u : (u | 0x80000000u); }

DEVINL int cond_of_row(int row) { return row < TCTX ? 8 : ((row - TCTX) >> 10); }


namespace pg8 {
#define PG8_LAS __attribute__((address_space(3)))
typedef unsigned u32x4 __attribute__((ext_vector_type(4)));
constexpr int BM = 256, BK = 64, HALF = 128, HTB = HALF * BK * 2, STAGE_BYTES = 8 * HTB, NXCD = 8, WGM = 8;
DEVINL int lds_byte(int r, int c) { const int st = (r >> 4) * 2 + (c >> 5), rr = r & 15, cc = c & 31, ob = rr * 64 + cc * 2; return st * 1024 + (ob ^ (((ob >> 9) & 1) << 5)); }
DEVINL void stage_rc(int b, int& R, int& C) { const int st = b / 1024, sb = b % 1024, swz = sb ^ (((sb >> 9) & 1) << 5); R = (st >> 1) * 16 + swz / 64; C = (st & 1) * 32 + (swz % 64) / 2; }
DEVINL int perm32(int rho) { const int n = rho >> 4, i = rho & 15; return 8 * (i >> 2) + 4 * n + (i & 3); }
struct Unit { int pm, pn; };
struct StaticOrder {
  int nM, nN, nwg, G, c;
  DEVINL void init(int M, int N, int G_, int c_) { nM = M / BM; nN = N / BM; nwg = nM * nN; G = G_; c = c_; }
  DEVINL bool next(int i, Unit& u) const {
    const long L = (long)i * G + c; if (L >= nwg) return false;
    int wgid = (int)L; { const int q = nwg / NXCD, r = nwg % NXCD, xcd = wgid % NXCD, off = wgid / NXCD; wgid = (xcd < r ? xcd * (q + 1) : r * (q + 1) + (xcd - r) * q) + off; }
    const int nig = WGM * nN, gid = wgid / nig, fm = gid * WGM, gsz = (nM - fm) < WGM ? (nM - fm) : WGM;
    u.pm = fm + ((wgid % nig) % gsz); u.pn = (wgid % nig) / gsz; return true;
  }
};
DEVINL unsigned cvt_pk_bf16(float lo, float hi) { return cvt_pk_bf16_(lo, hi); }

template <class Epi, class ASel>
DEVINL void gemm_phase(PG8_LAS unsigned char* lds, const ASel& asel, const bf16_t* Bt, const int K, const StaticOrder& S, const Epi& E, int gwid) {
  const int tid = tidx(gwid), wid = __builtin_amdgcn_readfirstlane(tid >> 6), lane = tid & 63, wr = wid >> 2, wc = wid & 3, fr = lane & 15, fq = lane >> 4;
  const int nt = K / BK;
  unsigned voffA[2], voffB[2];
#pragma unroll
  for (int i = 0; i < 2; ++i) { int R, C; stage_rc(tid * 16 + i * 8192, R, C); const int Rb = Epi::PERM ? ((R & ~31) + perm32(R & 31)) : R;
    voffA[i] = (unsigned)(R * K + C) * 2u; voffB[i] = (unsigned)(Rb * K + C) * 2u; }
  const size_t kstep = (size_t)(BK * 2);
  const size_t hstep = (size_t)HALF * K * 2;
  const size_t tstep = 2 * hstep;
  const unsigned ldsw = (unsigned)wid * 1024u;
  const int aoff = lds_byte(wr * 64 + fr, fq * 8), boff = lds_byte(wc * 32 + fr, fq * 8);
#define PG8_SA(b, h) (((b) * 2 + (h)) * HTB)
#define PG8_SB(b, h) ((4 + (b) * 2 + (h)) * HTB)
#define PG8_STAGE(bufoff, gbase, voff) do { _Pragma("unroll") for (int _i = 0; _i < 2; ++_i) \
    __builtin_amdgcn_global_load_lds((const unsigned*)((const char*)(gbase) + (voff)[_i]), (PG8_LAS unsigned*)(lds + (bufoff) + ldsw + _i * 8192), 16, 0, 0); } while (0)
#define PG8_LDA(dst, b, h) do { _Pragma("unroll") for (int m = 0; m < 4; ++m) _Pragma("unroll") for (int k = 0; k < 2; ++k) dst[m][k] = *(const PG8_LAS bf16x8*)(lds + PG8_SA(b, h) + aoff + m * 2048 + k * 1024); } while (0)
#define PG8_LDB(dst, b, h) do { _Pragma("unroll") for (int n = 0; n < 2; ++n) _Pragma("unroll") for (int k = 0; k < 2; ++k) dst[n][k] = *(const PG8_LAS bf16x8*)(lds + PG8_SB(b, h) + boff + n * 2048 + k * 1024); } while (0)
#define PG8_MMA(ai, bj, At, Bt_) do { __builtin_amdgcn_s_setprio(1); _Pragma("unroll") for (int m = 0; m < 4; ++m) _Pragma("unroll") for (int n = 0; n < 2; ++n) _Pragma("unroll") for (int k = 0; k < 2; ++k) \
    acc[ai][bj][m][n] = __builtin_amdgcn_mfma_f32_16x16x32_bf16(Bt_[n][k], At[m][k], acc[ai][bj][m][n], 0, 0, 0); __builtin_amdgcn_s_setprio(0); } while (0)
#define PG8_WAIT_V(n) asm volatile("s_waitcnt vmcnt(" #n ")" ::: "memory")
#define PG8_WAIT_L(n) asm volatile("s_waitcnt lgkmcnt(" #n ")" ::: "memory")
#define PG8_BAR __builtin_amdgcn_s_barrier()
#define PG8_SCHED __builtin_amdgcn_sched_barrier(0)
  Unit cur, nxt; int ui = 0;
  if (!S.next(0, cur)) return;
  f32x4 acc[2][2][4][2];
#pragma unroll
  for (int a = 0; a < 2; ++a)
#pragma unroll
    for (int b = 0; b < 2; ++b)
#pragma unroll
      for (int m = 0; m < 4; ++m)
#pragma unroll
        for (int n = 0; n < 2; ++n) acc[a][b][m][n] = (f32x4){0.f, 0.f, 0.f, 0.f};
  bf16x8 At[4][2], B0[2][2], B1[2][2];
  const char* cA = asel(cur.pn) + (size_t)cur.pm * tstep; const char* cB = (const char*)Bt + (size_t)cur.pn * tstep;
  PG8_STAGE(PG8_SB(0, 0), cB, voffB); PG8_STAGE(PG8_SA(0, 0), cA, voffA); PG8_STAGE(PG8_SB(0, 1), cB + hstep, voffB); PG8_STAGE(PG8_SA(0, 1), cA + hstep, voffA);
  if (wr == 1) PG8_BAR;
  PG8_WAIT_V(4); PG8_BAR;
  PG8_STAGE(PG8_SB(1, 0), cB + kstep, voffB); PG8_STAGE(PG8_SA(1, 0), cA + kstep, voffA); PG8_STAGE(PG8_SB(1, 1), cB + hstep + kstep, voffB);
  PG8_WAIT_V(6); PG8_BAR;
  for (;;) {
    const bool has_next = S.next(ui + 1, nxt);
    const char* nA = has_next ? asel(nxt.pn) + (size_t)nxt.pm * tstep : cA; const char* nB = has_next ? (const char*)Bt + (size_t)nxt.pn * tstep : cB;
    for (int t = 0; t < nt; t += 2) {
      const bool last = (t == nt - 2);
      const char* a1 = cA + (size_t)(t + 1) * kstep;
      const char* a2 = last ? nA : cA + (size_t)(t + 2) * kstep; const char* b2 = last ? nB : cB + (size_t)(t + 2) * kstep;
      const char* a3 = a2 + kstep; const char* b3 = b2 + kstep;
      PG8_LDB(B0, 0, 0); PG8_SCHED; PG8_LDA(At, 0, 0); PG8_STAGE(PG8_SA(1, 1), a1 + hstep, voffA);
      PG8_WAIT_L(8); PG8_BAR; PG8_WAIT_L(0); PG8_MMA(0, 0, At, B0); PG8_BAR; PG8_SCHED;
      PG8_LDB(B1, 0, 1); PG8_STAGE(PG8_SB(0, 0), b2, voffB);
      PG8_BAR; PG8_WAIT_L(0); PG8_MMA(0, 1, At, B1); PG8_BAR;
      PG8_LDA(At, 0, 1); PG8_STAGE(PG8_SA(0, 0), a2, voffA);
      PG8_BAR; PG8_WAIT_L(0); PG8_MMA(1, 0, At, B0); PG8_BAR; PG8_SCHED;
      PG8_STAGE(PG8_SB(0, 1), b2 + hstep, voffB);
      PG8_WAIT_V(6); PG8_BAR; PG8_MMA(1, 1, At, B1); PG8_BAR;
      PG8_LDB(B0, 1, 0); PG8_SCHED; PG8_LDA(At, 1, 0); PG8_STAGE(PG8_SA(0, 1), a2 + hstep, voffA);
      PG8_WAIT_L(8); PG8_BAR; PG8_WAIT_L(0); PG8_MMA(0, 0, At, B0); PG8_BAR; PG8_SCHED;
      PG8_LDB(B1, 1, 1); PG8_STAGE(PG8_SB(1, 0), b3, voffB);
      PG8_BAR; PG8_WAIT_L(0); PG8_MMA(0, 1, At, B1); PG8_BAR;
      PG8_LDA(At, 1, 1); PG8_STAGE(PG8_SA(1, 0), a3, voffA);
      PG8_BAR; PG8_WAIT_L(0); PG8_MMA(1, 0, At, B0); PG8_BAR; PG8_SCHED;
      PG8_STAGE(PG8_SB(1, 1), b3 + hstep, voffB);
      PG8_WAIT_V(6); PG8_BAR; PG8_MMA(1, 1, At, B1); PG8_BAR;
    }
    E(acc, cur, wr, wc, fr, fq);
    if (!has_next) break;
#pragma unroll
    for (int a = 0; a < 2; ++a)
#pragma unroll
      for (int b = 0; b < 2; ++b)
#pragma unroll
        for (int m = 0; m < 4; ++m)
#pragma unroll
          for (int n = 0; n < 2; ++n) acc[a][b][m][n] = (f32x4){0.f, 0.f, 0.f, 0.f};
    cur = nxt; cA = nA; cB = nB; ++ui;
  }
  PG8_WAIT_V(0);
  if (wr == 0) PG8_BAR;
  PG8_BAR;
#undef PG8_SA
#undef PG8_SB
#undef PG8_STAGE
#undef PG8_LDA
#undef PG8_LDB
#undef PG8_MMA
#undef PG8_WAIT_V
#undef PG8_WAIT_L
#undef PG8_BAR
#undef PG8_SCHED
}
struct ASelOne { const char* A; DEVINL const char* operator()(int) const { return A; } };
}

DEVINL void gemm_tile_128(const bf16_t* __restrict__ A, int lda, const bf16_t* __restrict__ Bt, int ldb, int K,
                          char* smem_half, f32x4 (&acc)[4][4], int gwid) {
  const int tid = tidx(gwid) & 255, wid = tid >> 6, lane = tid & 63;
  const int wr = wid >> 1, wc = wid & 1, fr = lane & 15, fq = lane >> 4;
  char* SA = smem_half;
  char* SB = smem_half + 8192;
#pragma unroll
  for (int m = 0; m < 4; ++m)
#pragma unroll
    for (int n = 0; n < 4; ++n) acc[m][n] = (f32x4){0.f, 0.f, 0.f, 0.f};
  for (int k0 = 0; k0 < K; k0 += 32) {
#pragma unroll
    for (int i = 0; i < 2; ++i) {
      int b = tid * 16 + i * 4096;
      int r = b >> 6, c = (b & 63) >> 1;
      __builtin_amdgcn_global_load_lds((const unsigned*)(A + (size_t)r * lda + k0 + c), (unsigned*)(SA + b), 16, 0, 0);
      __builtin_amdgcn_global_load_lds((const unsigned*)(Bt + (size_t)r * ldb + k0 + c), (unsigned*)(SB + b), 16, 0, 0);
    }
    asm volatile("s_waitcnt vmcnt(0)" ::: "memory");
    __syncthreads();
    bf16x8 a[4], b[4];
#pragma unroll
    for (int m = 0; m < 4; ++m) a[m] = *reinterpret_cast<const bf16x8*>(SA + (wr * 64 + m * 16 + fr) * 64 + fq * 16);
#pragma unroll
    for (int n = 0; n < 4; ++n) b[n] = *reinterpret_cast<const bf16x8*>(SB + (wc * 64 + n * 16 + fr) * 64 + fq * 16);
#pragma unroll
    for (int m = 0; m < 4; ++m)
#pragma unroll
      for (int n = 0; n < 4; ++n) acc[m][n] = __builtin_amdgcn_mfma_f32_16x16x32_bf16(a[m], b[n], acc[m][n], 0, 0, 0);
    __syncthreads();
  }
}

#define GEMM_LANE_VARS \
  const int tid = tidx(gwid) & 255, wid = tid >> 6, lane = tid & 63; \
  const int wr = wid >> 1, wc = wid & 1, fr = lane & 15, fq = lane >> 4; \
  (void)tid; (void)wid; (void)lane; (void)wr; (void)wc; (void)fr; (void)fq;

DEVINL void get_tjob(const Params& p, int ji, const float*& src, bf16_t*& dst, int& K, int& N) {
  if (ji < 28) {
    int j = ji / 14, s = ji % 14;
    bf16_t* rw = p.rwkv_in_t + (size_t)j * RW_N * 1024;
    if (s < 3) { src = p.in[12] + ((size_t)(j * 3 + s) << 20); dst = rw + ((size_t)s << 20); K = 1024; N = 1024; }
    else if (s < 5) { int z = s - 3; src = p.in[15] + (size_t)(j * 2 + z) * 65536; dst = rw + (size_t)(3072 + z * 64) * 1024; K = 1024; N = 64; }
    else if (s < 7) { int z = s - 5; src = p.in[18] + (size_t)(j * 2 + z) * 65536; dst = rw + (size_t)(3328 + z * 64) * 1024; K = 1024; N = 64; }
    else if (s == 7) { src = p.in[20] + (size_t)j * 131072; dst = rw + (size_t)3584 * 1024; K = 1024; N = 128; }
    else if (s < 10) { int z = s - 8; src = p.in[16] + (size_t)(j * 2 + z) * 65536; dst = p.w2t + (size_t)(j * 2 + z) * 65536; K = 64; N = 1024; }
    else if (s < 12) { int z = s - 10; src = p.in[19] + (size_t)(j * 2 + z) * 65536; dst = p.a2t + (size_t)(j * 2 + z) * 65536; K = 64; N = 1024; }
    else if (s == 12) { src = p.in[21] + (size_t)j * 131072; dst = p.g2t + (size_t)j * 131072; K = 128; N = 1024; }
    else { src = p.in[13] + ((size_t)j << 20); dst = p.rwkv_wo_t + ((size_t)j << 20); K = 1024; N = 1024; }
  } else if (ji < 32) {
    int j = (ji - 28) >> 1, s = (ji - 28) & 1;
    if (s == 0) { src = p.in[27] + (size_t)j * 1024 * 1536; dst = p.attn_wqkv_t + (size_t)j * 1536 * 1024; K = 1024; N = 1536; }
    else { src = p.in[28] + ((size_t)j << 20); dst = p.attn_wo_t + ((size_t)j << 20); K = 1024; N = 1024; }
  } else {
    int i = ji - 32;
    src = p.in[31] + (size_t)i * 1024 * 2048; dst = p.wq_t + (size_t)i * 2048 * 1024; K = 1024; N = 2048;
  }
}

DEVINL void sincos_d(double x, float& c, float& s) {
  const double TWO_PI = 6.283185307179586476925;
  double r = x - TWO_PI * rint(x / TWO_PI);
  double r2 = r * r;
  double ts = r, tc = 1.0, ss = r, cs = 1.0;
#pragma unroll 1
  for (int n = 1; n <= 14; ++n) {
    tc = -tc * r2 / (double)((2 * n - 1) * (2 * n));
    ts = -ts * r2 / (double)((2 * n) * (2 * n + 1));
    cs += tc; ss += ts;
  }
  c = (float)cs; s = (float)ss;
}

DEVINL void phase_prep(const Params& p, int w, int nw, char* smem, int gwid) {
  const int tid = tidx(gwid);
  {
    float (*tile)[65] = reinterpret_cast<float (*)[65]>(smem);
    int toff = 0;
    for (int ji = 0; ji < 36; ++ji) {
      const float* src; bf16_t* dst; int K, N;
      get_tjob(p, ji, src, dst, K, N);
      const int tn = N >> 6, nt = (K >> 6) * tn;
      int t0 = (w - (toff % nw) + nw) % nw;
      for (int t = t0; t < nt; t += nw) {
        const int k0 = (t / tn) << 6, n0 = (t % tn) << 6;
#pragma unroll
        for (int i = 0; i < 2; ++i) {
          int r = (tid >> 4) + 32 * i, c = (tid & 15) * 4;
          float4 v = *reinterpret_cast<const float4*>(src + (size_t)(k0 + r) * N + n0 + c);
          tile[r][c] = v.x; tile[r][c + 1] = v.y; tile[r][c + 2] = v.z; tile[r][c + 3] = v.w;
        }
        __syncthreads();
        {
          int q = tid;
          int n = q >> 3, kc = (q & 7) * 8;
          uint4 o;
          o.x = pack2(tile[kc + 0][n], tile[kc + 1][n]);
          o.y = pack2(tile[kc + 2][n], tile[kc + 3][n]);
          o.z = pack2(tile[kc + 4][n], tile[kc + 5][n]);
          o.w = pack2(tile[kc + 6][n], tile[kc + 7][n]);
          *reinterpret_cast<uint4*>(dst + (size_t)(n0 + n) * K + k0 + kc) = o;
        }
        __syncthreads();
      }
      toff += nt;
    }
  }
  const size_t gtid = (size_t)w * NTHREADS + tid, gn = (size_t)nw * NTHREADS;
  {
    const int lane = tid & 63;
    const int gw2 = w * NWAVES + (tid >> 6), ngw2 = nw * NWAVES;
    unsigned char* u8 = reinterpret_cast<unsigned char*>(p.ub);
    unsigned char* v8 = reinterpret_cast<unsigned char*>(p.vb);
    for (int r = gw2; r < 2 * 65536; r += ngw2) {
      const bool isv = r >= 65536;
      const int row = isv ? r - 65536 : r;
      const float* srow = (isv ? p.in[34] : p.in[33]) + (size_t)row * 1024 + lane * 16;
      float x[16];
#pragma unroll
      for (int q = 0; q < 4; ++q) { const float4 v = reinterpret_cast<const float4*>(srow)[q]; x[q * 4] = v.x; x[q * 4 + 1] = v.y; x[q * 4 + 2] = v.z; x[q * 4 + 3] = v.w; }
      float mx = 0.f;
#pragma unroll
      for (int q = 0; q < 16; ++q) mx = fmaxf(mx, fabsf(x[q]));
#pragma unroll
      for (int o = 32; o > 0; o >>= 1) mx = fmaxf(mx, __shfl_xor(mx, o));
      mx = fmaxf(mx, 1e-30f);
      const float sc = 440.0f / mx;
      uint4 o4;
      unsigned* ow = reinterpret_cast<unsigned*>(&o4);
#pragma unroll
      for (int q = 0; q < 4; ++q) {
        int pk = 0;
        pk = __builtin_amdgcn_cvt_pk_fp8_f32(x[q * 4] * sc, x[q * 4 + 1] * sc, pk, false);
        pk = __builtin_amdgcn_cvt_pk_fp8_f32(x[q * 4 + 2] * sc, x[q * 4 + 3] * sc, pk, true);
        ow[q] = (unsigned)pk;
      }
      *reinterpret_cast<uint4*>((isv ? v8 : u8) + (size_t)row * 1024 + lane * 16) = o4;
      if (lane == 0) (isv ? p.vinv : p.uinv)[row] = mx * (1.0f / 440.0f);
    }
    const size_t gtid0 = (size_t)w * NTHREADS + tid, gn0 = (size_t)nw * NTHREADS;
    const size_t nk8 = (size_t)4 * 2 * 128 * 128 / 8;
    for (size_t i = gtid0; i < nk8; i += gn0) {
      const float4* su = reinterpret_cast<const float4*>(p.in[32]) + i * 2;
      float4 a = su[0], b = su[1];
      uint4 o; o.x = pack2(a.x, a.y); o.y = pack2(a.z, a.w); o.z = pack2(b.x, b.y); o.w = pack2(b.z, b.w);
      reinterpret_cast<uint4*>(p.keysb)[i] = o;
    }
  }
  {
    const size_t nk = (size_t)8 * 2 * 512 * 4 * 64;
    for (size_t i = gtid; i < nk; i += gn) {
      int d = i & 63, kvh = (i >> 6) & 3, s = (i >> 8) & 511, j = (i >> 17) & 1, b = (int)(i >> 18);
      p.Klat[((size_t)((j * 8 + b) * 4 + kvh) * 1536 + s) * 64 + d] = f2bf(p.in[4][i]);
      p.VlatT[((size_t)((j * 8 + b) * 4 + kvh) * 64 + d) * 1536 + s] = f2bf(p.in[5][i]);
    }
  }
  for (size_t i = gtid; i < 1024; i += gn) {
    int pos = (int)(i >> 4), f = (int)(i & 15);
    float c, s; sincos_d((double)pos * p.freqs[f], c, s);
    p.rope[i * 2] = c; p.rope[i * 2 + 1] = s;
  }
  {
    const size_t n4 = (size_t)TT * DM / 4, nc4 = (size_t)TCTX * DM / 4;
    for (size_t i = gtid; i < n4; i += gn) {
      float4 v = (i < nc4) ? reinterpret_cast<const float4*>(p.in[0])[i] : reinterpret_cast<const float4*>(p.in[1])[i - nc4];
      reinterpret_cast<float4*>(p.xbuf)[i] = v;
    }
  }
  {
    float* sc = reinterpret_cast<float*>(smem);
    float* red = sc + 9 * 1024;
    bool loaded = false;
    for (int item = w; item < 384; item += nw) {
      if (!loaded) {
        __syncthreads();
        for (int e = tid; e < 9 * 1024; e += NTHREADS) {
          int c = e >> 10, d = e & 1023;
          float v = (c < 8) ? p.in[2][c * 1024 + d] : p.in[6][d];
          sc[e] = v / (1.0f + __expf(-v));
        }
        __syncthreads();
        loaded = true;
      }
      const int i = item / 96, cc = item % 96;
      const int col = cc * 64 + (tid & 63), ks = tid >> 6;
      float acc[9];
#pragma unroll
      for (int c = 0; c < 9; ++c) acc[c] = 0.f;
      const float* wp = p.in[7] + (size_t)i * 1024 * 6144 + col;
      for (int d0 = ks * 128; d0 < ks * 128 + 128; d0 += 16) {
        float wv[16];
#pragma unroll
        for (int u = 0; u < 16; ++u) wv[u] = wp[(size_t)(d0 + u) * 6144];
#pragma unroll
        for (int u = 0; u < 16; ++u)
#pragma unroll
          for (int c = 0; c < 9; ++c) acc[c] += sc[c * 1024 + d0 + u] * wv[u];
      }
#pragma unroll
      for (int c = 0; c < 9; ++c) red[(ks * 9 + c) * 64 + (tid & 63)] = acc[c];
      __syncthreads();
      for (int o = tid; o < 576; o += NTHREADS) {
        int c = o >> 6, cl = o & 63;
        float s = 0.f;
#pragma unroll
        for (int k2 = 0; k2 < 8; ++k2) s += red[(k2 * 9 + c) * 64 + cl];
        int n = cc * 64 + cl;
        p.mod[((size_t)i * 9 + c) * 6144 + n] = s + p.in[8][i * 6144 + n];
      }
      __syncthreads();
    }
  }
}

DEVINL void phase_r1(const Params& p, int layer, int w, int nw, int gwid) {
  const int j = layer >> 1;
  const int lane = tidx(gwid) & 63;
  const int gw = w * NWAVES + (tidx(gwid) >> 6), ngw = nw * NWAVES;
  bf16_t* A6 = reinterpret_cast<bf16_t*>(p.U1);
  const float* mu = p.in[11] + (size_t)j * 6 * 1024;
  for (int row = gw; row < TT; row += ngw) {
    int t, Tlen;
    if (row < TCTX) { t = row & 255; Tlen = 256; } else { t = (row - TCTX) & 1023; Tlen = 1024; }
    const int cond = cond_of_row(row);
    const float* sh = p.mod + ((size_t)layer * 9 + cond) * 6144;
    const float* sc = sh + 1024;
    const bool hasp = t > 0, hasn = t < Tlen - 1;
#pragma unroll
    for (int k = 0; k < 4; ++k) {
      const int col = k * 256 + lane * 4;
      const float4 xc = *reinterpret_cast<const float4*>(p.xbuf + (size_t)row * DM + col);
      float4 xp = make_float4(0, 0, 0, 0), xn = make_float4(0, 0, 0, 0);
      if (hasp) xp = *reinterpret_cast<const float4*>(p.xbuf + (size_t)(row - 1) * DM + col);
      if (hasn) xn = *reinterpret_cast<const float4*>(p.xbuf + (size_t)(row + 1) * DM + col);
      const float4 s4 = *reinterpret_cast<const float4*>(sh + col);
      const float4 c4 = *reinterpret_cast<const float4*>(sc + col);
      float h[4], xx[4];
      const float xcv[4] = {xc.x, xc.y, xc.z, xc.w}, xpv[4] = {xp.x, xp.y, xp.z, xp.w}, xnv[4] = {xn.x, xn.y, xn.z, xn.w};
      const float shv[4] = {s4.x, s4.y, s4.z, s4.w}, scv[4] = {c4.x, c4.y, c4.z, c4.w};
#pragma unroll
      for (int e = 0; e < 4; ++e) {
        float g = 1.0f + scv[e];
        h[e] = xcv[e] * g + shv[e];
        float hp = hasp ? (xpv[e] * g + shv[e]) : 0.f;
        float hn = hasn ? (xnv[e] * g + shv[e]) : 0.f;
        xx[e] = 0.5f * (hp + hn) - h[e];
      }
#pragma unroll
      for (int m = 0; m < 6; ++m) {
        const float4 m4 = *reinterpret_cast<const float4*>(mu + m * 1024 + col);
        uint2 o;
        o.x = pack2(h[0] + xx[0] * m4.x, h[1] + xx[1] * m4.y);
        o.y = pack2(h[2] + xx[2] * m4.z, h[3] + xx[3] * m4.w);
        *reinterpret_cast<uint2*>(A6 + ((size_t)m * TT + row) * DM + col) = o;
      }
    }
  }
}

#define U1_AA_OFF ((size_t)2 * TT * DM * 4)
#define U1_GG_OFF (U1_AA_OFF + (size_t)2 * TT * DM * 2)

struct ASelR2 {
  const char* A6;
  DEVINL const char* operator()(int pn) const {
    const int idx = pn < 12 ? (pn >> 2) : (pn - 9);
    const int m = (0x541320 >> (4 * idx)) & 7;
    return A6 + (size_t)m * TT * DM * 2;
  }
};
struct EpiR2 {
  static constexpr bool PERM = true;
  bf16_t *rb, *lw;
  DEVINL void operator()(const f32x4 (&acc)[2][2][4][2], const pg8::Unit& u, int wr, int wc, int fr, int fq) const {
    const int row0 = u.pm * 256 + wr * 64 + fr;
    const int pn = u.pn;
    if (pn < 12) {
      bf16_t* dst = rb + (size_t)(pn >> 2) * TT * DM;
      const int col0 = (pn & 3) * 256 + wc * 32 + 8 * fq;
#pragma unroll
      for (int ai = 0; ai < 2; ++ai)
#pragma unroll
        for (int m = 0; m < 4; ++m) {
          bf16_t* rowp = dst + (size_t)(row0 + ai * 128 + m * 16) * DM + col0;
#pragma unroll
          for (int bj = 0; bj < 2; ++bj) {
            const f32x4 v0 = acc[ai][bj][m][0], v1 = acc[ai][bj][m][1];
            pg8::u32x4 o; o.x = pg8::cvt_pk_bf16(v0[0], v0[1]); o.y = pg8::cvt_pk_bf16(v0[2], v0[3]); o.z = pg8::cvt_pk_bf16(v1[0], v1[1]); o.w = pg8::cvt_pk_bf16(v1[2], v1[3]);
            *reinterpret_cast<pg8::u32x4*>(rowp + bj * 128) = o;
          }
        }
    } else {
      bf16_t* dst = lw + (size_t)(pn - 12) * TT * 128;
      const int col0 = wc * 32 + 8 * fq;
      const float kx = (pn == 12 ? 2.0f : 1.0f) * 1.4426950408889634f, ka = pn == 12 ? 2.0f : 1.0f, kb = pn == 12 ? -1.0f : 0.0f;
#pragma unroll
      for (int ai = 0; ai < 2; ++ai)
#pragma unroll
        for (int m = 0; m < 4; ++m) {
          f32x4 v0 = acc[ai][0][m][0], v1 = acc[ai][0][m][1];
          if (pn != 13) {
#pragma unroll
            for (int e = 0; e < 4; ++e) {
              const float s0 = __builtin_amdgcn_rcpf(1.0f + __builtin_amdgcn_exp2f(-kx * v0[e]));
              const float s1 = __builtin_amdgcn_rcpf(1.0f + __builtin_amdgcn_exp2f(-kx * v1[e]));
              v0[e] = ka * s0 + kb; v1[e] = ka * s1 + kb;
            }
          }
          asm volatile("" ::: "memory");
          pg8::u32x4 o; o.x = pg8::cvt_pk_bf16(v0[0], v0[1]); o.y = pg8::cvt_pk_bf16(v0[2], v0[3]); o.z = pg8::cvt_pk_bf16(v1[0], v1[1]); o.w = pg8::cvt_pk_bf16(v1[2], v1[3]);
          *reinterpret_cast<pg8::u32x4*>(dst + (size_t)(row0 + ai * 128 + m * 16) * 128 + col0) = o;
        }
    }
  }
};
DEVINL void phase_r2(const Params& p, int layer, int w, int nw, char* smem, int gwid) {
  const int j = layer >> 1;
  bf16_t* rb = reinterpret_cast<bf16_t*>(p.U2);
  EpiR2 E;
  E.rb = rb; E.lw = p.abuf;
  ASelR2 as; as.A6 = p.U1;
  pg8::StaticOrder S; S.init(TT, RW_N, nw, w);
  pg8::gemm_phase<EpiR2, ASelR2>((PG8_LAS unsigned char*)smem, as, p.rwkv_in_t + (size_t)j * RW_N * 1024, 1024, S, E, gwid);
}

DEVINL void phase_r3(const Params& p, int layer, int w, int nw, char* smem, int gwid) {
  const int j = layer >> 1;
  GEMM_LANE_VARS
  const int half = tidx(gwid) >> 8;
  char* sh = smem + half * 16384;
  const bf16_t* lw = p.abuf;
  const bf16_t* la = lw + (size_t)TT * 128;
  const bf16_t* lg = la + (size_t)TT * 128;
  float* wdec = reinterpret_cast<float*>(p.U1);
  bf16_t* aa = reinterpret_cast<bf16_t*>(p.U1 + U1_AA_OFF);
  bf16_t* gg = reinterpret_cast<bf16_t*>(p.U1 + U1_GG_OFF);
  const int NTILES = 96 * 40;
  for (int it = 0; it * nw * 2 < NTILES; ++it) {
    int tile = (it * nw + w) * 2 + half;
    const bool valid = tile < NTILES;
    if (!valid) tile = 0;
    const int ct = tile / 96, rt = tile % 96;
    const int job = ct >> 3, nt = ct & 7;
    const int row0 = rt * 128, col0 = nt * 128;
    f32x4 acc[4][4];
    if (job < 2) {
      const int z = job;
      gemm_tile_128(lw + (size_t)row0 * 128 + z * 64, 128, p.w2t + (size_t)(j * 2 + z) * 65536 + (size_t)col0 * 64, 64, 64, sh, acc, gwid);
      if (valid) {
        const float* w0 = p.in[14] + (size_t)(j * 2 + z) * 1024;
#pragma unroll
        for (int m = 0; m < 4; ++m)
#pragma unroll
          for (int n = 0; n < 4; ++n)
#pragma unroll
            for (int jj = 0; jj < 4; ++jj) {
              int row = row0 + wr * 64 + m * 16 + fq * 4 + jj, col = col0 + wc * 64 + n * 16 + fr;
              float wl = acc[m][n][jj] + w0[col];
              wdec[((size_t)z * TT + row) * DM + col] = __expf(-0.6065306597126334f * sigmoidf_(wl));
            }
      }
    } else if (job < 4) {
      const int z = job - 2;
      gemm_tile_128(la + (size_t)row0 * 128 + z * 64, 128, p.a2t + (size_t)(j * 2 + z) * 65536 + (size_t)col0 * 64, 64, 64, sh, acc, gwid);
      if (valid) {
        const float* a0 = p.in[17] + (size_t)(j * 2 + z) * 1024;
#pragma unroll
        for (int m = 0; m < 4; ++m)
#pragma unroll
          for (int n = 0; n < 4; ++n)
#pragma unroll
            for (int jj = 0; jj < 4; ++jj) {
              int row = row0 + wr * 64 + m * 16 + fq * 4 + jj, col = col0 + wc * 64 + n * 16 + fr;
              aa[((size_t)z * TT + row) * DM + col] = f2bf(sigmoidf_(acc[m][n][jj] + a0[col]));
            }
      }
    } else {
      gemm_tile_128(lg + (size_t)row0 * 128, 128, p.g2t + (size_t)j * 131072 + (size_t)col0 * 128, 128, 128, sh, acc, gwid);
      if (valid) {
#pragma unroll
        for (int m = 0; m < 4; ++m)
#pragma unroll
          for (int n = 0; n < 4; ++n)
#pragma unroll
            for (int jj = 0; jj < 4; ++jj) {
              int row = row0 + wr * 64 + m * 16 + fq * 4 + jj, col = col0 + wc * 64 + n * 16 + fr;
              gg[(size_t)row * DM + col] = f2bf(acc[m][n][jj]);
            }
      }
    }
  }
  {
    const int l64 = tidx(gwid) & 63;
    const int gw = w * NWAVES + (tidx(gwid) >> 6), ngw = nw * NWAVES;
    const bf16_t* kb = reinterpret_cast<const bf16_t*>(p.U2) + (size_t)TT * DM;
    bf16_t* kkb = reinterpret_cast<bf16_t*>(p.U2) + (size_t)3 * TT * DM;
    const float* k_k = p.in[22] + j * 1024;
    for (int row = gw; row < TT; row += ngw) {
#pragma unroll
      for (int k = 0; k < 4; ++k) {
        const int col = k * 256 + l64 * 4;
        const uint2 k2 = *reinterpret_cast<const uint2*>(kb + (size_t)row * DM + col);
        const float4 kk4 = *reinterpret_cast<const float4*>(k_k + col);
        float v0 = bflo(k2.x) * kk4.x, v1 = bfhi(k2.x) * kk4.y, v2 = bflo(k2.y) * kk4.z, v3 = bfhi(k2.y) * kk4.w;
        float ss = grp16_sum(v0 * v0 + v1 * v1 + v2 * v2 + v3 * v3);
        float inv = 1.0f / fmaxf(sqrtf(ss), 1e-12f);
        uint2 o; o.x = pack2(v0 * inv, v1 * inv); o.y = pack2(v2 * inv, v3 * inv);
        *reinterpret_cast<uint2*>(kkb + (size_t)row * DM + col) = o;
      }
    }
  }
}

typedef __attribute__((ext_vector_type(4))) short bf16x4;
#define R4_WAVE_LDS 36864
DEVINL unsigned short bfbits(float f) { return f2bf(f); }
DEVINL bf16x4 pack4(float a, float b, float c, float d) {
  union { bf16x4 v; unsigned u[2]; } r; r.u[0] = pack2(a, b); r.u[1] = pack2(c, d); return r.v;
}
DEVINL void phase_r4(const Params& p, int layer, int w, int nw, char* smem, int gwid) {
  const int j = layer >> 1;
  const int lane = tidx(gwid) & 63, wid = __builtin_amdgcn_readfirstlane(tidx(gwid) >> 6);
  const int fr = lane & 15, fq = lane >> 4;
  if (wid >= 3) return;
  const bf16_t* rb = reinterpret_cast<const bf16_t*>(p.U2);
  const bf16_t* kb = rb + (size_t)TT * DM;
  const bf16_t* vb = kb + (size_t)TT * DM;
  const bf16_t* kkb = vb + (size_t)TT * DM;
  const float* wdec = reinterpret_cast<const float*>(p.U1);
  const bf16_t* aa = reinterpret_cast<const bf16_t*>(p.U1 + U1_AA_OFF);
  float* yout = reinterpret_cast<float*>(p.U3);
  char* wl = smem + wid * R4_WAVE_LDS;
  bf16_t* khR = reinterpret_cast<bf16_t*>(wl);
  bf16_t* ahR = khR + 1024;
  bf16_t* qhR = ahR + 1024;
  bf16_t* rhR = qhR + 1024;
  bf16_t* qhT = rhR + 1024;
  bf16_t* AtT = qhT + 1024;
  bf16_t* KtT = AtT + 1024;
  bf16_t* vT = KtT + 1024;
  float* NfT = reinterpret_cast<float*>(vT + 1024);
  float* WCf = NfT + 256;
  bf16_t* TTl = reinterpret_cast<bf16_t*>(WCf + 64);
  bf16_t* AkqR = TTl + 256;
  bf16_t* GR = AkqR + 256;
  bf16_t* QpR = khR;
  char* rawb = wl + 20480;
  const bf16_t* rawR = reinterpret_cast<const bf16_t*>(rawb);
  const bf16_t* rawK = rawR + 1024;
  const bf16_t* rawKK = rawK + 1024;
  const bf16_t* rawA = rawKK + 1024;
  const bf16_t* rawV = rawA + 1024;
  const float* rawW = reinterpret_cast<const float*>(rawb + 10240);
  {
    const int c = w + nw * wid;
    if (c >= 768) return;
    int seq, h, z;
    if (c < 256) { seq = 16 + (c >> 5); h = (c >> 1) & 15; z = c & 1; }
    else { int cc = c - 256; seq = cc >> 5; h = (cc >> 1) & 15; z = cc & 1; }
    const int Tlen = seq < 16 ? 256 : 1024;
    const int base = seq < 16 ? seq * 256 : TCTX + (seq - 16) * 1024;
    const int colb = h * 64;
    const float kal = p.in[23][j * 1024 + colb + lane];
    f32x4 ST[4][4];
    if (seq >= 16) {
      const float* s0 = p.in[3] + ((((size_t)(seq - 16) * 2 + j) * 2 + z) * 16 + h) * 4096;
#pragma unroll
      for (int b = 0; b < 4; ++b)
#pragma unroll
        for (int nb = 0; nb < 4; ++nb) ST[b][nb] = *reinterpret_cast<const f32x4*>(s0 + (size_t)(16 * nb + fr) * 64 + 16 * b + 4 * fq);
    } else {
#pragma unroll
      for (int b = 0; b < 4; ++b)
#pragma unroll
        for (int nb = 0; nb < 4; ++nb) ST[b][nb] = (f32x4){0.f, 0.f, 0.f, 0.f};
    }
#define R4_DMA(t0_) do { \
      _Pragma("unroll") for (int i_ = 0; i_ < 2; ++i_) { \
        const int t_ = (t0_) + 8 * i_ + (lane >> 3); \
        const int row_ = base + (z == 0 ? t_ : (Tlen - 1 - t_)); \
        const size_t o_ = (size_t)row_ * DM + colb + (lane & 7) * 8; \
        __builtin_amdgcn_global_load_lds((const unsigned*)(rb + o_), (unsigned*)(rawb + i_ * 1024 + lane * 16), 16, 0, 0); \
        __builtin_amdgcn_global_load_lds((const unsigned*)(kb + o_), (unsigned*)(rawb + 2048 + i_ * 1024 + lane * 16), 16, 0, 0); \
        __builtin_amdgcn_global_load_lds((const unsigned*)(kkb + o_), (unsigned*)(rawb + 4096 + i_ * 1024 + lane * 16), 16, 0, 0); \
        __builtin_amdgcn_global_load_lds((const unsigned*)(aa + (size_t)z * TT * DM + o_), (unsigned*)(rawb + 6144 + i_ * 1024 + lane * 16), 16, 0, 0); \
        __builtin_amdgcn_global_load_lds((const unsigned*)(vb + o_), (unsigned*)(rawb + 8192 + i_ * 1024 + lane * 16), 16, 0, 0); \
      } \
      _Pragma("unroll") for (int i_ = 0; i_ < 4; ++i_) { \
        const int t_ = (t0_) + 4 * i_ + (lane >> 4); \
        const int row_ = base + (z == 0 ? t_ : (Tlen - 1 - t_)); \
        __builtin_amdgcn_global_load_lds((const unsigned*)(wdec + ((size_t)z * TT + row_) * DM + colb + (lane & 15) * 4), (unsigned*)(rawb + 10240 + i_ * 1024 + lane * 16), 16, 0, 0); \
      } } while (0)
    R4_DMA(0);
#pragma unroll 1
    for (int t0 = 0; t0 < Tlen; t0 += 16) {
      asm volatile("s_waitcnt vmcnt(0)" ::: "memory");
      __builtin_amdgcn_wave_barrier();
      {
        float wx[16];
#pragma unroll
        for (int t = 0; t < 16; ++t) wx[t] = rawW[t * 64 + lane];
        float WCl = 1.0f;
#pragma unroll
        for (int t = 0; t < 16; ++t) WCl *= wx[t];
        WCf[lane] = WCl;
        float Wc = 1.0f;
#pragma unroll
        for (int tp = 0; tp < 8; ++tp) {
          float at2[2], kt2[2], qh2[2];
          unsigned vb2[2];
#pragma unroll
          for (int u = 0; u < 2; ++u) {
            const int t = tp * 2 + u;
            const float rr = bf2f(rawR[t * 64 + lane]), kx = bf2f(rawK[t * 64 + lane]), kkx = bf2f(rawKK[t * 64 + lane]);
            const float ax = bf2f(rawA[t * 64 + lane]);
            vb2[u] = rawV[t * 64 + lane];
            const float kd = kx * (1.0f + (ax - 1.0f) * kal);
            const float kka = kkx * ax;
            const float qh = Wc * kkx;
            Wc *= wx[t];
            const float rh = Wc * rr;
            const float iw = __builtin_amdgcn_rcpf(Wc);
            const float kh = kd * iw, ah = kka * iw;
            khR[t * 64 + lane] = f2bf(kh); ahR[t * 64 + lane] = f2bf(ah);
            qhR[t * 64 + lane] = f2bf(qh); rhR[t * 64 + lane] = f2bf(rh);
            at2[u] = ah * WCl; kt2[u] = kh * WCl; qh2[u] = qh;
          }
          *reinterpret_cast<unsigned*>(AtT + lane * 16 + tp * 2) = pack2(at2[0], at2[1]);
          *reinterpret_cast<unsigned*>(KtT + lane * 16 + tp * 2) = pack2(kt2[0], kt2[1]);
          *reinterpret_cast<unsigned*>(qhT + lane * 16 + tp * 2) = pack2(qh2[0], qh2[1]);
          *reinterpret_cast<unsigned*>(vT + lane * 16 + tp * 2) = vb2[0] | (vb2[1] << 16);
        }
      }
      asm volatile("s_waitcnt lgkmcnt(0)" ::: "memory");
      if (t0 + 16 < Tlen) R4_DMA(t0 + 16);
      __builtin_amdgcn_wave_barrier();
      f32x4 Akq = {0.f, 0.f, 0.f, 0.f}, Aaq = Akq, Akr = Akq, Aar = Akq;
      {
#pragma unroll
        for (int ks = 0; ks < 2; ++ks) {
          const bf16x8 khA = *reinterpret_cast<const bf16x8*>(khR + fr * 64 + ks * 32 + fq * 8);
          const bf16x8 ahA = *reinterpret_cast<const bf16x8*>(ahR + fr * 64 + ks * 32 + fq * 8);
          const bf16x8 qhB = *reinterpret_cast<const bf16x8*>(qhR + fr * 64 + ks * 32 + fq * 8);
          const bf16x8 rhB = *reinterpret_cast<const bf16x8*>(rhR + fr * 64 + ks * 32 + fq * 8);
          Akq = __builtin_amdgcn_mfma_f32_16x16x32_bf16(khA, qhB, Akq, 0, 0, 0);
          Aaq = __builtin_amdgcn_mfma_f32_16x16x32_bf16(ahA, qhB, Aaq, 0, 0, 0);
          Akr = __builtin_amdgcn_mfma_f32_16x16x32_bf16(khA, rhB, Akr, 0, 0, 0);
          Aar = __builtin_amdgcn_mfma_f32_16x16x32_bf16(ahA, rhB, Aar, 0, 0, 0);
        }
#pragma unroll
        for (int e = 0; e < 4; ++e) {
          const int s = 4 * fq + e;
          if (!(s < fr)) { Akq[e] = 0.f; Aaq[e] = 0.f; }
          if (!(s <= fr)) { Akr[e] = 0.f; Aar[e] = 0.f; }
        }
      }
      __builtin_amdgcn_wave_barrier();
      *reinterpret_cast<f32x4*>(NfT + fr * 16 + 4 * fq) = Aaq;
#pragma unroll
      for (int e = 0; e < 4; ++e) AkqR[(4 * fq + e) * 16 + fr] = f2bf(Akq[e]);
      __builtin_amdgcn_wave_barrier();
      {
        float Tr[16];
#pragma unroll
        for (int t = 0; t < 16; ++t) {
          float acc = (fr == t) ? 1.0f : 0.0f;
#pragma unroll
          for (int x = 0; x < t; ++x) acc -= Tr[x] * NfT[t * 16 + x];
          Tr[t] = acc;
        }
        if (fq == 0) {
#pragma unroll
          for (int t = 0; t < 16; ++t) TTl[t * 16 + fr] = f2bf(Tr[t]);
        }
      }
      __builtin_amdgcn_wave_barrier();
      const bf16x4 Tb = *reinterpret_cast<const bf16x4*>(TTl + fr * 16 + fq * 4);
      f32x4 G;
      {
        const bf16x4 AkqA = *reinterpret_cast<const bf16x4*>(AkqR + fr * 16 + fq * 4);
        G = __builtin_amdgcn_mfma_f32_16x16x16bf16_1k(AkqA, Tb, (f32x4){0.f, 0.f, 0.f, 0.f}, 0, 0, 0);
#pragma unroll
        for (int b = 0; b < 4; ++b) {
          const bf16x4 qa = *reinterpret_cast<const bf16x4*>(qhT + (16 * b + fr) * 16 + fq * 4);
          const f32x4 qp = __builtin_amdgcn_mfma_f32_16x16x16bf16_1k(qa, Tb, (f32x4){0.f, 0.f, 0.f, 0.f}, 0, 0, 0);
          *reinterpret_cast<bf16x4*>(QpR + fr * 64 + 16 * b + 4 * fq) = pack4(qp[0], qp[1], qp[2], qp[3]);
        }
#pragma unroll
        for (int e = 0; e < 4; ++e) GR[(4 * fq + e) * 16 + fr] = f2bf(G[e]);
      }
      __builtin_amdgcn_wave_barrier();
      f32x4 H, Zb[4];
      {
        const bf16x4 GA = *reinterpret_cast<const bf16x4*>(GR + fr * 16 + fq * 4);
        const bf16x4 AarB = pack4(Aar[0], Aar[1], Aar[2], Aar[3]);
        const f32x4 hm = __builtin_amdgcn_mfma_f32_16x16x16bf16_1k(GA, AarB, (f32x4){0.f, 0.f, 0.f, 0.f}, 0, 0, 0);
        H = Akr - hm;
#pragma unroll
        for (int b = 0; b < 4; ++b) {
          const bf16x4 AtB = *reinterpret_cast<const bf16x4*>(AtT + (16 * b + fr) * 16 + fq * 4);
          const f32x4 zm = __builtin_amdgcn_mfma_f32_16x16x16bf16_1k(GA, AtB, (f32x4){0.f, 0.f, 0.f, 0.f}, 0, 0, 0);
          const bf16x4 ktv = *reinterpret_cast<const bf16x4*>(KtT + (16 * b + fr) * 16 + fq * 4);
          union { bf16x4 v; unsigned short s[4]; } ku; ku.v = ktv;
          Zb[b][0] = bf2f(ku.s[0]) - zm[0]; Zb[b][1] = bf2f(ku.s[1]) - zm[1]; Zb[b][2] = bf2f(ku.s[2]) - zm[2]; Zb[b][3] = bf2f(ku.s[3]) - zm[3];
        }
      }
      bf16x8 QpA[2], rhA[2], AY, AS[4];
      {
#pragma unroll
        for (int ks = 0; ks < 2; ++ks) {
          union { bf16x8 v; bf16x4 h[2]; } u1, u2;
          u1.h[0] = *reinterpret_cast<const bf16x4*>(QpR + fr * 64 + 32 * ks + 4 * fq);
          u1.h[1] = *reinterpret_cast<const bf16x4*>(QpR + fr * 64 + 32 * ks + 16 + 4 * fq);
          u2.h[0] = *reinterpret_cast<const bf16x4*>(rhR + fr * 64 + 32 * ks + 4 * fq);
          u2.h[1] = *reinterpret_cast<const bf16x4*>(rhR + fr * 64 + 32 * ks + 16 + 4 * fq);
          QpA[ks] = u1.v; rhA[ks] = u2.v;
        }
        {
          union { bf16x8 v; bf16x4 h[2]; } u;
          u.h[0] = pack4(Aar[0], Aar[1], Aar[2], Aar[3]); u.h[1] = pack4(H[0], H[1], H[2], H[3]);
          AY = u.v;
        }
#pragma unroll
        for (int b = 0; b < 4; ++b) {
          union { bf16x8 v; bf16x4 h[2]; } u;
          u.h[0] = *reinterpret_cast<const bf16x4*>(AtT + (16 * b + fr) * 16 + fq * 4);
          u.h[1] = pack4(Zb[b][0], Zb[b][1], Zb[b][2], Zb[b][3]);
          AS[b] = u.v;
        }
      }
#pragma unroll
      for (int nb = 0; nb < 4; ++nb) {
        bf16x8 Bhi[2];
#pragma unroll
        for (int ks = 0; ks < 2; ++ks) {
          union { bf16x8 v; unsigned u[4]; } hi;
          hi.u[0] = pack2(ST[2 * ks][nb][0], ST[2 * ks][nb][1]); hi.u[1] = pack2(ST[2 * ks][nb][2], ST[2 * ks][nb][3]);
          hi.u[2] = pack2(ST[2 * ks + 1][nb][0], ST[2 * ks + 1][nb][1]); hi.u[3] = pack2(ST[2 * ks + 1][nb][2], ST[2 * ks + 1][nb][3]);
          Bhi[ks] = hi.v;
        }
        f32x4 P = {0.f, 0.f, 0.f, 0.f}, R = {0.f, 0.f, 0.f, 0.f};
        P = __builtin_amdgcn_mfma_f32_16x16x32_bf16(QpA[0], Bhi[0], P, 0, 0, 0);
        P = __builtin_amdgcn_mfma_f32_16x16x32_bf16(QpA[1], Bhi[1], P, 0, 0, 0);
        R = __builtin_amdgcn_mfma_f32_16x16x32_bf16(rhA[0], Bhi[0], R, 0, 0, 0);
        R = __builtin_amdgcn_mfma_f32_16x16x32_bf16(rhA[1], Bhi[1], R, 0, 0, 0);
        bf16x8 X;
        {
          union { bf16x8 v; bf16x4 h[2]; } u;
          u.h[0] = pack4(-P[0], -P[1], -P[2], -P[3]);
          u.h[1] = *reinterpret_cast<const bf16x4*>(vT + (16 * nb + fr) * 16 + fq * 4);
          X = u.v;
        }
        const f32x4 Y = __builtin_amdgcn_mfma_f32_16x16x32_bf16(AY, X, R, 0, 0, 0);
#pragma unroll
        for (int e = 0; e < 4; ++e) {
          const int t = t0 + 4 * fq + e;
          const int row = base + (z == 0 ? t : (Tlen - 1 - t));
          yout[((size_t)z * TT + row) * DM + colb + 16 * nb + fr] = Y[e];
        }
#pragma unroll
        for (int b = 0; b < 4; ++b) {
          const f32x4 wcv = *reinterpret_cast<const f32x4*>(WCf + 16 * b + 4 * fq);
          ST[b][nb] = __builtin_amdgcn_mfma_f32_16x16x32_bf16(AS[b], X, ST[b][nb] * wcv, 0, 0, 0);
        }
        __builtin_amdgcn_sched_barrier(0);
      }
    }
    if (seq < 16) {
      const int l2 = tidx(gwid) & 63, fr2 = l2 & 15, fq2 = l2 >> 4;
      float* so = p.out + OUT_STATE + ((((size_t)seq * 2 + j) * 2 + z) * 16 + h) * 4096;
#pragma unroll
      for (int b = 0; b < 4; ++b)
#pragma unroll
        for (int nb = 0; nb < 4; ++nb) *reinterpret_cast<f32x4*>(so + (size_t)(16 * nb + fr2) * 64 + 16 * b + 4 * fq2) = ST[b][nb];
    }
  }
}

DEVINL void phase_r5(const Params& p, int layer, int w, int nw, int gwid) {
  const int j = layer >> 1;
  const int lane = tidx(gwid) & 63;
  const int gw = w * NWAVES + (tidx(gwid) >> 6), ngw = nw * NWAVES;
  const bf16_t* rb = reinterpret_cast<const bf16_t*>(p.U2);
  const bf16_t* kb = rb + (size_t)TT * DM;
  const bf16_t* vb = kb + (size_t)TT * DM;
  const bf16_t* aa = reinterpret_cast<const bf16_t*>(p.U1 + U1_AA_OFF);
  const bf16_t* gg = reinterpret_cast<const bf16_t*>(p.U1 + U1_GG_OFF);
  const float* yin = reinterpret_cast<const float*>(p.U3);
  const float* ka = p.in[23] + j * 1024;
  const float* rk = p.in[24] + j * 1024;
  const float* lg = p.in[25] + j * 1024;
  const float* lb = p.in[26] + j * 1024;
  for (int row = gw; row < TT; row += ngw) {
#pragma unroll
    for (int k = 0; k < 4; ++k) {
      const int col = k * 256 + lane * 4;
      const size_t o = (size_t)row * DM + col;
      const float4 yf = *reinterpret_cast<const float4*>(yin + o);
      const float4 yb = *reinterpret_cast<const float4*>(yin + (size_t)TT * DM + o);
      const uint2 r2 = *reinterpret_cast<const uint2*>(rb + o);
      const uint2 k2 = *reinterpret_cast<const uint2*>(kb + o);
      const uint2 v2 = *reinterpret_cast<const uint2*>(vb + o);
      const uint2 a02 = *reinterpret_cast<const uint2*>(aa + o);
      const uint2 a12 = *reinterpret_cast<const uint2*>(aa + (size_t)TT * DM + o);
      const uint2 g2 = *reinterpret_cast<const uint2*>(gg + o);
      const float4 ka4 = *reinterpret_cast<const float4*>(ka + col);
      const float4 rk4 = *reinterpret_cast<const float4*>(rk + col);
      const float4 lg4 = *reinterpret_cast<const float4*>(lg + col);
      const float4 lb4 = *reinterpret_cast<const float4*>(lb + col);
      float y[4] = {yf.x + yb.x, yf.y + yb.y, yf.z + yb.z, yf.w + yb.w};
      float r[4] = {bflo(r2.x), bfhi(r2.x), bflo(r2.y), bfhi(r2.y)};
      float kx[4] = {bflo(k2.x), bfhi(k2.x), bflo(k2.y), bfhi(k2.y)};
      float v[4] = {bflo(v2.x), bfhi(v2.x), bflo(v2.y), bfhi(v2.y)};
      float a0[4] = {bflo(a02.x), bfhi(a02.x), bflo(a02.y), bfhi(a02.y)};
      float a1[4] = {bflo(a12.x), bfhi(a12.x), bflo(a12.y), bfhi(a12.y)};
      float g[4] = {bflo(g2.x), bfhi(g2.x), bflo(g2.y), bfhi(g2.y)};
      float kav[4] = {ka4.x, ka4.y, ka4.z, ka4.w}, rkv[4] = {rk4.x, rk4.y, rk4.z, rk4.w};
      float lgv[4] = {lg4.x, lg4.y, lg4.z, lg4.w}, lbv[4] = {lb4.x, lb4.y, lb4.z, lb4.w};
      float sm = y[0] + y[1] + y[2] + y[3];
      sm = grp16_sum(sm);
      const float mean = sm * (1.0f / 64.0f);
      float sv = 0.f, sb = 0.f;
#pragma unroll
      for (int e = 0; e < 4; ++e) {
        float d = y[e] - mean; sv += d * d;
        float kd0 = kx[e] * (1.0f + (a0[e] - 1.0f) * kav[e]);
        float kd1 = kx[e] * (1.0f + (a1[e] - 1.0f) * kav[e]);
        sb += r[e] * (kd0 + kd1) * rkv[e];
      }
      sv = grp16_sum(sv); sb = grp16_sum(sb);
      const float rstd = rsqrtf(sv * (1.0f / 64.0f) + GN_EPS_F);
      float o4[4];
#pragma unroll
      for (int e = 0; e < 4; ++e) {
        float yn = (y[e] - mean) * rstd * lgv[e] + lbv[e];
        o4[e] = (yn + sb * v[e]) * g[e];
      }
      uint2 oo; oo.x = pack2(o4[0], o4[1]); oo.y = pack2(o4[2], o4[3]);
      *reinterpret_cast<uint2*>(p.abuf + o) = oo;
    }
  }
}

struct EpiWO {
  static constexpr bool PERM = false;
  const float* x; const float* mod; float* z; int layer;
  DEVINL void operator()(const f32x4 (&acc)[2][2][4][2], const pg8::Unit& u, int wr, int wc, int fr, int fq) const {
    const int row0 = u.pm * 256 + wr * 64 + fr, col0 = u.pn * 256 + wc * 32 + 4 * fq;
    const float* gate = mod + ((size_t)layer * 9 + cond_of_row(u.pm * 256)) * 6144 + 2 * 1024;
    f32x4 gv[2][2];
#pragma unroll
    for (int bj = 0; bj < 2; ++bj)
#pragma unroll
      for (int n = 0; n < 2; ++n) gv[bj][n] = *reinterpret_cast<const f32x4*>(gate + col0 + bj * 128 + n * 16);
#pragma unroll
    for (int ai = 0; ai < 2; ++ai)
#pragma unroll
      for (int m = 0; m < 4; ++m) {
        const size_t off = (size_t)(row0 + ai * 128 + m * 16) * DM + col0;
#pragma unroll
        for (int bj = 0; bj < 2; ++bj)
#pragma unroll
          for (int n = 0; n < 2; ++n) {
            const f32x4 xv = *reinterpret_cast<const f32x4*>(x + off + bj * 128 + n * 16);
            *reinterpret_cast<f32x4*>(z + off + bj * 128 + n * 16) = ALPHA_F * xv + gv[bj][n] * acc[ai][bj][m][n];
          }
        asm volatile("" ::: "memory");
      }
  }
};
DEVINL void phase_wo(const Params& p, int layer, int w, int nw, char* smem, int gwid) {
  const int j = layer >> 1;
  const bf16_t* Wt = ((layer & 1) ? p.attn_wo_t : p.rwkv_wo_t) + ((size_t)j << 20);
  EpiWO E; E.x = p.xbuf; E.mod = p.mod; E.z = p.zbuf; E.layer = layer;
  pg8::ASelOne as; as.A = (const char*)p.abuf;
  pg8::StaticOrder S; S.init(TT, 1024, nw, w);
  pg8::gemm_phase<EpiWO, pg8::ASelOne>((PG8_LAS unsigned char*)smem, as, Wt, 1024, S, E, gwid);
}

DEVINL void phase_ln1(const Params& p, int layer, int w, int nw, int gwid) {
  const int lane = tidx(gwid) & 63;
  const int gw = w * NWAVES + (tidx(gwid) >> 6), ngw = nw * NWAVES;
  const float* lng = p.in[9] + (size_t)(layer * 2 + 0) * 1024;
  const float* lnb = p.in[10] + (size_t)(layer * 2 + 0) * 1024;
  for (int row = gw; row < TT; row += ngw) {
    const float* md = p.mod + ((size_t)layer * 9 + cond_of_row(row)) * 6144;
    float4 z[4];
    float s = 0.f;
#pragma unroll
    for (int k = 0; k < 4; ++k) {
      z[k] = *reinterpret_cast<const float4*>(p.zbuf + (size_t)row * DM + k * 256 + lane * 4);
      s += z[k].x + z[k].y + z[k].z + z[k].w;
    }
    const float mean = wave_sum(s) * (1.0f / 1024.0f);
    float sv = 0.f;
#pragma unroll
    for (int k = 0; k < 4; ++k) {
      float a = z[k].x - mean, b = z[k].y - mean, c = z[k].z - mean, d = z[k].w - mean;
      sv += a * a + b * b + c * c + d * d;
    }
    const float rstd = rsqrtf(wave_sum(sv) * (1.0f / 1024.0f) + LN_EPS_F);
#pragma unroll
    for (int k = 0; k < 4; ++k) {
      const int col = k * 256 + lane * 4;
      const float4 g4 = *reinterpret_cast<const float4*>(lng + col);
      const float4 b4 = *reinterpret_cast<const float4*>(lnb + col);
      const float4 sh = *reinterpret_cast<const float4*>(md + 3 * 1024 + col);
      const float4 sc = *reinterpret_cast<const float4*>(md + 4 * 1024 + col);
      float4 x1;
      x1.x = (z[k].x - mean) * rstd * g4.x + b4.x;
      x1.y = (z[k].y - mean) * rstd * g4.y + b4.y;
      x1.z = (z[k].z - mean) * rstd * g4.z + b4.z;
      x1.w = (z[k].w - mean) * rstd * g4.w + b4.w;
      *reinterpret_cast<float4*>(p.xbuf + (size_t)row * DM + col) = x1;
      uint2 o;
      o.x = pack2(x1.x * (1.0f + sc.x) + sh.x, x1.y * (1.0f + sc.y) + sh.y);
      o.y = pack2(x1.z * (1.0f + sc.z) + sh.z, x1.w * (1.0f + sc.w) + sh.w);
      *reinterpret_cast<uint2*>(p.hbuf + (size_t)row * DM + col) = o;
    }
  }
}

struct EpiBf16 {
  static constexpr bool PERM = true;
  bf16_t* O; int ldc;
  DEVINL void operator()(const f32x4 (&acc)[2][2][4][2], const pg8::Unit& u, int wr, int wc, int fr, int fq) const {
    const int row0 = u.pm * 256 + wr * 64 + fr, col0 = u.pn * 256 + wc * 32 + 8 * fq;
#pragma unroll
    for (int ai = 0; ai < 2; ++ai)
#pragma unroll
      for (int m = 0; m < 4; ++m) {
        bf16_t* rowp = O + (size_t)(row0 + ai * 128 + m * 16) * ldc + col0;
#pragma unroll
        for (int bj = 0; bj < 2; ++bj) {
          const f32x4 v0 = acc[ai][bj][m][0], v1 = acc[ai][bj][m][1];
          pg8::u32x4 o; o.x = pg8::cvt_pk_bf16(v0[0], v0[1]); o.y = pg8::cvt_pk_bf16(v0[2], v0[3]); o.z = pg8::cvt_pk_bf16(v1[0], v1[1]); o.w = pg8::cvt_pk_bf16(v1[2], v1[3]);
          *reinterpret_cast<pg8::u32x4*>(rowp + bj * 128) = o;
        }
      }
  }
};

DEVINL void phase_p1(const Params& p, int layer, int w, int nw, char* smem, int gwid) {
  EpiBf16 E; E.O = reinterpret_cast<bf16_t*>(p.U1); E.ldc = 2048;
  pg8::ASelOne as; as.A = (const char*)p.hbuf;
  pg8::StaticOrder S; S.init(TT, 2048, nw, w);
  pg8::gemm_phase<EpiBf16, pg8::ASelOne>((PG8_LAS unsigned char*)smem, as, p.wq_t + (size_t)layer * 2048 * 1024, 1024, S, E, gwid);
}

#define U1_S_OFF ((size_t)TT * 2048 * 2)
DEVINL void phase_p2(const Params& p, int layer, int w, int nw, char* smem, int gwid) {
  GEMM_LANE_VARS
  const int half = tidx(gwid) >> 8;
  char* sh = smem + half * 16384;
  const bf16_t* qb = reinterpret_cast<const bf16_t*>(p.U1);
  float* sb = reinterpret_cast<float*>(p.U1 + U1_S_OFF);
  const int NTILES = 96 * 16;
  for (int it = 0; it * nw * 2 < NTILES; ++it) {
    int tile = (it * nw + w) * 2 + half;
    const bool valid = tile < NTILES;
    if (!valid) tile = 0;
    const int ct = tile / 96, rt = tile % 96;
    const int row0 = rt * 128;
    const int z = ct & 1;
    f32x4 acc[4][4];
    gemm_tile_128(qb + (size_t)row0 * 2048 + ct * 128, 2048, p.keysb + (size_t)(layer * 2 + z) * 16384, 128, 128, sh, acc, gwid);
    if (valid) {
#pragma unroll
      for (int m = 0; m < 4; ++m)
#pragma unroll
        for (int n = 0; n < 4; ++n)
#pragma unroll
          for (int jj = 0; jj < 4; ++jj) {
            int row = row0 + wr * 64 + m * 16 + fq * 4 + jj, col = wc * 64 + n * 16 + fr;
            sb[(size_t)row * 2048 + ct * 128 + col] = acc[m][n][jj];
          }
    }
  }
}

#define DPP_QP_1032 0xB1
#define DPP_QP_2301 0x4E
#define DPP_ROW_HALF_MIRROR 0x141
#define DPP_ROW_MIRROR 0x140
DEVINL unsigned umax_(unsigned a, unsigned b) { return a > b ? a : b; }
DEVINL unsigned umin_(unsigned a, unsigned b) { return a < b ? a : b; }
DEVINL unsigned row_max_u(unsigned v) {
  v = umax_(v, (unsigned)__builtin_amdgcn_update_dpp(0, (int)v, DPP_QP_1032, 0xf, 0xf, true));
  v = umax_(v, (unsigned)__builtin_amdgcn_update_dpp(0, (int)v, DPP_QP_2301, 0xf, 0xf, true));
  v = umax_(v, (unsigned)__builtin_amdgcn_update_dpp(0, (int)v, DPP_ROW_HALF_MIRROR, 0xf, 0xf, true));
  v = umax_(v, (unsigned)__builtin_amdgcn_update_dpp(0, (int)v, DPP_ROW_MIRROR, 0xf, 0xf, true));
  return v;
}
DEVINL float row_max_f(float v) {
  v = fmaxf(v, __int_as_float(__builtin_amdgcn_update_dpp(0, __float_as_int(v), DPP_QP_1032, 0xf, 0xf, true)));
  v = fmaxf(v, __int_as_float(__builtin_amdgcn_update_dpp(0, __float_as_int(v), DPP_QP_2301, 0xf, 0xf, true)));
  v = fmaxf(v, __int_as_float(__builtin_amdgcn_update_dpp(0, __float_as_int(v), DPP_ROW_HALF_MIRROR, 0xf, 0xf, true)));
  v = fmaxf(v, __int_as_float(__builtin_amdgcn_update_dpp(0, __float_as_int(v), DPP_ROW_MIRROR, 0xf, 0xf, true)));
  return v;
}
DEVINL float row_sum_f(float v) {
  v += __int_as_float(__builtin_amdgcn_update_dpp(0, __float_as_int(v), DPP_QP_1032, 0xf, 0xf, true));
  v += __int_as_float(__builtin_amdgcn_update_dpp(0, __float_as_int(v), DPP_QP_2301, 0xf, 0xf, true));
  v += __int_as_float(__builtin_amdgcn_update_dpp(0, __float_as_int(v), DPP_ROW_HALF_MIRROR, 0xf, 0xf, true));
  v += __int_as_float(__builtin_amdgcn_update_dpp(0, __float_as_int(v), DPP_ROW_MIRROR, 0xf, 0xf, true));
  return v;
}
DEVINL float unordf(unsigned u) { return __uint_as_float((u & 0x80000000u) ? (u ^ 0x80000000u) : ~u); }
#define CSWAP(a, b) { const unsigned _hi = umax_(a, b), _lo = umin_(a, b); a = _hi; b = _lo; }
DEVINL void slot_ij(int s, int& i, int& j) {
  if (s < 16) { i = 0; j = s; }
  else if (s < 24) { i = 1; j = s - 16; }
  else if (s < 29) { i = 2; j = s - 24; }
  else if (s < 33) { i = 3; j = s - 29; }
  else if (s < 36) { i = 4; j = s - 33; }
  else if (s < 42) { i = 5 + ((s - 36) >> 1); j = (s - 36) & 1; }
  else { i = s - 34; j = 0; }
}
DEVINL void phase_p3(const Params& p, int layer, int w, int nw, char* smem, int gwid) {
  const int lane = tidx(gwid) & 63, wid = tidx(gwid) >> 6;
  const int fr = lane & 15, row = lane >> 4, pr = lane >> 5, l32 = lane & 31;
  const int gw = w * NWAVES + wid, ngw = nw * NWAVES;
  const float* sb = reinterpret_cast<const float*>(p.U1 + U1_S_OFF);
  float* svl = reinterpret_cast<float*>(smem) + wid * 128;
  int* sil = reinterpret_cast<int*>(smem) + wid * 128 + 64;
  int iA, jA, iB, jB;
  slot_ij(l32, iA, jA);
  const bool validB = (l32 + 32) < 50;
  slot_ij(validB ? (l32 + 32) : 0, iB, jB);
  for (int bt = gw; bt < TT * 4; bt += ngw) {
    const int t = bt >> 2, hp = bt & 3;
    {
      const int h = hp * 2 + (row >> 1), z = row & 1;
      const float* sp = sb + (size_t)t * 2048 + (h * 2 + z) * 128;
      const float4 a = *reinterpret_cast<const float4*>(sp + fr * 4);
      const float4 b = *reinterpret_cast<const float4*>(sp + 64 + fr * 4);
      unsigned k0 = (ordf(a.x) & ~127u) | (unsigned)(127 - (4 * fr + 0));
      unsigned k1 = (ordf(a.y) & ~127u) | (unsigned)(127 - (4 * fr + 1));
      unsigned k2 = (ordf(a.z) & ~127u) | (unsigned)(127 - (4 * fr + 2));
      unsigned k3 = (ordf(a.w) & ~127u) | (unsigned)(127 - (4 * fr + 3));
      unsigned k4 = (ordf(b.x) & ~127u) | (unsigned)(127 - (64 + 4 * fr + 0));
      unsigned k5 = (ordf(b.y) & ~127u) | (unsigned)(127 - (64 + 4 * fr + 1));
      unsigned k6 = (ordf(b.z) & ~127u) | (unsigned)(127 - (64 + 4 * fr + 2));
      unsigned k7 = (ordf(b.w) & ~127u) | (unsigned)(127 - (64 + 4 * fr + 3));
      CSWAP(k0, k1); CSWAP(k2, k3); CSWAP(k4, k5); CSWAP(k6, k7);
      CSWAP(k0, k2); CSWAP(k1, k3); CSWAP(k4, k6); CSWAP(k5, k7);
      CSWAP(k1, k2); CSWAP(k5, k6); CSWAP(k0, k4); CSWAP(k3, k7);
      CSWAP(k1, k5); CSWAP(k2, k6);
      CSWAP(k1, k4); CSWAP(k3, k6);
      CSWAP(k2, k4); CSWAP(k3, k5);
      CSWAP(k3, k4);
      unsigned mine = 0;
#pragma unroll
      for (int it = 0; it < 16; ++it) {
        const unsigned m = row_max_u(k0);
        if (fr == it) mine = m;
        const bool c = (k0 == m);
        k0 = c ? k1 : k0; k1 = c ? k2 : k1; k2 = c ? k3 : k2; k3 = c ? k4 : k3;
        k4 = c ? k5 : k4; k5 = c ? k6 : k5; k6 = c ? k7 : k6; k7 = c ? 0u : k7;
      }
      __builtin_amdgcn_wave_barrier();
      svl[row * 16 + fr] = unordf(mine & ~127u);
      sil[row * 16 + fr] = 127 - (int)(mine & 127u);
      __builtin_amdgcn_wave_barrier();
    }
    {
      const float* v0 = svl + (2 * pr) * 16;
      const float* v1 = svl + (2 * pr + 1) * 16;
      unsigned kA = (ordf(v0[iA] + v1[jA]) & ~63u) | (unsigned)(63 - l32);
      unsigned kB = validB ? ((ordf(v0[iB] + v1[jB]) & ~63u) | (unsigned)(63 - (l32 + 32))) : 0u;
      unsigned mine = 0;
#pragma unroll
      for (int it = 0; it < 16; ++it) {
        unsigned m = row_max_u(umax_(kA, kB));
        m = umax_(m, (unsigned)__shfl_xor((int)m, 16));
        if (l32 == it) mine = m;
        kA = (kA == m) ? 0u : kA;
        kB = (kB == m) ? 0u : kB;
      }
      int ii, jj;
      slot_ij(63 - (int)(mine & 63u), ii, jj);
      ii &= 15; jj &= 15;
      const float cv = v0[ii] + v1[jj];
      const int eidx = sil[(2 * pr) * 16 + ii] * 128 + sil[(2 * pr + 1) * 16 + jj];
      const float mx = row_max_f(cv);
      const float ex = __expf(cv - mx);
      const float sm = row_sum_f(ex);
      if (l32 < 16) {
        const int h = hp * 2 + pr;
        p.pidx[(size_t)t * 128 + h * 16 + l32] = eidx;
        p.pgate[(size_t)t * 128 + h * 16 + l32] = ex / sm;
      }
    }
  }
}

DEVINL float gelu_exact(float x) { return 0.5f * x * (1.0f + erff(x * 0.7071067811865476f)); }

DEVINL void phase_p4(const Params& p, int layer, int w, int nw, char* smem, int gwid) {
  const int tid = tidx(gwid), lane = tid & 63, wid = tid >> 6;
  const int fr = lane & 15, fq = lane >> 4;
  const int gw = w * NWAVES + wid, ngw = nw * NWAVES;
  const unsigned char* U = reinterpret_cast<const unsigned char*>(p.ub) + (size_t)layer * 16384 * 1024;
  const unsigned char* V = reinterpret_cast<const unsigned char*>(p.vb) + (size_t)layer * 16384 * 1024;
  const float* uinv = p.uinv + layer * 16384;
  const float* vinv = p.vinv + layer * 16384;
  const float* lng = p.in[9] + (size_t)(layer * 2 + 1) * 1024;
  const float* lnb = p.in[10] + (size_t)(layer * 2 + 1) * 1024;
  float* xout = (layer == 3) ? p.out : p.xbuf;
  char* wl = smem + wid * (3072 + 16384);
  unsigned char* ring = reinterpret_cast<unsigned char*>(wl) + 3072;
  unsigned char* xhi = reinterpret_cast<unsigned char*>(wl);
  unsigned char* xlo = xhi + 1024;
  float* wgt = reinterpret_cast<float*>(wl + 2048);
  int* il = reinterpret_cast<int*>(wl + 2560);
  for (int t = gw; t < TT; t += ngw) {
    __builtin_amdgcn_wave_barrier();
    const int gl = tidx(gwid) & 63;
    float xinv;
    {
      const uint4 a = *reinterpret_cast<const uint4*>(p.hbuf + (size_t)t * DM + gl * 16);
      const uint4 b = *reinterpret_cast<const uint4*>(p.hbuf + (size_t)t * DM + gl * 16 + 8);
      float x[16];
      x[0] = bflo(a.x); x[1] = bfhi(a.x); x[2] = bflo(a.y); x[3] = bfhi(a.y); x[4] = bflo(a.z); x[5] = bfhi(a.z); x[6] = bflo(a.w); x[7] = bfhi(a.w);
      x[8] = bflo(b.x); x[9] = bfhi(b.x); x[10] = bflo(b.y); x[11] = bfhi(b.y); x[12] = bflo(b.z); x[13] = bfhi(b.z); x[14] = bflo(b.w); x[15] = bfhi(b.w);
      float mx = 0.f;
#pragma unroll
      for (int q = 0; q < 16; ++q) mx = fmaxf(mx, fabsf(x[q]));
#pragma unroll
      for (int o = 32; o > 0; o >>= 1) mx = fmaxf(mx, __shfl_xor(mx, o));
      mx = fmaxf(mx, 1e-30f);
      const float sc = 440.0f / mx;
      xinv = mx * (1.0f / 440.0f);
      uint4 h4, l4;
      unsigned* hw = reinterpret_cast<unsigned*>(&h4);
      unsigned* lw = reinterpret_cast<unsigned*>(&l4);
#pragma unroll
      for (int q = 0; q < 4; ++q) {
        const float y0 = x[q * 4] * sc, y1 = x[q * 4 + 1] * sc, y2 = x[q * 4 + 2] * sc, y3 = x[q * 4 + 3] * sc;
        int pk = 0;
        pk = __builtin_amdgcn_cvt_pk_fp8_f32(y0, y1, pk, false);
        pk = __builtin_amdgcn_cvt_pk_fp8_f32(y2, y3, pk, true);
        const float r0 = y0 - __builtin_amdgcn_cvt_f32_fp8(pk, 0), r1 = y1 - __builtin_amdgcn_cvt_f32_fp8(pk, 1);
        const float r2 = y2 - __builtin_amdgcn_cvt_f32_fp8(pk, 2), r3 = y3 - __builtin_amdgcn_cvt_f32_fp8(pk, 3);
        int pl = 0;
        pl = __builtin_amdgcn_cvt_pk_fp8_f32(r0, r1, pl, false);
        pl = __builtin_amdgcn_cvt_pk_fp8_f32(r2, r3, pl, true);
        hw[q] = (unsigned)pk; lw[q] = (unsigned)pl;
      }
      *reinterpret_cast<uint4*>(xhi + lane * 16) = h4;
      *reinterpret_cast<uint4*>(xlo + lane * 16) = l4;
      il[lane] = p.pidx[(size_t)t * 128 + gl];
      il[64 + lane] = p.pidx[(size_t)t * 128 + 64 + gl];
    }
    __builtin_amdgcn_wave_barrier();
    f32x4 acc[8];
#pragma unroll
    for (int g = 0; g < 8; ++g) acc[g] = (f32x4){0.f, 0.f, 0.f, 0.f};
    {
      const int dr = lane >> 3, dpc = (lane & 7) ^ (lane >> 3);
      unsigned rowoff[8][2];
#pragma unroll
      for (int g = 0; g < 8; ++g) {
        rowoff[g][0] = (unsigned)il[g * 16 + dr] * 1024u + (unsigned)dpc * 16u;
        rowoff[g][1] = (unsigned)il[g * 16 + 8 + dr] * 1024u + (unsigned)dpc * 16u;
      }
      const int rd0 = fr * 128 + ((fq ^ (fr & 7)) * 16), rd1 = fr * 128 + (((4 + fq) ^ (fr & 7)) * 16);
#define P4_ISSUE(tile_c, tile_g, slot) do { \
        __builtin_amdgcn_global_load_lds((const unsigned*)(U + (rowoff[tile_g][0] + (unsigned)((tile_c) * 128))), (unsigned*)(ring + (slot) * 2048 + lane * 16), 16, 0, 0); \
        __builtin_amdgcn_global_load_lds((const unsigned*)(U + (rowoff[tile_g][1] + (unsigned)((tile_c) * 128))), (unsigned*)(ring + (slot) * 2048 + 1024 + lane * 16), 16, 0, 0); } while (0)
#pragma unroll
      for (int g = 0; g < 8; ++g) P4_ISSUE(0, g, g);
#pragma unroll 1
      for (int c = 0; c < 8; ++c) {
        const uint4 xh0v = *reinterpret_cast<const uint4*>(xhi + c * 128 + fq * 16);
        const uint4 xh1v = *reinterpret_cast<const uint4*>(xhi + c * 128 + 64 + fq * 16);
        const uint4 xl0v = *reinterpret_cast<const uint4*>(xlo + c * 128 + fq * 16);
        const uint4 xl1v = *reinterpret_cast<const uint4*>(xlo + c * 128 + 64 + fq * 16);
#define LL(v, a, b) ((long)(((unsigned long long)(v).b << 32) | (v).a))
#pragma unroll
        for (int g = 0; g < 8; ++g) {
          if (c < 7) asm volatile("s_waitcnt vmcnt(14)" ::: "memory");
          else {
            if (g == 0) asm volatile("s_waitcnt vmcnt(14)" ::: "memory");
            else if (g == 1) asm volatile("s_waitcnt vmcnt(12)" ::: "memory");
            else if (g == 2) asm volatile("s_waitcnt vmcnt(10)" ::: "memory");
            else if (g == 3) asm volatile("s_waitcnt vmcnt(8)" ::: "memory");
            else if (g == 4) asm volatile("s_waitcnt vmcnt(6)" ::: "memory");
            else if (g == 5) asm volatile("s_waitcnt vmcnt(4)" ::: "memory");
            else if (g == 6) asm volatile("s_waitcnt vmcnt(2)" ::: "memory");
            else asm volatile("s_waitcnt vmcnt(0)" ::: "memory");
          }
          const uint4 a0v = *reinterpret_cast<const uint4*>(ring + g * 2048 + rd0);
          const uint4 a1v = *reinterpret_cast<const uint4*>(ring + g * 2048 + rd1);
          asm volatile("s_waitcnt lgkmcnt(0)" ::: "memory");
          if (c < 7) P4_ISSUE(c + 1, g, g);
          acc[g] = __builtin_amdgcn_mfma_f32_16x16x32_fp8_fp8(LL(a0v, x, y), LL(xh0v, x, y), acc[g], 0, 0, 0);
          acc[g] = __builtin_amdgcn_mfma_f32_16x16x32_fp8_fp8(LL(a0v, z, w), LL(xh0v, z, w), acc[g], 0, 0, 0);
          acc[g] = __builtin_amdgcn_mfma_f32_16x16x32_fp8_fp8(LL(a1v, x, y), LL(xh1v, x, y), acc[g], 0, 0, 0);
          acc[g] = __builtin_amdgcn_mfma_f32_16x16x32_fp8_fp8(LL(a1v, z, w), LL(xh1v, z, w), acc[g], 0, 0, 0);
          acc[g] = __builtin_amdgcn_mfma_f32_16x16x32_fp8_fp8(LL(a0v, x, y), LL(xl0v, x, y), acc[g], 0, 0, 0);
          acc[g] = __builtin_amdgcn_mfma_f32_16x16x32_fp8_fp8(LL(a0v, z, w), LL(xl0v, z, w), acc[g], 0, 0, 0);
          acc[g] = __builtin_amdgcn_mfma_f32_16x16x32_fp8_fp8(LL(a1v, x, y), LL(xl1v, x, y), acc[g], 0, 0, 0);
          acc[g] = __builtin_amdgcn_mfma_f32_16x16x32_fp8_fp8(LL(a1v, z, w), LL(xl1v, z, w), acc[g], 0, 0, 0);
        }
      }
#undef LL
#undef P4_ISSUE
    }
#pragma unroll
    for (int g = 0; g < 8; ++g) {
      const float4 gt = *reinterpret_cast<const float4*>(p.pgate + (size_t)t * 128 + g * 16 + fq * 4);
      const int e0 = g * 16 + fq * 4;
      const int i0 = il[e0], i1 = il[e0 + 1], i2 = il[e0 + 2], i3 = il[e0 + 3];
      float4 wv;
      wv.x = gt.x * gelu_exact(acc[g][0] * (uinv[i0] * xinv)) * vinv[i0];
      wv.y = gt.y * gelu_exact(acc[g][1] * (uinv[i1] * xinv)) * vinv[i1];
      wv.z = gt.z * gelu_exact(acc[g][2] * (uinv[i2] * xinv)) * vinv[i2];
      wv.w = gt.w * gelu_exact(acc[g][3] * (uinv[i3] * xinv)) * vinv[i3];
      if (fr == 0) *reinterpret_cast<float4*>(wgt + e0) = wv;
    }
    __builtin_amdgcn_wave_barrier();
    float f[16];
#pragma unroll
    for (int e = 0; e < 16; ++e) f[e] = 0.f;
    {
#define P4V_ISSUE(ee, slot) do { const int _idx = __builtin_amdgcn_readfirstlane(il[ee]); \
        __builtin_amdgcn_global_load_lds((const unsigned*)(V + (size_t)_idx * 1024 + lane * 16), (unsigned*)(ring + (slot) * 1024 + lane * 16), 16, 0, 0); } while (0)
#define P4V_ACC(cv, we) do { const unsigned _cw[4] = {(cv).x, (cv).y, (cv).z, (cv).w}; \
        _Pragma("unroll") for (int q = 0; q < 4; ++q) { \
          const __attribute__((ext_vector_type(2))) float lo2 = __builtin_amdgcn_cvt_pk_f32_fp8((int)_cw[q], false); \
          const __attribute__((ext_vector_type(2))) float hi2 = __builtin_amdgcn_cvt_pk_f32_fp8((int)_cw[q], true); \
          f[q * 4 + 0] += (we) * lo2.x; f[q * 4 + 1] += (we) * lo2.y; f[q * 4 + 2] += (we) * hi2.x; f[q * 4 + 3] += (we) * hi2.y; } } while (0)
#pragma unroll
      for (int k = 0; k < 16; ++k) P4V_ISSUE(k, k);
#pragma unroll 1
      for (int eb = 0; eb < 7; ++eb) {
#pragma unroll
        for (int k = 0; k < 16; ++k) {
          asm volatile("s_waitcnt vmcnt(15)" ::: "memory");
          const uint4 cv = *reinterpret_cast<const uint4*>(ring + k * 1024 + lane * 16);
          const float we = wgt[eb * 16 + k];
          asm volatile("s_waitcnt lgkmcnt(0)" ::: "memory");
          P4V_ISSUE((eb + 1) * 16 + k, k);
          P4V_ACC(cv, we);
        }
      }
      {
        uint4 cv; float we;
#define P4V_TAIL(k, n) asm volatile("s_waitcnt vmcnt(" #n ")" ::: "memory"); cv = *reinterpret_cast<const uint4*>(ring + (k) * 1024 + lane * 16); we = wgt[112 + (k)]; P4V_ACC(cv, we);
        P4V_TAIL(0, 15) P4V_TAIL(1, 14) P4V_TAIL(2, 13) P4V_TAIL(3, 12) P4V_TAIL(4, 11) P4V_TAIL(5, 10) P4V_TAIL(6, 9) P4V_TAIL(7, 8)
        P4V_TAIL(8, 7) P4V_TAIL(9, 6) P4V_TAIL(10, 5) P4V_TAIL(11, 4) P4V_TAIL(12, 3) P4V_TAIL(13, 2) P4V_TAIL(14, 1) P4V_TAIL(15, 0)
#undef P4V_TAIL
      }
#undef P4V_ISSUE
#undef P4V_ACC
    }
    const int gl2 = tidx(gwid) & 63;
    const float* md = p.mod + ((size_t)layer * 9 + cond_of_row(t)) * 6144 + 5 * 1024;
    float zz[16];
    float s = 0.f;
#pragma unroll
    for (int q = 0; q < 4; ++q) {
      const int col = gl2 * 16 + q * 4;
      const float4 x0 = *reinterpret_cast<const float4*>(p.xbuf + (size_t)t * DM + col);
      const float4 g0 = *reinterpret_cast<const float4*>(md + col);
      zz[q * 4 + 0] = ALPHA_F * x0.x + g0.x * f[q * 4 + 0];
      zz[q * 4 + 1] = ALPHA_F * x0.y + g0.y * f[q * 4 + 1];
      zz[q * 4 + 2] = ALPHA_F * x0.z + g0.z * f[q * 4 + 2];
      zz[q * 4 + 3] = ALPHA_F * x0.w + g0.w * f[q * 4 + 3];
      s += zz[q * 4] + zz[q * 4 + 1] + zz[q * 4 + 2] + zz[q * 4 + 3];
    }
    const float mean = wave_sum(s) * (1.0f / 1024.0f);
    float sv = 0.f;
#pragma unroll
    for (int e = 0; e < 16; ++e) { float d = zz[e] - mean; sv += d * d; }
    const float rstd = rsqrtf(wave_sum(sv) * (1.0f / 1024.0f) + LN_EPS_F);
#pragma unroll
    for (int q = 0; q < 4; ++q) {
      const int col = gl2 * 16 + q * 4;
      const float4 g0 = *reinterpret_cast<const float4*>(lng + col);
      const float4 b0 = *reinterpret_cast<const float4*>(lnb + col);
      float4 o0;
      o0.x = (zz[q * 4 + 0] - mean) * rstd * g0.x + b0.x;
      o0.y = (zz[q * 4 + 1] - mean) * rstd * g0.y + b0.y;
      o0.z = (zz[q * 4 + 2] - mean) * rstd * g0.z + b0.z;
      o0.w = (zz[q * 4 + 3] - mean) * rstd * g0.w + b0.w;
      *reinterpret_cast<float4*>(xout + (size_t)t * DM + col) = o0;
    }
  }
}

DEVINL void phase_a1(const Params& p, int layer, int w, int nw, int gwid) {
  const int lane = tidx(gwid) & 63;
  const int gw = w * NWAVES + (tidx(gwid) >> 6), ngw = nw * NWAVES;
  for (int row = gw; row < TT; row += ngw) {
    const float* md = p.mod + ((size_t)layer * 9 + cond_of_row(row)) * 6144;
#pragma unroll
    for (int k = 0; k < 4; ++k) {
      const int col = k * 256 + lane * 4;
      const float4 x = *reinterpret_cast<const float4*>(p.xbuf + (size_t)row * DM + col);
      const float4 sh = *reinterpret_cast<const float4*>(md + col);
      const float4 sc = *reinterpret_cast<const float4*>(md + 1024 + col);
      uint2 o;
      o.x = pack2(x.x * (1.0f + sc.x) + sh.x, x.y * (1.0f + sc.y) + sh.y);
      o.y = pack2(x.z * (1.0f + sc.z) + sh.z, x.w * (1.0f + sc.w) + sh.w);
      *reinterpret_cast<uint2*>(p.hbuf + (size_t)row * DM + col) = o;
    }
  }
}

DEVINL void phase_a2(const Params& p, int layer, int w, int nw, char* smem, int gwid) {
  const int j = layer >> 1;
  EpiBf16 E; E.O = reinterpret_cast<bf16_t*>(p.U1); E.ldc = 1536;
  pg8::ASelOne as; as.A = (const char*)p.hbuf;
  pg8::StaticOrder S; S.init(TT, 1536, nw, w);
  pg8::gemm_phase<EpiBf16, pg8::ASelOne>((PG8_LAS unsigned char*)smem, as, p.attn_wqkv_t + (size_t)j * 1536 * 1024, 1024, S, E, gwid);
}

DEVINL void load16(const bf16_t* src, float (&x)[16]) {
  const uint4 a = *reinterpret_cast<const uint4*>(src);
  const uint4 b = *reinterpret_cast<const uint4*>(src + 8);
  x[0] = bflo(a.x); x[1] = bfhi(a.x); x[2] = bflo(a.y); x[3] = bfhi(a.y); x[4] = bflo(a.z); x[5] = bfhi(a.z); x[6] = bflo(a.w); x[7] = bfhi(a.w);
  x[8] = bflo(b.x); x[9] = bfhi(b.x); x[10] = bflo(b.y); x[11] = bfhi(b.y); x[12] = bflo(b.z); x[13] = bfhi(b.z); x[14] = bflo(b.w); x[15] = bfhi(b.w);
}
DEVINL void store16bf(bf16_t* dst, const float (&x)[16]) {
  uint4 a, b;
  a.x = pack2(x[0], x[1]); a.y = pack2(x[2], x[3]); a.z = pack2(x[4], x[5]); a.w = pack2(x[6], x[7]);
  b.x = pack2(x[8], x[9]); b.y = pack2(x[10], x[11]); b.z = pack2(x[12], x[13]); b.w = pack2(x[14], x[15]);
  *reinterpret_cast<uint4*>(dst) = a; *reinterpret_cast<uint4*>(dst + 8) = b;
}
DEVINL void headnorm_rope(float (&x)[16], const float* nwgt, int quarter, bool lat, int t, const float* rope) {
  float ss = 0.f;
#pragma unroll
  for (int e = 0; e < 16; ++e) ss += x[e] * x[e];
  ss += __shfl_xor(ss, 1); ss += __shfl_xor(ss, 2);
  const float rinv = rsqrtf(ss * (1.0f / 64.0f) + RMS_EPS_F);
#pragma unroll
  for (int e = 0; e < 16; ++e) x[e] = x[e] * rinv * nwgt[quarter * 16 + e];
  if (lat) {
    const int pos = (quarter < 2) ? (t >> 6) : (t & 63);
    const bool hi = quarter & 1;
#pragma unroll
    for (int e = 0; e < 16; ++e) {
      const float other = __shfl_xor(x[e], 1);
      const float c = rope[(pos * 16 + e) * 2], s = rope[(pos * 16 + e) * 2 + 1];
      x[e] = hi ? (x[e] * c + other * s) : (x[e] * c - other * s);
    }
  }
}

DEVINL void phase_a2b(const Params& p, int layer, int w, int nw, int gwid) {
  const int j = layer >> 1;
  const int lane = tidx(gwid) & 63;
  const int gw = w * NWAVES + (tidx(gwid) >> 6), ngw = nw * NWAVES;
  const bf16_t* qkv = reinterpret_cast<const bf16_t*>(p.U1);
  bf16_t* qb = reinterpret_cast<bf16_t*>(p.U2);
  const float* qn = p.in[29] + j * 64;
  const float* kn = p.in[30] + j * 64;
  for (int row = gw; row < TT; row += ngw) {
    const bool lat = row >= TCTX;
    const int t = lat ? ((row - TCTX) & 1023) : (row & 255);
    const int b = lat ? ((row - TCTX) >> 10) : (row >> 8);
    const bf16_t* src = qkv + (size_t)row * 1536;
    {
      float x[16];
      load16(src + lane * 16, x);
      headnorm_rope(x, qn, lane & 3, lat, t, p.rope);
#pragma unroll
      for (int e = 0; e < 16; ++e) x[e] *= QSCALE_F;
      store16bf(qb + (size_t)row * DM + lane * 16, x);
    }
    if (lane < 16) {
      const int kvh = lane >> 2, quarter = lane & 3;
      float x[16];
      load16(src + 1024 + lane * 16, x);
      headnorm_rope(x, kn, quarter, false, t, p.rope);
      if (lat) {
        const int pos = (quarter < 2) ? (t >> 6) : (t & 63);
        const bool hi = quarter & 1;
#pragma unroll
        for (int e = 0; e < 16; ++e) {
          const float other = __shfl_xor(x[e], 1);
          const float c = p.rope[(pos * 16 + e) * 2], s = p.rope[(pos * 16 + e) * 2 + 1];
          x[e] = hi ? (x[e] * c + other * s) : (x[e] * c - other * s);
        }
        store16bf(p.Klat + ((size_t)((j * 8 + b) * 4 + kvh) * 1536 + 512 + t) * 64 + quarter * 16, x);
      } else {
        store16bf(p.Kctx + ((size_t)((j * 16 + b) * 4 + kvh) * 256 + t) * 64 + quarter * 16, x);
        float* ko = p.out + OUT_CK + ((size_t)(b * 2 + j) * 256 + t) * 256 + kvh * 64 + quarter * 16;
#pragma unroll
        for (int q4 = 0; q4 < 4; ++q4) reinterpret_cast<float4*>(ko)[q4] = make_float4(x[q4 * 4], x[q4 * 4 + 1], x[q4 * 4 + 2], x[q4 * 4 + 3]);
      }
    } else if (lane < 32) {
      const int l2 = lane - 16;
      const int kvh = l2 >> 2, quarter = l2 & 3;
      float x[16];
      load16(src + 1280 + l2 * 16, x);
      if (lat) {
        bf16_t* vd = p.VlatT + (size_t)((j * 8 + b) * 4 + kvh) * 64 * 1536 + 512 + t;
#pragma unroll
        for (int e = 0; e < 16; ++e) vd[(size_t)(quarter * 16 + e) * 1536] = f2bf(x[e]);
      } else {
        bf16_t* vd = p.VctxT + (size_t)((j * 16 + b) * 4 + kvh) * 64 * 256 + t;
#pragma unroll
        for (int e = 0; e < 16; ++e) vd[(size_t)(quarter * 16 + e) * 256] = f2bf(x[e]);
        float* vo = p.out + OUT_CV + ((size_t)(b * 2 + j) * 256 + t) * 256 + kvh * 64 + quarter * 16;
#pragma unroll
        for (int q4 = 0; q4 < 4; ++q4) reinterpret_cast<float4*>(vo)[q4] = make_float4(x[q4 * 4], x[q4 * 4 + 1], x[q4 * 4 + 2], x[q4 * 4 + 3]);
      }
    }
  }
}

DEVINL void phase_a3(const Params& p, int layer, int w, int nw, int gwid) {
  const int j = layer >> 1;
  const int lane = tidx(gwid) & 63, wid = tidx(gwid) >> 6;
  const int ql = lane & 31, hh = lane >> 5;
  const bf16_t* qb = reinterpret_cast<const bf16_t*>(p.U2);
  for (int item = w; item < 768; item += nw) {
    int hq, Tk, row0;
    const bf16_t *Kb, *Vt;
    if (item < 512) {
      const int b = item >> 6, qblk = item & 3;
      hq = (item >> 2) & 15;
      const int kvh = hq >> 2;
      Kb = p.Klat + (size_t)((j * 8 + b) * 4 + kvh) * 1536 * 64;
      Vt = p.VlatT + (size_t)((j * 8 + b) * 4 + kvh) * 64 * 1536;
      Tk = 1536; row0 = TCTX + b * 1024 + qblk * 256;
    } else {
      const int it = item - 512;
      const int b = it >> 4;
      hq = it & 15;
      const int kvh = hq >> 2;
      Kb = p.Kctx + (size_t)((j * 16 + b) * 4 + kvh) * 256 * 64;
      Vt = p.VctxT + (size_t)((j * 16 + b) * 4 + kvh) * 64 * 256;
      Tk = 256; row0 = b * 256;
    }
    const int qrow = row0 + wid * 32 + ql;
    bf16x8 bq[4];
#pragma unroll
    for (int ks = 0; ks < 4; ++ks) bq[ks] = *reinterpret_cast<const bf16x8*>(qb + (size_t)qrow * DM + hq * 64 + ks * 16 + hh * 8);
    f32x16 o0, o1;
#pragma unroll
    for (int r = 0; r < 16; ++r) { o0[r] = 0.f; o1[r] = 0.f; }
    float mrun = -1e30f, lrun = 0.f;
    for (int kt = 0; kt < Tk; kt += 32) {
      f32x16 sacc;
#pragma unroll
      for (int r = 0; r < 16; ++r) sacc[r] = 0.f;
#pragma unroll
      for (int ks = 0; ks < 4; ++ks) {
        bf16x8 ka = *reinterpret_cast<const bf16x8*>(Kb + (size_t)(kt + ql) * 64 + ks * 16 + hh * 8);
        sacc = __builtin_amdgcn_mfma_f32_32x32x16_bf16(ka, bq[ks], sacc, 0, 0, 0);
      }
      float tmax = sacc[0];
#pragma unroll
      for (int r = 1; r < 16; ++r) tmax = fmaxf(tmax, sacc[r]);
      tmax = fmaxf(tmax, __shfl_xor(tmax, 32));
      const float mnew = fmaxf(mrun, tmax);
      const float corr = exp2f(mrun - mnew);
      mrun = mnew;
      lrun *= corr;
#pragma unroll
      for (int r = 0; r < 16; ++r) { o0[r] *= corr; o1[r] *= corr; }
      float pv[16];
#pragma unroll
      for (int r = 0; r < 16; ++r) { pv[r] = exp2f(sacc[r] - mnew); lrun += pv[r]; }
#pragma unroll
      for (int s2 = 0; s2 < 2; ++s2) {
        union { bf16x8 v; unsigned u[4]; } pb;
#pragma unroll
        for (int q = 0; q < 4; ++q) pb.u[q] = pack2(pv[s2 * 8 + q * 2], pv[s2 * 8 + q * 2 + 1]);
#pragma unroll
        for (int dblk = 0; dblk < 2; ++dblk) {
          const bf16_t* vp = Vt + (size_t)(dblk * 32 + ql) * Tk + kt + 16 * s2 + 4 * hh;
          const uint2 lo = *reinterpret_cast<const uint2*>(vp);
          const uint2 hi = *reinterpret_cast<const uint2*>(vp + 8);
          union { bf16x8 v; unsigned u[4]; } va;
          va.u[0] = lo.x; va.u[1] = lo.y; va.u[2] = hi.x; va.u[3] = hi.y;
          if (dblk == 0) o0 = __builtin_amdgcn_mfma_f32_32x32x16_bf16(va.v, pb.v, o0, 0, 0, 0);
          else o1 = __builtin_amdgcn_mfma_f32_32x32x16_bf16(va.v, pb.v, o1, 0, 0, 0);
        }
      }
    }
    const float ltot = lrun + __shfl_xor(lrun, 32);
    const float inv = 1.0f / ltot;
#pragma unroll
    for (int g = 0; g < 4; ++g) {
      uint2 oa, ob;
      oa.x = pack2(o0[4 * g] * inv, o0[4 * g + 1] * inv); oa.y = pack2(o0[4 * g + 2] * inv, o0[4 * g + 3] * inv);
      ob.x = pack2(o1[4 * g] * inv, o1[4 * g + 1] * inv); ob.y = pack2(o1[4 * g + 2] * inv, o1[4 * g + 3] * inv);
      *reinterpret_cast<uint2*>(p.abuf + (size_t)qrow * DM + hq * 64 + 8 * g + 4 * hh) = oa;
      *reinterpret_cast<uint2*>(p.abuf + (size_t)qrow * DM + hq * 64 + 32 + 8 * g + 4 * hh) = ob;
    }
  }
}

#define XB_TMO      128
#define XB_XCNT(j)  (256  + 64 * (j))
#define XB_XSUB(j)  (1280 + 64 * (j))
#define XB_XGEN(j)  (2304 + 64 * (j))
#define XB_TOP      3328
#define XB_TOPGEN   3392
#define XCD_BAR_WORDS 3456
#define XB_SPIN_CAP (1u << 22)
#define LAS __attribute__((address_space(3)))

DEVINL unsigned xb_ld(unsigned* p) { return __hip_atomic_load(p, __ATOMIC_RELAXED, __HIP_MEMORY_SCOPE_AGENT); }
DEVINL unsigned xb_add(unsigned* p, unsigned v) { return __hip_atomic_fetch_add(p, v, __ATOMIC_RELAXED, __HIP_MEMORY_SCOPE_AGENT); }
DEVINL unsigned xb_xcc_id() { return (unsigned)__builtin_amdgcn_s_getreg((3 << 11) | 20) & 0xFu; }
#define XB_SPIN(cond, bar) do { unsigned _sp = 0; while (cond) { __builtin_amdgcn_s_sleep(1); \
    if ((++_sp & 255u) == 0u) { if (xb_ld(&(bar)[XB_TMO])) break; if (_sp > XB_SPIN_CAP) { atomicAdd(&(bar)[XB_TMO], 1u); break; } } } } while (0)

struct XcdBarrier { unsigned* bar; unsigned x; volatile LAS unsigned* st; };

DEVINL XcdBarrier xcd_barrier_post(unsigned* bar, volatile LAS unsigned* st) {
  XcdBarrier b; b.bar = bar; b.x = xb_xcc_id(); b.st = st;
  if (threadIdx.x == 0) (void)xb_add(&bar[XB_XCNT(b.x)], 1u);
  return b;
}
DEVINL void xcd_barrier_complete(unsigned* bar, unsigned x, unsigned& nloc, unsigned& nx) {
  const unsigned G = gridDim.x * gridDim.y * gridDim.z;
  unsigned sum, cnt, mine, sp = 0u;
  for (;;) {
    sum = 0u; cnt = 0u; mine = 0u;
#pragma unroll
    for (unsigned j = 0; j < 16; ++j) { const unsigned c = xb_ld(&bar[XB_XCNT(j)]); sum += c; cnt += (c > 0u) ? 1u : 0u; mine = (j == x) ? c : mine; }
    if (sum == G) break;
    __builtin_amdgcn_s_sleep(1);
    if ((++sp & 255u) == 0u) { if (xb_ld(&bar[XB_TMO])) break; if (sp > XB_SPIN_CAP) { atomicAdd(&bar[XB_TMO], 1u); break; } }
  }
  nloc = mine > 0u ? mine : 1u; nx = cnt > 0u ? cnt : 1u;
}
DEVINL void xcd_barrier(const XcdBarrier& b) {
  asm volatile("s_waitcnt vmcnt(0)" ::: "memory");
  __syncthreads();
  if (threadIdx.x == 0) {
    unsigned* bar = b.bar;
    __builtin_amdgcn_s_waitcnt(0);
    unsigned nloc = b.st[0], nx = b.st[1];
    if (nloc == 0u) { xcd_barrier_complete(bar, b.x, nloc, nx); b.st[0] = nloc; b.st[1] = nx; }
    const unsigned old = xb_add(&bar[XB_XSUB(b.x)], 1u);
    const unsigned gen = old / nloc;
    if (old + 1u == (gen + 1u) * nloc) {
      __builtin_amdgcn_fence(__ATOMIC_RELEASE, "agent");
      asm volatile("s_waitcnt vmcnt(0)" ::: "memory");
      const unsigned og = xb_add(&bar[XB_TOP], 1u);
      const unsigned tg = og / nx;
      if (og + 1u == (tg + 1u) * nx) xb_add(&bar[XB_TOPGEN], 1u);
      else XB_SPIN(xb_ld(&bar[XB_TOPGEN]) == tg, bar);
      __builtin_amdgcn_fence(__ATOMIC_ACQUIRE, "agent");
      xb_add(&bar[XB_XGEN(b.x)], 1u);
      asm volatile("s_waitcnt vmcnt(0)" ::: "memory");
    } else {
      XB_SPIN(xb_ld(&bar[XB_XGEN(b.x)]) == gen, bar);
      __builtin_amdgcn_fence(__ATOMIC_ACQUIRE, "agent");
      asm volatile("s_waitcnt vmcnt(0)" ::: "memory");
    }
  }
  __syncthreads();
}

extern __shared__ __attribute__((aligned(16))) char dyn_smem[];
__global__ void __launch_bounds__(NTHREADS, 2) mega_kernel(Params p) {
  char* smem = dyn_smem;
  cg::grid_group grid = cg::this_grid();
  const int w = blockIdx.x, nw = gridDim.x;
  const int gwid = __builtin_amdgcn_readfirstlane((int)(threadIdx.x >> 6));
  if (p.use_cg_sync) grid.sync();
  volatile LAS unsigned* xst = (volatile LAS unsigned*)(smem + SMEM_BYTES - 16);
  if (threadIdx.x == 0) { xst[0] = 0u; xst[1] = 0u; }
  __syncthreads();
  XcdBarrier xb = xcd_barrier_post(p.bar, xst);
#define GSYNC() xcd_barrier(xb)
#ifndef REP_PREP
#define REP_PREP 1
#endif
#ifndef REP_R4
#define REP_R4 1
#endif
#ifndef REP_P3
#define REP_P3 1
#endif
#ifndef REP_P4L3
#define REP_P4L3 1
#endif
#ifndef REP_A3
#define REP_A3 1
#endif
#ifndef REP_GEMM
#define REP_GEMM 1
#endif
#ifndef REP_SG
#define REP_SG 1
#endif
#ifndef REP_EW
#define REP_EW 1
#endif
  for (int rep = 0; rep < REP_PREP; ++rep) { phase_prep(p, w, nw, smem, gwid); GSYNC(); }
  for (int layer = 0; layer < 4; ++layer) {
    if ((layer & 1) == 0) {
      for (int rep = 0; rep < REP_EW; ++rep) { phase_r1(p, layer, w, nw, gwid); GSYNC(); }
      for (int rep = 0; rep < REP_GEMM; ++rep) { phase_r2(p, layer, w, nw, smem, gwid); GSYNC(); }
      for (int rep = 0; rep < REP_SG; ++rep) { phase_r3(p, layer, w, nw, smem, gwid); GSYNC(); }
      for (int rep = 0; rep < REP_R4; ++rep) { phase_r4(p, layer, w, nw, smem, gwid); GSYNC(); }
      for (int rep = 0; rep < REP_EW; ++rep) { phase_r5(p, layer, w, nw, gwid); GSYNC(); }
    } else {
      for (int rep = 0; rep < REP_EW; ++rep) { phase_a1(p, layer, w, nw, gwid); GSYNC(); }
      for (int rep = 0; rep < REP_GEMM; ++rep) { phase_a2(p, layer, w, nw, smem, gwid); GSYNC(); }
      for (int rep = 0; rep < REP_EW; ++rep) { phase_a2b(p, layer, w, nw, gwid); GSYNC(); }
      for (int rep = 0; rep < REP_A3; ++rep) { phase_a3(p, layer, w, nw, gwid); GSYNC(); }
    }
    for (int rep = 0; rep < REP_GEMM; ++rep) { phase_wo(p, layer, w, nw, smem, gwid); GSYNC(); }
    for (int rep = 0; rep < REP_EW; ++rep) { phase_ln1(p, layer, w, nw, gwid); GSYNC(); }
    for (int rep = 0; rep < REP_GEMM; ++rep) { phase_p1(p, layer, w, nw, smem, gwid); GSYNC(); }
    for (int rep = 0; rep < REP_SG; ++rep) { phase_p2(p, layer, w, nw, smem, gwid); GSYNC(); }
    for (int rep = 0; rep < REP_P3; ++rep) { phase_p3(p, layer, w, nw, smem, gwid); GSYNC(); }
    for (int rep = 0; rep < (layer == 3 ? REP_P4L3 : 1); ++rep) { phase_p4(p, layer, w, nw, smem, gwid); GSYNC(); }
  }
}

static inline char* carve(char*& cur, size_t bytes) {
  char* r = cur;
  cur += (bytes + 255) & ~(size_t)255;
  return r;
}

extern "C" void kernel_launch(void* const* d_in, const int* in_sizes, int n_in, void* d_out, int out_size, void* d_ws,
                              size_t ws_size, hipStream_t stream) {
  Params p;
  memset(&p, 0, sizeof(p));
  for (int i = 0; i < 35; ++i) p.in[i] = (const float*)d_in[i];
  p.out = (float*)d_out;
  char* cur = (char*)d_ws;
  p.bar = (unsigned*)carve(cur, 16384);
  p.mod = (float*)carve(cur, (size_t)4 * 9 * 6144 * 4);
  p.rope = (float*)carve(cur, 64 * 16 * 2 * 4);
  p.rwkv_in_t = (bf16_t*)carve(cur, (size_t)2 * RW_N * 1024 * 2);
  p.w2t = (bf16_t*)carve(cur, (size_t)4 * 65536 * 2);
  p.a2t = (bf16_t*)carve(cur, (size_t)4 * 65536 * 2);
  p.g2t = (bf16_t*)carve(cur, (size_t)2 * 131072 * 2);
  p.rwkv_wo_t = (bf16_t*)carve(cur, (size_t)2 * 1048576 * 2);
  p.attn_wqkv_t = (bf16_t*)carve(cur, (size_t)2 * 1536 * 1024 * 2);
  p.attn_wo_t = (bf16_t*)carve(cur, (size_t)2 * 1048576 * 2);
  p.wq_t = (bf16_t*)carve(cur, (size_t)4 * 2048 * 1024 * 2);
  p.keysb = (bf16_t*)carve(cur, (size_t)4 * 2 * 128 * 128 * 2);
  p.ub = (bf16_t*)carve(cur, (size_t)4 * 16384 * 1024 * 2);
  p.vb = (bf16_t*)carve(cur, (size_t)4 * 16384 * 1024 * 2);
  p.uinv = (float*)carve(cur, (size_t)65536 * 4);
  p.vinv = (float*)carve(cur, (size_t)65536 * 4);
  p.Klat = (bf16_t*)carve(cur, (size_t)2 * 8 * 4 * 1536 * 64 * 2);
  p.VlatT = (bf16_t*)carve(cur, (size_t)2 * 8 * 4 * 1536 * 64 * 2);
  p.Kctx = (bf16_t*)carve(cur, (size_t)2 * 16 * 4 * 256 * 64 * 2);
  p.VctxT = (bf16_t*)carve(cur, (size_t)2 * 16 * 4 * 256 * 64 * 2);
  p.xbuf = (float*)carve(cur, (size_t)TT * DM * 4);
  p.zbuf = (float*)carve(cur, (size_t)TT * DM * 4);
  p.hbuf = (bf16_t*)carve(cur, (size_t)TT * DM * 2);
  p.abuf = (bf16_t*)carve(cur, (size_t)TT * DM * 2);
  p.U1 = carve(cur, (size_t)TT * DM * 14);
  p.U2 = carve(cur, (size_t)TT * DM * 8);
  p.U3 = carve(cur, (size_t)TT * DM * 8);
  p.pidx = (int*)carve(cur, (size_t)TT * 128 * 4);
  p.pgate = (float*)carve(cur, (size_t)TT * 128 * 4);
  for (int f = 0; f < 16; ++f) p.freqs[f] = pow(10000.0, -(double)f / 16.0);
  if ((size_t)(cur - (char*)d_ws) > ws_size) {
    fprintf(stderr, "workspace too small: need %zu have %zu\n", (size_t)(cur - (char*)d_ws), ws_size);
    return;
  }
  static int grid_blocks = 0;
  if (!grid_blocks) {
    int dev = 0, cus = 0, per_cu = 0;
    (void)hipGetDevice(&dev);
    (void)hipDeviceGetAttribute(&cus, hipDeviceAttributeMultiprocessorCount, dev);
    (void)hipFuncSetAttribute((const void*)mega_kernel, hipFuncAttributeMaxDynamicSharedMemorySize, SMEM_BYTES);
    (void)hipOccupancyMaxActiveBlocksPerMultiprocessor(&per_cu, mega_kernel, NTHREADS, SMEM_BYTES);
    if (per_cu > 1) per_cu = 1;
    if (per_cu < 1) per_cu = 1;
    grid_blocks = cus * per_cu;
  }
  (void)hipMemsetAsync(p.bar, 0, 16384, stream);
  void* args[] = {&p};
  hipError_t e = hipLaunchCooperativeKernel((void*)mega_kernel, dim3(grid_blocks), dim3(NTHREADS), args, SMEM_BYTES, stream);
  if (e != hipSuccess) fprintf(stderr, "cooperative launch failed: %s (grid %d)\n", hipGetErrorString(e), grid_blocks);
}
```

```cpp
#include <hip/hip_runtime.h>
#include <hip/hip_cooperative_groups.h>
#include <stdint.h>
#include <string.h>
#include <math.h>
#include <stdio.h>

namespace cg = cooperative_groups;

typedef unsigned short bf16_t;
typedef __attribute__((ext_vector_type(8))) short bf16x8;
typedef __attribute__((ext_vector_type(4))) float f32x4;
typedef __attribute__((ext_vector_type(16))) float f32x16;

#define DEVINL __device__ __forceinline__
#define NTHREADS 512
#define NWAVES 8
#define GEMM_LDS 131072
#define SMEM_BYTES 163840
#define RW_N 3840

#define DM 1024
#define TCTX 4096
#define TLAT 8192
#define TT 12288
#define ALPHA_F 1.681792830507429f
#define LN_EPS_F 1e-5f
#define GN_EPS_F 6.4e-4f
#define RMS_EPS_F 1e-6f
#define QSCALE_F (0.125f * 1.4426950408889634f)

#define OUT_Y 0
#define OUT_STATE 12582912
#define OUT_CK 16777216
#define OUT_CV 18874368

struct Params {
  const float* in[35];
  float* out;
  float* mod;
  float* rope;
  bf16_t* rwkv_in_t;
  bf16_t* w2t;
  bf16_t* a2t;
  bf16_t* g2t;
  bf16_t* rwkv_wo_t;
  bf16_t* attn_wqkv_t;
  bf16_t* attn_wo_t;
  bf16_t* wq_t;
  bf16_t* keysb;
  bf16_t* ub;
  bf16_t* vb;
  float* uinv;
  float* vinv;
  bf16_t* Klat;
  bf16_t* VlatT;
  bf16_t* Kctx;
  bf16_t* VctxT;
  float* xbuf;
  float* zbuf;
  bf16_t* hbuf;
  bf16_t* abuf;
  char* U1;
  char* U2;
  char* U3;
  int* pidx;
  float* pgate;
  double freqs[16];
  unsigned* bar;
  int use_cg_sync;
  int pad0;
};

DEVINL int lane_id() { return (int)__builtin_amdgcn_mbcnt_hi(~0u, __builtin_amdgcn_mbcnt_lo(~0u, 0u)); }
DEVINL int tidx(int gwid) {
  int t = gwid * 64 + lane_id(); asm volatile("" : "+v"(t)); return t;
}
typedef __bf16 bf16v2_ __attribute__((ext_vector_type(2)));
typedef float f32v2_ __attribute__((ext_vector_type(2)));
DEVINL unsigned cvt_pk_bf16_(float lo, float hi) { f32v2_ v = {lo, hi}; bf16v2_ r = __builtin_convertvector(v, bf16v2_); return __builtin_bit_cast(unsigned, r); }
DEVINL bf16_t f2bf(float f) { return (bf16_t)(cvt_pk_bf16_(f, f) & 0xFFFFu); }
DEVINL float bf2f(bf16_t h) { return __uint_as_float(((unsigned)h) << 16); }
DEVINL unsigned pack2(float a, float b) { return cvt_pk_bf16_(a, b); }
DEVINL float bflo(unsigned u) { return __uint_as_float(u << 16); }
DEVINL float bfhi(unsigned u) { return __uint_as_float(u & 0xFFFF0000u); }

DEVINL float wave_sum(float v) {
#pragma unroll
  for (int o = 32; o > 0; o >>= 1) v += __shfl_xor(v, o);
  return v;
}
DEVINL float grp16_sum(float v) {
#pragma unroll
  for (int o = 8; o > 0; o >>= 1) v += __shfl_xor(v, o);
  return v;
}
DEVINL unsigned wave_max_u(unsigned v) {
#pragma unroll
  for (int o = 32; o > 0; o >>= 1) { unsigned t = (unsigned)__shfl_xor((int)v, o); v = v > t ? v : t; }
  return v;
}
DEVINL float sigmoidf_(float x) { return 1.0f / (1.0f + __expf(-x)); }
DEVINL float tanhf_(float x) { float e = __expf(-2.0f * fabsf(x)); float t = (1.0f - e) / (1.0f + e); return x < 0 ? -t : t; }
DEVINL unsigned ordf(float f) { unsigned u = __float_as_uint(f); return (u & 0x80000000u) ? ~u : (u | 0x80000000u); }

DEVINL int cond_of_row(int row) { return row < TCTX ? 8 : ((row - TCTX) >> 10); }


namespace pg8 {
#define PG8_LAS __attribute__((address_space(3)))
typedef unsigned u32x4 __attribute__((ext_vector_type(4)));
constexpr int BM = 256, BK = 64, HALF = 128, HTB = HALF * BK * 2, STAGE_BYTES = 8 * HTB, NXCD = 8, WGM = 8;
DEVINL int lds_byte(int r, int c) { const int st = (r >> 4) * 2 + (c >> 5), rr = r & 15, cc = c & 31, ob = rr * 64 + cc * 2; return st * 1024 + (ob ^ (((ob >> 9) & 1) << 5)); }
DEVINL void stage_rc(int b, int& R, int& C) { const int st = b / 1024, sb = b % 1024, swz = sb ^ (((sb >> 9) & 1) << 5); R = (st >> 1) * 16 + swz / 64; C = (st & 1) * 32 + (swz % 64) / 2; }
DEVINL int perm32(int rho) { const int n = rho >> 4, i = rho & 15; return 8 * (i >> 2) + 4 * n + (i & 3); }
struct Unit { int pm, pn; };
struct StaticOrder {
  int nM, nN, nwg, G, c;
  DEVINL void init(int M, int N, int G_, int c_) { nM = M / BM; nN = N / BM; nwg = nM * nN; G = G_; c = c_; }
  DEVINL bool next(int i, Unit& u) const {
    const long L = (long)i * G + c; if (L >= nwg) return false;
    int wgid = (int)L; { const int q = nwg / NXCD, r = nwg % NXCD, xcd = wgid % NXCD, off = wgid / NXCD; wgid = (xcd < r ? xcd * (q + 1) : r * (q + 1) + (xcd - r) * q) + off; }
    const int nig = WGM * nN, gid = wgid / nig, fm = gid * WGM, gsz = (nM - fm) < WGM ? (nM - fm) : WGM;
    u.pm = fm + ((wgid % nig) % gsz); u.pn = (wgid % nig) / gsz; return true;
  }
};
DEVINL unsigned cvt_pk_bf16(float lo, float hi) { return cvt_pk_bf16_(lo, hi); }

template <class Epi, class ASel>
DEVINL void gemm_phase(PG8_LAS unsigned char* lds, const ASel& asel, const bf16_t* Bt, const int K, const StaticOrder& S, const Epi& E, int gwid) {
  const int tid = tidx(gwid), wid = __builtin_amdgcn_readfirstlane(tid >> 6), lane = tid & 63, wr = wid >> 2, wc = wid & 3, fr = lane & 15, fq = lane >> 4;
  const int nt = K / BK;
  unsigned voffA[2], voffB[2];
#pragma unroll
  for (int i = 0; i < 2; ++i) { int R, C; stage_rc(tid * 16 + i * 8192, R, C); const int Rb = Epi::PERM ? ((R & ~31) + perm32(R & 31)) : R;
    voffA[i] = (unsigned)(R * K + C) * 2u; voffB[i] = (unsigned)(Rb * K + C) * 2u; }
  const size_t kstep = (size_t)(BK * 2);
  const size_t hstep = (size_t)HALF * K * 2;
  const size_t tstep = 2 * hstep;
  const unsigned ldsw = (unsigned)wid * 1024u;
  const int aoff = lds_byte(wr * 64 + fr, fq * 8), boff = lds_byte(wc * 32 + fr, fq * 8);
#define PG8_SA(b, h) (((b) * 2 + (h)) * HTB)
#define PG8_SB(b, h) ((4 + (b) * 2 + (h)) * HTB)
#define PG8_STAGE(bufoff, gbase, voff) do { _Pragma("unroll") for (int _i = 0; _i < 2; ++_i) \
    __builtin_amdgcn_global_load_lds((const unsigned*)((const char*)(gbase) + (voff)[_i]), (PG8_LAS unsigned*)(lds + (bufoff) + ldsw + _i * 8192), 16, 0, 0); } while (0)
#define PG8_LDA(dst, b, h) do { _Pragma("unroll") for (int m = 0; m < 4; ++m) _Pragma("unroll") for (int k = 0; k < 2; ++k) dst[m][k] = *(const PG8_LAS bf16x8*)(lds + PG8_SA(b, h) + aoff + m * 2048 + k * 1024); } while (0)
#define PG8_LDB(dst, b, h) do { _Pragma("unroll") for (int n = 0; n < 2; ++n) _Pragma("unroll") for (int k = 0; k < 2; ++k) dst[n][k] = *(const PG8_LAS bf16x8*)(lds + PG8_SB(b, h) + boff + n * 2048 + k * 1024); } while (0)
#define PG8_MMA(ai, bj, At, Bt_) do { __builtin_amdgcn_s_setprio(1); _Pragma("unroll") for (int m = 0; m < 4; ++m) _Pragma("unroll") for (int n = 0; n < 2; ++n) _Pragma("unroll") for (int k = 0; k < 2; ++k) \
    acc[ai][bj][m][n] = __builtin_amdgcn_mfma_f32_16x16x32_bf16(Bt_[n][k], At[m][k], acc[ai][bj][m][n], 0, 0, 0); __builtin_amdgcn_s_setprio(0); } while (0)
#define PG8_WAIT_V(n) asm volatile("s_waitcnt vmcnt(" #n ")" ::: "memory")
#define PG8_WAIT_L(n) asm volatile("s_waitcnt lgkmcnt(" #n ")" ::: "memory")
#define PG8_BAR __builtin_amdgcn_s_barrier()
#define PG8_SCHED __builtin_amdgcn_sched_barrier(0)
  Unit cur, nxt; int ui = 0;
  if (!S.next(0, cur)) return;
  f32x4 acc[2][2][4][2];
#pragma unroll
  for (int a = 0; a < 2; ++a)
#pragma unroll
    for (int b = 0; b < 2; ++b)
#pragma unroll
      for (int m = 0; m < 4; ++m)
#pragma unroll
        for (int n = 0; n < 2; ++n) acc[a][b][m][n] = (f32x4){0.f, 0.f, 0.f, 0.f};
  bf16x8 At[4][2], B0[2][2], B1[2][2];
  const char* cA = asel(cur.pn) + (size_t)cur.pm * tstep; const char* cB = (const char*)Bt + (size_t)cur.pn * tstep;
  PG8_STAGE(PG8_SB(0, 0), cB, voffB); PG8_STAGE(PG8_SA(0, 0), cA, voffA); PG8_STAGE(PG8_SB(0, 1), cB + hstep, voffB); PG8_STAGE(PG8_SA(0, 1), cA + hstep, voffA);
  if (wr == 1) PG8_BAR;
  PG8_WAIT_V(4); PG8_BAR;
  PG8_STAGE(PG8_SB(1, 0), cB + kstep, voffB); PG8_STAGE(PG8_SA(1, 0), cA + kstep, voffA); PG8_STAGE(PG8_SB(1, 1), cB + hstep + kstep, voffB);
  PG8_WAIT_V(6); PG8_BAR;
  for (;;) {
    const bool has_next = S.next(ui + 1, nxt);
    const char* nA = has_next ? asel(nxt.pn) + (size_t)nxt.pm * tstep : cA; const char* nB = has_next ? (const char*)Bt + (size_t)nxt.pn * tstep : cB;
    for (int t = 0; t < nt; t += 2) {
      const bool last = (t == nt - 2);
      const char* a1 = cA + (size_t)(t + 1) * kstep;
      const char* a2 = last ? nA : cA + (size_t)(t + 2) * kstep; const char* b2 = last ? nB : cB + (size_t)(t + 2) * kstep;
      const char* a3 = a2 + kstep; const char* b3 = b2 + kstep;
      PG8_LDB(B0, 0, 0); PG8_SCHED; PG8_LDA(At, 0, 0); PG8_STAGE(PG8_SA(1, 1), a1 + hstep, voffA);
      PG8_WAIT_L(8); PG8_BAR; PG8_WAIT_L(0); PG8_MMA(0, 0, At, B0); PG8_BAR; PG8_SCHED;
      PG8_LDB(B1, 0, 1); PG8_STAGE(PG8_SB(0, 0), b2, voffB);
      PG8_BAR; PG8_WAIT_L(0); PG8_MMA(0, 1, At, B1); PG8_BAR;
      PG8_LDA(At, 0, 1); PG8_STAGE(PG8_SA(0, 0), a2, voffA);
      PG8_BAR; PG8_WAIT_L(0); PG8_MMA(1, 0, At, B0); PG8_BAR; PG8_SCHED;
      PG8_STAGE(PG8_SB(0, 1), b2 + hstep, voffB);
      PG8_WAIT_V(6); PG8_BAR; PG8_MMA(1, 1, At, B1); PG8_BAR;
      PG8_LDB(B0, 1, 0); PG8_SCHED; PG8_LDA(At, 1, 0); PG8_STAGE(PG8_SA(0, 1), a2 + hstep, voffA);
      PG8_WAIT_L(8); PG8_BAR; PG8_WAIT_L(0); PG8_MMA(0, 0, At, B0); PG8_BAR; PG8_SCHED;
      PG8_LDB(B1, 1, 1); PG8_STAGE(PG8_SB(1, 0), b3, voffB);
      PG8_BAR; PG8_WAIT_L(0); PG8_MMA(0, 1, At, B1); PG8_BAR;
      PG8_LDA(At, 1, 1); PG8_STAGE(PG8_SA(1, 0), a3, voffA);
      PG8_BAR; PG8_WAIT_L(0); PG8_MMA(1, 0, At, B0); PG8_BAR; PG8_SCHED;
      PG8_STAGE(PG8_SB(1, 1), b3 + hstep, voffB);
      PG8_WAIT_V(6); PG8_BAR; PG8_MMA(1, 1, At, B1); PG8_BAR;
    }
    E(acc, cur, wr, wc, fr, fq);
    if (!has_next) break;
#pragma unroll
    for (int a = 0; a < 2; ++a)
#pragma unroll
      for (int b = 0; b < 2; ++b)
#pragma unroll
        for (int m = 0; m < 4; ++m)
#pragma unroll
          for (int n = 0; n < 2; ++n) acc[a][b][m][n] = (f32x4){0.f, 0.f, 0.f, 0.f};
    cur = nxt; cA = nA; cB = nB; ++ui;
  }
  PG8_WAIT_V(0);
  if (wr == 0) PG8_BAR;
  PG8_BAR;
#undef PG8_SA
#undef PG8_SB
#undef PG8_STAGE
#undef PG8_LDA
#undef PG8_LDB
#undef PG8_MMA
#undef PG8_WAIT_V
#undef PG8_WAIT_L
#undef PG8_BAR
#undef PG8_SCHED
}
struct ASelOne { const char* A; DEVINL const char* operator()(int) const { return A; } };
}

DEVINL void gemm_tile_128(const bf16_t* __restrict__ A, int lda, const bf16_t* __restrict__ Bt, int ldb, int K,
                          char* smem_half, f32x4 (&acc)[4][4], int gwid) {
  const int tid = tidx(gwid) & 255, wid = tid >> 6, lane = tid & 63;
  const int wr = wid >> 1, wc = wid & 1, fr = lane & 15, fq = lane >> 4;
  char* SA = smem_half;
  char* SB = smem_half + 8192;
#pragma unroll
  for (int m = 0; m < 4; ++m)
#pragma unroll
    for (int n = 0; n < 4; ++n) acc[m][n] = (f32x4){0.f, 0.f, 0.f, 0.f};
  for (int k0 = 0; k0 < K; k0 += 32) {
#pragma unroll
    for (int i = 0; i < 2; ++i) {
      int b = tid * 16 + i * 4096;
      int r = b >> 6, c = (b & 63) >> 1;
      __builtin_amdgcn_global_load_lds((const unsigned*)(A + (size_t)r * lda + k0 + c), (unsigned*)(SA + b), 16, 0, 0);
      __builtin_amdgcn_global_load_lds((const unsigned*)(Bt + (size_t)r * ldb + k0 + c), (unsigned*)(SB + b), 16, 0, 0);
    }
    asm volatile("s_waitcnt vmcnt(0)" ::: "memory");
    __syncthreads();
    bf16x8 a[4], b[4];
#pragma unroll
    for (int m = 0; m < 4; ++m) a[m] = *reinterpret_cast<const bf16x8*>(SA + (wr * 64 + m * 16 + fr) * 64 + fq * 16);
#pragma unroll
    for (int n = 0; n < 4; ++n) b[n] = *reinterpret_cast<const bf16x8*>(SB + (wc * 64 + n * 16 + fr) * 64 + fq * 16);
#pragma unroll
    for (int m = 0; m < 4; ++m)
#pragma unroll
      for (int n = 0; n < 4; ++n) acc[m][n] = __builtin_amdgcn_mfma_f32_16x16x32_bf16(a[m], b[n], acc[m][n], 0, 0, 0);
    __syncthreads();
  }
}

#define GEMM_LANE_VARS \
  const int tid = tidx(gwid) & 255, wid = tid >> 6, lane = tid & 63; \
  const int wr = wid >> 1, wc = wid & 1, fr = lane & 15, fq = lane >> 4; \
  (void)tid; (void)wid; (void)lane; (void)wr; (void)wc; (void)fr; (void)fq;

DEVINL void get_tjob(const Params& p, int ji, const float*& src, bf16_t*& dst, int& K, int& N) {
  if (ji < 28) {
    int j = ji / 14, s = ji % 14;
    bf16_t* rw = p.rwkv_in_t + (size_t)j * RW_N * 1024;
    if (s < 3) { src = p.in[12] + ((size_t)(j * 3 + s) << 20); dst = rw + ((size_t)s << 20); K = 1024; N = 1024; }
    else if (s < 5) { int z = s - 3; src = p.in[15] + (size_t)(j * 2 + z) * 65536; dst = rw + (size_t)(3072 + z * 64) * 1024; K = 1024; N = 64; }
    else if (s < 7) { int z = s - 5; src = p.in[18] + (size_t)(j * 2 + z) * 65536; dst = rw + (size_t)(3328 + z * 64) * 1024; K = 1024; N = 64; }
    else if (s == 7) { src = p.in[20] + (size_t)j * 131072; dst = rw + (size_t)3584 * 1024; K = 1024; N = 128; }
    else if (s < 10) { int z = s - 8; src = p.in[16] + (size_t)(j * 2 + z) * 65536; dst = p.w2t + (size_t)(j * 2 + z) * 65536; K = 64; N = 1024; }
    else if (s < 12) { int z = s - 10; src = p.in[19] + (size_t)(j * 2 + z) * 65536; dst = p.a2t + (size_t)(j * 2 + z) * 65536; K = 64; N = 1024; }
    else if (s == 12) { src = p.in[21] + (size_t)j * 131072; dst = p.g2t + (size_t)j * 131072; K = 128; N = 1024; }
    else { src = p.in[13] + ((size_t)j << 20); dst = p.rwkv_wo_t + ((size_t)j << 20); K = 1024; N = 1024; }
  } else if (ji < 32) {
    int j = (ji - 28) >> 1, s = (ji - 28) & 1;
    if (s == 0) { src = p.in[27] + (size_t)j * 1024 * 1536; dst = p.attn_wqkv_t + (size_t)j * 1536 * 1024; K = 1024; N = 1536; }
    else { src = p.in[28] + ((size_t)j << 20); dst = p.attn_wo_t + ((size_t)j << 20); K = 1024; N = 1024; }
  } else {
    int i = ji - 32;
    src = p.in[31] + (size_t)i * 1024 * 2048; dst = p.wq_t + (size_t)i * 2048 * 1024; K = 1024; N = 2048;
  }
}

DEVINL void sincos_d(double x, float& c, float& s) {
  const double TWO_PI = 6.283185307179586476925;
  double r = x - TWO_PI * rint(x / TWO_PI);
  double r2 = r * r;
  double ts = r, tc = 1.0, ss = r, cs = 1.0;
#pragma unroll 1
  for (int n = 1; n <= 14; ++n) {
    tc = -tc * r2 / (double)((2 * n - 1) * (2 * n));
    ts = -ts * r2 / (double)((2 * n) * (2 * n + 1));
    cs += tc; ss += ts;
  }
  c = (float)cs; s = (float)ss;
}

DEVINL void phase_prep(const Params& p, int w, int nw, char* smem, int gwid) {
  const int tid = tidx(gwid);
  {
    float (*tile)[65] = reinterpret_cast<float (*)[65]>(smem);
    int toff = 0;
    for (int ji = 0; ji < 36; ++ji) {
      const float* src; bf16_t* dst; int K, N;
      get_tjob(p, ji, src, dst, K, N);
      const int tn = N >> 6, nt = (K >> 6) * tn;
      int t0 = (w - (toff % nw) + nw) % nw;
      for (int t = t0; t < nt; t += nw) {
        const int k0 = (t / tn) << 6, n0 = (t % tn) << 6;
#pragma unroll
        for (int i = 0; i < 2; ++i) {
          int r = (tid >> 4) + 32 * i, c = (tid & 15) * 4;
          float4 v = *reinterpret_cast<const float4*>(src + (size_t)(k0 + r) * N + n0 + c);
          tile[r][c] = v.x; tile[r][c + 1] = v.y; tile[r][c + 2] = v.z; tile[r][c + 3] = v.w;
        }
        __syncthreads();
        {
          int q = tid;
          int n = q >> 3, kc = (q & 7) * 8;
          uint4 o;
          o.x = pack2(tile[kc + 0][n], tile[kc + 1][n]);
          o.y = pack2(tile[kc + 2][n], tile[kc + 3][n]);
          o.z = pack2(tile[kc + 4][n], tile[kc + 5][n]);
          o.w = pack2(tile[kc + 6][n], tile[kc + 7][n]);
          *reinterpret_cast<uint4*>(dst + (size_t)(n0 + n) * K + k0 + kc) = o;
        }
        __syncthreads();
      }
      toff += nt;
    }
  }
  const size_t gtid = (size_t)w * NTHREADS + tid, gn = (size_t)nw * NTHREADS;
  {
    const int lane = tid & 63;
    const int gw2 = w * NWAVES + (tid >> 6), ngw2 = nw * NWAVES;
    unsigned char* u8 = reinterpret_cast<unsigned char*>(p.ub);
    unsigned char* v8 = reinterpret_cast<unsigned char*>(p.vb);
    for (int r = gw2; r < 2 * 65536; r += ngw2) {
      const bool isv = r >= 65536;
      const int row = isv ? r - 65536 : r;
      const float* srow = (isv ? p.in[34] : p.in[33]) + (size_t)row * 1024 + lane * 16;
      float x[16];
#pragma unroll
      for (int q = 0; q < 4; ++q) { const float4 v = reinterpret_cast<const float4*>(srow)[q]; x[q * 4] = v.x; x[q * 4 + 1] = v.y; x[q * 4 + 2] = v.z; x[q * 4 + 3] = v.w; }
      float mx = 0.f;
#pragma unroll
      for (int q = 0; q < 16; ++q) mx = fmaxf(mx, fabsf(x[q]));
#pragma unroll
      for (int o = 32; o > 0; o >>= 1) mx = fmaxf(mx, __shfl_xor(mx, o));
      mx = fmaxf(mx, 1e-30f);
      const float sc = 440.0f / mx;
      uint4 o4;
      unsigned* ow = reinterpret_cast<unsigned*>(&o4);
#pragma unroll
      for (int q = 0; q < 4; ++q) {
        int pk = 0;
        pk = __builtin_amdgcn_cvt_pk_fp8_f32(x[q * 4] * sc, x[q * 4 + 1] * sc, pk, false);
        pk = __builtin_amdgcn_cvt_pk_fp8_f32(x[q * 4 + 2] * sc, x[q * 4 + 3] * sc, pk, true);
        ow[q] = (unsigned)pk;
      }
      *reinterpret_cast<uint4*>((isv ? v8 : u8) + (size_t)row * 1024 + lane * 16) = o4;
      if (lane == 0) (isv ? p.vinv : p.uinv)[row] = mx * (1.0f / 440.0f);
    }
    const size_t gtid0 = (size_t)w * NTHREADS + tid, gn0 = (size_t)nw * NTHREADS;
    const size_t nk8 = (size_t)4 * 2 * 128 * 128 / 8;
    for (size_t i = gtid0; i < nk8; i += gn0) {
      const float4* su = reinterpret_cast<const float4*>(p.in[32]) + i * 2;
      float4 a = su[0], b = su[1];
      uint4 o; o.x = pack2(a.x, a.y); o.y = pack2(a.z, a.w); o.z = pack2(b.x, b.y); o.w = pack2(b.z, b.w);
      reinterpret_cast<uint4*>(p.keysb)[i] = o;
    }
  }
  {
    const size_t nk = (size_t)8 * 2 * 512 * 4 * 64;
    for (size_t i = gtid; i < nk; i += gn) {
      int d = i & 63, kvh = (i >> 6) & 3, s = (i >> 8) & 511, j = (i >> 17) & 1, b = (int)(i >> 18);
      p.Klat[((size_t)((j * 8 + b) * 4 + kvh) * 1536 + s) * 64 + d] = f2bf(p.in[4][i]);
      p.VlatT[((size_t)((j * 8 + b) * 4 + kvh) * 64 + d) * 1536 + s] = f2bf(p.in[5][i]);
    }
  }
  for (size_t i = gtid; i < 1024; i += gn) {
    int pos = (int)(i >> 4), f = (int)(i & 15);
    float c, s; sincos_d((double)pos * p.freqs[f], c, s);
    p.rope[i * 2] = c; p.rope[i * 2 + 1] = s;
  }
  {
    const size_t n4 = (size_t)TT * DM / 4, nc4 = (size_t)TCTX * DM / 4;
    for (size_t i = gtid; i < n4; i += gn) {
      float4 v = (i < nc4) ? reinterpret_cast<const float4*>(p.in[0])[i] : reinterpret_cast<const float4*>(p.in[1])[i - nc4];
      reinterpret_cast<float4*>(p.xbuf)[i] = v;
    }
  }
  {
    float* sc = reinterpret_cast<float*>(smem);
    float* red = sc + 9 * 1024;
    bool loaded = false;
    for (int item = w; item < 384; item += nw) {
      if (!loaded) {
        __syncthreads();
        for (int e = tid; e < 9 * 1024; e += NTHREADS) {
          int c = e >> 10, d = e & 1023;
          float v = (c < 8) ? p.in[2][c * 1024 + d] : p.in[6][d];
          sc[e] = v / (1.0f + __expf(-v));
        }
        __syncthreads();
        loaded = true;
      }
      const int i = item / 96, cc = item % 96;
      const int col = cc * 64 + (tid & 63), ks = tid >> 6;
      float acc[9];
#pragma unroll
      for (int c = 0; c < 9; ++c) acc[c] = 0.f;
      const float* wp = p.in[7] + (size_t)i * 1024 * 6144 + col;
      for (int d0 = ks * 128; d0 < ks * 128 + 128; d0 += 16) {
        float wv[16];
#pragma unroll
        for (int u = 0; u < 16; ++u) wv[u] = wp[(size_t)(d0 + u) * 6144];
#pragma unroll
        for (int u = 0; u < 16; ++u)
#pragma unroll
          for (int c = 0; c < 9; ++c) acc[c] += sc[c * 1024 + d0 + u] * wv[u];
      }
#pragma unroll
      for (int c = 0; c < 9; ++c) red[(ks * 9 + c) * 64 + (tid & 63)] = acc[c];
      __syncthreads();
      for (int o = tid; o < 576; o += NTHREADS) {
        int c = o >> 6, cl = o & 63;
        float s = 0.f;
#pragma unroll
        for (int k2 = 0; k2 < 8; ++k2) s += red[(k2 * 9 + c) * 64 + cl];
        int n = cc * 64 + cl;
        p.mod[((size_t)i * 9 + c) * 6144 + n] = s + p.in[8][i * 6144 + n];
      }
      __syncthreads();
    }
  }
}

DEVINL void phase_r1(const Params& p, int layer, int w, int nw, int gwid) {
  const int j = layer >> 1;
  const int lane = tidx(gwid) & 63;
  const int gw = w * NWAVES + (tidx(gwid) >> 6), ngw = nw * NWAVES;
  bf16_t* A6 = reinterpret_cast<bf16_t*>(p.U1);
  const float* mu = p.in[11] + (size_t)j * 6 * 1024;
  for (int row = gw; row < TT; row += ngw) {
    int t, Tlen;
    if (row < TCTX) { t = row & 255; Tlen = 256; } else { t = (row - TCTX) & 1023; Tlen = 1024; }
    const int cond = cond_of_row(row);
    const float* sh = p.mod + ((size_t)layer * 9 + cond) * 6144;
    const float* sc = sh + 1024;
    const bool hasp = t > 0, hasn = t < Tlen - 1;
#pragma unroll
    for (int k = 0; k < 4; ++k) {
      const int col = k * 256 + lane * 4;
      const float4 xc = *reinterpret_cast<const float4*>(p.xbuf + (size_t)row * DM + col);
      float4 xp = make_float4(0, 0, 0, 0), xn = make_float4(0, 0, 0, 0);
      if (hasp) xp = *reinterpret_cast<const float4*>(p.xbuf + (size_t)(row - 1) * DM + col);
      if (hasn) xn = *reinterpret_cast<const float4*>(p.xbuf + (size_t)(row + 1) * DM + col);
      const float4 s4 = *reinterpret_cast<const float4*>(sh + col);
      const float4 c4 = *reinterpret_cast<const float4*>(sc + col);
      float h[4], xx[4];
      const float xcv[4] = {xc.x, xc.y, xc.z, xc.w}, xpv[4] = {xp.x, xp.y, xp.z, xp.w}, xnv[4] = {xn.x, xn.y, xn.z, xn.w};
      const float shv[4] = {s4.x, s4.y, s4.z, s4.w}, scv[4] = {c4.x, c4.y, c4.z, c4.w};
#pragma unroll
      for (int e = 0; e < 4; ++e) {
        float g = 1.0f + scv[e];
        h[e] = xcv[e] * g + shv[e];
        float hp = hasp ? (xpv[e] * g + shv[e]) : 0.f;
        float hn = hasn ? (xnv[e] * g + shv[e]) : 0.f;
        xx[e] = 0.5f * (hp + hn) - h[e];
      }
#pragma unroll
      for (int m = 0; m < 6; ++m) {
        const float4 m4 = *reinterpret_cast<const float4*>(mu + m * 1024 + col);
        uint2 o;
        o.x = pack2(h[0] + xx[0] * m4.x, h[1] + xx[1] * m4.y);
        o.y = pack2(h[2] + xx[2] * m4.z, h[3] + xx[3] * m4.w);
        *reinterpret_cast<uint2*>(A6 + ((size_t)m * TT + row) * DM + col) = o;
      }
    }
  }
}

#define U1_AA_OFF ((size_t)2 * TT * DM * 4)
#define U1_GG_OFF (U1_AA_OFF + (size_t)2 * TT * DM * 2)

struct ASelR2 {
  const char* A6;
  DEVINL const char* operator()(int pn) const {
    const int idx = pn < 12 ? (pn >> 2) : (pn - 9);
    const int m = (0x541320 >> (4 * idx)) & 7;
    return A6 + (size_t)m * TT * DM * 2;
  }
};
struct EpiR2 {
  static constexpr bool PERM = true;
  bf16_t *rb, *lw;
  DEVINL void operator()(const f32x4 (&acc)[2][2][4][2], const pg8::Unit& u, int wr, int wc, int fr, int fq) const {
    const int row0 = u.pm * 256 + wr * 64 + fr;
    const int pn = u.pn;
    if (pn < 12) {
      bf16_t* dst = rb + (size_t)(pn >> 2) * TT * DM;
      const int col0 = (pn & 3) * 256 + wc * 32 + 8 * fq;
#pragma unroll
      for (int ai = 0; ai < 2; ++ai)
#pragma unroll
        for (int m = 0; m < 4; ++m) {
          bf16_t* rowp = dst + (size_t)(row0 + ai * 128 + m * 16) * DM + col0;
#pragma unroll
          for (int bj = 0; bj < 2; ++bj) {
            const f32x4 v0 = acc[ai][bj][m][0], v1 = acc[ai][bj][m][1];
            pg8::u32x4 o; o.x = pg8::cvt_pk_bf16(v0[0], v0[1]); o.y = pg8::cvt_pk_bf16(v0[2], v0[3]); o.z = pg8::cvt_pk_bf16(v1[0], v1[1]); o.w = pg8::cvt_pk_bf16(v1[2], v1[3]);
            *reinterpret_cast<pg8::u32x4*>(rowp + bj * 128) = o;
          }
        }
    } else {
      bf16_t* dst = lw + (size_t)(pn - 12) * TT * 128;
      const int col0 = wc * 32 + 8 * fq;
      const float kx = (pn == 12 ? 2.0f : 1.0f) * 1.4426950408889634f, ka = pn == 12 ? 2.0f : 1.0f, kb = pn == 12 ? -1.0f : 0.0f;
#pragma unroll
      for (int ai = 0; ai < 2; ++ai)
#pragma unroll
        for (int m = 0; m < 4; ++m) {
          f32x4 v0 = acc[ai][0][m][0], v1 = acc[ai][0][m][1];
          if (pn != 13) {
#pragma unroll
            for (int e = 0; e < 4; ++e) {
              const float s0 = __builtin_amdgcn_rcpf(1.0f + __builtin_amdgcn_exp2f(-kx * v0[e]));
              const float s1 = __builtin_amdgcn_rcpf(1.0f + __builtin_amdgcn_exp2f(-kx * v1[e]));
              v0[e] = ka * s0 + kb; v1[e] = ka * s1 + kb;
            }
          }
          asm volatile("" ::: "memory");
          pg8::u32x4 o; o.x = pg8::cvt_pk_bf16(v0[0], v0[1]); o.y = pg8::cvt_pk_bf16(v0[2], v0[3]); o.z = pg8::cvt_pk_bf16(v1[0], v1[1]); o.w = pg8::cvt_pk_bf16(v1[2], v1[3]);
          *reinterpret_cast<pg8::u32x4*>(dst + (size_t)(row0 + ai * 128 + m * 16) * 128 + col0) = o;
        }
    }
  }
};
DEVINL void phase_r2(const Params& p, int layer, int w, int nw, char* smem, int gwid) {
  const int j = layer >> 1;
  bf16_t* rb = reinterpret_cast<bf16_t*>(p.U2);
  EpiR2 E;
  E.rb = rb; E.lw = p.abuf;
  ASelR2 as; as.A6 = p.U1;
  pg8::StaticOrder S; S.init(TT, RW_N, nw, w);
  pg8::gemm_phase<EpiR2, ASelR2>((PG8_LAS unsigned char*)smem, as, p.rwkv_in_t + (size_t)j * RW_N * 1024, 1024, S, E, gwid);
}

DEVINL void phase_r3(const Params& p, int layer, int w, int nw, char* smem, int gwid) {
  const int j = layer >> 1;
  GEMM_LANE_VARS
  const int half = tidx(gwid) >> 8;
  char* sh = smem + half * 16384;
  const bf16_t* lw = p.abuf;
  const bf16_t* la = lw + (size_t)TT * 128;
  const bf16_t* lg = la + (size_t)TT * 128;
  float* wdec = reinterpret_cast<float*>(p.U1);
  bf16_t* aa = reinterpret_cast<bf16_t*>(p.U1 + U1_AA_OFF);
  bf16_t* gg = reinterpret_cast<bf16_t*>(p.U1 + U1_GG_OFF);
  const int NTILES = 96 * 40;
  for (int it = 0; it * nw * 2 < NTILES; ++it) {
    int tile = (it * nw + w) * 2 + half;
    const bool valid = tile < NTILES;
    if (!valid) tile = 0;
    const int ct = tile / 96, rt = tile % 96;
    const int job = ct >> 3, nt = ct & 7;
    const int row0 = rt * 128, col0 = nt * 128;
    f32x4 acc[4][4];
    if (job < 2) {
      const int z = job;
      gemm_tile_128(lw + (size_t)row0 * 128 + z * 64, 128, p.w2t + (size_t)(j * 2 + z) * 65536 + (size_t)col0 * 64, 64, 64, sh, acc, gwid);
      if (valid) {
        const float* w0 = p.in[14] + (size_t)(j * 2 + z) * 1024;
#pragma unroll
        for (int m = 0; m < 4; ++m)
#pragma unroll
          for (int n = 0; n < 4; ++n)
#pragma unroll
            for (int jj = 0; jj < 4; ++jj) {
              int row = row0 + wr * 64 + m * 16 + fq * 4 + jj, col = col0 + wc * 64 + n * 16 + fr;
              float wl = acc[m][n][jj] + w0[col];
              wdec[((size_t)z * TT + row) * DM + col] = __expf(-0.6065306597126334f * sigmoidf_(wl));
            }
      }
    } else if (job < 4) {
      const int z = job - 2;
      gemm_tile_128(la + (size_t)row0 * 128 + z * 64, 128, p.a2t + (size_t)(j * 2 + z) * 65536 + (size_t)col0 * 64, 64, 64, sh, acc, gwid);
      if (valid) {
        const float* a0 = p.in[17] + (size_t)(j * 2 + z) * 1024;
#pragma unroll
        for (int m = 0; m < 4; ++m)
#pragma unroll
          for (int n = 0; n < 4; ++n)
#pragma unroll
            for (int jj = 0; jj < 4; ++jj) {
              int row = row0 + wr * 64 + m * 16 + fq * 4 + jj, col = col0 + wc * 64 + n * 16 + fr;
              aa[((size_t)z * TT + row) * DM + col] = f2bf(sigmoidf_(acc[m][n][jj] + a0[col]));
            }
      }
    } else {
      gemm_tile_128(lg + (size_t)row0 * 128, 128, p.g2t + (size_t)j * 131072 + (size_t)col0 * 128, 128, 128, sh, acc, gwid);
      if (valid) {
#pragma unroll
        for (int m = 0; m < 4; ++m)
#pragma unroll
          for (int n = 0; n < 4; ++n)
#pragma unroll
            for (int jj = 0; jj < 4; ++jj) {
              int row = row0 + wr * 64 + m * 16 + fq * 4 + jj, col = col0 + wc * 64 + n * 16 + fr;
              gg[(size_t)row * DM + col] = f2bf(acc[m][n][jj]);
            }
      }
    }
  }
  {
    const int l64 = tidx(gwid) & 63;
    const int gw = w * NWAVES + (tidx(gwid) >> 6), ngw = nw * NWAVES;
    const bf16_t* kb = reinterpret_cast<const bf16_t*>(p.U2) + (size_t)TT * DM;
    bf16_t* kkb = reinterpret_cast<bf16_t*>(p.U2) + (size_t)3 * TT * DM;
    const float* k_k = p.in[22] + j * 1024;
    for (int row = gw; row < TT; row += ngw) {
#pragma unroll
      for (int k = 0; k < 4; ++k) {
        const int col = k * 256 + l64 * 4;
        const uint2 k2 = *reinterpret_cast<const uint2*>(kb + (size_t)row * DM + col);
        const float4 kk4 = *reinterpret_cast<const float4*>(k_k + col);
        float v0 = bflo(k2.x) * kk4.x, v1 = bfhi(k2.x) * kk4.y, v2 = bflo(k2.y) * kk4.z, v3 = bfhi(k2.y) * kk4.w;
        float ss = grp16_sum(v0 * v0 + v1 * v1 + v2 * v2 + v3 * v3);
        float inv = 1.0f / fmaxf(sqrtf(ss), 1e-12f);
        uint2 o; o.x = pack2(v0 * inv, v1 * inv); o.y = pack2(v2 * inv, v3 * inv);
        *reinterpret_cast<uint2*>(kkb + (size_t)row * DM + col) = o;
      }
    }
  }
}

typedef __attribute__((ext_vector_type(4))) short bf16x4;
#define R4_WAVE_LDS 36864
DEVINL unsigned short bfbits(float f) { return f2bf(f); }
DEVINL bf16x4 pack4(float a, float b, float c, float d) {
  union { bf16x4 v; unsigned u[2]; } r; r.u[0] = pack2(a, b); r.u[1] = pack2(c, d); return r.v;
}
DEVINL void phase_r4(const Params& p, int layer, int w, int nw, char* smem, int gwid) {
  const int j = layer >> 1;
  const int lane = tidx(gwid) & 63, wid = __builtin_amdgcn_readfirstlane(tidx(gwid) >> 6);
  const int fr = lane & 15, fq = lane >> 4;
  if (wid >= 3) return;
  const bf16_t* rb = reinterpret_cast<const bf16_t*>(p.U2);
  const bf16_t* kb = rb + (size_t)TT * DM;
  const bf16_t* vb = kb + (size_t)TT * DM;
  const bf16_t* kkb = vb + (size_t)TT * DM;
  const float* wdec = reinterpret_cast<const float*>(p.U1);
  const bf16_t* aa = reinterpret_cast<const bf16_t*>(p.U1 + U1_AA_OFF);
  float* yout = reinterpret_cast<float*>(p.U3);
  char* wl = smem + wid * R4_WAVE_LDS;
  bf16_t* khR = reinterpret_cast<bf16_t*>(wl);
  bf16_t* ahR = khR + 1024;
  bf16_t* qhR = ahR + 1024;
  bf16_t* rhR = qhR + 1024;
  bf16_t* qhT = rhR + 1024;
  bf16_t* AtT = qhT + 1024;
  bf16_t* KtT = AtT + 1024;
  bf16_t* vT = KtT + 1024;
  float* NfT = reinterpret_cast<float*>(vT + 1024);
  float* WCf = NfT + 256;
  bf16_t* TTl = reinterpret_cast<bf16_t*>(WCf + 64);
  bf16_t* AkqR = TTl + 256;
  bf16_t* GR = AkqR + 256;
  bf16_t* QpR = khR;
  char* rawb = wl + 20480;
  const bf16_t* rawR = reinterpret_cast<const bf16_t*>(rawb);
  const bf16_t* rawK = rawR + 1024;
  const bf16_t* rawKK = rawK + 1024;
  const bf16_t* rawA = rawKK + 1024;
  const bf16_t* rawV = rawA + 1024;
  const float* rawW = reinterpret_cast<const float*>(rawb + 10240);
  {
    const int c = w + nw * wid;
    if (c >= 768) return;
    int seq, h, z;
    if (c < 256) { seq = 16 + (c >> 5); h = (c >> 1) & 15; z = c & 1; }
    else { int cc = c - 256; seq = cc >> 5; h = (cc >> 1) & 15; z = cc & 1; }
    const int Tlen = seq < 16 ? 256 : 1024;
    const int base = seq < 16 ? seq * 256 : TCTX + (seq - 16) * 1024;
    const int colb = h * 64;
    const float kal = p.in[23][j * 1024 + colb + lane];
    f32x4 ST[4][4];
    if (seq >= 16) {
      const float* s0 = p.in[3] + ((((size_t)(seq - 16) * 2 + j) * 2 + z) * 16 + h) * 4096;
#pragma unroll
      for (int b = 0; b < 4; ++b)
#pragma unroll
        for (int nb = 0; nb < 4; ++nb) ST[b][nb] = *reinterpret_cast<const f32x4*>(s0 + (size_t)(16 * nb + fr) * 64 + 16 * b + 4 * fq);
    } else {
#pragma unroll
      for (int b = 0; b < 4; ++b)
#pragma unroll
        for (int nb = 0; nb < 4; ++nb) ST[b][nb] = (f32x4){0.f, 0.f, 0.f, 0.f};
    }
#define R4_DMA(t0_) do { \
      _Pragma("unroll") for (int i_ = 0; i_ < 2; ++i_) { \
        const int t_ = (t0_) + 8 * i_ + (lane >> 3); \
        const int row_ = base + (z == 0 ? t_ : (Tlen - 1 - t_)); \
        const size_t o_ = (size_t)row_ * DM + colb + (lane & 7) * 8; \
        __builtin_amdgcn_global_load_lds((const unsigned*)(rb + o_), (unsigned*)(rawb + i_ * 1024 + lane * 16), 16, 0, 0); \
        __builtin_amdgcn_global_load_lds((const unsigned*)(kb + o_), (unsigned*)(rawb + 2048 + i_ * 1024 + lane * 16), 16, 0, 0); \
        __builtin_amdgcn_global_load_lds((const unsigned*)(kkb + o_), (unsigned*)(rawb + 4096 + i_ * 1024 + lane * 16), 16, 0, 0); \
        __builtin_amdgcn_global_load_lds((const unsigned*)(aa + (size_t)z * TT * DM + o_), (unsigned*)(rawb + 6144 + i_ * 1024 + lane * 16), 16, 0, 0); \
        __builtin_amdgcn_global_load_lds((const unsigned*)(vb + o_), (unsigned*)(rawb + 8192 + i_ * 1024 + lane * 16), 16, 0, 0); \
      } \
      _Pragma("unroll") for (int i_ = 0; i_ < 4; ++i_) { \
        const int t_ = (t0_) + 4 * i_ + (lane >> 4); \
        const int row_ = base + (z == 0 ? t_ : (Tlen - 1 - t_)); \
        __builtin_amdgcn_global_load_lds((const unsigned*)(wdec + ((size_t)z * TT + row_) * DM + colb + (lane & 15) * 4), (unsigned*)(rawb + 10240 + i_ * 1024 + lane * 16), 16, 0, 0); \
      } } while (0)
    R4_DMA(0);
#pragma unroll 1
    for (int t0 = 0; t0 < Tlen; t0 += 16) {
      asm volatile("s_waitcnt vmcnt(0)" ::: "memory");
      __builtin_amdgcn_wave_barrier();
      {
        float wx[16];
#pragma unroll
        for (int t = 0; t < 16; ++t) wx[t] = rawW[t * 64 + lane];
        float WCl = 1.0f;
#pragma unroll
        for (int t = 0; t < 16; ++t) WCl *= wx[t];
        WCf[lane] = WCl;
        float Wc = 1.0f;
#pragma unroll
        for (int tp = 0; tp < 8; ++tp) {
          float at2[2], kt2[2], qh2[2];
          unsigned vb2[2];
#pragma unroll
          for (int u = 0; u < 2; ++u) {
            const int t = tp * 2 + u;
            const float rr = bf2f(rawR[t * 64 + lane]), kx = bf2f(rawK[t * 64 + lane]), kkx = bf2f(rawKK[t * 64 + lane]);
            const float ax = bf2f(rawA[t * 64 + lane]);
            vb2[u] = rawV[t * 64 + lane];
            const float kd = kx * (1.0f + (ax - 1.0f) * kal);
            const float kka = kkx * ax;
            const float qh = Wc * kkx;
            Wc *= wx[t];
            const float rh = Wc * rr;
            const float iw = __builtin_amdgcn_rcpf(Wc);
            const float kh = kd * iw, ah = kka * iw;
            khR[t * 64 + lane] = f2bf(kh); ahR[t * 64 + lane] = f2bf(ah);
            qhR[t * 64 + lane] = f2bf(qh); rhR[t * 64 + lane] = f2bf(rh);
            at2[u] = ah * WCl; kt2[u] = kh * WCl; qh2[u] = qh;
          }
          *reinterpret_cast<unsigned*>(AtT + lane * 16 + tp * 2) = pack2(at2[0], at2[1]);
          *reinterpret_cast<unsigned*>(KtT + lane * 16 + tp * 2) = pack2(kt2[0], kt2[1]);
          *reinterpret_cast<unsigned*>(qhT + lane * 16 + tp * 2) = pack2(qh2[0], qh2[1]);
          *reinterpret_cast<unsigned*>(vT + lane * 16 + tp * 2) = vb2[0] | (vb2[1] << 16);
        }
      }
      asm volatile("s_waitcnt lgkmcnt(0)" ::: "memory");
      if (t0 + 16 < Tlen) R4_DMA(t0 + 16);
      __builtin_amdgcn_wave_barrier();
      f32x4 Akq = {0.f, 0.f, 0.f, 0.f}, Aaq = Akq, Akr = Akq, Aar = Akq;
      {
#pragma unroll
        for (int ks = 0; ks < 2; ++ks) {
          const bf16x8 khA = *reinterpret_cast<const bf16x8*>(khR + fr * 64 + ks * 32 + fq * 8);
          const bf16x8 ahA = *reinterpret_cast<const bf16x8*>(ahR + fr * 64 + ks * 32 + fq * 8);
          const bf16x8 qhB = *reinterpret_cast<const bf16x8*>(qhR + fr * 64 + ks * 32 + fq * 8);
          const bf16x8 rhB = *reinterpret_cast<const bf16x8*>(rhR + fr * 64 + ks * 32 + fq * 8);
          Akq = __builtin_amdgcn_mfma_f32_16x16x32_bf16(khA, qhB, Akq, 0, 0, 0);
          Aaq = __builtin_amdgcn_mfma_f32_16x16x32_bf16(ahA, qhB, Aaq, 0, 0, 0);
          Akr = __builtin_amdgcn_mfma_f32_16x16x32_bf16(khA, rhB, Akr, 0, 0, 0);
          Aar = __builtin_amdgcn_mfma_f32_16x16x32_bf16(ahA, rhB, Aar, 0, 0, 0);
        }
#pragma unroll
        for (int e = 0; e < 4; ++e) {
          const int s = 4 * fq + e;
          if (!(s < fr)) { Akq[e] = 0.f; Aaq[e] = 0.f; }
          if (!(s <= fr)) { Akr[e] = 0.f; Aar[e] = 0.f; }
        }
      }
      __builtin_amdgcn_wave_barrier();
      *reinterpret_cast<f32x4*>(NfT + fr * 16 + 4 * fq) = Aaq;
#pragma unroll
      for (int e = 0; e < 4; ++e) AkqR[(4 * fq + e) * 16 + fr] = f2bf(Akq[e]);
      __builtin_amdgcn_wave_barrier();
      {
        float Tr[16];
#pragma unroll
        for (int t = 0; t < 16; ++t) {
          float acc = (fr == t) ? 1.0f : 0.0f;
#pragma unroll
          for (int x = 0; x < t; ++x) acc -= Tr[x] * NfT[t * 16 + x];
          Tr[t] = acc;
        }
        if (fq == 0) {
#pragma unroll
          for (int t = 0; t < 16; ++t) TTl[t * 16 + fr] = f2bf(Tr[t]);
        }
      }
      __builtin_amdgcn_wave_barrier();
      const bf16x4 Tb = *reinterpret_cast<const bf16x4*>(TTl + fr * 16 + fq * 4);
      f32x4 G;
      {
        const bf16x4 AkqA = *reinterpret_cast<const bf16x4*>(AkqR + fr * 16 + fq * 4);
        G = __builtin_amdgcn_mfma_f32_16x16x16bf16_1k(AkqA, Tb, (f32x4){0.f, 0.f, 0.f, 0.f}, 0, 0, 0);
#pragma unroll
        for (int b = 0; b < 4; ++b) {
          const bf16x4 qa = *reinterpret_cast<const bf16x4*>(qhT + (16 * b + fr) * 16 + fq * 4);
          const f32x4 qp = __builtin_amdgcn_mfma_f32_16x16x16bf16_1k(qa, Tb, (f32x4){0.f, 0.f, 0.f, 0.f}, 0, 0, 0);
          *reinterpret_cast<bf16x4*>(QpR + fr * 64 + 16 * b + 4 * fq) = pack4(qp[0], qp[1], qp[2], qp[3]);
        }
#pragma unroll
        for (int e = 0; e < 4; ++e) GR[(4 * fq + e) * 16 + fr] = f2bf(G[e]);
      }
      __builtin_amdgcn_wave_barrier();
      f32x4 H, Zb[4];
      {
        const bf16x4 GA = *reinterpret_cast<const bf16x4*>(GR + fr * 16 + fq * 4);
        const bf16x4 AarB = pack4(Aar[0], Aar[1], Aar[2], Aar[3]);
        const f32x4 hm = __builtin_amdgcn_mfma_f32_16x16x16bf16_1k(GA, AarB, (f32x4){0.f, 0.f, 0.f, 0.f}, 0, 0, 0);
        H = Akr - hm;
#pragma unroll
        for (int b = 0; b < 4; ++b) {
          const bf16x4 AtB = *reinterpret_cast<const bf16x4*>(AtT + (16 * b + fr) * 16 + fq * 4);
          const f32x4 zm = __builtin_amdgcn_mfma_f32_16x16x16bf16_1k(GA, AtB, (f32x4){0.f, 0.f, 0.f, 0.f}, 0, 0, 0);
          const bf16x4 ktv = *reinterpret_cast<const bf16x4*>(KtT + (16 * b + fr) * 16 + fq * 4);
          union { bf16x4 v; unsigned short s[4]; } ku; ku.v = ktv;
          Zb[b][0] = bf2f(ku.s[0]) - zm[0]; Zb[b][1] = bf2f(ku.s[1]) - zm[1]; Zb[b][2] = bf2f(ku.s[2]) - zm[2]; Zb[b][3] = bf2f(ku.s[3]) - zm[3];
        }
      }
      bf16x8 QpA[2], rhA[2], AY, AS[4];
      {
#pragma unroll
        for (int ks = 0; ks < 2; ++ks) {
          union { bf16x8 v; bf16x4 h[2]; } u1, u2;
          u1.h[0] = *reinterpret_cast<const bf16x4*>(QpR + fr * 64 + 32 * ks + 4 * fq);
          u1.h[1] = *reinterpret_cast<const bf16x4*>(QpR + fr * 64 + 32 * ks + 16 + 4 * fq);
          u2.h[0] = *reinterpret_cast<const bf16x4*>(rhR + fr * 64 + 32 * ks + 4 * fq);
          u2.h[1] = *reinterpret_cast<const bf16x4*>(rhR + fr * 64 + 32 * ks + 16 + 4 * fq);
          QpA[ks] = u1.v; rhA[ks] = u2.v;
        }
        {
          union { bf16x8 v; bf16x4 h[2]; } u;
          u.h[0] = pack4(Aar[0], Aar[1], Aar[2], Aar[3]); u.h[1] = pack4(H[0], H[1], H[2], H[3]);
          AY = u.v;
        }
#pragma unroll
        for (int b = 0; b < 4; ++b) {
          union { bf16x8 v; bf16x4 h[2]; } u;
          u.h[0] = *reinterpret_cast<const bf16x4*>(AtT + (16 * b + fr) * 16 + fq * 4);
          u.h[1] = pack4(Zb[b][0], Zb[b][1], Zb[b][2], Zb[b][3]);
          AS[b] = u.v;
        }
      }
#pragma unroll
      for (int nb = 0; nb < 4; ++nb) {
        bf16x8 Bhi[2];
#pragma unroll
        for (int ks = 0; ks < 2; ++ks) {
          union { bf16x8 v; unsigned u[4]; } hi;
          hi.u[0] = pack2(ST[2 * ks][nb][0], ST[2 * ks][nb][1]); hi.u[1] = pack2(ST[2 * ks][nb][2], ST[2 * ks][nb][3]);
          hi.u[2] = pack2(ST[2 * ks + 1][nb][0], ST[2 * ks + 1][nb][1]); hi.u[3] = pack2(ST[2 * ks + 1][nb][2], ST[2 * ks + 1][nb][3]);
          Bhi[ks] = hi.v;
        }
        f32x4 P = {0.f, 0.f, 0.f, 0.f}, R = {0.f, 0.f, 0.f, 0.f};
        P = __builtin_amdgcn_mfma_f32_16x16x32_bf16(QpA[0], Bhi[0], P, 0, 0, 0);
        P = __builtin_amdgcn_mfma_f32_16x16x32_bf16(QpA[1], Bhi[1], P, 0, 0, 0);
        R = __builtin_amdgcn_mfma_f32_16x16x32_bf16(rhA[0], Bhi[0], R, 0, 0, 0);
        R = __builtin_amdgcn_mfma_f32_16x16x32_bf16(rhA[1], Bhi[1], R, 0, 0, 0);
        bf16x8 X;
        {
          union { bf16x8 v; bf16x4 h[2]; } u;
          u.h[0] = pack4(-P[0], -P[1], -P[2], -P[3]);
          u.h[1] = *reinterpret_cast<const bf16x4*>(vT + (16 * nb + fr) * 16 + fq * 4);
          X = u.v;
        }
        const f32x4 Y = __builtin_amdgcn_mfma_f32_16x16x32_bf16(AY, X, R, 0, 0, 0);
#pragma unroll
        for (int e = 0; e < 4; ++e) {
          const int t = t0 + 4 * fq + e;
          const int row = base + (z == 0 ? t : (Tlen - 1 - t));
          yout[((size_t)z * TT + row) * DM + colb + 16 * nb + fr] = Y[e];
        }
#pragma unroll
        for (int b = 0; b < 4; ++b) {
          const f32x4 wcv = *reinterpret_cast<const f32x4*>(WCf + 16 * b + 4 * fq);
          ST[b][nb] = __builtin_amdgcn_mfma_f32_16x16x32_bf16(AS[b], X, ST[b][nb] * wcv, 0, 0, 0);
        }
        __builtin_amdgcn_sched_barrier(0);
      }
    }
    if (seq < 16) {
      const int l2 = tidx(gwid) & 63, fr2 = l2 & 15, fq2 = l2 >> 4;
      float* so = p.out + OUT_STATE + ((((size_t)seq * 2 + j) * 2 + z) * 16 + h) * 4096;
#pragma unroll
      for (int b = 0; b < 4; ++b)
#pragma unroll
        for (int nb = 0; nb < 4; ++nb) *reinterpret_cast<f32x4*>(so + (size_t)(16 * nb + fr2) * 64 + 16 * b + 4 * fq2) = ST[b][nb];
    }
  }
}

DEVINL void phase_r5(const Params& p, int layer, int w, int nw, int gwid) {
  const int j = layer >> 1;
  const int lane = tidx(gwid) & 63;
  const int gw = w * NWAVES + (tidx(gwid) >> 6), ngw = nw * NWAVES;
  const bf16_t* rb = reinterpret_cast<const bf16_t*>(p.U2);
  const bf16_t* kb = rb + (size_t)TT * DM;
  const bf16_t* vb = kb + (size_t)TT * DM;
  const bf16_t* aa = reinterpret_cast<const bf16_t*>(p.U1 + U1_AA_OFF);
  const bf16_t* gg = reinterpret_cast<const bf16_t*>(p.U1 + U1_GG_OFF);
  const float* yin = reinterpret_cast<const float*>(p.U3);
  const float* ka = p.in[23] + j * 1024;
  const float* rk = p.in[24] + j * 1024;
  const float* lg = p.in[25] + j * 1024;
  const float* lb = p.in[26] + j * 1024;
  for (int row = gw; row < TT; row += ngw) {
#pragma unroll
    for (int k = 0; k < 4; ++k) {
      const int col = k * 256 + lane * 4;
      const size_t o = (size_t)row * DM + col;
      const float4 yf = *reinterpret_cast<const float4*>(yin + o);
      const float4 yb = *reinterpret_cast<const float4*>(yin + (size_t)TT * DM + o);
      const uint2 r2 = *reinterpret_cast<const uint2*>(rb + o);
      const uint2 k2 = *reinterpret_cast<const uint2*>(kb + o);
      const uint2 v2 = *reinterpret_cast<const uint2*>(vb + o);
      const uint2 a02 = *reinterpret_cast<const uint2*>(aa + o);
      const uint2 a12 = *reinterpret_cast<const uint2*>(aa + (size_t)TT * DM + o);
      const uint2 g2 = *reinterpret_cast<const uint2*>(gg + o);
      const float4 ka4 = *reinterpret_cast<const float4*>(ka + col);
      const float4 rk4 = *reinterpret_cast<const float4*>(rk + col);
      const float4 lg4 = *reinterpret_cast<const float4*>(lg + col);
      const float4 lb4 = *reinterpret_cast<const float4*>(lb + col);
      float y[4] = {yf.x + yb.x, yf.y + yb.y, yf.z + yb.z, yf.w + yb.w};
      float r[4] = {bflo(r2.x), bfhi(r2.x), bflo(r2.y), bfhi(r2.y)};
      float kx[4] = {bflo(k2.x), bfhi(k2.x), bflo(k2.y), bfhi(k2.y)};
      float v[4] = {bflo(v2.x), bfhi(v2.x), bflo(v2.y), bfhi(v2.y)};
      float a0[4] = {bflo(a02.x), bfhi(a02.x), bflo(a02.y), bfhi(a02.y)};
      float a1[4] = {bflo(a12.x), bfhi(a12.x), bflo(a12.y), bfhi(a12.y)};
      float g[4] = {bflo(g2.x), bfhi(g2.x), bflo(g2.y), bfhi(g2.y)};
      float kav[4] = {ka4.x, ka4.y, ka4.z, ka4.w}, rkv[4] = {rk4.x, rk4.y, rk4.z, rk4.w};
      float lgv[4] = {lg4.x, lg4.y, lg4.z, lg4.w}, lbv[4] = {lb4.x, lb4.y, lb4.z, lb4.w};
      float sm = y[0] + y[1] + y[2] + y[3];
      sm = grp16_sum(sm);
      const float mean = sm * (1.0f / 64.0f);
      float sv = 0.f, sb = 0.f;
#pragma unroll
      for (int e = 0; e < 4; ++e) {
        float d = y[e] - mean; sv += d * d;
        float kd0 = kx[e] * (1.0f + (a0[e] - 1.0f) * kav[e]);
        float kd1 = kx[e] * (1.0f + (a1[e] - 1.0f) * kav[e]);
        sb += r[e] * (kd0 + kd1) * rkv[e];
      }
      sv = grp16_sum(sv); sb = grp16_sum(sb);
      const float rstd = rsqrtf(sv * (1.0f / 64.0f) + GN_EPS_F);
      float o4[4];
#pragma unroll
      for (int e = 0; e < 4; ++e) {
        float yn = (y[e] - mean) * rstd * lgv[e] + lbv[e];
        o4[e] = (yn + sb * v[e]) * g[e];
      }
      uint2 oo; oo.x = pack2(o4[0], o4[1]); oo.y = pack2(o4[2], o4[3]);
      *reinterpret_cast<uint2*>(p.abuf + o) = oo;
    }
  }
}

struct EpiWO {
  static constexpr bool PERM = false;
  const float* x; const float* mod; float* z; int layer;
  DEVINL void operator()(const f32x4 (&acc)[2][2][4][2], const pg8::Unit& u, int wr, int wc, int fr, int fq) const {
    const int row0 = u.pm * 256 + wr * 64 + fr, col0 = u.pn * 256 + wc * 32 + 4 * fq;
    const float* gate = mod + ((size_t)layer * 9 + cond_of_row(u.pm * 256)) * 6144 + 2 * 1024;
    f32x4 gv[2][2];
#pragma unroll
    for (int bj = 0; bj < 2; ++bj)
#pragma unroll
      for (int n = 0; n < 2; ++n) gv[bj][n] = *reinterpret_cast<const f32x4*>(gate + col0 + bj * 128 + n * 16);
#pragma unroll
    for (int ai = 0; ai < 2; ++ai)
#pragma unroll
      for (int m = 0; m < 4; ++m) {
        const size_t off = (size_t)(row0 + ai * 128 + m * 16) * DM + col0;
#pragma unroll
        for (int bj = 0; bj < 2; ++bj)
#pragma unroll
          for (int n = 0; n < 2; ++n) {
            const f32x4 xv = *reinterpret_cast<const f32x4*>(x + off + bj * 128 + n * 16);
            *reinterpret_cast<f32x4*>(z + off + bj * 128 + n * 16) = ALPHA_F * xv + gv[bj][n] * acc[ai][bj][m][n];
          }
        asm volatile("" ::: "memory");
      }
  }
};
DEVINL void phase_wo(const Params& p, int layer, int w, int nw, char* smem, int gwid) {
  const int j = layer >> 1;
  const bf16_t* Wt = ((layer & 1) ? p.attn_wo_t : p.rwkv_wo_t) + ((size_t)j << 20);
  EpiWO E; E.x = p.xbuf; E.mod = p.mod; E.z = p.zbuf; E.layer = layer;
  pg8::ASelOne as; as.A = (const char*)p.abuf;
  pg8::StaticOrder S; S.init(TT, 1024, nw, w);
  pg8::gemm_phase<EpiWO, pg8::ASelOne>((PG8_LAS unsigned char*)smem, as, Wt, 1024, S, E, gwid);
}

DEVINL void phase_ln1(const Params& p, int layer, int w, int nw, int gwid) {
  const int lane = tidx(gwid) & 63;
  const int gw = w * NWAVES + (tidx(gwid) >> 6), ngw = nw * NWAVES;
  const float* lng = p.in[9] + (size_t)(layer * 2 + 0) * 1024;
  const float* lnb = p.in[10] + (size_t)(layer * 2 + 0) * 1024;
  for (int row = gw; row < TT; row += ngw) {
    const float* md = p.mod + ((size_t)layer * 9 + cond_of_row(row)) * 6144;
    float4 z[4];
    float s = 0.f;
#pragma unroll
    for (int k = 0; k < 4; ++k) {
      z[k] = *reinterpret_cast<const float4*>(p.zbuf + (size_t)row * DM + k * 256 + lane * 4);
      s += z[k].x + z[k].y + z[k].z + z[k].w;
    }
    const float mean = wave_sum(s) * (1.0f / 1024.0f);
    float sv = 0.f;
#pragma unroll
    for (int k = 0; k < 4; ++k) {
      float a = z[k].x - mean, b = z[k].y - mean, c = z[k].z - mean, d = z[k].w - mean;
      sv += a * a + b * b + c * c + d * d;
    }
    const float rstd = rsqrtf(wave_sum(sv) * (1.0f / 1024.0f) + LN_EPS_F);
#pragma unroll
    for (int k = 0; k < 4; ++k) {
      const int col = k * 256 + lane * 4;
      const float4 g4 = *reinterpret_cast<const float4*>(lng + col);
      const float4 b4 = *reinterpret_cast<const float4*>(lnb + col);
      const float4 sh = *reinterpret_cast<const float4*>(md + 3 * 1024 + col);
      const float4 sc = *reinterpret_cast<const float4*>(md + 4 * 1024 + col);
      float4 x1;
      x1.x = (z[k].x - mean) * rstd * g4.x + b4.x;
      x1.y = (z[k].y - mean) * rstd * g4.y + b4.y;
      x1.z = (z[k].z - mean) * rstd * g4.z + b4.z;
      x1.w = (z[k].w - mean) * rstd * g4.w + b4.w;
      *reinterpret_cast<float4*>(p.xbuf + (size_t)row * DM + col) = x1;
      uint2 o;
      o.x = pack2(x1.x * (1.0f + sc.x) + sh.x, x1.y * (1.0f + sc.y) + sh.y);
      o.y = pack2(x1.z * (1.0f + sc.z) + sh.z, x1.w * (1.0f + sc.w) + sh.w);
      *reinterpret_cast<uint2*>(p.hbuf + (size_t)row * DM + col) = o;
    }
  }
}

struct EpiBf16 {
  static constexpr bool PERM = true;
  bf16_t* O; int ldc;
  DEVINL void operator()(const f32x4 (&acc)[2][2][4][2], const pg8::Unit& u, int wr, int wc, int fr, int fq) const {
    const int row0 = u.pm * 256 + wr * 64 + fr, col0 = u.pn * 256 + wc * 32 + 8 * fq;
#pragma unroll
    for (int ai = 0; ai < 2; ++ai)
#pragma unroll
      for (int m = 0; m < 4; ++m) {
        bf16_t* rowp = O + (size_t)(row0 + ai * 128 + m * 16) * ldc + col0;
#pragma unroll
        for (int bj = 0; bj < 2; ++bj) {
          const f32x4 v0 = acc[ai][bj][m][0], v1 = acc[ai][bj][m][1];
          pg8::u32x4 o; o.x = pg8::cvt_pk_bf16(v0[0], v0[1]); o.y = pg8::cvt_pk_bf16(v0[2], v0[3]); o.z = pg8::cvt_pk_bf16(v1[0], v1[1]); o.w = pg8::cvt_pk_bf16(v1[2], v1[3]);
          *reinterpret_cast<pg8::u32x4*>(rowp + bj * 128) = o;
        }
      }
  }
};

DEVINL void phase_p1(const Params& p, int layer, int w, int nw, char* smem, int gwid) {
  EpiBf16 E; E.O = reinterpret_cast<bf16_t*>(p.U1); E.ldc = 2048;
  pg8::ASelOne as; as.A = (const char*)p.hbuf;
  pg8::StaticOrder S; S.init(TT, 2048, nw, w);
  pg8::gemm_phase<EpiBf16, pg8::ASelOne>((PG8_LAS unsigned char*)smem, as, p.wq_t + (size_t)layer * 2048 * 1024, 1024, S, E, gwid);
}

#define U1_S_OFF ((size_t)TT * 2048 * 2)
DEVINL void phase_p2(const Params& p, int layer, int w, int nw, char* smem, int gwid) {
  GEMM_LANE_VARS
  const int half = tidx(gwid) >> 8;
  char* sh = smem + half * 16384;
  const bf16_t* qb = reinterpret_cast<const bf16_t*>(p.U1);
  float* sb = reinterpret_cast<float*>(p.U1 + U1_S_OFF);
  const int NTILES = 96 * 16;
  for (int it = 0; it * nw * 2 < NTILES; ++it) {
    int tile = (it * nw + w) * 2 + half;
    const bool valid = tile < NTILES;
    if (!valid) tile = 0;
    const int ct = tile / 96, rt = tile % 96;
    const int row0 = rt * 128;
    const int z = ct & 1;
    f32x4 acc[4][4];
    gemm_tile_128(qb + (size_t)row0 * 2048 + ct * 128, 2048, p.keysb + (size_t)(layer * 2 + z) * 16384, 128, 128, sh, acc, gwid);
    if (valid) {
#pragma unroll
      for (int m = 0; m < 4; ++m)
#pragma unroll
        for (int n = 0; n < 4; ++n)
#pragma unroll
          for (int jj = 0; jj < 4; ++jj) {
            int row = row0 + wr * 64 + m * 16 + fq * 4 + jj, col = wc * 64 + n * 16 + fr;
            sb[(size_t)row * 2048 + ct * 128 + col] = acc[m][n][jj];
          }
    }
  }
}

#define DPP_QP_1032 0xB1
#define DPP_QP_2301 0x4E
#define DPP_ROW_HALF_MIRROR 0x141
#define DPP_ROW_MIRROR 0x140
DEVINL unsigned umax_(unsigned a, unsigned b) { return a > b ? a : b; }
DEVINL unsigned umin_(unsigned a, unsigned b) { return a < b ? a : b; }
DEVINL unsigned row_max_u(unsigned v) {
  v = umax_(v, (unsigned)__builtin_amdgcn_update_dpp(0, (int)v, DPP_QP_1032, 0xf, 0xf, true));
  v = umax_(v, (unsigned)__builtin_amdgcn_update_dpp(0, (int)v, DPP_QP_2301, 0xf, 0xf, true));
  v = umax_(v, (unsigned)__builtin_amdgcn_update_dpp(0, (int)v, DPP_ROW_HALF_MIRROR, 0xf, 0xf, true));
  v = umax_(v, (unsigned)__builtin_amdgcn_update_dpp(0, (int)v, DPP_ROW_MIRROR, 0xf, 0xf, true));
  return v;
}
DEVINL float row_max_f(float v) {
  v = fmaxf(v, __int_as_float(__builtin_amdgcn_update_dpp(0, __float_as_int(v), DPP_QP_1032, 0xf, 0xf, true)));
  v = fmaxf(v, __int_as_float(__builtin_amdgcn_update_dpp(0, __float_as_int(v), DPP_QP_2301, 0xf, 0xf, true)));
  v = fmaxf(v, __int_as_float(__builtin_amdgcn_update_dpp(0, __float_as_int(v), DPP_ROW_HALF_MIRROR, 0xf, 0xf, true)));
  v = fmaxf(v, __int_as_float(__builtin_amdgcn_update_dpp(0, __float_as_int(v), DPP_ROW_MIRROR, 0xf, 0xf, true)));
  return v;
}
DEVINL float row_sum_f(float v) {
  v += __int_as_float(__builtin_amdgcn_update_dpp(0, __float_as_int(v), DPP_QP_1032, 0xf, 0xf, true));
  v += __int_as_float(__builtin_amdgcn_update_dpp(0, __float_as_int(v), DPP_QP_2301, 0xf, 0xf, true));
  v += __int_as_float(__builtin_amdgcn_update_dpp(0, __float_as_int(v), DPP_ROW_HALF_MIRROR, 0xf, 0xf, true));
  v += __int_as_float(__builtin_amdgcn_update_dpp(0, __float_as_int(v), DPP_ROW_MIRROR, 0xf, 0xf, true));
  return v;
}
DEVINL float unordf(unsigned u) { return __uint_as_float((u & 0x80000000u) ? (u ^ 0x80000000u) : ~u); }
#define CSWAP(a, b) { const unsigned _hi = umax_(a, b), _lo = umin_(a, b); a = _hi; b = _lo; }
DEVINL void slot_ij(int s, int& i, int& j) {
  if (s < 16) { i = 0; j = s; }
  else if (s < 24) { i = 1; j = s - 16; }
  else if (s < 29) { i = 2; j = s - 24; }
  else if (s < 33) { i = 3; j = s - 29; }
  else if (s < 36) { i = 4; j = s - 33; }
  else if (s < 42) { i = 5 + ((s - 36) >> 1); j = (s - 36) & 1; }
  else { i = s - 34; j = 0; }
}
DEVINL void phase_p3(const Params& p, int layer, int w, int nw, char* smem, int gwid) {
  const int lane = tidx(gwid) & 63, wid = tidx(gwid) >> 6;
  const int fr = lane & 15, row = lane >> 4, pr = lane >> 5, l32 = lane & 31;
  const int gw = w * NWAVES + wid, ngw = nw * NWAVES;
  const float* sb = reinterpret_cast<const float*>(p.U1 + U1_S_OFF);
  float* svl = reinterpret_cast<float*>(smem) + wid * 128;
  int* sil = reinterpret_cast<int*>(smem) + wid * 128 + 64;
  int iA, jA, iB, jB;
  slot_ij(l32, iA, jA);
  const bool validB = (l32 + 32) < 50;
  slot_ij(validB ? (l32 + 32) : 0, iB, jB);
  for (int bt = gw; bt < TT * 4; bt += ngw) {
    const int t = bt >> 2, hp = bt & 3;
    {
      const int h = hp * 2 + (row >> 1), z = row & 1;
      const float* sp = sb + (size_t)t * 2048 + (h * 2 + z) * 128;
      const float4 a = *reinterpret_cast<const float4*>(sp + fr * 4);
      const float4 b = *reinterpret_cast<const float4*>(sp + 64 + fr * 4);
      unsigned k0 = (ordf(a.x) & ~127u) | (unsigned)(127 - (4 * fr + 0));
      unsigned k1 = (ordf(a.y) & ~127u) | (unsigned)(127 - (4 * fr + 1));
      unsigned k2 = (ordf(a.z) & ~127u) | (unsigned)(127 - (4 * fr + 2));
      unsigned k3 = (ordf(a.w) & ~127u) | (unsigned)(127 - (4 * fr + 3));
      unsigned k4 = (ordf(b.x) & ~127u) | (unsigned)(127 - (64 + 4 * fr + 0));
      unsigned k5 = (ordf(b.y) & ~127u) | (unsigned)(127 - (64 + 4 * fr + 1));
      unsigned k6 = (ordf(b.z) & ~127u) | (unsigned)(127 - (64 + 4 * fr + 2));
      unsigned k7 = (ordf(b.w) & ~127u) | (unsigned)(127 - (64 + 4 * fr + 3));
      CSWAP(k0, k1); CSWAP(k2, k3); CSWAP(k4, k5); CSWAP(k6, k7);
      CSWAP(k0, k2); CSWAP(k1, k3); CSWAP(k4, k6); CSWAP(k5, k7);
      CSWAP(k1, k2); CSWAP(k5, k6); CSWAP(k0, k4); CSWAP(k3, k7);
      CSWAP(k1, k5); CSWAP(k2, k6);
      CSWAP(k1, k4); CSWAP(k3, k6);
      CSWAP(k2, k4); CSWAP(k3, k5);
      CSWAP(k3, k4);
      unsigned mine = 0;
#pragma unroll
      for (int it = 0; it < 16; ++it) {
        const unsigned m = row_max_u(k0);
        if (fr == it) mine = m;
        const bool c = (k0 == m);
        k0 = c ? k1 : k0; k1 = c ? k2 : k1; k2 = c ? k3 : k2; k3 = c ? k4 : k3;
        k4 = c ? k5 : k4; k5 = c ? k6 : k5; k6 = c ? k7 : k6; k7 = c ? 0u : k7;
      }
      __builtin_amdgcn_wave_barrier();
      svl[row * 16 + fr] = unordf(mine & ~127u);
      sil[row * 16 + fr] = 127 - (int)(mine & 127u);
      __builtin_amdgcn_wave_barrier();
    }
    {
      const float* v0 = svl + (2 * pr) * 16;
      const float* v1 = svl + (2 * pr + 1) * 16;
      unsigned kA = (ordf(v0[iA] + v1[jA]) & ~63u) | (unsigned)(63 - l32);
      unsigned kB = validB ? ((ordf(v0[iB] + v1[jB]) & ~63u) | (unsigned)(63 - (l32 + 32))) : 0u;
      unsigned mine = 0;
#pragma unroll
      for (int it = 0; it < 16; ++it) {
        unsigned m = row_max_u(umax_(kA, kB));
        m = umax_(m, (unsigned)__shfl_xor((int)m, 16));
        if (l32 == it) mine = m;
        kA = (kA == m) ? 0u : kA;
        kB = (kB == m) ? 0u : kB;
      }
      int ii, jj;
      slot_ij(63 - (int)(mine & 63u), ii, jj);
      ii &= 15; jj &= 15;
      const float cv = v0[ii] + v1[jj];
      const int eidx = sil[(2 * pr) * 16 + ii] * 128 + sil[(2 * pr + 1) * 16 + jj];
      const float mx = row_max_f(cv);
      const float ex = __expf(cv - mx);
      const float sm = row_sum_f(ex);
      if (l32 < 16) {
        const int h = hp * 2 + pr;
        p.pidx[(size_t)t * 128 + h * 16 + l32] = eidx;
        p.pgate[(size_t)t * 128 + h * 16 + l32] = ex / sm;
      }
    }
  }
}

DEVINL float gelu_exact(float x) { return 0.5f * x * (1.0f + erff(x * 0.7071067811865476f)); }

DEVINL void phase_p4(const Params& p, int layer, int w, int nw, char* smem, int gwid) {
  const int tid = tidx(gwid), lane = tid & 63, wid = tid >> 6;
  const int fr = lane & 15, fq = lane >> 4;
  const int gw = w * NWAVES + wid, ngw = nw * NWAVES;
  const unsigned char* U = reinterpret_cast<const unsigned char*>(p.ub) + (size_t)layer * 16384 * 1024;
  const unsigned char* V = reinterpret_cast<const unsigned char*>(p.vb) + (size_t)layer * 16384 * 1024;
  const float* uinv = p.uinv + layer * 16384;
  const float* vinv = p.vinv + layer * 16384;
  const float* lng = p.in[9] + (size_t)(layer * 2 + 1) * 1024;
  const float* lnb = p.in[10] + (size_t)(layer * 2 + 1) * 1024;
  float* xout = (layer == 3) ? p.out : p.xbuf;
  char* wl = smem + wid * (3072 + 16384);
  unsigned char* ring = reinterpret_cast<unsigned char*>(wl) + 3072;
  unsigned char* xhi = reinterpret_cast<unsigned char*>(wl);
  unsigned char* xlo = xhi + 1024;
  float* wgt = reinterpret_cast<float*>(wl + 2048);
  int* il = reinterpret_cast<int*>(wl + 2560);
  for (int t = gw; t < TT; t += ngw) {
    __builtin_amdgcn_wave_barrier();
    const int gl = tidx(gwid) & 63;
    float xinv;
    {
      const uint4 a = *reinterpret_cast<const uint4*>(p.hbuf + (size_t)t * DM + gl * 16);
      const uint4 b = *reinterpret_cast<const uint4*>(p.hbuf + (size_t)t * DM + gl * 16 + 8);
      float x[16];
      x[0] = bflo(a.x); x[1] = bfhi(a.x); x[2] = bflo(a.y); x[3] = bfhi(a.y); x[4] = bflo(a.z); x[5] = bfhi(a.z); x[6] = bflo(a.w); x[7] = bfhi(a.w);
      x[8] = bflo(b.x); x[9] = bfhi(b.x); x[10] = bflo(b.y); x[11] = bfhi(b.y); x[12] = bflo(b.z); x[13] = bfhi(b.z); x[14] = bflo(b.w); x[15] = bfhi(b.w);
      float mx = 0.f;
#pragma unroll
      for (int q = 0; q < 16; ++q) mx = fmaxf(mx, fabsf(x[q]));
#pragma unroll
      for (int o = 32; o > 0; o >>= 1) mx = fmaxf(mx, __shfl_xor(mx, o));
      mx = fmaxf(mx, 1e-30f);
      const float sc = 440.0f / mx;
      xinv = mx * (1.0f / 440.0f);
      uint4 h4, l4;
      unsigned* hw = reinterpret_cast<unsigned*>(&h4);
      unsigned* lw = reinterpret_cast<unsigned*>(&l4);
#pragma unroll
      for (int q = 0; q < 4; ++q) {
        const float y0 = x[q * 4] * sc, y1 = x[q * 4 + 1] * sc, y2 = x[q * 4 + 2] * sc, y3 = x[q * 4 + 3] * sc;
        int pk = 0;
        pk = __builtin_amdgcn_cvt_pk_fp8_f32(y0, y1, pk, false);
        pk = __builtin_amdgcn_cvt_pk_fp8_f32(y2, y3, pk, true);
        const float r0 = y0 - __builtin_amdgcn_cvt_f32_fp8(pk, 0), r1 = y1 - __builtin_amdgcn_cvt_f32_fp8(pk, 1);
        const float r2 = y2 - __builtin_amdgcn_cvt_f32_fp8(pk, 2), r3 = y3 - __builtin_amdgcn_cvt_f32_fp8(pk, 3);
        int pl = 0;
        pl = __builtin_amdgcn_cvt_pk_fp8_f32(r0, r1, pl, false);
        pl = __builtin_amdgcn_cvt_pk_fp8_f32(r2, r3, pl, true);
        hw[q] = (unsigned)pk; lw[q] = (unsigned)pl;
      }
      *reinterpret_cast<uint4*>(xhi + lane * 16) = h4;
      *reinterpret_cast<uint4*>(xlo + lane * 16) = l4;
      il[lane] = p.pidx[(size_t)t * 128 + gl];
      il[64 + lane] = p.pidx[(size_t)t * 128 + 64 + gl];
    }
    __builtin_amdgcn_wave_barrier();
    f32x4 acc[8];
#pragma unroll
    for (int g = 0; g < 8; ++g) acc[g] = (f32x4){0.f, 0.f, 0.f, 0.f};
    {
      const int dr = lane >> 3, dpc = (lane & 7) ^ (lane >> 3);
      unsigned rowoff[8][2];
#pragma unroll
      for (int g = 0; g < 8; ++g) {
        rowoff[g][0] = (unsigned)il[g * 16 + dr] * 1024u + (unsigned)dpc * 16u;
        rowoff[g][1] = (unsigned)il[g * 16 + 8 + dr] * 1024u + (unsigned)dpc * 16u;
      }
      const int rd0 = fr * 128 + ((fq ^ (fr & 7)) * 16), rd1 = fr * 128 + (((4 + fq) ^ (fr & 7)) * 16);
#define P4_ISSUE(tile_c, tile_g, slot) do { \
        __builtin_amdgcn_global_load_lds((const unsigned*)(U + (rowoff[tile_g][0] + (unsigned)((tile_c) * 128))), (unsigned*)(ring + (slot) * 2048 + lane * 16), 16, 0, 0); \
        __builtin_amdgcn_global_load_lds((const unsigned*)(U + (rowoff[tile_g][1] + (unsigned)((tile_c) * 128))), (unsigned*)(ring + (slot) * 2048 + 1024 + lane * 16), 16, 0, 0); } while (0)
#pragma unroll
      for (int g = 0; g < 8; ++g) P4_ISSUE(0, g, g);
#pragma unroll 1
      for (int c = 0; c < 8; ++c) {
        const uint4 xh0v = *reinterpret_cast<const uint4*>(xhi + c * 128 + fq * 16);
        const uint4 xh1v = *reinterpret_cast<const uint4*>(xhi + c * 128 + 64 + fq * 16);
        const uint4 xl0v = *reinterpret_cast<const uint4*>(xlo + c * 128 + fq * 16);
        const uint4 xl1v = *reinterpret_cast<const uint4*>(xlo + c * 128 + 64 + fq * 16);
#define LL(v, a, b) ((long)(((unsigned long long)(v).b << 32) | (v).a))
#pragma unroll
        for (int g = 0; g < 8; ++g) {
          if (c < 7) asm volatile("s_waitcnt vmcnt(14)" ::: "memory");
          else {
            if (g == 0) asm volatile("s_waitcnt vmcnt(14)" ::: "memory");
            else if (g == 1) asm volatile("s_waitcnt vmcnt(12)" ::: "memory");
            else if (g == 2) asm volatile("s_waitcnt vmcnt(10)" ::: "memory");
            else if (g == 3) asm volatile("s_waitcnt vmcnt(8)" ::: "memory");
            else if (g == 4) asm volatile("s_waitcnt vmcnt(6)" ::: "memory");
            else if (g == 5) asm volatile("s_waitcnt vmcnt(4)" ::: "memory");
            else if (g == 6) asm volatile("s_waitcnt vmcnt(2)" ::: "memory");
            else asm volatile("s_waitcnt vmcnt(0)" ::: "memory");
          }
          const uint4 a0v = *reinterpret_cast<const uint4*>(ring + g * 2048 + rd0);
          const uint4 a1v = *reinterpret_cast<const uint4*>(ring + g * 2048 + rd1);
          asm volatile("s_waitcnt lgkmcnt(0)" ::: "memory");
          if (c < 7) P4_ISSUE(c + 1, g, g);
          acc[g] = __builtin_amdgcn_mfma_f32_16x16x32_fp8_fp8(LL(a0v, x, y), LL(xh0v, x, y), acc[g], 0, 0, 0);
          acc[g] = __builtin_amdgcn_mfma_f32_16x16x32_fp8_fp8(LL(a0v, z, w), LL(xh0v, z, w), acc[g], 0, 0, 0);
          acc[g] = __builtin_amdgcn_mfma_f32_16x16x32_fp8_fp8(LL(a1v, x, y), LL(xh1v, x, y), acc[g], 0, 0, 0);
          acc[g] = __builtin_amdgcn_mfma_f32_16x16x32_fp8_fp8(LL(a1v, z, w), LL(xh1v, z, w), acc[g], 0, 0, 0);
          acc[g] = __builtin_amdgcn_mfma_f32_16x16x32_fp8_fp8(LL(a0v, x, y), LL(xl0v, x, y), acc[g], 0, 0, 0);
          acc[g] = __builtin_amdgcn_mfma_f32_16x16x32_fp8_fp8(LL(a0v, z, w), LL(xl0v, z, w), acc[g], 0, 0, 0);
          acc[g] = __builtin_amdgcn_mfma_f32_16x16x32_fp8_fp8(LL(a1v, x, y), LL(xl1v, x, y), acc[g], 0, 0, 0);
          acc[g] = __builtin_amdgcn_mfma_f32_16x16x32_fp8_fp8(LL(a1v, z, w), LL(xl1v, z, w), acc[g], 0, 0, 0);
        }
      }
#undef LL
#undef P4_ISSUE
    }
#pragma unroll
    for (int g = 0; g < 8; ++g) {
      const float4 gt = *reinterpret_cast<const float4*>(p.pgate + (size_t)t * 128 + g * 16 + fq * 4);
      const int e0 = g * 16 + fq * 4;
      const int i0 = il[e0], i1 = il[e0 + 1], i2 = il[e0 + 2], i3 = il[e0 + 3];
      float4 wv;
      wv.x = gt.x * gelu_exact(acc[g][0] * (uinv[i0] * xinv)) * vinv[i0];
      wv.y = gt.y * gelu_exact(acc[g][1] * (uinv[i1] * xinv)) * vinv[i1];
      wv.z = gt.z * gelu_exact(acc[g][2] * (uinv[i2] * xinv)) * vinv[i2];
      wv.w = gt.w * gelu_exact(acc[g][3] * (uinv[i3] * xinv)) * vinv[i3];
      if (fr == 0) *reinterpret_cast<float4*>(wgt + e0) = wv;
    }
    __builtin_amdgcn_wave_barrier();
    float f[16];
#pragma unroll
    for (int e = 0; e < 16; ++e) f[e] = 0.f;
    {
#define P4V_ISSUE(ee, slot) do { const int _idx = __builtin_amdgcn_readfirstlane(il[ee]); \
        __builtin_amdgcn_global_load_lds((const unsigned*)(V + (size_t)_idx * 1024 + lane * 16), (unsigned*)(ring + (slot) * 1024 + lane * 16), 16, 0, 0); } while (0)
#define P4V_ACC(cv, we) do { const unsigned _cw[4] = {(cv).x, (cv).y, (cv).z, (cv).w}; \
        _Pragma("unroll") for (int q = 0; q < 4; ++q) { \
          const __attribute__((ext_vector_type(2))) float lo2 = __builtin_amdgcn_cvt_pk_f32_fp8((int)_cw[q], false); \
          const __attribute__((ext_vector_type(2))) float hi2 = __builtin_amdgcn_cvt_pk_f32_fp8((int)_cw[q], true); \
          f[q * 4 + 0] += (we) * lo2.x; f[q * 4 + 1] += (we) * lo2.y; f[q * 4 + 2] += (we) * hi2.x; f[q * 4 + 3] += (we) * hi2.y; } } while (0)
#pragma unroll
      for (int k = 0; k < 16; ++k) P4V_ISSUE(k, k);
#pragma unroll 1
      for (int eb = 0; eb < 7; ++eb) {
#pragma unroll
        for (int k = 0; k < 16; ++k) {
          asm volatile("s_waitcnt vmcnt(15)" ::: "memory");
          const uint4 cv = *reinterpret_cast<const uint4*>(ring + k * 1024 + lane * 16);
          const float we = wgt[eb * 16 + k];
          asm volatile("s_waitcnt lgkmcnt(0)" ::: "memory");
          P4V_ISSUE((eb + 1) * 16 + k, k);
          P4V_ACC(cv, we);
        }
      }
      {
        uint4 cv; float we;
#define P4V_TAIL(k, n) asm volatile("s_waitcnt vmcnt(" #n ")" ::: "memory"); cv = *reinterpret_cast<const uint4*>(ring + (k) * 1024 + lane * 16); we = wgt[112 + (k)]; P4V_ACC(cv, we);
        P4V_TAIL(0, 15) P4V_TAIL(1, 14) P4V_TAIL(2, 13) P4V_TAIL(3, 12) P4V_TAIL(4, 11) P4V_TAIL(5, 10) P4V_TAIL(6, 9) P4V_TAIL(7, 8)
        P4V_TAIL(8, 7) P4V_TAIL(9, 6) P4V_TAIL(10, 5) P4V_TAIL(11, 4) P4V_TAIL(12, 3) P4V_TAIL(13, 2) P4V_TAIL(14, 1) P4V_TAIL(15, 0)
#undef P4V_TAIL
      }
#undef P4V_ISSUE
#undef P4V_ACC
    }
    const int gl2 = tidx(gwid) & 63;
    const float* md = p.mod + ((size_t)layer * 9 + cond_of_row(t)) * 6144 + 5 * 1024;
    float zz[16];
    float s = 0.f;
#pragma unroll
    for (int q = 0; q < 4; ++q) {
      const int col = gl2 * 16 + q * 4;
      const float4 x0 = *reinterpret_cast<const float4*>(p.xbuf + (size_t)t * DM + col);
      const float4 g0 = *reinterpret_cast<const float4*>(md + col);
      zz[q * 4 + 0] = ALPHA_F * x0.x + g0.x * f[q * 4 + 0];
      zz[q * 4 + 1] = ALPHA_F * x0.y + g0.y * f[q * 4 + 1];
      zz[q * 4 + 2] = ALPHA_F * x0.z + g0.z * f[q * 4 + 2];
      zz[q * 4 + 3] = ALPHA_F * x0.w + g0.w * f[q * 4 + 3];
      s += zz[q * 4] + zz[q * 4 + 1] + zz[q * 4 + 2] + zz[q * 4 + 3];
    }
    const float mean = wave_sum(s) * (1.0f / 1024.0f);
    float sv = 0.f;
#pragma unroll
    for (int e = 0; e < 16; ++e) { float d = zz[e] - mean; sv += d * d; }
    const float rstd = rsqrtf(wave_sum(sv) * (1.0f / 1024.0f) + LN_EPS_F);
#pragma unroll
    for (int q = 0; q < 4; ++q) {
      const int col = gl2 * 16 + q * 4;
      const float4 g0 = *reinterpret_cast<const float4*>(lng + col);
      const float4 b0 = *reinterpret_cast<const float4*>(lnb + col);
      float4 o0;
      o0.x = (zz[q * 4 + 0] - mean) * rstd * g0.x + b0.x;
      o0.y = (zz[q * 4 + 1] - mean) * rstd * g0.y + b0.y;
      o0.z = (zz[q * 4 + 2] - mean) * rstd * g0.z + b0.z;
      o0.w = (zz[q * 4 + 3] - mean) * rstd * g0.w + b0.w;
      *reinterpret_cast<float4*>(xout + (size_t)t * DM + col) = o0;
    }
  }
}

DEVINL void phase_a1(const Params& p, int layer, int w, int nw, int gwid) {
  const int lane = tidx(gwid) & 63;
  const int gw = w * NWAVES + (tidx(gwid) >> 6), ngw = nw * NWAVES;
  for (int row = gw; row < TT; row += ngw) {
    const float* md = p.mod + ((size_t)layer * 9 + cond_of_row(row)) * 6144;
#pragma unroll
    for (int k = 0; k < 4; ++k) {
      const int col = k * 256 + lane * 4;
      const float4 x = *reinterpret_cast<const float4*>(p.xbuf + (size_t)row * DM + col);
      const float4 sh = *reinterpret_cast<const float4*>(md + col);
      const float4 sc = *reinterpret_cast<const float4*>(md + 1024 + col);
      uint2 o;
      o.x = pack2(x.x * (1.0f + sc.x) + sh.x, x.y * (1.0f + sc.y) + sh.y);
      o.y = pack2(x.z * (1.0f + sc.z) + sh.z, x.w * (1.0f + sc.w) + sh.w);
      *reinterpret_cast<uint2*>(p.hbuf + (size_t)row * DM + col) = o;
    }
  }
}

DEVINL void phase_a2(const Params& p, int layer, int w, int nw, char* smem, int gwid) {
  const int j = layer >> 1;
  EpiBf16 E; E.O = reinterpret_cast<bf16_t*>(p.U1); E.ldc = 1536;
  pg8::ASelOne as; as.A = (const char*)p.hbuf;
  pg8::StaticOrder S; S.init(TT, 1536, nw, w);
  pg8::gemm_phase<EpiBf16, pg8::ASelOne>((PG8_LAS unsigned char*)smem, as, p.attn_wqkv_t + (size_t)j * 1536 * 1024, 1024, S, E, gwid);
}

DEVINL void load16(const bf16_t* src, float (&x)[16]) {
  const uint4 a = *reinterpret_cast<const uint4*>(src);
  const uint4 b = *reinterpret_cast<const uint4*>(src + 8);
  x[0] = bflo(a.x); x[1] = bfhi(a.x); x[2] = bflo(a.y); x[3] = bfhi(a.y); x[4] = bflo(a.z); x[5] = bfhi(a.z); x[6] = bflo(a.w); x[7] = bfhi(a.w);
  x[8] = bflo(b.x); x[9] = bfhi(b.x); x[10] = bflo(b.y); x[11] = bfhi(b.y); x[12] = bflo(b.z); x[13] = bfhi(b.z); x[14] = bflo(b.w); x[15] = bfhi(b.w);
}
DEVINL void store16bf(bf16_t* dst, const float (&x)[16]) {
  uint4 a, b;
  a.x = pack2(x[0], x[1]); a.y = pack2(x[2], x[3]); a.z = pack2(x[4], x[5]); a.w = pack2(x[6], x[7]);
  b.x = pack2(x[8], x[9]); b.y = pack2(x[10], x[11]); b.z = pack2(x[12], x[13]); b.w = pack2(x[14], x[15]);
  *reinterpret_cast<uint4*>(dst) = a; *reinterpret_cast<uint4*>(dst + 8) = b;
}
DEVINL void headnorm_rope(float (&x)[16], const float* nwgt, int quarter, bool lat, int t, const float* rope) {
  float ss = 0.f;
#pragma unroll
  for (int e = 0; e < 16; ++e) ss += x[e] * x[e];
  ss += __shfl_xor(ss, 1); ss += __shfl_xor(ss, 2);
  const float rinv = rsqrtf(ss * (1.0f / 64.0f) + RMS_EPS_F);
#pragma unroll
  for (int e = 0; e < 16; ++e) x[e] = x[e] * rinv * nwgt[quarter * 16 + e];
  if (lat) {
    const int pos = (quarter < 2) ? (t >> 6) : (t & 63);
    const bool hi = quarter & 1;
#pragma unroll
    for (int e = 0; e < 16; ++e) {
      const float other = __shfl_xor(x[e], 1);
      const float c = rope[(pos * 16 + e) * 2], s = rope[(pos * 16 + e) * 2 + 1];
      x[e] = hi ? (x[e] * c + other * s) : (x[e] * c - other * s);
    }
  }
}

DEVINL void phase_a2b(const Params& p, int layer, int w, int nw, int gwid) {
  const int j = layer >> 1;
  const int lane = tidx(gwid) & 63;
  const int gw = w * NWAVES + (tidx(gwid) >> 6), ngw = nw * NWAVES;
  const bf16_t* qkv = reinterpret_cast<const bf16_t*>(p.U1);
  bf16_t* qb = reinterpret_cast<bf16_t*>(p.U2);
  const float* qn = p.in[29] + j * 64;
  const float* kn = p.in[30] + j * 64;
  for (int row = gw; row < TT; row += ngw) {
    const bool lat = row >= TCTX;
    const int t = lat ? ((row - TCTX) & 1023) : (row & 255);
    const int b = lat ? ((row - TCTX) >> 10) : (row >> 8);
    const bf16_t* src = qkv + (size_t)row * 1536;
    {
      float x[16];
      load16(src + lane * 16, x);
      headnorm_rope(x, qn, lane & 3, lat, t, p.rope);
#pragma unroll
      for (int e = 0; e < 16; ++e) x[e] *= QSCALE_F;
      store16bf(qb + (size_t)row * DM + lane * 16, x);
    }
    if (lane < 16) {
      const int kvh = lane >> 2, quarter = lane & 3;
      float x[16];
      load16(src + 1024 + lane * 16, x);
      headnorm_rope(x, kn, quarter, false, t, p.rope);
      if (lat) {
        const int pos = (quarter < 2) ? (t >> 6) : (t & 63);
        const bool hi = quarter & 1;
#pragma unroll
        for (int e = 0; e < 16; ++e) {
          const float other = __shfl_xor(x[e], 1);
          const float c = p.rope[(pos * 16 + e) * 2], s = p.rope[(pos * 16 + e) * 2 + 1];
          x[e] = hi ? (x[e] * c + other * s) : (x[e] * c - other * s);
        }
        store16bf(p.Klat + ((size_t)((j * 8 + b) * 4 + kvh) * 1536 + 512 + t) * 64 + quarter * 16, x);
      } else {
        store16bf(p.Kctx + ((size_t)((j * 16 + b) * 4 + kvh) * 256 + t) * 64 + quarter * 16, x);
        float* ko = p.out + OUT_CK + ((size_t)(b * 2 + j) * 256 + t) * 256 + kvh * 64 + quarter * 16;
#pragma unroll
        for (int q4 = 0; q4 < 4; ++q4) reinterpret_cast<float4*>(ko)[q4] = make_float4(x[q4 * 4], x[q4 * 4 + 1], x[q4 * 4 + 2], x[q4 * 4 + 3]);
      }
    } else if (lane < 32) {
      const int l2 = lane - 16;
      const int kvh = l2 >> 2, quarter = l2 & 3;
      float x[16];
      load16(src + 1280 + l2 * 16, x);
      if (lat) {
        bf16_t* vd = p.VlatT + (size_t)((j * 8 + b) * 4 + kvh) * 64 * 1536 + 512 + t;
#pragma unroll
        for (int e = 0; e < 16; ++e) vd[(size_t)(quarter * 16 + e) * 1536] = f2bf(x[e]);
      } else {
        bf16_t* vd = p.VctxT + (size_t)((j * 16 + b) * 4 + kvh) * 64 * 256 + t;
#pragma unroll
        for (int e = 0; e < 16; ++e) vd[(size_t)(quarter * 16 + e) * 256] = f2bf(x[e]);
        float* vo = p.out + OUT_CV + ((size_t)(b * 2 + j) * 256 + t) * 256 + kvh * 64 + quarter * 16;
#pragma unroll
        for (int q4 = 0; q4 < 4; ++q4) reinterpret_cast<float4*>(vo)[q4] = make_float4(x[q4 * 4], x[q4 * 4 + 1], x[q4 * 4 + 2], x[q4 * 4 + 3]);
      }
    }
  }
}

DEVINL void phase_a3(const Params& p, int layer, int w, int nw, char* smem, int gwid) {
  const int j = layer >> 1;
  const int lane = tidx(gwid) & 63, wid = __builtin_amdgcn_readfirstlane(tidx(gwid) >> 6);
  const int ql = lane & 31, hh = lane >> 5;
  const bf16_t* qb = reinterpret_cast<const bf16_t*>(p.U2);
  const int drow = wid * 8 + (lane >> 3);
  const int dsp = (lane & 7) ^ ((lane >> 3) & 7);
  for (int item = w; item < 768; item += nw) {
    int kvh, Tk, row0;
    const bf16_t *Kb, *Vt;
    if (item < 512) {
      const int b = item >> 6, qblk = item & 15;
      kvh = (item >> 4) & 3;
      Kb = p.Klat + (size_t)((j * 8 + b) * 4 + kvh) * 1536 * 64;
      Vt = p.VlatT + (size_t)((j * 8 + b) * 4 + kvh) * 64 * 1536;
      Tk = 1536; row0 = TCTX + b * 1024 + qblk * 64;
    } else {
      const int it = item - 512;
      const int b = it >> 4, qblk = it & 3;
      kvh = (it >> 2) & 3;
      Kb = p.Kctx + (size_t)((j * 16 + b) * 4 + kvh) * 256 * 64;
      Vt = p.VctxT + (size_t)((j * 16 + b) * 4 + kvh) * 64 * 256;
      Tk = 256; row0 = b * 256 + qblk * 64;
    }
    const int hq = kvh * 4 + (wid >> 1);
    const int qrow = row0 + (wid & 1) * 32 + ql;
    bf16x8 bq[4];
#pragma unroll
    for (int ks = 0; ks < 4; ++ks) bq[ks] = *reinterpret_cast<const bf16x8*>(qb + (size_t)qrow * DM + hq * 64 + ks * 16 + hh * 8);
    f32x16 o0, o1;
#pragma unroll
    for (int r = 0; r < 16; ++r) { o0[r] = 0.f; o1[r] = 0.f; }
    float mrun = -1e30f, lrun = 0.f;
    const int ntile = Tk >> 6;
#define A3_DMA(kt_, st_) do { \
      __builtin_amdgcn_global_load_lds((const unsigned*)(Kb + (size_t)((kt_) * 64 + drow) * 64 + dsp * 8), (unsigned*)(smem + (st_) * 16384 + wid * 1024 + lane * 16), 16, 0, 0); \
      __builtin_amdgcn_global_load_lds((const unsigned*)(Vt + (size_t)drow * Tk + (kt_) * 64 + dsp * 8), (unsigned*)(smem + (st_) * 16384 + 8192 + wid * 1024 + lane * 16), 16, 0, 0); } while (0)
    __syncthreads();
    A3_DMA(0, 0);
    for (int kt = 0; kt < ntile; ++kt) {
      asm volatile("s_waitcnt vmcnt(0)" ::: "memory");
      __syncthreads();
      if (kt + 1 < ntile) A3_DMA(kt + 1, (kt + 1) & 1);
      const char* Kt_ = smem + (kt & 1) * 16384;
      const char* Vt_ = Kt_ + 8192;
      f32x16 sacc[2];
#pragma unroll
      for (int kb2 = 0; kb2 < 2; ++kb2) {
#pragma unroll
        for (int r = 0; r < 16; ++r) sacc[kb2][r] = 0.f;
        const int r_ = kb2 * 32 + ql;
#pragma unroll
        for (int ks = 0; ks < 4; ++ks) {
          const bf16x8 ka = *reinterpret_cast<const bf16x8*>(Kt_ + r_ * 128 + (((ks * 2 + hh) ^ (r_ & 7)) * 16));
          sacc[kb2] = __builtin_amdgcn_mfma_f32_32x32x16_bf16(ka, bq[ks], sacc[kb2], 0, 0, 0);
        }
      }
      float tmax = sacc[0][0];
#pragma unroll
      for (int r = 1; r < 16; ++r) tmax = fmaxf(tmax, sacc[0][r]);
#pragma unroll
      for (int r = 0; r < 16; ++r) tmax = fmaxf(tmax, sacc[1][r]);
      tmax = fmaxf(tmax, __shfl_xor(tmax, 32));
      const float mnew = fmaxf(mrun, tmax);
      const float corr = exp2f(mrun - mnew);
      mrun = mnew;
      lrun *= corr;
#pragma unroll
      for (int r = 0; r < 16; ++r) { o0[r] *= corr; o1[r] *= corr; }
#pragma unroll
      for (int kb2 = 0; kb2 < 2; ++kb2) {
        float pv[16];
#pragma unroll
        for (int r = 0; r < 16; ++r) { pv[r] = exp2f(sacc[kb2][r] - mnew); lrun += pv[r]; }
#pragma unroll
        for (int s2 = 0; s2 < 2; ++s2) {
          union { bf16x8 v; unsigned u[4]; } pb;
#pragma unroll
          for (int q = 0; q < 4; ++q) pb.u[q] = pack2(pv[s2 * 8 + q * 2], pv[s2 * 8 + q * 2 + 1]);
          const int P1 = 4 * kb2 + 2 * s2;
#pragma unroll
          for (int dblk = 0; dblk < 2; ++dblk) {
            const int r_ = dblk * 32 + ql;
            const uint2 lo = *reinterpret_cast<const uint2*>(Vt_ + r_ * 128 + ((P1 ^ (r_ & 7)) * 16) + 8 * hh);
            const uint2 hi = *reinterpret_cast<const uint2*>(Vt_ + r_ * 128 + (((P1 + 1) ^ (r_ & 7)) * 16) + 8 * hh);
            union { bf16x8 v; unsigned u[4]; } va;
            va.u[0] = lo.x; va.u[1] = lo.y; va.u[2] = hi.x; va.u[3] = hi.y;
            if (dblk == 0) o0 = __builtin_amdgcn_mfma_f32_32x32x16_bf16(va.v, pb.v, o0, 0, 0, 0);
            else o1 = __builtin_amdgcn_mfma_f32_32x32x16_bf16(va.v, pb.v, o1, 0, 0, 0);
          }
        }
      }
    }
#undef A3_DMA
    const float ltot = lrun + __shfl_xor(lrun, 32);
    const float inv = 1.0f / ltot;
#pragma unroll
    for (int g = 0; g < 4; ++g) {
      uint2 oa, ob;
      oa.x = pack2(o0[4 * g] * inv, o0[4 * g + 1] * inv); oa.y = pack2(o0[4 * g + 2] * inv, o0[4 * g + 3] * inv);
      ob.x = pack2(o1[4 * g] * inv, o1[4 * g + 1] * inv); ob.y = pack2(o1[4 * g + 2] * inv, o1[4 * g + 3] * inv);
      *reinterpret_cast<uint2*>(p.abuf + (size_t)qrow * DM + hq * 64 + 8 * g + 4 * hh) = oa;
      *reinterpret_cast<uint2*>(p.abuf + (size_t)qrow * DM + hq * 64 + 32 + 8 * g + 4 * hh) = ob;
    }
  }
}

#define XB_TMO      128
#define XB_XCNT(j)  (256  + 64 * (j))
#define XB_XSUB(j)  (1280 + 64 * (j))
#define XB_XGEN(j)  (2304 + 64 * (j))
#define XB_TOP      3328
#define XB_TOPGEN   3392
#define XCD_BAR_WORDS 3456
#define XB_SPIN_CAP (1u << 22)
#define LAS __attribute__((address_space(3)))

DEVINL unsigned xb_ld(unsigned* p) { return __hip_atomic_load(p, __ATOMIC_RELAXED, __HIP_MEMORY_SCOPE_AGENT); }
DEVINL unsigned xb_add(unsigned* p, unsigned v) { return __hip_atomic_fetch_add(p, v, __ATOMIC_RELAXED, __HIP_MEMORY_SCOPE_AGENT); }
DEVINL unsigned xb_xcc_id() { return (unsigned)__builtin_amdgcn_s_getreg((3 << 11) | 20) & 0xFu; }
#define XB_SPIN(cond, bar) do { unsigned _sp = 0; while (cond) { __builtin_amdgcn_s_sleep(1); \
    if ((++_sp & 255u) == 0u) { if (xb_ld(&(bar)[XB_TMO])) break; if (_sp > XB_SPIN_CAP) { atomicAdd(&(bar)[XB_TMO], 1u); break; } } } } while (0)

struct XcdBarrier { unsigned* bar; unsigned x; volatile LAS unsigned* st; };

DEVINL XcdBarrier xcd_barrier_post(unsigned* bar, volatile LAS unsigned* st) {
  XcdBarrier b; b.bar = bar; b.x = xb_xcc_id(); b.st = st;
  if (threadIdx.x == 0) (void)xb_add(&bar[XB_XCNT(b.x)], 1u);
  return b;
}
DEVINL void xcd_barrier_complete(unsigned* bar, unsigned x, unsigned& nloc, unsigned& nx) {
  const unsigned G = gridDim.x * gridDim.y * gridDim.z;
  unsigned sum, cnt, mine, sp = 0u;
  for (;;) {
    sum = 0u; cnt = 0u; mine = 0u;
#pragma unroll
    for (unsigned j = 0; j < 16; ++j) { const unsigned c = xb_ld(&bar[XB_XCNT(j)]); sum += c; cnt += (c > 0u) ? 1u : 0u; mine = (j == x) ? c : mine; }
    if (sum == G) break;
    __builtin_amdgcn_s_sleep(1);
    if ((++sp & 255u) == 0u) { if (xb_ld(&bar[XB_TMO])) break; if (sp > XB_SPIN_CAP) { atomicAdd(&bar[XB_TMO], 1u); break; } }
  }
  nloc = mine > 0u ? mine : 1u; nx = cnt > 0u ? cnt : 1u;
}
DEVINL void xcd_barrier(const XcdBarrier& b) {
  asm volatile("s_waitcnt vmcnt(0)" ::: "memory");
  __syncthreads();
  if (threadIdx.x == 0) {
    unsigned* bar = b.bar;
    __builtin_amdgcn_s_waitcnt(0);
    unsigned nloc = b.st[0], nx = b.st[1];
    if (nloc == 0u) { xcd_barrier_complete(bar, b.x, nloc, nx); b.st[0] = nloc; b.st[1] = nx; }
    const unsigned old = xb_add(&bar[XB_XSUB(b.x)], 1u);
    const unsigned gen = old / nloc;
    if (old + 1u == (gen + 1u) * nloc) {
      __builtin_amdgcn_fence(__ATOMIC_RELEASE, "agent");
      asm volatile("s_waitcnt vmcnt(0)" ::: "memory");
      const unsigned og = xb_add(&bar[XB_TOP], 1u);
      const unsigned tg = og / nx;
      if (og + 1u == (tg + 1u) * nx) xb_add(&bar[XB_TOPGEN], 1u);
      else XB_SPIN(xb_ld(&bar[XB_TOPGEN]) == tg, bar);
      __builtin_amdgcn_fence(__ATOMIC_ACQUIRE, "agent");
      xb_add(&bar[XB_XGEN(b.x)], 1u);
      asm volatile("s_waitcnt vmcnt(0)" ::: "memory");
    } else {
      XB_SPIN(xb_ld(&bar[XB_XGEN(b.x)]) == gen, bar);
      __builtin_amdgcn_fence(__ATOMIC_ACQUIRE, "agent");
      asm volatile("s_waitcnt vmcnt(0)" ::: "memory");
    }
  }
  __syncthreads();
}

extern __shared__ __attribute__((aligned(16))) char dyn_smem[];
__global__ void __launch_bounds__(NTHREADS, 2) mega_kernel(Params p) {
  char* smem = dyn_smem;
  cg::grid_group grid = cg::this_grid();
  const int w = blockIdx.x, nw = gridDim.x;
  const int gwid = __builtin_amdgcn_readfirstlane((int)(threadIdx.x >> 6));
  if (p.use_cg_sync) grid.sync();
  volatile LAS unsigned* xst = (volatile LAS unsigned*)(smem + SMEM_BYTES - 16);
  if (threadIdx.x == 0) { xst[0] = 0u; xst[1] = 0u; }
  __syncthreads();
  XcdBarrier xb = xcd_barrier_post(p.bar, xst);
#define GSYNC() xcd_barrier(xb)
#ifndef REP_PREP
#define REP_PREP 1
#endif
#ifndef REP_R4
#define REP_R4 1
#endif
#ifndef REP_P3
#define REP_P3 1
#endif
#ifndef REP_P4L3
#define REP_P4L3 1
#endif
#ifndef REP_A3
#define REP_A3 1
#endif
#ifndef REP_GEMM
#define REP_GEMM 1
#endif
#ifndef REP_SG
#define REP_SG 1
#endif
#ifndef REP_EW
#define REP_EW 1
#endif
  for (int rep = 0; rep < REP_PREP; ++rep) { phase_prep(p, w, nw, smem, gwid); GSYNC(); }
  for (int layer = 0; layer < 4; ++layer) {
    if ((layer & 1) == 0) {
      for (int rep = 0; rep < REP_EW; ++rep) { phase_r1(p, layer, w, nw, gwid); GSYNC(); }
      for (int rep = 0; rep < REP_GEMM; ++rep) { phase_r2(p, layer, w, nw, smem, gwid); GSYNC(); }
      for (int rep = 0; rep < REP_SG; ++rep) { phase_r3(p, layer, w, nw, smem, gwid); GSYNC(); }
      for (int rep = 0; rep < REP_R4; ++rep) { phase_r4(p, layer, w, nw, smem, gwid); GSYNC(); }
      for (int rep = 0; rep < REP_EW; ++rep) { phase_r5(p, layer, w, nw, gwid); GSYNC(); }
    } else {
      for (int rep = 0; rep < REP_EW; ++rep) { phase_a1(p, layer, w, nw, gwid); GSYNC(); }
      for (int rep = 0; rep < REP_GEMM; ++rep) { phase_a2(p, layer, w, nw, smem, gwid); GSYNC(); }
      for (int rep = 0; rep < REP_EW; ++rep) { phase_a2b(p, layer, w, nw, gwid); GSYNC(); }
      for (int rep = 0; rep < REP_A3; ++rep) { phase_a3(p, layer, w, nw, smem, gwid); GSYNC(); }
    }
    for (int rep = 0; rep < REP_GEMM; ++rep) { phase_wo(p, layer, w, nw, smem, gwid); GSYNC(); }
    for (int rep = 0; rep < REP_EW; ++rep) { phase_ln1(p, layer, w, nw, gwid); GSYNC(); }
    for (int rep = 0; rep < REP_GEMM; ++rep) { phase_p1(p, layer, w, nw, smem, gwid); GSYNC(); }
    for (int rep = 0; rep < REP_SG; ++rep) { phase_p2(p, layer, w, nw, smem, gwid); GSYNC(); }
    for (int rep = 0; rep < REP_P3; ++rep) { phase_p3(p, layer, w, nw, smem, gwid); GSYNC(); }
    for (int rep = 0; rep < (layer == 3 ? REP_P4L3 : 1); ++rep) { phase_p4(p, layer, w, nw, smem, gwid); GSYNC(); }
  }
}

static inline char* carve(char*& cur, size_t bytes) {
  char* r = cur;
  cur += (bytes + 255) & ~(size_t)255;
  return r;
}

extern "C" void kernel_launch(void* const* d_in, const int* in_sizes, int n_in, void* d_out, int out_size, void* d_ws,
                              size_t ws_size, hipStream_t stream) {
  Params p;
  memset(&p, 0, sizeof(p));
  for (int i = 0; i < 35; ++i) p.in[i] = (const float*)d_in[i];
  p.out = (float*)d_out;
  char* cur = (char*)d_ws;
  p.bar = (unsigned*)carve(cur, 16384);
  p.mod = (float*)carve(cur, (size_t)4 * 9 * 6144 * 4);
  p.rope = (float*)carve(cur, 64 * 16 * 2 * 4);
  p.rwkv_in_t = (bf16_t*)carve(cur, (size_t)2 * RW_N * 1024 * 2);
  p.w2t = (bf16_t*)carve(cur, (size_t)4 * 65536 * 2);
  p.a2t = (bf16_t*)carve(cur, (size_t)4 * 65536 * 2);
  p.g2t = (bf16_t*)carve(cur, (size_t)2 * 131072 * 2);
  p.rwkv_wo_t = (bf16_t*)carve(cur, (size_t)2 * 1048576 * 2);
  p.attn_wqkv_t = (bf16_t*)carve(cur, (size_t)2 * 1536 * 1024 * 2);
  p.attn_wo_t = (bf16_t*)carve(cur, (size_t)2 * 1048576 * 2);
  p.wq_t = (bf16_t*)carve(cur, (size_t)4 * 2048 * 1024 * 2);
  p.keysb = (bf16_t*)carve(cur, (size_t)4 * 2 * 128 * 128 * 2);
  p.ub = (bf16_t*)carve(cur, (size_t)4 * 16384 * 1024 * 2);
  p.vb = (bf16_t*)carve(cur, (size_t)4 * 16384 * 1024 * 2);
  p.uinv = (float*)carve(cur, (size_t)65536 * 4);
  p.vinv = (float*)carve(cur, (size_t)65536 * 4);
  p.Klat = (bf16_t*)carve(cur, (size_t)2 * 8 * 4 * 1536 * 64 * 2);
  p.VlatT = (bf16_t*)carve(cur, (size_t)2 * 8 * 4 * 1536 * 64 * 2);
  p.Kctx = (bf16_t*)carve(cur, (size_t)2 * 16 * 4 * 256 * 64 * 2);
  p.VctxT = (bf16_t*)carve(cur, (size_t)2 * 16 * 4 * 256 * 64 * 2);
  p.xbuf = (float*)carve(cur, (size_t)TT * DM * 4);
  p.zbuf = (float*)carve(cur, (size_t)TT * DM * 4);
  p.hbuf = (bf16_t*)carve(cur, (size_t)TT * DM * 2);
  p.abuf = (bf16_t*)carve(cur, (size_t)TT * DM * 2);
  p.U1 = carve(cur, (size_t)TT * DM * 14);
  p.U2 = carve(cur, (size_t)TT * DM * 8);
  p.U3 = carve(cur, (size_t)TT * DM * 8);
  p.pidx = (int*)carve(cur, (size_t)TT * 128 * 4);
  p.pgate = (float*)carve(cur, (size_t)TT * 128 * 4);
  for (int f = 0; f < 16; ++f) p.freqs[f] = pow(10000.0, -(double)f / 16.0);
  if ((size_t)(cur - (char*)d_ws) > ws_size) {
    fprintf(stderr, "workspace too small: need %zu have %zu\n", (size_t)(cur - (char*)d_ws), ws_size);
    return;
  }
  static int grid_blocks = 0;
  if (!grid_blocks) {
    int dev = 0, cus = 0, per_cu = 0;
    (void)hipGetDevice(&dev);
    (void)hipDeviceGetAttribute(&cus, hipDeviceAttributeMultiprocessorCount, dev);
    (void)hipFuncSetAttribute((const void*)mega_kernel, hipFuncAttributeMaxDynamicSharedMemorySize, SMEM_BYTES);
    (void)hipOccupancyMaxActiveBlocksPerMultiprocessor(&per_cu, mega_kernel, NTHREADS, SMEM_BYTES);
    if (per_cu > 1) per_cu = 1;
    if (per_cu < 1) per_cu = 1;
    grid_blocks = cus * per_cu;
  }
  (void)hipMemsetAsync(p.bar, 0, 16384, stream);
  void* args[] = {&p};
  hipError_t e = hipLaunchCooperativeKernel((void*)mega_kernel, dim3(grid_blocks), dim3(NTHREADS), args, SMEM_BYTES, stream);
  if (e != hipSuccess) fprintf(stderr, "cooperative launch failed: %s (grid %d)\n", hipGetErrorString(e), grid_blocks);
}
```

```cpp
#include <hip/hip_runtime.h>
#include <hip/hip_cooperative_groups.h>
#include <stdint.h>
#include <string.h>
#include <math.h>
#include <stdio.h>

namespace cg = cooperative_groups;

typedef unsigned short bf16_t;
typedef __attribute__((ext_vector_type(8))) short bf16x8;
typedef __attribute__((ext_vector_type(4))) float f32x4;
typedef __attribute__((ext_vector_type(16))) float f32x16;

#define DEVINL __device__ __forceinline__
#define NTHREADS 512
#define NWAVES 8
#define GEMM_LDS 131072
#define SMEM_BYTES 163840
#define RW_N 3840

#define DM 1024
#define TCTX 4096
#define TLAT 8192
#define TT 12288
#define ALPHA_F 1.681792830507429f
#define LN_EPS_F 1e-5f
#define GN_EPS_F 6.4e-4f
#define RMS_EPS_F 1e-6f
#define QSCALE_F (0.125f * 1.4426950408889634f)

#define OUT_Y 0
#define OUT_STATE 12582912
#define OUT_CK 16777216
#define OUT_CV 18874368

struct Params {
  const float* in[35];
  float* out;
  float* mod;
  float* rope;
  bf16_t* rwkv_in_t;
  bf16_t* w2t;
  bf16_t* a2t;
  bf16_t* g2t;
  bf16_t* rwkv_wo_t;
  bf16_t* attn_wqkv_t;
  bf16_t* attn_wo_t;
  bf16_t* wq_t;
  bf16_t* keysb;
  bf16_t* ub;
  bf16_t* vb;
  float* uinv;
  float* vinv;
  bf16_t* Klat;
  bf16_t* VlatT;
  bf16_t* Kctx;
  bf16_t* VctxT;
  float* xbuf;
  float* zbuf;
  bf16_t* hbuf;
  bf16_t* abuf;
  char* U1;
  char* U2;
  char* U3;
  int* pidx;
  float* pgate;
  double freqs[16];
  unsigned* bar;
  int use_cg_sync;
  int pad0;
};

DEVINL int lane_id() { return (int)__builtin_amdgcn_mbcnt_hi(~0u, __builtin_amdgcn_mbcnt_lo(~0u, 0u)); }
DEVINL int tidx(int gwid) {
  int t = gwid * 64 + lane_id(); asm volatile("" : "+v"(t)); return t;
}
typedef __bf16 bf16v2_ __attribute__((ext_vector_type(2)));
typedef float f32v2_ __attribute__((ext_vector_type(2)));
DEVINL unsigned cvt_pk_bf16_(float lo, float hi) { f32v2_ v = {lo, hi}; bf16v2_ r = __builtin_convertvector(v, bf16v2_); return __builtin_bit_cast(unsigned, r); }
DEVINL bf16_t f2bf(float f) { return (bf16_t)(cvt_pk_bf16_(f, f) & 0xFFFFu); }
DEVINL float bf2f(bf16_t h) { return __uint_as_float(((unsigned)h) << 16); }
DEVINL unsigned pack2(float a, float b) { return cvt_pk_bf16_(a, b); }
DEVINL float bflo(unsigned u) { return __uint_as_float(u << 16); }
DEVINL float bfhi(unsigned u) { return __uint_as_float(u & 0xFFFF0000u); }

DEVINL float wave_sum(float v) {
#pragma unroll
  for (int o = 32; o > 0; o >>= 1) v += __shfl_xor(v, o);
  return v;
}
DEVINL float grp16_sum(float v) {
#pragma unroll
  for (int o = 8; o > 0; o >>= 1) v += __shfl_xor(v, o);
  return v;
}
DEVINL unsigned wave_max_u(unsigned v) {
#pragma unroll
  for (int o = 32; o > 0; o >>= 1) { unsigned t = (unsigned)__shfl_xor((int)v, o); v = v > t ? v : t; }
  return v;
}
DEVINL float sigmoidf_(float x) { return 1.0f / (1.0f + __expf(-x)); }
DEVINL float tanhf_(float x) { float e = __expf(-2.0f * fabsf(x)); float t = (1.0f - e) / (1.0f + e); return x < 0 ? -t : t; }
DEVINL unsigned ordf(float f) { unsigned u = __float_as_uint(f); return (u & 0x80000000u) ? ~u : (u | 0x80000000u); }

DEVINL int cond_of_row(int row) { return row < TCTX ? 8 : ((row - TCTX) >> 10); }


namespace pg8 {
#define PG8_LAS __attribute__((address_space(3)))
typedef unsigned u32x4 __attribute__((ext_vector_type(4)));
constexpr int BM = 256, BK = 64, HALF = 128, HTB = HALF * BK * 2, STAGE_BYTES = 8 * HTB, NXCD = 8, WGM = 8;
DEVINL int lds_byte(int r, int c) { const int st = (r >> 4) * 2 + (c >> 5), rr = r & 15, cc = c & 31, ob = rr * 64 + cc * 2; return st * 1024 + (ob ^ (((ob >> 9) & 1) << 5)); }
DEVINL void stage_rc(int b, int& R, int& C) { const int st = b / 1024, sb = b % 1024, swz = sb ^ (((sb >> 9) & 1) << 5); R = (st >> 1) * 16 + swz / 64; C = (st & 1) * 32 + (swz % 64) / 2; }
DEVINL int perm32(int rho) { const int n = rho >> 4, i = rho & 15; return 8 * (i >> 2) + 4 * n + (i & 3); }
struct Unit { int pm, pn; };
struct StaticOrder {
  int nM, nN, nwg, G, c;
  DEVINL void init(int M, int N, int G_, int c_) { nM = M / BM; nN = N / BM; nwg = nM * nN; G = G_; c = c_; }
  DEVINL bool next(int i, Unit& u) const {
    const long L = (long)i * G + c; if (L >= nwg) return false;
    int wgid = (int)L; { const int q = nwg / NXCD, r = nwg % NXCD, xcd = wgid % NXCD, off = wgid / NXCD; wgid = (xcd < r ? xcd * (q + 1) : r * (q + 1) + (xcd - r) * q) + off; }
    const int nig = WGM * nN, gid = wgid / nig, fm = gid * WGM, gsz = (nM - fm) < WGM ? (nM - fm) : WGM;
    u.pm = fm + ((wgid % nig) % gsz); u.pn = (wgid % nig) / gsz; return true;
  }
};
DEVINL unsigned cvt_pk_bf16(float lo, float hi) { return cvt_pk_bf16_(lo, hi); }

template <class Epi, class ASel>
DEVINL void gemm_phase(PG8_LAS unsigned char* lds, const ASel& asel, const bf16_t* Bt, const int K, const StaticOrder& S, const Epi& E, int gwid) {
  const int tid = tidx(gwid), wid = __builtin_amdgcn_readfirstlane(tid >> 6), lane = tid & 63, wr = wid >> 2, wc = wid & 3, fr = lane & 15, fq = lane >> 4;
  const int nt = K / BK;
  unsigned voffA[2], voffB[2];
#pragma unroll
  for (int i = 0; i < 2; ++i) { int R, C; stage_rc(tid * 16 + i * 8192, R, C); const int Rb = Epi::PERM ? ((R & ~31) + perm32(R & 31)) : R;
    voffA[i] = (unsigned)(R * K + C) * 2u; voffB[i] = (unsigned)(Rb * K + C) * 2u; }
  const size_t kstep = (size_t)(BK * 2);
  const size_t hstep = (size_t)HALF * K * 2;
  const size_t tstep = 2 * hstep;
  const unsigned ldsw = (unsigned)wid * 1024u;
  const int aoff = lds_byte(wr * 64 + fr, fq * 8), boff = lds_byte(wc * 32 + fr, fq * 8);
#define PG8_SA(b, h) (((b) * 2 + (h)) * HTB)
#define PG8_SB(b, h) ((4 + (b) * 2 + (h)) * HTB)
#define PG8_STAGE(bufoff, gbase, voff) do { _Pragma("unroll") for (int _i = 0; _i < 2; ++_i) \
    __builtin_amdgcn_global_load_lds((const unsigned*)((const char*)(gbase) + (voff)[_i]), (PG8_LAS unsigned*)(lds + (bufoff) + ldsw + _i * 8192), 16, 0, 0); } while (0)
#define PG8_LDA(dst, b, h) do { _Pragma("unroll") for (int m = 0; m < 4; ++m) _Pragma("unroll") for (int k = 0; k < 2; ++k) dst[m][k] = *(const PG8_LAS bf16x8*)(lds + PG8_SA(b, h) + aoff + m * 2048 + k * 1024); } while (0)
#define PG8_LDB(dst, b, h) do { _Pragma("unroll") for (int n = 0; n < 2; ++n) _Pragma("unroll") for (int k = 0; k < 2; ++k) dst[n][k] = *(const PG8_LAS bf16x8*)(lds + PG8_SB(b, h) + boff + n * 2048 + k * 1024); } while (0)
#define PG8_MMA(ai, bj, At, Bt_) do { __builtin_amdgcn_s_setprio(1); _Pragma("unroll") for (int m = 0; m < 4; ++m) _Pragma("unroll") for (int n = 0; n < 2; ++n) _Pragma("unroll") for (int k = 0; k < 2; ++k) \
    acc[ai][bj][m][n] = __builtin_amdgcn_mfma_f32_16x16x32_bf16(Bt_[n][k], At[m][k], acc[ai][bj][m][n], 0, 0, 0); __builtin_amdgcn_s_setprio(0); } while (0)
#define PG8_WAIT_V(n) asm volatile("s_waitcnt vmcnt(" #n ")" ::: "memory")
#define PG8_WAIT_L(n) asm volatile("s_waitcnt lgkmcnt(" #n ")" ::: "memory")
#define PG8_BAR __builtin_amdgcn_s_barrier()
#define PG8_SCHED __builtin_amdgcn_sched_barrier(0)
  Unit cur, nxt; int ui = 0;
  if (!S.next(0, cur)) return;
  f32x4 acc[2][2][4][2];
#pragma unroll
  for (int a = 0; a < 2; ++a)
#pragma unroll
    for (int b = 0; b < 2; ++b)
#pragma unroll
      for (int m = 0; m < 4; ++m)
#pragma unroll
        for (int n = 0; n < 2; ++n) acc[a][b][m][n] = (f32x4){0.f, 0.f, 0.f, 0.f};
  bf16x8 At[4][2], B0[2][2], B1[2][2];
  const char* cA = asel(cur.pn) + (size_t)cur.pm * tstep; const char* cB = (const char*)Bt + (size_t)cur.pn * tstep;
  PG8_STAGE(PG8_SB(0, 0), cB, voffB); PG8_STAGE(PG8_SA(0, 0), cA, voffA); PG8_STAGE(PG8_SB(0, 1), cB + hstep, voffB); PG8_STAGE(PG8_SA(0, 1), cA + hstep, voffA);
  if (wr == 1) PG8_BAR;
  PG8_WAIT_V(4); PG8_BAR;
  PG8_STAGE(PG8_SB(1, 0), cB + kstep, voffB); PG8_STAGE(PG8_SA(1, 0), cA + kstep, voffA); PG8_STAGE(PG8_SB(1, 1), cB + hstep + kstep, voffB);
  PG8_WAIT_V(6); PG8_BAR;
  for (;;) {
    const bool has_next = S.next(ui + 1, nxt);
    const char* nA = has_next ? asel(nxt.pn) + (size_t)nxt.pm * tstep : cA; const char* nB = has_next ? (const char*)Bt + (size_t)nxt.pn * tstep : cB;
    for (int t = 0; t < nt; t += 2) {
      const bool last = (t == nt - 2);
      const char* a1 = cA + (size_t)(t + 1) * kstep;
      const char* a2 = last ? nA : cA + (size_t)(t + 2) * kstep; const char* b2 = last ? nB : cB + (size_t)(t + 2) * kstep;
      const char* a3 = a2 + kstep; const char* b3 = b2 + kstep;
      PG8_LDB(B0, 0, 0); PG8_SCHED; PG8_LDA(At, 0, 0); PG8_STAGE(PG8_SA(1, 1), a1 + hstep, voffA);
      PG8_WAIT_L(8); PG8_BAR; PG8_WAIT_L(0); PG8_MMA(0, 0, At, B0); PG8_BAR; PG8_SCHED;
      PG8_LDB(B1, 0, 1); PG8_STAGE(PG8_SB(0, 0), b2, voffB);
      PG8_BAR; PG8_WAIT_L(0); PG8_MMA(0, 1, At, B1); PG8_BAR;
      PG8_LDA(At, 0, 1); PG8_STAGE(PG8_SA(0, 0), a2, voffA);
      PG8_BAR; PG8_WAIT_L(0); PG8_MMA(1, 0, At, B0); PG8_BAR; PG8_SCHED;
      PG8_STAGE(PG8_SB(0, 1), b2 + hstep, voffB);
      PG8_WAIT_V(6); PG8_BAR; PG8_MMA(1, 1, At, B1); PG8_BAR;
      PG8_LDB(B0, 1, 0); PG8_SCHED; PG8_LDA(At, 1, 0); PG8_STAGE(PG8_SA(0, 1), a2 + hstep, voffA);
      PG8_WAIT_L(8); PG8_BAR; PG8_WAIT_L(0); PG8_MMA(0, 0, At, B0); PG8_BAR; PG8_SCHED;
      PG8_LDB(B1, 1, 1); PG8_STAGE(PG8_SB(1, 0), b3, voffB);
      PG8_BAR; PG8_WAIT_L(0); PG8_MMA(0, 1, At, B1); PG8_BAR;
      PG8_LDA(At, 1, 1); PG8_STAGE(PG8_SA(1, 0), a3, voffA);
      PG8_BAR; PG8_WAIT_L(0); PG8_MMA(1, 0, At, B0); PG8_BAR; PG8_SCHED;
      PG8_STAGE(PG8_SB(1, 1), b3 + hstep, voffB);
      PG8_WAIT_V(6); PG8_BAR; PG8_MMA(1, 1, At, B1); PG8_BAR;
    }
    E(acc, cur, wr, wc, fr, fq);
    if (!has_next) break;
#pragma unroll
    for (int a = 0; a < 2; ++a)
#pragma unroll
      for (int b = 0; b < 2; ++b)
#pragma unroll
        for (int m = 0; m < 4; ++m)
#pragma unroll
          for (int n = 0; n < 2; ++n) acc[a][b][m][n] = (f32x4){0.f, 0.f, 0.f, 0.f};
    cur = nxt; cA = nA; cB = nB; ++ui;
  }
  PG8_WAIT_V(0);
  if (wr == 0) PG8_BAR;
  PG8_BAR;
#undef PG8_SA
#undef PG8_SB
#undef PG8_STAGE
#undef PG8_LDA
#undef PG8_LDB
#undef PG8_MMA
#undef PG8_WAIT_V
#undef PG8_WAIT_L
#undef PG8_BAR
#undef PG8_SCHED
}
struct ASelOne { const char* A; DEVINL const char* operator()(int) const { return A; } };
}

DEVINL void gemm_tile_128(const bf16_t* __restrict__ A, int lda, const bf16_t* __restrict__ Bt, int ldb, int K,
                          char* smem_half, f32x4 (&acc)[4][4], int gwid) {
  const int tid = tidx(gwid) & 255, wid = tid >> 6, lane = tid & 63;
  const int wr = wid >> 1, wc = wid & 1, fr = lane & 15, fq = lane >> 4;
  char* SA = smem_half;
  char* SB = smem_half + 8192;
#pragma unroll
  for (int m = 0; m < 4; ++m)
#pragma unroll
    for (int n = 0; n < 4; ++n) acc[m][n] = (f32x4){0.f, 0.f, 0.f, 0.f};
  for (int k0 = 0; k0 < K; k0 += 32) {
#pragma unroll
    for (int i = 0; i < 2; ++i) {
      int b = tid * 16 + i * 4096;
      int r = b >> 6, c = (b & 63) >> 1;
      __builtin_amdgcn_global_load_lds((const unsigned*)(A + (size_t)r * lda + k0 + c), (unsigned*)(SA + b), 16, 0, 0);
      __builtin_amdgcn_global_load_lds((const unsigned*)(Bt + (size_t)r * ldb + k0 + c), (unsigned*)(SB + b), 16, 0, 0);
    }
    asm volatile("s_waitcnt vmcnt(0)" ::: "memory");
    __syncthreads();
    bf16x8 a[4], b[4];
#pragma unroll
    for (int m = 0; m < 4; ++m) a[m] = *reinterpret_cast<const bf16x8*>(SA + (wr * 64 + m * 16 + fr) * 64 + fq * 16);
#pragma unroll
    for (int n = 0; n < 4; ++n) b[n] = *reinterpret_cast<const bf16x8*>(SB + (wc * 64 + n * 16 + fr) * 64 + fq * 16);
#pragma unroll
    for (int m = 0; m < 4; ++m)
#pragma unroll
      for (int n = 0; n < 4; ++n) acc[m][n] = __builtin_amdgcn_mfma_f32_16x16x32_bf16(a[m], b[n], acc[m][n], 0, 0, 0);
    __syncthreads();
  }
}

#define GEMM_LANE_VARS \
  const int tid = tidx(gwid) & 255, wid = tid >> 6, lane = tid & 63; \
  const int wr = wid >> 1, wc = wid & 1, fr = lane & 15, fq = lane >> 4; \
  (void)tid; (void)wid; (void)lane; (void)wr; (void)wc; (void)fr; (void)fq;

DEVINL void get_tjob(const Params& p, int ji, const float*& src, bf16_t*& dst, int& K, int& N) {
  if (ji < 28) {
    int j = ji / 14, s = ji % 14;
    bf16_t* rw = p.rwkv_in_t + (size_t)j * RW_N * 1024;
    if (s < 3) { src = p.in[12] + ((size_t)(j * 3 + s) << 20); dst = rw + ((size_t)s << 20); K = 1024; N = 1024; }
    else if (s < 5) { int z = s - 3; src = p.in[15] + (size_t)(j * 2 + z) * 65536; dst = rw + (size_t)(3072 + z * 64) * 1024; K = 1024; N = 64; }
    else if (s < 7) { int z = s - 5; src = p.in[18] + (size_t)(j * 2 + z) * 65536; dst = rw + (size_t)(3328 + z * 64) * 1024; K = 1024; N = 64; }
    else if (s == 7) { src = p.in[20] + (size_t)j * 131072; dst = rw + (size_t)3584 * 1024; K = 1024; N = 128; }
    else if (s < 10) { int z = s - 8; src = p.in[16] + (size_t)(j * 2 + z) * 65536; dst = p.w2t + (size_t)(j * 2 + z) * 65536; K = 64; N = 1024; }
    else if (s < 12) { int z = s - 10; src = p.in[19] + (size_t)(j * 2 + z) * 65536; dst = p.a2t + (size_t)(j * 2 + z) * 65536; K = 64; N = 1024; }
    else if (s == 12) { src = p.in[21] + (size_t)j * 131072; dst = p.g2t + (size_t)j * 131072; K = 128; N = 1024; }
    else { src = p.in[13] + ((size_t)j << 20); dst = p.rwkv_wo_t + ((size_t)j << 20); K = 1024; N = 1024; }
  } else if (ji < 32) {
    int j = (ji - 28) >> 1, s = (ji - 28) & 1;
    if (s == 0) { src = p.in[27] + (size_t)j * 1024 * 1536; dst = p.attn_wqkv_t + (size_t)j * 1536 * 1024; K = 1024; N = 1536; }
    else { src = p.in[28] + ((size_t)j << 20); dst = p.attn_wo_t + ((size_t)j << 20); K = 1024; N = 1024; }
  } else {
    int i = ji - 32;
    src = p.in[31] + (size_t)i * 1024 * 2048; dst = p.wq_t + (size_t)i * 2048 * 1024; K = 1024; N = 2048;
  }
}

DEVINL void sincos_d(double x, float& c, float& s) {
  const double TWO_PI = 6.283185307179586476925;
  double r = x - TWO_PI * rint(x / TWO_PI);
  double r2 = r * r;
  double ts = r, tc = 1.0, ss = r, cs = 1.0;
#pragma unroll 1
  for (int n = 1; n <= 14; ++n) {
    tc = -tc * r2 / (double)((2 * n - 1) * (2 * n));
    ts = -ts * r2 / (double)((2 * n) * (2 * n + 1));
    cs += tc; ss += ts;
  }
  c = (float)cs; s = (float)ss;
}

DEVINL void phase_prep(const Params& p, int w, int nw, char* smem, int gwid) {
  const int tid = tidx(gwid);
  {
    float (*tile)[65] = reinterpret_cast<float (*)[65]>(smem);
    int toff = 0;
    for (int ji = 0; ji < 36; ++ji) {
      const float* src; bf16_t* dst; int K, N;
      get_tjob(p, ji, src, dst, K, N);
      const int tn = N >> 6, nt = (K >> 6) * tn;
      int t0 = (w - (toff % nw) + nw) % nw;
      for (int t = t0; t < nt; t += nw) {
        const int k0 = (t / tn) << 6, n0 = (t % tn) << 6;
#pragma unroll
        for (int i = 0; i < 2; ++i) {
          int r = (tid >> 4) + 32 * i, c = (tid & 15) * 4;
          float4 v = *reinterpret_cast<const float4*>(src + (size_t)(k0 + r) * N + n0 + c);
          tile[r][c] = v.x; tile[r][c + 1] = v.y; tile[r][c + 2] = v.z; tile[r][c + 3] = v.w;
        }
        __syncthreads();
        {
          int q = tid;
          int n = q >> 3, kc = (q & 7) * 8;
          uint4 o;
          o.x = pack2(tile[kc + 0][n], tile[kc + 1][n]);
          o.y = pack2(tile[kc + 2][n], tile[kc + 3][n]);
          o.z = pack2(tile[kc + 4][n], tile[kc + 5][n]);
          o.w = pack2(tile[kc + 6][n], tile[kc + 7][n]);
          *reinterpret_cast<uint4*>(dst + (size_t)(n0 + n) * K + k0 + kc) = o;
        }
        __syncthreads();
      }
      toff += nt;
    }
  }
  const size_t gtid = (size_t)w * NTHREADS + tid, gn = (size_t)nw * NTHREADS;
  {
    const int lane = tid & 63;
    const int gw2 = w * NWAVES + (tid >> 6), ngw2 = nw * NWAVES;
    unsigned char* u8 = reinterpret_cast<unsigned char*>(p.ub);
    unsigned char* v8 = reinterpret_cast<unsigned char*>(p.vb);
    for (int r = gw2; r < 2 * 65536; r += ngw2) {
      const bool isv = r >= 65536;
      const int row = isv ? r - 65536 : r;
      const float* srow = (isv ? p.in[34] : p.in[33]) + (size_t)row * 1024 + lane * 16;
      float x[16];
#pragma unroll
      for (int q = 0; q < 4; ++q) { const float4 v = reinterpret_cast<const float4*>(srow)[q]; x[q * 4] = v.x; x[q * 4 + 1] = v.y; x[q * 4 + 2] = v.z; x[q * 4 + 3] = v.w; }
      float mx = 0.f;
#pragma unroll
      for (int q = 0; q < 16; ++q) mx = fmaxf(mx, fabsf(x[q]));
#pragma unroll
      for (int o = 32; o > 0; o >>= 1) mx = fmaxf(mx, __shfl_xor(mx, o));
      mx = fmaxf(mx, 1e-30f);
      const float sc = 440.0f / mx;
      uint4 o4;
      unsigned* ow = reinterpret_cast<unsigned*>(&o4);
#pragma unroll
      for (int q = 0; q < 4; ++q) {
        int pk = 0;
        pk = __builtin_amdgcn_cvt_pk_fp8_f32(x[q * 4] * sc, x[q * 4 + 1] * sc, pk, false);
        pk = __builtin_amdgcn_cvt_pk_fp8_f32(x[q * 4 + 2] * sc, x[q * 4 + 3] * sc, pk, true);
        ow[q] = (unsigned)pk;
      }
      *reinterpret_cast<uint4*>((isv ? v8 : u8) + (size_t)row * 1024 + lane * 16) = o4;
      if (lane == 0) (isv ? p.vinv : p.uinv)[row] = mx * (1.0f / 440.0f);
    }
    const size_t gtid0 = (size_t)w * NTHREADS + tid, gn0 = (size_t)nw * NTHREADS;
    const size_t nk8 = (size_t)4 * 2 * 128 * 128 / 8;
    for (size_t i = gtid0; i < nk8; i += gn0) {
      const float4* su = reinterpret_cast<const float4*>(p.in[32]) + i * 2;
      float4 a = su[0], b = su[1];
      uint4 o; o.x = pack2(a.x, a.y); o.y = pack2(a.z, a.w); o.z = pack2(b.x, b.y); o.w = pack2(b.z, b.w);
      reinterpret_cast<uint4*>(p.keysb)[i] = o;
    }
  }
  {
    const size_t nk = (size_t)8 * 2 * 512 * 4 * 64;
    for (size_t i = gtid; i < nk; i += gn) {
      int d = i & 63, kvh = (i >> 6) & 3, s = (i >> 8) & 511, j = (i >> 17) & 1, b = (int)(i >> 18);
      p.Klat[((size_t)((j * 8 + b) * 4 + kvh) * 1536 + s) * 64 + d] = f2bf(p.in[4][i]);
      p.VlatT[((size_t)((j * 8 + b) * 4 + kvh) * 64 + d) * 1536 + s] = f2bf(p.in[5][i]);
    }
  }
  for (size_t i = gtid; i < 1024; i += gn) {
    int pos = (int)(i >> 4), f = (int)(i & 15);
    float c, s; sincos_d((double)pos * p.freqs[f], c, s);
    p.rope[i * 2] = c; p.rope[i * 2 + 1] = s;
  }
  {
    const size_t n4 = (size_t)TT * DM / 4, nc4 = (size_t)TCTX * DM / 4;
    for (size_t i = gtid; i < n4; i += gn) {
      float4 v = (i < nc4) ? reinterpret_cast<const float4*>(p.in[0])[i] : reinterpret_cast<const float4*>(p.in[1])[i - nc4];
      reinterpret_cast<float4*>(p.xbuf)[i] = v;
    }
  }
  {
    float* sc = reinterpret_cast<float*>(smem);
    float* red = sc + 9 * 1024;
    bool loaded = false;
    for (int item = w; item < 384; item += nw) {
      if (!loaded) {
        __syncthreads();
        for (int e = tid; e < 9 * 1024; e += NTHREADS) {
          int c = e >> 10, d = e & 1023;
          float v = (c < 8) ? p.in[2][c * 1024 + d] : p.in[6][d];
          sc[e] = v / (1.0f + __expf(-v));
        }
        __syncthreads();
        loaded = true;
      }
      const int i = item / 96, cc = item % 96;
      const int col = cc * 64 + (tid & 63), ks = tid >> 6;
      float acc[9];
#pragma unroll
      for (int c = 0; c < 9; ++c) acc[c] = 0.f;
      const float* wp = p.in[7] + (size_t)i * 1024 * 6144 + col;
      for (int d0 = ks * 128; d0 < ks * 128 + 128; d0 += 16) {
        float wv[16];
#pragma unroll
        for (int u = 0; u < 16; ++u) wv[u] = wp[(size_t)(d0 + u) * 6144];
#pragma unroll
        for (int u = 0; u < 16; ++u)
#pragma unroll
          for (int c = 0; c < 9; ++c) acc[c] += sc[c * 1024 + d0 + u] * wv[u];
      }
#pragma unroll
      for (int c = 0; c < 9; ++c) red[(ks * 9 + c) * 64 + (tid & 63)] = acc[c];
      __syncthreads();
      for (int o = tid; o < 576; o += NTHREADS) {
        int c = o >> 6, cl = o & 63;
        float s = 0.f;
#pragma unroll
        for (int k2 = 0; k2 < 8; ++k2) s += red[(k2 * 9 + c) * 64 + cl];
        int n = cc * 64 + cl;
        p.mod[((size_t)i * 9 + c) * 6144 + n] = s + p.in[8][i * 6144 + n];
      }
      __syncthreads();
    }
  }
}

DEVINL void phase_r1(const Params& p, int layer, int w, int nw, int gwid) {
  const int j = layer >> 1;
  const int lane = tidx(gwid) & 63;
  const int gw = w * NWAVES + (tidx(gwid) >> 6), ngw = nw * NWAVES;
  bf16_t* A6 = reinterpret_cast<bf16_t*>(p.U1);
  const float* mu = p.in[11] + (size_t)j * 6 * 1024;
  for (int row = gw; row < TT; row += ngw) {
    int t, Tlen;
    if (row < TCTX) { t = row & 255; Tlen = 256; } else { t = (row - TCTX) & 1023; Tlen = 1024; }
    const int cond = cond_of_row(row);
    const float* sh = p.mod + ((size_t)layer * 9 + cond) * 6144;
    const float* sc = sh + 1024;
    const bool hasp = t > 0, hasn = t < Tlen - 1;
#pragma unroll
    for (int k = 0; k < 4; ++k) {
      const int col = k * 256 + lane * 4;
      const float4 xc = *reinterpret_cast<const float4*>(p.xbuf + (size_t)row * DM + col);
      float4 xp = make_float4(0, 0, 0, 0), xn = make_float4(0, 0, 0, 0);
      if (hasp) xp = *reinterpret_cast<const float4*>(p.xbuf + (size_t)(row - 1) * DM + col);
      if (hasn) xn = *reinterpret_cast<const float4*>(p.xbuf + (size_t)(row + 1) * DM + col);
      const float4 s4 = *reinterpret_cast<const float4*>(sh + col);
      const float4 c4 = *reinterpret_cast<const float4*>(sc + col);
      float h[4], xx[4];
      const float xcv[4] = {xc.x, xc.y, xc.z, xc.w}, xpv[4] = {xp.x, xp.y, xp.z, xp.w}, xnv[4] = {xn.x, xn.y, xn.z, xn.w};
      const float shv[4] = {s4.x, s4.y, s4.z, s4.w}, scv[4] = {c4.x, c4.y, c4.z, c4.w};
#pragma unroll
      for (int e = 0; e < 4; ++e) {
        float g = 1.0f + scv[e];
        h[e] = xcv[e] * g + shv[e];
        float hp = hasp ? (xpv[e] * g + shv[e]) : 0.f;
        float hn = hasn ? (xnv[e] * g + shv[e]) : 0.f;
        xx[e] = 0.5f * (hp + hn) - h[e];
      }
#pragma unroll
      for (int m = 0; m < 6; ++m) {
        const float4 m4 = *reinterpret_cast<const float4*>(mu + m * 1024 + col);
        uint2 o;
        o.x = pack2(h[0] + xx[0] * m4.x, h[1] + xx[1] * m4.y);
        o.y = pack2(h[2] + xx[2] * m4.z, h[3] + xx[3] * m4.w);
        *reinterpret_cast<uint2*>(A6 + ((size_t)m * TT + row) * DM + col) = o;
      }
    }
  }
}

#define U1_AA_OFF ((size_t)2 * TT * DM * 4)
#define U1_GG_OFF (U1_AA_OFF + (size_t)2 * TT * DM * 2)

struct ASelR2 {
  const char* A6;
  DEVINL const char* operator()(int pn) const {
    const int idx = pn < 12 ? (pn >> 2) : (pn - 9);
    const int m = (0x541320 >> (4 * idx)) & 7;
    return A6 + (size_t)m * TT * DM * 2;
  }
};
struct EpiR2 {
  static constexpr bool PERM = true;
  bf16_t *rb, *lw;
  DEVINL void operator()(const f32x4 (&acc)[2][2][4][2], const pg8::Unit& u, int wr, int wc, int fr, int fq) const {
    const int row0 = u.pm * 256 + wr * 64 + fr;
    const int pn = u.pn;
    if (pn < 12) {
      bf16_t* dst = rb + (size_t)(pn >> 2) * TT * DM;
      const int col0 = (pn & 3) * 256 + wc * 32 + 8 * fq;
#pragma unroll
      for (int ai = 0; ai < 2; ++ai)
#pragma unroll
        for (int m = 0; m < 4; ++m) {
          bf16_t* rowp = dst + (size_t)(row0 + ai * 128 + m * 16) * DM + col0;
#pragma unroll
          for (int bj = 0; bj < 2; ++bj) {
            const f32x4 v0 = acc[ai][bj][m][0], v1 = acc[ai][bj][m][1];
            pg8::u32x4 o; o.x = pg8::cvt_pk_bf16(v0[0], v0[1]); o.y = pg8::cvt_pk_bf16(v0[2], v0[3]); o.z = pg8::cvt_pk_bf16(v1[0], v1[1]); o.w = pg8::cvt_pk_bf16(v1[2], v1[3]);
            *reinterpret_cast<pg8::u32x4*>(rowp + bj * 128) = o;
          }
        }
    } else {
      bf16_t* dst = lw + (size_t)(pn - 12) * TT * 128;
      const int col0 = wc * 32 + 8 * fq;
      const float kx = (pn == 12 ? 2.0f : 1.0f) * 1.4426950408889634f, ka = pn == 12 ? 2.0f : 1.0f, kb = pn == 12 ? -1.0f : 0.0f;
#pragma unroll
      for (int ai = 0; ai < 2; ++ai)
#pragma unroll
        for (int m = 0; m < 4; ++m) {
          f32x4 v0 = acc[ai][0][m][0], v1 = acc[ai][0][m][1];
          if (pn != 13) {
#pragma unroll
            for (int e = 0; e < 4; ++e) {
              const float s0 = __builtin_amdgcn_rcpf(1.0f + __builtin_amdgcn_exp2f(-kx * v0[e]));
              const float s1 = __builtin_amdgcn_rcpf(1.0f + __builtin_amdgcn_exp2f(-kx * v1[e]));
              v0[e] = ka * s0 + kb; v1[e] = ka * s1 + kb;
            }
          }
          asm volatile("" ::: "memory");
          pg8::u32x4 o; o.x = pg8::cvt_pk_bf16(v0[0], v0[1]); o.y = pg8::cvt_pk_bf16(v0[2], v0[3]); o.z = pg8::cvt_pk_bf16(v1[0], v1[1]); o.w = pg8::cvt_pk_bf16(v1[2], v1[3]);
          *reinterpret_cast<pg8::u32x4*>(dst + (size_t)(row0 + ai * 128 + m * 16) * 128 + col0) = o;
        }
    }
  }
};
DEVINL void phase_r2(const Params& p, int layer, int w, int nw, char* smem, int gwid) {
  const int j = layer >> 1;
  bf16_t* rb = reinterpret_cast<bf16_t*>(p.U2);
  EpiR2 E;
  E.rb = rb; E.lw = p.abuf;
  ASelR2 as; as.A6 = p.U1;
  pg8::StaticOrder S; S.init(TT, RW_N, nw, w);
  pg8::gemm_phase<EpiR2, ASelR2>((PG8_LAS unsigned char*)smem, as, p.rwkv_in_t + (size_t)j * RW_N * 1024, 1024, S, E, gwid);
}

DEVINL void phase_r3(const Params& p, int layer, int w, int nw, char* smem, int gwid) {
  const int j = layer >> 1;
  GEMM_LANE_VARS
  const int half = tidx(gwid) >> 8;
  char* sh = smem + half * 16384;
  const bf16_t* lw = p.abuf;
  const bf16_t* la = lw + (size_t)TT * 128;
  const bf16_t* lg = la + (size_t)TT * 128;
  float* wdec = reinterpret_cast<float*>(p.U1);
  bf16_t* aa = reinterpret_cast<bf16_t*>(p.U1 + U1_AA_OFF);
  bf16_t* gg = reinterpret_cast<bf16_t*>(p.U1 + U1_GG_OFF);
  const int NTILES = 96 * 40;
  for (int it = 0; it * nw * 2 < NTILES; ++it) {
    int tile = (it * nw + w) * 2 + half;
    const bool valid = tile < NTILES;
    if (!valid) tile = 0;
    const int ct = tile / 96, rt = tile % 96;
    const int job = ct >> 3, nt = ct & 7;
    const int row0 = rt * 128, col0 = nt * 128;
    f32x4 acc[4][4];
    if (job < 2) {
      const int z = job;
      gemm_tile_128(lw + (size_t)row0 * 128 + z * 64, 128, p.w2t + (size_t)(j * 2 + z) * 65536 + (size_t)col0 * 64, 64, 64, sh, acc, gwid);
      if (valid) {
        const float* w0 = p.in[14] + (size_t)(j * 2 + z) * 1024;
#pragma unroll
        for (int m = 0; m < 4; ++m)
#pragma unroll
          for (int n = 0; n < 4; ++n)
#pragma unroll
            for (int jj = 0; jj < 4; ++jj) {
              int row = row0 + wr * 64 + m * 16 + fq * 4 + jj, col = col0 + wc * 64 + n * 16 + fr;
              float wl = acc[m][n][jj] + w0[col];
              wdec[((size_t)z * TT + row) * DM + col] = __expf(-0.6065306597126334f * sigmoidf_(wl));
            }
      }
    } else if (job < 4) {
      const int z = job - 2;
      gemm_tile_128(la + (size_t)row0 * 128 + z * 64, 128, p.a2t + (size_t)(j * 2 + z) * 65536 + (size_t)col0 * 64, 64, 64, sh, acc, gwid);
      if (valid) {
        const float* a0 = p.in[17] + (size_t)(j * 2 + z) * 1024;
#pragma unroll
        for (int m = 0; m < 4; ++m)
#pragma unroll
          for (int n = 0; n < 4; ++n)
#pragma unroll
            for (int jj = 0; jj < 4; ++jj) {
              int row = row0 + wr * 64 + m * 16 + fq * 4 + jj, col = col0 + wc * 64 + n * 16 + fr;
              aa[((size_t)z * TT + row) * DM + col] = f2bf(sigmoidf_(acc[m][n][jj] + a0[col]));
            }
      }
    } else {
      gemm_tile_128(lg + (size_t)row0 * 128, 128, p.g2t + (size_t)j * 131072 + (size_t)col0 * 128, 128, 128, sh, acc, gwid);
      if (valid) {
#pragma unroll
        for (int m = 0; m < 4; ++m)
#pragma unroll
          for (int n = 0; n < 4; ++n)
#pragma unroll
            for (int jj = 0; jj < 4; ++jj) {
              int row = row0 + wr * 64 + m * 16 + fq * 4 + jj, col = col0 + wc * 64 + n * 16 + fr;
              gg[(size_t)row * DM + col] = f2bf(acc[m][n][jj]);
            }
      }
    }
  }
  {
    const int l64 = tidx(gwid) & 63;
    const int gw = w * NWAVES + (tidx(gwid) >> 6), ngw = nw * NWAVES;
    const bf16_t* kb = reinterpret_cast<const bf16_t*>(p.U2) + (size_t)TT * DM;
    bf16_t* kkb = reinterpret_cast<bf16_t*>(p.U2) + (size_t)3 * TT * DM;
    const float* k_k = p.in[22] + j * 1024;
    for (int row = gw; row < TT; row += ngw) {
#pragma unroll
      for (int k = 0; k < 4; ++k) {
        const int col = k * 256 + l64 * 4;
        const uint2 k2 = *reinterpret_cast<const uint2*>(kb + (size_t)row * DM + col);
        const float4 kk4 = *reinterpret_cast<const float4*>(k_k + col);
        float v0 = bflo(k2.x) * kk4.x, v1 = bfhi(k2.x) * kk4.y, v2 = bflo(k2.y) * kk4.z, v3 = bfhi(k2.y) * kk4.w;
        float ss = grp16_sum(v0 * v0 + v1 * v1 + v2 * v2 + v3 * v3);
        float inv = 1.0f / fmaxf(sqrtf(ss), 1e-12f);
        uint2 o; o.x = pack2(v0 * inv, v1 * inv); o.y = pack2(v2 * inv, v3 * inv);
        *reinterpret_cast<uint2*>(kkb + (size_t)row * DM + col) = o;
      }
    }
  }
}

typedef __attribute__((ext_vector_type(4))) short bf16x4;
#define R4_WAVE_LDS 36864
DEVINL unsigned short bfbits(float f) { return f2bf(f); }
DEVINL bf16x4 pack4(float a, float b, float c, float d) {
  union { bf16x4 v; unsigned u[2]; } r; r.u[0] = pack2(a, b); r.u[1] = pack2(c, d); return r.v;
}
DEVINL void phase_r4(const Params& p, int layer, int w, int nw, char* smem, int gwid) {
  const int j = layer >> 1;
  const int lane = tidx(gwid) & 63, wid = __builtin_amdgcn_readfirstlane(tidx(gwid) >> 6);
  const int fr = lane & 15, fq = lane >> 4;
  if (wid >= 3) return;
  const bf16_t* rb = reinterpret_cast<const bf16_t*>(p.U2);
  const bf16_t* kb = rb + (size_t)TT * DM;
  const bf16_t* vb = kb + (size_t)TT * DM;
  const bf16_t* kkb = vb + (size_t)TT * DM;
  const float* wdec = reinterpret_cast<const float*>(p.U1);
  const bf16_t* aa = reinterpret_cast<const bf16_t*>(p.U1 + U1_AA_OFF);
  float* yout = reinterpret_cast<float*>(p.U3);
  char* wl = smem + wid * R4_WAVE_LDS;
  bf16_t* khR = reinterpret_cast<bf16_t*>(wl);
  bf16_t* ahR = khR + 1024;
  bf16_t* qhR = ahR + 1024;
  bf16_t* rhR = qhR + 1024;
  bf16_t* qhT = rhR + 1024;
  bf16_t* AtT = qhT + 1024;
  bf16_t* KtT = AtT + 1024;
  bf16_t* vT = KtT + 1024;
  float* NfT = reinterpret_cast<float*>(vT + 1024);
  float* WCf = NfT + 256;
  bf16_t* TTl = reinterpret_cast<bf16_t*>(WCf + 64);
  bf16_t* AkqR = TTl + 256;
  bf16_t* GR = AkqR + 256;
  bf16_t* QpR = khR;
  char* rawb = wl + 20480;
  const bf16_t* rawR = reinterpret_cast<const bf16_t*>(rawb);
  const bf16_t* rawK = rawR + 1024;
  const bf16_t* rawKK = rawK + 1024;
  const bf16_t* rawA = rawKK + 1024;
  const bf16_t* rawV = rawA + 1024;
  const float* rawW = reinterpret_cast<const float*>(rawb + 10240);
  {
    const int c = w + nw * wid;
    if (c >= 768) return;
    int seq, h, z;
    if (c < 256) { seq = 16 + (c >> 5); h = (c >> 1) & 15; z = c & 1; }
    else { int cc = c - 256; seq = cc >> 5; h = (cc >> 1) & 15; z = cc & 1; }
    const int Tlen = seq < 16 ? 256 : 1024;
    const int base = seq < 16 ? seq * 256 : TCTX + (seq - 16) * 1024;
    const int colb = h * 64;
    const float kal = p.in[23][j * 1024 + colb + lane];
    f32x4 ST[4][4];
    if (seq >= 16) {
      const float* s0 = p.in[3] + ((((size_t)(seq - 16) * 2 + j) * 2 + z) * 16 + h) * 4096;
#pragma unroll
      for (int b = 0; b < 4; ++b)
#pragma unroll
        for (int nb = 0; nb < 4; ++nb) ST[b][nb] = *reinterpret_cast<const f32x4*>(s0 + (size_t)(16 * nb + fr) * 64 + 16 * b + 4 * fq);
    } else {
#pragma unroll
      for (int b = 0; b < 4; ++b)
#pragma unroll
        for (int nb = 0; nb < 4; ++nb) ST[b][nb] = (f32x4){0.f, 0.f, 0.f, 0.f};
    }
#define R4_DMA(t0_) do { \
      _Pragma("unroll") for (int i_ = 0; i_ < 2; ++i_) { \
        const int t_ = (t0_) + 8 * i_ + (lane >> 3); \
        const int row_ = base + (z == 0 ? t_ : (Tlen - 1 - t_)); \
        const size_t o_ = (size_t)row_ * DM + colb + (lane & 7) * 8; \
        __builtin_amdgcn_global_load_lds((const unsigned*)(rb + o_), (unsigned*)(rawb + i_ * 1024 + lane * 16), 16, 0, 0); \
        __builtin_amdgcn_global_load_lds((const unsigned*)(kb + o_), (unsigned*)(rawb + 2048 + i_ * 1024 + lane * 16), 16, 0, 0); \
        __builtin_amdgcn_global_load_lds((const unsigned*)(kkb + o_), (unsigned*)(rawb + 4096 + i_ * 1024 + lane * 16), 16, 0, 0); \
        __builtin_amdgcn_global_load_lds((const unsigned*)(aa + (size_t)z * TT * DM + o_), (unsigned*)(rawb + 6144 + i_ * 1024 + lane * 16), 16, 0, 0); \
        __builtin_amdgcn_global_load_lds((const unsigned*)(vb + o_), (unsigned*)(rawb + 8192 + i_ * 1024 + lane * 16), 16, 0, 0); \
      } \
      _Pragma("unroll") for (int i_ = 0; i_ < 4; ++i_) { \
        const int t_ = (t0_) + 4 * i_ + (lane >> 4); \
        const int row_ = base + (z == 0 ? t_ : (Tlen - 1 - t_)); \
        __builtin_amdgcn_global_load_lds((const unsigned*)(wdec + ((size_t)z * TT + row_) * DM + colb + (lane & 15) * 4), (unsigned*)(rawb + 10240 + i_ * 1024 + lane * 16), 16, 0, 0); \
      } } while (0)
    R4_DMA(0);
#pragma unroll 1
    for (int t0 = 0; t0 < Tlen; t0 += 16) {
      asm volatile("s_waitcnt vmcnt(0)" ::: "memory");
      __builtin_amdgcn_wave_barrier();
      {
        float wx[16];
#pragma unroll
        for (int t = 0; t < 16; ++t) wx[t] = rawW[t * 64 + lane];
        float WCl = 1.0f;
#pragma unroll
        for (int t = 0; t < 16; ++t) WCl *= wx[t];
        WCf[lane] = WCl;
        float Wc = 1.0f;
#pragma unroll
        for (int tp = 0; tp < 8; ++tp) {
          float at2[2], kt2[2], qh2[2];
          unsigned vb2[2];
#pragma unroll
          for (int u = 0; u < 2; ++u) {
            const int t = tp * 2 + u;
            const float rr = bf2f(rawR[t * 64 + lane]), kx = bf2f(rawK[t * 64 + lane]), kkx = bf2f(rawKK[t * 64 + lane]);
            const float ax = bf2f(rawA[t * 64 + lane]);
            vb2[u] = rawV[t * 64 + lane];
            const float kd = kx * (1.0f + (ax - 1.0f) * kal);
            const float kka = kkx * ax;
            const float qh = Wc * kkx;
            Wc *= wx[t];
            const float rh = Wc * rr;
            const float iw = __builtin_amdgcn_rcpf(Wc);
            const float kh = kd * iw, ah = kka * iw;
            khR[t * 64 + lane] = f2bf(kh); ahR[t * 64 + lane] = f2bf(ah);
            qhR[t * 64 + lane] = f2bf(qh); rhR[t * 64 + lane] = f2bf(rh);
            at2[u] = ah * WCl; kt2[u] = kh * WCl; qh2[u] = qh;
          }
          *reinterpret_cast<unsigned*>(AtT + lane * 16 + tp * 2) = pack2(at2[0], at2[1]);
          *reinterpret_cast<unsigned*>(KtT + lane * 16 + tp * 2) = pack2(kt2[0], kt2[1]);
          *reinterpret_cast<unsigned*>(qhT + lane * 16 + tp * 2) = pack2(qh2[0], qh2[1]);
          *reinterpret_cast<unsigned*>(vT + lane * 16 + tp * 2) = vb2[0] | (vb2[1] << 16);
        }
      }
      asm volatile("s_waitcnt lgkmcnt(0)" ::: "memory");
      if (t0 + 16 < Tlen) R4_DMA(t0 + 16);
      __builtin_amdgcn_wave_barrier();
      f32x4 Akq = {0.f, 0.f, 0.f, 0.f}, Aaq = Akq, Akr = Akq, Aar = Akq;
      {
#pragma unroll
        for (int ks = 0; ks < 2; ++ks) {
          const bf16x8 khA = *reinterpret_cast<const bf16x8*>(khR + fr * 64 + ks * 32 + fq * 8);
          const bf16x8 ahA = *reinterpret_cast<const bf16x8*>(ahR + fr * 64 + ks * 32 + fq * 8);
          const bf16x8 qhB = *reinterpret_cast<const bf16x8*>(qhR + fr * 64 + ks * 32 + fq * 8);
          const bf16x8 rhB = *reinterpret_cast<const bf16x8*>(rhR + fr * 64 + ks * 32 + fq * 8);
          Akq = __builtin_amdgcn_mfma_f32_16x16x32_bf16(khA, qhB, Akq, 0, 0, 0);
          Aaq = __builtin_amdgcn_mfma_f32_16x16x32_bf16(ahA, qhB, Aaq, 0, 0, 0);
          Akr = __builtin_amdgcn_mfma_f32_16x16x32_bf16(khA, rhB, Akr, 0, 0, 0);
          Aar = __builtin_amdgcn_mfma_f32_16x16x32_bf16(ahA, rhB, Aar, 0, 0, 0);
        }
#pragma unroll
        for (int e = 0; e < 4; ++e) {
          const int s = 4 * fq + e;
          if (!(s < fr)) { Akq[e] = 0.f; Aaq[e] = 0.f; }
          if (!(s <= fr)) { Akr[e] = 0.f; Aar[e] = 0.f; }
        }
      }
      __builtin_amdgcn_wave_barrier();
      *reinterpret_cast<f32x4*>(NfT + fr * 16 + 4 * fq) = Aaq;
#pragma unroll
      for (int e = 0; e < 4; ++e) AkqR[(4 * fq + e) * 16 + fr] = f2bf(Akq[e]);
      __builtin_amdgcn_wave_barrier();
      {
        float Tr[16];
#pragma unroll
        for (int t = 0; t < 16; ++t) {
          float acc = (fr == t) ? 1.0f : 0.0f;
#pragma unroll
          for (int x = 0; x < t; ++x) acc -= Tr[x] * NfT[t * 16 + x];
          Tr[t] = acc;
        }
        if (fq == 0) {
#pragma unroll
          for (int t = 0; t < 16; ++t) TTl[t * 16 + fr] = f2bf(Tr[t]);
        }
      }
      __builtin_amdgcn_wave_barrier();
      const bf16x4 Tb = *reinterpret_cast<const bf16x4*>(TTl + fr * 16 + fq * 4);
      f32x4 G;
      {
        const bf16x4 AkqA = *reinterpret_cast<const bf16x4*>(AkqR + fr * 16 + fq * 4);
        G = __builtin_amdgcn_mfma_f32_16x16x16bf16_1k(AkqA, Tb, (f32x4){0.f, 0.f, 0.f, 0.f}, 0, 0, 0);
#pragma unroll
        for (int b = 0; b < 4; ++b) {
          const bf16x4 qa = *reinterpret_cast<const bf16x4*>(qhT + (16 * b + fr) * 16 + fq * 4);
          const f32x4 qp = __builtin_amdgcn_mfma_f32_16x16x16bf16_1k(qa, Tb, (f32x4){0.f, 0.f, 0.f, 0.f}, 0, 0, 0);
          *reinterpret_cast<bf16x4*>(QpR + fr * 64 + 16 * b + 4 * fq) = pack4(qp[0], qp[1], qp[2], qp[3]);
        }
#pragma unroll
        for (int e = 0; e < 4; ++e) GR[(4 * fq + e) * 16 + fr] = f2bf(G[e]);
      }
      __builtin_amdgcn_wave_barrier();
      f32x4 H, Zb[4];
      {
        const bf16x4 GA = *reinterpret_cast<const bf16x4*>(GR + fr * 16 + fq * 4);
        const bf16x4 AarB = pack4(Aar[0], Aar[1], Aar[2], Aar[3]);
        const f32x4 hm = __builtin_amdgcn_mfma_f32_16x16x16bf16_1k(GA, AarB, (f32x4){0.f, 0.f, 0.f, 0.f}, 0, 0, 0);
        H = Akr - hm;
#pragma unroll
        for (int b = 0; b < 4; ++b) {
          const bf16x4 AtB = *reinterpret_cast<const bf16x4*>(AtT + (16 * b + fr) * 16 + fq * 4);
          const f32x4 zm = __builtin_amdgcn_mfma_f32_16x16x16bf16_1k(GA, AtB, (f32x4){0.f, 0.f, 0.f, 0.f}, 0, 0, 0);
          const bf16x4 ktv = *reinterpret_cast<const bf16x4*>(KtT + (16 * b + fr) * 16 + fq * 4);
          union { bf16x4 v; unsigned short s[4]; } ku; ku.v = ktv;
          Zb[b][0] = bf2f(ku.s[0]) - zm[0]; Zb[b][1] = bf2f(ku.s[1]) - zm[1]; Zb[b][2] = bf2f(ku.s[2]) - zm[2]; Zb[b][3] = bf2f(ku.s[3]) - zm[3];
        }
      }
      bf16x8 QpA[2], rhA[2], AY, AS[4];
      {
#pragma unroll
        for (int ks = 0; ks < 2; ++ks) {
          union { bf16x8 v; bf16x4 h[2]; } u1, u2;
          u1.h[0] = *reinterpret_cast<const bf16x4*>(QpR + fr * 64 + 32 * ks + 4 * fq);
          u1.h[1] = *reinterpret_cast<const bf16x4*>(QpR + fr * 64 + 32 * ks + 16 + 4 * fq);
          u2.h[0] = *reinterpret_cast<const bf16x4*>(rhR + fr * 64 + 32 * ks + 4 * fq);
          u2.h[1] = *reinterpret_cast<const bf16x4*>(rhR + fr * 64 + 32 * ks + 16 + 4 * fq);
          QpA[ks] = u1.v; rhA[ks] = u2.v;
        }
        {
          union { bf16x8 v; bf16x4 h[2]; } u;
          u.h[0] = pack4(Aar[0], Aar[1], Aar[2], Aar[3]); u.h[1] = pack4(H[0], H[1], H[2], H[3]);
          AY = u.v;
        }
#pragma unroll
        for (int b = 0; b < 4; ++b) {
          union { bf16x8 v; bf16x4 h[2]; } u;
          u.h[0] = *reinterpret_cast<const bf16x4*>(AtT + (16 * b + fr) * 16 + fq * 4);
          u.h[1] = pack4(Zb[b][0], Zb[b][1], Zb[b][2], Zb[b][3]);
          AS[b] = u.v;
        }
      }
#pragma unroll
      for (int nb = 0; nb < 4; ++nb) {
        bf16x8 Bhi[2];
#pragma unroll
        for (int ks = 0; ks < 2; ++ks) {
          union { bf16x8 v; unsigned u[4]; } hi;
          hi.u[0] = pack2(ST[2 * ks][nb][0], ST[2 * ks][nb][1]); hi.u[1] = pack2(ST[2 * ks][nb][2], ST[2 * ks][nb][3]);
          hi.u[2] = pack2(ST[2 * ks + 1][nb][0], ST[2 * ks + 1][nb][1]); hi.u[3] = pack2(ST[2 * ks + 1][nb][2], ST[2 * ks + 1][nb][3]);
          Bhi[ks] = hi.v;
        }
        f32x4 P = {0.f, 0.f, 0.f, 0.f}, R = {0.f, 0.f, 0.f, 0.f};
        P = __builtin_amdgcn_mfma_f32_16x16x32_bf16(QpA[0], Bhi[0], P, 0, 0, 0);
        P = __builtin_amdgcn_mfma_f32_16x16x32_bf16(QpA[1], Bhi[1], P, 0, 0, 0);
        R = __builtin_amdgcn_mfma_f32_16x16x32_bf16(rhA[0], Bhi[0], R, 0, 0, 0);
        R = __builtin_amdgcn_mfma_f32_16x16x32_bf16(rhA[1], Bhi[1], R, 0, 0, 0);
        bf16x8 X;
        {
          union { bf16x8 v; bf16x4 h[2]; } u;
          u.h[0] = pack4(-P[0], -P[1], -P[2], -P[3]);
          u.h[1] = *reinterpret_cast<const bf16x4*>(vT + (16 * nb + fr) * 16 + fq * 4);
          X = u.v;
        }
        const f32x4 Y = __builtin_amdgcn_mfma_f32_16x16x32_bf16(AY, X, R, 0, 0, 0);
#pragma unroll
        for (int e = 0; e < 4; ++e) {
          const int t = t0 + 4 * fq + e;
          const int row = base + (z == 0 ? t : (Tlen - 1 - t));
          yout[((size_t)z * TT + row) * DM + colb + 16 * nb + fr] = Y[e];
        }
#pragma unroll
        for (int b = 0; b < 4; ++b) {
          const f32x4 wcv = *reinterpret_cast<const f32x4*>(WCf + 16 * b + 4 * fq);
          ST[b][nb] = __builtin_amdgcn_mfma_f32_16x16x32_bf16(AS[b], X, ST[b][nb] * wcv, 0, 0, 0);
        }
        __builtin_amdgcn_sched_barrier(0);
      }
    }
    if (seq < 16) {
      const int l2 = tidx(gwid) & 63, fr2 = l2 & 15, fq2 = l2 >> 4;
      float* so = p.out + OUT_STATE + ((((size_t)seq * 2 + j) * 2 + z) * 16 + h) * 4096;
#pragma unroll
      for (int b = 0; b < 4; ++b)
#pragma unroll
        for (int nb = 0; nb < 4; ++nb) *reinterpret_cast<f32x4*>(so + (size_t)(16 * nb + fr2) * 64 + 16 * b + 4 * fq2) = ST[b][nb];
    }
  }
}

DEVINL void phase_r5(const Params& p, int layer, int w, int nw, int gwid) {
  const int j = layer >> 1;
  const int lane = tidx(gwid) & 63;
  const int gw = w * NWAVES + (tidx(gwid) >> 6), ngw = nw * NWAVES;
  const bf16_t* rb = reinterpret_cast<const bf16_t*>(p.U2);
  const bf16_t* kb = rb + (size_t)TT * DM;
  const bf16_t* vb = kb + (size_t)TT * DM;
  const bf16_t* aa = reinterpret_cast<const bf16_t*>(p.U1 + U1_AA_OFF);
  const bf16_t* gg = reinterpret_cast<const bf16_t*>(p.U1 + U1_GG_OFF);
  const float* yin = reinterpret_cast<const float*>(p.U3);
  const float* ka = p.in[23] + j * 1024;
  const float* rk = p.in[24] + j * 1024;
  const float* lg = p.in[25] + j * 1024;
  const float* lb = p.in[26] + j * 1024;
  for (int row = gw; row < TT; row += ngw) {
#pragma unroll
    for (int k = 0; k < 4; ++k) {
      const int col = k * 256 + lane * 4;
      const size_t o = (size_t)row * DM + col;
      const float4 yf = *reinterpret_cast<const float4*>(yin + o);
      const float4 yb = *reinterpret_cast<const float4*>(yin + (size_t)TT * DM + o);
      const uint2 r2 = *reinterpret_cast<const uint2*>(rb + o);
      const uint2 k2 = *reinterpret_cast<const uint2*>(kb + o);
      const uint2 v2 = *reinterpret_cast<const uint2*>(vb + o);
      const uint2 a02 = *reinterpret_cast<const uint2*>(aa + o);
      const uint2 a12 = *reinterpret_cast<const uint2*>(aa + (size_t)TT * DM + o);
      const uint2 g2 = *reinterpret_cast<const uint2*>(gg + o);
      const float4 ka4 = *reinterpret_cast<const float4*>(ka + col);
      const float4 rk4 = *reinterpret_cast<const float4*>(rk + col);
      const float4 lg4 = *reinterpret_cast<const float4*>(lg + col);
      const float4 lb4 = *reinterpret_cast<const float4*>(lb + col);
      float y[4] = {yf.x + yb.x, yf.y + yb.y, yf.z + yb.z, yf.w + yb.w};
      float r[4] = {bflo(r2.x), bfhi(r2.x), bflo(r2.y), bfhi(r2.y)};
      float kx[4] = {bflo(k2.x), bfhi(k2.x), bflo(k2.y), bfhi(k2.y)};
      float v[4] = {bflo(v2.x), bfhi(v2.x), bflo(v2.y), bfhi(v2.y)};
      float a0[4] = {bflo(a02.x), bfhi(a02.x), bflo(a02.y), bfhi(a02.y)};
      float a1[4] = {bflo(a12.x), bfhi(a12.x), bflo(a12.y), bfhi(a12.y)};
      float g[4] = {bflo(g2.x), bfhi(g2.x), bflo(g2.y), bfhi(g2.y)};
      float kav[4] = {ka4.x, ka4.y, ka4.z, ka4.w}, rkv[4] = {rk4.x, rk4.y, rk4.z, rk4.w};
      float lgv[4] = {lg4.x, lg4.y, lg4.z, lg4.w}, lbv[4] = {lb4.x, lb4.y, lb4.z, lb4.w};
      float sm = y[0] + y[1] + y[2] + y[3];
      sm = grp16_sum(sm);
      const float mean = sm * (1.0f / 64.0f);
      float sv = 0.f, sb = 0.f;
#pragma unroll
      for (int e = 0; e < 4; ++e) {
        float d = y[e] - mean; sv += d * d;
        float kd0 = kx[e] * (1.0f + (a0[e] - 1.0f) * kav[e]);
        float kd1 = kx[e] * (1.0f + (a1[e] - 1.0f) * kav[e]);
        sb += r[e] * (kd0 + kd1) * rkv[e];
      }
      sv = grp16_sum(sv); sb = grp16_sum(sb);
      const float rstd = rsqrtf(sv * (1.0f / 64.0f) + GN_EPS_F);
      float o4[4];
#pragma unroll
      for (int e = 0; e < 4; ++e) {
        float yn = (y[e] - mean) * rstd * lgv[e] + lbv[e];
        o4[e] = (yn + sb * v[e]) * g[e];
      }
      uint2 oo; oo.x = pack2(o4[0], o4[1]); oo.y = pack2(o4[2], o4[3]);
      *reinterpret_cast<uint2*>(p.abuf + o) = oo;
    }
  }
}

struct EpiWO {
  static constexpr bool PERM = false;
  const float* x; const float* mod; float* z; int layer;
  DEVINL void operator()(const f32x4 (&acc)[2][2][4][2], const pg8::Unit& u, int wr, int wc, int fr, int fq) const {
    const int row0 = u.pm * 256 + wr * 64 + fr, col0 = u.pn * 256 + wc * 32 + 4 * fq;
    const float* gate = mod + ((size_t)layer * 9 + cond_of_row(u.pm * 256)) * 6144 + 2 * 1024;
    f32x4 gv[2][2];
#pragma unroll
    for (int bj = 0; bj < 2; ++bj)
#pragma unroll
      for (int n = 0; n < 2; ++n) gv[bj][n] = *reinterpret_cast<const f32x4*>(gate + col0 + bj * 128 + n * 16);
#pragma unroll
    for (int ai = 0; ai < 2; ++ai)
#pragma unroll
      for (int m = 0; m < 4; ++m) {
        const size_t off = (size_t)(row0 + ai * 128 + m * 16) * DM + col0;
#pragma unroll
        for (int bj = 0; bj < 2; ++bj)
#pragma unroll
          for (int n = 0; n < 2; ++n) {
            const f32x4 xv = *reinterpret_cast<const f32x4*>(x + off + bj * 128 + n * 16);
            *reinterpret_cast<f32x4*>(z + off + bj * 128 + n * 16) = ALPHA_F * xv + gv[bj][n] * acc[ai][bj][m][n];
          }
        asm volatile("" ::: "memory");
      }
  }
};
DEVINL void phase_wo(const Params& p, int layer, int w, int nw, char* smem, int gwid) {
  const int j = layer >> 1;
  const bf16_t* Wt = ((layer & 1) ? p.attn_wo_t : p.rwkv_wo_t) + ((size_t)j << 20);
  EpiWO E; E.x = p.xbuf; E.mod = p.mod; E.z = p.zbuf; E.layer = layer;
  pg8::ASelOne as; as.A = (const char*)p.abuf;
  pg8::StaticOrder S; S.init(TT, 1024, nw, w);
  pg8::gemm_phase<EpiWO, pg8::ASelOne>((PG8_LAS unsigned char*)smem, as, Wt, 1024, S, E, gwid);
}

DEVINL void phase_ln1(const Params& p, int layer, int w, int nw, int gwid) {
  const int lane = tidx(gwid) & 63;
  const int gw = w * NWAVES + (tidx(gwid) >> 6), ngw = nw * NWAVES;
  const float* lng = p.in[9] + (size_t)(layer * 2 + 0) * 1024;
  const float* lnb = p.in[10] + (size_t)(layer * 2 + 0) * 1024;
  for (int row = gw; row < TT; row += ngw) {
    const float* md = p.mod + ((size_t)layer * 9 + cond_of_row(row)) * 6144;
    float4 z[4];
    float s = 0.f;
#pragma unroll
    for (int k = 0; k < 4; ++k) {
      z[k] = *reinterpret_cast<const float4*>(p.zbuf + (size_t)row * DM + k * 256 + lane * 4);
      s += z[k].x + z[k].y + z[k].z + z[k].w;
    }
    const float mean = wave_sum(s) * (1.0f / 1024.0f);
    float sv = 0.f;
#pragma unroll
    for (int k = 0; k < 4; ++k) {
      float a = z[k].x - mean, b = z[k].y - mean, c = z[k].z - mean, d = z[k].w - mean;
      sv += a * a + b * b + c * c + d * d;
    }
    const float rstd = rsqrtf(wave_sum(sv) * (1.0f / 1024.0f) + LN_EPS_F);
#pragma unroll
    for (int k = 0; k < 4; ++k) {
      const int col = k * 256 + lane * 4;
      const float4 g4 = *reinterpret_cast<const float4*>(lng + col);
      const float4 b4 = *reinterpret_cast<const float4*>(lnb + col);
      const float4 sh = *reinterpret_cast<const float4*>(md + 3 * 1024 + col);
      const float4 sc = *reinterpret_cast<const float4*>(md + 4 * 1024 + col);
      float4 x1;
      x1.x = (z[k].x - mean) * rstd * g4.x + b4.x;
      x1.y = (z[k].y - mean) * rstd * g4.y + b4.y;
      x1.z = (z[k].z - mean) * rstd * g4.z + b4.z;
      x1.w = (z[k].w - mean) * rstd * g4.w + b4.w;
      *reinterpret_cast<float4*>(p.xbuf + (size_t)row * DM + col) = x1;
      uint2 o;
      o.x = pack2(x1.x * (1.0f + sc.x) + sh.x, x1.y * (1.0f + sc.y) + sh.y);
      o.y = pack2(x1.z * (1.0f + sc.z) + sh.z, x1.w * (1.0f + sc.w) + sh.w);
      *reinterpret_cast<uint2*>(p.hbuf + (size_t)row * DM + col) = o;
    }
  }
}

struct EpiBf16 {
  static constexpr bool PERM = true;
  bf16_t* O; int ldc;
  DEVINL void operator()(const f32x4 (&acc)[2][2][4][2], const pg8::Unit& u, int wr, int wc, int fr, int fq) const {
    const int row0 = u.pm * 256 + wr * 64 + fr, col0 = u.pn * 256 + wc * 32 + 8 * fq;
#pragma unroll
    for (int ai = 0; ai < 2; ++ai)
#pragma unroll
      for (int m = 0; m < 4; ++m) {
        bf16_t* rowp = O + (size_t)(row0 + ai * 128 + m * 16) * ldc + col0;
#pragma unroll
        for (int bj = 0; bj < 2; ++bj) {
          const f32x4 v0 = acc[ai][bj][m][0], v1 = acc[ai][bj][m][1];
          pg8::u32x4 o; o.x = pg8::cvt_pk_bf16(v0[0], v0[1]); o.y = pg8::cvt_pk_bf16(v0[2], v0[3]); o.z = pg8::cvt_pk_bf16(v1[0], v1[1]); o.w = pg8::cvt_pk_bf16(v1[2], v1[3]);
          *reinterpret_cast<pg8::u32x4*>(rowp + bj * 128) = o;
        }
      }
  }
};

DEVINL void phase_p1(const Params& p, int layer, int w, int nw, char* smem, int gwid) {
  EpiBf16 E; E.O = reinterpret_cast<bf16_t*>(p.U1); E.ldc = 2048;
  pg8::ASelOne as; as.A = (const char*)p.hbuf;
  pg8::StaticOrder S; S.init(TT, 2048, nw, w);
  pg8::gemm_phase<EpiBf16, pg8::ASelOne>((PG8_LAS unsigned char*)smem, as, p.wq_t + (size_t)layer * 2048 * 1024, 1024, S, E, gwid);
}

#define U1_S_OFF ((size_t)TT * 2048 * 2)
DEVINL void phase_p2(const Params& p, int layer, int w, int nw, char* smem, int gwid) {
  GEMM_LANE_VARS
  const int half = tidx(gwid) >> 8;
  char* sh = smem + half * 16384;
  const bf16_t* qb = reinterpret_cast<const bf16_t*>(p.U1);
  float* sb = reinterpret_cast<float*>(p.U1 + U1_S_OFF);
  const int NTILES = 96 * 16;
  for (int it = 0; it * nw * 2 < NTILES; ++it) {
    int tile = (it * nw + w) * 2 + half;
    const bool valid = tile < NTILES;
    if (!valid) tile = 0;
    const int ct = tile / 96, rt = tile % 96;
    const int row0 = rt * 128;
    const int z = ct & 1;
    f32x4 acc[4][4];
    gemm_tile_128(qb + (size_t)row0 * 2048 + ct * 128, 2048, p.keysb + (size_t)(layer * 2 + z) * 16384, 128, 128, sh, acc, gwid);
    if (valid) {
#pragma unroll
      for (int m = 0; m < 4; ++m)
#pragma unroll
        for (int n = 0; n < 4; ++n)
#pragma unroll
          for (int jj = 0; jj < 4; ++jj) {
            int row = row0 + wr * 64 + m * 16 + fq * 4 + jj, col = wc * 64 + n * 16 + fr;
            sb[(size_t)row * 2048 + ct * 128 + col] = acc[m][n][jj];
          }
    }
  }
}

#define DPP_QP_1032 0xB1
#define DPP_QP_2301 0x4E
#define DPP_ROW_HALF_MIRROR 0x141
#define DPP_ROW_MIRROR 0x140
DEVINL unsigned umax_(unsigned a, unsigned b) { return a > b ? a : b; }
DEVINL unsigned umin_(unsigned a, unsigned b) { return a < b ? a : b; }
DEVINL unsigned row_max_u(unsigned v) {
  v = umax_(v, (unsigned)__builtin_amdgcn_update_dpp(0, (int)v, DPP_QP_1032, 0xf, 0xf, true));
  v = umax_(v, (unsigned)__builtin_amdgcn_update_dpp(0, (int)v, DPP_QP_2301, 0xf, 0xf, true));
  v = umax_(v, (unsigned)__builtin_amdgcn_update_dpp(0, (int)v, DPP_ROW_HALF_MIRROR, 0xf, 0xf, true));
  v = umax_(v, (unsigned)__builtin_amdgcn_update_dpp(0, (int)v, DPP_ROW_MIRROR, 0xf, 0xf, true));
  return v;
}
DEVINL float row_max_f(float v) {
  v = fmaxf(v, __int_as_float(__builtin_amdgcn_update_dpp(0, __float_as_int(v), DPP_QP_1032, 0xf, 0xf, true)));
  v = fmaxf(v, __int_as_float(__builtin_amdgcn_update_dpp(0, __float_as_int(v), DPP_QP_2301, 0xf, 0xf, true)));
  v = fmaxf(v, __int_as_float(__builtin_amdgcn_update_dpp(0, __float_as_int(v), DPP_ROW_HALF_MIRROR, 0xf, 0xf, true)));
  v = fmaxf(v, __int_as_float(__builtin_amdgcn_update_dpp(0, __float_as_int(v), DPP_ROW_MIRROR, 0xf, 0xf, true)));
  return v;
}
DEVINL float row_sum_f(float v) {
  v += __int_as_float(__builtin_amdgcn_update_dpp(0, __float_as_int(v), DPP_QP_1032, 0xf, 0xf, true));
  v += __int_as_float(__builtin_amdgcn_update_dpp(0, __float_as_int(v), DPP_QP_2301, 0xf, 0xf, true));
  v += __int_as_float(__builtin_amdgcn_update_dpp(0, __float_as_int(v), DPP_ROW_HALF_MIRROR, 0xf, 0xf, true));
  v += __int_as_float(__builtin_amdgcn_update_dpp(0, __float_as_int(v), DPP_ROW_MIRROR, 0xf, 0xf, true));
  return v;
}
DEVINL float unordf(unsigned u) { return __uint_as_float((u & 0x80000000u) ? (u ^ 0x80000000u) : ~u); }
#define CSWAP(a, b) { const unsigned _hi = umax_(a, b), _lo = umin_(a, b); a = _hi; b = _lo; }
DEVINL void slot_ij(int s, int& i, int& j) {
  if (s < 16) { i = 0; j = s; }
  else if (s < 24) { i = 1; j = s - 16; }
  else if (s < 29) { i = 2; j = s - 24; }
  else if (s < 33) { i = 3; j = s - 29; }
  else if (s < 36) { i = 4; j = s - 33; }
  else if (s < 42) { i = 5 + ((s - 36) >> 1); j = (s - 36) & 1; }
  else { i = s - 34; j = 0; }
}
DEVINL void phase_p3(const Params& p, int layer, int w, int nw, char* smem, int gwid) {
  const int lane = tidx(gwid) & 63, wid = tidx(gwid) >> 6;
  const int fr = lane & 15, row = lane >> 4, pr = lane >> 5, l32 = lane & 31;
  const int gw = w * NWAVES + wid, ngw = nw * NWAVES;
  const float* sb = reinterpret_cast<const float*>(p.U1 + U1_S_OFF);
  float* svl = reinterpret_cast<float*>(smem) + wid * 128;
  int* sil = reinterpret_cast<int*>(smem) + wid * 128 + 64;
  int iA, jA, iB, jB;
  slot_ij(l32, iA, jA);
  const bool validB = (l32 + 32) < 50;
  slot_ij(validB ? (l32 + 32) : 0, iB, jB);
  for (int bt = gw; bt < TT * 4; bt += ngw) {
    const int t = bt >> 2, hp = bt & 3;
    {
      const int h = hp * 2 + (row >> 1), z = row & 1;
      const float* sp = sb + (size_t)t * 2048 + (h * 2 + z) * 128;
      const float4 a = *reinterpret_cast<const float4*>(sp + fr * 4);
      const float4 b = *reinterpret_cast<const float4*>(sp + 64 + fr * 4);
      unsigned k0 = (ordf(a.x) & ~127u) | (unsigned)(127 - (4 * fr + 0));
      unsigned k1 = (ordf(a.y) & ~127u) | (unsigned)(127 - (4 * fr + 1));
      unsigned k2 = (ordf(a.z) & ~127u) | (unsigned)(127 - (4 * fr + 2));
      unsigned k3 = (ordf(a.w) & ~127u) | (unsigned)(127 - (4 * fr + 3));
      unsigned k4 = (ordf(b.x) & ~127u) | (unsigned)(127 - (64 + 4 * fr + 0));
      unsigned k5 = (ordf(b.y) & ~127u) | (unsigned)(127 - (64 + 4 * fr + 1));
      unsigned k6 = (ordf(b.z) & ~127u) | (unsigned)(127 - (64 + 4 * fr + 2));
      unsigned k7 = (ordf(b.w) & ~127u) | (unsigned)(127 - (64 + 4 * fr + 3));
      CSWAP(k0, k1); CSWAP(k2, k3); CSWAP(k4, k5); CSWAP(k6, k7);
      CSWAP(k0, k2); CSWAP(k1, k3); CSWAP(k4, k6); CSWAP(k5, k7);
      CSWAP(k1, k2); CSWAP(k5, k6); CSWAP(k0, k4); CSWAP(k3, k7);
      CSWAP(k1, k5); CSWAP(k2, k6);
      CSWAP(k1, k4); CSWAP(k3, k6);
      CSWAP(k2, k4); CSWAP(k3, k5);
      CSWAP(k3, k4);
      unsigned mine = 0;
#pragma unroll
      for (int it = 0; it < 16; ++it) {
        const unsigned m = row_max_u(k0);
        if (fr == it) mine = m;
        const bool c = (k0 == m);
        k0 = c ? k1 : k0; k1 = c ? k2 : k1; k2 = c ? k3 : k2; k3 = c ? k4 : k3;
        k4 = c ? k5 : k4; k5 = c ? k6 : k5; k6 = c ? k7 : k6; k7 = c ? 0u : k7;
      }
      __builtin_amdgcn_wave_barrier();
      svl[row * 16 + fr] = unordf(mine & ~127u);
      sil[row * 16 + fr] = 127 - (int)(mine & 127u);
      __builtin_amdgcn_wave_barrier();
    }
    {
      const float* v0 = svl + (2 * pr) * 16;
      const float* v1 = svl + (2 * pr + 1) * 16;
      unsigned kA = (ordf(v0[iA] + v1[jA]) & ~63u) | (unsigned)(63 - l32);
      unsigned kB = validB ? ((ordf(v0[iB] + v1[jB]) & ~63u) | (unsigned)(63 - (l32 + 32))) : 0u;
      unsigned mine = 0;
#pragma unroll
      for (int it = 0; it < 16; ++it) {
        unsigned m = row_max_u(umax_(kA, kB));
        m = umax_(m, (unsigned)__shfl_xor((int)m, 16));
        if (l32 == it) mine = m;
        kA = (kA == m) ? 0u : kA;
        kB = (kB == m) ? 0u : kB;
      }
      int ii, jj;
      slot_ij(63 - (int)(mine & 63u), ii, jj);
      ii &= 15; jj &= 15;
      const float cv = v0[ii] + v1[jj];
      const int eidx = sil[(2 * pr) * 16 + ii] * 128 + sil[(2 * pr + 1) * 16 + jj];
      const float mx = row_max_f(cv);
      const float ex = __expf(cv - mx);
      const float sm = row_sum_f(ex);
      if (l32 < 16) {
        const int h = hp * 2 + pr;
        p.pidx[(size_t)t * 128 + h * 16 + l32] = eidx;
        p.pgate[(size_t)t * 128 + h * 16 + l32] = ex / sm;
      }
    }
  }
}

DEVINL void phase_p23(const Params& p, int layer, int w, int nw, char* smem, int gwid) {
  GEMM_LANE_VARS
  const int l64 = tidx(gwid) & 63, wid8 = tidx(gwid) >> 6, half = tidx(gwid) >> 8;
  const int row = l64 >> 4, pr = l64 >> 5, l32 = l64 & 31;
  const bf16_t* qb = reinterpret_cast<const bf16_t*>(p.U1);
  float* tiles = reinterpret_cast<float*>(smem);
  float* svl = reinterpret_cast<float*>(smem + 131072) + wid8 * 128;
  int* sil = reinterpret_cast<int*>(smem + 131072) + wid8 * 128 + 64;
  int iA, jA, iB, jB;
  slot_ij(l32, iA, jA);
  const bool validB = (l32 + 32) < 50;
  slot_ij(validB ? (l32 + 32) : 0, iB, jB);
  for (int unit = w; unit < 96 * 8; unit += nw) {
    const int h = unit / 96, rt = unit % 96;
    const int row0 = rt * 128;
    {
      f32x4 acc[4][4];
      gemm_tile_128(qb + (size_t)row0 * 2048 + (h * 2 + half) * 128, 2048, p.keysb + (size_t)(layer * 2 + half) * 16384, 128, 128, smem + half * 16384, acc, gwid);
      float* tz = tiles + half * 16384;
#pragma unroll
      for (int m = 0; m < 4; ++m)
#pragma unroll
        for (int n = 0; n < 4; ++n)
#pragma unroll
          for (int jj = 0; jj < 4; ++jj) tz[(wr * 64 + m * 16 + fq * 4 + jj) * 128 + wc * 64 + n * 16 + fr] = acc[m][n][jj];
    }
    __syncthreads();
#pragma unroll 1
    for (int i = 0; i < 8; ++i) {
      const int tl = wid8 * 16 + i * 2;
      {
        const int z = row & 1, tt = tl + (row >> 1);
        const float* sp = tiles + z * 16384 + tt * 128;
        const float4 a = *reinterpret_cast<const float4*>(sp + fr * 4);
        const float4 b = *reinterpret_cast<const float4*>(sp + 64 + fr * 4);
        unsigned k0 = (ordf(a.x) & ~127u) | (unsigned)(127 - (4 * fr + 0));
        unsigned k1 = (ordf(a.y) & ~127u) | (unsigned)(127 - (4 * fr + 1));
        unsigned k2 = (ordf(a.z) & ~127u) | (unsigned)(127 - (4 * fr + 2));
        unsigned k3 = (ordf(a.w) & ~127u) | (unsigned)(127 - (4 * fr + 3));
        unsigned k4 = (ordf(b.x) & ~127u) | (unsigned)(127 - (64 + 4 * fr + 0));
        unsigned k5 = (ordf(b.y) & ~127u) | (unsigned)(127 - (64 + 4 * fr + 1));
        unsigned k6 = (ordf(b.z) & ~127u) | (unsigned)(127 - (64 + 4 * fr + 2));
        unsigned k7 = (ordf(b.w) & ~127u) | (unsigned)(127 - (64 + 4 * fr + 3));
        CSWAP(k0, k1); CSWAP(k2, k3); CSWAP(k4, k5); CSWAP(k6, k7);
        CSWAP(k0, k2); CSWAP(k1, k3); CSWAP(k4, k6); CSWAP(k5, k7);
        CSWAP(k1, k2); CSWAP(k5, k6); CSWAP(k0, k4); CSWAP(k3, k7);
        CSWAP(k1, k5); CSWAP(k2, k6);
        CSWAP(k1, k4); CSWAP(k3, k6);
        CSWAP(k2, k4); CSWAP(k3, k5);
        CSWAP(k3, k4);
        unsigned mine = 0;
#pragma unroll
        for (int it = 0; it < 16; ++it) {
          const unsigned m = row_max_u(k0);
          if (fr == it) mine = m;
          const bool c = (k0 == m);
          k0 = c ? k1 : k0; k1 = c ? k2 : k1; k2 = c ? k3 : k2; k3 = c ? k4 : k3;
          k4 = c ? k5 : k4; k5 = c ? k6 : k5; k6 = c ? k7 : k6; k7 = c ? 0u : k7;
        }
        __builtin_amdgcn_wave_barrier();
        svl[row * 16 + fr] = unordf(mine & ~127u);
        sil[row * 16 + fr] = 127 - (int)(mine & 127u);
        __builtin_amdgcn_wave_barrier();
      }
      {
        const float* v0 = svl + (2 * pr) * 16;
        const float* v1 = svl + (2 * pr + 1) * 16;
        unsigned kA = (ordf(v0[iA] + v1[jA]) & ~63u) | (unsigned)(63 - l32);
        unsigned kB = validB ? ((ordf(v0[iB] + v1[jB]) & ~63u) | (unsigned)(63 - (l32 + 32))) : 0u;
        unsigned mine = 0;
#pragma unroll
        for (int it = 0; it < 16; ++it) {
          unsigned m = row_max_u(umax_(kA, kB));
          m = umax_(m, (unsigned)__shfl_xor((int)m, 16));
          if (l32 == it) mine = m;
          kA = (kA == m) ? 0u : kA;
          kB = (kB == m) ? 0u : kB;
        }
        int ii, jj;
        slot_ij(63 - (int)(mine & 63u), ii, jj);
        ii &= 15; jj &= 15;
        const float cv = v0[ii] + v1[jj];
        const int eidx = sil[(2 * pr) * 16 + ii] * 128 + sil[(2 * pr + 1) * 16 + jj];
        const float mx = row_max_f(cv);
        const float ex = __expf(cv - mx);
        const float sm = row_sum_f(ex);
        if (l32 < 16) {
          const int t = row0 + tl + pr;
          p.pidx[(size_t)t * 128 + h * 16 + l32] = eidx;
          p.pgate[(size_t)t * 128 + h * 16 + l32] = ex / sm;
        }
      }
    }
    __syncthreads();
  }
}

DEVINL float gelu_exact(float x) { return 0.5f * x * (1.0f + erff(x * 0.7071067811865476f)); }

DEVINL void phase_p4(const Params& p, int layer, int w, int nw, char* smem, int gwid) {
  const int tid = tidx(gwid), lane = tid & 63, wid = tid >> 6;
  const int fr = lane & 15, fq = lane >> 4;
  const int gw = w * NWAVES + wid, ngw = nw * NWAVES;
  const unsigned char* U = reinterpret_cast<const unsigned char*>(p.ub) + (size_t)layer * 16384 * 1024;
  const unsigned char* V = reinterpret_cast<const unsigned char*>(p.vb) + (size_t)layer * 16384 * 1024;
  const float* uinv = p.uinv + layer * 16384;
  const float* vinv = p.vinv + layer * 16384;
  const float* lng = p.in[9] + (size_t)(layer * 2 + 1) * 1024;
  const float* lnb = p.in[10] + (size_t)(layer * 2 + 1) * 1024;
  float* xout = (layer == 3) ? p.out : p.xbuf;
  char* wl = smem + wid * (3072 + 16384);
  unsigned char* ring = reinterpret_cast<unsigned char*>(wl) + 3072;
  unsigned char* xhi = reinterpret_cast<unsigned char*>(wl);
  unsigned char* xlo = xhi + 1024;
  float* wgt = reinterpret_cast<float*>(wl + 2048);
  int* il = reinterpret_cast<int*>(wl + 2560);
  for (int t = gw; t < TT; t += ngw) {
    __builtin_amdgcn_wave_barrier();
    const int gl = tidx(gwid) & 63;
    float xinv;
    {
      const uint4 a = *reinterpret_cast<const uint4*>(p.hbuf + (size_t)t * DM + gl * 16);
      const uint4 b = *reinterpret_cast<const uint4*>(p.hbuf + (size_t)t * DM + gl * 16 + 8);
      float x[16];
      x[0] = bflo(a.x); x[1] = bfhi(a.x); x[2] = bflo(a.y); x[3] = bfhi(a.y); x[4] = bflo(a.z); x[5] = bfhi(a.z); x[6] = bflo(a.w); x[7] = bfhi(a.w);
      x[8] = bflo(b.x); x[9] = bfhi(b.x); x[10] = bflo(b.y); x[11] = bfhi(b.y); x[12] = bflo(b.z); x[13] = bfhi(b.z); x[14] = bflo(b.w); x[15] = bfhi(b.w);
      float mx = 0.f;
#pragma unroll
      for (int q = 0; q < 16; ++q) mx = fmaxf(mx, fabsf(x[q]));
#pragma unroll
      for (int o = 32; o > 0; o >>= 1) mx = fmaxf(mx, __shfl_xor(mx, o));
      mx = fmaxf(mx, 1e-30f);
      const float sc = 440.0f / mx;
      xinv = mx * (1.0f / 440.0f);
      uint4 h4, l4;
      unsigned* hw = reinterpret_cast<unsigned*>(&h4);
      unsigned* lw = reinterpret_cast<unsigned*>(&l4);
#pragma unroll
      for (int q = 0; q < 4; ++q) {
        const float y0 = x[q * 4] * sc, y1 = x[q * 4 + 1] * sc, y2 = x[q * 4 + 2] * sc, y3 = x[q * 4 + 3] * sc;
        int pk = 0;
        pk = __builtin_amdgcn_cvt_pk_fp8_f32(y0, y1, pk, false);
        pk = __builtin_amdgcn_cvt_pk_fp8_f32(y2, y3, pk, true);
        const float r0 = y0 - __builtin_amdgcn_cvt_f32_fp8(pk, 0), r1 = y1 - __builtin_amdgcn_cvt_f32_fp8(pk, 1);
        const float r2 = y2 - __builtin_amdgcn_cvt_f32_fp8(pk, 2), r3 = y3 - __builtin_amdgcn_cvt_f32_fp8(pk, 3);
        int pl = 0;
        pl = __builtin_amdgcn_cvt_pk_fp8_f32(r0, r1, pl, false);
        pl = __builtin_amdgcn_cvt_pk_fp8_f32(r2, r3, pl, true);
        hw[q] = (unsigned)pk; lw[q] = (unsigned)pl;
      }
      *reinterpret_cast<uint4*>(xhi + lane * 16) = h4;
      *reinterpret_cast<uint4*>(xlo + lane * 16) = l4;
      il[lane] = p.pidx[(size_t)t * 128 + gl];
      il[64 + lane] = p.pidx[(size_t)t * 128 + 64 + gl];
    }
    __builtin_amdgcn_wave_barrier();
    f32x4 acc[8];
#pragma unroll
    for (int g = 0; g < 8; ++g) acc[g] = (f32x4){0.f, 0.f, 0.f, 0.f};
    {
      const int dr = lane >> 3, dpc = (lane & 7) ^ (lane >> 3);
      unsigned rowoff[8][2];
#pragma unroll
      for (int g = 0; g < 8; ++g) {
        rowoff[g][0] = (unsigned)il[g * 16 + dr] * 1024u + (unsigned)dpc * 16u;
        rowoff[g][1] = (unsigned)il[g * 16 + 8 + dr] * 1024u + (unsigned)dpc * 16u;
      }
      const int rd0 = fr * 128 + ((fq ^ (fr & 7)) * 16), rd1 = fr * 128 + (((4 + fq) ^ (fr & 7)) * 16);
#define P4_ISSUE(tile_c, tile_g, slot) do { \
        __builtin_amdgcn_global_load_lds((const unsigned*)(U + (rowoff[tile_g][0] + (unsigned)((tile_c) * 128))), (unsigned*)(ring + (slot) * 2048 + lane * 16), 16, 0, 0); \
        __builtin_amdgcn_global_load_lds((const unsigned*)(U + (rowoff[tile_g][1] + (unsigned)((tile_c) * 128))), (unsigned*)(ring + (slot) * 2048 + 1024 + lane * 16), 16, 0, 0); } while (0)
#pragma unroll
      for (int g = 0; g < 8; ++g) P4_ISSUE(0, g, g);
#pragma unroll 1
      for (int c = 0; c < 8; ++c) {
        const uint4 xh0v = *reinterpret_cast<const uint4*>(xhi + c * 128 + fq * 16);
        const uint4 xh1v = *reinterpret_cast<const uint4*>(xhi + c * 128 + 64 + fq * 16);
        const uint4 xl0v = *reinterpret_cast<const uint4*>(xlo + c * 128 + fq * 16);
        const uint4 xl1v = *reinterpret_cast<const uint4*>(xlo + c * 128 + 64 + fq * 16);
#define LL(v, a, b) ((long)(((unsigned long long)(v).b << 32) | (v).a))
#pragma unroll
        for (int g = 0; g < 8; ++g) {
          if (c < 7) asm volatile("s_waitcnt vmcnt(14)" ::: "memory");
          else {
            if (g == 0) asm volatile("s_waitcnt vmcnt(14)" ::: "memory");
            else if (g == 1) asm volatile("s_waitcnt vmcnt(12)" ::: "memory");
            else if (g == 2) asm volatile("s_waitcnt vmcnt(10)" ::: "memory");
            else if (g == 3) asm volatile("s_waitcnt vmcnt(8)" ::: "memory");
            else if (g == 4) asm volatile("s_waitcnt vmcnt(6)" ::: "memory");
            else if (g == 5) asm volatile("s_waitcnt vmcnt(4)" ::: "memory");
            else if (g == 6) asm volatile("s_waitcnt vmcnt(2)" ::: "memory");
            else asm volatile("s_waitcnt vmcnt(0)" ::: "memory");
          }
          const uint4 a0v = *reinterpret_cast<const uint4*>(ring + g * 2048 + rd0);
          const uint4 a1v = *reinterpret_cast<const uint4*>(ring + g * 2048 + rd1);
          asm volatile("s_waitcnt lgkmcnt(0)" ::: "memory");
          if (c < 7) P4_ISSUE(c + 1, g, g);
          acc[g] = __builtin_amdgcn_mfma_f32_16x16x32_fp8_fp8(LL(a0v, x, y), LL(xh0v, x, y), acc[g], 0, 0, 0);
          acc[g] = __builtin_amdgcn_mfma_f32_16x16x32_fp8_fp8(LL(a0v, z, w), LL(xh0v, z, w), acc[g], 0, 0, 0);
          acc[g] = __builtin_amdgcn_mfma_f32_16x16x32_fp8_fp8(LL(a1v, x, y), LL(xh1v, x, y), acc[g], 0, 0, 0);
          acc[g] = __builtin_amdgcn_mfma_f32_16x16x32_fp8_fp8(LL(a1v, z, w), LL(xh1v, z, w), acc[g], 0, 0, 0);
          acc[g] = __builtin_amdgcn_mfma_f32_16x16x32_fp8_fp8(LL(a0v, x, y), LL(xl0v, x, y), acc[g], 0, 0, 0);
          acc[g] = __builtin_amdgcn_mfma_f32_16x16x32_fp8_fp8(LL(a0v, z, w), LL(xl0v, z, w), acc[g], 0, 0, 0);
          acc[g] = __builtin_amdgcn_mfma_f32_16x16x32_fp8_fp8(LL(a1v, x, y), LL(xl1v, x, y), acc[g], 0, 0, 0);
          acc[g] = __builtin_amdgcn_mfma_f32_16x16x32_fp8_fp8(LL(a1v, z, w), LL(xl1v, z, w), acc[g], 0, 0, 0);
        }
      }
#undef LL
#undef P4_ISSUE
    }
#pragma unroll
    for (int g = 0; g < 8; ++g) {
      const float4 gt = *reinterpret_cast<const float4*>(p.pgate + (size_t)t * 128 + g * 16 + fq * 4);
      const int e0 = g * 16 + fq * 4;
      const int i0 = il[e0], i1 = il[e0 + 1], i2 = il[e0 + 2], i3 = il[e0 + 3];
      float4 wv;
      wv.x = gt.x * gelu_exact(acc[g][0] * (uinv[i0] * xinv)) * vinv[i0];
      wv.y = gt.y * gelu_exact(acc[g][1] * (uinv[i1] * xinv)) * vinv[i1];
      wv.z = gt.z * gelu_exact(acc[g][2] * (uinv[i2] * xinv)) * vinv[i2];
      wv.w = gt.w * gelu_exact(acc[g][3] * (uinv[i3] * xinv)) * vinv[i3];
      if (fr == 0) *reinterpret_cast<float4*>(wgt + e0) = wv;
    }
    __builtin_amdgcn_wave_barrier();
    float f[16];
#pragma unroll
    for (int e = 0; e < 16; ++e) f[e] = 0.f;
    {
#define P4V_ISSUE(ee, slot) do { const int _idx = __builtin_amdgcn_readfirstlane(il[ee]); \
        __builtin_amdgcn_global_load_lds((const unsigned*)(V + (size_t)_idx * 1024 + lane * 16), (unsigned*)(ring + (slot) * 1024 + lane * 16), 16, 0, 0); } while (0)
#define P4V_ACC(cv, we) do { const unsigned _cw[4] = {(cv).x, (cv).y, (cv).z, (cv).w}; \
        _Pragma("unroll") for (int q = 0; q < 4; ++q) { \
          const __attribute__((ext_vector_type(2))) float lo2 = __builtin_amdgcn_cvt_pk_f32_fp8((int)_cw[q], false); \
          const __attribute__((ext_vector_type(2))) float hi2 = __builtin_amdgcn_cvt_pk_f32_fp8((int)_cw[q], true); \
          f[q * 4 + 0] += (we) * lo2.x; f[q * 4 + 1] += (we) * lo2.y; f[q * 4 + 2] += (we) * hi2.x; f[q * 4 + 3] += (we) * hi2.y; } } while (0)
#pragma unroll
      for (int k = 0; k < 16; ++k) P4V_ISSUE(k, k);
#pragma unroll 1
      for (int eb = 0; eb < 7; ++eb) {
#pragma unroll
        for (int k = 0; k < 16; ++k) {
          asm volatile("s_waitcnt vmcnt(15)" ::: "memory");
          const uint4 cv = *reinterpret_cast<const uint4*>(ring + k * 1024 + lane * 16);
          const float we = wgt[eb * 16 + k];
          asm volatile("s_waitcnt lgkmcnt(0)" ::: "memory");
          P4V_ISSUE((eb + 1) * 16 + k, k);
          P4V_ACC(cv, we);
        }
      }
      {
        uint4 cv; float we;
#define P4V_TAIL(k, n) asm volatile("s_waitcnt vmcnt(" #n ")" ::: "memory"); cv = *reinterpret_cast<const uint4*>(ring + (k) * 1024 + lane * 16); we = wgt[112 + (k)]; P4V_ACC(cv, we);
        P4V_TAIL(0, 15) P4V_TAIL(1, 14) P4V_TAIL(2, 13) P4V_TAIL(3, 12) P4V_TAIL(4, 11) P4V_TAIL(5, 10) P4V_TAIL(6, 9) P4V_TAIL(7, 8)
        P4V_TAIL(8, 7) P4V_TAIL(9, 6) P4V_TAIL(10, 5) P4V_TAIL(11, 4) P4V_TAIL(12, 3) P4V_TAIL(13, 2) P4V_TAIL(14, 1) P4V_TAIL(15, 0)
#undef P4V_TAIL
      }
#undef P4V_ISSUE
#undef P4V_ACC
    }
    const int gl2 = tidx(gwid) & 63;
    const float* md = p.mod + ((size_t)layer * 9 + cond_of_row(t)) * 6144 + 5 * 1024;
    float zz[16];
    float s = 0.f;
#pragma unroll
    for (int q = 0; q < 4; ++q) {
      const int col = gl2 * 16 + q * 4;
      const float4 x0 = *reinterpret_cast<const float4*>(p.xbuf + (size_t)t * DM + col);
      const float4 g0 = *reinterpret_cast<const float4*>(md + col);
      zz[q * 4 + 0] = ALPHA_F * x0.x + g0.x * f[q * 4 + 0];
      zz[q * 4 + 1] = ALPHA_F * x0.y + g0.y * f[q * 4 + 1];
      zz[q * 4 + 2] = ALPHA_F * x0.z + g0.z * f[q * 4 + 2];
      zz[q * 4 + 3] = ALPHA_F * x0.w + g0.w * f[q * 4 + 3];
      s += zz[q * 4] + zz[q * 4 + 1] + zz[q * 4 + 2] + zz[q * 4 + 3];
    }
    const float mean = wave_sum(s) * (1.0f / 1024.0f);
    float sv = 0.f;
#pragma unroll
    for (int e = 0; e < 16; ++e) { float d = zz[e] - mean; sv += d * d; }
    const float rstd = rsqrtf(wave_sum(sv) * (1.0f / 1024.0f) + LN_EPS_F);
#pragma unroll
    for (int q = 0; q < 4; ++q) {
      const int col = gl2 * 16 + q * 4;
      const float4 g0 = *reinterpret_cast<const float4*>(lng + col);
      const float4 b0 = *reinterpret_cast<const float4*>(lnb + col);
      float4 o0;
      o0.x = (zz[q * 4 + 0] - mean) * rstd * g0.x + b0.x;
      o0.y = (zz[q * 4 + 1] - mean) * rstd * g0.y + b0.y;
      o0.z = (zz[q * 4 + 2] - mean) * rstd * g0.z + b0.z;
      o0.w = (zz[q * 4 + 3] - mean) * rstd * g0.w + b0.w;
      *reinterpret_cast<float4*>(xout + (size_t)t * DM + col) = o0;
    }
  }
}

DEVINL void phase_a1(const Params& p, int layer, int w, int nw, int gwid) {
  const int lane = tidx(gwid) & 63;
  const int gw = w * NWAVES + (tidx(gwid) >> 6), ngw = nw * NWAVES;
  for (int row = gw; row < TT; row += ngw) {
    const float* md = p.mod + ((size_t)layer * 9 + cond_of_row(row)) * 6144;
#pragma unroll
    for (int k = 0; k < 4; ++k) {
      const int col = k * 256 + lane * 4;
      const float4 x = *reinterpret_cast<const float4*>(p.xbuf + (size_t)row * DM + col);
      const float4 sh = *reinterpret_cast<const float4*>(md + col);
      const float4 sc = *reinterpret_cast<const float4*>(md + 1024 + col);
      uint2 o;
      o.x = pack2(x.x * (1.0f + sc.x) + sh.x, x.y * (1.0f + sc.y) + sh.y);
      o.y = pack2(x.z * (1.0f + sc.z) + sh.z, x.w * (1.0f + sc.w) + sh.w);
      *reinterpret_cast<uint2*>(p.hbuf + (size_t)row * DM + col) = o;
    }
  }
}

DEVINL void phase_a2(const Params& p, int layer, int w, int nw, char* smem, int gwid) {
  const int j = layer >> 1;
  EpiBf16 E; E.O = reinterpret_cast<bf16_t*>(p.U1); E.ldc = 1536;
  pg8::ASelOne as; as.A = (const char*)p.hbuf;
  pg8::StaticOrder S; S.init(TT, 1536, nw, w);
  pg8::gemm_phase<EpiBf16, pg8::ASelOne>((PG8_LAS unsigned char*)smem, as, p.attn_wqkv_t + (size_t)j * 1536 * 1024, 1024, S, E, gwid);
}

DEVINL void load16(const bf16_t* src, float (&x)[16]) {
  const uint4 a = *reinterpret_cast<const uint4*>(src);
  const uint4 b = *reinterpret_cast<const uint4*>(src + 8);
  x[0] = bflo(a.x); x[1] = bfhi(a.x); x[2] = bflo(a.y); x[3] = bfhi(a.y); x[4] = bflo(a.z); x[5] = bfhi(a.z); x[6] = bflo(a.w); x[7] = bfhi(a.w);
  x[8] = bflo(b.x); x[9] = bfhi(b.x); x[10] = bflo(b.y); x[11] = bfhi(b.y); x[12] = bflo(b.z); x[13] = bfhi(b.z); x[14] = bflo(b.w); x[15] = bfhi(b.w);
}
DEVINL void store16bf(bf16_t* dst, const float (&x)[16]) {
  uint4 a, b;
  a.x = pack2(x[0], x[1]); a.y = pack2(x[2], x[3]); a.z = pack2(x[4], x[5]); a.w = pack2(x[6], x[7]);
  b.x = pack2(x[8], x[9]); b.y = pack2(x[10], x[11]); b.z = pack2(x[12], x[13]); b.w = pack2(x[14], x[15]);
  *reinterpret_cast<uint4*>(dst) = a; *reinterpret_cast<uint4*>(dst + 8) = b;
}
DEVINL void headnorm_rope(float (&x)[16], const float* nwgt, int quarter, bool lat, int t, const float* rope) {
  float ss = 0.f;
#pragma unroll
  for (int e = 0; e < 16; ++e) ss += x[e] * x[e];
  ss += __shfl_xor(ss, 1); ss += __shfl_xor(ss, 2);
  const float rinv = rsqrtf(ss * (1.0f / 64.0f) + RMS_EPS_F);
#pragma unroll
  for (int e = 0; e < 16; ++e) x[e] = x[e] * rinv * nwgt[quarter * 16 + e];
  if (lat) {
    const int pos = (quarter < 2) ? (t >> 6) : (t & 63);
    const bool hi = quarter & 1;
#pragma unroll
    for (int e = 0; e < 16; ++e) {
      const float other = __shfl_xor(x[e], 1);
      const float c = rope[(pos * 16 + e) * 2], s = rope[(pos * 16 + e) * 2 + 1];
      x[e] = hi ? (x[e] * c + other * s) : (x[e] * c - other * s);
    }
  }
}

DEVINL void phase_a2b(const Params& p, int layer, int w, int nw, int gwid) {
  const int j = layer >> 1;
  const int lane = tidx(gwid) & 63;
  const int gw = w * NWAVES + (tidx(gwid) >> 6), ngw = nw * NWAVES;
  const bf16_t* qkv = reinterpret_cast<const bf16_t*>(p.U1);
  bf16_t* qb = reinterpret_cast<bf16_t*>(p.U2);
  const float* qn = p.in[29] + j * 64;
  const float* kn = p.in[30] + j * 64;
  for (int row = gw; row < TT; row += ngw) {
    const bool lat = row >= TCTX;
    const int t = lat ? ((row - TCTX) & 1023) : (row & 255);
    const int b = lat ? ((row - TCTX) >> 10) : (row >> 8);
    const bf16_t* src = qkv + (size_t)row * 1536;
    {
      float x[16];
      load16(src + lane * 16, x);
      headnorm_rope(x, qn, lane & 3, lat, t, p.rope);
#pragma unroll
      for (int e = 0; e < 16; ++e) x[e] *= QSCALE_F;
      store16bf(qb + (size_t)row * DM + lane * 16, x);
    }
    if (lane < 16) {
      const int kvh = lane >> 2, quarter = lane & 3;
      float x[16];
      load16(src + 1024 + lane * 16, x);
      headnorm_rope(x, kn, quarter, false, t, p.rope);
      if (lat) {
        const int pos = (quarter < 2) ? (t >> 6) : (t & 63);
        const bool hi = quarter & 1;
#pragma unroll
        for (int e = 0; e < 16; ++e) {
          const float other = __shfl_xor(x[e], 1);
          const float c = p.rope[(pos * 16 + e) * 2], s = p.rope[(pos * 16 + e) * 2 + 1];
          x[e] = hi ? (x[e] * c + other * s) : (x[e] * c - other * s);
        }
        store16bf(p.Klat + ((size_t)((j * 8 + b) * 4 + kvh) * 1536 + 512 + t) * 64 + quarter * 16, x);
      } else {
        store16bf(p.Kctx + ((size_t)((j * 16 + b) * 4 + kvh) * 256 + t) * 64 + quarter * 16, x);
        float* ko = p.out + OUT_CK + ((size_t)(b * 2 + j) * 256 + t) * 256 + kvh * 64 + quarter * 16;
#pragma unroll
        for (int q4 = 0; q4 < 4; ++q4) reinterpret_cast<float4*>(ko)[q4] = make_float4(x[q4 * 4], x[q4 * 4 + 1], x[q4 * 4 + 2], x[q4 * 4 + 3]);
      }
    } else if (lane < 32) {
      const int l2 = lane - 16;
      const int kvh = l2 >> 2, quarter = l2 & 3;
      float x[16];
      load16(src + 1280 + l2 * 16, x);
      if (lat) {
        bf16_t* vd = p.VlatT + (size_t)((j * 8 + b) * 4 + kvh) * 64 * 1536 + 512 + t;
#pragma unroll
        for (int e = 0; e < 16; ++e) vd[(size_t)(quarter * 16 + e) * 1536] = f2bf(x[e]);
      } else {
        bf16_t* vd = p.VctxT + (size_t)((j * 16 + b) * 4 + kvh) * 64 * 256 + t;
#pragma unroll
        for (int e = 0; e < 16; ++e) vd[(size_t)(quarter * 16 + e) * 256] = f2bf(x[e]);
        float* vo = p.out + OUT_CV + ((size_t)(b * 2 + j) * 256 + t) * 256 + kvh * 64 + quarter * 16;
#pragma unroll
        for (int q4 = 0; q4 < 4; ++q4) reinterpret_cast<float4*>(vo)[q4] = make_float4(x[q4 * 4], x[q4 * 4 + 1], x[q4 * 4 + 2], x[q4 * 4 + 3]);
      }
    }
  }
}

DEVINL void phase_a3(const Params& p, int layer, int w, int nw, char* smem, int gwid) {
  const int j = layer >> 1;
  const int lane = tidx(gwid) & 63, wid = __builtin_amdgcn_readfirstlane(tidx(gwid) >> 6);
  const int ql = lane & 31, hh = lane >> 5;
  const bf16_t* qb = reinterpret_cast<const bf16_t*>(p.U2);
  const int drow = wid * 8 + (lane >> 3);
  const int dsp = (lane & 7) ^ ((lane >> 3) & 7);
  for (int item = w; item < 768; item += nw) {
    int kvh, Tk, row0;
    const bf16_t *Kb, *Vt;
    if (item < 512) {
      const int b = item >> 6, qblk = item & 15;
      kvh = (item >> 4) & 3;
      Kb = p.Klat + (size_t)((j * 8 + b) * 4 + kvh) * 1536 * 64;
      Vt = p.VlatT + (size_t)((j * 8 + b) * 4 + kvh) * 64 * 1536;
      Tk = 1536; row0 = TCTX + b * 1024 + qblk * 64;
    } else {
      const int it = item - 512;
      const int b = it >> 4, qblk = it & 3;
      kvh = (it >> 2) & 3;
      Kb = p.Kctx + (size_t)((j * 16 + b) * 4 + kvh) * 256 * 64;
      Vt = p.VctxT + (size_t)((j * 16 + b) * 4 + kvh) * 64 * 256;
      Tk = 256; row0 = b * 256 + qblk * 64;
    }
    const int hq = kvh * 4 + (wid >> 1);
    const int qrow = row0 + (wid & 1) * 32 + ql;
    bf16x8 bq[4];
#pragma unroll
    for (int ks = 0; ks < 4; ++ks) bq[ks] = *reinterpret_cast<const bf16x8*>(qb + (size_t)qrow * DM + hq * 64 + ks * 16 + hh * 8);
    f32x16 o0, o1;
#pragma unroll
    for (int r = 0; r < 16; ++r) { o0[r] = 0.f; o1[r] = 0.f; }
    float mrun = -1e30f, lrun = 0.f;
    const int ntile = Tk >> 6;
#define A3_DMA(kt_, st_) do { \
      __builtin_amdgcn_global_load_lds((const unsigned*)(Kb + (size_t)((kt_) * 64 + drow) * 64 + dsp * 8), (unsigned*)(smem + (st_) * 16384 + wid * 1024 + lane * 16), 16, 0, 0); \
      __builtin_amdgcn_global_load_lds((const unsigned*)(Vt + (size_t)drow * Tk + (kt_) * 64 + dsp * 8), (unsigned*)(smem + (st_) * 16384 + 8192 + wid * 1024 + lane * 16), 16, 0, 0); } while (0)
    __syncthreads();
    A3_DMA(0, 0);
    for (int kt = 0; kt < ntile; ++kt) {
      asm volatile("s_waitcnt vmcnt(0)" ::: "memory");
      __syncthreads();
      if (kt + 1 < ntile) A3_DMA(kt + 1, (kt + 1) & 1);
      const char* Kt_ = smem + (kt & 1) * 16384;
      const char* Vt_ = Kt_ + 8192;
      f32x16 sacc[2];
#pragma unroll
      for (int kb2 = 0; kb2 < 2; ++kb2) {
#pragma unroll
        for (int r = 0; r < 16; ++r) sacc[kb2][r] = 0.f;
        const int r_ = kb2 * 32 + ql;
#pragma unroll
        for (int ks = 0; ks < 4; ++ks) {
          const bf16x8 ka = *reinterpret_cast<const bf16x8*>(Kt_ + r_ * 128 + (((ks * 2 + hh) ^ (r_ & 7)) * 16));
          sacc[kb2] = __builtin_amdgcn_mfma_f32_32x32x16_bf16(ka, bq[ks], sacc[kb2], 0, 0, 0);
        }
      }
      float tmax = sacc[0][0];
#pragma unroll
      for (int r = 1; r < 16; ++r) tmax = fmaxf(tmax, sacc[0][r]);
#pragma unroll
      for (int r = 0; r < 16; ++r) tmax = fmaxf(tmax, sacc[1][r]);
      tmax = fmaxf(tmax, __shfl_xor(tmax, 32));
      const float mnew = fmaxf(mrun, tmax);
      const float corr = exp2f(mrun - mnew);
      mrun = mnew;
      lrun *= corr;
#pragma unroll
      for (int r = 0; r < 16; ++r) { o0[r] *= corr; o1[r] *= corr; }
#pragma unroll
      for (int kb2 = 0; kb2 < 2; ++kb2) {
        float pv[16];
#pragma unroll
        for (int r = 0; r < 16; ++r) { pv[r] = exp2f(sacc[kb2][r] - mnew); lrun += pv[r]; }
#pragma unroll
        for (int s2 = 0; s2 < 2; ++s2) {
          union { bf16x8 v; unsigned u[4]; } pb;
#pragma unroll
          for (int q = 0; q < 4; ++q) pb.u[q] = pack2(pv[s2 * 8 + q * 2], pv[s2 * 8 + q * 2 + 1]);
          const int P1 = 4 * kb2 + 2 * s2;
#pragma unroll
          for (int dblk = 0; dblk < 2; ++dblk) {
            const int r_ = dblk * 32 + ql;
            const uint2 lo = *reinterpret_cast<const uint2*>(Vt_ + r_ * 128 + ((P1 ^ (r_ & 7)) * 16) + 8 * hh);
            const uint2 hi = *reinterpret_cast<const uint2*>(Vt_ + r_ * 128 + (((P1 + 1) ^ (r_ & 7)) * 16) + 8 * hh);
            union { bf16x8 v; unsigned u[4]; } va;
            va.u[0] = lo.x; va.u[1] = lo.y; va.u[2] = hi.x; va.u[3] = hi.y;
            if (dblk == 0) o0 = __builtin_amdgcn_mfma_f32_32x32x16_bf16(va.v, pb.v, o0, 0, 0, 0);
            else o1 = __builtin_amdgcn_mfma_f32_32x32x16_bf16(va.v, pb.v, o1, 0, 0, 0);
          }
        }
      }
    }
#undef A3_DMA
    const float ltot = lrun + __shfl_xor(lrun, 32);
    const float inv = 1.0f / ltot;
#pragma unroll
    for (int g = 0; g < 4; ++g) {
      uint2 oa, ob;
      oa.x = pack2(o0[4 * g] * inv, o0[4 * g + 1] * inv); oa.y = pack2(o0[4 * g + 2] * inv, o0[4 * g + 3] * inv);
      ob.x = pack2(o1[4 * g] * inv, o1[4 * g + 1] * inv); ob.y = pack2(o1[4 * g + 2] * inv, o1[4 * g + 3] * inv);
      *reinterpret_cast<uint2*>(p.abuf + (size_t)qrow * DM + hq * 64 + 8 * g + 4 * hh) = oa;
      *reinterpret_cast<uint2*>(p.abuf + (size_t)qrow * DM + hq * 64 + 32 + 8 * g + 4 * hh) = ob;
    }
  }
}

#define XB_TMO      128
#define XB_XCNT(j)  (256  + 64 * (j))
#define XB_XSUB(j)  (1280 + 64 * (j))
#define XB_XGEN(j)  (2304 + 64 * (j))
#define XB_TOP      3328
#define XB_TOPGEN   3392
#define XCD_BAR_WORDS 3456
#define XB_SPIN_CAP (1u << 22)
#define LAS __attribute__((address_space(3)))

DEVINL unsigned xb_ld(unsigned* p) { return __hip_atomic_load(p, __ATOMIC_RELAXED, __HIP_MEMORY_SCOPE_AGENT); }
DEVINL unsigned xb_add(unsigned* p, unsigned v) { return __hip_atomic_fetch_add(p, v, __ATOMIC_RELAXED, __HIP_MEMORY_SCOPE_AGENT); }
DEVINL unsigned xb_xcc_id() { return (unsigned)__builtin_amdgcn_s_getreg((3 << 11) | 20) & 0xFu; }
#define XB_SPIN(cond, bar) do { unsigned _sp = 0; while (cond) { __builtin_amdgcn_s_sleep(1); \
    if ((++_sp & 255u) == 0u) { if (xb_ld(&(bar)[XB_TMO])) break; if (_sp > XB_SPIN_CAP) { atomicAdd(&(bar)[XB_TMO], 1u); break; } } } } while (0)

struct XcdBarrier { unsigned* bar; unsigned x; volatile LAS unsigned* st; };

DEVINL XcdBarrier xcd_barrier_post(unsigned* bar, volatile LAS unsigned* st) {
  XcdBarrier b; b.bar = bar; b.x = xb_xcc_id(); b.st = st;
  if (threadIdx.x == 0) (void)xb_add(&bar[XB_XCNT(b.x)], 1u);
  return b;
}
DEVINL void xcd_barrier_complete(unsigned* bar, unsigned x, unsigned& nloc, unsigned& nx) {
  const unsigned G = gridDim.x * gridDim.y * gridDim.z;
  unsigned sum, cnt, mine, sp = 0u;
  for (;;) {
    sum = 0u; cnt = 0u; mine = 0u;
#pragma unroll
    for (unsigned j = 0; j < 16; ++j) { const unsigned c = xb_ld(&bar[XB_XCNT(j)]); sum += c; cnt += (c > 0u) ? 1u : 0u; mine = (j == x) ? c : mine; }
    if (sum == G) break;
    __builtin_amdgcn_s_sleep(1);
    if ((++sp & 255u) == 0u) { if (xb_ld(&bar[XB_TMO])) break; if (sp > XB_SPIN_CAP) { atomicAdd(&bar[XB_TMO], 1u); break; } }
  }
  nloc = mine > 0u ? mine : 1u; nx = cnt > 0u ? cnt : 1u;
}
DEVINL void xcd_barrier(const XcdBarrier& b) {
  asm volatile("s_waitcnt vmcnt(0)" ::: "memory");
  __syncthreads();
  if (threadIdx.x == 0) {
    unsigned* bar = b.bar;
    __builtin_amdgcn_s_waitcnt(0);
    unsigned nloc = b.st[0], nx = b.st[1];
    if (nloc == 0u) { xcd_barrier_complete(bar, b.x, nloc, nx); b.st[0] = nloc; b.st[1] = nx; }
    const unsigned old = xb_add(&bar[XB_XSUB(b.x)], 1u);
    const unsigned gen = old / nloc;
    if (old + 1u == (gen + 1u) * nloc) {
      __builtin_amdgcn_fence(__ATOMIC_RELEASE, "agent");
      asm volatile("s_waitcnt vmcnt(0)" ::: "memory");
      const unsigned og = xb_add(&bar[XB_TOP], 1u);
      const unsigned tg = og / nx;
      if (og + 1u == (tg + 1u) * nx) xb_add(&bar[XB_TOPGEN], 1u);
      else XB_SPIN(xb_ld(&bar[XB_TOPGEN]) == tg, bar);
      __builtin_amdgcn_fence(__ATOMIC_ACQUIRE, "agent");
      xb_add(&bar[XB_XGEN(b.x)], 1u);
      asm volatile("s_waitcnt vmcnt(0)" ::: "memory");
    } else {
      XB_SPIN(xb_ld(&bar[XB_XGEN(b.x)]) == gen, bar);
      __builtin_amdgcn_fence(__ATOMIC_ACQUIRE, "agent");
      asm volatile("s_waitcnt vmcnt(0)" ::: "memory");
    }
  }
  __syncthreads();
}

extern __shared__ __attribute__((aligned(16))) char dyn_smem[];
__global__ void __launch_bounds__(NTHREADS, 2) mega_kernel(Params p) {
  char* smem = dyn_smem;
  cg::grid_group grid = cg::this_grid();
  const int w = blockIdx.x, nw = gridDim.x;
  const int gwid = __builtin_amdgcn_readfirstlane((int)(threadIdx.x >> 6));
  if (p.use_cg_sync) grid.sync();
  volatile LAS unsigned* xst = (volatile LAS unsigned*)(smem + SMEM_BYTES - 16);
  if (threadIdx.x == 0) { xst[0] = 0u; xst[1] = 0u; }
  __syncthreads();
  XcdBarrier xb = xcd_barrier_post(p.bar, xst);
#define GSYNC() xcd_barrier(xb)
#ifndef REP_PREP
#define REP_PREP 1
#endif
#ifndef REP_R4
#define REP_R4 1
#endif
#ifndef REP_P3
#define REP_P3 1
#endif
#ifndef REP_P4L3
#define REP_P4L3 1
#endif
#ifndef REP_A3
#define REP_A3 1
#endif
#ifndef REP_GEMM
#define REP_GEMM 1
#endif
#ifndef REP_SG
#define REP_SG 1
#endif
#ifndef REP_EW
#define REP_EW 1
#endif
  for (int rep = 0; rep < REP_PREP; ++rep) { phase_prep(p, w, nw, smem, gwid); GSYNC(); }
  for (int layer = 0; layer < 4; ++layer) {
    if ((layer & 1) == 0) {
      for (int rep = 0; rep < REP_EW; ++rep) { phase_r1(p, layer, w, nw, gwid); GSYNC(); }
      for (int rep = 0; rep < REP_GEMM; ++rep) { phase_r2(p, layer, w, nw, smem, gwid); GSYNC(); }
      for (int rep = 0; rep < REP_SG; ++rep) { phase_r3(p, layer, w, nw, smem, gwid); GSYNC(); }
      for (int rep = 0; rep < REP_R4; ++rep) { phase_r4(p, layer, w, nw, smem, gwid); GSYNC(); }
      for (int rep = 0; rep < REP_EW; ++rep) { phase_r5(p, layer, w, nw, gwid); GSYNC(); }
    } else {
      for (int rep = 0; rep < REP_EW; ++rep) { phase_a1(p, layer, w, nw, gwid); GSYNC(); }
      for (int rep = 0; rep < REP_GEMM; ++rep) { phase_a2(p, layer, w, nw, smem, gwid); GSYNC(); }
      for (int rep = 0; rep < REP_EW; ++rep) { phase_a2b(p, layer, w, nw, gwid); GSYNC(); }
      for (int rep = 0; rep < REP_A3; ++rep) { phase_a3(p, layer, w, nw, smem, gwid); GSYNC(); }
    }
    for (int rep = 0; rep < REP_GEMM; ++rep) { phase_wo(p, layer, w, nw, smem, gwid); GSYNC(); }
    for (int rep = 0; rep < REP_EW; ++rep) { phase_ln1(p, layer, w, nw, gwid); GSYNC(); }
    for (int rep = 0; rep < REP_GEMM; ++rep) { phase_p1(p, layer, w, nw, smem, gwid); GSYNC(); }
    for (int rep = 0; rep < REP_P3; ++rep) { phase_p23(p, layer, w, nw, smem, gwid); GSYNC(); }
    for (int rep = 0; rep < (layer == 3 ? REP_P4L3 : 1); ++rep) { phase_p4(p, layer, w, nw, smem, gwid); GSYNC(); }
  }
}

static inline char* carve(char*& cur, size_t bytes) {
  char* r = cur;
  cur += (bytes + 255) & ~(size_t)255;
  return r;
}

extern "C" void kernel_launch(void* const* d_in, const int* in_sizes, int n_in, void* d_out, int out_size, void* d_ws,
                              size_t ws_size, hipStream_t stream) {
  Params p;
  memset(&p, 0, sizeof(p));
  for (int i = 0; i < 35; ++i) p.in[i] = (const float*)d_in[i];
  p.out = (float*)d_out;
  char* cur = (char*)d_ws;
  p.bar = (unsigned*)carve(cur, 16384);
  p.mod = (float*)carve(cur, (size_t)4 * 9 * 6144 * 4);
  p.rope = (float*)carve(cur, 64 * 16 * 2 * 4);
  p.rwkv_in_t = (bf16_t*)carve(cur, (size_t)2 * RW_N * 1024 * 2);
  p.w2t = (bf16_t*)carve(cur, (size_t)4 * 65536 * 2);
  p.a2t = (bf16_t*)carve(cur, (size_t)4 * 65536 * 2);
  p.g2t = (bf16_t*)carve(cur, (size_t)2 * 131072 * 2);
  p.rwkv_wo_t = (bf16_t*)carve(cur, (size_t)2 * 1048576 * 2);
  p.attn_wqkv_t = (bf16_t*)carve(cur, (size_t)2 * 1536 * 1024 * 2);
  p.attn_wo_t = (bf16_t*)carve(cur, (size_t)2 * 1048576 * 2);
  p.wq_t = (bf16_t*)carve(cur, (size_t)4 * 2048 * 1024 * 2);
  p.keysb = (bf16_t*)carve(cur, (size_t)4 * 2 * 128 * 128 * 2);
  p.ub = (bf16_t*)carve(cur, (size_t)4 * 16384 * 1024 * 2);
  p.vb = (bf16_t*)carve(cur, (size_t)4 * 16384 * 1024 * 2);
  p.uinv = (float*)carve(cur, (size_t)65536 * 4);
  p.vinv = (float*)carve(cur, (size_t)65536 * 4);
  p.Klat = (bf16_t*)carve(cur, (size_t)2 * 8 * 4 * 1536 * 64 * 2);
  p.VlatT = (bf16_t*)carve(cur, (size_t)2 * 8 * 4 * 1536 * 64 * 2);
  p.Kctx = (bf16_t*)carve(cur, (size_t)2 * 16 * 4 * 256 * 64 * 2);
  p.VctxT = (bf16_t*)carve(cur, (size_t)2 * 16 * 4 * 256 * 64 * 2);
  p.xbuf = (float*)carve(cur, (size_t)TT * DM * 4);
  p.zbuf = (float*)carve(cur, (size_t)TT * DM * 4);
  p.hbuf = (bf16_t*)carve(cur, (size_t)TT * DM * 2);
  p.abuf = (bf16_t*)carve(cur, (size_t)TT * DM * 2);
  p.U1 = carve(cur, (size_t)TT * DM * 14);
  p.U2 = carve(cur, (size_t)TT * DM * 8);
  p.U3 = carve(cur, (size_t)TT * DM * 8);
  p.pidx = (int*)carve(cur, (size_t)TT * 128 * 4);
  p.pgate = (float*)carve(cur, (size_t)TT * 128 * 4);
  for (int f = 0; f < 16; ++f) p.freqs[f] = pow(10000.0, -(double)f / 16.0);
  if ((size_t)(cur - (char*)d_ws) > ws_size) {
    fprintf(stderr, "workspace too small: need %zu have %zu\n", (size_t)(cur - (char*)d_ws), ws_size);
    return;
  }
  static int grid_blocks = 0;
  if (!grid_blocks) {
    int dev = 0, cus = 0, per_cu = 0;
    (void)hipGetDevice(&dev);
    (void)hipDeviceGetAttribute(&cus, hipDeviceAttributeMultiprocessorCount, dev);
    (void)hipFuncSetAttribute((const void*)mega_kernel, hipFuncAttributeMaxDynamicSharedMemorySize, SMEM_BYTES);
    (void)hipOccupancyMaxActiveBlocksPerMultiprocessor(&per_cu, mega_kernel, NTHREADS, SMEM_BYTES);
    if (per_cu > 1) per_cu = 1;
    if (per_cu < 1) per_cu = 1;
    grid_blocks = cus * per_cu;
  }
  (void)hipMemsetAsync(p.bar, 0, 16384, stream);
  void* args[] = {&p};
  hipError_t e = hipLaunchCooperativeKernel((void*)mega_kernel, dim3(grid_blocks), dim3(NTHREADS), args, SMEM_BYTES, stream);
  if (e != hipSuccess) fprintf(stderr, "cooperative launch failed: %s (grid %d)\n", hipGetErrorString(e), grid_blocks);
}
```

```cpp
#include <hip/hip_runtime.h>
#include <hip/hip_cooperative_groups.h>
#include <stdint.h>
#include <string.h>
#include <math.h>
#include <stdio.h>

namespace cg = cooperative_groups;

typedef unsigned short bf16_t;
typedef __attribute__((ext_vector_type(8))) short bf16x8;
typedef __attribute__((ext_vector_type(4))) float f32x4;
typedef __attribute__((ext_vector_type(16))) float f32x16;

#define DEVINL __device__ __forceinline__
#define NTHREADS 512
#define NWAVES 8
#define GEMM_LDS 131072
#define SMEM_BYTES 163840
#define RW_N 3840

#define DM 1024
#define TCTX 4096
#define TLAT 8192
#define TT 12288
#define ALPHA_F 1.681792830507429f
#define LN_EPS_F 1e-5f
#define GN_EPS_F 6.4e-4f
#define RMS_EPS_F 1e-6f
#define QSCALE_F (0.125f * 1.4426950408889634f)

#define OUT_Y 0
#define OUT_STATE 12582912
#define OUT_CK 16777216
#define OUT_CV 18874368

struct Params {
  const float* in[35];
  float* out;
  float* mod;
  float* rope;
  bf16_t* rwkv_in_t;
  bf16_t* w2t;
  bf16_t* a2t;
  bf16_t* g2t;
  bf16_t* rwkv_wo_t;
  bf16_t* attn_wqkv_t;
  bf16_t* attn_wo_t;
  bf16_t* wq_t;
  bf16_t* keysb;
  bf16_t* ub;
  bf16_t* vb;
  float* uinv;
  float* vinv;
  bf16_t* Klat;
  bf16_t* VlatT;
  bf16_t* Kctx;
  bf16_t* VctxT;
  float* xbuf;
  float* zbuf;
  bf16_t* hbuf;
  bf16_t* abuf;
  char* U1;
  char* U2;
  char* U3;
  int* pidx;
  float* pgate;
  double freqs[16];
  unsigned* bar;
  int use_cg_sync;
  int pad0;
};

DEVINL int lane_id() { return (int)__builtin_amdgcn_mbcnt_hi(~0u, __builtin_amdgcn_mbcnt_lo(~0u, 0u)); }
DEVINL int tidx(int gwid) {
  int t = gwid * 64 + lane_id(); asm volatile("" : "+v"(t)); return t;
}
typedef __bf16 bf16v2_ __attribute__((ext_vector_type(2)));
typedef float f32v2_ __attribute__((ext_vector_type(2)));
DEVINL unsigned cvt_pk_bf16_(float lo, float hi) { f32v2_ v = {lo, hi}; bf16v2_ r = __builtin_convertvector(v, bf16v2_); return __builtin_bit_cast(unsigned, r); }
DEVINL bf16_t f2bf(float f) { return (bf16_t)(cvt_pk_bf16_(f, f) & 0xFFFFu); }
DEVINL float bf2f(bf16_t h) { return __uint_as_float(((unsigned)h) << 16); }
DEVINL unsigned pack2(float a, float b) { return cvt_pk_bf16_(a, b); }
DEVINL float bflo(unsigned u) { return __uint_as_float(u << 16); }
DEVINL float bfhi(unsigned u) { return __uint_as_float(u & 0xFFFF0000u); }

DEVINL unsigned umax_(unsigned a, unsigned b) { return a > b ? a : b; }
DEVINL unsigned umin_(unsigned a, unsigned b) { return a < b ? a : b; }
#define DPP_QP_1032 0xB1
#define DPP_QP_2301 0x4E
#define DPP_ROW_HALF_MIRROR 0x141
#define DPP_ROW_MIRROR 0x140
DEVINL unsigned row_max_u(unsigned v) {
  v = umax_(v, (unsigned)__builtin_amdgcn_update_dpp(0, (int)v, DPP_QP_1032, 0xf, 0xf, true));
  v = umax_(v, (unsigned)__builtin_amdgcn_update_dpp(0, (int)v, DPP_QP_2301, 0xf, 0xf, true));
  v = umax_(v, (unsigned)__builtin_amdgcn_update_dpp(0, (int)v, DPP_ROW_HALF_MIRROR, 0xf, 0xf, true));
  v = umax_(v, (unsigned)__builtin_amdgcn_update_dpp(0, (int)v, DPP_ROW_MIRROR, 0xf, 0xf, true));
  return v;
}
DEVINL float row_max_f(float v) {
  v = fmaxf(v, __int_as_float(__builtin_amdgcn_update_dpp(0, __float_as_int(v), DPP_QP_1032, 0xf, 0xf, true)));
  v = fmaxf(v, __int_as_float(__builtin_amdgcn_update_dpp(0, __float_as_int(v), DPP_QP_2301, 0xf, 0xf, true)));
  v = fmaxf(v, __int_as_float(__builtin_amdgcn_update_dpp(0, __float_as_int(v), DPP_ROW_HALF_MIRROR, 0xf, 0xf, true)));
  v = fmaxf(v, __int_as_float(__builtin_amdgcn_update_dpp(0, __float_as_int(v), DPP_ROW_MIRROR, 0xf, 0xf, true)));
  return v;
}
DEVINL float row_sum_f(float v) {
  v += __int_as_float(__builtin_amdgcn_update_dpp(0, __float_as_int(v), DPP_QP_1032, 0xf, 0xf, true));
  v += __int_as_float(__builtin_amdgcn_update_dpp(0, __float_as_int(v), DPP_QP_2301, 0xf, 0xf, true));
  v += __int_as_float(__builtin_amdgcn_update_dpp(0, __float_as_int(v), DPP_ROW_HALF_MIRROR, 0xf, 0xf, true));
  v += __int_as_float(__builtin_amdgcn_update_dpp(0, __float_as_int(v), DPP_ROW_MIRROR, 0xf, 0xf, true));
  return v;
}
DEVINL float rdl(float v, int l) { return __int_as_float(__builtin_amdgcn_readlane(__float_as_int(v), l)); }
DEVINL float wave_sum(float v) { const float r = row_sum_f(v); return (rdl(r, 0) + rdl(r, 16)) + (rdl(r, 32) + rdl(r, 48)); }
DEVINL float wave_max(float v) { const float r = row_max_f(v); return fmaxf(fmaxf(rdl(r, 0), rdl(r, 16)), fmaxf(rdl(r, 32), rdl(r, 48))); }
DEVINL float grp16_sum(float v) {
#pragma unroll
  for (int o = 8; o > 0; o >>= 1) v += __shfl_xor(v, o);
  return v;
}
DEVINL unsigned wave_max_u(unsigned v) {
#pragma unroll
  for (int o = 32; o > 0; o >>= 1) { unsigned t = (unsigned)__shfl_xor((int)v, o); v = v > t ? v : t; }
  return v;
}
DEVINL float sigmoidf_(float x) { return 1.0f / (1.0f + __expf(-x)); }
DEVINL float tanhf_(float x) { float e = __expf(-2.0f * fabsf(x)); float t = (1.0f - e) / (1.0f + e); return x < 0 ? -t : t; }
DEVINL unsigned ordf(float f) { unsigned u = __float_as_uint(f); return (u & 0x80000000u) ? ~u : (u | 0x80000000u); }

DEVINL int cond_of_row(int row) { return row < TCTX ? 8 : ((row - TCTX) >> 10); }


namespace pg8 {
#define PG8_LAS __attribute__((address_space(3)))
typedef unsigned u32x4 __attribute__((ext_vector_type(4)));
constexpr int BM = 256, BK = 64, HALF = 128, HTB = HALF * BK * 2, STAGE_BYTES = 8 * HTB, NXCD = 8, WGM = 8;
DEVINL int lds_byte(int r, int c) { const int st = (r >> 4) * 2 + (c >> 5), rr = r & 15, cc = c & 31, ob = rr * 64 + cc * 2; return st * 1024 + (ob ^ (((ob >> 9) & 1) << 5)); }
DEVINL void stage_rc(int b, int& R, int& C) { const int st = b / 1024, sb = b % 1024, swz = sb ^ (((sb >> 9) & 1) << 5); R = (st >> 1) * 16 + swz / 64; C = (st & 1) * 32 + (swz % 64) / 2; }
DEVINL int perm32(int rho) { const int n = rho >> 4, i = rho & 15; return 8 * (i >> 2) + 4 * n + (i & 3); }
struct Unit { int pm, pn; };
struct StaticOrder {
  int nM, nN, nwg, G, c;
  DEVINL void init(int M, int N, int G_, int c_) { nM = M / BM; nN = N / BM; nwg = nM * nN; G = G_; c = c_; }
  DEVINL bool next(int i, Unit& u) const {
    const long L = (long)i * G + c; if (L >= nwg) return false;
    int wgid = (int)L; { const int q = nwg / NXCD, r = nwg % NXCD, xcd = wgid % NXCD, off = wgid / NXCD; wgid = (xcd < r ? xcd * (q + 1) : r * (q + 1) + (xcd - r) * q) + off; }
    const int nig = WGM * nN, gid = wgid / nig, fm = gid * WGM, gsz = (nM - fm) < WGM ? (nM - fm) : WGM;
    u.pm = fm + ((wgid % nig) % gsz); u.pn = (wgid % nig) / gsz; return true;
  }
};
DEVINL unsigned cvt_pk_bf16(float lo, float hi) { return cvt_pk_bf16_(lo, hi); }

template <class Epi, class ASel>
DEVINL void gemm_phase(PG8_LAS unsigned char* lds, const ASel& asel, const bf16_t* Bt, const int K, const StaticOrder& S, const Epi& E, int gwid) {
  const int tid = tidx(gwid), wid = __builtin_amdgcn_readfirstlane(tid >> 6), lane = tid & 63, wr = wid >> 2, wc = wid & 3, fr = lane & 15, fq = lane >> 4;
  const int nt = K / BK;
  unsigned voffA[2], voffB[2];
#pragma unroll
  for (int i = 0; i < 2; ++i) { int R, C; stage_rc(tid * 16 + i * 8192, R, C); const int Rb = Epi::PERM ? ((R & ~31) + perm32(R & 31)) : R;
    voffA[i] = (unsigned)(R * K + C) * 2u; voffB[i] = (unsigned)(Rb * K + C) * 2u; }
  const size_t kstep = (size_t)(BK * 2);
  const size_t hstep = (size_t)HALF * K * 2;
  const size_t tstep = 2 * hstep;
  const unsigned ldsw = (unsigned)wid * 1024u;
  const int aoff = lds_byte(wr * 64 + fr, fq * 8), boff = lds_byte(wc * 32 + fr, fq * 8);
#define PG8_SA(b, h) (((b) * 2 + (h)) * HTB)
#define PG8_SB(b, h) ((4 + (b) * 2 + (h)) * HTB)
#define PG8_STAGE(bufoff, gbase, voff) do { _Pragma("unroll") for (int _i = 0; _i < 2; ++_i) \
    __builtin_amdgcn_global_load_lds((const unsigned*)((const char*)(gbase) + (voff)[_i]), (PG8_LAS unsigned*)(lds + (bufoff) + ldsw + _i * 8192), 16, 0, 0); } while (0)
#define PG8_LDA(dst, b, h) do { _Pragma("unroll") for (int m = 0; m < 4; ++m) _Pragma("unroll") for (int k = 0; k < 2; ++k) dst[m][k] = *(const PG8_LAS bf16x8*)(lds + PG8_SA(b, h) + aoff + m * 2048 + k * 1024); } while (0)
#define PG8_LDB(dst, b, h) do { _Pragma("unroll") for (int n = 0; n < 2; ++n) _Pragma("unroll") for (int k = 0; k < 2; ++k) dst[n][k] = *(const PG8_LAS bf16x8*)(lds + PG8_SB(b, h) + boff + n * 2048 + k * 1024); } while (0)
#define PG8_MMA(ai, bj, At, Bt_) do { __builtin_amdgcn_s_setprio(1); _Pragma("unroll") for (int m = 0; m < 4; ++m) _Pragma("unroll") for (int n = 0; n < 2; ++n) _Pragma("unroll") for (int k = 0; k < 2; ++k) \
    acc[ai][bj][m][n] = __builtin_amdgcn_mfma_f32_16x16x32_bf16(Bt_[n][k], At[m][k], acc[ai][bj][m][n], 0, 0, 0); __builtin_amdgcn_s_setprio(0); } while (0)
#define PG8_WAIT_V(n) asm volatile("s_waitcnt vmcnt(" #n ")" ::: "memory")
#define PG8_WAIT_L(n) asm volatile("s_waitcnt lgkmcnt(" #n ")" ::: "memory")
#define PG8_BAR __builtin_amdgcn_s_barrier()
#define PG8_SCHED __builtin_amdgcn_sched_barrier(0)
  Unit cur, nxt; int ui = 0;
  if (!S.next(0, cur)) return;
  f32x4 acc[2][2][4][2];
#pragma unroll
  for (int a = 0; a < 2; ++a)
#pragma unroll
    for (int b = 0; b < 2; ++b)
#pragma unroll
      for (int m = 0; m < 4; ++m)
#pragma unroll
        for (int n = 0; n < 2; ++n) acc[a][b][m][n] = (f32x4){0.f, 0.f, 0.f, 0.f};
  bf16x8 At[4][2], B0[2][2], B1[2][2];
  const char* cA = asel(cur.pn) + (size_t)cur.pm * tstep; const char* cB = (const char*)Bt + (size_t)cur.pn * tstep;
  PG8_STAGE(PG8_SB(0, 0), cB, voffB); PG8_STAGE(PG8_SA(0, 0), cA, voffA); PG8_STAGE(PG8_SB(0, 1), cB + hstep, voffB); PG8_STAGE(PG8_SA(0, 1), cA + hstep, voffA);
  if (wr == 1) PG8_BAR;
  PG8_WAIT_V(4); PG8_BAR;
  PG8_STAGE(PG8_SB(1, 0), cB + kstep, voffB); PG8_STAGE(PG8_SA(1, 0), cA + kstep, voffA); PG8_STAGE(PG8_SB(1, 1), cB + hstep + kstep, voffB);
  PG8_WAIT_V(6); PG8_BAR;
  for (;;) {
    const bool has_next = S.next(ui + 1, nxt);
    const char* nA = has_next ? asel(nxt.pn) + (size_t)nxt.pm * tstep : cA; const char* nB = has_next ? (const char*)Bt + (size_t)nxt.pn * tstep : cB;
    for (int t = 0; t < nt; t += 2) {
      const bool last = (t == nt - 2);
      const char* a1 = cA + (size_t)(t + 1) * kstep;
      const char* a2 = last ? nA : cA + (size_t)(t + 2) * kstep; const char* b2 = last ? nB : cB + (size_t)(t + 2) * kstep;
      const char* a3 = a2 + kstep; const char* b3 = b2 + kstep;
      PG8_LDB(B0, 0, 0); PG8_SCHED; PG8_LDA(At, 0, 0); PG8_STAGE(PG8_SA(1, 1), a1 + hstep, voffA);
      PG8_WAIT_L(8); PG8_BAR; PG8_WAIT_L(0); PG8_MMA(0, 0, At, B0); PG8_BAR; PG8_SCHED;
      PG8_LDB(B1, 0, 1); PG8_STAGE(PG8_SB(0, 0), b2, voffB);
      PG8_BAR; PG8_WAIT_L(0); PG8_MMA(0, 1, At, B1); PG8_BAR;
      PG8_LDA(At, 0, 1); PG8_STAGE(PG8_SA(0, 0), a2, voffA);
      PG8_BAR; PG8_WAIT_L(0); PG8_MMA(1, 0, At, B0); PG8_BAR; PG8_SCHED;
      PG8_STAGE(PG8_SB(0, 1), b2 + hstep, voffB);
      PG8_WAIT_V(6); PG8_BAR; PG8_MMA(1, 1, At, B1); PG8_BAR;
      PG8_LDB(B0, 1, 0); PG8_SCHED; PG8_LDA(At, 1, 0); PG8_STAGE(PG8_SA(0, 1), a2 + hstep, voffA);
      PG8_WAIT_L(8); PG8_BAR; PG8_WAIT_L(0); PG8_MMA(0, 0, At, B0); PG8_BAR; PG8_SCHED;
      PG8_LDB(B1, 1, 1); PG8_STAGE(PG8_SB(1, 0), b3, voffB);
      PG8_BAR; PG8_WAIT_L(0); PG8_MMA(0, 1, At, B1); PG8_BAR;
      PG8_LDA(At, 1, 1); PG8_STAGE(PG8_SA(1, 0), a3, voffA);
      PG8_BAR; PG8_WAIT_L(0); PG8_MMA(1, 0, At, B0); PG8_BAR; PG8_SCHED;
      PG8_STAGE(PG8_SB(1, 1), b3 + hstep, voffB);
      PG8_WAIT_V(6); PG8_BAR; PG8_MMA(1, 1, At, B1); PG8_BAR;
    }
    E(acc, cur, wr, wc, fr, fq);
    if (!has_next) break;
#pragma unroll
    for (int a = 0; a < 2; ++a)
#pragma unroll
      for (int b = 0; b < 2; ++b)
#pragma unroll
        for (int m = 0; m < 4; ++m)
#pragma unroll
          for (int n = 0; n < 2; ++n) acc[a][b][m][n] = (f32x4){0.f, 0.f, 0.f, 0.f};
    cur = nxt; cA = nA; cB = nB; ++ui;
  }
  PG8_WAIT_V(0);
  if (wr == 0) PG8_BAR;
  PG8_BAR;
#undef PG8_SA
#undef PG8_SB
#undef PG8_STAGE
#undef PG8_LDA
#undef PG8_LDB
#undef PG8_MMA
#undef PG8_WAIT_V
#undef PG8_WAIT_L
#undef PG8_BAR
#undef PG8_SCHED
}
struct ASelOne { const char* A; DEVINL const char* operator()(int) const { return A; } };
}

DEVINL void gemm_tile_128(const bf16_t* __restrict__ A, int lda, const bf16_t* __restrict__ Bt, int ldb, int K,
                          char* smem_half, f32x4 (&acc)[4][4], int gwid) {
  const int tid = tidx(gwid) & 255, wid = tid >> 6, lane = tid & 63;
  const int wr = wid >> 1, wc = wid & 1, fr = lane & 15, fq = lane >> 4;
  char* SA = smem_half;
  char* SB = smem_half + 8192;
#pragma unroll
  for (int m = 0; m < 4; ++m)
#pragma unroll
    for (int n = 0; n < 4; ++n) acc[m][n] = (f32x4){0.f, 0.f, 0.f, 0.f};
  for (int k0 = 0; k0 < K; k0 += 32) {
#pragma unroll
    for (int i = 0; i < 2; ++i) {
      int b = tid * 16 + i * 4096;
      int r = b >> 6, c = (b & 63) >> 1;
      __builtin_amdgcn_global_load_lds((const unsigned*)(A + (size_t)r * lda + k0 + c), (unsigned*)(SA + b), 16, 0, 0);
      __builtin_amdgcn_global_load_lds((const unsigned*)(Bt + (size_t)r * ldb + k0 + c), (unsigned*)(SB + b), 16, 0, 0);
    }
    asm volatile("s_waitcnt vmcnt(0)" ::: "memory");
    __syncthreads();
    bf16x8 a[4], b[4];
#pragma unroll
    for (int m = 0; m < 4; ++m) a[m] = *reinterpret_cast<const bf16x8*>(SA + (wr * 64 + m * 16 + fr) * 64 + fq * 16);
#pragma unroll
    for (int n = 0; n < 4; ++n) b[n] = *reinterpret_cast<const bf16x8*>(SB + (wc * 64 + n * 16 + fr) * 64 + fq * 16);
#pragma unroll
    for (int m = 0; m < 4; ++m)
#pragma unroll
      for (int n = 0; n < 4; ++n) acc[m][n] = __builtin_amdgcn_mfma_f32_16x16x32_bf16(a[m], b[n], acc[m][n], 0, 0, 0);
    __syncthreads();
  }
}

#define GEMM_LANE_VARS \
  const int tid = tidx(gwid) & 255, wid = tid >> 6, lane = tid & 63; \
  const int wr = wid >> 1, wc = wid & 1, fr = lane & 15, fq = lane >> 4; \
  (void)tid; (void)wid; (void)lane; (void)wr; (void)wc; (void)fr; (void)fq;

DEVINL void get_tjob(const Params& p, int ji, const float*& src, bf16_t*& dst, int& K, int& N) {
  if (ji < 28) {
    int j = ji / 14, s = ji % 14;
    bf16_t* rw = p.rwkv_in_t + (size_t)j * RW_N * 1024;
    if (s < 3) { src = p.in[12] + ((size_t)(j * 3 + s) << 20); dst = rw + ((size_t)s << 20); K = 1024; N = 1024; }
    else if (s < 5) { int z = s - 3; src = p.in[15] + (size_t)(j * 2 + z) * 65536; dst = rw + (size_t)(3072 + z * 64) * 1024; K = 1024; N = 64; }
    else if (s < 7) { int z = s - 5; src = p.in[18] + (size_t)(j * 2 + z) * 65536; dst = rw + (size_t)(3328 + z * 64) * 1024; K = 1024; N = 64; }
    else if (s == 7) { src = p.in[20] + (size_t)j * 131072; dst = rw + (size_t)3584 * 1024; K = 1024; N = 128; }
    else if (s < 10) { int z = s - 8; src = p.in[16] + (size_t)(j * 2 + z) * 65536; dst = p.w2t + (size_t)(j * 2 + z) * 65536; K = 64; N = 1024; }
    else if (s < 12) { int z = s - 10; src = p.in[19] + (size_t)(j * 2 + z) * 65536; dst = p.a2t + (size_t)(j * 2 + z) * 65536; K = 64; N = 1024; }
    else if (s == 12) { src = p.in[21] + (size_t)j * 131072; dst = p.g2t + (size_t)j * 131072; K = 128; N = 1024; }
    else { src = p.in[13] + ((size_t)j << 20); dst = p.rwkv_wo_t + ((size_t)j << 20); K = 1024; N = 1024; }
  } else if (ji < 32) {
    int j = (ji - 28) >> 1, s = (ji - 28) & 1;
    if (s == 0) { src = p.in[27] + (size_t)j * 1024 * 1536; dst = p.attn_wqkv_t + (size_t)j * 1536 * 1024; K = 1024; N = 1536; }
    else { src = p.in[28] + ((size_t)j << 20); dst = p.attn_wo_t + ((size_t)j << 20); K = 1024; N = 1024; }
  } else {
    int i = ji - 32;
    src = p.in[31] + (size_t)i * 1024 * 2048; dst = p.wq_t + (size_t)i * 2048 * 1024; K = 1024; N = 2048;
  }
}

DEVINL void sincos_d(double x, float& c, float& s) {
  const double TWO_PI = 6.283185307179586476925;
  double r = x - TWO_PI * rint(x / TWO_PI);
  double r2 = r * r;
  double ts = r, tc = 1.0, ss = r, cs = 1.0;
#pragma unroll 1
  for (int n = 1; n <= 14; ++n) {
    tc = -tc * r2 / (double)((2 * n - 1) * (2 * n));
    ts = -ts * r2 / (double)((2 * n) * (2 * n + 1));
    cs += tc; ss += ts;
  }
  c = (float)cs; s = (float)ss;
}

DEVINL void phase_prep(const Params& p, int w, int nw, char* smem, int gwid) {
  const int tid = tidx(gwid);
  {
    float (*tile)[65] = reinterpret_cast<float (*)[65]>(smem);
    int toff = 0;
    for (int ji = 0; ji < 36; ++ji) {
      const float* src; bf16_t* dst; int K, N;
      get_tjob(p, ji, src, dst, K, N);
      const int tn = N >> 6, nt = (K >> 6) * tn;
      int t0 = (w - (toff % nw) + nw) % nw;
      for (int t = t0; t < nt; t += nw) {
        const int k0 = (t / tn) << 6, n0 = (t % tn) << 6;
#pragma unroll
        for (int i = 0; i < 2; ++i) {
          int r = (tid >> 4) + 32 * i, c = (tid & 15) * 4;
          float4 v = *reinterpret_cast<const float4*>(src + (size_t)(k0 + r) * N + n0 + c);
          tile[r][c] = v.x; tile[r][c + 1] = v.y; tile[r][c + 2] = v.z; tile[r][c + 3] = v.w;
        }
        __syncthreads();
        {
          int q = tid;
          int n = q >> 3, kc = (q & 7) * 8;
          uint4 o;
          o.x = pack2(tile[kc + 0][n], tile[kc + 1][n]);
          o.y = pack2(tile[kc + 2][n], tile[kc + 3][n]);
          o.z = pack2(tile[kc + 4][n], tile[kc + 5][n]);
          o.w = pack2(tile[kc + 6][n], tile[kc + 7][n]);
          *reinterpret_cast<uint4*>(dst + (size_t)(n0 + n) * K + k0 + kc) = o;
        }
        __syncthreads();
      }
      toff += nt;
    }
  }
  const size_t gtid = (size_t)w * NTHREADS + tid, gn = (size_t)nw * NTHREADS;
  {
    const int lane = tid & 63;
    const int gw2 = w * NWAVES + (tid >> 6), ngw2 = nw * NWAVES;
    unsigned char* u4 = reinterpret_cast<unsigned char*>(p.ub);
    unsigned char* v4 = reinterpret_cast<unsigned char*>(p.vb);
    unsigned char* usc = u4 + (size_t)65536 * 512;
    unsigned char* vsc = v4 + (size_t)65536 * 512;
    for (int r = gw2; r < 2 * 65536; r += ngw2) {
      const bool isv = r >= 65536;
      const int row = isv ? r - 65536 : r;
      const float* srow = (isv ? p.in[34] : p.in[33]) + (size_t)row * 1024 + lane * 16;
      float x[16];
#pragma unroll
      for (int q = 0; q < 4; ++q) { const float4 v = reinterpret_cast<const float4*>(srow)[q]; x[q * 4] = v.x; x[q * 4 + 1] = v.y; x[q * 4 + 2] = v.z; x[q * 4 + 3] = v.w; }
      float mx = 0.f;
#pragma unroll
      for (int q = 0; q < 16; ++q) mx = fmaxf(mx, fabsf(x[q]));
      mx = fmaxf(mx, __shfl_xor(mx, 1));
      const unsigned yb = __float_as_uint(mx * (1.0f / 6.0f));
      unsigned eb = ((yb >> 23) & 0xFFu) + ((yb & 0x7FFFFFu) ? 1u : 0u);
      eb = eb < 1u ? 1u : (eb > 254u ? 254u : eb);
      if (mx == 0.f) eb = 127u;
      const float inv = __uint_as_float((254u - eb) << 23);
      unsigned w0 = 0, w1 = 0;
#define Q4(q) w0 = __builtin_amdgcn_cvt_scalef32_pk_fp4_f32(w0, x[2 * q] * inv, x[2 * q + 1] * inv, 1.0f, q); \
               w1 = __builtin_amdgcn_cvt_scalef32_pk_fp4_f32(w1, x[8 + 2 * q] * inv, x[8 + 2 * q + 1] * inv, 1.0f, q);
      Q4(0) Q4(1) Q4(2) Q4(3)
#undef Q4
      uint2 o2; o2.x = w0; o2.y = w1;
      *reinterpret_cast<uint2*>((isv ? v4 : u4) + (size_t)row * 512 + lane * 8) = o2;
      if ((lane & 1) == 0) {
        const int b = lane >> 1;
        if (isv) vsc[(size_t)row * 32 + b] = (unsigned char)eb;
        else usc[(size_t)row * 32 + (b & 3) * 8 + (b >> 2)] = (unsigned char)eb;
      }
    }
    const size_t gtid0 = (size_t)w * NTHREADS + tid, gn0 = (size_t)nw * NTHREADS;
    const size_t nk8 = (size_t)4 * 2 * 128 * 128 / 8;
    for (size_t i = gtid0; i < nk8; i += gn0) {
      const float4* su = reinterpret_cast<const float4*>(p.in[32]) + i * 2;
      float4 a = su[0], b = su[1];
      uint4 o; o.x = pack2(a.x, a.y); o.y = pack2(a.z, a.w); o.z = pack2(b.x, b.y); o.w = pack2(b.z, b.w);
      reinterpret_cast<uint4*>(p.keysb)[i] = o;
    }
  }
  {
    const size_t nk = (size_t)8 * 2 * 512 * 4 * 64;
    for (size_t i = gtid; i < nk; i += gn) {
      int d = i & 63, kvh = (i >> 6) & 3, s = (i >> 8) & 511, j = (i >> 17) & 1, b = (int)(i >> 18);
      p.Klat[((size_t)((j * 8 + b) * 4 + kvh) * 1536 + s) * 64 + d] = f2bf(p.in[4][i]);
      p.VlatT[((size_t)((j * 8 + b) * 4 + kvh) * 64 + d) * 1536 + s] = f2bf(p.in[5][i]);
    }
  }
  for (size_t i = gtid; i < 1024; i += gn) {
    int pos = (int)(i >> 4), f = (int)(i & 15);
    float c, s; sincos_d((double)pos * p.freqs[f], c, s);
    p.rope[i * 2] = c; p.rope[i * 2 + 1] = s;
  }
  {
    const size_t n4 = (size_t)TT * DM / 4, nc4 = (size_t)TCTX * DM / 4;
    for (size_t i = gtid; i < n4; i += gn) {
      float4 v = (i < nc4) ? reinterpret_cast<const float4*>(p.in[0])[i] : reinterpret_cast<const float4*>(p.in[1])[i - nc4];
      reinterpret_cast<float4*>(p.xbuf)[i] = v;
    }
  }
  {
    float* sc = reinterpret_cast<float*>(smem);
    float* red = sc + 9 * 1024;
    bool loaded = false;
    for (int item = w; item < 384; item += nw) {
      if (!loaded) {
        __syncthreads();
        for (int e = tid; e < 9 * 1024; e += NTHREADS) {
          int c = e >> 10, d = e & 1023;
          float v = (c < 8) ? p.in[2][c * 1024 + d] : p.in[6][d];
          sc[e] = v / (1.0f + __expf(-v));
        }
        __syncthreads();
        loaded = true;
      }
      const int i = item / 96, cc = item % 96;
      const int col = cc * 64 + (tid & 63), ks = tid >> 6;
      float acc[9];
#pragma unroll
      for (int c = 0; c < 9; ++c) acc[c] = 0.f;
      const float* wp = p.in[7] + (size_t)i * 1024 * 6144 + col;
      for (int d0 = ks * 128; d0 < ks * 128 + 128; d0 += 16) {
        float wv[16];
#pragma unroll
        for (int u = 0; u < 16; ++u) wv[u] = wp[(size_t)(d0 + u) * 6144];
#pragma unroll
        for (int u = 0; u < 16; ++u)
#pragma unroll
          for (int c = 0; c < 9; ++c) acc[c] += sc[c * 1024 + d0 + u] * wv[u];
      }
#pragma unroll
      for (int c = 0; c < 9; ++c) red[(ks * 9 + c) * 64 + (tid & 63)] = acc[c];
      __syncthreads();
      for (int o = tid; o < 576; o += NTHREADS) {
        int c = o >> 6, cl = o & 63;
        float s = 0.f;
#pragma unroll
        for (int k2 = 0; k2 < 8; ++k2) s += red[(k2 * 9 + c) * 64 + cl];
        int n = cc * 64 + cl;
        p.mod[((size_t)i * 9 + c) * 6144 + n] = s + p.in[8][i * 6144 + n];
      }
      __syncthreads();
    }
  }
}

DEVINL void phase_r1(const Params& p, int layer, int w, int nw, int gwid) {
  const int j = layer >> 1;
  const int lane = tidx(gwid) & 63;
  const int gw = w * NWAVES + (tidx(gwid) >> 6), ngw = nw * NWAVES;
  bf16_t* A6 = reinterpret_cast<bf16_t*>(p.U1);
  const float* mu = p.in[11] + (size_t)j * 6 * 1024;
  for (int row = gw; row < TT; row += ngw) {
    int t, Tlen;
    if (row < TCTX) { t = row & 255; Tlen = 256; } else { t = (row - TCTX) & 1023; Tlen = 1024; }
    const int cond = cond_of_row(row);
    const float* sh = p.mod + ((size_t)layer * 9 + cond) * 6144;
    const float* sc = sh + 1024;
    const bool hasp = t > 0, hasn = t < Tlen - 1;
#pragma unroll
    for (int k = 0; k < 4; ++k) {
      const int col = k * 256 + lane * 4;
      const float4 xc = *reinterpret_cast<const float4*>(p.xbuf + (size_t)row * DM + col);
      float4 xp = make_float4(0, 0, 0, 0), xn = make_float4(0, 0, 0, 0);
      if (hasp) xp = *reinterpret_cast<const float4*>(p.xbuf + (size_t)(row - 1) * DM + col);
      if (hasn) xn = *reinterpret_cast<const float4*>(p.xbuf + (size_t)(row + 1) * DM + col);
      const float4 s4 = *reinterpret_cast<const float4*>(sh + col);
      const float4 c4 = *reinterpret_cast<const float4*>(sc + col);
      float h[4], xx[4];
      const float xcv[4] = {xc.x, xc.y, xc.z, xc.w}, xpv[4] = {xp.x, xp.y, xp.z, xp.w}, xnv[4] = {xn.x, xn.y, xn.z, xn.w};
      const float shv[4] = {s4.x, s4.y, s4.z, s4.w}, scv[4] = {c4.x, c4.y, c4.z, c4.w};
#pragma unroll
      for (int e = 0; e < 4; ++e) {
        float g = 1.0f + scv[e];
        h[e] = xcv[e] * g + shv[e];
        float hp = hasp ? (xpv[e] * g + shv[e]) : 0.f;
        float hn = hasn ? (xnv[e] * g + shv[e]) : 0.f;
        xx[e] = 0.5f * (hp + hn) - h[e];
      }
#pragma unroll
      for (int m = 0; m < 6; ++m) {
        const float4 m4 = *reinterpret_cast<const float4*>(mu + m * 1024 + col);
        uint2 o;
        o.x = pack2(h[0] + xx[0] * m4.x, h[1] + xx[1] * m4.y);
        o.y = pack2(h[2] + xx[2] * m4.z, h[3] + xx[3] * m4.w);
        *reinterpret_cast<uint2*>(A6 + ((size_t)m * TT + row) * DM + col) = o;
      }
    }
  }
}

#define U1_AA_OFF ((size_t)2 * TT * DM * 4)
#define U1_GG_OFF (U1_AA_OFF + (size_t)2 * TT * DM * 2)

struct ASelR2 {
  const char* A6;
  DEVINL const char* operator()(int pn) const {
    const int idx = pn < 12 ? (pn >> 2) : (pn - 9);
    const int m = (0x541320 >> (4 * idx)) & 7;
    return A6 + (size_t)m * TT * DM * 2;
  }
};
struct EpiR2 {
  static constexpr bool PERM = true;
  bf16_t *rb, *lw;
  DEVINL void operator()(const f32x4 (&acc)[2][2][4][2], const pg8::Unit& u, int wr, int wc, int fr, int fq) const {
    const int row0 = u.pm * 256 + wr * 64 + fr;
    const int pn = u.pn;
    if (pn < 12) {
      bf16_t* dst = rb + (size_t)(pn >> 2) * TT * DM;
      const int col0 = (pn & 3) * 256 + wc * 32 + 8 * fq;
#pragma unroll
      for (int ai = 0; ai < 2; ++ai)
#pragma unroll
        for (int m = 0; m < 4; ++m) {
          bf16_t* rowp = dst + (size_t)(row0 + ai * 128 + m * 16) * DM + col0;
#pragma unroll
          for (int bj = 0; bj < 2; ++bj) {
            const f32x4 v0 = acc[ai][bj][m][0], v1 = acc[ai][bj][m][1];
            pg8::u32x4 o; o.x = pg8::cvt_pk_bf16(v0[0], v0[1]); o.y = pg8::cvt_pk_bf16(v0[2], v0[3]); o.z = pg8::cvt_pk_bf16(v1[0], v1[1]); o.w = pg8::cvt_pk_bf16(v1[2], v1[3]);
            *reinterpret_cast<pg8::u32x4*>(rowp + bj * 128) = o;
          }
        }
    } else {
      bf16_t* dst = lw + (size_t)(pn - 12) * TT * 128;
      const int col0 = wc * 32 + 8 * fq;
      const float kx = (pn == 12 ? 2.0f : 1.0f) * 1.4426950408889634f, ka = pn == 12 ? 2.0f : 1.0f, kb = pn == 12 ? -1.0f : 0.0f;
#pragma unroll
      for (int ai = 0; ai < 2; ++ai)
#pragma unroll
        for (int m = 0; m < 4; ++m) {
          f32x4 v0 = acc[ai][0][m][0], v1 = acc[ai][0][m][1];
          if (pn != 13) {
#pragma unroll
            for (int e = 0; e < 4; ++e) {
              const float s0 = __builtin_amdgcn_rcpf(1.0f + __builtin_amdgcn_exp2f(-kx * v0[e]));
              const float s1 = __builtin_amdgcn_rcpf(1.0f + __builtin_amdgcn_exp2f(-kx * v1[e]));
              v0[e] = ka * s0 + kb; v1[e] = ka * s1 + kb;
            }
          }
          asm volatile("" ::: "memory");
          pg8::u32x4 o; o.x = pg8::cvt_pk_bf16(v0[0], v0[1]); o.y = pg8::cvt_pk_bf16(v0[2], v0[3]); o.z = pg8::cvt_pk_bf16(v1[0], v1[1]); o.w = pg8::cvt_pk_bf16(v1[2], v1[3]);
          *reinterpret_cast<pg8::u32x4*>(dst + (size_t)(row0 + ai * 128 + m * 16) * 128 + col0) = o;
        }
    }
  }
};
DEVINL void phase_r2(const Params& p, int layer, int w, int nw, char* smem, int gwid) {
  const int j = layer >> 1;
  bf16_t* rb = reinterpret_cast<bf16_t*>(p.U2);
  EpiR2 E;
  E.rb = rb; E.lw = p.abuf;
  ASelR2 as; as.A6 = p.U1;
  pg8::StaticOrder S; S.init(TT, RW_N, nw, w);
  pg8::gemm_phase<EpiR2, ASelR2>((PG8_LAS unsigned char*)smem, as, p.rwkv_in_t + (size_t)j * RW_N * 1024, 1024, S, E, gwid);
}

DEVINL void phase_r3(const Params& p, int layer, int w, int nw, char* smem, int gwid) {
  const int j = layer >> 1;
  GEMM_LANE_VARS
  const int half = tidx(gwid) >> 8;
  char* sh = smem + half * 16384;
  const bf16_t* lw = p.abuf;
  const bf16_t* la = lw + (size_t)TT * 128;
  const bf16_t* lg = la + (size_t)TT * 128;
  float* wdec = reinterpret_cast<float*>(p.U1);
  bf16_t* aa = reinterpret_cast<bf16_t*>(p.U1 + U1_AA_OFF);
  bf16_t* gg = reinterpret_cast<bf16_t*>(p.U1 + U1_GG_OFF);
  const int NTILES = 96 * 40;
  for (int it = 0; it * nw * 2 < NTILES; ++it) {
    int tile = (it * nw + w) * 2 + half;
    const bool valid = tile < NTILES;
    if (!valid) tile = 0;
    const int ct = tile / 96, rt = tile % 96;
    const int job = ct >> 3, nt = ct & 7;
    const int row0 = rt * 128, col0 = nt * 128;
    f32x4 acc[4][4];
    if (job < 2) {
      const int z = job;
      gemm_tile_128(lw + (size_t)row0 * 128 + z * 64, 128, p.w2t + (size_t)(j * 2 + z) * 65536 + (size_t)col0 * 64, 64, 64, sh, acc, gwid);
      if (valid) {
        const float* w0 = p.in[14] + (size_t)(j * 2 + z) * 1024;
#pragma unroll
        for (int m = 0; m < 4; ++m)
#pragma unroll
          for (int n = 0; n < 4; ++n)
#pragma unroll
            for (int jj = 0; jj < 4; ++jj) {
              int row = row0 + wr * 64 + m * 16 + fq * 4 + jj, col = col0 + wc * 64 + n * 16 + fr;
              float wl = acc[m][n][jj] + w0[col];
              wdec[((size_t)z * TT + row) * DM + col] = __expf(-0.6065306597126334f * sigmoidf_(wl));
            }
      }
    } else if (job < 4) {
      const int z = job - 2;
      gemm_tile_128(la + (size_t)row0 * 128 + z * 64, 128, p.a2t + (size_t)(j * 2 + z) * 65536 + (size_t)col0 * 64, 64, 64, sh, acc, gwid);
      if (valid) {
        const float* a0 = p.in[17] + (size_t)(j * 2 + z) * 1024;
#pragma unroll
        for (int m = 0; m < 4; ++m)
#pragma unroll
          for (int n = 0; n < 4; ++n)
#pragma unroll
            for (int jj = 0; jj < 4; ++jj) {
              int row = row0 + wr * 64 + m * 16 + fq * 4 + jj, col = col0 + wc * 64 + n * 16 + fr;
              aa[((size_t)z * TT + row) * DM + col] = f2bf(sigmoidf_(acc[m][n][jj] + a0[col]));
            }
      }
    } else {
      gemm_tile_128(lg + (size_t)row0 * 128, 128, p.g2t + (size_t)j * 131072 + (size_t)col0 * 128, 128, 128, sh, acc, gwid);
      if (valid) {
#pragma unroll
        for (int m = 0; m < 4; ++m)
#pragma unroll
          for (int n = 0; n < 4; ++n)
#pragma unroll
            for (int jj = 0; jj < 4; ++jj) {
              int row = row0 + wr * 64 + m * 16 + fq * 4 + jj, col = col0 + wc * 64 + n * 16 + fr;
              gg[(size_t)row * DM + col] = f2bf(acc[m][n][jj]);
            }
      }
    }
  }
  {
    const int l64 = tidx(gwid) & 63;
    const int gw = w * NWAVES + (tidx(gwid) >> 6), ngw = nw * NWAVES;
    const bf16_t* kb = reinterpret_cast<const bf16_t*>(p.U2) + (size_t)TT * DM;
    bf16_t* kkb = reinterpret_cast<bf16_t*>(p.U2) + (size_t)3 * TT * DM;
    const float* k_k = p.in[22] + j * 1024;
    for (int row = gw; row < TT; row += ngw) {
#pragma unroll
      for (int k = 0; k < 4; ++k) {
        const int col = k * 256 + l64 * 4;
        const uint2 k2 = *reinterpret_cast<const uint2*>(kb + (size_t)row * DM + col);
        const float4 kk4 = *reinterpret_cast<const float4*>(k_k + col);
        float v0 = bflo(k2.x) * kk4.x, v1 = bfhi(k2.x) * kk4.y, v2 = bflo(k2.y) * kk4.z, v3 = bfhi(k2.y) * kk4.w;
        float ss = grp16_sum(v0 * v0 + v1 * v1 + v2 * v2 + v3 * v3);
        float inv = 1.0f / fmaxf(sqrtf(ss), 1e-12f);
        uint2 o; o.x = pack2(v0 * inv, v1 * inv); o.y = pack2(v2 * inv, v3 * inv);
        *reinterpret_cast<uint2*>(kkb + (size_t)row * DM + col) = o;
      }
    }
  }
}

typedef __attribute__((ext_vector_type(4))) short bf16x4;
#define R4_WAVE_LDS 36864
DEVINL unsigned short bfbits(float f) { return f2bf(f); }
DEVINL bf16x4 pack4(float a, float b, float c, float d) {
  union { bf16x4 v; unsigned u[2]; } r; r.u[0] = pack2(a, b); r.u[1] = pack2(c, d); return r.v;
}
DEVINL void phase_r4(const Params& p, int layer, int w, int nw, char* smem, int gwid) {
  const int j = layer >> 1;
  const int lane = tidx(gwid) & 63, wid = __builtin_amdgcn_readfirstlane(tidx(gwid) >> 6);
  const int fr = lane & 15, fq = lane >> 4;
  if (wid >= 3) return;
  const bf16_t* rb = reinterpret_cast<const bf16_t*>(p.U2);
  const bf16_t* kb = rb + (size_t)TT * DM;
  const bf16_t* vb = kb + (size_t)TT * DM;
  const bf16_t* kkb = vb + (size_t)TT * DM;
  const float* wdec = reinterpret_cast<const float*>(p.U1);
  const bf16_t* aa = reinterpret_cast<const bf16_t*>(p.U1 + U1_AA_OFF);
  float* yout = reinterpret_cast<float*>(p.U3);
  char* wl = smem + wid * R4_WAVE_LDS;
  bf16_t* khR = reinterpret_cast<bf16_t*>(wl);
  bf16_t* ahR = khR + 1024;
  bf16_t* qhR = ahR + 1024;
  bf16_t* rhR = qhR + 1024;
  bf16_t* qhT = rhR + 1024;
  bf16_t* AtT = qhT + 1024;
  bf16_t* KtT = AtT + 1024;
  bf16_t* vT = KtT + 1024;
  float* NfT = reinterpret_cast<float*>(vT + 1024);
  float* WCf = NfT + 256;
  bf16_t* TTl = reinterpret_cast<bf16_t*>(WCf + 64);
  bf16_t* AkqR = TTl + 256;
  bf16_t* GR = AkqR + 256;
  bf16_t* QpR = khR;
  char* rawb = wl + 20480;
  const bf16_t* rawR = reinterpret_cast<const bf16_t*>(rawb);
  const bf16_t* rawK = rawR + 1024;
  const bf16_t* rawKK = rawK + 1024;
  const bf16_t* rawA = rawKK + 1024;
  const bf16_t* rawV = rawA + 1024;
  const float* rawW = reinterpret_cast<const float*>(rawb + 10240);
  {
    const int c = w + nw * wid;
    if (c >= 768) return;
    int seq, h, z;
    if (c < 256) { seq = 16 + (c >> 5); h = (c >> 1) & 15; z = c & 1; }
    else { int cc = c - 256; seq = cc >> 5; h = (cc >> 1) & 15; z = cc & 1; }
    const int Tlen = seq < 16 ? 256 : 1024;
    const int base = seq < 16 ? seq * 256 : TCTX + (seq - 16) * 1024;
    const int colb = h * 64;
    const float kal = p.in[23][j * 1024 + colb + lane];
    f32x4 ST[4][4];
    if (seq >= 16) {
      const float* s0 = p.in[3] + ((((size_t)(seq - 16) * 2 + j) * 2 + z) * 16 + h) * 4096;
#pragma unroll
      for (int b = 0; b < 4; ++b)
#pragma unroll
        for (int nb = 0; nb < 4; ++nb) ST[b][nb] = *reinterpret_cast<const f32x4*>(s0 + (size_t)(16 * nb + fr) * 64 + 16 * b + 4 * fq);
    } else {
#pragma unroll
      for (int b = 0; b < 4; ++b)
#pragma unroll
        for (int nb = 0; nb < 4; ++nb) ST[b][nb] = (f32x4){0.f, 0.f, 0.f, 0.f};
    }
#define R4_DMA(t0_) do { \
      _Pragma("unroll") for (int i_ = 0; i_ < 2; ++i_) { \
        const int t_ = (t0_) + 8 * i_ + (lane >> 3); \
        const int row_ = base + (z == 0 ? t_ : (Tlen - 1 - t_)); \
        const size_t o_ = (size_t)row_ * DM + colb + (lane & 7) * 8; \
        __builtin_amdgcn_global_load_lds((const unsigned*)(rb + o_), (unsigned*)(rawb + i_ * 1024 + lane * 16), 16, 0, 0); \
        __builtin_amdgcn_global_load_lds((const unsigned*)(kb + o_), (unsigned*)(rawb + 2048 + i_ * 1024 + lane * 16), 16, 0, 0); \
        __builtin_amdgcn_global_load_lds((const unsigned*)(kkb + o_), (unsigned*)(rawb + 4096 + i_ * 1024 + lane * 16), 16, 0, 0); \
        __builtin_amdgcn_global_load_lds((const unsigned*)(aa + (size_t)z * TT * DM + o_), (unsigned*)(rawb + 6144 + i_ * 1024 + lane * 16), 16, 0, 0); \
        __builtin_amdgcn_global_load_lds((const unsigned*)(vb + o_), (unsigned*)(rawb + 8192 + i_ * 1024 + lane * 16), 16, 0, 0); \
      } \
      _Pragma("unroll") for (int i_ = 0; i_ < 4; ++i_) { \
        const int t_ = (t0_) + 4 * i_ + (lane >> 4); \
        const int row_ = base + (z == 0 ? t_ : (Tlen - 1 - t_)); \
        __builtin_amdgcn_global_load_lds((const unsigned*)(wdec + ((size_t)z * TT + row_) * DM + colb + (lane & 15) * 4), (unsigned*)(rawb + 10240 + i_ * 1024 + lane * 16), 16, 0, 0); \
      } } while (0)
    R4_DMA(0);
#pragma unroll 1
    for (int t0 = 0; t0 < Tlen; t0 += 16) {
      asm volatile("s_waitcnt vmcnt(0)" ::: "memory");
      __builtin_amdgcn_wave_barrier();
      {
        float wx[16];
#pragma unroll
        for (int t = 0; t < 16; ++t) wx[t] = rawW[t * 64 + lane];
        float WCl = 1.0f;
#pragma unroll
        for (int t = 0; t < 16; ++t) WCl *= wx[t];
        WCf[lane] = WCl;
        float Wc = 1.0f;
#pragma unroll
        for (int tp = 0; tp < 8; ++tp) {
          float at2[2], kt2[2], qh2[2];
          unsigned vb2[2];
#pragma unroll
          for (int u = 0; u < 2; ++u) {
            const int t = tp * 2 + u;
            const float rr = bf2f(rawR[t * 64 + lane]), kx = bf2f(rawK[t * 64 + lane]), kkx = bf2f(rawKK[t * 64 + lane]);
            const float ax = bf2f(rawA[t * 64 + lane]);
            vb2[u] = rawV[t * 64 + lane];
            const float kd = kx * (1.0f + (ax - 1.0f) * kal);
            const float kka = kkx * ax;
            const float qh = Wc * kkx;
            Wc *= wx[t];
            const float rh = Wc * rr;
            const float iw = __builtin_amdgcn_rcpf(Wc);
            const float kh = kd * iw, ah = kka * iw;
            khR[t * 64 + lane] = f2bf(kh); ahR[t * 64 + lane] = f2bf(ah);
            qhR[t * 64 + lane] = f2bf(qh); rhR[t * 64 + lane] = f2bf(rh);
            at2[u] = ah * WCl; kt2[u] = kh * WCl; qh2[u] = qh;
          }
          *reinterpret_cast<unsigned*>(AtT + lane * 16 + tp * 2) = pack2(at2[0], at2[1]);
          *reinterpret_cast<unsigned*>(KtT + lane * 16 + tp * 2) = pack2(kt2[0], kt2[1]);
          *reinterpret_cast<unsigned*>(qhT + lane * 16 + tp * 2) = pack2(qh2[0], qh2[1]);
          *reinterpret_cast<unsigned*>(vT + lane * 16 + tp * 2) = vb2[0] | (vb2[1] << 16);
        }
      }
      asm volatile("s_waitcnt lgkmcnt(0)" ::: "memory");
      if (t0 + 16 < Tlen) R4_DMA(t0 + 16);
      __builtin_amdgcn_wave_barrier();
      f32x4 Akq = {0.f, 0.f, 0.f, 0.f}, Aaq = Akq, Akr = Akq, Aar = Akq;
      {
#pragma unroll
        for (int ks = 0; ks < 2; ++ks) {
          const bf16x8 khA = *reinterpret_cast<const bf16x8*>(khR + fr * 64 + ks * 32 + fq * 8);
          const bf16x8 ahA = *reinterpret_cast<const bf16x8*>(ahR + fr * 64 + ks * 32 + fq * 8);
          const bf16x8 qhB = *reinterpret_cast<const bf16x8*>(qhR + fr * 64 + ks * 32 + fq * 8);
          const bf16x8 rhB = *reinterpret_cast<const bf16x8*>(rhR + fr * 64 + ks * 32 + fq * 8);
          Akq = __builtin_amdgcn_mfma_f32_16x16x32_bf16(khA, qhB, Akq, 0, 0, 0);
          Aaq = __builtin_amdgcn_mfma_f32_16x16x32_bf16(ahA, qhB, Aaq, 0, 0, 0);
          Akr = __builtin_amdgcn_mfma_f32_16x16x32_bf16(khA, rhB, Akr, 0, 0, 0);
          Aar = __builtin_amdgcn_mfma_f32_16x16x32_bf16(ahA, rhB, Aar, 0, 0, 0);
        }
#pragma unroll
        for (int e = 0; e < 4; ++e) {
          const int s = 4 * fq + e;
          if (!(s < fr)) { Akq[e] = 0.f; Aaq[e] = 0.f; }
          if (!(s <= fr)) { Akr[e] = 0.f; Aar[e] = 0.f; }
        }
      }
      __builtin_amdgcn_wave_barrier();
      *reinterpret_cast<f32x4*>(NfT + fr * 16 + 4 * fq) = Aaq;
#pragma unroll
      for (int e = 0; e < 4; ++e) AkqR[(4 * fq + e) * 16 + fr] = f2bf(Akq[e]);
      __builtin_amdgcn_wave_barrier();
      {
        float Tr[16];
#pragma unroll
        for (int t = 0; t < 16; ++t) {
          float acc = (fr == t) ? 1.0f : 0.0f;
#pragma unroll
          for (int x = 0; x < t; ++x) acc -= Tr[x] * NfT[t * 16 + x];
          Tr[t] = acc;
        }
        if (fq == 0) {
#pragma unroll
          for (int t = 0; t < 16; ++t) TTl[t * 16 + fr] = f2bf(Tr[t]);
        }
      }
      __builtin_amdgcn_wave_barrier();
      const bf16x4 Tb = *reinterpret_cast<const bf16x4*>(TTl + fr * 16 + fq * 4);
      f32x4 G;
      {
        const bf16x4 AkqA = *reinterpret_cast<const bf16x4*>(AkqR + fr * 16 + fq * 4);
        G = __builtin_amdgcn_mfma_f32_16x16x16bf16_1k(AkqA, Tb, (f32x4){0.f, 0.f, 0.f, 0.f}, 0, 0, 0);
#pragma unroll
        for (int b = 0; b < 4; ++b) {
          const bf16x4 qa = *reinterpret_cast<const bf16x4*>(qhT + (16 * b + fr) * 16 + fq * 4);
          const f32x4 qp = __builtin_amdgcn_mfma_f32_16x16x16bf16_1k(qa, Tb, (f32x4){0.f, 0.f, 0.f, 0.f}, 0, 0, 0);
          *reinterpret_cast<bf16x4*>(QpR + fr * 64 + 16 * b + 4 * fq) = pack4(qp[0], qp[1], qp[2], qp[3]);
        }
#pragma unroll
        for (int e = 0; e < 4; ++e) GR[(4 * fq + e) * 16 + fr] = f2bf(G[e]);
      }
      __builtin_amdgcn_wave_barrier();
      f32x4 H, Zb[4];
      {
        const bf16x4 GA = *reinterpret_cast<const bf16x4*>(GR + fr * 16 + fq * 4);
        const bf16x4 AarB = pack4(Aar[0], Aar[1], Aar[2], Aar[3]);
        const f32x4 hm = __builtin_amdgcn_mfma_f32_16x16x16bf16_1k(GA, AarB, (f32x4){0.f, 0.f, 0.f, 0.f}, 0, 0, 0);
        H = Akr - hm;
#pragma unroll
        for (int b = 0; b < 4; ++b) {
          const bf16x4 AtB = *reinterpret_cast<const bf16x4*>(AtT + (16 * b + fr) * 16 + fq * 4);
          const f32x4 zm = __builtin_amdgcn_mfma_f32_16x16x16bf16_1k(GA, AtB, (f32x4){0.f, 0.f, 0.f, 0.f}, 0, 0, 0);
          const bf16x4 ktv = *reinterpret_cast<const bf16x4*>(KtT + (16 * b + fr) * 16 + fq * 4);
          union { bf16x4 v; unsigned short s[4]; } ku; ku.v = ktv;
          Zb[b][0] = bf2f(ku.s[0]) - zm[0]; Zb[b][1] = bf2f(ku.s[1]) - zm[1]; Zb[b][2] = bf2f(ku.s[2]) - zm[2]; Zb[b][3] = bf2f(ku.s[3]) - zm[3];
        }
      }
      bf16x8 QpA[2], rhA[2], AY, AS[4];
      {
#pragma unroll
        for (int ks = 0; ks < 2; ++ks) {
          union { bf16x8 v; bf16x4 h[2]; } u1, u2;
          u1.h[0] = *reinterpret_cast<const bf16x4*>(QpR + fr * 64 + 32 * ks + 4 * fq);
          u1.h[1] = *reinterpret_cast<const bf16x4*>(QpR + fr * 64 + 32 * ks + 16 + 4 * fq);
          u2.h[0] = *reinterpret_cast<const bf16x4*>(rhR + fr * 64 + 32 * ks + 4 * fq);
          u2.h[1] = *reinterpret_cast<const bf16x4*>(rhR + fr * 64 + 32 * ks + 16 + 4 * fq);
          QpA[ks] = u1.v; rhA[ks] = u2.v;
        }
        {
          union { bf16x8 v; bf16x4 h[2]; } u;
          u.h[0] = pack4(Aar[0], Aar[1], Aar[2], Aar[3]); u.h[1] = pack4(H[0], H[1], H[2], H[3]);
          AY = u.v;
        }
#pragma unroll
        for (int b = 0; b < 4; ++b) {
          union { bf16x8 v; bf16x4 h[2]; } u;
          u.h[0] = *reinterpret_cast<const bf16x4*>(AtT + (16 * b + fr) * 16 + fq * 4);
          u.h[1] = pack4(Zb[b][0], Zb[b][1], Zb[b][2], Zb[b][3]);
          AS[b] = u.v;
        }
      }
#pragma unroll
      for (int nb = 0; nb < 4; ++nb) {
        bf16x8 Bhi[2];
#pragma unroll
        for (int ks = 0; ks < 2; ++ks) {
          union { bf16x8 v; unsigned u[4]; } hi;
          hi.u[0] = pack2(ST[2 * ks][nb][0], ST[2 * ks][nb][1]); hi.u[1] = pack2(ST[2 * ks][nb][2], ST[2 * ks][nb][3]);
          hi.u[2] = pack2(ST[2 * ks + 1][nb][0], ST[2 * ks + 1][nb][1]); hi.u[3] = pack2(ST[2 * ks + 1][nb][2], ST[2 * ks + 1][nb][3]);
          Bhi[ks] = hi.v;
        }
        f32x4 P = {0.f, 0.f, 0.f, 0.f}, R = {0.f, 0.f, 0.f, 0.f};
        P = __builtin_amdgcn_mfma_f32_16x16x32_bf16(QpA[0], Bhi[0], P, 0, 0, 0);
        P = __builtin_amdgcn_mfma_f32_16x16x32_bf16(QpA[1], Bhi[1], P, 0, 0, 0);
        R = __builtin_amdgcn_mfma_f32_16x16x32_bf16(rhA[0], Bhi[0], R, 0, 0, 0);
        R = __builtin_amdgcn_mfma_f32_16x16x32_bf16(rhA[1], Bhi[1], R, 0, 0, 0);
        bf16x8 X;
        {
          union { bf16x8 v; bf16x4 h[2]; } u;
          u.h[0] = pack4(-P[0], -P[1], -P[2], -P[3]);
          u.h[1] = *reinterpret_cast<const bf16x4*>(vT + (16 * nb + fr) * 16 + fq * 4);
          X = u.v;
        }
        const f32x4 Y = __builtin_amdgcn_mfma_f32_16x16x32_bf16(AY, X, R, 0, 0, 0);
#pragma unroll
        for (int e = 0; e < 4; ++e) {
          const int t = t0 + 4 * fq + e;
          const int row = base + (z == 0 ? t : (Tlen - 1 - t));
          yout[((size_t)z * TT + row) * DM + colb + 16 * nb + fr] = Y[e];
        }
#pragma unroll
        for (int b = 0; b < 4; ++b) {
          const f32x4 wcv = *reinterpret_cast<const f32x4*>(WCf + 16 * b + 4 * fq);
          ST[b][nb] = __builtin_amdgcn_mfma_f32_16x16x32_bf16(AS[b], X, ST[b][nb] * wcv, 0, 0, 0);
        }
        __builtin_amdgcn_sched_barrier(0);
      }
    }
    if (seq < 16) {
      const int l2 = tidx(gwid) & 63, fr2 = l2 & 15, fq2 = l2 >> 4;
      float* so = p.out + OUT_STATE + ((((size_t)seq * 2 + j) * 2 + z) * 16 + h) * 4096;
#pragma unroll
      for (int b = 0; b < 4; ++b)
#pragma unroll
        for (int nb = 0; nb < 4; ++nb) *reinterpret_cast<f32x4*>(so + (size_t)(16 * nb + fr2) * 64 + 16 * b + 4 * fq2) = ST[b][nb];
    }
  }
}

DEVINL void phase_r5(const Params& p, int layer, int w, int nw, int gwid) {
  const int j = layer >> 1;
  const int lane = tidx(gwid) & 63;
  const int gw = w * NWAVES + (tidx(gwid) >> 6), ngw = nw * NWAVES;
  const bf16_t* rb = reinterpret_cast<const bf16_t*>(p.U2);
  const bf16_t* kb = rb + (size_t)TT * DM;
  const bf16_t* vb = kb + (size_t)TT * DM;
  const bf16_t* aa = reinterpret_cast<const bf16_t*>(p.U1 + U1_AA_OFF);
  const bf16_t* gg = reinterpret_cast<const bf16_t*>(p.U1 + U1_GG_OFF);
  const float* yin = reinterpret_cast<const float*>(p.U3);
  const float* ka = p.in[23] + j * 1024;
  const float* rk = p.in[24] + j * 1024;
  const float* lg = p.in[25] + j * 1024;
  const float* lb = p.in[26] + j * 1024;
  for (int row = gw; row < TT; row += ngw) {
#pragma unroll
    for (int k = 0; k < 4; ++k) {
      const int col = k * 256 + lane * 4;
      const size_t o = (size_t)row * DM + col;
      const float4 yf = *reinterpret_cast<const float4*>(yin + o);
      const float4 yb = *reinterpret_cast<const float4*>(yin + (size_t)TT * DM + o);
      const uint2 r2 = *reinterpret_cast<const uint2*>(rb + o);
      const uint2 k2 = *reinterpret_cast<const uint2*>(kb + o);
      const uint2 v2 = *reinterpret_cast<const uint2*>(vb + o);
      const uint2 a02 = *reinterpret_cast<const uint2*>(aa + o);
      const uint2 a12 = *reinterpret_cast<const uint2*>(aa + (size_t)TT * DM + o);
      const uint2 g2 = *reinterpret_cast<const uint2*>(gg + o);
      const float4 ka4 = *reinterpret_cast<const float4*>(ka + col);
      const float4 rk4 = *reinterpret_cast<const float4*>(rk + col);
      const float4 lg4 = *reinterpret_cast<const float4*>(lg + col);
      const float4 lb4 = *reinterpret_cast<const float4*>(lb + col);
      float y[4] = {yf.x + yb.x, yf.y + yb.y, yf.z + yb.z, yf.w + yb.w};
      float r[4] = {bflo(r2.x), bfhi(r2.x), bflo(r2.y), bfhi(r2.y)};
      float kx[4] = {bflo(k2.x), bfhi(k2.x), bflo(k2.y), bfhi(k2.y)};
      float v[4] = {bflo(v2.x), bfhi(v2.x), bflo(v2.y), bfhi(v2.y)};
      float a0[4] = {bflo(a02.x), bfhi(a02.x), bflo(a02.y), bfhi(a02.y)};
      float a1[4] = {bflo(a12.x), bfhi(a12.x), bflo(a12.y), bfhi(a12.y)};
      float g[4] = {bflo(g2.x), bfhi(g2.x), bflo(g2.y), bfhi(g2.y)};
      float kav[4] = {ka4.x, ka4.y, ka4.z, ka4.w}, rkv[4] = {rk4.x, rk4.y, rk4.z, rk4.w};
      float lgv[4] = {lg4.x, lg4.y, lg4.z, lg4.w}, lbv[4] = {lb4.x, lb4.y, lb4.z, lb4.w};
      float sm = y[0] + y[1] + y[2] + y[3];
      sm = grp16_sum(sm);
      const float mean = sm * (1.0f / 64.0f);
      float sv = 0.f, sb = 0.f;
#pragma unroll
      for (int e = 0; e < 4; ++e) {
        float d = y[e] - mean; sv += d * d;
        float kd0 = kx[e] * (1.0f + (a0[e] - 1.0f) * kav[e]);
        float kd1 = kx[e] * (1.0f + (a1[e] - 1.0f) * kav[e]);
        sb += r[e] * (kd0 + kd1) * rkv[e];
      }
      sv = grp16_sum(sv); sb = grp16_sum(sb);
      const float rstd = rsqrtf(sv * (1.0f / 64.0f) + GN_EPS_F);
      float o4[4];
#pragma unroll
      for (int e = 0; e < 4; ++e) {
        float yn = (y[e] - mean) * rstd * lgv[e] + lbv[e];
        o4[e] = (yn + sb * v[e]) * g[e];
      }
      uint2 oo; oo.x = pack2(o4[0], o4[1]); oo.y = pack2(o4[2], o4[3]);
      *reinterpret_cast<uint2*>(p.abuf + o) = oo;
    }
  }
}

struct EpiWO {
  static constexpr bool PERM = false;
  const float* x; const float* mod; float* z; int layer;
  DEVINL void operator()(const f32x4 (&acc)[2][2][4][2], const pg8::Unit& u, int wr, int wc, int fr, int fq) const {
    const int row0 = u.pm * 256 + wr * 64 + fr, col0 = u.pn * 256 + wc * 32 + 4 * fq;
    const float* gate = mod + ((size_t)layer * 9 + cond_of_row(u.pm * 256)) * 6144 + 2 * 1024;
    f32x4 gv[2][2];
#pragma unroll
    for (int bj = 0; bj < 2; ++bj)
#pragma unroll
      for (int n = 0; n < 2; ++n) gv[bj][n] = *reinterpret_cast<const f32x4*>(gate + col0 + bj * 128 + n * 16);
#pragma unroll
    for (int ai = 0; ai < 2; ++ai)
#pragma unroll
      for (int m = 0; m < 4; ++m) {
        const size_t off = (size_t)(row0 + ai * 128 + m * 16) * DM + col0;
#pragma unroll
        for (int bj = 0; bj < 2; ++bj)
#pragma unroll
          for (int n = 0; n < 2; ++n) {
            const f32x4 xv = *reinterpret_cast<const f32x4*>(x + off + bj * 128 + n * 16);
            *reinterpret_cast<f32x4*>(z + off + bj * 128 + n * 16) = ALPHA_F * xv + gv[bj][n] * acc[ai][bj][m][n];
          }
        asm volatile("" ::: "memory");
      }
  }
};
DEVINL void phase_wo(const Params& p, int layer, int w, int nw, char* smem, int gwid) {
  const int j = layer >> 1;
  const bf16_t* Wt = ((layer & 1) ? p.attn_wo_t : p.rwkv_wo_t) + ((size_t)j << 20);
  EpiWO E; E.x = p.xbuf; E.mod = p.mod; E.z = p.zbuf; E.layer = layer;
  pg8::ASelOne as; as.A = (const char*)p.abuf;
  pg8::StaticOrder S; S.init(TT, 1024, nw, w);
  pg8::gemm_phase<EpiWO, pg8::ASelOne>((PG8_LAS unsigned char*)smem, as, Wt, 1024, S, E, gwid);
}

DEVINL void phase_ln1(const Params& p, int layer, int w, int nw, int gwid) {
  const int lane = tidx(gwid) & 63;
  const int gw = w * NWAVES + (tidx(gwid) >> 6), ngw = nw * NWAVES;
  const float* lng = p.in[9] + (size_t)(layer * 2 + 0) * 1024;
  const float* lnb = p.in[10] + (size_t)(layer * 2 + 0) * 1024;
  for (int row = gw; row < TT; row += ngw) {
    const float* md = p.mod + ((size_t)layer * 9 + cond_of_row(row)) * 6144;
    float4 z[4];
    float s = 0.f;
#pragma unroll
    for (int k = 0; k < 4; ++k) {
      z[k] = *reinterpret_cast<const float4*>(p.zbuf + (size_t)row * DM + k * 256 + lane * 4);
      s += z[k].x + z[k].y + z[k].z + z[k].w;
    }
    const float mean = wave_sum(s) * (1.0f / 1024.0f);
    float sv = 0.f;
#pragma unroll
    for (int k = 0; k < 4; ++k) {
      float a = z[k].x - mean, b = z[k].y - mean, c = z[k].z - mean, d = z[k].w - mean;
      sv += a * a + b * b + c * c + d * d;
    }
    const float rstd = rsqrtf(wave_sum(sv) * (1.0f / 1024.0f) + LN_EPS_F);
#pragma unroll
    for (int k = 0; k < 4; ++k) {
      const int col = k * 256 + lane * 4;
      const float4 g4 = *reinterpret_cast<const float4*>(lng + col);
      const float4 b4 = *reinterpret_cast<const float4*>(lnb + col);
      const float4 sh = *reinterpret_cast<const float4*>(md + 3 * 1024 + col);
      const float4 sc = *reinterpret_cast<const float4*>(md + 4 * 1024 + col);
      float4 x1;
      x1.x = (z[k].x - mean) * rstd * g4.x + b4.x;
      x1.y = (z[k].y - mean) * rstd * g4.y + b4.y;
      x1.z = (z[k].z - mean) * rstd * g4.z + b4.z;
      x1.w = (z[k].w - mean) * rstd * g4.w + b4.w;
      *reinterpret_cast<float4*>(p.xbuf + (size_t)row * DM + col) = x1;
      uint2 o;
      o.x = pack2(x1.x * (1.0f + sc.x) + sh.x, x1.y * (1.0f + sc.y) + sh.y);
      o.y = pack2(x1.z * (1.0f + sc.z) + sh.z, x1.w * (1.0f + sc.w) + sh.w);
      *reinterpret_cast<uint2*>(p.hbuf + (size_t)row * DM + col) = o;
    }
  }
}

struct EpiBf16 {
  static constexpr bool PERM = true;
  bf16_t* O; int ldc;
  DEVINL void operator()(const f32x4 (&acc)[2][2][4][2], const pg8::Unit& u, int wr, int wc, int fr, int fq) const {
    const int row0 = u.pm * 256 + wr * 64 + fr, col0 = u.pn * 256 + wc * 32 + 8 * fq;
#pragma unroll
    for (int ai = 0; ai < 2; ++ai)
#pragma unroll
      for (int m = 0; m < 4; ++m) {
        bf16_t* rowp = O + (size_t)(row0 + ai * 128 + m * 16) * ldc + col0;
#pragma unroll
        for (int bj = 0; bj < 2; ++bj) {
          const f32x4 v0 = acc[ai][bj][m][0], v1 = acc[ai][bj][m][1];
          pg8::u32x4 o; o.x = pg8::cvt_pk_bf16(v0[0], v0[1]); o.y = pg8::cvt_pk_bf16(v0[2], v0[3]); o.z = pg8::cvt_pk_bf16(v1[0], v1[1]); o.w = pg8::cvt_pk_bf16(v1[2], v1[3]);
          *reinterpret_cast<pg8::u32x4*>(rowp + bj * 128) = o;
        }
      }
  }
};

DEVINL void phase_p1(const Params& p, int layer, int w, int nw, char* smem, int gwid) {
  EpiBf16 E; E.O = reinterpret_cast<bf16_t*>(p.U1); E.ldc = 2048;
  pg8::ASelOne as; as.A = (const char*)p.hbuf;
  pg8::StaticOrder S; S.init(TT, 2048, nw, w);
  pg8::gemm_phase<EpiBf16, pg8::ASelOne>((PG8_LAS unsigned char*)smem, as, p.wq_t + (size_t)layer * 2048 * 1024, 1024, S, E, gwid);
}

#define U1_S_OFF ((size_t)TT * 2048 * 2)
DEVINL void phase_p2(const Params& p, int layer, int w, int nw, char* smem, int gwid) {
  GEMM_LANE_VARS
  const int half = tidx(gwid) >> 8;
  char* sh = smem + half * 16384;
  const bf16_t* qb = reinterpret_cast<const bf16_t*>(p.U1);
  float* sb = reinterpret_cast<float*>(p.U1 + U1_S_OFF);
  const int NTILES = 96 * 16;
  for (int it = 0; it * nw * 2 < NTILES; ++it) {
    int tile = (it * nw + w) * 2 + half;
    const bool valid = tile < NTILES;
    if (!valid) tile = 0;
    const int ct = tile / 96, rt = tile % 96;
    const int row0 = rt * 128;
    const int z = ct & 1;
    f32x4 acc[4][4];
    gemm_tile_128(qb + (size_t)row0 * 2048 + ct * 128, 2048, p.keysb + (size_t)(layer * 2 + z) * 16384, 128, 128, sh, acc, gwid);
    if (valid) {
#pragma unroll
      for (int m = 0; m < 4; ++m)
#pragma unroll
        for (int n = 0; n < 4; ++n)
#pragma unroll
          for (int jj = 0; jj < 4; ++jj) {
            int row = row0 + wr * 64 + m * 16 + fq * 4 + jj, col = wc * 64 + n * 16 + fr;
            sb[(size_t)row * 2048 + ct * 128 + col] = acc[m][n][jj];
          }
    }
  }
}

DEVINL float unordf(unsigned u) { return __uint_as_float((u & 0x80000000u) ? (u ^ 0x80000000u) : ~u); }
#define CSWAP(a, b) { const unsigned _hi = umax_(a, b), _lo = umin_(a, b); a = _hi; b = _lo; }
DEVINL void slot_ij(int s, int& i, int& j) {
  if (s < 16) { i = 0; j = s; }
  else if (s < 24) { i = 1; j = s - 16; }
  else if (s < 29) { i = 2; j = s - 24; }
  else if (s < 33) { i = 3; j = s - 29; }
  else if (s < 36) { i = 4; j = s - 33; }
  else if (s < 42) { i = 5 + ((s - 36) >> 1); j = (s - 36) & 1; }
  else { i = s - 34; j = 0; }
}
DEVINL void phase_p3(const Params& p, int layer, int w, int nw, char* smem, int gwid) {
  const int lane = tidx(gwid) & 63, wid = tidx(gwid) >> 6;
  const int fr = lane & 15, row = lane >> 4, pr = lane >> 5, l32 = lane & 31;
  const int gw = w * NWAVES + wid, ngw = nw * NWAVES;
  const float* sb = reinterpret_cast<const float*>(p.U1 + U1_S_OFF);
  float* svl = reinterpret_cast<float*>(smem) + wid * 128;
  int* sil = reinterpret_cast<int*>(smem) + wid * 128 + 64;
  int iA, jA, iB, jB;
  slot_ij(l32, iA, jA);
  const bool validB = (l32 + 32) < 50;
  slot_ij(validB ? (l32 + 32) : 0, iB, jB);
  for (int bt = gw; bt < TT * 4; bt += ngw) {
    const int t = bt >> 2, hp = bt & 3;
    {
      const int h = hp * 2 + (row >> 1), z = row & 1;
      const float* sp = sb + (size_t)t * 2048 + (h * 2 + z) * 128;
      const float4 a = *reinterpret_cast<const float4*>(sp + fr * 4);
      const float4 b = *reinterpret_cast<const float4*>(sp + 64 + fr * 4);
      unsigned k0 = (ordf(a.x) & ~127u) | (unsigned)(127 - (4 * fr + 0));
      unsigned k1 = (ordf(a.y) & ~127u) | (unsigned)(127 - (4 * fr + 1));
      unsigned k2 = (ordf(a.z) & ~127u) | (unsigned)(127 - (4 * fr + 2));
      unsigned k3 = (ordf(a.w) & ~127u) | (unsigned)(127 - (4 * fr + 3));
      unsigned k4 = (ordf(b.x) & ~127u) | (unsigned)(127 - (64 + 4 * fr + 0));
      unsigned k5 = (ordf(b.y) & ~127u) | (unsigned)(127 - (64 + 4 * fr + 1));
      unsigned k6 = (ordf(b.z) & ~127u) | (unsigned)(127 - (64 + 4 * fr + 2));
      unsigned k7 = (ordf(b.w) & ~127u) | (unsigned)(127 - (64 + 4 * fr + 3));
      CSWAP(k0, k1); CSWAP(k2, k3); CSWAP(k4, k5); CSWAP(k6, k7);
      CSWAP(k0, k2); CSWAP(k1, k3); CSWAP(k4, k6); CSWAP(k5, k7);
      CSWAP(k1, k2); CSWAP(k5, k6); CSWAP(k0, k4); CSWAP(k3, k7);
      CSWAP(k1, k5); CSWAP(k2, k6);
      CSWAP(k1, k4); CSWAP(k3, k6);
      CSWAP(k2, k4); CSWAP(k3, k5);
      CSWAP(k3, k4);
      unsigned mine = 0;
#pragma unroll
      for (int it = 0; it < 16; ++it) {
        const unsigned m = row_max_u(k0);
        if (fr == it) mine = m;
        const bool c = (k0 == m);
        k0 = c ? k1 : k0; k1 = c ? k2 : k1; k2 = c ? k3 : k2; k3 = c ? k4 : k3;
        k4 = c ? k5 : k4; k5 = c ? k6 : k5; k6 = c ? k7 : k6; k7 = c ? 0u : k7;
      }
      __builtin_amdgcn_wave_barrier();
      svl[row * 16 + fr] = unordf(mine & ~127u);
      sil[row * 16 + fr] = 127 - (int)(mine & 127u);
      __builtin_amdgcn_wave_barrier();
    }
    {
      const float* v0 = svl + (2 * pr) * 16;
      const float* v1 = svl + (2 * pr + 1) * 16;
      unsigned kA = (ordf(v0[iA] + v1[jA]) & ~63u) | (unsigned)(63 - l32);
      unsigned kB = validB ? ((ordf(v0[iB] + v1[jB]) & ~63u) | (unsigned)(63 - (l32 + 32))) : 0u;
      unsigned mine = 0;
#pragma unroll
      for (int it = 0; it < 16; ++it) {
        unsigned m = row_max_u(umax_(kA, kB));
        m = umax_(m, (unsigned)__shfl_xor((int)m, 16));
        if (l32 == it) mine = m;
        kA = (kA == m) ? 0u : kA;
        kB = (kB == m) ? 0u : kB;
      }
      int ii, jj;
      slot_ij(63 - (int)(mine & 63u), ii, jj);
      ii &= 15; jj &= 15;
      const float cv = v0[ii] + v1[jj];
      const int eidx = sil[(2 * pr) * 16 + ii] * 128 + sil[(2 * pr + 1) * 16 + jj];
      const float mx = row_max_f(cv);
      const float ex = __expf(cv - mx);
      const float sm = row_sum_f(ex);
      if (l32 < 16) {
        const int h = hp * 2 + pr;
        p.pidx[(size_t)t * 128 + h * 16 + l32] = eidx;
        p.pgate[(size_t)t * 128 + h * 16 + l32] = ex / sm;
      }
    }
  }
}

DEVINL void phase_p23(const Params& p, int layer, int w, int nw, char* smem, int gwid) {
  GEMM_LANE_VARS
  const int l64 = tidx(gwid) & 63, wid8 = tidx(gwid) >> 6, half = tidx(gwid) >> 8;
  const int row = l64 >> 4, pr = l64 >> 5, l32 = l64 & 31;
  const bf16_t* qb = reinterpret_cast<const bf16_t*>(p.U1);
  float* tiles = reinterpret_cast<float*>(smem);
  float* svl = reinterpret_cast<float*>(smem + 131072) + wid8 * 128;
  int* sil = reinterpret_cast<int*>(smem + 131072) + wid8 * 128 + 64;
  int iA, jA, iB, jB;
  slot_ij(l32, iA, jA);
  const bool validB = (l32 + 32) < 50;
  slot_ij(validB ? (l32 + 32) : 0, iB, jB);
  for (int unit = w; unit < 96 * 8; unit += nw) {
    const int h = unit / 96, rt = unit % 96;
    const int row0 = rt * 128;
    {
      f32x4 acc[4][4];
      gemm_tile_128(qb + (size_t)row0 * 2048 + (h * 2 + half) * 128, 2048, p.keysb + (size_t)(layer * 2 + half) * 16384, 128, 128, smem + half * 16384, acc, gwid);
      float* tz = tiles + half * 16384;
#pragma unroll
      for (int m = 0; m < 4; ++m)
#pragma unroll
        for (int n = 0; n < 4; ++n)
#pragma unroll
          for (int jj = 0; jj < 4; ++jj) tz[(wr * 64 + m * 16 + fq * 4 + jj) * 128 + wc * 64 + n * 16 + fr] = acc[m][n][jj];
    }
    __syncthreads();
#pragma unroll 1
    for (int i = 0; i < 8; ++i) {
      const int tl = wid8 * 16 + i * 2;
      {
        const int z = row & 1, tt = tl + (row >> 1);
        const float* sp = tiles + z * 16384 + tt * 128;
        const float4 a = *reinterpret_cast<const float4*>(sp + fr * 4);
        const float4 b = *reinterpret_cast<const float4*>(sp + 64 + fr * 4);
        unsigned k0 = (ordf(a.x) & ~127u) | (unsigned)(127 - (4 * fr + 0));
        unsigned k1 = (ordf(a.y) & ~127u) | (unsigned)(127 - (4 * fr + 1));
        unsigned k2 = (ordf(a.z) & ~127u) | (unsigned)(127 - (4 * fr + 2));
        unsigned k3 = (ordf(a.w) & ~127u) | (unsigned)(127 - (4 * fr + 3));
        unsigned k4 = (ordf(b.x) & ~127u) | (unsigned)(127 - (64 + 4 * fr + 0));
        unsigned k5 = (ordf(b.y) & ~127u) | (unsigned)(127 - (64 + 4 * fr + 1));
        unsigned k6 = (ordf(b.z) & ~127u) | (unsigned)(127 - (64 + 4 * fr + 2));
        unsigned k7 = (ordf(b.w) & ~127u) | (unsigned)(127 - (64 + 4 * fr + 3));
        CSWAP(k0, k1); CSWAP(k2, k3); CSWAP(k4, k5); CSWAP(k6, k7);
        CSWAP(k0, k2); CSWAP(k1, k3); CSWAP(k4, k6); CSWAP(k5, k7);
        CSWAP(k1, k2); CSWAP(k5, k6); CSWAP(k0, k4); CSWAP(k3, k7);
        CSWAP(k1, k5); CSWAP(k2, k6);
        CSWAP(k1, k4); CSWAP(k3, k6);
        CSWAP(k2, k4); CSWAP(k3, k5);
        CSWAP(k3, k4);
        unsigned mine = 0;
#pragma unroll
        for (int it = 0; it < 16; ++it) {
          const unsigned m = row_max_u(k0);
          if (fr == it) mine = m;
          const bool c = (k0 == m);
          k0 = c ? k1 : k0; k1 = c ? k2 : k1; k2 = c ? k3 : k2; k3 = c ? k4 : k3;
          k4 = c ? k5 : k4; k5 = c ? k6 : k5; k6 = c ? k7 : k6; k7 = c ? 0u : k7;
        }
        __builtin_amdgcn_wave_barrier();
        svl[row * 16 + fr] = unordf(mine & ~127u);
        sil[row * 16 + fr] = 127 - (int)(mine & 127u);
        __builtin_amdgcn_wave_barrier();
      }
      {
        const float* v0 = svl + (2 * pr) * 16;
        const float* v1 = svl + (2 * pr + 1) * 16;
        unsigned kA = (ordf(v0[iA] + v1[jA]) & ~63u) | (unsigned)(63 - l32);
        unsigned kB = validB ? ((ordf(v0[iB] + v1[jB]) & ~63u) | (unsigned)(63 - (l32 + 32))) : 0u;
        unsigned mine = 0;
#pragma unroll
        for (int it = 0; it < 16; ++it) {
          unsigned m = row_max_u(umax_(kA, kB));
          m = umax_(m, (unsigned)__shfl_xor((int)m, 16));
          if (l32 == it) mine = m;
          kA = (kA == m) ? 0u : kA;
          kB = (kB == m) ? 0u : kB;
        }
        int ii, jj;
        slot_ij(63 - (int)(mine & 63u), ii, jj);
        ii &= 15; jj &= 15;
        const float cv = v0[ii] + v1[jj];
        const int eidx = sil[(2 * pr) * 16 + ii] * 128 + sil[(2 * pr + 1) * 16 + jj];
        const float mx = row_max_f(cv);
        const float ex = __expf(cv - mx);
        const float sm = row_sum_f(ex);
        if (l32 < 16) {
          const int t = row0 + tl + pr;
          p.pidx[(size_t)t * 128 + h * 16 + l32] = eidx;
          p.pgate[(size_t)t * 128 + h * 16 + l32] = ex / sm;
        }
      }
    }
    __syncthreads();
  }
}

DEVINL float gelu_exact(float x) { return 0.5f * x * (1.0f + erff(x * 0.7071067811865476f)); }

typedef __attribute__((ext_vector_type(8))) int i32x8;
#define P4_WAVE_LDS 19456
DEVINL void phase_p4(const Params& p, int layer, int w, int nw, char* smem, int gwid) {
  const int wid = __builtin_amdgcn_readfirstlane(tidx(gwid) >> 6);
  const int gw = w * NWAVES + wid, ngw = nw * NWAVES;
  const unsigned char* U = reinterpret_cast<const unsigned char*>(p.ub) + (size_t)layer * 16384 * 512;
  const unsigned char* V = reinterpret_cast<const unsigned char*>(p.vb) + (size_t)layer * 16384 * 512;
  const unsigned char* Usc = reinterpret_cast<const unsigned char*>(p.ub) + (size_t)65536 * 512 + (size_t)layer * 16384 * 32;
  const unsigned char* Vsc = reinterpret_cast<const unsigned char*>(p.vb) + (size_t)65536 * 512 + (size_t)layer * 16384 * 32;
  const float* lng = p.in[9] + (size_t)(layer * 2 + 1) * 1024;
  const float* lnb = p.in[10] + (size_t)(layer * 2 + 1) * 1024;
  float* xout = (layer == 3) ? p.out : p.xbuf;
  char* wl = smem + wid * P4_WAVE_LDS;
  unsigned char* xq = reinterpret_cast<unsigned char*>(wl);
  unsigned char* xsc = xq + 1536;
  float* wgt = reinterpret_cast<float*>(wl + 2048);
  int* il = reinterpret_cast<int*>(wl + 2560);
  unsigned char* vscl = reinterpret_cast<unsigned char*>(wl) + 3072;
  unsigned char* ring = reinterpret_cast<unsigned char*>(wl) + 7168;
  for (int t = gw; t < TT; t += ngw) {
    __builtin_amdgcn_wave_barrier();
    const int lane = tidx(gwid) & 63, fr = lane & 15, fq = lane >> 4;
    const int gl = lane;
    {
      const uint4 a = *reinterpret_cast<const uint4*>(p.hbuf + (size_t)t * DM + gl * 16);
      const uint4 b = *reinterpret_cast<const uint4*>(p.hbuf + (size_t)t * DM + gl * 16 + 8);
      float x[16];
      x[0] = bflo(a.x); x[1] = bfhi(a.x); x[2] = bflo(a.y); x[3] = bfhi(a.y); x[4] = bflo(a.z); x[5] = bfhi(a.z); x[6] = bflo(a.w); x[7] = bfhi(a.w);
      x[8] = bflo(b.x); x[9] = bfhi(b.x); x[10] = bflo(b.y); x[11] = bfhi(b.y); x[12] = bflo(b.z); x[13] = bfhi(b.z); x[14] = bflo(b.w); x[15] = bfhi(b.w);
#pragma unroll
      for (int term = 0; term < 3; ++term) {
        float mx = 0.f;
#pragma unroll
        for (int q = 0; q < 16; ++q) mx = fmaxf(mx, fabsf(x[q]));
        mx = fmaxf(mx, __int_as_float(__builtin_amdgcn_update_dpp(0, __float_as_int(mx), DPP_QP_1032, 0xf, 0xf, true)));
        const unsigned yb = __float_as_uint(mx * (1.0f / 6.0f));
        unsigned eb = ((yb >> 23) & 0xFFu) + ((yb & 0x7FFFFFu) ? 1u : 0u);
        eb = eb < 1u ? 1u : (eb > 254u ? 254u : eb);
        if (mx == 0.f) eb = 127u;
        const float inv = __uint_as_float((254u - eb) << 23), sc = __uint_as_float(eb << 23);
        unsigned w0 = 0, w1 = 0;
#define Q4(q) w0 = __builtin_amdgcn_cvt_scalef32_pk_fp4_f32(w0, x[2 * q] * inv, x[2 * q + 1] * inv, 1.0f, q); \
               w1 = __builtin_amdgcn_cvt_scalef32_pk_fp4_f32(w1, x[8 + 2 * q] * inv, x[8 + 2 * q + 1] * inv, 1.0f, q);
        Q4(0) Q4(1) Q4(2) Q4(3)
#undef Q4
        uint2 o2; o2.x = w0; o2.y = w1;
        *reinterpret_cast<uint2*>(xq + term * 512 + lane * 8) = o2;
        if ((lane & 1) == 0) { const int bb = lane >> 1; xsc[term * 32 + (bb & 3) * 8 + (bb >> 2)] = (unsigned char)eb; }
        if (term < 2) {
#define R4(q) { const __attribute__((ext_vector_type(2))) float a2 = __builtin_amdgcn_cvt_scalef32_pk_f32_fp4(w0, 1.0f, q); \
                const __attribute__((ext_vector_type(2))) float b2 = __builtin_amdgcn_cvt_scalef32_pk_f32_fp4(w1, 1.0f, q); \
                x[2 * q] -= sc * a2.x; x[2 * q + 1] -= sc * a2.y; x[8 + 2 * q] -= sc * b2.x; x[8 + 2 * q + 1] -= sc * b2.y; }
          R4(0) R4(1) R4(2) R4(3)
#undef R4
        }
      }
      il[lane] = p.pidx[(size_t)t * 128 + gl];
      il[64 + lane] = p.pidx[(size_t)t * 128 + 64 + gl];
    }
    __builtin_amdgcn_wave_barrier();
#pragma unroll
    for (int i = 0; i < 4; ++i) {
      const int rr = il[i * 32 + (lane >> 1)];
      __builtin_amdgcn_global_load_lds((const unsigned*)(Vsc + (size_t)rr * 32 + (lane & 1) * 16), (unsigned*)(vscl + i * 1024 + lane * 16), 16, 0, 0);
    }
    f32x4 acc[8];
#pragma unroll
    for (int g = 0; g < 8; ++g) acc[g] = (f32x4){0.f, 0.f, 0.f, 0.f};
    {
      const int dr = lane >> 3, dpc = (lane & 7) ^ (lane >> 3);
      unsigned sclo[8], schi[8];
      unsigned xslo[3], xshi[3];
#pragma unroll
      for (int term = 0; term < 3; ++term) { const uint2 s2 = *reinterpret_cast<const uint2*>(xsc + term * 32 + fq * 8); xslo[term] = s2.x; xshi[term] = s2.y; }
#pragma unroll
      for (int g = 0; g < 8; ++g) {
        const uint2 s2 = *reinterpret_cast<const uint2*>(Usc + (size_t)il[g * 16 + fr] * 32 + fq * 8);
        sclo[g] = s2.x; schi[g] = s2.y;
      }
      const int rd0 = fr * 128 + ((fq ^ (fr & 7)) * 16), rd1 = fr * 128 + (((4 + fq) ^ (fr & 7)) * 16);
#define P4_ISSUE(tile_c, tile_g, slot) do { \
        const unsigned _o0 = (unsigned)il[(tile_g) * 16 + dr] * 512u + (unsigned)dpc * 16u + (unsigned)((tile_c) * 128); \
        const unsigned _o1 = (unsigned)il[(tile_g) * 16 + 8 + dr] * 512u + (unsigned)dpc * 16u + (unsigned)((tile_c) * 128); \
        __builtin_amdgcn_global_load_lds((const unsigned*)(U + _o0), (unsigned*)(ring + (slot) * 2048 + lane * 16), 16, 0, 0); \
        __builtin_amdgcn_global_load_lds((const unsigned*)(U + _o1), (unsigned*)(ring + (slot) * 2048 + 1024 + lane * 16), 16, 0, 0); } while (0)
#define P4_WAITV(n) asm volatile("s_waitcnt vmcnt(" #n ")" ::: "memory")
      P4_ISSUE(0, 0, 0); P4_ISSUE(0, 1, 1); P4_ISSUE(0, 2, 2); P4_ISSUE(0, 3, 3); P4_ISSUE(0, 4, 4); P4_ISSUE(0, 5, 5);
#pragma unroll 1
      for (int c = 0; c < 4; ++c) {
        i32x8 xb[3][2];
#pragma unroll
        for (int term = 0; term < 3; ++term)
#pragma unroll
          for (int m2 = 0; m2 < 2; ++m2) {
            const uint4 x4 = *reinterpret_cast<const uint4*>(xq + term * 512 + (c * 8 + m2 * 4 + fq) * 16);
            xb[term][m2] = (i32x8){(int)x4.x, (int)x4.y, (int)x4.z, (int)x4.w, 0, 0, 0, 0};
          }
        const int xs0 = (c < 2) ? (int)xslo[0] : (int)xshi[0], xs1 = (c < 2) ? (int)xslo[1] : (int)xshi[1], xs2 = (c < 2) ? (int)xslo[2] : (int)xshi[2];
#pragma unroll
        for (int g = 0; g < 8; ++g) {
          const int ti = c * 8 + g;
          if (c < 3 || g < 3) P4_WAITV(10);
          else if (g == 3) P4_WAITV(8);
          else if (g == 4) P4_WAITV(6);
          else if (g == 5) P4_WAITV(4);
          else if (g == 6) P4_WAITV(2);
          else P4_WAITV(0);
          const int slot = ti % 6;
          const uint4 a0v = *reinterpret_cast<const uint4*>(ring + slot * 2048 + rd0);
          const uint4 a1v = *reinterpret_cast<const uint4*>(ring + slot * 2048 + rd1);
          asm volatile("s_waitcnt lgkmcnt(0)" ::: "memory");
          if (ti + 6 < 32) P4_ISSUE((ti + 6) >> 3, (g + 6) & 7, slot);
          const i32x8 A0 = (i32x8){(int)a0v.x, (int)a0v.y, (int)a0v.z, (int)a0v.w, 0, 0, 0, 0};
          const i32x8 A1 = (i32x8){(int)a1v.x, (int)a1v.y, (int)a1v.z, (int)a1v.w, 0, 0, 0, 0};
          const int sreg = (c < 2) ? (int)sclo[g] : (int)schi[g];
          if ((c & 1) == 0) {
            acc[g] = __builtin_amdgcn_mfma_scale_f32_16x16x128_f8f6f4(A0, xb[0][0], acc[g], 4, 4, 0, sreg, 0, xs0);
            acc[g] = __builtin_amdgcn_mfma_scale_f32_16x16x128_f8f6f4(A1, xb[0][1], acc[g], 4, 4, 1, sreg, 1, xs0);
            acc[g] = __builtin_amdgcn_mfma_scale_f32_16x16x128_f8f6f4(A0, xb[1][0], acc[g], 4, 4, 0, sreg, 0, xs1);
            acc[g] = __builtin_amdgcn_mfma_scale_f32_16x16x128_f8f6f4(A1, xb[1][1], acc[g], 4, 4, 1, sreg, 1, xs1);
            acc[g] = __builtin_amdgcn_mfma_scale_f32_16x16x128_f8f6f4(A0, xb[2][0], acc[g], 4, 4, 0, sreg, 0, xs2);
            acc[g] = __builtin_amdgcn_mfma_scale_f32_16x16x128_f8f6f4(A1, xb[2][1], acc[g], 4, 4, 1, sreg, 1, xs2);
          } else {
            acc[g] = __builtin_amdgcn_mfma_scale_f32_16x16x128_f8f6f4(A0, xb[0][0], acc[g], 4, 4, 2, sreg, 2, xs0);
            acc[g] = __builtin_amdgcn_mfma_scale_f32_16x16x128_f8f6f4(A1, xb[0][1], acc[g], 4, 4, 3, sreg, 3, xs0);
            acc[g] = __builtin_amdgcn_mfma_scale_f32_16x16x128_f8f6f4(A0, xb[1][0], acc[g], 4, 4, 2, sreg, 2, xs1);
            acc[g] = __builtin_amdgcn_mfma_scale_f32_16x16x128_f8f6f4(A1, xb[1][1], acc[g], 4, 4, 3, sreg, 3, xs1);
            acc[g] = __builtin_amdgcn_mfma_scale_f32_16x16x128_f8f6f4(A0, xb[2][0], acc[g], 4, 4, 2, sreg, 2, xs2);
            acc[g] = __builtin_amdgcn_mfma_scale_f32_16x16x128_f8f6f4(A1, xb[2][1], acc[g], 4, 4, 3, sreg, 3, xs2);
          }
          __builtin_amdgcn_sched_barrier(0);
        }
      }
#undef P4_ISSUE
    }
#pragma unroll
    for (int g = 0; g < 8; ++g) {
      const float4 gt = *reinterpret_cast<const float4*>(p.pgate + (size_t)t * 128 + g * 16 + fq * 4);
      float4 wv;
      wv.x = gt.x * gelu_exact(acc[g][0]);
      wv.y = gt.y * gelu_exact(acc[g][1]);
      wv.z = gt.z * gelu_exact(acc[g][2]);
      wv.w = gt.w * gelu_exact(acc[g][3]);
      if (fr == 0) *reinterpret_cast<float4*>(wgt + g * 16 + fq * 4) = wv;
    }
    __builtin_amdgcn_wave_barrier();
    float f[16];
#pragma unroll
    for (int e = 0; e < 16; ++e) f[e] = 0.f;
    {
      const int lane = tidx(gwid) & 63;
#define P4V_ISSUE(pp, slot) do { const int _idx = il[2 * (pp) + (lane >> 5)]; \
        __builtin_amdgcn_global_load_lds((const unsigned*)(V + (size_t)_idx * 512 + (lane & 31) * 16), (unsigned*)(ring + (slot) * 1024 + lane * 16), 16, 0, 0); } while (0)
#define P4V_ROW(ee, slot) do { \
        const uint2 cv = *reinterpret_cast<const uint2*>(ring + (slot) * 1024 + ((ee) & 1) * 512 + lane * 8); \
        const unsigned sb = vscl[(ee) * 32 + (lane >> 1)]; \
        const float ws = wgt[ee] * __uint_as_float(sb << 23); \
        P4V_Q(0) P4V_Q(1) P4V_Q(2) P4V_Q(3) } while (0)
#define P4V_Q(q) { const __attribute__((ext_vector_type(2))) float a2 = __builtin_amdgcn_cvt_scalef32_pk_f32_fp4(cv.x, 1.0f, q); \
          const __attribute__((ext_vector_type(2))) float b2 = __builtin_amdgcn_cvt_scalef32_pk_f32_fp4(cv.y, 1.0f, q); \
          f[2 * q] += ws * a2.x; f[2 * q + 1] += ws * a2.y; f[8 + 2 * q] += ws * b2.x; f[8 + 2 * q + 1] += ws * b2.y; }
#pragma unroll
      for (int k = 0; k < 12; ++k) P4V_ISSUE(k, k);
#pragma unroll 1
      for (int pb = 0; pb < 4; ++pb) {
#pragma unroll
        for (int k = 0; k < 12; ++k) {
          const int pp = pb * 12 + k;
          P4_WAITV(11);
          P4V_ROW(2 * pp, k);
          P4V_ROW(2 * pp + 1, k);
          asm volatile("s_waitcnt lgkmcnt(0)" ::: "memory");
          P4V_ISSUE(pp + 12, k);
        }
      }
#pragma unroll
      for (int k = 0; k < 4; ++k) {
        const int pp = 48 + k;
        P4_WAITV(11);
        P4V_ROW(2 * pp, k);
        P4V_ROW(2 * pp + 1, k);
        asm volatile("s_waitcnt lgkmcnt(0)" ::: "memory");
        P4V_ISSUE(pp + 12, k);
      }
#define P4V_TAIL(pp, slot, n) P4_WAITV(n); P4V_ROW(2 * (pp), slot); P4V_ROW(2 * (pp) + 1, slot);
      P4V_TAIL(52, 4, 11) P4V_TAIL(53, 5, 10) P4V_TAIL(54, 6, 9) P4V_TAIL(55, 7, 8) P4V_TAIL(56, 8, 7) P4V_TAIL(57, 9, 6)
      P4V_TAIL(58, 10, 5) P4V_TAIL(59, 11, 4) P4V_TAIL(60, 0, 3) P4V_TAIL(61, 1, 2) P4V_TAIL(62, 2, 1) P4V_TAIL(63, 3, 0)
#undef P4V_TAIL
#undef P4V_ISSUE
#undef P4V_ROW
#undef P4V_Q
#undef P4_WAITV
    }
    const int gl2 = tidx(gwid) & 63;
    const bool next_attn = (layer == 0 || layer == 2);
    const float* mdn = p.mod + ((size_t)(layer + 1) * 9 + cond_of_row(t)) * 6144;
    const float* md = p.mod + ((size_t)layer * 9 + cond_of_row(t)) * 6144 + 5 * 1024;
    float zz[16];
    float s = 0.f;
#pragma unroll
    for (int q = 0; q < 4; ++q) {
      const int col = gl2 * 16 + q * 4;
      const float4 x0 = *reinterpret_cast<const float4*>(p.xbuf + (size_t)t * DM + col);
      const float4 g0 = *reinterpret_cast<const float4*>(md + col);
      zz[q * 4 + 0] = ALPHA_F * x0.x + g0.x * f[q * 4 + 0];
      zz[q * 4 + 1] = ALPHA_F * x0.y + g0.y * f[q * 4 + 1];
      zz[q * 4 + 2] = ALPHA_F * x0.z + g0.z * f[q * 4 + 2];
      zz[q * 4 + 3] = ALPHA_F * x0.w + g0.w * f[q * 4 + 3];
      s += zz[q * 4] + zz[q * 4 + 1] + zz[q * 4 + 2] + zz[q * 4 + 3];
    }
    const float mean = wave_sum(s) * (1.0f / 1024.0f);
    float sv = 0.f;
#pragma unroll
    for (int e = 0; e < 16; ++e) { float d = zz[e] - mean; sv += d * d; }
    const float rstd = rsqrtf(wave_sum(sv) * (1.0f / 1024.0f) + LN_EPS_F);
#pragma unroll
    for (int q = 0; q < 4; ++q) {
      const int col = gl2 * 16 + q * 4;
      const float4 g0 = *reinterpret_cast<const float4*>(lng + col);
      const float4 b0 = *reinterpret_cast<const float4*>(lnb + col);
      float4 o0;
      o0.x = (zz[q * 4 + 0] - mean) * rstd * g0.x + b0.x;
      o0.y = (zz[q * 4 + 1] - mean) * rstd * g0.y + b0.y;
      o0.z = (zz[q * 4 + 2] - mean) * rstd * g0.z + b0.z;
      o0.w = (zz[q * 4 + 3] - mean) * rstd * g0.w + b0.w;
      *reinterpret_cast<float4*>(xout + (size_t)t * DM + col) = o0;
      if (next_attn) {
        const float4 sh = *reinterpret_cast<const float4*>(mdn + col);
        const float4 sc = *reinterpret_cast<const float4*>(mdn + 1024 + col);
        uint2 hb;
        hb.x = pack2(o0.x * (1.0f + sc.x) + sh.x, o0.y * (1.0f + sc.y) + sh.y);
        hb.y = pack2(o0.z * (1.0f + sc.z) + sh.z, o0.w * (1.0f + sc.w) + sh.w);
        *reinterpret_cast<uint2*>(p.hbuf + (size_t)t * DM + col) = hb;
      }
    }
  }
}

DEVINL void phase_a1(const Params& p, int layer, int w, int nw, int gwid) {
  const int lane = tidx(gwid) & 63;
  const int gw = w * NWAVES + (tidx(gwid) >> 6), ngw = nw * NWAVES;
  for (int row = gw; row < TT; row += ngw) {
    const float* md = p.mod + ((size_t)layer * 9 + cond_of_row(row)) * 6144;
#pragma unroll
    for (int k = 0; k < 4; ++k) {
      const int col = k * 256 + lane * 4;
      const float4 x = *reinterpret_cast<const float4*>(p.xbuf + (size_t)row * DM + col);
      const float4 sh = *reinterpret_cast<const float4*>(md + col);
      const float4 sc = *reinterpret_cast<const float4*>(md + 1024 + col);
      uint2 o;
      o.x = pack2(x.x * (1.0f + sc.x) + sh.x, x.y * (1.0f + sc.y) + sh.y);
      o.y = pack2(x.z * (1.0f + sc.z) + sh.z, x.w * (1.0f + sc.w) + sh.w);
      *reinterpret_cast<uint2*>(p.hbuf + (size_t)row * DM + col) = o;
    }
  }
}

DEVINL void phase_a2(const Params& p, int layer, int w, int nw, char* smem, int gwid) {
  const int j = layer >> 1;
  EpiBf16 E; E.O = reinterpret_cast<bf16_t*>(p.U1); E.ldc = 1536;
  pg8::ASelOne as; as.A = (const char*)p.hbuf;
  pg8::StaticOrder S; S.init(TT, 1536, nw, w);
  pg8::gemm_phase<EpiBf16, pg8::ASelOne>((PG8_LAS unsigned char*)smem, as, p.attn_wqkv_t + (size_t)j * 1536 * 1024, 1024, S, E, gwid);
}

DEVINL void load16(const bf16_t* src, float (&x)[16]) {
  const uint4 a = *reinterpret_cast<const uint4*>(src);
  const uint4 b = *reinterpret_cast<const uint4*>(src + 8);
  x[0] = bflo(a.x); x[1] = bfhi(a.x); x[2] = bflo(a.y); x[3] = bfhi(a.y); x[4] = bflo(a.z); x[5] = bfhi(a.z); x[6] = bflo(a.w); x[7] = bfhi(a.w);
  x[8] = bflo(b.x); x[9] = bfhi(b.x); x[10] = bflo(b.y); x[11] = bfhi(b.y); x[12] = bflo(b.z); x[13] = bfhi(b.z); x[14] = bflo(b.w); x[15] = bfhi(b.w);
}
DEVINL void store16bf(bf16_t* dst, const float (&x)[16]) {
  uint4 a, b;
  a.x = pack2(x[0], x[1]); a.y = pack2(x[2], x[3]); a.z = pack2(x[4], x[5]); a.w = pack2(x[6], x[7]);
  b.x = pack2(x[8], x[9]); b.y = pack2(x[10], x[11]); b.z = pack2(x[12], x[13]); b.w = pack2(x[14], x[15]);
  *reinterpret_cast<uint4*>(dst) = a; *reinterpret_cast<uint4*>(dst + 8) = b;
}
DEVINL void headnorm_rope(float (&x)[16], const float* nwgt, int quarter, bool lat, int t, const float* rope) {
  float ss = 0.f;
#pragma unroll
  for (int e = 0; e < 16; ++e) ss += x[e] * x[e];
  ss += __shfl_xor(ss, 1); ss += __shfl_xor(ss, 2);
  const float rinv = rsqrtf(ss * (1.0f / 64.0f) + RMS_EPS_F);
#pragma unroll
  for (int e = 0; e < 16; ++e) x[e] = x[e] * rinv * nwgt[quarter * 16 + e];
  if (lat) {
    const int pos = (quarter < 2) ? (t >> 6) : (t & 63);
    const bool hi = quarter & 1;
#pragma unroll
    for (int e = 0; e < 16; ++e) {
      const float other = __shfl_xor(x[e], 1);
      const float c = rope[(pos * 16 + e) * 2], s = rope[(pos * 16 + e) * 2 + 1];
      x[e] = hi ? (x[e] * c + other * s) : (x[e] * c - other * s);
    }
  }
}

DEVINL void phase_a2b(const Params& p, int layer, int w, int nw, int gwid) {
  const int j = layer >> 1;
  const int lane = tidx(gwid) & 63;
  const int gw = w * NWAVES + (tidx(gwid) >> 6), ngw = nw * NWAVES;
  const bf16_t* qkv = reinterpret_cast<const bf16_t*>(p.U1);
  bf16_t* qb = reinterpret_cast<bf16_t*>(p.U2);
  const float* qn = p.in[29] + j * 64;
  const float* kn = p.in[30] + j * 64;
  for (int row = gw; row < TT; row += ngw) {
    const bool lat = row >= TCTX;
    const int t = lat ? ((row - TCTX) & 1023) : (row & 255);
    const int b = lat ? ((row - TCTX) >> 10) : (row >> 8);
    const bf16_t* src = qkv + (size_t)row * 1536;
    {
      float x[16];
      load16(src + lane * 16, x);
      headnorm_rope(x, qn, lane & 3, lat, t, p.rope);
#pragma unroll
      for (int e = 0; e < 16; ++e) x[e] *= QSCALE_F;
      store16bf(qb + (size_t)row * DM + lane * 16, x);
    }
    if (lane < 16) {
      const int kvh = lane >> 2, quarter = lane & 3;
      float x[16];
      load16(src + 1024 + lane * 16, x);
      headnorm_rope(x, kn, quarter, false, t, p.rope);
      if (lat) {
        const int pos = (quarter < 2) ? (t >> 6) : (t & 63);
        const bool hi = quarter & 1;
#pragma unroll
        for (int e = 0; e < 16; ++e) {
          const float other = __shfl_xor(x[e], 1);
          const float c = p.rope[(pos * 16 + e) * 2], s = p.rope[(pos * 16 + e) * 2 + 1];
          x[e] = hi ? (x[e] * c + other * s) : (x[e] * c - other * s);
        }
        store16bf(p.Klat + ((size_t)((j * 8 + b) * 4 + kvh) * 1536 + 512 + t) * 64 + quarter * 16, x);
      } else {
        store16bf(p.Kctx + ((size_t)((j * 16 + b) * 4 + kvh) * 256 + t) * 64 + quarter * 16, x);
        float* ko = p.out + OUT_CK + ((size_t)(b * 2 + j) * 256 + t) * 256 + kvh * 64 + quarter * 16;
#pragma unroll
        for (int q4 = 0; q4 < 4; ++q4) reinterpret_cast<float4*>(ko)[q4] = make_float4(x[q4 * 4], x[q4 * 4 + 1], x[q4 * 4 + 2], x[q4 * 4 + 3]);
      }
    } else if (lane < 32) {
      const int l2 = lane - 16;
      const int kvh = l2 >> 2, quarter = l2 & 3;
      float x[16];
      load16(src + 1280 + l2 * 16, x);
      if (lat) {
        bf16_t* vd = p.VlatT + (size_t)((j * 8 + b) * 4 + kvh) * 64 * 1536 + 512 + t;
#pragma unroll
        for (int e = 0; e < 16; ++e) vd[(size_t)(quarter * 16 + e) * 1536] = f2bf(x[e]);
      } else {
        bf16_t* vd = p.VctxT + (size_t)((j * 16 + b) * 4 + kvh) * 64 * 256 + t;
#pragma unroll
        for (int e = 0; e < 16; ++e) vd[(size_t)(quarter * 16 + e) * 256] = f2bf(x[e]);
        float* vo = p.out + OUT_CV + ((size_t)(b * 2 + j) * 256 + t) * 256 + kvh * 64 + quarter * 16;
#pragma unroll
        for (int q4 = 0; q4 < 4; ++q4) reinterpret_cast<float4*>(vo)[q4] = make_float4(x[q4 * 4], x[q4 * 4 + 1], x[q4 * 4 + 2], x[q4 * 4 + 3]);
      }
    }
  }
}

DEVINL void phase_a3(const Params& p, int layer, int w, int nw, char* smem, int gwid) {
  const int j = layer >> 1;
  const int lane = tidx(gwid) & 63, wid = __builtin_amdgcn_readfirstlane(tidx(gwid) >> 6);
  const int ql = lane & 31, hh = lane >> 5;
  const bf16_t* qb = reinterpret_cast<const bf16_t*>(p.U2);
  const int drow = wid * 8 + (lane >> 3);
  const int dsp = (lane & 7) ^ ((lane >> 3) & 7);
  for (int item = w; item < 768; item += nw) {
    int kvh, Tk, row0;
    const bf16_t *Kb, *Vt;
    if (item < 512) {
      const int b = item >> 6, qblk = item & 15;
      kvh = (item >> 4) & 3;
      Kb = p.Klat + (size_t)((j * 8 + b) * 4 + kvh) * 1536 * 64;
      Vt = p.VlatT + (size_t)((j * 8 + b) * 4 + kvh) * 64 * 1536;
      Tk = 1536; row0 = TCTX + b * 1024 + qblk * 64;
    } else {
      const int it = item - 512;
      const int b = it >> 4, qblk = it & 3;
      kvh = (it >> 2) & 3;
      Kb = p.Kctx + (size_t)((j * 16 + b) * 4 + kvh) * 256 * 64;
      Vt = p.VctxT + (size_t)((j * 16 + b) * 4 + kvh) * 64 * 256;
      Tk = 256; row0 = b * 256 + qblk * 64;
    }
    const int hq = kvh * 4 + (wid >> 1);
    const int qrow = row0 + (wid & 1) * 32 + ql;
    bf16x8 bq[4];
#pragma unroll
    for (int ks = 0; ks < 4; ++ks) bq[ks] = *reinterpret_cast<const bf16x8*>(qb + (size_t)qrow * DM + hq * 64 + ks * 16 + hh * 8);
    f32x16 o0, o1;
#pragma unroll
    for (int r = 0; r < 16; ++r) { o0[r] = 0.f; o1[r] = 0.f; }
    float mrun = -1e30f, lrun = 0.f;
    const int ntile = Tk >> 6;
#define A3_DMA(kt_, st_) do { \
      __builtin_amdgcn_global_load_lds((const unsigned*)(Kb + (size_t)((kt_) * 64 + drow) * 64 + dsp * 8), (unsigned*)(smem + (st_) * 16384 + wid * 1024 + lane * 16), 16, 0, 0); \
      __builtin_amdgcn_global_load_lds((const unsigned*)(Vt + (size_t)drow * Tk + (kt_) * 64 + dsp * 8), (unsigned*)(smem + (st_) * 16384 + 8192 + wid * 1024 + lane * 16), 16, 0, 0); } while (0)
    __syncthreads();
    A3_DMA(0, 0);
    for (int kt = 0; kt < ntile; ++kt) {
      asm volatile("s_waitcnt vmcnt(0)" ::: "memory");
      __syncthreads();
      if (kt + 1 < ntile) A3_DMA(kt + 1, (kt + 1) & 1);
      const char* Kt_ = smem + (kt & 1) * 16384;
      const char* Vt_ = Kt_ + 8192;
      f32x16 sacc[2];
#pragma unroll
      for (int kb2 = 0; kb2 < 2; ++kb2) {
#pragma unroll
        for (int r = 0; r < 16; ++r) sacc[kb2][r] = 0.f;
        const int r_ = kb2 * 32 + ql;
#pragma unroll
        for (int ks = 0; ks < 4; ++ks) {
          const bf16x8 ka = *reinterpret_cast<const bf16x8*>(Kt_ + r_ * 128 + (((ks * 2 + hh) ^ (r_ & 7)) * 16));
          sacc[kb2] = __builtin_amdgcn_mfma_f32_32x32x16_bf16(ka, bq[ks], sacc[kb2], 0, 0, 0);
        }
      }
      float tmax = sacc[0][0];
#pragma unroll
      for (int r = 1; r < 16; ++r) tmax = fmaxf(tmax, sacc[0][r]);
#pragma unroll
      for (int r = 0; r < 16; ++r) tmax = fmaxf(tmax, sacc[1][r]);
      tmax = fmaxf(tmax, __shfl_xor(tmax, 32));
      const float mnew = fmaxf(mrun, tmax);
      const float corr = exp2f(mrun - mnew);
      mrun = mnew;
      lrun *= corr;
#pragma unroll
      for (int r = 0; r < 16; ++r) { o0[r] *= corr; o1[r] *= corr; }
#pragma unroll
      for (int kb2 = 0; kb2 < 2; ++kb2) {
        float pv[16];
#pragma unroll
        for (int r = 0; r < 16; ++r) { pv[r] = exp2f(sacc[kb2][r] - mnew); lrun += pv[r]; }
#pragma unroll
        for (int s2 = 0; s2 < 2; ++s2) {
          union { bf16x8 v; unsigned u[4]; } pb;
#pragma unroll
          for (int q = 0; q < 4; ++q) pb.u[q] = pack2(pv[s2 * 8 + q * 2], pv[s2 * 8 + q * 2 + 1]);
          const int P1 = 4 * kb2 + 2 * s2;
#pragma unroll
          for (int dblk = 0; dblk < 2; ++dblk) {
            const int r_ = dblk * 32 + ql;
            const uint2 lo = *reinterpret_cast<const uint2*>(Vt_ + r_ * 128 + ((P1 ^ (r_ & 7)) * 16) + 8 * hh);
            const uint2 hi = *reinterpret_cast<const uint2*>(Vt_ + r_ * 128 + (((P1 + 1) ^ (r_ & 7)) * 16) + 8 * hh);
            union { bf16x8 v; unsigned u[4]; } va;
            va.u[0] = lo.x; va.u[1] = lo.y; va.u[2] = hi.x; va.u[3] = hi.y;
            if (dblk == 0) o0 = __builtin_amdgcn_mfma_f32_32x32x16_bf16(va.v, pb.v, o0, 0, 0, 0);
            else o1 = __builtin_amdgcn_mfma_f32_32x32x16_bf16(va.v, pb.v, o1, 0, 0, 0);
          }
        }
      }
    }
#undef A3_DMA
    const float ltot = lrun + __shfl_xor(lrun, 32);
    const float inv = 1.0f / ltot;
#pragma unroll
    for (int g = 0; g < 4; ++g) {
      uint2 oa, ob;
      oa.x = pack2(o0[4 * g] * inv, o0[4 * g + 1] * inv); oa.y = pack2(o0[4 * g + 2] * inv, o0[4 * g + 3] * inv);
      ob.x = pack2(o1[4 * g] * inv, o1[4 * g + 1] * inv); ob.y = pack2(o1[4 * g + 2] * inv, o1[4 * g + 3] * inv);
      *reinterpret_cast<uint2*>(p.abuf + (size_t)qrow * DM + hq * 64 + 8 * g + 4 * hh) = oa;
      *reinterpret_cast<uint2*>(p.abuf + (size_t)qrow * DM + hq * 64 + 32 + 8 * g + 4 * hh) = ob;
    }
  }
}

#define XB_TMO      128
#define XB_XCNT(j)  (256  + 64 * (j))
#define XB_XSUB(j)  (1280 + 64 * (j))
#define XB_XGEN(j)  (2304 + 64 * (j))
#define XB_TOP      3328
#define XB_TOPGEN   3392
#define XCD_BAR_WORDS 3456
#define XB_SPIN_CAP (1u << 22)
#define LAS __attribute__((address_space(3)))

DEVINL unsigned xb_ld(unsigned* p) { return __hip_atomic_load(p, __ATOMIC_RELAXED, __HIP_MEMORY_SCOPE_AGENT); }
DEVINL unsigned xb_add(unsigned* p, unsigned v) { return __hip_atomic_fetch_add(p, v, __ATOMIC_RELAXED, __HIP_MEMORY_SCOPE_AGENT); }
DEVINL unsigned xb_xcc_id() { return (unsigned)__builtin_amdgcn_s_getreg((3 << 11) | 20) & 0xFu; }
#define XB_SPIN(cond, bar) do { unsigned _sp = 0; while (cond) { __builtin_amdgcn_s_sleep(1); \
    if ((++_sp & 255u) == 0u) { if (xb_ld(&(bar)[XB_TMO])) break; if (_sp > XB_SPIN_CAP) { atomicAdd(&(bar)[XB_TMO], 1u); break; } } } } while (0)

struct XcdBarrier { unsigned* bar; unsigned x; volatile LAS unsigned* st; };

DEVINL XcdBarrier xcd_barrier_post(unsigned* bar, volatile LAS unsigned* st) {
  XcdBarrier b; b.bar = bar; b.x = xb_xcc_id(); b.st = st;
  if (threadIdx.x == 0) (void)xb_add(&bar[XB_XCNT(b.x)], 1u);
  return b;
}
DEVINL void xcd_barrier_complete(unsigned* bar, unsigned x, unsigned& nloc, unsigned& nx) {
  const unsigned G = gridDim.x * gridDim.y * gridDim.z;
  unsigned sum, cnt, mine, sp = 0u;
  for (;;) {
    sum = 0u; cnt = 0u; mine = 0u;
#pragma unroll
    for (unsigned j = 0; j < 16; ++j) { const unsigned c = xb_ld(&bar[XB_XCNT(j)]); sum += c; cnt += (c > 0u) ? 1u : 0u; mine = (j == x) ? c : mine; }
    if (sum == G) break;
    __builtin_amdgcn_s_sleep(1);
    if ((++sp & 255u) == 0u) { if (xb_ld(&bar[XB_TMO])) break; if (sp > XB_SPIN_CAP) { atomicAdd(&bar[XB_TMO], 1u); break; } }
  }
  nloc = mine > 0u ? mine : 1u; nx = cnt > 0u ? cnt : 1u;
}
DEVINL void xcd_barrier(const XcdBarrier& b) {
  asm volatile("s_waitcnt vmcnt(0)" ::: "memory");
  __syncthreads();
  if (threadIdx.x == 0) {
    unsigned* bar = b.bar;
    __builtin_amdgcn_s_waitcnt(0);
    unsigned nloc = b.st[0], nx = b.st[1];
    if (nloc == 0u) { xcd_barrier_complete(bar, b.x, nloc, nx); b.st[0] = nloc; b.st[1] = nx; }
    const unsigned old = xb_add(&bar[XB_XSUB(b.x)], 1u);
    const unsigned gen = old / nloc;
    if (old + 1u == (gen + 1u) * nloc) {
      __builtin_amdgcn_fence(__ATOMIC_RELEASE, "agent");
      asm volatile("s_waitcnt vmcnt(0)" ::: "memory");
      const unsigned og = xb_add(&bar[XB_TOP], 1u);
      const unsigned tg = og / nx;
      if (og + 1u == (tg + 1u) * nx) xb_add(&bar[XB_TOPGEN], 1u);
      else XB_SPIN(xb_ld(&bar[XB_TOPGEN]) == tg, bar);
      __builtin_amdgcn_fence(__ATOMIC_ACQUIRE, "agent");
      xb_add(&bar[XB_XGEN(b.x)], 1u);
      asm volatile("s_waitcnt vmcnt(0)" ::: "memory");
    } else {
      XB_SPIN(xb_ld(&bar[XB_XGEN(b.x)]) == gen, bar);
      __builtin_amdgcn_fence(__ATOMIC_ACQUIRE, "agent");
      asm volatile("s_waitcnt vmcnt(0)" ::: "memory");
    }
  }
  __syncthreads();
}

extern __shared__ __attribute__((aligned(16))) char dyn_smem[];
__global__ void __launch_bounds__(NTHREADS, 2) mega_kernel(Params p) {
  char* smem = dyn_smem;
  cg::grid_group grid = cg::this_grid();
  const int w = blockIdx.x, nw = gridDim.x;
  const int gwid = __builtin_amdgcn_readfirstlane((int)(threadIdx.x >> 6));
  if (p.use_cg_sync) grid.sync();
  volatile LAS unsigned* xst = (volatile LAS unsigned*)(smem + SMEM_BYTES - 16);
  if (threadIdx.x == 0) { xst[0] = 0u; xst[1] = 0u; }
  __syncthreads();
  XcdBarrier xb = xcd_barrier_post(p.bar, xst);
#define GSYNC() xcd_barrier(xb)
#ifndef REP_PREP
#define REP_PREP 1
#endif
#ifndef REP_R4
#define REP_R4 1
#endif
#ifndef REP_P3
#define REP_P3 1
#endif
#ifndef REP_P4L3
#define REP_P4L3 1
#endif
#ifndef REP_A3
#define REP_A3 1
#endif
#ifndef REP_GEMM
#define REP_GEMM 1
#endif
#ifndef REP_SG
#define REP_SG 1
#endif
#ifndef REP_EW
#define REP_EW 1
#endif
  for (int rep = 0; rep < REP_PREP; ++rep) { phase_prep(p, w, nw, smem, gwid); GSYNC(); }
  for (int layer = 0; layer < 4; ++layer) {
    if ((layer & 1) == 0) {
      for (int rep = 0; rep < REP_EW; ++rep) { phase_r1(p, layer, w, nw, gwid); GSYNC(); }
      for (int rep = 0; rep < REP_GEMM; ++rep) { phase_r2(p, layer, w, nw, smem, gwid); GSYNC(); }
      for (int rep = 0; rep < REP_SG; ++rep) { phase_r3(p, layer, w, nw, smem, gwid); GSYNC(); }
      for (int rep = 0; rep < REP_R4; ++rep) { phase_r4(p, layer, w, nw, smem, gwid); GSYNC(); }
      for (int rep = 0; rep < REP_EW; ++rep) { phase_r5(p, layer, w, nw, gwid); GSYNC(); }
    } else {
      for (int rep = 0; rep < REP_GEMM; ++rep) { phase_a2(p, layer, w, nw, smem, gwid); GSYNC(); }
      for (int rep = 0; rep < REP_EW; ++rep) { phase_a2b(p, layer, w, nw, gwid); GSYNC(); }
      for (int rep = 0; rep < REP_A3; ++rep) { phase_a3(p, layer, w, nw, smem, gwid); GSYNC(); }
    }
    for (int rep = 0; rep < REP_GEMM; ++rep) { phase_wo(p, layer, w, nw, smem, gwid); GSYNC(); }
    for (int rep = 0; rep < REP_EW; ++rep) { phase_ln1(p, layer, w, nw, gwid); GSYNC(); }
    for (int rep = 0; rep < REP_GEMM; ++rep) { phase_p1(p, layer, w, nw, smem, gwid); GSYNC(); }
    for (int rep = 0; rep < REP_P3; ++rep) { phase_p23(p, layer, w, nw, smem, gwid); GSYNC(); }
    for (int rep = 0; rep < (layer == 3 ? REP_P4L3 : 1); ++rep) { phase_p4(p, layer, w, nw, smem, gwid); GSYNC(); }
  }
}

static inline char* carve(char*& cur, size_t bytes) {
  char* r = cur;
  cur += (bytes + 255) & ~(size_t)255;
  return r;
}

extern "C" void kernel_launch(void* const* d_in, const int* in_sizes, int n_in, void* d_out, int out_size, void* d_ws,
                              size_t ws_size, hipStream_t stream) {
  Params p;
  memset(&p, 0, sizeof(p));
  for (int i = 0; i < 35; ++i) p.in[i] = (const float*)d_in[i];
  p.out = (float*)d_out;
  char* cur = (char*)d_ws;
  p.bar = (unsigned*)carve(cur, 16384);
  p.mod = (float*)carve(cur, (size_t)4 * 9 * 6144 * 4);
  p.rope = (float*)carve(cur, 64 * 16 * 2 * 4);
  p.rwkv_in_t = (bf16_t*)carve(cur, (size_t)2 * RW_N * 1024 * 2);
  p.w2t = (bf16_t*)carve(cur, (size_t)4 * 65536 * 2);
  p.a2t = (bf16_t*)carve(cur, (size_t)4 * 65536 * 2);
  p.g2t = (bf16_t*)carve(cur, (size_t)2 * 131072 * 2);
  p.rwkv_wo_t = (bf16_t*)carve(cur, (size_t)2 * 1048576 * 2);
  p.attn_wqkv_t = (bf16_t*)carve(cur, (size_t)2 * 1536 * 1024 * 2);
  p.attn_wo_t = (bf16_t*)carve(cur, (size_t)2 * 1048576 * 2);
  p.wq_t = (bf16_t*)carve(cur, (size_t)4 * 2048 * 1024 * 2);
  p.keysb = (bf16_t*)carve(cur, (size_t)4 * 2 * 128 * 128 * 2);
  p.ub = (bf16_t*)carve(cur, (size_t)4 * 16384 * 1024 * 2);
  p.vb = (bf16_t*)carve(cur, (size_t)4 * 16384 * 1024 * 2);
  p.uinv = (float*)carve(cur, (size_t)65536 * 4);
  p.vinv = (float*)carve(cur, (size_t)65536 * 4);
  p.Klat = (bf16_t*)carve(cur, (size_t)2 * 8 * 4 * 1536 * 64 * 2);
  p.VlatT = (bf16_t*)carve(cur, (size_t)2 * 8 * 4 * 1536 * 64 * 2);
  p.Kctx = (bf16_t*)carve(cur, (size_t)2 * 16 * 4 * 256 * 64 * 2);
  p.VctxT = (bf16_t*)carve(cur, (size_t)2 * 16 * 4 * 256 * 64 * 2);
  p.xbuf = (float*)carve(cur, (size_t)TT * DM * 4);
  p.zbuf = (float*)carve(cur, (size_t)TT * DM * 4);
  p.hbuf = (bf16_t*)carve(cur, (size_t)TT * DM * 2);
  p.abuf = (bf16_t*)carve(cur, (size_t)TT * DM * 2);
  p.U1 = carve(cur, (size_t)TT * DM * 14);
  p.U2 = carve(cur, (size_t)TT * DM * 8);
  p.U3 = carve(cur, (size_t)TT * DM * 8);
  p.pidx = (int*)carve(cur, (size_t)TT * 128 * 4);
  p.pgate = (float*)carve(cur, (size_t)TT * 128 * 4);
  for (int f = 0; f < 16; ++f) p.freqs[f] = pow(10000.0, -(double)f / 16.0);
  if ((size_t)(cur - (char*)d_ws) > ws_size) {
    fprintf(stderr, "workspace too small: need %zu have %zu\n", (size_t)(cur - (char*)d_ws), ws_size);
    return;
  }
  static int grid_blocks = 0;
  if (!grid_blocks) {
    int dev = 0, cus = 0, per_cu = 0;
    (void)hipGetDevice(&dev);
    (void)hipDeviceGetAttribute(&cus, hipDeviceAttributeMultiprocessorCount, dev);
    (void)hipFuncSetAttribute((const void*)mega_kernel, hipFuncAttributeMaxDynamicSharedMemorySize, SMEM_BYTES);
    (void)hipOccupancyMaxActiveBlocksPerMultiprocessor(&per_cu, mega_kernel, NTHREADS, SMEM_BYTES);
    if (per_cu > 1) per_cu = 1;
    if (per_cu < 1) per_cu = 1;
    grid_blocks = cus * per_cu;
  }
  (void)hipMemsetAsync(p.bar, 0, 16384, stream);
  void* args[] = {&p};
  hipError_t e = hipLaunchCooperativeKernel((void*)mega_kernel, dim3(grid_blocks), dim3(NTHREADS), args, SMEM_BYTES, stream);
  if (e != hipSuccess) fprintf(stderr, "cooperative launch failed: %s (grid %d)\n", hipGetErrorString(e), grid_blocks);
}
```

```cpp
#include <hip/hip_runtime.h>
#include <hip/hip_cooperative_groups.h>
#include <stdint.h>
#include <string.h>
#include <math.h>
#include <stdio.h>

namespace cg = cooperative_groups;

typedef unsigned short bf16_t;
typedef __attribute__((ext_vector_type(8))) short bf16x8;
typedef __attribute__((ext_vector_type(4))) float f32x4;
typedef __attribute__((ext_vector_type(16))) float f32x16;

#define DEVINL __device__ __forceinline__
#define NTHREADS 512
#define NWAVES 8
#define GEMM_LDS 131072
#define SMEM_BYTES 163840
#define RW_N 3840

#define DM 1024
#define TCTX 4096
#define TLAT 8192
#define TT 12288
#define ALPHA_F 1.681792830507429f
#define LN_EPS_F 1e-5f
#define GN_EPS_F 6.4e-4f
#define RMS_EPS_F 1e-6f
#define QSCALE_F (0.125f * 1.4426950408889634f)

#define OUT_Y 0
#define OUT_STATE 12582912
#define OUT_CK 16777216
#define OUT_CV 18874368

struct Params {
  const float* in[35];
  float* out;
  float* mod;
  float* rope;
  bf16_t* rwkv_in_t;
  bf16_t* w2t;
  bf16_t* a2t;
  bf16_t* g2t;
  bf16_t* rwkv_wo_t;
  bf16_t* attn_wqkv_t;
  bf16_t* attn_wo_t;
  bf16_t* wq_t;
  bf16_t* keysb;
  bf16_t* ub;
  bf16_t* vb;
  float* uinv;
  float* vinv;
  bf16_t* Klat;
  bf16_t* VlatT;
  bf16_t* Kctx;
  bf16_t* VctxT;
  float* xbuf;
  float* zbuf;
  bf16_t* hbuf;
  bf16_t* abuf;
  char* U1;
  char* U2;
  char* U3;
  int* pidx;
  float* pgate;
  double freqs[16];
  unsigned* bar;
  int use_cg_sync;
  int pad0;
};

DEVINL int lane_id() { return (int)__builtin_amdgcn_mbcnt_hi(~0u, __builtin_amdgcn_mbcnt_lo(~0u, 0u)); }
DEVINL int tidx(int gwid) {
  int l; asm volatile("v_mbcnt_lo_u32_b32 %0, -1, 0\n\tv_mbcnt_hi_u32_b32 %0, -1, %0" : "=v"(l));
  return gwid * 64 + l;
}
typedef __bf16 bf16v2_ __attribute__((ext_vector_type(2)));
typedef float f32v2_ __attribute__((ext_vector_type(2)));
DEVINL unsigned cvt_pk_bf16_(float lo, float hi) { f32v2_ v = {lo, hi}; bf16v2_ r = __builtin_convertvector(v, bf16v2_); return __builtin_bit_cast(unsigned, r); }
DEVINL bf16_t f2bf(float f) { return (bf16_t)(cvt_pk_bf16_(f, f) & 0xFFFFu); }
DEVINL float bf2f(bf16_t h) { return __uint_as_float(((unsigned)h) << 16); }
DEVINL unsigned pack2(float a, float b) { return cvt_pk_bf16_(a, b); }
DEVINL float bflo(unsigned u) { return __uint_as_float(u << 16); }
DEVINL float bfhi(unsigned u) { return __uint_as_float(u & 0xFFFF0000u); }

DEVINL unsigned umax_(unsigned a, unsigned b) { return a > b ? a : b; }
DEVINL unsigned umin_(unsigned a, unsigned b) { return a < b ? a : b; }
#define DPP_QP_1032 0xB1
#define DPP_QP_2301 0x4E
#define DPP_ROW_HALF_MIRROR 0x141
#define DPP_ROW_MIRROR 0x140
DEVINL unsigned row_max_u(unsigned v) {
  v = umax_(v, (unsigned)__builtin_amdgcn_update_dpp(0, (int)v, DPP_QP_1032, 0xf, 0xf, true));
  v = umax_(v, (unsigned)__builtin_amdgcn_update_dpp(0, (int)v, DPP_QP_2301, 0xf, 0xf, true));
  v = umax_(v, (unsigned)__builtin_amdgcn_update_dpp(0, (int)v, DPP_ROW_HALF_MIRROR, 0xf, 0xf, true));
  v = umax_(v, (unsigned)__builtin_amdgcn_update_dpp(0, (int)v, DPP_ROW_MIRROR, 0xf, 0xf, true));
  return v;
}
DEVINL float row_max_f(float v) {
  v = fmaxf(v, __int_as_float(__builtin_amdgcn_update_dpp(0, __float_as_int(v), DPP_QP_1032, 0xf, 0xf, true)));
  v = fmaxf(v, __int_as_float(__builtin_amdgcn_update_dpp(0, __float_as_int(v), DPP_QP_2301, 0xf, 0xf, true)));
  v = fmaxf(v, __int_as_float(__builtin_amdgcn_update_dpp(0, __float_as_int(v), DPP_ROW_HALF_MIRROR, 0xf, 0xf, true)));
  v = fmaxf(v, __int_as_float(__builtin_amdgcn_update_dpp(0, __float_as_int(v), DPP_ROW_MIRROR, 0xf, 0xf, true)));
  return v;
}
DEVINL float row_sum_f(float v) {
  v += __int_as_float(__builtin_amdgcn_update_dpp(0, __float_as_int(v), DPP_QP_1032, 0xf, 0xf, true));
  v += __int_as_float(__builtin_amdgcn_update_dpp(0, __float_as_int(v), DPP_QP_2301, 0xf, 0xf, true));
  v += __int_as_float(__builtin_amdgcn_update_dpp(0, __float_as_int(v), DPP_ROW_HALF_MIRROR, 0xf, 0xf, true));
  v += __int_as_float(__builtin_amdgcn_update_dpp(0, __float_as_int(v), DPP_ROW_MIRROR, 0xf, 0xf, true));
  return v;
}
DEVINL float rdl(float v, int l) { return __int_as_float(__builtin_amdgcn_readlane(__float_as_int(v), l)); }
DEVINL float wave_sum(float v) { const float r = row_sum_f(v); return (rdl(r, 0) + rdl(r, 16)) + (rdl(r, 32) + rdl(r, 48)); }
DEVINL float wave_max(float v) { const float r = row_max_f(v); return fmaxf(fmaxf(rdl(r, 0), rdl(r, 16)), fmaxf(rdl(r, 32), rdl(r, 48))); }
DEVINL float grp16_sum(float v) {
#pragma unroll
  for (int o = 8; o > 0; o >>= 1) v += __shfl_xor(v, o);
  return v;
}
DEVINL unsigned wave_max_u(unsigned v) {
#pragma unroll
  for (int o = 32; o > 0; o >>= 1) { unsigned t = (unsigned)__shfl_xor((int)v, o); v = v > t ? v : t; }
  return v;
}
DEVINL float sigmoidf_(float x) { return 1.0f / (1.0f + __expf(-x)); }
DEVINL float tanhf_(float x) { float e = __expf(-2.0f * fabsf(x)); float t = (1.0f - e) / (1.0f + e); return x < 0 ? -t : t; }
DEVINL unsigned ordf(float f) { unsigned u = __float_as_uint(f); return (u & 0x80000000u) ? ~u : (u | 0x80000000u); }

DEVINL int cond_of_row(int row) { return row < TCTX ? 8 : ((row - TCTX) >> 10); }


namespace pg8 {
#define PG8_LAS __attribute__((address_space(3)))
typedef unsigned u32x4 __attribute__((ext_vector_type(4)));
constexpr int BM = 256, BK = 64, HALF = 128, HTB = HALF * BK * 2, STAGE_BYTES = 8 * HTB, NXCD = 8, WGM = 8;
DEVINL int lds_byte(int r, int c) { const int st = (r >> 4) * 2 + (c >> 5), rr = r & 15, cc = c & 31, ob = rr * 64 + cc * 2; return st * 1024 + (ob ^ (((ob >> 9) & 1) << 5)); }
DEVINL void stage_rc(int b, int& R, int& C) { const int st = b / 1024, sb = b % 1024, swz = sb ^ (((sb >> 9) & 1) << 5); R = (st >> 1) * 16 + swz / 64; C = (st & 1) * 32 + (swz % 64) / 2; }
DEVINL int perm32(int rho) { const int n = rho >> 4, i = rho & 15; return 8 * (i >> 2) + 4 * n + (i & 3); }
struct Unit { int pm, pn; };
struct StaticOrder {
  int nM, nN, nwg, G, c;
  DEVINL void init(int M, int N, int G_, int c_) { nM = M / BM; nN = N / BM; nwg = nM * nN; G = G_; c = c_; }
  DEVINL bool next(int i, Unit& u) const {
    const long L = (long)i * G + c; if (L >= nwg) return false;
    int wgid = (int)L; { const int q = nwg / NXCD, r = nwg % NXCD, xcd = wgid % NXCD, off = wgid / NXCD; wgid = (xcd < r ? xcd * (q + 1) : r * (q + 1) + (xcd - r) * q) + off; }
    const int nig = WGM * nN, gid = wgid / nig, fm = gid * WGM, gsz = (nM - fm) < WGM ? (nM - fm) : WGM;
    u.pm = fm + ((wgid % nig) % gsz); u.pn = (wgid % nig) / gsz; return true;
  }
};
DEVINL unsigned cvt_pk_bf16(float lo, float hi) { return cvt_pk_bf16_(lo, hi); }

template <class Epi, class ASel>
DEVINL void gemm_phase(PG8_LAS unsigned char* lds, const ASel& asel, const bf16_t* Bt, const int K, const StaticOrder& S, const Epi& E, int gwid) {
  const int tid = tidx(gwid), wid = __builtin_amdgcn_readfirstlane(tid >> 6), lane = tid & 63, wr = wid >> 2, wc = wid & 3, fr = lane & 15, fq = lane >> 4;
  const int nt = K / BK;
  unsigned voffA[2], voffB[2];
#pragma unroll
  for (int i = 0; i < 2; ++i) { int R, C; stage_rc(tid * 16 + i * 8192, R, C); const int Rb = Epi::PERM ? ((R & ~31) + perm32(R & 31)) : R;
    voffA[i] = (unsigned)(R * K + C) * 2u; voffB[i] = (unsigned)(Rb * K + C) * 2u; }
  const size_t kstep = (size_t)(BK * 2);
  const size_t hstep = (size_t)HALF * K * 2;
  const size_t tstep = 2 * hstep;
  const unsigned ldsw = (unsigned)wid * 1024u;
  const int aoff = lds_byte(wr * 64 + fr, fq * 8), boff = lds_byte(wc * 32 + fr, fq * 8);
#define PG8_SA(b, h) (((b) * 2 + (h)) * HTB)
#define PG8_SB(b, h) ((4 + (b) * 2 + (h)) * HTB)
#define PG8_STAGE(bufoff, gbase, voff) do { _Pragma("unroll") for (int _i = 0; _i < 2; ++_i) \
    __builtin_amdgcn_global_load_lds((const unsigned*)((const char*)(gbase) + (voff)[_i]), (PG8_LAS unsigned*)(lds + (bufoff) + ldsw + _i * 8192), 16, 0, 0); } while (0)
#define PG8_LDA(dst, b, h) do { _Pragma("unroll") for (int m = 0; m < 4; ++m) _Pragma("unroll") for (int k = 0; k < 2; ++k) dst[m][k] = *(const PG8_LAS bf16x8*)(lds + PG8_SA(b, h) + aoff + m * 2048 + k * 1024); } while (0)
#define PG8_LDB(dst, b, h) do { _Pragma("unroll") for (int n = 0; n < 2; ++n) _Pragma("unroll") for (int k = 0; k < 2; ++k) dst[n][k] = *(const PG8_LAS bf16x8*)(lds + PG8_SB(b, h) + boff + n * 2048 + k * 1024); } while (0)
#define PG8_MMA(ai, bj, At, Bt_) do { __builtin_amdgcn_s_setprio(1); _Pragma("unroll") for (int m = 0; m < 4; ++m) _Pragma("unroll") for (int n = 0; n < 2; ++n) _Pragma("unroll") for (int k = 0; k < 2; ++k) \
    acc[ai][bj][m][n] = __builtin_amdgcn_mfma_f32_16x16x32_bf16(Bt_[n][k], At[m][k], acc[ai][bj][m][n], 0, 0, 0); __builtin_amdgcn_s_setprio(0); } while (0)
#define PG8_WAIT_V(n) asm volatile("s_waitcnt vmcnt(" #n ")" ::: "memory")
#define PG8_WAIT_L(n) asm volatile("s_waitcnt lgkmcnt(" #n ")" ::: "memory")
#define PG8_BAR __builtin_amdgcn_s_barrier()
#define PG8_SCHED __builtin_amdgcn_sched_barrier(0)
  Unit cur, nxt; int ui = 0;
  if (!S.next(0, cur)) return;
  f32x4 acc[2][2][4][2];
#pragma unroll
  for (int a = 0; a < 2; ++a)
#pragma unroll
    for (int b = 0; b < 2; ++b)
#pragma unroll
      for (int m = 0; m < 4; ++m)
#pragma unroll
        for (int n = 0; n < 2; ++n) acc[a][b][m][n] = (f32x4){0.f, 0.f, 0.f, 0.f};
  bf16x8 At[4][2], B0[2][2], B1[2][2];
  const char* cA = asel(cur.pn) + (size_t)cur.pm * tstep; const char* cB = (const char*)Bt + (size_t)cur.pn * tstep;
  PG8_STAGE(PG8_SB(0, 0), cB, voffB); PG8_STAGE(PG8_SA(0, 0), cA, voffA); PG8_STAGE(PG8_SB(0, 1), cB + hstep, voffB); PG8_STAGE(PG8_SA(0, 1), cA + hstep, voffA);
  if (wr == 1) PG8_BAR;
  PG8_WAIT_V(4); PG8_BAR;
  PG8_STAGE(PG8_SB(1, 0), cB + kstep, voffB); PG8_STAGE(PG8_SA(1, 0), cA + kstep, voffA); PG8_STAGE(PG8_SB(1, 1), cB + hstep + kstep, voffB);
  PG8_WAIT_V(6); PG8_BAR;
  for (;;) {
    const bool has_next = S.next(ui + 1, nxt);
    const char* nA = has_next ? asel(nxt.pn) + (size_t)nxt.pm * tstep : cA; const char* nB = has_next ? (const char*)Bt + (size_t)nxt.pn * tstep : cB;
    for (int t = 0; t < nt; t += 2) {
      const bool last = (t == nt - 2);
      const char* a1 = cA + (size_t)(t + 1) * kstep;
      const char* a2 = last ? nA : cA + (size_t)(t + 2) * kstep; const char* b2 = last ? nB : cB + (size_t)(t + 2) * kstep;
      const char* a3 = a2 + kstep; const char* b3 = b2 + kstep;
      PG8_LDB(B0, 0, 0); PG8_SCHED; PG8_LDA(At, 0, 0); PG8_STAGE(PG8_SA(1, 1), a1 + hstep, voffA);
      PG8_WAIT_L(8); PG8_BAR; PG8_WAIT_L(0); PG8_MMA(0, 0, At, B0); PG8_BAR; PG8_SCHED;
      PG8_LDB(B1, 0, 1); PG8_STAGE(PG8_SB(0, 0), b2, voffB);
      PG8_BAR; PG8_WAIT_L(0); PG8_MMA(0, 1, At, B1); PG8_BAR;
      PG8_LDA(At, 0, 1); PG8_STAGE(PG8_SA(0, 0), a2, voffA);
      PG8_BAR; PG8_WAIT_L(0); PG8_MMA(1, 0, At, B0); PG8_BAR; PG8_SCHED;
      PG8_STAGE(PG8_SB(0, 1), b2 + hstep, voffB);
      PG8_WAIT_V(6); PG8_BAR; PG8_MMA(1, 1, At, B1); PG8_BAR;
      PG8_LDB(B0, 1, 0); PG8_SCHED; PG8_LDA(At, 1, 0); PG8_STAGE(PG8_SA(0, 1), a2 + hstep, voffA);
      PG8_WAIT_L(8); PG8_BAR; PG8_WAIT_L(0); PG8_MMA(0, 0, At, B0); PG8_BAR; PG8_SCHED;
      PG8_LDB(B1, 1, 1); PG8_STAGE(PG8_SB(1, 0), b3, voffB);
      PG8_BAR; PG8_WAIT_L(0); PG8_MMA(0, 1, At, B1); PG8_BAR;
      PG8_LDA(At, 1, 1); PG8_STAGE(PG8_SA(1, 0), a3, voffA);
      PG8_BAR; PG8_WAIT_L(0); PG8_MMA(1, 0, At, B0); PG8_BAR; PG8_SCHED;
      PG8_STAGE(PG8_SB(1, 1), b3 + hstep, voffB);
      PG8_WAIT_V(6); PG8_BAR; PG8_MMA(1, 1, At, B1); PG8_BAR;
    }
    E(acc, cur, wr, wc, fr, fq);
    if (!has_next) break;
#pragma unroll
    for (int a = 0; a < 2; ++a)
#pragma unroll
      for (int b = 0; b < 2; ++b)
#pragma unroll
        for (int m = 0; m < 4; ++m)
#pragma unroll
          for (int n = 0; n < 2; ++n) acc[a][b][m][n] = (f32x4){0.f, 0.f, 0.f, 0.f};
    cur = nxt; cA = nA; cB = nB; ++ui;
  }
  PG8_WAIT_V(0);
  if (wr == 0) PG8_BAR;
  PG8_BAR;
#undef PG8_SA
#undef PG8_SB
#undef PG8_STAGE
#undef PG8_LDA
#undef PG8_LDB
#undef PG8_MMA
#undef PG8_WAIT_V
#undef PG8_WAIT_L
#undef PG8_BAR
#undef PG8_SCHED
}
struct ASelOne { const char* A; DEVINL const char* operator()(int) const { return A; } };
}

DEVINL void gemm_tile_128(const bf16_t* __restrict__ A, int lda, const bf16_t* __restrict__ Bt, int ldb, int K,
                          char* smem_half, f32x4 (&acc)[4][4], int gwid) {
  const int tid = tidx(gwid) & 255, wid = tid >> 6, lane = tid & 63;
  const int wr = wid >> 1, wc = wid & 1, fr = lane & 15, fq = lane >> 4;
  char* SA = smem_half;
  char* SB = smem_half + 8192;
#pragma unroll
  for (int m = 0; m < 4; ++m)
#pragma unroll
    for (int n = 0; n < 4; ++n) acc[m][n] = (f32x4){0.f, 0.f, 0.f, 0.f};
  for (int k0 = 0; k0 < K; k0 += 32) {
#pragma unroll
    for (int i = 0; i < 2; ++i) {
      int b = tid * 16 + i * 4096;
      int r = b >> 6, c = (b & 63) >> 1;
      __builtin_amdgcn_global_load_lds((const unsigned*)(A + (size_t)r * lda + k0 + c), (unsigned*)(SA + b), 16, 0, 0);
      __builtin_amdgcn_global_load_lds((const unsigned*)(Bt + (size_t)r * ldb + k0 + c), (unsigned*)(SB + b), 16, 0, 0);
    }
    asm volatile("s_waitcnt vmcnt(0)" ::: "memory");
    __syncthreads();
    bf16x8 a[4], b[4];
#pragma unroll
    for (int m = 0; m < 4; ++m) a[m] = *reinterpret_cast<const bf16x8*>(SA + (wr * 64 + m * 16 + fr) * 64 + fq * 16);
#pragma unroll
    for (int n = 0; n < 4; ++n) b[n] = *reinterpret_cast<const bf16x8*>(SB + (wc * 64 + n * 16 + fr) * 64 + fq * 16);
#pragma unroll
    for (int m = 0; m < 4; ++m)
#pragma unroll
      for (int n = 0; n < 4; ++n) acc[m][n] = __builtin_amdgcn_mfma_f32_16x16x32_bf16(a[m], b[n], acc[m][n], 0, 0, 0);
    __syncthreads();
  }
}

#define GEMM_LANE_VARS \
  const int tid = tidx(gwid) & 255, wid = tid >> 6, lane = tid & 63; \
  const int wr = wid >> 1, wc = wid & 1, fr = lane & 15, fq = lane >> 4; \
  (void)tid; (void)wid; (void)lane; (void)wr; (void)wc; (void)fr; (void)fq;

DEVINL void get_tjob(const Params& p, int ji, const float*& src, bf16_t*& dst, int& K, int& N) {
  if (ji < 28) {
    int j = ji / 14, s = ji % 14;
    bf16_t* rw = p.rwkv_in_t + (size_t)j * RW_N * 1024;
    if (s < 3) { src = p.in[12] + ((size_t)(j * 3 + s) << 20); dst = rw + ((size_t)s << 20); K = 1024; N = 1024; }
    else if (s < 5) { int z = s - 3; src = p.in[15] + (size_t)(j * 2 + z) * 65536; dst = rw + (size_t)(3072 + z * 64) * 1024; K = 1024; N = 64; }
    else if (s < 7) { int z = s - 5; src = p.in[18] + (size_t)(j * 2 + z) * 65536; dst = rw + (size_t)(3328 + z * 64) * 1024; K = 1024; N = 64; }
    else if (s == 7) { src = p.in[20] + (size_t)j * 131072; dst = rw + (size_t)3584 * 1024; K = 1024; N = 128; }
    else if (s < 10) { int z = s - 8; src = p.in[16] + (size_t)(j * 2 + z) * 65536; dst = p.w2t + (size_t)(j * 2 + z) * 65536; K = 64; N = 1024; }
    else if (s < 12) { int z = s - 10; src = p.in[19] + (size_t)(j * 2 + z) * 65536; dst = p.a2t + (size_t)(j * 2 + z) * 65536; K = 64; N = 1024; }
    else if (s == 12) { src = p.in[21] + (size_t)j * 131072; dst = p.g2t + (size_t)j * 131072; K = 128; N = 1024; }
    else { src = p.in[13] + ((size_t)j << 20); dst = p.rwkv_wo_t + ((size_t)j << 20); K = 1024; N = 1024; }
  } else if (ji < 32) {
    int j = (ji - 28) >> 1, s = (ji - 28) & 1;
    if (s == 0) { src = p.in[27] + (size_t)j * 1024 * 1536; dst = p.attn_wqkv_t + (size_t)j * 1536 * 1024; K = 1024; N = 1536; }
    else { src = p.in[28] + ((size_t)j << 20); dst = p.attn_wo_t + ((size_t)j << 20); K = 1024; N = 1024; }
  } else {
    int i = ji - 32;
    src = p.in[31] + (size_t)i * 1024 * 2048; dst = p.wq_t + (size_t)i * 2048 * 1024; K = 1024; N = 2048;
  }
}

DEVINL void sincos_d(double x, float& c, float& s) {
  const double TWO_PI = 6.283185307179586476925;
  double r = x - TWO_PI * rint(x / TWO_PI);
  double r2 = r * r;
  double ts = r, tc = 1.0, ss = r, cs = 1.0;
#pragma unroll 1
  for (int n = 1; n <= 14; ++n) {
    tc = -tc * r2 / (double)((2 * n - 1) * (2 * n));
    ts = -ts * r2 / (double)((2 * n) * (2 * n + 1));
    cs += tc; ss += ts;
  }
  c = (float)cs; s = (float)ss;
}

DEVINL void phase_prep(const Params& p, int w, int nw, char* smem, int gwid) {
  const int tid = tidx(gwid);
  {
    float (*tile)[65] = reinterpret_cast<float (*)[65]>(smem);
    int toff = 0;
    for (int ji = 0; ji < 36; ++ji) {
      const float* src; bf16_t* dst; int K, N;
      get_tjob(p, ji, src, dst, K, N);
      const int tn = N >> 6, nt = (K >> 6) * tn;
      int t0 = (w - (toff % nw) + nw) % nw;
      for (int t = t0; t < nt; t += nw) {
        const int k0 = (t / tn) << 6, n0 = (t % tn) << 6;
#pragma unroll
        for (int i = 0; i < 2; ++i) {
          int r = (tid >> 4) + 32 * i, c = (tid & 15) * 4;
          float4 v = *reinterpret_cast<const float4*>(src + (size_t)(k0 + r) * N + n0 + c);
          tile[r][c] = v.x; tile[r][c + 1] = v.y; tile[r][c + 2] = v.z; tile[r][c + 3] = v.w;
        }
        __syncthreads();
        {
          int q = tid;
          int n = q >> 3, kc = (q & 7) * 8;
          uint4 o;
          o.x = pack2(tile[kc + 0][n], tile[kc + 1][n]);
          o.y = pack2(tile[kc + 2][n], tile[kc + 3][n]);
          o.z = pack2(tile[kc + 4][n], tile[kc + 5][n]);
          o.w = pack2(tile[kc + 6][n], tile[kc + 7][n]);
          *reinterpret_cast<uint4*>(dst + (size_t)(n0 + n) * K + k0 + kc) = o;
        }
        __syncthreads();
      }
      toff += nt;
    }
  }
  const size_t gtid = (size_t)w * NTHREADS + tid, gn = (size_t)nw * NTHREADS;
  {
    const int lane = tid & 63;
    const int gw2 = w * NWAVES + (tid >> 6), ngw2 = nw * NWAVES;
    unsigned char* u4 = reinterpret_cast<unsigned char*>(p.ub);
    unsigned char* v4 = reinterpret_cast<unsigned char*>(p.vb);
    unsigned char* usc = u4 + (size_t)65536 * 512;
    unsigned char* vsc = v4 + (size_t)65536 * 512;
    for (int r = gw2; r < 2 * 65536; r += ngw2) {
      const bool isv = r >= 65536;
      const int row = isv ? r - 65536 : r;
      const float* srow = (isv ? p.in[34] : p.in[33]) + (size_t)row * 1024 + lane * 16;
      float x[16];
#pragma unroll
      for (int q = 0; q < 4; ++q) { const float4 v = reinterpret_cast<const float4*>(srow)[q]; x[q * 4] = v.x; x[q * 4 + 1] = v.y; x[q * 4 + 2] = v.z; x[q * 4 + 3] = v.w; }
      float mx = 0.f;
#pragma unroll
      for (int q = 0; q < 16; ++q) mx = fmaxf(mx, fabsf(x[q]));
      mx = fmaxf(mx, __shfl_xor(mx, 1));
      const unsigned yb = __float_as_uint(mx * (1.0f / 6.0f));
      unsigned eb = ((yb >> 23) & 0xFFu) + ((yb & 0x7FFFFFu) ? 1u : 0u);
      eb = eb < 1u ? 1u : (eb > 254u ? 254u : eb);
      if (mx == 0.f) eb = 127u;
      const float inv = __uint_as_float((254u - eb) << 23);
      unsigned w0 = 0, w1 = 0;
#define Q4(q) w0 = __builtin_amdgcn_cvt_scalef32_pk_fp4_f32(w0, x[2 * q] * inv, x[2 * q + 1] * inv, 1.0f, q); \
               w1 = __builtin_amdgcn_cvt_scalef32_pk_fp4_f32(w1, x[8 + 2 * q] * inv, x[8 + 2 * q + 1] * inv, 1.0f, q);
      Q4(0) Q4(1) Q4(2) Q4(3)
#undef Q4
      uint2 o2; o2.x = w0; o2.y = w1;
      *reinterpret_cast<uint2*>((isv ? v4 : u4) + (size_t)row * 512 + lane * 8) = o2;
      if ((lane & 1) == 0) {
        const int b = lane >> 1;
        if (isv) vsc[(size_t)row * 32 + b] = (unsigned char)eb;
        else usc[(size_t)row * 32 + (b & 3) * 8 + (b >> 2)] = (unsigned char)eb;
      }
    }
    const size_t gtid0 = (size_t)w * NTHREADS + tid, gn0 = (size_t)nw * NTHREADS;
    const size_t nk8 = (size_t)4 * 2 * 128 * 128 / 8;
    for (size_t i = gtid0; i < nk8; i += gn0) {
      const float4* su = reinterpret_cast<const float4*>(p.in[32]) + i * 2;
      float4 a = su[0], b = su[1];
      uint4 o; o.x = pack2(a.x, a.y); o.y = pack2(a.z, a.w); o.z = pack2(b.x, b.y); o.w = pack2(b.z, b.w);
      reinterpret_cast<uint4*>(p.keysb)[i] = o;
    }
  }
  {
    const size_t nk = (size_t)8 * 2 * 512 * 4 * 64;
    for (size_t i = gtid; i < nk; i += gn) {
      int d = i & 63, kvh = (i >> 6) & 3, s = (i >> 8) & 511, j = (i >> 17) & 1, b = (int)(i >> 18);
      p.Klat[((size_t)((j * 8 + b) * 4 + kvh) * 1536 + s) * 64 + d] = f2bf(p.in[4][i]);
      p.VlatT[((size_t)((j * 8 + b) * 4 + kvh) * 64 + d) * 1536 + s] = f2bf(p.in[5][i]);
    }
  }
  for (size_t i = gtid; i < 1024; i += gn) {
    int pos = (int)(i >> 4), f = (int)(i & 15);
    float c, s; sincos_d((double)pos * p.freqs[f], c, s);
    p.rope[i * 2] = c; p.rope[i * 2 + 1] = s;
  }
  {
    const size_t n4 = (size_t)TT * DM / 4, nc4 = (size_t)TCTX * DM / 4;
    for (size_t i = gtid; i < n4; i += gn) {
      float4 v = (i < nc4) ? reinterpret_cast<const float4*>(p.in[0])[i] : reinterpret_cast<const float4*>(p.in[1])[i - nc4];
      reinterpret_cast<float4*>(p.xbuf)[i] = v;
    }
  }
  {
    float* sc = reinterpret_cast<float*>(smem);
    float* red = sc + 9 * 1024;
    bool loaded = false;
    for (int item = w; item < 384; item += nw) {
      if (!loaded) {
        __syncthreads();
        for (int e = tid; e < 9 * 1024; e += NTHREADS) {
          int c = e >> 10, d = e & 1023;
          float v = (c < 8) ? p.in[2][c * 1024 + d] : p.in[6][d];
          sc[e] = v / (1.0f + __expf(-v));
        }
        __syncthreads();
        loaded = true;
      }
      const int i = item / 96, cc = item % 96;
      const int col = cc * 64 + (tid & 63), ks = tid >> 6;
      float acc[9];
#pragma unroll
      for (int c = 0; c < 9; ++c) acc[c] = 0.f;
      const float* wp = p.in[7] + (size_t)i * 1024 * 6144 + col;
      for (int d0 = ks * 128; d0 < ks * 128 + 128; d0 += 16) {
        float wv[16];
#pragma unroll
        for (int u = 0; u < 16; ++u) wv[u] = wp[(size_t)(d0 + u) * 6144];
#pragma unroll
        for (int u = 0; u < 16; ++u)
#pragma unroll
          for (int c = 0; c < 9; ++c) acc[c] += sc[c * 1024 + d0 + u] * wv[u];
      }
#pragma unroll
      for (int c = 0; c < 9; ++c) red[(ks * 9 + c) * 64 + (tid & 63)] = acc[c];
      __syncthreads();
      for (int o = tid; o < 576; o += NTHREADS) {
        int c = o >> 6, cl = o & 63;
        float s = 0.f;
#pragma unroll
        for (int k2 = 0; k2 < 8; ++k2) s += red[(k2 * 9 + c) * 64 + cl];
        int n = cc * 64 + cl;
        p.mod[((size_t)i * 9 + c) * 6144 + n] = s + p.in[8][i * 6144 + n];
      }
      __syncthreads();
    }
  }
}

DEVINL void phase_r1(const Params& p, int layer, int w, int nw, int gwid) {
  const int j = layer >> 1;
  const int lane = tidx(gwid) & 63;
  const int gw = w * NWAVES + (tidx(gwid) >> 6), ngw = nw * NWAVES;
  bf16_t* A6 = reinterpret_cast<bf16_t*>(p.U1);
  const float* mu = p.in[11] + (size_t)j * 6 * 1024;
  for (int row = gw; row < TT; row += ngw) {
    int t, Tlen;
    if (row < TCTX) { t = row & 255; Tlen = 256; } else { t = (row - TCTX) & 1023; Tlen = 1024; }
    const int cond = cond_of_row(row);
    const float* sh = p.mod + ((size_t)layer * 9 + cond) * 6144;
    const float* sc = sh + 1024;
    const bool hasp = t > 0, hasn = t < Tlen - 1;
#pragma unroll
    for (int k = 0; k < 4; ++k) {
      const int col = k * 256 + lane * 4;
      const float4 xc = *reinterpret_cast<const float4*>(p.xbuf + (size_t)row * DM + col);
      float4 xp = make_float4(0, 0, 0, 0), xn = make_float4(0, 0, 0, 0);
      if (hasp) xp = *reinterpret_cast<const float4*>(p.xbuf + (size_t)(row - 1) * DM + col);
      if (hasn) xn = *reinterpret_cast<const float4*>(p.xbuf + (size_t)(row + 1) * DM + col);
      const float4 s4 = *reinterpret_cast<const float4*>(sh + col);
      const float4 c4 = *reinterpret_cast<const float4*>(sc + col);
      float h[4], xx[4];
      const float xcv[4] = {xc.x, xc.y, xc.z, xc.w}, xpv[4] = {xp.x, xp.y, xp.z, xp.w}, xnv[4] = {xn.x, xn.y, xn.z, xn.w};
      const float shv[4] = {s4.x, s4.y, s4.z, s4.w}, scv[4] = {c4.x, c4.y, c4.z, c4.w};
#pragma unroll
      for (int e = 0; e < 4; ++e) {
        float g = 1.0f + scv[e];
        h[e] = xcv[e] * g + shv[e];
        float hp = hasp ? (xpv[e] * g + shv[e]) : 0.f;
        float hn = hasn ? (xnv[e] * g + shv[e]) : 0.f;
        xx[e] = 0.5f * (hp + hn) - h[e];
      }
#pragma unroll
      for (int m = 0; m < 6; ++m) {
        const float4 m4 = *reinterpret_cast<const float4*>(mu + m * 1024 + col);
        uint2 o;
        o.x = pack2(h[0] + xx[0] * m4.x, h[1] + xx[1] * m4.y);
        o.y = pack2(h[2] + xx[2] * m4.z, h[3] + xx[3] * m4.w);
        *reinterpret_cast<uint2*>(A6 + ((size_t)m * TT + row) * DM + col) = o;
      }
    }
  }
}

#define U1_AA_OFF ((size_t)2 * TT * DM * 4)
#define U1_GG_OFF (U1_AA_OFF + (size_t)2 * TT * DM * 2)

struct ASelR2 {
  const char* A6;
  DEVINL const char* operator()(int pn) const {
    const int idx = pn < 12 ? (pn >> 2) : (pn - 9);
    const int m = (0x541320 >> (4 * idx)) & 7;
    return A6 + (size_t)m * TT * DM * 2;
  }
};
struct EpiR2 {
  static constexpr bool PERM = true;
  bf16_t *rb, *lw;
  DEVINL void operator()(const f32x4 (&acc)[2][2][4][2], const pg8::Unit& u, int wr, int wc, int fr, int fq) const {
    const int row0 = u.pm * 256 + wr * 64 + fr;
    const int pn = u.pn;
    if (pn < 12) {
      bf16_t* dst = rb + (size_t)(pn >> 2) * TT * DM;
      const int col0 = (pn & 3) * 256 + wc * 32 + 8 * fq;
#pragma unroll
      for (int ai = 0; ai < 2; ++ai)
#pragma unroll
        for (int m = 0; m < 4; ++m) {
          bf16_t* rowp = dst + (size_t)(row0 + ai * 128 + m * 16) * DM + col0;
#pragma unroll
          for (int bj = 0; bj < 2; ++bj) {
            const f32x4 v0 = acc[ai][bj][m][0], v1 = acc[ai][bj][m][1];
            pg8::u32x4 o; o.x = pg8::cvt_pk_bf16(v0[0], v0[1]); o.y = pg8::cvt_pk_bf16(v0[2], v0[3]); o.z = pg8::cvt_pk_bf16(v1[0], v1[1]); o.w = pg8::cvt_pk_bf16(v1[2], v1[3]);
            *reinterpret_cast<pg8::u32x4*>(rowp + bj * 128) = o;
          }
        }
    } else {
      bf16_t* dst = lw + (size_t)(pn - 12) * TT * 128;
      const int col0 = wc * 32 + 8 * fq;
      const float kx = (pn == 12 ? 2.0f : 1.0f) * 1.4426950408889634f, ka = pn == 12 ? 2.0f : 1.0f, kb = pn == 12 ? -1.0f : 0.0f;
#pragma unroll
      for (int ai = 0; ai < 2; ++ai)
#pragma unroll
        for (int m = 0; m < 4; ++m) {
          f32x4 v0 = acc[ai][0][m][0], v1 = acc[ai][0][m][1];
          if (pn != 13) {
#pragma unroll
            for (int e = 0; e < 4; ++e) {
              const float s0 = __builtin_amdgcn_rcpf(1.0f + __builtin_amdgcn_exp2f(-kx * v0[e]));
              const float s1 = __builtin_amdgcn_rcpf(1.0f + __builtin_amdgcn_exp2f(-kx * v1[e]));
              v0[e] = ka * s0 + kb; v1[e] = ka * s1 + kb;
            }
          }
          asm volatile("" ::: "memory");
          pg8::u32x4 o; o.x = pg8::cvt_pk_bf16(v0[0], v0[1]); o.y = pg8::cvt_pk_bf16(v0[2], v0[3]); o.z = pg8::cvt_pk_bf16(v1[0], v1[1]); o.w = pg8::cvt_pk_bf16(v1[2], v1[3]);
          *reinterpret_cast<pg8::u32x4*>(dst + (size_t)(row0 + ai * 128 + m * 16) * 128 + col0) = o;
        }
    }
  }
};
DEVINL void phase_r2(const Params& p, int layer, int w, int nw, char* smem, int gwid) {
  const int j = layer >> 1;
  bf16_t* rb = reinterpret_cast<bf16_t*>(p.U2);
  EpiR2 E;
  E.rb = rb; E.lw = p.abuf;
  ASelR2 as; as.A6 = p.U1;
  pg8::StaticOrder S; S.init(TT, RW_N, nw, w);
  pg8::gemm_phase<EpiR2, ASelR2>((PG8_LAS unsigned char*)smem, as, p.rwkv_in_t + (size_t)j * RW_N * 1024, 1024, S, E, gwid);
}

DEVINL void phase_r3(const Params& p, int layer, int w, int nw, char* smem, int gwid) {
  const int j = layer >> 1;
  GEMM_LANE_VARS
  const int half = tidx(gwid) >> 8;
  char* sh = smem + half * 16384;
  const bf16_t* lw = p.abuf;
  const bf16_t* la = lw + (size_t)TT * 128;
  const bf16_t* lg = la + (size_t)TT * 128;
  float* wdec = reinterpret_cast<float*>(p.U1);
  bf16_t* aa = reinterpret_cast<bf16_t*>(p.U1 + U1_AA_OFF);
  bf16_t* gg = reinterpret_cast<bf16_t*>(p.U1 + U1_GG_OFF);
  const int NTILES = 96 * 40;
  for (int it = 0; it * nw * 2 < NTILES; ++it) {
    int tile = (it * nw + w) * 2 + half;
    const bool valid = tile < NTILES;
    if (!valid) tile = 0;
    const int ct = tile / 96, rt = tile % 96;
    const int job = ct >> 3, nt = ct & 7;
    const int row0 = rt * 128, col0 = nt * 128;
    f32x4 acc[4][4];
    if (job < 2) {
      const int z = job;
      gemm_tile_128(lw + (size_t)row0 * 128 + z * 64, 128, p.w2t + (size_t)(j * 2 + z) * 65536 + (size_t)col0 * 64, 64, 64, sh, acc, gwid);
      if (valid) {
        const float* w0 = p.in[14] + (size_t)(j * 2 + z) * 1024;
#pragma unroll
        for (int m = 0; m < 4; ++m)
#pragma unroll
          for (int n = 0; n < 4; ++n)
#pragma unroll
            for (int jj = 0; jj < 4; ++jj) {
              int row = row0 + wr * 64 + m * 16 + fq * 4 + jj, col = col0 + wc * 64 + n * 16 + fr;
              float wl = acc[m][n][jj] + w0[col];
              wdec[((size_t)z * TT + row) * DM + col] = __expf(-0.6065306597126334f * sigmoidf_(wl));
            }
      }
    } else if (job < 4) {
      const int z = job - 2;
      gemm_tile_128(la + (size_t)row0 * 128 + z * 64, 128, p.a2t + (size_t)(j * 2 + z) * 65536 + (size_t)col0 * 64, 64, 64, sh, acc, gwid);
      if (valid) {
        const float* a0 = p.in[17] + (size_t)(j * 2 + z) * 1024;
#pragma unroll
        for (int m = 0; m < 4; ++m)
#pragma unroll
          for (int n = 0; n < 4; ++n)
#pragma unroll
            for (int jj = 0; jj < 4; ++jj) {
              int row = row0 + wr * 64 + m * 16 + fq * 4 + jj, col = col0 + wc * 64 + n * 16 + fr;
              aa[((size_t)z * TT + row) * DM + col] = f2bf(sigmoidf_(acc[m][n][jj] + a0[col]));
            }
      }
    } else {
      gemm_tile_128(lg + (size_t)row0 * 128, 128, p.g2t + (size_t)j * 131072 + (size_t)col0 * 128, 128, 128, sh, acc, gwid);
      if (valid) {
#pragma unroll
        for (int m = 0; m < 4; ++m)
#pragma unroll
          for (int n = 0; n < 4; ++n)
#pragma unroll
            for (int jj = 0; jj < 4; ++jj) {
              int row = row0 + wr * 64 + m * 16 + fq * 4 + jj, col = col0 + wc * 64 + n * 16 + fr;
              gg[(size_t)row * DM + col] = f2bf(acc[m][n][jj]);
            }
      }
    }
  }
  {
    const int l64 = tidx(gwid) & 63;
    const int gw = w * NWAVES + (tidx(gwid) >> 6), ngw = nw * NWAVES;
    const bf16_t* kb = reinterpret_cast<const bf16_t*>(p.U2) + (size_t)TT * DM;
    bf16_t* kkb = reinterpret_cast<bf16_t*>(p.U2) + (size_t)3 * TT * DM;
    const float* k_k = p.in[22] + j * 1024;
    for (int row = gw; row < TT; row += ngw) {
#pragma unroll
      for (int k = 0; k < 4; ++k) {
        const int col = k * 256 + l64 * 4;
        const uint2 k2 = *reinterpret_cast<const uint2*>(kb + (size_t)row * DM + col);
        const float4 kk4 = *reinterpret_cast<const float4*>(k_k + col);
        float v0 = bflo(k2.x) * kk4.x, v1 = bfhi(k2.x) * kk4.y, v2 = bflo(k2.y) * kk4.z, v3 = bfhi(k2.y) * kk4.w;
        float ss = grp16_sum(v0 * v0 + v1 * v1 + v2 * v2 + v3 * v3);
        float inv = 1.0f / fmaxf(sqrtf(ss), 1e-12f);
        uint2 o; o.x = pack2(v0 * inv, v1 * inv); o.y = pack2(v2 * inv, v3 * inv);
        *reinterpret_cast<uint2*>(kkb + (size_t)row * DM + col) = o;
      }
    }
  }
}

typedef __attribute__((ext_vector_type(4))) short bf16x4;
DEVINL bf16x4 pack4(float a, float b, float c, float d) {
  union { bf16x4 v; unsigned u[2]; } r; r.u[0] = pack2(a, b); r.u[1] = pack2(c, d); return r.v;
}
struct R4Chain { int base, Tlen, colb, z, seq, h; };
DEVINL R4Chain r4_chain(int c) {
  R4Chain k;
  if (c < 256) { k.seq = 16 + (c >> 5); k.h = (c >> 1) & 15; k.z = c & 1; }
  else { const int cc = c - 256; k.seq = cc >> 5; k.h = (cc >> 1) & 15; k.z = cc & 1; }
  k.Tlen = k.seq < 16 ? 256 : 1024;
  k.base = k.seq < 16 ? k.seq * 256 : TCTX + (k.seq - 16) * 1024;
  k.colb = k.h * 64;
  return k;
}
#define R4E_KH 0
#define R4E_AH 2048
#define R4E_QH 4096
#define R4E_RH 6144
#define R4E_QHT 8192
#define R4E_ATT 10240
#define R4E_KTT 12288
#define R4E_VT 14336
#define R4E_WC 16384
#define R4E_BYTES 16640
#define R4M_QP 0
#define R4M_AY 2048
#define R4M_Z 3072
#define R4M_BYTES 5120
#define R4S_BYTES 2560
#define R4RAW_BYTES 14336

DEVINL void r4_dma(const Params& p, const R4Chain& k, int t0, char* rawb, int lane) {
  const bf16_t* rb = reinterpret_cast<const bf16_t*>(p.U2);
  const bf16_t* kb = rb + (size_t)TT * DM;
  const bf16_t* vb = kb + (size_t)TT * DM;
  const bf16_t* kkb = vb + (size_t)TT * DM;
  const float* wdec = reinterpret_cast<const float*>(p.U1);
  const bf16_t* aa = reinterpret_cast<const bf16_t*>(p.U1 + U1_AA_OFF);
#pragma unroll
  for (int i_ = 0; i_ < 2; ++i_) {
    const int t_ = t0 + 8 * i_ + (lane >> 3);
    const int row_ = k.base + (k.z == 0 ? t_ : (k.Tlen - 1 - t_));
    const size_t o_ = (size_t)row_ * DM + k.colb + (lane & 7) * 8;
    __builtin_amdgcn_global_load_lds((const unsigned*)(rb + o_), (unsigned*)(rawb + i_ * 1024 + lane * 16), 16, 0, 0);
    __builtin_amdgcn_global_load_lds((const unsigned*)(kb + o_), (unsigned*)(rawb + 2048 + i_ * 1024 + lane * 16), 16, 0, 0);
    __builtin_amdgcn_global_load_lds((const unsigned*)(kkb + o_), (unsigned*)(rawb + 4096 + i_ * 1024 + lane * 16), 16, 0, 0);
    __builtin_amdgcn_global_load_lds((const unsigned*)(aa + (size_t)k.z * TT * DM + o_), (unsigned*)(rawb + 6144 + i_ * 1024 + lane * 16), 16, 0, 0);
    __builtin_amdgcn_global_load_lds((const unsigned*)(vb + o_), (unsigned*)(rawb + 8192 + i_ * 1024 + lane * 16), 16, 0, 0);
  }
#pragma unroll
  for (int i_ = 0; i_ < 4; ++i_) {
    const int t_ = t0 + 4 * i_ + (lane >> 4);
    const int row_ = k.base + (k.z == 0 ? t_ : (k.Tlen - 1 - t_));
    __builtin_amdgcn_global_load_lds((const unsigned*)(wdec + ((size_t)k.z * TT + row_) * DM + k.colb + (lane & 15) * 4), (unsigned*)(rawb + 10240 + i_ * 1024 + lane * 16), 16, 0, 0);
  }
}

DEVINL void r4_stageE(const char* rawb, char* eb, float kal, int lane) {
  const bf16_t* rawR = reinterpret_cast<const bf16_t*>(rawb);
  const bf16_t* rawK = rawR + 1024;
  const bf16_t* rawKK = rawK + 1024;
  const bf16_t* rawA = rawKK + 1024;
  const bf16_t* rawV = rawA + 1024;
  const float* rawW = reinterpret_cast<const float*>(rawb + 10240);
  bf16_t* khR = reinterpret_cast<bf16_t*>(eb + R4E_KH);
  bf16_t* ahR = reinterpret_cast<bf16_t*>(eb + R4E_AH);
  bf16_t* qhR = reinterpret_cast<bf16_t*>(eb + R4E_QH);
  bf16_t* rhR = reinterpret_cast<bf16_t*>(eb + R4E_RH);
  bf16_t* qhT = reinterpret_cast<bf16_t*>(eb + R4E_QHT);
  bf16_t* AtT = reinterpret_cast<bf16_t*>(eb + R4E_ATT);
  bf16_t* KtT = reinterpret_cast<bf16_t*>(eb + R4E_KTT);
  bf16_t* vT = reinterpret_cast<bf16_t*>(eb + R4E_VT);
  float* WCf = reinterpret_cast<float*>(eb + R4E_WC);
  float wx[16];
#pragma unroll
  for (int t = 0; t < 16; ++t) wx[t] = rawW[t * 64 + lane];
  float WCl = 1.0f;
#pragma unroll
  for (int t = 0; t < 16; ++t) WCl *= wx[t];
  WCf[lane] = WCl;
  float Wc = 1.0f;
#pragma unroll
  for (int th = 0; th < 2; ++th) {
    float at8[8], kt8[8], qh8[8];
    unsigned vb8[8];
#pragma unroll
    for (int u = 0; u < 8; ++u) {
      const int t = th * 8 + u;
      const float rr = bf2f(rawR[t * 64 + lane]), kx = bf2f(rawK[t * 64 + lane]), kkx = bf2f(rawKK[t * 64 + lane]);
      const float ax = bf2f(rawA[t * 64 + lane]);
      vb8[u] = rawV[t * 64 + lane];
      const float kd = kx * (1.0f + (ax - 1.0f) * kal);
      const float kka = kkx * ax;
      const float qh = Wc * kkx;
      Wc *= wx[t];
      const float rh = Wc * rr;
      const float iw = __builtin_amdgcn_rcpf(Wc);
      const float kh = kd * iw, ah = kka * iw;
      khR[t * 64 + lane] = f2bf(kh); ahR[t * 64 + lane] = f2bf(ah);
      qhR[t * 64 + lane] = f2bf(qh); rhR[t * 64 + lane] = f2bf(rh);
      at8[u] = ah * WCl; kt8[u] = kh * WCl; qh8[u] = qh;
    }
    uint4 o;
    o.x = pack2(at8[0], at8[1]); o.y = pack2(at8[2], at8[3]); o.z = pack2(at8[4], at8[5]); o.w = pack2(at8[6], at8[7]);
    *reinterpret_cast<uint4*>(AtT + lane * 16 + th * 8) = o;
    o.x = pack2(kt8[0], kt8[1]); o.y = pack2(kt8[2], kt8[3]); o.z = pack2(kt8[4], kt8[5]); o.w = pack2(kt8[6], kt8[7]);
    *reinterpret_cast<uint4*>(KtT + lane * 16 + th * 8) = o;
    o.x = pack2(qh8[0], qh8[1]); o.y = pack2(qh8[2], qh8[3]); o.z = pack2(qh8[4], qh8[5]); o.w = pack2(qh8[6], qh8[7]);
    *reinterpret_cast<uint4*>(qhT + lane * 16 + th * 8) = o;
    o.x = vb8[0] | (vb8[1] << 16); o.y = vb8[2] | (vb8[3] << 16); o.z = vb8[4] | (vb8[5] << 16); o.w = vb8[6] | (vb8[7] << 16);
    *reinterpret_cast<uint4*>(vT + lane * 16 + th * 8) = o;
  }
}

DEVINL void r4_stageM(const char* eb, char* mb, char* sc, int lane) {
  const int fr = lane & 15, fq = lane >> 4;
  const bf16_t* khR = reinterpret_cast<const bf16_t*>(eb + R4E_KH);
  const bf16_t* ahR = reinterpret_cast<const bf16_t*>(eb + R4E_AH);
  const bf16_t* qhR = reinterpret_cast<const bf16_t*>(eb + R4E_QH);
  const bf16_t* rhR = reinterpret_cast<const bf16_t*>(eb + R4E_RH);
  const bf16_t* qhT = reinterpret_cast<const bf16_t*>(eb + R4E_QHT);
  const bf16_t* AtT = reinterpret_cast<const bf16_t*>(eb + R4E_ATT);
  const bf16_t* KtT = reinterpret_cast<const bf16_t*>(eb + R4E_KTT);
  bf16_t* QpR = reinterpret_cast<bf16_t*>(mb + R4M_QP);
  float* NfT = reinterpret_cast<float*>(sc);
  bf16_t* TTl = reinterpret_cast<bf16_t*>(sc + 1024);
  bf16_t* AkqR = reinterpret_cast<bf16_t*>(sc + 1536);
  bf16_t* GR = reinterpret_cast<bf16_t*>(sc + 2048);
  f32x4 Akq = {0.f, 0.f, 0.f, 0.f}, Aaq = Akq, Akr = Akq, Aar = Akq;
#pragma unroll
  for (int ks = 0; ks < 2; ++ks) {
    const bf16x8 khA = *reinterpret_cast<const bf16x8*>(khR + fr * 64 + ks * 32 + fq * 8);
    const bf16x8 ahA = *reinterpret_cast<const bf16x8*>(ahR + fr * 64 + ks * 32 + fq * 8);
    const bf16x8 qhB = *reinterpret_cast<const bf16x8*>(qhR + fr * 64 + ks * 32 + fq * 8);
    const bf16x8 rhB = *reinterpret_cast<const bf16x8*>(rhR + fr * 64 + ks * 32 + fq * 8);
    Akq = __builtin_amdgcn_mfma_f32_16x16x32_bf16(khA, qhB, Akq, 0, 0, 0);
    Aaq = __builtin_amdgcn_mfma_f32_16x16x32_bf16(ahA, qhB, Aaq, 0, 0, 0);
    Akr = __builtin_amdgcn_mfma_f32_16x16x32_bf16(khA, rhB, Akr, 0, 0, 0);
    Aar = __builtin_amdgcn_mfma_f32_16x16x32_bf16(ahA, rhB, Aar, 0, 0, 0);
  }
#pragma unroll
  for (int e = 0; e < 4; ++e) {
    const int s = 4 * fq + e;
    if (!(s < fr)) { Akq[e] = 0.f; Aaq[e] = 0.f; }
    if (!(s <= fr)) { Akr[e] = 0.f; Aar[e] = 0.f; }
  }
  __builtin_amdgcn_wave_barrier();
  *reinterpret_cast<f32x4*>(NfT + fr * 16 + 4 * fq) = Aaq;
#pragma unroll
  for (int e = 0; e < 4; ++e) AkqR[(4 * fq + e) * 16 + fr] = f2bf(Akq[e]);
  __builtin_amdgcn_wave_barrier();
  {
    float Tr[16];
#pragma unroll
    for (int t = 0; t < 16; ++t) {
      float acc = (fr == t) ? 1.0f : 0.0f;
#pragma unroll
      for (int x = 0; x < t; ++x) acc -= Tr[x] * NfT[t * 16 + x];
      Tr[t] = acc;
    }
    if (fq == 0) {
#pragma unroll
      for (int t = 0; t < 16; ++t) TTl[t * 16 + fr] = f2bf(Tr[t]);
    }
  }
  __builtin_amdgcn_wave_barrier();
  const bf16x4 Tb = *reinterpret_cast<const bf16x4*>(TTl + fr * 16 + fq * 4);
  f32x4 G;
  {
    const bf16x4 AkqA = *reinterpret_cast<const bf16x4*>(AkqR + fr * 16 + fq * 4);
    G = __builtin_amdgcn_mfma_f32_16x16x16bf16_1k(AkqA, Tb, (f32x4){0.f, 0.f, 0.f, 0.f}, 0, 0, 0);
#pragma unroll
    for (int b = 0; b < 4; ++b) {
      const bf16x4 qa = *reinterpret_cast<const bf16x4*>(qhT + (16 * b + fr) * 16 + fq * 4);
      const f32x4 qp = __builtin_amdgcn_mfma_f32_16x16x16bf16_1k(qa, Tb, (f32x4){0.f, 0.f, 0.f, 0.f}, 0, 0, 0);
      *reinterpret_cast<bf16x4*>(QpR + fr * 64 + 16 * b + 4 * fq) = pack4(qp[0], qp[1], qp[2], qp[3]);
    }
#pragma unroll
    for (int e = 0; e < 4; ++e) GR[(4 * fq + e) * 16 + fr] = f2bf(G[e]);
  }
  __builtin_amdgcn_wave_barrier();
  {
    const bf16x4 GA = *reinterpret_cast<const bf16x4*>(GR + fr * 16 + fq * 4);
    const bf16x4 AarB = pack4(Aar[0], Aar[1], Aar[2], Aar[3]);
    const f32x4 hm = __builtin_amdgcn_mfma_f32_16x16x16bf16_1k(GA, AarB, (f32x4){0.f, 0.f, 0.f, 0.f}, 0, 0, 0);
    const f32x4 H = Akr - hm;
    union { bf16x8 v; bf16x4 h[2]; } ay;
    ay.h[0] = AarB; ay.h[1] = pack4(H[0], H[1], H[2], H[3]);
    *reinterpret_cast<bf16x8*>(mb + R4M_AY + lane * 16) = ay.v;
#pragma unroll
    for (int b = 0; b < 4; ++b) {
      const bf16x4 AtB = *reinterpret_cast<const bf16x4*>(AtT + (16 * b + fr) * 16 + fq * 4);
      const f32x4 zm = __builtin_amdgcn_mfma_f32_16x16x16bf16_1k(GA, AtB, (f32x4){0.f, 0.f, 0.f, 0.f}, 0, 0, 0);
      const bf16x4 ktv = *reinterpret_cast<const bf16x4*>(KtT + (16 * b + fr) * 16 + fq * 4);
      union { bf16x4 v; unsigned short s[4]; } ku; ku.v = ktv;
      *reinterpret_cast<bf16x4*>(mb + R4M_Z + b * 512 + lane * 8) = pack4(bf2f(ku.s[0]) - zm[0], bf2f(ku.s[1]) - zm[1], bf2f(ku.s[2]) - zm[2], bf2f(ku.s[3]) - zm[3]);
    }
  }
}

DEVINL void r4_stageC(const Params& p, const R4Chain& k, int t0, const char* eb, const char* mb, f32x4 (&ST)[4][4], int lane) {
  const int fr = lane & 15, fq = lane >> 4;
  const bf16_t* rhR = reinterpret_cast<const bf16_t*>(eb + R4E_RH);
  const bf16_t* AtT = reinterpret_cast<const bf16_t*>(eb + R4E_ATT);
  const bf16_t* vT = reinterpret_cast<const bf16_t*>(eb + R4E_VT);
  const float* WCf = reinterpret_cast<const float*>(eb + R4E_WC);
  const bf16_t* QpR = reinterpret_cast<const bf16_t*>(mb + R4M_QP);
  float* yout = reinterpret_cast<float*>(p.U3);
  bf16x8 QpA[2], rhA[2], AY, AS[4];
#pragma unroll
  for (int ks = 0; ks < 2; ++ks) {
    union { bf16x8 v; bf16x4 h[2]; } u1, u2;
    u1.h[0] = *reinterpret_cast<const bf16x4*>(QpR + fr * 64 + 32 * ks + 4 * fq);
    u1.h[1] = *reinterpret_cast<const bf16x4*>(QpR + fr * 64 + 32 * ks + 16 + 4 * fq);
    u2.h[0] = *reinterpret_cast<const bf16x4*>(rhR + fr * 64 + 32 * ks + 4 * fq);
    u2.h[1] = *reinterpret_cast<const bf16x4*>(rhR + fr * 64 + 32 * ks + 16 + 4 * fq);
    QpA[ks] = u1.v; rhA[ks] = u2.v;
  }
  AY = *reinterpret_cast<const bf16x8*>(mb + R4M_AY + lane * 16);
#pragma unroll
  for (int b = 0; b < 4; ++b) {
    union { bf16x8 v; bf16x4 h[2]; } u;
    u.h[0] = *reinterpret_cast<const bf16x4*>(AtT + (16 * b + fr) * 16 + fq * 4);
    u.h[1] = *reinterpret_cast<const bf16x4*>(mb + R4M_Z + b * 512 + lane * 8);
    AS[b] = u.v;
  }
#pragma unroll
  for (int nb = 0; nb < 4; ++nb) {
    bf16x8 Bhi[2];
#pragma unroll
    for (int ks = 0; ks < 2; ++ks) {
      union { bf16x8 v; unsigned u[4]; } hi;
      hi.u[0] = pack2(ST[2 * ks][nb][0], ST[2 * ks][nb][1]); hi.u[1] = pack2(ST[2 * ks][nb][2], ST[2 * ks][nb][3]);
      hi.u[2] = pack2(ST[2 * ks + 1][nb][0], ST[2 * ks + 1][nb][1]); hi.u[3] = pack2(ST[2 * ks + 1][nb][2], ST[2 * ks + 1][nb][3]);
      Bhi[ks] = hi.v;
    }
    f32x4 P = {0.f, 0.f, 0.f, 0.f}, R = {0.f, 0.f, 0.f, 0.f};
    P = __builtin_amdgcn_mfma_f32_16x16x32_bf16(QpA[0], Bhi[0], P, 0, 0, 0);
    P = __builtin_amdgcn_mfma_f32_16x16x32_bf16(QpA[1], Bhi[1], P, 0, 0, 0);
    R = __builtin_amdgcn_mfma_f32_16x16x32_bf16(rhA[0], Bhi[0], R, 0, 0, 0);
    R = __builtin_amdgcn_mfma_f32_16x16x32_bf16(rhA[1], Bhi[1], R, 0, 0, 0);
    bf16x8 X;
    {
      union { bf16x8 v; bf16x4 h[2]; } u;
      u.h[0] = pack4(-P[0], -P[1], -P[2], -P[3]);
      u.h[1] = *reinterpret_cast<const bf16x4*>(vT + (16 * nb + fr) * 16 + fq * 4);
      X = u.v;
    }
    const f32x4 Y = __builtin_amdgcn_mfma_f32_16x16x32_bf16(AY, X, R, 0, 0, 0);
#pragma unroll
    for (int e = 0; e < 4; ++e) {
      const int t = t0 + 4 * fq + e;
      const int row = k.base + (k.z == 0 ? t : (k.Tlen - 1 - t));
      yout[((size_t)k.z * TT + row) * DM + k.colb + 16 * nb + fr] = Y[e];
    }
#pragma unroll
    for (int b = 0; b < 4; ++b) {
      const f32x4 wcv = *reinterpret_cast<const f32x4*>(WCf + 16 * b + 4 * fq);
      ST[b][nb] = __builtin_amdgcn_mfma_f32_16x16x32_bf16(AS[b], X, ST[b][nb] * wcv, 0, 0, 0);
    }
    __builtin_amdgcn_sched_barrier(0);
  }
}

DEVINL void r4_load_state(const Params& p, const R4Chain& k, int j, f32x4 (&ST)[4][4], int lane) {
  const int fr = lane & 15, fq = lane >> 4;
  if (k.seq >= 16) {
    const float* s0 = p.in[3] + ((((size_t)(k.seq - 16) * 2 + j) * 2 + k.z) * 16 + k.h) * 4096;
#pragma unroll
    for (int b = 0; b < 4; ++b)
#pragma unroll
      for (int nb = 0; nb < 4; ++nb) ST[b][nb] = *reinterpret_cast<const f32x4*>(s0 + (size_t)(16 * nb + fr) * 64 + 16 * b + 4 * fq);
  } else {
#pragma unroll
    for (int b = 0; b < 4; ++b)
#pragma unroll
      for (int nb = 0; nb < 4; ++nb) ST[b][nb] = (f32x4){0.f, 0.f, 0.f, 0.f};
  }
}
DEVINL int r4_ldcnt(volatile int* c) { return *c; }
#define R4_SPIN(cond) do { while (!(cond)) __builtin_amdgcn_s_sleep(1); } while (0)

DEVINL void phase_r4(const Params& p, int layer, int w, int nw, char* smem, int gwid) {
  const int j = layer >> 1;
  const int wid = __builtin_amdgcn_readfirstlane(tidx(gwid) >> 6);
  char* ebuf = smem;
  char* mbuf = smem + 3 * R4E_BYTES;
  char* msc = mbuf + 2 * R4M_BYTES;
  char* raw0 = msc + R4S_BYTES;
  volatile int* cnt = reinterpret_cast<volatile int*>(raw0 + R4RAW_BYTES);
  char* solo = raw0 + R4RAW_BYTES + 64;
#define R4_SOLO_BYTES (R4E_BYTES + R4M_BYTES + R4S_BYTES + R4RAW_BYTES)
  if (tidx(gwid) < 3) cnt[tidx(gwid)] = 0;
  __syncthreads();
  if (wid == 0) {
    const int lane = tidx(gwid) & 63;
    const R4Chain k = r4_chain(w);
    const float kal = p.in[23][j * 1024 + k.colb + lane];
    r4_dma(p, k, 0, raw0, lane);
#pragma unroll 1
    for (int i = 0; i < 64; ++i) {
      R4_SPIN(r4_ldcnt(cnt + 2) >= i - 2);
      asm volatile("s_waitcnt vmcnt(0)" ::: "memory");
      __builtin_amdgcn_wave_barrier();
      r4_stageE(raw0, ebuf + (i % 3) * R4E_BYTES, kal, lane);
      asm volatile("s_waitcnt lgkmcnt(0)" ::: "memory");
      if (i + 1 < 64) r4_dma(p, k, (i + 1) * 16, raw0, lane);
      if (lane == 0) cnt[0] = i + 1;
    }
  } else if (wid == 1) {
    const int lane = tidx(gwid) & 63;
#pragma unroll 1
    for (int i = 0; i < 64; ++i) {
      R4_SPIN(r4_ldcnt(cnt + 0) >= i + 1 && r4_ldcnt(cnt + 2) >= i - 1);
      __builtin_amdgcn_wave_barrier();
      r4_stageM(ebuf + (i % 3) * R4E_BYTES, mbuf + (i & 1) * R4M_BYTES, msc, lane);
      asm volatile("s_waitcnt lgkmcnt(0)" ::: "memory");
      if (lane == 0) cnt[1] = i + 1;
    }
  } else if (wid == 2) {
    const int lane = tidx(gwid) & 63;
    const R4Chain k = r4_chain(w);
    f32x4 ST[4][4];
    r4_load_state(p, k, j, ST, lane);
#pragma unroll 1
    for (int i = 0; i < 64; ++i) {
      R4_SPIN(r4_ldcnt(cnt + 1) >= i + 1);
      __builtin_amdgcn_wave_barrier();
      r4_stageC(p, k, i * 16, ebuf + (i % 3) * R4E_BYTES, mbuf + (i & 1) * R4M_BYTES, ST, lane);
      asm volatile("s_waitcnt lgkmcnt(0)" ::: "memory");
      if (lane == 0) cnt[2] = i + 1;
    }
  } else if (wid < 5) {
    const int lane = tidx(gwid) & 63;
    const R4Chain k = r4_chain(w + nw * (wid - 2));
    char* my = solo + (wid - 3) * R4_SOLO_BYTES;
    char* eb = my; char* mb = my + R4E_BYTES; char* sc = mb + R4M_BYTES; char* rawb = sc + R4S_BYTES;
    const float kal = p.in[23][j * 1024 + k.colb + lane];
    f32x4 ST[4][4];
    r4_load_state(p, k, j, ST, lane);
    r4_dma(p, k, 0, rawb, lane);
#pragma unroll 1
    for (int t0 = 0; t0 < k.Tlen; t0 += 16) {
      asm volatile("s_waitcnt vmcnt(0)" ::: "memory");
      __builtin_amdgcn_wave_barrier();
      r4_stageE(rawb, eb, kal, lane);
      asm volatile("s_waitcnt lgkmcnt(0)" ::: "memory");
      if (t0 + 16 < k.Tlen) r4_dma(p, k, t0 + 16, rawb, lane);
      __builtin_amdgcn_wave_barrier();
      r4_stageM(eb, mb, sc, lane);
      __builtin_amdgcn_wave_barrier();
      r4_stageC(p, k, t0, eb, mb, ST, lane);
    }
    {
      const int l2 = tidx(gwid) & 63, fr2 = l2 & 15, fq2 = l2 >> 4;
      float* so = p.out + OUT_STATE + ((((size_t)k.seq * 2 + j) * 2 + k.z) * 16 + k.h) * 4096;
#pragma unroll
      for (int b = 0; b < 4; ++b)
#pragma unroll
        for (int nb = 0; nb < 4; ++nb) *reinterpret_cast<f32x4*>(so + (size_t)(16 * nb + fr2) * 64 + 16 * b + 4 * fq2) = ST[b][nb];
    }
  }
}

DEVINL void phase_r5(const Params& p, int layer, int w, int nw, int gwid) {
  const int j = layer >> 1;
  const int lane = tidx(gwid) & 63;
  const int gw = w * NWAVES + (tidx(gwid) >> 6), ngw = nw * NWAVES;
  const bf16_t* rb = reinterpret_cast<const bf16_t*>(p.U2);
  const bf16_t* kb = rb + (size_t)TT * DM;
  const bf16_t* vb = kb + (size_t)TT * DM;
  const bf16_t* aa = reinterpret_cast<const bf16_t*>(p.U1 + U1_AA_OFF);
  const bf16_t* gg = reinterpret_cast<const bf16_t*>(p.U1 + U1_GG_OFF);
  const float* yin = reinterpret_cast<const float*>(p.U3);
  const float* ka = p.in[23] + j * 1024;
  const float* rk = p.in[24] + j * 1024;
  const float* lg = p.in[25] + j * 1024;
  const float* lb = p.in[26] + j * 1024;
  for (int row = gw; row < TT; row += ngw) {
#pragma unroll
    for (int k = 0; k < 4; ++k) {
      const int col = k * 256 + lane * 4;
      const size_t o = (size_t)row * DM + col;
      const float4 yf = *reinterpret_cast<const float4*>(yin + o);
      const float4 yb = *reinterpret_cast<const float4*>(yin + (size_t)TT * DM + o);
      const uint2 r2 = *reinterpret_cast<const uint2*>(rb + o);
      const uint2 k2 = *reinterpret_cast<const uint2*>(kb + o);
      const uint2 v2 = *reinterpret_cast<const uint2*>(vb + o);
      const uint2 a02 = *reinterpret_cast<const uint2*>(aa + o);
      const uint2 a12 = *reinterpret_cast<const uint2*>(aa + (size_t)TT * DM + o);
      const uint2 g2 = *reinterpret_cast<const uint2*>(gg + o);
      const float4 ka4 = *reinterpret_cast<const float4*>(ka + col);
      const float4 rk4 = *reinterpret_cast<const float4*>(rk + col);
      const float4 lg4 = *reinterpret_cast<const float4*>(lg + col);
      const float4 lb4 = *reinterpret_cast<const float4*>(lb + col);
      float y[4] = {yf.x + yb.x, yf.y + yb.y, yf.z + yb.z, yf.w + yb.w};
      float r[4] = {bflo(r2.x), bfhi(r2.x), bflo(r2.y), bfhi(r2.y)};
      float kx[4] = {bflo(k2.x), bfhi(k2.x), bflo(k2.y), bfhi(k2.y)};
      float v[4] = {bflo(v2.x), bfhi(v2.x), bflo(v2.y), bfhi(v2.y)};
      float a0[4] = {bflo(a02.x), bfhi(a02.x), bflo(a02.y), bfhi(a02.y)};
      float a1[4] = {bflo(a12.x), bfhi(a12.x), bflo(a12.y), bfhi(a12.y)};
      float g[4] = {bflo(g2.x), bfhi(g2.x), bflo(g2.y), bfhi(g2.y)};
      float kav[4] = {ka4.x, ka4.y, ka4.z, ka4.w}, rkv[4] = {rk4.x, rk4.y, rk4.z, rk4.w};
      float lgv[4] = {lg4.x, lg4.y, lg4.z, lg4.w}, lbv[4] = {lb4.x, lb4.y, lb4.z, lb4.w};
      float sm = y[0] + y[1] + y[2] + y[3];
      sm = grp16_sum(sm);
      const float mean = sm * (1.0f / 64.0f);
      float sv = 0.f, sb = 0.f;
#pragma unroll
      for (int e = 0; e < 4; ++e) {
        float d = y[e] - mean; sv += d * d;
        float kd0 = kx[e] * (1.0f + (a0[e] - 1.0f) * kav[e]);
        float kd1 = kx[e] * (1.0f + (a1[e] - 1.0f) * kav[e]);
        sb += r[e] * (kd0 + kd1) * rkv[e];
      }
      sv = grp16_sum(sv); sb = grp16_sum(sb);
      const float rstd = rsqrtf(sv * (1.0f / 64.0f) + GN_EPS_F);
      float o4[4];
#pragma unroll
      for (int e = 0; e < 4; ++e) {
        float yn = (y[e] - mean) * rstd * lgv[e] + lbv[e];
        o4[e] = (yn + sb * v[e]) * g[e];
      }
      uint2 oo; oo.x = pack2(o4[0], o4[1]); oo.y = pack2(o4[2], o4[3]);
      *reinterpret_cast<uint2*>(p.abuf + o) = oo;
    }
  }
}

struct EpiWO {
  static constexpr bool PERM = false;
  const float* x; const float* mod; float* z; int layer;
  DEVINL void operator()(const f32x4 (&acc)[2][2][4][2], const pg8::Unit& u, int wr, int wc, int fr, int fq) const {
    const int row0 = u.pm * 256 + wr * 64 + fr, col0 = u.pn * 256 + wc * 32 + 4 * fq;
    const float* gate = mod + ((size_t)layer * 9 + cond_of_row(u.pm * 256)) * 6144 + 2 * 1024;
    f32x4 gv[2][2];
#pragma unroll
    for (int bj = 0; bj < 2; ++bj)
#pragma unroll
      for (int n = 0; n < 2; ++n) gv[bj][n] = *reinterpret_cast<const f32x4*>(gate + col0 + bj * 128 + n * 16);
#pragma unroll
    for (int ai = 0; ai < 2; ++ai)
#pragma unroll
      for (int m = 0; m < 4; ++m) {
        const size_t off = (size_t)(row0 + ai * 128 + m * 16) * DM + col0;
#pragma unroll
        for (int bj = 0; bj < 2; ++bj)
#pragma unroll
          for (int n = 0; n < 2; ++n) {
            const f32x4 xv = *reinterpret_cast<const f32x4*>(x + off + bj * 128 + n * 16);
            *reinterpret_cast<f32x4*>(z + off + bj * 128 + n * 16) = ALPHA_F * xv + gv[bj][n] * acc[ai][bj][m][n];
          }
        asm volatile("" ::: "memory");
      }
  }
};
DEVINL void phase_wo(const Params& p, int layer, int w, int nw, char* smem, int gwid) {
  const int j = layer >> 1;
  const bf16_t* Wt = ((layer & 1) ? p.attn_wo_t : p.rwkv_wo_t) + ((size_t)j << 20);
  EpiWO E; E.x = p.xbuf; E.mod = p.mod; E.z = p.zbuf; E.layer = layer;
  pg8::ASelOne as; as.A = (const char*)p.abuf;
  pg8::StaticOrder S; S.init(TT, 1024, nw, w);
  pg8::gemm_phase<EpiWO, pg8::ASelOne>((PG8_LAS unsigned char*)smem, as, Wt, 1024, S, E, gwid);
}

DEVINL void phase_ln1(const Params& p, int layer, int w, int nw, int gwid) {
  const int lane = tidx(gwid) & 63;
  const int gw = w * NWAVES + (tidx(gwid) >> 6), ngw = nw * NWAVES;
  const float* lng = p.in[9] + (size_t)(layer * 2 + 0) * 1024;
  const float* lnb = p.in[10] + (size_t)(layer * 2 + 0) * 1024;
  for (int row = gw; row < TT; row += ngw) {
    const float* md = p.mod + ((size_t)layer * 9 + cond_of_row(row)) * 6144;
    float4 z[4];
    float s = 0.f;
#pragma unroll
    for (int k = 0; k < 4; ++k) {
      z[k] = *reinterpret_cast<const float4*>(p.zbuf + (size_t)row * DM + k * 256 + lane * 4);
      s += z[k].x + z[k].y + z[k].z + z[k].w;
    }
    const float mean = wave_sum(s) * (1.0f / 1024.0f);
    float sv = 0.f;
#pragma unroll
    for (int k = 0; k < 4; ++k) {
      float a = z[k].x - mean, b = z[k].y - mean, c = z[k].z - mean, d = z[k].w - mean;
      sv += a * a + b * b + c * c + d * d;
    }
    const float rstd = rsqrtf(wave_sum(sv) * (1.0f / 1024.0f) + LN_EPS_F);
#pragma unroll
    for (int k = 0; k < 4; ++k) {
      const int col = k * 256 + lane * 4;
      const float4 g4 = *reinterpret_cast<const float4*>(lng + col);
      const float4 b4 = *reinterpret_cast<const float4*>(lnb + col);
      const float4 sh = *reinterpret_cast<const float4*>(md + 3 * 1024 + col);
      const float4 sc = *reinterpret_cast<const float4*>(md + 4 * 1024 + col);
      float4 x1;
      x1.x = (z[k].x - mean) * rstd * g4.x + b4.x;
      x1.y = (z[k].y - mean) * rstd * g4.y + b4.y;
      x1.z = (z[k].z - mean) * rstd * g4.z + b4.z;
      x1.w = (z[k].w - mean) * rstd * g4.w + b4.w;
      *reinterpret_cast<float4*>(p.xbuf + (size_t)row * DM + col) = x1;
      uint2 o;
      o.x = pack2(x1.x * (1.0f + sc.x) + sh.x, x1.y * (1.0f + sc.y) + sh.y);
      o.y = pack2(x1.z * (1.0f + sc.z) + sh.z, x1.w * (1.0f + sc.w) + sh.w);
      *reinterpret_cast<uint2*>(p.hbuf + (size_t)row * DM + col) = o;
    }
  }
}

struct EpiBf16 {
  static constexpr bool PERM = true;
  bf16_t* O; int ldc;
  DEVINL void operator()(const f32x4 (&acc)[2][2][4][2], const pg8::Unit& u, int wr, int wc, int fr, int fq) const {
    const int row0 = u.pm * 256 + wr * 64 + fr, col0 = u.pn * 256 + wc * 32 + 8 * fq;
#pragma unroll
    for (int ai = 0; ai < 2; ++ai)
#pragma unroll
      for (int m = 0; m < 4; ++m) {
        bf16_t* rowp = O + (size_t)(row0 + ai * 128 + m * 16) * ldc + col0;
#pragma unroll
        for (int bj = 0; bj < 2; ++bj) {
          const f32x4 v0 = acc[ai][bj][m][0], v1 = acc[ai][bj][m][1];
          pg8::u32x4 o; o.x = pg8::cvt_pk_bf16(v0[0], v0[1]); o.y = pg8::cvt_pk_bf16(v0[2], v0[3]); o.z = pg8::cvt_pk_bf16(v1[0], v1[1]); o.w = pg8::cvt_pk_bf16(v1[2], v1[3]);
          *reinterpret_cast<pg8::u32x4*>(rowp + bj * 128) = o;
        }
      }
  }
};

DEVINL void phase_p1(const Params& p, int layer, int w, int nw, char* smem, int gwid) {
  EpiBf16 E; E.O = reinterpret_cast<bf16_t*>(p.U1); E.ldc = 2048;
  pg8::ASelOne as; as.A = (const char*)p.hbuf;
  pg8::StaticOrder S; S.init(TT, 2048, nw, w);
  pg8::gemm_phase<EpiBf16, pg8::ASelOne>((PG8_LAS unsigned char*)smem, as, p.wq_t + (size_t)layer * 2048 * 1024, 1024, S, E, gwid);
}

#define U1_S_OFF ((size_t)TT * 2048 * 2)
DEVINL void phase_p2(const Params& p, int layer, int w, int nw, char* smem, int gwid) {
  GEMM_LANE_VARS
  const int half = tidx(gwid) >> 8;
  char* sh = smem + half * 16384;
  const bf16_t* qb = reinterpret_cast<const bf16_t*>(p.U1);
  float* sb = reinterpret_cast<float*>(p.U1 + U1_S_OFF);
  const int NTILES = 96 * 16;
  for (int it = 0; it * nw * 2 < NTILES; ++it) {
    int tile = (it * nw + w) * 2 + half;
    const bool valid = tile < NTILES;
    if (!valid) tile = 0;
    const int ct = tile / 96, rt = tile % 96;
    const int row0 = rt * 128;
    const int z = ct & 1;
    f32x4 acc[4][4];
    gemm_tile_128(qb + (size_t)row0 * 2048 + ct * 128, 2048, p.keysb + (size_t)(layer * 2 + z) * 16384, 128, 128, sh, acc, gwid);
    if (valid) {
#pragma unroll
      for (int m = 0; m < 4; ++m)
#pragma unroll
        for (int n = 0; n < 4; ++n)
#pragma unroll
          for (int jj = 0; jj < 4; ++jj) {
            int row = row0 + wr * 64 + m * 16 + fq * 4 + jj, col = wc * 64 + n * 16 + fr;
            sb[(size_t)row * 2048 + ct * 128 + col] = acc[m][n][jj];
          }
    }
  }
}

DEVINL float unordf(unsigned u) { return __uint_as_float((u & 0x80000000u) ? (u ^ 0x80000000u) : ~u); }
#define CSWAP(a, b) { const unsigned _hi = umax_(a, b), _lo = umin_(a, b); a = _hi; b = _lo; }
DEVINL void slot_ij(int s, int& i, int& j) {
  if (s < 16) { i = 0; j = s; }
  else if (s < 24) { i = 1; j = s - 16; }
  else if (s < 29) { i = 2; j = s - 24; }
  else if (s < 33) { i = 3; j = s - 29; }
  else if (s < 36) { i = 4; j = s - 33; }
  else if (s < 42) { i = 5 + ((s - 36) >> 1); j = (s - 36) & 1; }
  else { i = s - 34; j = 0; }
}
DEVINL void phase_p3(const Params& p, int layer, int w, int nw, char* smem, int gwid) {
  const int lane = tidx(gwid) & 63, wid = tidx(gwid) >> 6;
  const int fr = lane & 15, row = lane >> 4, pr = lane >> 5, l32 = lane & 31;
  const int gw = w * NWAVES + wid, ngw = nw * NWAVES;
  const float* sb = reinterpret_cast<const float*>(p.U1 + U1_S_OFF);
  float* svl = reinterpret_cast<float*>(smem) + wid * 128;
  int* sil = reinterpret_cast<int*>(smem) + wid * 128 + 64;
  int iA, jA, iB, jB;
  slot_ij(l32, iA, jA);
  const bool validB = (l32 + 32) < 50;
  slot_ij(validB ? (l32 + 32) : 0, iB, jB);
  for (int bt = gw; bt < TT * 4; bt += ngw) {
    const int t = bt >> 2, hp = bt & 3;
    {
      const int h = hp * 2 + (row >> 1), z = row & 1;
      const float* sp = sb + (size_t)t * 2048 + (h * 2 + z) * 128;
      const float4 a = *reinterpret_cast<const float4*>(sp + fr * 4);
      const float4 b = *reinterpret_cast<const float4*>(sp + 64 + fr * 4);
      unsigned k0 = (ordf(a.x) & ~127u) | (unsigned)(127 - (4 * fr + 0));
      unsigned k1 = (ordf(a.y) & ~127u) | (unsigned)(127 - (4 * fr + 1));
      unsigned k2 = (ordf(a.z) & ~127u) | (unsigned)(127 - (4 * fr + 2));
      unsigned k3 = (ordf(a.w) & ~127u) | (unsigned)(127 - (4 * fr + 3));
      unsigned k4 = (ordf(b.x) & ~127u) | (unsigned)(127 - (64 + 4 * fr + 0));
      unsigned k5 = (ordf(b.y) & ~127u) | (unsigned)(127 - (64 + 4 * fr + 1));
      unsigned k6 = (ordf(b.z) & ~127u) | (unsigned)(127 - (64 + 4 * fr + 2));
      unsigned k7 = (ordf(b.w) & ~127u) | (unsigned)(127 - (64 + 4 * fr + 3));
      CSWAP(k0, k1); CSWAP(k2, k3); CSWAP(k4, k5); CSWAP(k6, k7);
      CSWAP(k0, k2); CSWAP(k1, k3); CSWAP(k4, k6); CSWAP(k5, k7);
      CSWAP(k1, k2); CSWAP(k5, k6); CSWAP(k0, k4); CSWAP(k3, k7);
      CSWAP(k1, k5); CSWAP(k2, k6);
      CSWAP(k1, k4); CSWAP(k3, k6);
      CSWAP(k2, k4); CSWAP(k3, k5);
      CSWAP(k3, k4);
      unsigned mine = 0;
#pragma unroll
      for (int it = 0; it < 16; ++it) {
        const unsigned m = row_max_u(k0);
        if (fr == it) mine = m;
        const bool c = (k0 == m);
        k0 = c ? k1 : k0; k1 = c ? k2 : k1; k2 = c ? k3 : k2; k3 = c ? k4 : k3;
        k4 = c ? k5 : k4; k5 = c ? k6 : k5; k6 = c ? k7 : k6; k7 = c ? 0u : k7;
      }
      __builtin_amdgcn_wave_barrier();
      svl[row * 16 + fr] = unordf(mine & ~127u);
      sil[row * 16 + fr] = 127 - (int)(mine & 127u);
      __builtin_amdgcn_wave_barrier();
    }
    {
      const float* v0 = svl + (2 * pr) * 16;
      const float* v1 = svl + (2 * pr + 1) * 16;
      unsigned kA = (ordf(v0[iA] + v1[jA]) & ~63u) | (unsigned)(63 - l32);
      unsigned kB = validB ? ((ordf(v0[iB] + v1[jB]) & ~63u) | (unsigned)(63 - (l32 + 32))) : 0u;
      unsigned mine = 0;
#pragma unroll
      for (int it = 0; it < 16; ++it) {
        unsigned m = row_max_u(umax_(kA, kB));
        m = umax_(m, (unsigned)__shfl_xor((int)m, 16));
        if (l32 == it) mine = m;
        kA = (kA == m) ? 0u : kA;
        kB = (kB == m) ? 0u : kB;
      }
      int ii, jj;
      slot_ij(63 - (int)(mine & 63u), ii, jj);
      ii &= 15; jj &= 15;
      const float cv = v0[ii] + v1[jj];
      const int eidx = sil[(2 * pr) * 16 + ii] * 128 + sil[(2 * pr + 1) * 16 + jj];
      const float mx = row_max_f(cv);
      const float ex = __expf(cv - mx);
      const float sm = row_sum_f(ex);
      if (l32 < 16) {
        const int h = hp * 2 + pr;
        p.pidx[(size_t)t * 128 + h * 16 + l32] = eidx;
        p.pgate[(size_t)t * 128 + h * 16 + l32] = ex / sm;
      }
    }
  }
}

DEVINL void phase_p23(const Params& p, int layer, int w, int nw, char* smem, int gwid) {
  GEMM_LANE_VARS
  const int l64 = tidx(gwid) & 63, wid8 = tidx(gwid) >> 6, half = tidx(gwid) >> 8;
  const int row = l64 >> 4, pr = l64 >> 5, l32 = l64 & 31;
  const bf16_t* qb = reinterpret_cast<const bf16_t*>(p.U1);
  float* tiles = reinterpret_cast<float*>(smem);
  float* svl = reinterpret_cast<float*>(smem + 131072) + wid8 * 128;
  int* sil = reinterpret_cast<int*>(smem + 131072) + wid8 * 128 + 64;
  int iA, jA, iB, jB;
  slot_ij(l32, iA, jA);
  const bool validB = (l32 + 32) < 50;
  slot_ij(validB ? (l32 + 32) : 0, iB, jB);
  for (int unit = w; unit < 96 * 8; unit += nw) {
    const int h = unit / 96, rt = unit % 96;
    const int row0 = rt * 128;
    {
      f32x4 acc[4][4];
      gemm_tile_128(qb + (size_t)row0 * 2048 + (h * 2 + half) * 128, 2048, p.keysb + (size_t)(layer * 2 + half) * 16384, 128, 128, smem + half * 16384, acc, gwid);
      float* tz = tiles + half * 16384;
#pragma unroll
      for (int m = 0; m < 4; ++m)
#pragma unroll
        for (int n = 0; n < 4; ++n)
#pragma unroll
          for (int jj = 0; jj < 4; ++jj) tz[(wr * 64 + m * 16 + fq * 4 + jj) * 128 + wc * 64 + n * 16 + fr] = acc[m][n][jj];
    }
    __syncthreads();
#pragma unroll 1
    for (int i = 0; i < 8; ++i) {
      const int tl = wid8 * 16 + i * 2;
      {
        const int z = row & 1, tt = tl + (row >> 1);
        const float* sp = tiles + z * 16384 + tt * 128;
        const float4 a = *reinterpret_cast<const float4*>(sp + fr * 4);
        const float4 b = *reinterpret_cast<const float4*>(sp + 64 + fr * 4);
        unsigned k0 = (ordf(a.x) & ~127u) | (unsigned)(127 - (4 * fr + 0));
        unsigned k1 = (ordf(a.y) & ~127u) | (unsigned)(127 - (4 * fr + 1));
        unsigned k2 = (ordf(a.z) & ~127u) | (unsigned)(127 - (4 * fr + 2));
        unsigned k3 = (ordf(a.w) & ~127u) | (unsigned)(127 - (4 * fr + 3));
        unsigned k4 = (ordf(b.x) & ~127u) | (unsigned)(127 - (64 + 4 * fr + 0));
        unsigned k5 = (ordf(b.y) & ~127u) | (unsigned)(127 - (64 + 4 * fr + 1));
        unsigned k6 = (ordf(b.z) & ~127u) | (unsigned)(127 - (64 + 4 * fr + 2));
        unsigned k7 = (ordf(b.w) & ~127u) | (unsigned)(127 - (64 + 4 * fr + 3));
        CSWAP(k0, k1); CSWAP(k2, k3); CSWAP(k4, k5); CSWAP(k6, k7);
        CSWAP(k0, k2); CSWAP(k1, k3); CSWAP(k4, k6); CSWAP(k5, k7);
        CSWAP(k1, k2); CSWAP(k5, k6); CSWAP(k0, k4); CSWAP(k3, k7);
        CSWAP(k1, k5); CSWAP(k2, k6);
        CSWAP(k1, k4); CSWAP(k3, k6);
        CSWAP(k2, k4); CSWAP(k3, k5);
        CSWAP(k3, k4);
        unsigned mine = 0;
#pragma unroll
        for (int it = 0; it < 16; ++it) {
          const unsigned m = row_max_u(k0);
          if (fr == it) mine = m;
          const bool c = (k0 == m);
          k0 = c ? k1 : k0; k1 = c ? k2 : k1; k2 = c ? k3 : k2; k3 = c ? k4 : k3;
          k4 = c ? k5 : k4; k5 = c ? k6 : k5; k6 = c ? k7 : k6; k7 = c ? 0u : k7;
        }
        __builtin_amdgcn_wave_barrier();
        svl[row * 16 + fr] = unordf(mine & ~127u);
        sil[row * 16 + fr] = 127 - (int)(mine & 127u);
        __builtin_amdgcn_wave_barrier();
      }
      {
        const float* v0 = svl + (2 * pr) * 16;
        const float* v1 = svl + (2 * pr + 1) * 16;
        unsigned kA = (ordf(v0[iA] + v1[jA]) & ~63u) | (unsigned)(63 - l32);
        unsigned kB = validB ? ((ordf(v0[iB] + v1[jB]) & ~63u) | (unsigned)(63 - (l32 + 32))) : 0u;
        unsigned mine = 0;
#pragma unroll
        for (int it = 0; it < 16; ++it) {
          unsigned m = row_max_u(umax_(kA, kB));
          m = umax_(m, (unsigned)__shfl_xor((int)m, 16));
          if (l32 == it) mine = m;
          kA = (kA == m) ? 0u : kA;
          kB = (kB == m) ? 0u : kB;
        }
        int ii, jj;
        slot_ij(63 - (int)(mine & 63u), ii, jj);
        ii &= 15; jj &= 15;
        const float cv = v0[ii] + v1[jj];
        const int eidx = sil[(2 * pr) * 16 + ii] * 128 + sil[(2 * pr + 1) * 16 + jj];
        const float mx = row_max_f(cv);
        const float ex = __expf(cv - mx);
        const float sm = row_sum_f(ex);
        if (l32 < 16) {
          const int t = row0 + tl + pr;
          p.pidx[(size_t)t * 128 + h * 16 + l32] = eidx;
          p.pgate[(size_t)t * 128 + h * 16 + l32] = ex / sm;
        }
      }
    }
    __syncthreads();
  }
}

DEVINL float gelu_exact(float x) { return 0.5f * x * (1.0f + erff(x * 0.7071067811865476f)); }

typedef __attribute__((ext_vector_type(8))) int i32x8;
#define P4_WAVE_LDS 19456
DEVINL void phase_p4(const Params& p, int layer, int w, int nw, char* smem, int gwid) {
  const int wid = __builtin_amdgcn_readfirstlane(tidx(gwid) >> 6);
  const int gw = w * NWAVES + wid, ngw = nw * NWAVES;
  const unsigned char* U = reinterpret_cast<const unsigned char*>(p.ub) + (size_t)layer * 16384 * 512;
  const unsigned char* V = reinterpret_cast<const unsigned char*>(p.vb) + (size_t)layer * 16384 * 512;
  const unsigned char* Usc = reinterpret_cast<const unsigned char*>(p.ub) + (size_t)65536 * 512 + (size_t)layer * 16384 * 32;
  const unsigned char* Vsc = reinterpret_cast<const unsigned char*>(p.vb) + (size_t)65536 * 512 + (size_t)layer * 16384 * 32;
  const float* lng = p.in[9] + (size_t)(layer * 2 + 1) * 1024;
  const float* lnb = p.in[10] + (size_t)(layer * 2 + 1) * 1024;
  float* xout = (layer == 3) ? p.out : p.xbuf;
  char* wl = smem + wid * P4_WAVE_LDS;
  unsigned char* xq = reinterpret_cast<unsigned char*>(wl);
  unsigned char* xsc = xq + 1536;
  float* wgt = reinterpret_cast<float*>(wl + 2048);
  int* il = reinterpret_cast<int*>(wl + 2560);
  unsigned char* vscl = reinterpret_cast<unsigned char*>(wl) + 3072;
  unsigned char* ring = reinterpret_cast<unsigned char*>(wl) + 7168;
  for (int t = gw; t < TT; t += ngw) {
    __builtin_amdgcn_wave_barrier();
    const int lane = tidx(gwid) & 63, fr = lane & 15, fq = lane >> 4;
    const int gl = lane;
    {
      const uint4 a = *reinterpret_cast<const uint4*>(p.hbuf + (size_t)t * DM + gl * 16);
      const uint4 b = *reinterpret_cast<const uint4*>(p.hbuf + (size_t)t * DM + gl * 16 + 8);
      float x[16];
      x[0] = bflo(a.x); x[1] = bfhi(a.x); x[2] = bflo(a.y); x[3] = bfhi(a.y); x[4] = bflo(a.z); x[5] = bfhi(a.z); x[6] = bflo(a.w); x[7] = bfhi(a.w);
      x[8] = bflo(b.x); x[9] = bfhi(b.x); x[10] = bflo(b.y); x[11] = bfhi(b.y); x[12] = bflo(b.z); x[13] = bfhi(b.z); x[14] = bflo(b.w); x[15] = bfhi(b.w);
#pragma unroll
      for (int term = 0; term < 3; ++term) {
        float mx = 0.f;
#pragma unroll
        for (int q = 0; q < 16; ++q) mx = fmaxf(mx, fabsf(x[q]));
        mx = fmaxf(mx, __int_as_float(__builtin_amdgcn_update_dpp(0, __float_as_int(mx), DPP_QP_1032, 0xf, 0xf, true)));
        const unsigned yb = __float_as_uint(mx * (1.0f / 6.0f));
        unsigned eb = ((yb >> 23) & 0xFFu) + ((yb & 0x7FFFFFu) ? 1u : 0u);
        eb = eb < 1u ? 1u : (eb > 254u ? 254u : eb);
        if (mx == 0.f) eb = 127u;
        const float inv = __uint_as_float((254u - eb) << 23), sc = __uint_as_float(eb << 23);
        unsigned w0 = 0, w1 = 0;
#define Q4(q) w0 = __builtin_amdgcn_cvt_scalef32_pk_fp4_f32(w0, x[2 * q] * inv, x[2 * q + 1] * inv, 1.0f, q); \
               w1 = __builtin_amdgcn_cvt_scalef32_pk_fp4_f32(w1, x[8 + 2 * q] * inv, x[8 + 2 * q + 1] * inv, 1.0f, q);
        Q4(0) Q4(1) Q4(2) Q4(3)
#undef Q4
        uint2 o2; o2.x = w0; o2.y = w1;
        *reinterpret_cast<uint2*>(xq + term * 512 + lane * 8) = o2;
        if ((lane & 1) == 0) { const int bb = lane >> 1; xsc[term * 32 + (bb & 3) * 8 + (bb >> 2)] = (unsigned char)eb; }
        if (term < 2) {
#define R4(q) { const __attribute__((ext_vector_type(2))) float a2 = __builtin_amdgcn_cvt_scalef32_pk_f32_fp4(w0, 1.0f, q); \
                const __attribute__((ext_vector_type(2))) float b2 = __builtin_amdgcn_cvt_scalef32_pk_f32_fp4(w1, 1.0f, q); \
                x[2 * q] -= sc * a2.x; x[2 * q + 1] -= sc * a2.y; x[8 + 2 * q] -= sc * b2.x; x[8 + 2 * q + 1] -= sc * b2.y; }
          R4(0) R4(1) R4(2) R4(3)
#undef R4
        }
      }
      il[lane] = p.pidx[(size_t)t * 128 + gl];
      il[64 + lane] = p.pidx[(size_t)t * 128 + 64 + gl];
    }
    __builtin_amdgcn_wave_barrier();
#pragma unroll
    for (int i = 0; i < 4; ++i) {
      const int rr = il[i * 32 + (lane >> 1)];
      __builtin_amdgcn_global_load_lds((const unsigned*)(Vsc + (size_t)rr * 32 + (lane & 1) * 16), (unsigned*)(vscl + i * 1024 + lane * 16), 16, 0, 0);
    }
    f32x4 acc[8];
#pragma unroll
    for (int g = 0; g < 8; ++g) acc[g] = (f32x4){0.f, 0.f, 0.f, 0.f};
    {
      const int dr = lane >> 3, dpc = (lane & 7) ^ (lane >> 3);
      unsigned sclo[8], schi[8];
      unsigned xslo[3], xshi[3];
#pragma unroll
      for (int term = 0; term < 3; ++term) { const uint2 s2 = *reinterpret_cast<const uint2*>(xsc + term * 32 + fq * 8); xslo[term] = s2.x; xshi[term] = s2.y; }
#pragma unroll
      for (int g = 0; g < 8; ++g) {
        const uint2 s2 = *reinterpret_cast<const uint2*>(Usc + (size_t)il[g * 16 + fr] * 32 + fq * 8);
        sclo[g] = s2.x; schi[g] = s2.y;
      }
      const int rd0 = fr * 128 + ((fq ^ (fr & 7)) * 16), rd1 = fr * 128 + (((4 + fq) ^ (fr & 7)) * 16);
#define P4_ISSUE(tile_c, tile_g, slot) do { \
        const unsigned _o0 = (unsigned)il[(tile_g) * 16 + dr] * 512u + (unsigned)dpc * 16u + (unsigned)((tile_c) * 128); \
        const unsigned _o1 = (unsigned)il[(tile_g) * 16 + 8 + dr] * 512u + (unsigned)dpc * 16u + (unsigned)((tile_c) * 128); \
        __builtin_amdgcn_global_load_lds((const unsigned*)(U + _o0), (unsigned*)(ring + (slot) * 2048 + lane * 16), 16, 0, 0); \
        __builtin_amdgcn_global_load_lds((const unsigned*)(U + _o1), (unsigned*)(ring + (slot) * 2048 + 1024 + lane * 16), 16, 0, 0); } while (0)
#define P4_WAITV(n) asm volatile("s_waitcnt vmcnt(" #n ")" ::: "memory")
      P4_ISSUE(0, 0, 0); P4_ISSUE(0, 1, 1); P4_ISSUE(0, 2, 2); P4_ISSUE(0, 3, 3); P4_ISSUE(0, 4, 4); P4_ISSUE(0, 5, 5);
#pragma unroll 1
      for (int c = 0; c < 4; ++c) {
        i32x8 xb[3][2];
#pragma unroll
        for (int term = 0; term < 3; ++term)
#pragma unroll
          for (int m2 = 0; m2 < 2; ++m2) {
            const uint4 x4 = *reinterpret_cast<const uint4*>(xq + term * 512 + (c * 8 + m2 * 4 + fq) * 16);
            xb[term][m2] = (i32x8){(int)x4.x, (int)x4.y, (int)x4.z, (int)x4.w, 0, 0, 0, 0};
          }
        const int xs0 = (c < 2) ? (int)xslo[0] : (int)xshi[0], xs1 = (c < 2) ? (int)xslo[1] : (int)xshi[1], xs2 = (c < 2) ? (int)xslo[2] : (int)xshi[2];
#pragma unroll
        for (int g = 0; g < 8; ++g) {
          const int ti = c * 8 + g;
          if (c < 3 || g < 3) P4_WAITV(10);
          else if (g == 3) P4_WAITV(8);
          else if (g == 4) P4_WAITV(6);
          else if (g == 5) P4_WAITV(4);
          else if (g == 6) P4_WAITV(2);
          else P4_WAITV(0);
          const int slot = ti % 6;
          const uint4 a0v = *reinterpret_cast<const uint4*>(ring + slot * 2048 + rd0);
          const uint4 a1v = *reinterpret_cast<const uint4*>(ring + slot * 2048 + rd1);
          asm volatile("s_waitcnt lgkmcnt(0)" ::: "memory");
          if (ti + 6 < 32) P4_ISSUE((ti + 6) >> 3, (g + 6) & 7, slot);
          const i32x8 A0 = (i32x8){(int)a0v.x, (int)a0v.y, (int)a0v.z, (int)a0v.w, 0, 0, 0, 0};
          const i32x8 A1 = (i32x8){(int)a1v.x, (int)a1v.y, (int)a1v.z, (int)a1v.w, 0, 0, 0, 0};
          const int sreg = (c < 2) ? (int)sclo[g] : (int)schi[g];
          if ((c & 1) == 0) {
            acc[g] = __builtin_amdgcn_mfma_scale_f32_16x16x128_f8f6f4(A0, xb[0][0], acc[g], 4, 4, 0, sreg, 0, xs0);
            acc[g] = __builtin_amdgcn_mfma_scale_f32_16x16x128_f8f6f4(A1, xb[0][1], acc[g], 4, 4, 1, sreg, 1, xs0);
            acc[g] = __builtin_amdgcn_mfma_scale_f32_16x16x128_f8f6f4(A0, xb[1][0], acc[g], 4, 4, 0, sreg, 0, xs1);
            acc[g] = __builtin_amdgcn_mfma_scale_f32_16x16x128_f8f6f4(A1, xb[1][1], acc[g], 4, 4, 1, sreg, 1, xs1);
            acc[g] = __builtin_amdgcn_mfma_scale_f32_16x16x128_f8f6f4(A0, xb[2][0], acc[g], 4, 4, 0, sreg, 0, xs2);
            acc[g] = __builtin_amdgcn_mfma_scale_f32_16x16x128_f8f6f4(A1, xb[2][1], acc[g], 4, 4, 1, sreg, 1, xs2);
          } else {
            acc[g] = __builtin_amdgcn_mfma_scale_f32_16x16x128_f8f6f4(A0, xb[0][0], acc[g], 4, 4, 2, sreg, 2, xs0);
            acc[g] = __builtin_amdgcn_mfma_scale_f32_16x16x128_f8f6f4(A1, xb[0][1], acc[g], 4, 4, 3, sreg, 3, xs0);
            acc[g] = __builtin_amdgcn_mfma_scale_f32_16x16x128_f8f6f4(A0, xb[1][0], acc[g], 4, 4, 2, sreg, 2, xs1);
            acc[g] = __builtin_amdgcn_mfma_scale_f32_16x16x128_f8f6f4(A1, xb[1][1], acc[g], 4, 4, 3, sreg, 3, xs1);
            acc[g] = __builtin_amdgcn_mfma_scale_f32_16x16x128_f8f6f4(A0, xb[2][0], acc[g], 4, 4, 2, sreg, 2, xs2);
            acc[g] = __builtin_amdgcn_mfma_scale_f32_16x16x128_f8f6f4(A1, xb[2][1], acc[g], 4, 4, 3, sreg, 3, xs2);
          }
          __builtin_amdgcn_sched_barrier(0);
        }
      }
#undef P4_ISSUE
    }
#pragma unroll
    for (int g = 0; g < 8; ++g) {
      const float4 gt = *reinterpret_cast<const float4*>(p.pgate + (size_t)t * 128 + g * 16 + fq * 4);
      float4 wv;
      wv.x = gt.x * gelu_exact(acc[g][0]);
      wv.y = gt.y * gelu_exact(acc[g][1]);
      wv.z = gt.z * gelu_exact(acc[g][2]);
      wv.w = gt.w * gelu_exact(acc[g][3]);
      if (fr == 0) *reinterpret_cast<float4*>(wgt + g * 16 + fq * 4) = wv;
    }
    __builtin_amdgcn_wave_barrier();
    float f[16];
#pragma unroll
    for (int e = 0; e < 16; ++e) f[e] = 0.f;
    {
      const int lane = tidx(gwid) & 63;
#define P4V_ISSUE(pp, slot) do { const int _idx = il[2 * (pp) + (lane >> 5)]; \
        __builtin_amdgcn_global_load_lds((const unsigned*)(V + (size_t)_idx * 512 + (lane & 31) * 16), (unsigned*)(ring + (slot) * 1024 + lane * 16), 16, 0, 0); } while (0)
#define P4V_ROW(ee, slot) do { \
        const uint2 cv = *reinterpret_cast<const uint2*>(ring + (slot) * 1024 + ((ee) & 1) * 512 + lane * 8); \
        const unsigned sb = vscl[(ee) * 32 + (lane >> 1)]; \
        const float ws = wgt[ee] * __uint_as_float(sb << 23); \
        P4V_Q(0) P4V_Q(1) P4V_Q(2) P4V_Q(3) } while (0)
#define P4V_Q(q) { const __attribute__((ext_vector_type(2))) float a2 = __builtin_amdgcn_cvt_scalef32_pk_f32_fp4(cv.x, 1.0f, q); \
          const __attribute__((ext_vector_type(2))) float b2 = __builtin_amdgcn_cvt_scalef32_pk_f32_fp4(cv.y, 1.0f, q); \
          f[2 * q] += ws * a2.x; f[2 * q + 1] += ws * a2.y; f[8 + 2 * q] += ws * b2.x; f[8 + 2 * q + 1] += ws * b2.y; }
#pragma unroll
      for (int k = 0; k < 12; ++k) P4V_ISSUE(k, k);
#pragma unroll 1
      for (int pb = 0; pb < 4; ++pb) {
#pragma unroll
        for (int k = 0; k < 12; ++k) {
          const int pp = pb * 12 + k;
          P4_WAITV(11);
          P4V_ROW(2 * pp, k);
          P4V_ROW(2 * pp + 1, k);
          asm volatile("s_waitcnt lgkmcnt(0)" ::: "memory");
          P4V_ISSUE(pp + 12, k);
        }
      }
#pragma unroll
      for (int k = 0; k < 4; ++k) {
        const int pp = 48 + k;
        P4_WAITV(11);
        P4V_ROW(2 * pp, k);
        P4V_ROW(2 * pp + 1, k);
        asm volatile("s_waitcnt lgkmcnt(0)" ::: "memory");
        P4V_ISSUE(pp + 12, k);
      }
#define P4V_TAIL(pp, slot, n) P4_WAITV(n); P4V_ROW(2 * (pp), slot); P4V_ROW(2 * (pp) + 1, slot);
      P4V_TAIL(52, 4, 11) P4V_TAIL(53, 5, 10) P4V_TAIL(54, 6, 9) P4V_TAIL(55, 7, 8) P4V_TAIL(56, 8, 7) P4V_TAIL(57, 9, 6)
      P4V_TAIL(58, 10, 5) P4V_TAIL(59, 11, 4) P4V_TAIL(60, 0, 3) P4V_TAIL(61, 1, 2) P4V_TAIL(62, 2, 1) P4V_TAIL(63, 3, 0)
#undef P4V_TAIL
#undef P4V_ISSUE
#undef P4V_ROW
#undef P4V_Q
#undef P4_WAITV
    }
    const int gl2 = tidx(gwid) & 63;
    const bool next_attn = (layer == 0 || layer == 2);
    const float* mdn = p.mod + ((size_t)(layer + 1) * 9 + cond_of_row(t)) * 6144;
    const float* md = p.mod + ((size_t)layer * 9 + cond_of_row(t)) * 6144 + 5 * 1024;
    float zz[16];
    float s = 0.f;
#pragma unroll
    for (int q = 0; q < 4; ++q) {
      const int col = gl2 * 16 + q * 4;
      const float4 x0 = *reinterpret_cast<const float4*>(p.xbuf + (size_t)t * DM + col);
      const float4 g0 = *reinterpret_cast<const float4*>(md + col);
      zz[q * 4 + 0] = ALPHA_F * x0.x + g0.x * f[q * 4 + 0];
      zz[q * 4 + 1] = ALPHA_F * x0.y + g0.y * f[q * 4 + 1];
      zz[q * 4 + 2] = ALPHA_F * x0.z + g0.z * f[q * 4 + 2];
      zz[q * 4 + 3] = ALPHA_F * x0.w + g0.w * f[q * 4 + 3];
      s += zz[q * 4] + zz[q * 4 + 1] + zz[q * 4 + 2] + zz[q * 4 + 3];
    }
    const float mean = wave_sum(s) * (1.0f / 1024.0f);
    float sv = 0.f;
#pragma unroll
    for (int e = 0; e < 16; ++e) { float d = zz[e] - mean; sv += d * d; }
    const float rstd = rsqrtf(wave_sum(sv) * (1.0f / 1024.0f) + LN_EPS_F);
#pragma unroll
    for (int q = 0; q < 4; ++q) {
      const int col = gl2 * 16 + q * 4;
      const float4 g0 = *reinterpret_cast<const float4*>(lng + col);
      const float4 b0 = *reinterpret_cast<const float4*>(lnb + col);
      float4 o0;
      o0.x = (zz[q * 4 + 0] - mean) * rstd * g0.x + b0.x;
      o0.y = (zz[q * 4 + 1] - mean) * rstd * g0.y + b0.y;
      o0.z = (zz[q * 4 + 2] - mean) * rstd * g0.z + b0.z;
      o0.w = (zz[q * 4 + 3] - mean) * rstd * g0.w + b0.w;
      *reinterpret_cast<float4*>(xout + (size_t)t * DM + col) = o0;
      if (next_attn) {
        const float4 sh = *reinterpret_cast<const float4*>(mdn + col);
        const float4 sc = *reinterpret_cast<const float4*>(mdn + 1024 + col);
        uint2 hb;
        hb.x = pack2(o0.x * (1.0f + sc.x) + sh.x, o0.y * (1.0f + sc.y) + sh.y);
        hb.y = pack2(o0.z * (1.0f + sc.z) + sh.z, o0.w * (1.0f + sc.w) + sh.w);
        *reinterpret_cast<uint2*>(p.hbuf + (size_t)t * DM + col) = hb;
      }
    }
  }
}

DEVINL void phase_a1(const Params& p, int layer, int w, int nw, int gwid) {
  const int lane = tidx(gwid) & 63;
  const int gw = w * NWAVES + (tidx(gwid) >> 6), ngw = nw * NWAVES;
  for (int row = gw; row < TT; row += ngw) {
    const float* md = p.mod + ((size_t)layer * 9 + cond_of_row(row)) * 6144;
#pragma unroll
    for (int k = 0; k < 4; ++k) {
      const int col = k * 256 + lane * 4;
      const float4 x = *reinterpret_cast<const float4*>(p.xbuf + (size_t)row * DM + col);
      const float4 sh = *reinterpret_cast<const float4*>(md + col);
      const float4 sc = *reinterpret_cast<const float4*>(md + 1024 + col);
      uint2 o;
      o.x = pack2(x.x * (1.0f + sc.x) + sh.x, x.y * (1.0f + sc.y) + sh.y);
      o.y = pack2(x.z * (1.0f + sc.z) + sh.z, x.w * (1.0f + sc.w) + sh.w);
      *reinterpret_cast<uint2*>(p.hbuf + (size_t)row * DM + col) = o;
    }
  }
}

DEVINL void phase_a2(const Params& p, int layer, int w, int nw, char* smem, int gwid) {
  const int j = layer >> 1;
  EpiBf16 E; E.O = reinterpret_cast<bf16_t*>(p.U1); E.ldc = 1536;
  pg8::ASelOne as; as.A = (const char*)p.hbuf;
  pg8::StaticOrder S; S.init(TT, 1536, nw, w);
  pg8::gemm_phase<EpiBf16, pg8::ASelOne>((PG8_LAS unsigned char*)smem, as, p.attn_wqkv_t + (size_t)j * 1536 * 1024, 1024, S, E, gwid);
}

DEVINL void load16(const bf16_t* src, float (&x)[16]) {
  const uint4 a = *reinterpret_cast<const uint4*>(src);
  const uint4 b = *reinterpret_cast<const uint4*>(src + 8);
  x[0] = bflo(a.x); x[1] = bfhi(a.x); x[2] = bflo(a.y); x[3] = bfhi(a.y); x[4] = bflo(a.z); x[5] = bfhi(a.z); x[6] = bflo(a.w); x[7] = bfhi(a.w);
  x[8] = bflo(b.x); x[9] = bfhi(b.x); x[10] = bflo(b.y); x[11] = bfhi(b.y); x[12] = bflo(b.z); x[13] = bfhi(b.z); x[14] = bflo(b.w); x[15] = bfhi(b.w);
}
DEVINL void store16bf(bf16_t* dst, const float (&x)[16]) {
  uint4 a, b;
  a.x = pack2(x[0], x[1]); a.y = pack2(x[2], x[3]); a.z = pack2(x[4], x[5]); a.w = pack2(x[6], x[7]);
  b.x = pack2(x[8], x[9]); b.y = pack2(x[10], x[11]); b.z = pack2(x[12], x[13]); b.w = pack2(x[14], x[15]);
  *reinterpret_cast<uint4*>(dst) = a; *reinterpret_cast<uint4*>(dst + 8) = b;
}
DEVINL void headnorm_rope(float (&x)[16], const float* nwgt, int quarter, bool lat, int t, const float* rope) {
  float ss = 0.f;
#pragma unroll
  for (int e = 0; e < 16; ++e) ss += x[e] * x[e];
  ss += __shfl_xor(ss, 1); ss += __shfl_xor(ss, 2);
  const float rinv = rsqrtf(ss * (1.0f / 64.0f) + RMS_EPS_F);
#pragma unroll
  for (int e = 0; e < 16; ++e) x[e] = x[e] * rinv * nwgt[quarter * 16 + e];
  if (lat) {
    const int pos = (quarter < 2) ? (t >> 6) : (t & 63);
    const bool hi = quarter & 1;
#pragma unroll
    for (int e = 0; e < 16; ++e) {
      const float other = __shfl_xor(x[e], 1);
      const float c = rope[(pos * 16 + e) * 2], s = rope[(pos * 16 + e) * 2 + 1];
      x[e] = hi ? (x[e] * c + other * s) : (x[e] * c - other * s);
    }
  }
}

DEVINL void phase_a2b(const Params& p, int layer, int w, int nw, int gwid) {
  const int j = layer >> 1;
  const int lane = tidx(gwid) & 63;
  const int gw = w * NWAVES + (tidx(gwid) >> 6), ngw = nw * NWAVES;
  const bf16_t* qkv = reinterpret_cast<const bf16_t*>(p.U1);
  bf16_t* qb = reinterpret_cast<bf16_t*>(p.U2);
  const float* qn = p.in[29] + j * 64;
  const float* kn = p.in[30] + j * 64;
  for (int row = gw; row < TT; row += ngw) {
    const bool lat = row >= TCTX;
    const int t = lat ? ((row - TCTX) & 1023) : (row & 255);
    const int b = lat ? ((row - TCTX) >> 10) : (row >> 8);
    const bf16_t* src = qkv + (size_t)row * 1536;
    {
      float x[16];
      load16(src + lane * 16, x);
      headnorm_rope(x, qn, lane & 3, lat, t, p.rope);
#pragma unroll
      for (int e = 0; e < 16; ++e) x[e] *= QSCALE_F;
      store16bf(qb + (size_t)row * DM + lane * 16, x);
    }
    if (lane < 16) {
      const int kvh = lane >> 2, quarter = lane & 3;
      float x[16];
      load16(src + 1024 + lane * 16, x);
      headnorm_rope(x, kn, quarter, false, t, p.rope);
      if (lat) {
        const int pos = (quarter < 2) ? (t >> 6) : (t & 63);
        const bool hi = quarter & 1;
#pragma unroll
        for (int e = 0; e < 16; ++e) {
          const float other = __shfl_xor(x[e], 1);
          const float c = p.rope[(pos * 16 + e) * 2], s = p.rope[(pos * 16 + e) * 2 + 1];
          x[e] = hi ? (x[e] * c + other * s) : (x[e] * c - other * s);
        }
        store16bf(p.Klat + ((size_t)((j * 8 + b) * 4 + kvh) * 1536 + 512 + t) * 64 + quarter * 16, x);
      } else {
        store16bf(p.Kctx + ((size_t)((j * 16 + b) * 4 + kvh) * 256 + t) * 64 + quarter * 16, x);
        float* ko = p.out + OUT_CK + ((size_t)(b * 2 + j) * 256 + t) * 256 + kvh * 64 + quarter * 16;
#pragma unroll
        for (int q4 = 0; q4 < 4; ++q4) reinterpret_cast<float4*>(ko)[q4] = make_float4(x[q4 * 4], x[q4 * 4 + 1], x[q4 * 4 + 2], x[q4 * 4 + 3]);
      }
    } else if (lane < 32) {
      const int l2 = lane - 16;
      const int kvh = l2 >> 2, quarter = l2 & 3;
      float x[16];
      load16(src + 1280 + l2 * 16, x);
      if (lat) {
        bf16_t* vd = p.VlatT + (size_t)((j * 8 + b) * 4 + kvh) * 64 * 1536 + 512 + t;
#pragma unroll
        for (int e = 0; e < 16; ++e) vd[(size_t)(quarter * 16 + e) * 1536] = f2bf(x[e]);
      } else {
        bf16_t* vd = p.VctxT + (size_t)((j * 16 + b) * 4 + kvh) * 64 * 256 + t;
#pragma unroll
        for (int e = 0; e < 16; ++e) vd[(size_t)(quarter * 16 + e) * 256] = f2bf(x[e]);
        float* vo = p.out + OUT_CV + ((size_t)(b * 2 + j) * 256 + t) * 256 + kvh * 64 + quarter * 16;
#pragma unroll
        for (int q4 = 0; q4 < 4; ++q4) reinterpret_cast<float4*>(vo)[q4] = make_float4(x[q4 * 4], x[q4 * 4 + 1], x[q4 * 4 + 2], x[q4 * 4 + 3]);
      }
    }
  }
}

DEVINL void phase_a3(const Params& p, int layer, int w, int nw, char* smem, int gwid) {
  const int j = layer >> 1;
  const int lane = tidx(gwid) & 63, wid = __builtin_amdgcn_readfirstlane(tidx(gwid) >> 6);
  const int ql = lane & 31, hh = lane >> 5;
  const bf16_t* qb = reinterpret_cast<const bf16_t*>(p.U2);
  const int drow = wid * 8 + (lane >> 3);
  const int dsp = (lane & 7) ^ ((lane >> 3) & 7);
  for (int item = w; item < 768; item += nw) {
    int kvh, Tk, row0;
    const bf16_t *Kb, *Vt;
    if (item < 512) {
      const int b = item >> 6, qblk = item & 15;
      kvh = (item >> 4) & 3;
      Kb = p.Klat + (size_t)((j * 8 + b) * 4 + kvh) * 1536 * 64;
      Vt = p.VlatT + (size_t)((j * 8 + b) * 4 + kvh) * 64 * 1536;
      Tk = 1536; row0 = TCTX + b * 1024 + qblk * 64;
    } else {
      const int it = item - 512;
      const int b = it >> 4, qblk = it & 3;
      kvh = (it >> 2) & 3;
      Kb = p.Kctx + (size_t)((j * 16 + b) * 4 + kvh) * 256 * 64;
      Vt = p.VctxT + (size_t)((j * 16 + b) * 4 + kvh) * 64 * 256;
      Tk = 256; row0 = b * 256 + qblk * 64;
    }
    const int hq = kvh * 4 + (wid >> 1);
    const int qrow = row0 + (wid & 1) * 32 + ql;
    bf16x8 bq[4];
#pragma unroll
    for (int ks = 0; ks < 4; ++ks) bq[ks] = *reinterpret_cast<const bf16x8*>(qb + (size_t)qrow * DM + hq * 64 + ks * 16 + hh * 8);
    f32x16 o0, o1;
#pragma unroll
    for (int r = 0; r < 16; ++r) { o0[r] = 0.f; o1[r] = 0.f; }
    float mrun = -1e30f, lrun = 0.f;
    const int ntile = Tk >> 6;
#define A3_DMA(kt_, st_) do { \
      __builtin_amdgcn_global_load_lds((const unsigned*)(Kb + (size_t)((kt_) * 64 + drow) * 64 + dsp * 8), (unsigned*)(smem + (st_) * 16384 + wid * 1024 + lane * 16), 16, 0, 0); \
      __builtin_amdgcn_global_load_lds((const unsigned*)(Vt + (size_t)drow * Tk + (kt_) * 64 + dsp * 8), (unsigned*)(smem + (st_) * 16384 + 8192 + wid * 1024 + lane * 16), 16, 0, 0); } while (0)
    __syncthreads();
    A3_DMA(0, 0);
    for (int kt = 0; kt < ntile; ++kt) {
      asm volatile("s_waitcnt vmcnt(0)" ::: "memory");
      __syncthreads();
      if (kt + 1 < ntile) A3_DMA(kt + 1, (kt + 1) & 1);
      const char* Kt_ = smem + (kt & 1) * 16384;
      const char* Vt_ = Kt_ + 8192;
      f32x16 sacc[2];
#pragma unroll
      for (int kb2 = 0; kb2 < 2; ++kb2) {
#pragma unroll
        for (int r = 0; r < 16; ++r) sacc[kb2][r] = 0.f;
        const int r_ = kb2 * 32 + ql;
#pragma unroll
        for (int ks = 0; ks < 4; ++ks) {
          const bf16x8 ka = *reinterpret_cast<const bf16x8*>(Kt_ + r_ * 128 + (((ks * 2 + hh) ^ (r_ & 7)) * 16));
          sacc[kb2] = __builtin_amdgcn_mfma_f32_32x32x16_bf16(ka, bq[ks], sacc[kb2], 0, 0, 0);
        }
      }
      float tmax = sacc[0][0];
#pragma unroll
      for (int r = 1; r < 16; ++r) tmax = fmaxf(tmax, sacc[0][r]);
#pragma unroll
      for (int r = 0; r < 16; ++r) tmax = fmaxf(tmax, sacc[1][r]);
      tmax = fmaxf(tmax, __shfl_xor(tmax, 32));
      const float mnew = fmaxf(mrun, tmax);
      const float corr = exp2f(mrun - mnew);
      mrun = mnew;
      lrun *= corr;
#pragma unroll
      for (int r = 0; r < 16; ++r) { o0[r] *= corr; o1[r] *= corr; }
#pragma unroll
      for (int kb2 = 0; kb2 < 2; ++kb2) {
        float pv[16];
#pragma unroll
        for (int r = 0; r < 16; ++r) { pv[r] = exp2f(sacc[kb2][r] - mnew); lrun += pv[r]; }
#pragma unroll
        for (int s2 = 0; s2 < 2; ++s2) {
          union { bf16x8 v; unsigned u[4]; } pb;
#pragma unroll
          for (int q = 0; q < 4; ++q) pb.u[q] = pack2(pv[s2 * 8 + q * 2], pv[s2 * 8 + q * 2 + 1]);
          const int P1 = 4 * kb2 + 2 * s2;
#pragma unroll
          for (int dblk = 0; dblk < 2; ++dblk) {
            const int r_ = dblk * 32 + ql;
            const uint2 lo = *reinterpret_cast<const uint2*>(Vt_ + r_ * 128 + ((P1 ^ (r_ & 7)) * 16) + 8 * hh);
            const uint2 hi = *reinterpret_cast<const uint2*>(Vt_ + r_ * 128 + (((P1 + 1) ^ (r_ & 7)) * 16) + 8 * hh);
            union { bf16x8 v; unsigned u[4]; } va;
            va.u[0] = lo.x; va.u[1] = lo.y; va.u[2] = hi.x; va.u[3] = hi.y;
            if (dblk == 0) o0 = __builtin_amdgcn_mfma_f32_32x32x16_bf16(va.v, pb.v, o0, 0, 0, 0);
            else o1 = __builtin_amdgcn_mfma_f32_32x32x16_bf16(va.v, pb.v, o1, 0, 0, 0);
          }
        }
      }
    }
#undef A3_DMA
    const float ltot = lrun + __shfl_xor(lrun, 32);
    const float inv = 1.0f / ltot;
#pragma unroll
    for (int g = 0; g < 4; ++g) {
      uint2 oa, ob;
      oa.x = pack2(o0[4 * g] * inv, o0[4 * g + 1] * inv); oa.y = pack2(o0[4 * g + 2] * inv, o0[4 * g + 3] * inv);
      ob.x = pack2(o1[4 * g] * inv, o1[4 * g + 1] * inv); ob.y = pack2(o1[4 * g + 2] * inv, o1[4 * g + 3] * inv);
      *reinterpret_cast<uint2*>(p.abuf + (size_t)qrow * DM + hq * 64 + 8 * g + 4 * hh) = oa;
      *reinterpret_cast<uint2*>(p.abuf + (size_t)qrow * DM + hq * 64 + 32 + 8 * g + 4 * hh) = ob;
    }
  }
}

#define XB_TMO      128
#define XB_XCNT(j)  (256  + 64 * (j))
#define XB_XSUB(j)  (1280 + 64 * (j))
#define XB_XGEN(j)  (2304 + 64 * (j))
#define XB_TOP      3328
#define XB_TOPGEN   3392
#define XCD_BAR_WORDS 3456
#define XB_SPIN_CAP (1u << 22)
#define LAS __attribute__((address_space(3)))

DEVINL unsigned xb_ld(unsigned* p) { return __hip_atomic_load(p, __ATOMIC_RELAXED, __HIP_MEMORY_SCOPE_AGENT); }
DEVINL unsigned xb_add(unsigned* p, unsigned v) { return __hip_atomic_fetch_add(p, v, __ATOMIC_RELAXED, __HIP_MEMORY_SCOPE_AGENT); }
DEVINL unsigned xb_xcc_id() { return (unsigned)__builtin_amdgcn_s_getreg((3 << 11) | 20) & 0xFu; }
#define XB_SPIN(cond, bar) do { unsigned _sp = 0; while (cond) { __builtin_amdgcn_s_sleep(1); \
    if ((++_sp & 255u) == 0u) { if (xb_ld(&(bar)[XB_TMO])) break; if (_sp > XB_SPIN_CAP) { atomicAdd(&(bar)[XB_TMO], 1u); break; } } } } while (0)

struct XcdBarrier { unsigned* bar; unsigned x; volatile LAS unsigned* st; };

DEVINL XcdBarrier xcd_barrier_post(unsigned* bar, volatile LAS unsigned* st) {
  XcdBarrier b; b.bar = bar; b.x = xb_xcc_id(); b.st = st;
  if (threadIdx.x == 0) (void)xb_add(&bar[XB_XCNT(b.x)], 1u);
  return b;
}
DEVINL void xcd_barrier_complete(unsigned* bar, unsigned x, unsigned& nloc, unsigned& nx) {
  const unsigned G = gridDim.x * gridDim.y * gridDim.z;
  unsigned sum, cnt, mine, sp = 0u;
  for (;;) {
    sum = 0u; cnt = 0u; mine = 0u;
#pragma unroll
    for (unsigned j = 0; j < 16; ++j) { const unsigned c = xb_ld(&bar[XB_XCNT(j)]); sum += c; cnt += (c > 0u) ? 1u : 0u; mine = (j == x) ? c : mine; }
    if (sum == G) break;
    __builtin_amdgcn_s_sleep(1);
    if ((++sp & 255u) == 0u) { if (xb_ld(&bar[XB_TMO])) break; if (sp > XB_SPIN_CAP) { atomicAdd(&bar[XB_TMO], 1u); break; } }
  }
  nloc = mine > 0u ? mine : 1u; nx = cnt > 0u ? cnt : 1u;
}
DEVINL void xcd_barrier(const XcdBarrier& b) {
  asm volatile("s_waitcnt vmcnt(0)" ::: "memory");
  __syncthreads();
  if (threadIdx.x == 0) {
    unsigned* bar = b.bar;
    __builtin_amdgcn_s_waitcnt(0);
    unsigned nloc = b.st[0], nx = b.st[1];
    if (nloc == 0u) { xcd_barrier_complete(bar, b.x, nloc, nx); b.st[0] = nloc; b.st[1] = nx; }
    const unsigned old = xb_add(&bar[XB_XSUB(b.x)], 1u);
    const unsigned gen = old / nloc;
    if (old + 1u == (gen + 1u) * nloc) {
      __builtin_amdgcn_fence(__ATOMIC_RELEASE, "agent");
      asm volatile("s_waitcnt vmcnt(0)" ::: "memory");
      const unsigned og = xb_add(&bar[XB_TOP], 1u);
      const unsigned tg = og / nx;
      if (og + 1u == (tg + 1u) * nx) xb_add(&bar[XB_TOPGEN], 1u);
      else XB_SPIN(xb_ld(&bar[XB_TOPGEN]) == tg, bar);
      __builtin_amdgcn_fence(__ATOMIC_ACQUIRE, "agent");
      xb_add(&bar[XB_XGEN(b.x)], 1u);
      asm volatile("s_waitcnt vmcnt(0)" ::: "memory");
    } else {
      XB_SPIN(xb_ld(&bar[XB_XGEN(b.x)]) == gen, bar);
      __builtin_amdgcn_fence(__ATOMIC_ACQUIRE, "agent");
      asm volatile("s_waitcnt vmcnt(0)" ::: "memory");
    }
  }
  __syncthreads();
}

extern __shared__ __attribute__((aligned(16))) char dyn_smem[];
__global__ void __launch_bounds__(NTHREADS, 2) mega_kernel(Params p) {
  char* smem = dyn_smem;
  cg::grid_group grid = cg::this_grid();
  const int w = blockIdx.x, nw = gridDim.x;
  const int gwid = __builtin_amdgcn_readfirstlane((int)(threadIdx.x >> 6));
  if (p.use_cg_sync) grid.sync();
  volatile LAS unsigned* xst = (volatile LAS unsigned*)(smem + SMEM_BYTES - 16);
  if (threadIdx.x == 0) { xst[0] = 0u; xst[1] = 0u; }
  __syncthreads();
  XcdBarrier xb = xcd_barrier_post(p.bar, xst);
#define GSYNC() xcd_barrier(xb)
#ifndef REP_PREP
#define REP_PREP 1
#endif
#ifndef REP_R4
#define REP_R4 1
#endif
#ifndef REP_P3
#define REP_P3 1
#endif
#ifndef REP_P4L3
#define REP_P4L3 1
#endif
#ifndef REP_A3
#define REP_A3 1
#endif
#ifndef REP_GEMM
#define REP_GEMM 1
#endif
#ifndef REP_SG
#define REP_SG 1
#endif
#ifndef REP_EW
#define REP_EW 1
#endif
  for (int rep = 0; rep < REP_PREP; ++rep) { phase_prep(p, w, nw, smem, gwid); GSYNC(); }
  for (int layer = 0; layer < 4; ++layer) {
    if ((layer & 1) == 0) {
      for (int rep = 0; rep < REP_EW; ++rep) { phase_r1(p, layer, w, nw, gwid); GSYNC(); }
      for (int rep = 0; rep < REP_GEMM; ++rep) { phase_r2(p, layer, w, nw, smem, gwid); GSYNC(); }
      for (int rep = 0; rep < REP_SG; ++rep) { phase_r3(p, layer, w, nw, smem, gwid); GSYNC(); }
      for (int rep = 0; rep < REP_R4; ++rep) { phase_r4(p, layer, w, nw, smem, gwid); GSYNC(); }
      for (int rep = 0; rep < REP_EW; ++rep) { phase_r5(p, layer, w, nw, gwid); GSYNC(); }
    } else {
      for (int rep = 0; rep < REP_GEMM; ++rep) { phase_a2(p, layer, w, nw, smem, gwid); GSYNC(); }
      for (int rep = 0; rep < REP_EW; ++rep) { phase_a2b(p, layer, w, nw, gwid); GSYNC(); }
      for (int rep = 0; rep < REP_A3; ++rep) { phase_a3(p, layer, w, nw, smem, gwid); GSYNC(); }
    }
    for (int rep = 0; rep < REP_GEMM; ++rep) { phase_wo(p, layer, w, nw, smem, gwid); GSYNC(); }
    for (int rep = 0; rep < REP_EW; ++rep) { phase_ln1(p, layer, w, nw, gwid); GSYNC(); }
    for (int rep = 0; rep < REP_GEMM; ++rep) { phase_p1(p, layer, w, nw, smem, gwid); GSYNC(); }
    for (int rep = 0; rep < REP_P3; ++rep) { phase_p23(p, layer, w, nw, smem, gwid); GSYNC(); }
    for (int rep = 0; rep < (layer == 3 ? REP_P4L3 : 1); ++rep) { phase_p4(p, layer, w, nw, smem, gwid); GSYNC(); }
  }
}

static inline char* carve(char*& cur, size_t bytes) {
  char* r = cur;
  cur += (bytes + 255) & ~(size_t)255;
  return r;
}

extern "C" void kernel_launch(void* const* d_in, const int* in_sizes, int n_in, void* d_out, int out_size, void* d_ws,
                              size_t ws_size, hipStream_t stream) {
  Params p;
  memset(&p, 0, sizeof(p));
  for (int i = 0; i < 35; ++i) p.in[i] = (const float*)d_in[i];
  p.out = (float*)d_out;
  char* cur = (char*)d_ws;
  p.bar = (unsigned*)carve(cur, 16384);
  p.mod = (float*)carve(cur, (size_t)4 * 9 * 6144 * 4);
  p.rope = (float*)carve(cur, 64 * 16 * 2 * 4);
  p.rwkv_in_t = (bf16_t*)carve(cur, (size_t)2 * RW_N * 1024 * 2);
  p.w2t = (bf16_t*)carve(cur, (size_t)4 * 65536 * 2);
  p.a2t = (bf16_t*)carve(cur, (size_t)4 * 65536 * 2);
  p.g2t = (bf16_t*)carve(cur, (size_t)2 * 131072 * 2);
  p.rwkv_wo_t = (bf16_t*)carve(cur, (size_t)2 * 1048576 * 2);
  p.attn_wqkv_t = (bf16_t*)carve(cur, (size_t)2 * 1536 * 1024 * 2);
  p.attn_wo_t = (bf16_t*)carve(cur, (size_t)2 * 1048576 * 2);
  p.wq_t = (bf16_t*)carve(cur, (size_t)4 * 2048 * 1024 * 2);
  p.keysb = (bf16_t*)carve(cur, (size_t)4 * 2 * 128 * 128 * 2);
  p.ub = (bf16_t*)carve(cur, (size_t)4 * 16384 * 1024 * 2);
  p.vb = (bf16_t*)carve(cur, (size_t)4 * 16384 * 1024 * 2);
  p.uinv = (float*)carve(cur, (size_t)65536 * 4);
  p.vinv = (float*)carve(cur, (size_t)65536 * 4);
  p.Klat = (bf16_t*)carve(cur, (size_t)2 * 8 * 4 * 1536 * 64 * 2);
  p.VlatT = (bf16_t*)carve(cur, (size_t)2 * 8 * 4 * 1536 * 64 * 2);
  p.Kctx = (bf16_t*)carve(cur, (size_t)2 * 16 * 4 * 256 * 64 * 2);
  p.VctxT = (bf16_t*)carve(cur, (size_t)2 * 16 * 4 * 256 * 64 * 2);
  p.xbuf = (float*)carve(cur, (size_t)TT * DM * 4);
  p.zbuf = (float*)carve(cur, (size_t)TT * DM * 4);
  p.hbuf = (bf16_t*)carve(cur, (size_t)TT * DM * 2);
  p.abuf = (bf16_t*)carve(cur, (size_t)TT * DM * 2);
  p.U1 = carve(cur, (size_t)TT * DM * 14);
  p.U2 = carve(cur, (size_t)TT * DM * 8);
  p.U3 = carve(cur, (size_t)TT * DM * 8);
  p.pidx = (int*)carve(cur, (size_t)TT * 128 * 4);
  p.pgate = (float*)carve(cur, (size_t)TT * 128 * 4);
  for (int f = 0; f < 16; ++f) p.freqs[f] = pow(10000.0, -(double)f / 16.0);
  if ((size_t)(cur - (char*)d_ws) > ws_size) {
    fprintf(stderr, "workspace too small: need %zu have %zu\n", (size_t)(cur - (char*)d_ws), ws_size);
    return;
  }
  static int grid_blocks = 0;
  if (!grid_blocks) {
    int dev = 0, cus = 0, per_cu = 0;
    (void)hipGetDevice(&dev);
    (void)hipDeviceGetAttribute(&cus, hipDeviceAttributeMultiprocessorCount, dev);
    (void)hipFuncSetAttribute((const void*)mega_kernel, hipFuncAttributeMaxDynamicSharedMemorySize, SMEM_BYTES);
    (void)hipOccupancyMaxActiveBlocksPerMultiprocessor(&per_cu, mega_kernel, NTHREADS, SMEM_BYTES);
    if (per_cu > 1) per_cu = 1;
    if (per_cu < 1) per_cu = 1;
    grid_blocks = cus * per_cu;
  }
  (void)hipMemsetAsync(p.bar, 0, 16384, stream);
  void* args[] = {&p};
  hipError_t e = hipLaunchCooperativeKernel((void*)mega_kernel, dim3(grid_blocks), dim3(NTHREADS), args, SMEM_BYTES, stream);
  if (e != hipSuccess) fprintf(stderr, "cooperative launch failed: %s (grid %d)\n", hipGetErrorString(e), grid_blocks);
}
```
